# Optimizing an MI355X kernel written in HIP

```python
import math
import jax, jax.numpy as jnp
from jax import lax
import numpy as np

D_MODEL = 1024
BATCH = 1
SEQ = 16384
DEPTH = 2
DEC_BATCH = 16
DEC_SEQ = 64
PAST_LEN = 4096

CHUNK = 64
N_A = DEPTH // 2
N_B = DEPTH - N_A
ML_HEADS = 4
ML_HEAD_DIM = D_MODEL // ML_HEADS
ML_WIDTH = ML_HEADS * ML_HEAD_DIM
DA_HEAD_DIM = 64
DA_V_DIM = 2 * DA_HEAD_DIM
DA_HEADS = D_MODEL // DA_V_DIM
DA_QK_WIDTH = DA_HEADS * 2 * DA_HEAD_DIM
DA_V_WIDTH = DA_HEADS * DA_V_DIM
MEM_LEN = 256
MEM_HEADS = 4
MEM_HEAD_DIM = 128
MEM_WIDTH = MEM_HEADS * MEM_HEAD_DIM
A_IN = 5 * ML_WIDTH + 2 * ML_HEADS + 2 * MEM_WIDTH
B_IN = DA_QK_WIDTH + DA_V_WIDTH + 2 * MEM_WIDTH
A_SPLITS = [ML_WIDTH, 2 * ML_WIDTH, 3 * ML_WIDTH, 4 * ML_WIDTH, 5 * ML_WIDTH,
            5 * ML_WIDTH + 2 * ML_HEADS, 5 * ML_WIDTH + 2 * ML_HEADS + MEM_WIDTH]
B_SPLITS = [DA_QK_WIDTH, DA_QK_WIDTH + DA_V_WIDTH, DA_QK_WIDTH + DA_V_WIDTH + MEM_WIDTH]
Q_BLOCK = 128
EPS = 1e-6

kernel_name = "yoco_mlstm_diffattn_stream_step"


def _rmsnorm(x, g):
    x32 = x.astype(jnp.float32)
    y = x32 * lax.rsqrt(jnp.mean(x32 * x32, axis=-1, keepdims=True) + EPS)
    return (y * g.astype(jnp.float32)).astype(x.dtype)


def _mem_attend(q, mem_k, mem_v):
    s = jnp.einsum('bthd,bmhd->bhtm', q, mem_k).astype(jnp.float32) * (MEM_HEAD_DIM ** -0.5)
    p = jax.nn.softmax(s, axis=-1).astype(mem_v.dtype)
    return jnp.einsum('bhtm,bmhd->bthd', p, mem_v)


def _mlstm_chunk(carry, xs):
    C, n, m = carry
    q, k, v, ig, lf = xs
    L = q.shape[2]
    g = jnp.cumsum(lf, axis=-1)
    causal = jnp.tril(jnp.ones((L, L), dtype=bool))
    dmat = jnp.where(causal, g[..., :, None] - g[..., None, :] + ig[..., None, :], -jnp.inf)
    inter = g + m[..., None]
    m_t = jnp.maximum(inter, jnp.max(dmat, axis=-1))
    w_intra = jnp.exp(dmat - m_t[..., None])
    w_inter = jnp.exp(inter - m_t)
    s = w_intra * jnp.einsum('bhtd,bhsd->bhts', q, k)
    num = w_inter[..., None] * jnp.einsum('bhvk,bhtk->bhtv', C, q) + jnp.einsum('bhts,bhsv->bhtv', s, v)
    den = w_inter * jnp.einsum('bhk,bhtk->bht', n, q) + jnp.sum(s, axis=-1)
    h = num / jnp.maximum(jnp.abs(den), jnp.exp(-m_t))[..., None]
    g_last = g[..., -1]
    m_new = m_t[..., -1]
    w_s = jnp.exp(g_last[..., None] - g + ig - m_new[..., None])
    dec = jnp.exp(g_last + m - m_new)
    C_new = dec[..., None, None] * C + jnp.einsum('bhs,bhsv,bhsk->bhvk', w_s, v, k)
    n_new = dec[..., None] * n + jnp.einsum('bhs,bhsk->bhk', w_s, k)
    return (C_new, n_new, m_new), h


def _mlstm_layer(x, C0, n0, m0, mem_k, mem_v, norm_g, w_in, b_gate, head_g, w_out):
    B, T, _ = x.shape
    H, dh = ML_HEADS, ML_HEAD_DIM
    f32 = jnp.float32
    p = _rmsnorm(x, norm_g) @ w_in
    q, k, v, o, z, gates, mq, mz = jnp.split(p, A_SPLITS, axis=-1)
    gates = gates.astype(f32) + b_gate.astype(f32)
    ig = gates[..., :H]
    lf = jax.nn.log_sigmoid(gates[..., H:])
    L = min(T, CHUNK)
    nc = T // L

    def to_chunks(a):
        return a.reshape(B, nc, L, H, -1).transpose(1, 0, 3, 2, 4)

    qc = to_chunks(q.astype(f32))
    kc = to_chunks(k.astype(f32)) * (dh ** -0.5)
    vc = to_chunks(v.astype(f32))
    igc = to_chunks(ig)[..., 0]
    lfc = to_chunks(lf)[..., 0]
    (C, n, m), hc = lax.scan(_mlstm_chunk, (C0.astype(f32), n0.astype(f32), m0.astype(f32)),
                             (qc, kc, vc, igc, lfc))
    hm = hc.transpose(1, 0, 3, 2, 4).reshape(B, T, H, dh)
    hm = jax.nn.sigmoid(o.astype(f32)).reshape(B, T, H, dh) * hm
    hm = hm * lax.rsqrt(jnp.mean(hm * hm, axis=-1, keepdims=True) + EPS)
    hm = (hm * head_g.astype(f32).reshape(H, dh)).reshape(B, T, ML_WIDTH).astype(x.dtype)
    hm = hm * jax.nn.silu(z)
    mo = _mem_attend(mq.reshape(B, T, MEM_HEADS, MEM_HEAD_DIM), mem_k, mem_v).reshape(B, T, MEM_WIDTH)
    mo = mo * jax.nn.silu(mz)
    y = x + jnp.concatenate([hm, mo], axis=-1) @ w_out
    return y, C, n, m


def _diff_attend(q, k5, v_all, q_pos, k_pos, lam, slopes):
    s = jnp.einsum('bqhcd,bkhcd->bchqk', q, k5).astype(jnp.float32)
    dist = jnp.abs(q_pos[:, None] - k_pos[None, :]).astype(jnp.float32)
    bias = -slopes[:, None, None] * dist
    visible = (k_pos[None, :] // CHUNK) <= (q_pos[:, None] // CHUNK)
    s = jnp.where(visible, s + bias, -jnp.inf)
    p = jax.nn.softmax(s, axis=-1)
    attn = p[:, 0] - lam * p[:, 1]
    return jnp.einsum('bhqk,bkhv->bqhv', attn.astype(v_all.dtype), v_all)


def _diff_layer(x, k_all, v_all, q_pos, k_pos, mem_k, mem_v, norm_g, w_in, lam_v, subln_g, w_out, lam_init):
    B, T, _ = x.shape
    S = k_all.shape[1]
    f32 = jnp.float32
    p = _rmsnorm(x, norm_g) @ w_in
    q, z, mq, mz = jnp.split(p, B_SPLITS, axis=-1)
    q = q.reshape(B, T, DA_HEADS, 2, DA_HEAD_DIM) * (DA_HEAD_DIM ** -0.5)
    lv = lam_v.astype(f32)
    lam = jnp.exp(jnp.sum(lv[0] * lv[1])) - jnp.exp(jnp.sum(lv[2] * lv[3])) + lam_init
    slopes = jnp.exp2(-8.0 * jnp.arange(1, DA_HEADS + 1, dtype=f32) / DA_HEADS)
    k5 = k_all.reshape(B, S, DA_HEADS, 2, DA_HEAD_DIM)
    if T % Q_BLOCK == 0:
        nb = T // Q_BLOCK
        qb = q.reshape(B, nb, Q_BLOCK, DA_HEADS, 2, DA_HEAD_DIM).transpose(1, 0, 2, 3, 4, 5)
        pb = q_pos.reshape(nb, Q_BLOCK)
        ob = lax.map(lambda a: _diff_attend(a[0], k5, v_all, a[1], k_pos, lam, slopes), (qb, pb))
        o = ob.transpose(1, 0, 2, 3, 4).reshape(B, T, DA_HEADS, DA_V_DIM)
    else:
        o = _diff_attend(q, k5, v_all, q_pos, k_pos, lam, slopes)
    o = o.astype(f32)
    o = o * lax.rsqrt(jnp.mean(o * o, axis=-1, keepdims=True) + EPS) * subln_g.astype(f32) * (1.0 - lam_init)
    o = o.reshape(B, T, DA_V_WIDTH).astype(x.dtype) * jax.nn.silu(z)
    mo = _mem_attend(mq.reshape(B, T, MEM_HEADS, MEM_HEAD_DIM), mem_k, mem_v).reshape(B, T, MEM_WIDTH)
    mo = mo * jax.nn.silu(mz)
    return x + jnp.concatenate([o, mo], axis=-1) @ w_out


def _trunk(x, C0, n0, m0, past_k, past_v, mem_k, mem_v, norm_g, final_norm_g, w_in_a, b_gate_a,
           head_g_a, w_out_a, kv_norm_g, w_kv, w_in_b, lam_b, subln_g_b, w_out_b):
    B, T, _ = x.shape
    P = past_k.shape[1]
    q_pos = P + jnp.arange(T, dtype=jnp.int32)
    k_pos = jnp.arange(P + T, dtype=jnp.int32)
    Cs, ns, ms = [], [], []
    k_new = v_new = k_all = v_all = None
    for l in range(DEPTH):
        if l < N_A:
            x, C, n, m = _mlstm_layer(x, C0[l], n0[l], m0[l], mem_k[l], mem_v[l], norm_g[l],
                                      w_in_a[l], b_gate_a[l], head_g_a[l], w_out_a[l])
            Cs.append(C.astype(x.dtype))
            ns.append(n.astype(x.dtype))
            ms.append(m.astype(x.dtype))
        else:
            if l == N_A:
                kv = _rmsnorm(x, kv_norm_g) @ w_kv
                k_new = kv[..., :DA_QK_WIDTH].reshape(B, T, DA_HEADS, 2 * DA_HEAD_DIM)
                v_new = kv[..., DA_QK_WIDTH:].reshape(B, T, DA_HEADS, DA_V_DIM)
                k_all = jnp.concatenate([past_k.astype(x.dtype), k_new], axis=1)
                v_all = jnp.concatenate([past_v.astype(x.dtype), v_new], axis=1)
            j = l - N_A
            lam_init = 0.8 - 0.6 * math.exp(-0.3 * l)
            x = _diff_layer(x, k_all, v_all, q_pos, k_pos, mem_k[l], mem_v[l], norm_g[l],
                            w_in_b[j], lam_b[j], subln_g_b[j], w_out_b[j], lam_init)
    y = _rmsnorm(x, final_norm_g)
    return y, jnp.stack(Cs), jnp.stack(ns), jnp.stack(ms), k_new, v_new


def setup_inputs(seed: int = 0) -> dict:
    key = jax.random.key(seed)
    ks = jax.random.split(key, 32)
    f32 = jnp.float32

    def nrm(k, shape, s):
        return jax.random.normal(k, shape, f32) * s

    return {
        "x_prompt": nrm(ks[0], (BATCH, SEQ, D_MODEL), 1.0),
        "x_sample": nrm(ks[1], (DEC_BATCH, DEC_SEQ, D_MODEL), 1.0),
        "cache_k": nrm(ks[2], (DEC_BATCH, PAST_LEN, DA_HEADS, 2 * DA_HEAD_DIM), 1.0),
        "cache_v": nrm(ks[3], (DEC_BATCH, PAST_LEN, DA_HEADS, DA_V_DIM), 1.0),
        "cache_mem_k": nrm(ks[4], (DEPTH, DEC_BATCH, MEM_LEN, MEM_HEADS, MEM_HEAD_DIM), 1.0),
        "cache_mem_v": nrm(ks[5], (DEPTH, DEC_BATCH, MEM_LEN, MEM_HEADS, MEM_HEAD_DIM), 1.0),
        "state_C": nrm(ks[6], (N_A, DEC_BATCH, ML_HEADS, ML_HEAD_DIM, ML_HEAD_DIM), 0.1),
        "state_n": nrm(ks[7], (N_A, DEC_BATCH, ML_HEADS, ML_HEAD_DIM), 0.1),
        "state_m": nrm(ks[8], (N_A, DEC_BATCH, ML_HEADS), 0.5),
        "mem_prompt": nrm(ks[9], (BATCH, MEM_LEN, D_MODEL), 1.0),
        "norm_g": 1.0 + nrm(ks[10], (DEPTH, D_MODEL), 0.02),
        "final_norm_g": 1.0 + nrm(ks[11], (D_MODEL,), 0.02),
        "mem_norm_g": 1.0 + nrm(ks[12], (DEPTH, D_MODEL), 0.02),
        "w_mem_kv": nrm(ks[13], (DEPTH, D_MODEL, 2 * MEM_WIDTH), D_MODEL ** -0.5),
        "w_in_a": nrm(ks[14], (N_A, D_MODEL, A_IN), D_MODEL ** -0.5),
        "b_gate_a": jnp.concatenate([nrm(ks[15], (N_A, ML_HEADS), 0.1),
                                     3.0 + 3.0 * jax.random.uniform(ks[16], (N_A, ML_HEADS), f32)], axis=-1),
        "head_g_a": 1.0 + nrm(ks[17], (N_A, ML_WIDTH), 0.02),
        "w_out_a": nrm(ks[18], (N_A, ML_WIDTH + MEM_WIDTH, D_MODEL), (ML_WIDTH + MEM_WIDTH) ** -0.5),
        "kv_norm_g": 1.0 + nrm(ks[19], (D_MODEL,), 0.02),
        "w_kv": nrm(ks[20], (D_MODEL, DA_QK_WIDTH + DA_V_WIDTH), D_MODEL ** -0.5),
        "w_in_b": nrm(ks[21], (N_B, D_MODEL, B_IN), D_MODEL ** -0.5),
        "lam_b": nrm(ks[22], (N_B, 4, DA_HEAD_DIM), 0.1),
        "subln_g_b": 1.0 + nrm(ks[23], (N_B, DA_V_DIM), 0.02),
        "w_out_b": nrm(ks[24], (N_B, DA_V_WIDTH + MEM_WIDTH, D_MODEL), (DA_V_WIDTH + MEM_WIDTH) ** -0.5),
    }


def reference(x_prompt, x_sample, cache_k, cache_v, cache_mem_k, cache_mem_v, state_C, state_n, state_m,
              mem_prompt, norm_g, final_norm_g, mem_norm_g, w_mem_kv, w_in_a, b_gate_a, head_g_a, w_out_a,
              kv_norm_g, w_kv, w_in_b, lam_b, subln_g_b, w_out_b):
    B = x_prompt.shape[0]
    dt = x_prompt.dtype
    mk, mv = [], []
    for l in range(DEPTH):
        kv = _rmsnorm(mem_prompt, mem_norm_g[l]) @ w_mem_kv[l]
        mk.append(kv[..., :MEM_WIDTH].reshape(B, MEM_LEN, MEM_HEADS, MEM_HEAD_DIM))
        mv.append(kv[..., MEM_WIDTH:].reshape(B, MEM_LEN, MEM_HEADS, MEM_HEAD_DIM))
    prompt_mem_k = jnp.stack(mk)
    prompt_mem_v = jnp.stack(mv)
    C0 = jnp.zeros((N_A, B, ML_HEADS, ML_HEAD_DIM, ML_HEAD_DIM), dt)
    n0 = jnp.zeros((N_A, B, ML_HEADS, ML_HEAD_DIM), dt)
    m0 = jnp.zeros((N_A, B, ML_HEADS), dt)
    pk0 = jnp.zeros((B, 0, DA_HEADS, 2 * DA_HEAD_DIM), dt)
    pv0 = jnp.zeros((B, 0, DA_HEADS, DA_V_DIM), dt)
    y_prompt, prompt_C, prompt_n, prompt_m, prompt_k, prompt_v = _trunk(
        x_prompt, C0, n0, m0, pk0, pv0, prompt_mem_k, prompt_mem_v, norm_g, final_norm_g, w_in_a, b_gate_a,
        head_g_a, w_out_a, kv_norm_g, w_kv, w_in_b, lam_b, subln_g_b, w_out_b)
    y_sample, sample_C, sample_n, sample_m, sample_k, sample_v = _trunk(
        x_sample, state_C, state_n, state_m, cache_k, cache_v, cache_mem_k, cache_mem_v, norm_g, final_norm_g,
        w_in_a, b_gate_a, head_g_a, w_out_a, kv_norm_g, w_kv, w_in_b, lam_b, subln_g_b, w_out_b)
    return (y_prompt, y_sample, prompt_C, prompt_n, prompt_m, prompt_k, prompt_v, prompt_mem_k, prompt_mem_v,
            sample_C, sample_n, sample_m, sample_k, sample_v)
```

```cpp
#include <hip/hip_runtime.h>
#include <hip/hip_cooperative_groups.h>
#include <cstdio>
#include <cstdint>
namespace cg = cooperative_groups;

typedef unsigned short bf16_t;
typedef short bf16x8 __attribute__((ext_vector_type(8)));
typedef short s16x4 __attribute__((ext_vector_type(4)));
typedef float f32x16 __attribute__((ext_vector_type(16)));
typedef float f32x4 __attribute__((ext_vector_type(4)));
typedef float f32x2 __attribute__((ext_vector_type(2)));
typedef __bf16 bf2_t __attribute__((ext_vector_type(2)));
typedef unsigned u32x4 __attribute__((ext_vector_type(4)));
typedef unsigned u32x2 __attribute__((ext_vector_type(2)));
#define DI __device__ __forceinline__
#define MFMA32(a, b, c) __builtin_amdgcn_mfma_f32_32x32x16_bf16((a), (b), (c), 0, 0, 0)

struct Params { const float* in[24]; float* out; unsigned char* ws; int ph_lo, ph_hi; int wv, pad; };
#define TIDX (p.wv * 64 + (int)__builtin_amdgcn_mbcnt_hi(~0u, __builtin_amdgcn_mbcnt_lo(~0u, 0u)))
constexpr int LDS_BYTES = 110592;
constexpr int NTHREADS = 512;
constexpr int NPHASE = 10;

constexpr int TP = 16384, TS = 1024, TT = 17408, DM = 1024;
constexpr int NCH = 272;
constexpr int PAST = 4096, SKV = 4160;
constexpr float EPS = 1e-6f;
constexpr float LOG2E = 1.4426950408889634f;
enum { I_XP = 0, I_XS, I_CK, I_CV, I_CMK, I_CMV, I_SC, I_SN, I_SM, I_MEMP, I_NG, I_FNG, I_MNG, I_WMKV, I_WINA, I_BGA, I_HGA, I_WOA,
       I_KVNG, I_WKV, I_WINB, I_LAMB, I_SUBG, I_WOB };
constexpr size_t O_Y = 0, O_PC = 17825792, O_PN = 18087936, O_PM = 18088960, O_PK = 18088964, O_PV = 34866180, O_PMK = 51643396,
                 O_PMV = 51905540, O_SC = 52167684, O_SN = 56361988, O_SM = 56378372, O_SK = 56378436, O_SV = 57427012;
constexpr size_t WS_CTR = 0;
constexpr size_t WS_WA = 4096;
constexpr size_t WS_WOA = WS_WA + (size_t)6144 * 1024 * 2;
constexpr size_t WS_WKB = WS_WOA + (size_t)1024 * 1536 * 2;
constexpr size_t WS_WOB = WS_WKB + (size_t)5120 * 1024 * 2;
constexpr size_t WS_WM = WS_WOB + (size_t)1024 * 1536 * 2;
constexpr size_t WS_MEMN = WS_WM + (size_t)2 * 1024 * 1024 * 2;
constexpr size_t WS_MEMK = WS_MEMN + (size_t)2 * 256 * 1024 * 2;
constexpr size_t WS_MEMVT = WS_MEMK + (size_t)2 * 17 * 256 * 512 * 2;
constexpr size_t WS_GATE = WS_MEMVT + (size_t)2 * 17 * 256 * 512 * 2;
constexpr size_t SZ_CH = (size_t)NCH * 4 * 64 * 4;
constexpr size_t WS_GC = WS_GATE + (size_t)TT * 8 * 4;
constexpr size_t WS_MT = WS_GC + SZ_CH;
constexpr size_t WS_WS = WS_MT + SZ_CH;
constexpr size_t WS_WI = WS_WS + SZ_CH;
constexpr size_t WS_AS = WS_WI + SZ_CH;
constexpr size_t WS_BT = WS_AS + SZ_CH;
constexpr size_t WS_DEC = WS_BT + SZ_CH;
constexpr size_t WS_DENI = WS_DEC + 8192;
constexpr size_t WS_DENA = WS_DENI + (size_t)TT * 4 * 4;
constexpr size_t WS_XN = WS_DENA + (size_t)TT * 4 * 4;
constexpr size_t WS_AO = WS_XN + (size_t)TT * 1024 * 2;
constexpr size_t WS_Y1 = WS_AO + (size_t)TT * 1536 * 2;
constexpr size_t WS_KT = WS_Y1 + (size_t)TT * 1024 * 4;
constexpr size_t WS_VTA = WS_KT + (size_t)NCH * 4 * 256 * 64 * 2;
constexpr size_t WS_R1 = WS_VTA + (size_t)NCH * 4 * 256 * 64 * 2;
constexpr size_t SZ_R1 = (size_t)TT * 6144 * 2;
constexpr size_t WS_PB = WS_R1;
constexpr size_t WS_KBP = WS_PB + (size_t)TT * 3072 * 2;
constexpr size_t WS_VTP = WS_KBP + (size_t)TP * 1024 * 2;
constexpr size_t WS_R2 = WS_R1 + SZ_R1;
constexpr size_t WS_HINTER = WS_R2;
constexpr size_t WS_HINTRA = WS_R2 + (size_t)TT * 1024 * 4;
constexpr size_t WS_KBS = WS_R2;
constexpr size_t WS_VTS = WS_KBS + (size_t)16 * SKV * 1024 * 2;
constexpr size_t WS_END = WS_VTS + (size_t)16 * SKV * 1024 * 2;
static_assert(WS_VTP + (size_t)TP * 1024 * 2 <= WS_R2, "R1 overflow");

DI unsigned pk2(float lo, float hi) { f32x2 v = {lo, hi}; return __builtin_bit_cast(unsigned, __builtin_convertvector(v, bf2_t)); }
DI bf16_t f2bf(float x) { return (bf16_t)(pk2(x, 0.f) & 0xffffu); }
DI float bf2f(unsigned v16) { return __uint_as_float(v16 << 16); }
DI float bflo(unsigned u) { return __uint_as_float(u << 16); }
DI float bfhi(unsigned u) { return __uint_as_float(u & 0xffff0000u); }
DI float rbf(float x) { return bflo(pk2(x, 0.f) & 0xffffu); }
DI int crow(int i, int h) { return (i & 3) + 8 * (i >> 2) + 4 * h; }
DI float wave_sum(float v) {
#pragma unroll
  for (int o = 32; o >= 1; o >>= 1) v += __shfl_xor(v, o);
  return v;
}
DI float fexp2(float x) { return __builtin_amdgcn_exp2f(x); }
DI float fexp(float x) { return __builtin_amdgcn_exp2f(x * LOG2E); }
DI float sigmoidf_(float x) { return 1.f / (1.f + __expf(-x)); }
DI float siluf_(float x) { return x / (1.f + __expf(-x)); }
DI bf16x8 pack_acc(const f32x16& x, int s) {
  u32x4 p;
  p[0] = pk2(x[8 * s + 0], x[8 * s + 1]); p[1] = pk2(x[8 * s + 2], x[8 * s + 3]);
  p[2] = pk2(x[8 * s + 4], x[8 * s + 5]); p[3] = pk2(x[8 * s + 6], x[8 * s + 7]);
  return __builtin_bit_cast(bf16x8, p);
}
DI bf16x8 ld16(const void* p) { return *(const bf16x8*)p; }
DI bf16x8 ld8x2(const void* p0, const void* p1) {
  u32x2 a = *(const u32x2*)p0, b = *(const u32x2*)p1; u32x4 r = {a[0], a[1], b[0], b[1]};
  return __builtin_bit_cast(bf16x8, r);
}
DI f32x16 zero16() { f32x16 z; for (int i = 0; i < 16; ++i) z[i] = 0.f; return z; }

DI void transpose_tile(const float* __restrict__ src, size_t ld_s, bf16_t* __restrict__ dst, size_t ld_d, const float* __restrict__ scale,
                       float* scr, int t) {
  {
    const int c4 = t & 15, rb = t >> 4;
#pragma unroll
    for (int i = 0; i < 2; ++i) {
      const int r = rb + 32 * i;
      f32x4 v = *(const f32x4*)(src + (size_t)r * ld_s + 4 * c4);
      if (scale) { const float s = scale[r]; v = v * s; }
      float* d = scr + r * 65 + 4 * c4; d[0] = v[0]; d[1] = v[1]; d[2] = v[2]; d[3] = v[3];
    }
  }
  __syncthreads();
  {
    const int c = t >> 3, rg = t & 7;
    const float* s = scr + (8 * rg) * 65 + c;
    u32x4 o; o[0] = pk2(s[0], s[65]); o[1] = pk2(s[2 * 65], s[3 * 65]); o[2] = pk2(s[4 * 65], s[5 * 65]); o[3] = pk2(s[6 * 65], s[7 * 65]);
    *(u32x4*)(dst + (size_t)c * ld_d + 8 * rg) = o;
  }
  __syncthreads();
}

struct TJob { const float* src; size_t ld_s; bf16_t* dst; size_t ld_d; const float* scale; int tr, tc; };

DI void run_tjob_tile(const TJob& j, int tile, float* scr, int tid) {
  const int ir = tile / j.tc, ic = tile % j.tc;
  transpose_tile(j.src + (size_t)(64 * ir) * j.ld_s + 64 * ic, j.ld_s, j.dst + (size_t)(64 * ic) * j.ld_d + 64 * ir, j.ld_d,
                 j.scale ? j.scale + 64 * ir : nullptr, scr, tid);
}

DI float row_load_rstd(const float* xrow, f32x4 (&v)[4], int lane) {
  float ss = 0.f;
#pragma unroll
  for (int j = 0; j < 4; ++j) { v[j] = *(const f32x4*)(xrow + 4 * lane + 256 * j); ss += v[j][0] * v[j][0] + v[j][1] * v[j][1] + v[j][2] * v[j][2] + v[j][3] * v[j][3]; }
  ss = wave_sum(ss);
  return __builtin_amdgcn_rsqf(ss * (1.f / 1024.f) + EPS);
}

DI void phase0(const Params& p, unsigned char* lds) {
  const int tid = TIDX, lane = tid & 63, wid = tid >> 6;
  unsigned char* ws = p.ws;
  if (blockIdx.x == 0 && tid < 64) ((unsigned*)(ws + WS_CTR))[tid] = 0u;
  {
    TJob jobs[8];
    jobs[0] = {p.in[I_WINA], 6152, (bf16_t*)(ws + WS_WA), 1024, p.in[I_NG], 16, 80};
    jobs[1] = {p.in[I_WINA] + 5128, 6152, (bf16_t*)(ws + WS_WA) + (size_t)5120 * 1024, 1024, p.in[I_NG], 16, 16};
    jobs[2] = {p.in[I_WOA], 1024, (bf16_t*)(ws + WS_WOA), 1536, nullptr, 24, 16};
    jobs[3] = {p.in[I_WKV], 2048, (bf16_t*)(ws + WS_WKB), 1024, p.in[I_KVNG], 16, 32};
    jobs[4] = {p.in[I_WINB], 3072, (bf16_t*)(ws + WS_WKB) + (size_t)2048 * 1024, 1024, p.in[I_NG] + 1024, 16, 48};
    jobs[5] = {p.in[I_WOB], 1024, (bf16_t*)(ws + WS_WOB), 1536, nullptr, 24, 16};
    jobs[6] = {p.in[I_WMKV], 1024, (bf16_t*)(ws + WS_WM), 1024, nullptr, 16, 16};
    jobs[7] = {p.in[I_WMKV] + (size_t)1024 * 1024, 1024, (bf16_t*)(ws + WS_WM) + (size_t)1024 * 1024, 1024, nullptr, 16, 16};
    int base = 0;
#pragma unroll
    for (int j = 0; j < 8; ++j) {
      const int n = jobs[j].tr * jobs[j].tc;
      for (int t = blockIdx.x; t < n; t += gridDim.x) run_tjob_tile(jobs[j], t, (float*)lds, tid);
      base += n;
    }
    for (int t = blockIdx.x; t < 128 * 8; t += gridDim.x) {
      const int jb = t >> 3, tile = t & 7, l = jb >> 6, b = (jb >> 2) & 15, h = jb & 3;
      TJob j = {p.in[I_CMV] + ((size_t)(l * 16 + b) * 256) * 512 + h * 128, 512,
                (bf16_t*)(ws + WS_MEMVT) + ((size_t)(l * 17 + 1 + b) * 4 + h) * 128 * 256, 256, nullptr, 4, 2};
      run_tjob_tile(j, tile, (float*)lds, tid);
    }
  }
  {
    const size_t n8 = (size_t)2 * 16 * 256 * 512 / 8;
    for (size_t i = (size_t)blockIdx.x * NTHREADS + tid; i < n8; i += (size_t)gridDim.x * NTHREADS) {
      const size_t e = i * 8; const int l = (int)(e / ((size_t)16 * 131072)); const size_t rem = e - (size_t)l * 16 * 131072;
      const f32x4 a = *(const f32x4*)(p.in[I_CMK] + e), b = *(const f32x4*)(p.in[I_CMK] + e + 4);
      u32x4 o = {pk2(a[0], a[1]), pk2(a[2], a[3]), pk2(b[0], b[1]), pk2(b[2], b[3])};
      *(u32x4*)((bf16_t*)(ws + WS_MEMK) + ((size_t)(l * 17 + 1) * 131072) + rem) = o;
    }
  }
  {
    const int gw = blockIdx.x * 8 + wid, nw = gridDim.x * 8;
    const float* ng = p.in[I_NG];
    for (int r = gw; r < TT; r += nw) {
      const float* xrow = r < TP ? p.in[I_XP] + (size_t)r * 1024 : p.in[I_XS] + (size_t)(r - TP) * 1024;
      f32x4 v[4];
      const float rstd = row_load_rstd(xrow, v, lane);
      float gacc[8];
#pragma unroll
      for (int c = 0; c < 8; ++c) gacc[c] = 0.f;
      bf16_t* xn = (bf16_t*)(ws + WS_XN) + (size_t)r * 1024;
#pragma unroll
      for (int j = 0; j < 4; ++j) {
        const int k0 = 4 * lane + 256 * j;
        const f32x4 xs = v[j] * rstd;
        u32x2 o = {pk2(xs[0], xs[1]), pk2(xs[2], xs[3])};
        *(u32x2*)(xn + k0) = o;
        const f32x4 g = *(const f32x4*)(ng + k0);
#pragma unroll
        for (int e = 0; e < 4; ++e) {
          const float xg = xs[e] * g[e];
          const float* wr = p.in[I_WINA] + (size_t)(k0 + e) * 6152 + 5120;
          const f32x4 w0 = *(const f32x4*)wr, w1 = *(const f32x4*)(wr + 4);
          gacc[0] += xg * w0[0]; gacc[1] += xg * w0[1]; gacc[2] += xg * w0[2]; gacc[3] += xg * w0[3];
          gacc[4] += xg * w1[0]; gacc[5] += xg * w1[1]; gacc[6] += xg * w1[2]; gacc[7] += xg * w1[3];
        }
      }
#pragma unroll
      for (int c = 0; c < 8; ++c) gacc[c] = wave_sum(gacc[c]);
      if (lane < 8) {
        float gv = gacc[0];
#pragma unroll
        for (int c = 1; c < 8; ++c) gv = lane == c ? gacc[c] : gv;
        gv += p.in[I_BGA][lane];
        if (lane >= 4) gv = fminf(gv, 0.f) - log1pf(__expf(-fabsf(gv)));
        ((float*)(ws + WS_GATE))[(size_t)r * 8 + lane] = gv;
      }
    }
    for (int r = gw; r < 512; r += nw) {
      const int l = r >> 8, rr = r & 255;
      f32x4 v[4];
      const float rstd = row_load_rstd(p.in[I_MEMP] + (size_t)rr * 1024, v, lane);
      bf16_t* o = (bf16_t*)(ws + WS_MEMN) + (size_t)r * 1024;
#pragma unroll
      for (int j = 0; j < 4; ++j) {
        const int k0 = 4 * lane + 256 * j;
        const f32x4 g = *(const f32x4*)(p.in[I_MNG] + l * 1024 + k0);
        const f32x4 xs = v[j] * rstd * g;
        u32x2 ov = {pk2(xs[0], xs[1]), pk2(xs[2], xs[3])};
        *(u32x2*)(o + k0) = ov;
      }
    }
  }
}

constexpr int G_ROWB = 144, G_BUF = (256 + 128) * G_ROWB;
struct GemmAcc { f32x16 a[2][2]; };

DI void gemm_tile(const bf16_t* __restrict__ A, size_t lda, const bf16_t* __restrict__ Bt, size_t ldb, int K, unsigned char* lds, GemmAcc& acc, int tid) {
  const int lane = tid & 63, wid = tid >> 6, r = lane & 31, h = lane >> 5;
  const int wr = wid >> 1, wc = wid & 1;
#pragma unroll
  for (int a = 0; a < 2; ++a)
#pragma unroll
    for (int b = 0; b < 2; ++b) acc.a[a][b] = zero16();
  u32x4 ra[4], rb[2];
  const int nk = K / 64;
  auto gload = [&](int kt) {
#pragma unroll
    for (int e = 0; e < 4; ++e) { const int id = tid + 512 * e, row = id >> 3, c = id & 7; ra[e] = *(const u32x4*)(A + (size_t)row * lda + kt * 64 + 8 * c); }
#pragma unroll
    for (int e = 0; e < 2; ++e) { const int id = tid + 512 * e, row = id >> 3, c = id & 7; rb[e] = *(const u32x4*)(Bt + (size_t)row * ldb + kt * 64 + 8 * c); }
  };
  auto lstore = [&](int buf) {
    unsigned char* base = lds + buf * G_BUF;
#pragma unroll
    for (int e = 0; e < 4; ++e) { const int id = tid + 512 * e, row = id >> 3, c = id & 7; *(u32x4*)(base + row * G_ROWB + 16 * c) = ra[e]; }
#pragma unroll
    for (int e = 0; e < 2; ++e) { const int id = tid + 512 * e, row = id >> 3, c = id & 7; *(u32x4*)(base + (256 + row) * G_ROWB + 16 * c) = rb[e]; }
  };
  gload(0);
  __syncthreads();
  lstore(0);
  __syncthreads();
  for (int kt = 0; kt < nk; ++kt) {
    if (kt + 1 < nk) gload(kt + 1);
    const unsigned char* base = lds + (kt & 1) * G_BUF;
    const unsigned char* pa = base + (wr * 64 + r) * G_ROWB + 16 * h;
    const unsigned char* pb = base + (256 + wc * 64 + r) * G_ROWB + 16 * h;
#pragma unroll
    for (int kk = 0; kk < 4; ++kk) {
      const bf16x8 a0 = ld16(pa + 32 * kk), a1 = ld16(pa + 32 * G_ROWB + 32 * kk);
      const bf16x8 b0 = ld16(pb + 32 * kk), b1 = ld16(pb + 32 * G_ROWB + 32 * kk);
      acc.a[0][0] = MFMA32(a0, b0, acc.a[0][0]);
      acc.a[0][1] = MFMA32(a0, b1, acc.a[0][1]);
      acc.a[1][0] = MFMA32(a1, b0, acc.a[1][0]);
      acc.a[1][1] = MFMA32(a1, b1, acc.a[1][1]);
    }
    if (kt + 1 < nk) lstore((kt + 1) & 1);
    __syncthreads();
  }
}

DI void gate_scan(const Params& p, unsigned char* lds) {
  const int tid = TIDX, lane = tid & 63, wid = tid >> 6;
  unsigned char* ws = p.ws;
  const float* gate = (const float*)(ws + WS_GATE);
  float* s_gl = (float*)lds;
  float* s_A = s_gl + NCH * 4;
  float* s_mc = s_A + NCH * 4;
  float* s_mn = s_mc + NCH * 4;
  __syncthreads();
  for (int pr = wid; pr < NCH * 4; pr += 8) {
    const int cc = pr >> 2, hd = pr & 3;
    const float ig = gate[(size_t)(cc * 64 + lane) * 8 + hd], lf = gate[(size_t)(cc * 64 + lane) * 8 + 4 + hd];
    float g = lf;
#pragma unroll
    for (int o = 1; o < 64; o <<= 1) { const float t = __shfl_up(g, o); if (lane >= o) g += t; }
    float a = ig - g;
#pragma unroll
    for (int o = 32; o >= 1; o >>= 1) a = fmaxf(a, __shfl_xor(a, o));
    const float gl = __shfl(g, 63);
    if (lane == 0) { s_gl[pr] = gl; s_A[pr] = a; }
  }
  __syncthreads();
  if (tid < 4) {
    float m = 0.f;
    for (int c = 0; c < 256; ++c) { s_mc[c * 4 + tid] = m; m = s_gl[c * 4 + tid] + fmaxf(m, s_A[c * 4 + tid]); s_mn[c * 4 + tid] = m; }
    p.out[O_PM + tid] = m;
  } else if (tid >= 64 && tid < 128) {
    const int b = (tid - 64) >> 2, hd = tid & 3, pr = (256 + b) * 4 + hd;
    const float m0 = p.in[I_SM][b * 4 + hd];
    const float m = s_gl[pr] + fmaxf(m0, s_A[pr]);
    s_mc[pr] = m0; s_mn[pr] = m;
    p.out[O_SM + b * 4 + hd] = m;
  }
  __syncthreads();
  for (int pr = wid; pr < NCH * 4; pr += 8) {
    const int cc = pr >> 2, hd = pr & 3;
    const float ig = gate[(size_t)(cc * 64 + lane) * 8 + hd], lf = gate[(size_t)(cc * 64 + lane) * 8 + 4 + hd];
    float g = lf;
#pragma unroll
    for (int o = 1; o < 64; o <<= 1) { const float t = __shfl_up(g, o); if (lane >= o) g += t; }
    const float a = ig - g;
    float pm = a;
#pragma unroll
    for (int o = 1; o < 64; o <<= 1) { const float t = __shfl_up(pm, o); if (lane >= o) pm = fmaxf(pm, t); }
    const float mc = s_mc[pr], mn = s_mn[pr], gl = s_gl[pr];
    const float mt = g + fmaxf(mc, pm);
    const size_t o = (size_t)pr * 64 + lane;
    ((float*)(ws + WS_GC))[o] = g;
    ((float*)(ws + WS_MT))[o] = mt;
    ((float*)(ws + WS_WS))[o] = __expf(gl - g + ig - mn);
    ((float*)(ws + WS_WI))[o] = __expf(g + mc - mt);
    ((float*)(ws + WS_AS))[o] = (ig - g) * LOG2E;
    ((float*)(ws + WS_BT))[o] = (g - mt) * LOG2E;
    if (lane == 0) ((float*)(ws + WS_DEC))[pr] = __expf(gl + mc - mn);
  }
  __syncthreads();
}

DI void phase1(const Params& p, unsigned char* lds) {
  const int tid = TIDX, lane = tid & 63, wid = tid >> 6, r = lane & 31, h = lane >> 5, wr = wid >> 1, wc = wid & 1;
  unsigned char* ws = p.ws;
  if (blockIdx.x == gridDim.x - 1) gate_scan(p, lds);
  const int n_main = 68 * 48, n_mem = 16;
  for (int t = blockIdx.x; t < n_main + n_mem; t += gridDim.x) {
    GemmAcc acc;
    if (t < n_main) {
      const int tm = t / 48, tn = t % 48, m0 = tm * 256, n0 = tn * 128;
      gemm_tile((const bf16_t*)(ws + WS_XN) + (size_t)m0 * 1024, 1024, (const bf16_t*)(ws + WS_WA) + (size_t)n0 * 1024, 1024, 1024, lds, acc, tid);
      bf16_t* PA = (bf16_t*)(ws + WS_R1);
      const int sec = n0 >> 10;
#pragma unroll
      for (int a = 0; a < 2; ++a)
#pragma unroll
        for (int b = 0; b < 2; ++b) {
          __builtin_amdgcn_sched_barrier(0);
          const int n = n0 + wc * 64 + 32 * b + r, mb = m0 + wr * 64 + 32 * a;
          if (sec != 2) {
            const float sc = sec == 1 ? 0.0625f : 1.f;
#pragma unroll
            for (int i = 0; i < 16; ++i) PA[(size_t)(mb + crow(i, h)) * 6144 + n] = f2bf(acc.a[a][b][i] * sc);
          }
          if (sec == 1 || sec == 2) {
            const float sc = sec == 1 ? 0.0625f : 1.f;
            const int f = n & 1023, hd = f >> 8, fe = f & 255;
            bf16_t* T = (bf16_t*)(ws + (sec == 1 ? WS_KT : WS_VTA));
#pragma unroll
            for (int g = 0; g < 4; ++g) {
              const int m = mb + 8 * g + 4 * h, cc = m >> 6, s = m & 63;
              u32x2 o = {pk2(acc.a[a][b][4 * g] * sc, acc.a[a][b][4 * g + 1] * sc), pk2(acc.a[a][b][4 * g + 2] * sc, acc.a[a][b][4 * g + 3] * sc)};
              *(u32x2*)(T + (((size_t)cc * 4 + hd) * 256 + fe) * 64 + s) = o;
            }
          }
        }
    } else {
      const int tt = t - n_main, l = tt >> 3, n0 = (tt & 7) * 128;
      gemm_tile((const bf16_t*)(ws + WS_MEMN) + (size_t)l * 256 * 1024, 1024, (const bf16_t*)(ws + WS_WM) + ((size_t)l * 1024 + n0) * 1024, 1024, 1024, lds, acc, tid);
      const bool isv = n0 >= 512;
      float* of = p.out + (isv ? O_PMV : O_PMK) + (size_t)l * 131072;
      bf16_t* mk = (bf16_t*)(ws + WS_MEMK) + (size_t)(l * 17) * 131072;
      bf16_t* mv = (bf16_t*)(ws + WS_MEMVT) + (size_t)(l * 17) * 131072;
#pragma unroll
      for (int a = 0; a < 2; ++a)
#pragma unroll
        for (int b = 0; b < 2; ++b) {
          __builtin_amdgcn_sched_barrier(0);
          const int f = (n0 & 511) + wc * 64 + 32 * b + r, mb = wr * 64 + 32 * a;
#pragma unroll
          for (int g = 0; g < 4; ++g) {
            const int m = mb + 8 * g + 4 * h;
            float* o4 = of + (size_t)m * 512 + f;
            o4[0] = acc.a[a][b][4 * g]; o4[512] = acc.a[a][b][4 * g + 1]; o4[1024] = acc.a[a][b][4 * g + 2]; o4[1536] = acc.a[a][b][4 * g + 3];
            if (!isv) {
              bf16_t* k4 = mk + (size_t)m * 512 + f;
              k4[0] = f2bf(acc.a[a][b][4 * g]); k4[512] = f2bf(acc.a[a][b][4 * g + 1]); k4[1024] = f2bf(acc.a[a][b][4 * g + 2]); k4[1536] = f2bf(acc.a[a][b][4 * g + 3]);
            } else {
              u32x2 o = {pk2(acc.a[a][b][4 * g], acc.a[a][b][4 * g + 1]), pk2(acc.a[a][b][4 * g + 2], acc.a[a][b][4 * g + 3])};
              *(u32x2*)(mv + (size_t)f * 256 + m) = o;
            }
          }
        }
    }
  }
}

DI void scan_task(const Params& p, unsigned char* lds, int sb  , int hd, int j) {
  const int tid = TIDX, lane = tid & 63, wid = tid >> 6, r = lane & 31, h = lane >> 5;
  unsigned char* ws = p.ws;
  const int cc0 = sb < 0 ? 0 : 256 + sb, nch = sb < 0 ? 256 : 1;
  const bf16_t* PA = (const bf16_t*)(ws + WS_R1);
  const bf16_t* KT = (const bf16_t*)(ws + WS_KT);
  const bf16_t* VT = (const bf16_t*)(ws + WS_VTA);
  const float* WSa = (const float*)(ws + WS_WS);
  const float* WIa = (const float*)(ws + WS_WI);
  const float* DEC = (const float*)(ws + WS_DEC);
  float* red = (float*)lds;
  const bool nsl = j == 8;
  f32x16 S = zero16();
  if (sb >= 0) {
    if (!nsl) {
      const float* C0 = p.in[I_SC] + ((size_t)(sb * 4 + hd) * 256 + 32 * j + r) * 256 + 32 * wid;
#pragma unroll
      for (int g = 0; g < 4; ++g) { const f32x4 c = *(const f32x4*)(C0 + 8 * g + 4 * h); S[4 * g] = c[0]; S[4 * g + 1] = c[1]; S[4 * g + 2] = c[2]; S[4 * g + 3] = c[3]; }
    } else if (r == 0) {
      const float* n0 = p.in[I_SN] + (size_t)(sb * 4 + hd) * 256 + 32 * wid;
#pragma unroll
      for (int g = 0; g < 4; ++g) { const f32x4 c = *(const f32x4*)(n0 + 8 * g + 4 * h); S[4 * g] = c[0]; S[4 * g + 1] = c[1]; S[4 * g + 2] = c[2]; S[4 * g + 3] = c[3]; }
    }
  }
  bf16x8 kt[4], wv[4], qf[2][2];
  auto loadc = [&](int cc) {
    const size_t ch = (size_t)cc * 4 + hd;
    const bf16_t* kp = KT + (ch * 256 + 32 * wid + r) * 64 + 8 * h;
#pragma unroll
    for (int st = 0; st < 4; ++st) kt[st] = ld16(kp + 16 * st);
    const float* wsp = WSa + ch * 64 + 8 * h;
    if (!nsl) {
      const bf16_t* vp = VT + (ch * 256 + 32 * j + r) * 64 + 8 * h;
#pragma unroll
      for (int st = 0; st < 4; ++st) {
        const u32x4 v = *(const u32x4*)(vp + 16 * st);
        const f32x4 w0 = *(const f32x4*)(wsp + 16 * st), w1 = *(const f32x4*)(wsp + 16 * st + 4);
        u32x4 o;
        o[0] = pk2(bflo(v[0]) * w0[0], bfhi(v[0]) * w0[1]); o[1] = pk2(bflo(v[1]) * w0[2], bfhi(v[1]) * w0[3]);
        o[2] = pk2(bflo(v[2]) * w1[0], bfhi(v[2]) * w1[1]); o[3] = pk2(bflo(v[3]) * w1[2], bfhi(v[3]) * w1[3]);
        wv[st] = __builtin_bit_cast(bf16x8, o);
      }
    } else {
#pragma unroll
      for (int st = 0; st < 4; ++st) {
        const f32x4 w0 = *(const f32x4*)(wsp + 16 * st), w1 = *(const f32x4*)(wsp + 16 * st + 4);
        u32x4 o = {pk2(w0[0], w0[1]), pk2(w0[2], w0[3]), pk2(w1[0], w1[1]), pk2(w1[2], w1[3])};
        if (r != 0) o = (u32x4){0u, 0u, 0u, 0u};
        wv[st] = __builtin_bit_cast(bf16x8, o);
      }
    }
#pragma unroll
    for (int tt = 0; tt < 2; ++tt) {
      const bf16_t* qp = PA + (size_t)(cc * 64 + 32 * tt + r) * 6144 + hd * 256 + 32 * wid + 4 * h;
#pragma unroll
      for (int s2 = 0; s2 < 2; ++s2) qf[tt][s2] = ld8x2(qp + 16 * s2, qp + 16 * s2 + 8);
    }
  };
  for (int c = 0; c < nch; ++c) {
    const int cc = cc0 + c;
    loadc(cc);
    const float dec = DEC[cc * 4 + hd];
    const bf16x8 xs0 = pack_acc(S, 0), xs1 = pack_acc(S, 1);
    f32x16 z0 = MFMA32(xs0, qf[0][0], zero16()); z0 = MFMA32(xs1, qf[0][1], z0);
    f32x16 z1 = MFMA32(xs0, qf[1][0], zero16()); z1 = MFMA32(xs1, qf[1][1], z1);
    S = S * dec;
#pragma unroll
    for (int st = 0; st < 4; ++st) S = MFMA32(kt[st], wv[st], S);
    __syncthreads();
    {
      float* rw = red + wid * (64 * 33);
#pragma unroll
      for (int i = 0; i < 16; ++i) { rw[r * 33 + crow(i, h)] = z0[i]; rw[(32 + r) * 33 + crow(i, h)] = z1[i]; }
    }
    __syncthreads();
    {
      const int v = tid & 31;
#pragma unroll
      for (int e = 0; e < 4; ++e) {
        const int t = (tid >> 5) + 16 * e;
        float s = 0.f;
#pragma unroll
        for (int w8 = 0; w8 < 8; ++w8) s += red[w8 * (64 * 33) + t * 33 + v];
        const float wi = WIa[((size_t)cc * 4 + hd) * 64 + t];
        if (!nsl) ((float*)(ws + WS_HINTER))[(size_t)(cc * 64 + t) * 1024 + hd * 256 + 32 * j + v] = s * wi;
        else if (v == 0) ((float*)(ws + WS_DENI))[(size_t)(cc * 64 + t) * 4 + hd] = s * wi;
      }
    }
  }
  {
    if (!nsl) {
      float* Co = (sb < 0 ? p.out + O_PC + (size_t)hd * 65536 : p.out + O_SC + (size_t)(sb * 4 + hd) * 65536) + (size_t)(32 * j + r) * 256 + 32 * wid;
#pragma unroll
      for (int g = 0; g < 4; ++g) { f32x4 c = {S[4 * g], S[4 * g + 1], S[4 * g + 2], S[4 * g + 3]}; *(f32x4*)(Co + 8 * g + 4 * h) = c; }
    } else if (r == 0) {
      float* no = (sb < 0 ? p.out + O_PN + (size_t)hd * 256 : p.out + O_SN + (size_t)(sb * 4 + hd) * 256) + 32 * wid;
#pragma unroll
      for (int g = 0; g < 4; ++g) { f32x4 c = {S[4 * g], S[4 * g + 1], S[4 * g + 2], S[4 * g + 3]}; *(f32x4*)(no + 8 * g + 4 * h) = c; }
    }
  }
  __syncthreads();
}

DI void intra_task(const Params& p, int cc, int hd) {
  const int tid = TIDX, lane = tid & 63, wid = tid >> 6, r = lane & 31, h = lane >> 5;
  unsigned char* ws = p.ws;
  const int tt = wid & 1, vq = wid >> 1;
  const bf16_t* PA = (const bf16_t*)(ws + WS_R1);
  const bf16_t* VT = (const bf16_t*)(ws + WS_VTA);
  const size_t ch = (size_t)cc * 4 + hd;
  f32x16 s0 = zero16(), s1 = zero16();
  {
    const bf16_t* qp = PA + (size_t)(cc * 64 + 32 * tt + r) * 6144 + hd * 256 + 8 * h;
    const bf16_t* kp = PA + (size_t)(cc * 64 + r) * 6144 + 1024 + hd * 256 + 8 * h;
#pragma unroll 4
    for (int kk = 0; kk < 16; ++kk) {
      const bf16x8 q = ld16(qp + 16 * kk), k0 = ld16(kp + 16 * kk), k1 = ld16(kp + (size_t)32 * 6144 + 16 * kk);
      s0 = MFMA32(k0, q, s0);
      if (tt == 1) s1 = MFMA32(k1, q, s1);
    }
  }
  const int t = 32 * tt + r;
  const float bt = ((const float*)(ws + WS_BT))[ch * 64 + t];
  const float* asp = (const float*)(ws + WS_AS) + ch * 64;
  float den = 0.f;
#pragma unroll
  for (int g = 0; g < 4; ++g) {
    const f32x4 a0 = *(const f32x4*)(asp + 8 * g + 4 * h);
    const f32x4 a1 = *(const f32x4*)(asp + 32 + 8 * g + 4 * h);
#pragma unroll
    for (int e = 0; e < 4; ++e) {
      const int s = 8 * g + 4 * h + e;
      const float w0 = s <= t ? fexp2(bt + a0[e]) : 0.f;
      const float w1 = (32 + s) <= t ? fexp2(bt + a1[e]) : 0.f;
      s0[4 * g + e] *= w0; s1[4 * g + e] *= w1;
      den += s0[4 * g + e] + s1[4 * g + e];
    }
  }
  den += __shfl_xor(den, 32);
  if (vq == 0 && h == 0) ((float*)(ws + WS_DENA))[(size_t)(cc * 64 + t) * 4 + hd] = den;
  bf16x8 pf[2][2];
  pf[0][0] = pack_acc(s0, 0); pf[0][1] = pack_acc(s0, 1); pf[1][0] = pack_acc(s1, 0); pf[1][1] = pack_acc(s1, 1);
  float* Ho = (float*)(ws + WS_HINTRA) + (size_t)(cc * 64 + t) * 1024 + hd * 256;
#pragma unroll
  for (int vt = 0; vt < 2; ++vt) {
    const int v0 = vq * 64 + vt * 32;
    const bf16_t* vp = VT + (ch * 256 + v0 + r) * 64 + 4 * h;
    f32x16 o = zero16();
#pragma unroll
    for (int st = 0; st < 2; ++st)
#pragma unroll
      for (int s2 = 0; s2 < 2; ++s2) {
        const bf16x8 a = ld8x2(vp + 32 * st + 16 * s2, vp + 32 * st + 16 * s2 + 8);
        o = MFMA32(a, pf[st][s2], o);
      }
#pragma unroll
    for (int g = 0; g < 4; ++g) { f32x4 c = {o[4 * g], o[4 * g + 1], o[4 * g + 2], o[4 * g + 3]}; *(f32x4*)(Ho + v0 + 8 * g + 4 * h) = c; }
  }
}

DI void memattn_task(const Params& p, int tile, int layer, const bf16_t* Qb, const bf16_t* Zb, size_t ldq) {
  const int tid = TIDX, lane = tid & 63, wid = tid >> 6, r = lane & 31, h = lane >> 5;
  unsigned char* ws = p.ws;
  const int hd = wid >> 1, tok = tile * 64 + 32 * (wid & 1) + r;
  const int sbi = tile < 256 ? 0 : 1 + (tile - 256);
  const bf16_t* MK = (const bf16_t*)(ws + WS_MEMK) + (size_t)(layer * 17 + sbi) * 131072 + hd * 128;
  const bf16_t* MV = (const bf16_t*)(ws + WS_MEMVT) + ((size_t)(layer * 17 + sbi) * 4 + hd) * 128 * 256;
  bf16x8 qf[8];
  {
    const bf16_t* qp = Qb + (size_t)tok * ldq + hd * 128 + 8 * h;
#pragma unroll
    for (int kk = 0; kk < 8; ++kk) qf[kk] = ld16(qp + 16 * kk);
  }
  const float sc = 0.08838834764831845f * LOG2E;
  f32x16 O[4];
#pragma unroll
  for (int vt = 0; vt < 4; ++vt) O[vt] = zero16();
  float mrun = -1e30f, l = 0.f;
#pragma unroll 1
  for (int kb = 0; kb < 4; ++kb) {
    f32x16 s0 = zero16(), s1 = zero16();
    const bf16_t* kp = MK + (size_t)(kb * 64 + r) * 512 + 8 * h;
#pragma unroll
    for (int kk = 0; kk < 8; ++kk) {
      const bf16x8 k0 = ld16(kp + 16 * kk), k1 = ld16(kp + (size_t)32 * 512 + 16 * kk);
      s0 = MFMA32(k0, qf[kk], s0); s1 = MFMA32(k1, qf[kk], s1);
    }
    float mx = -1e30f;
#pragma unroll
    for (int i = 0; i < 16; ++i) mx = fmaxf(mx, fmaxf(s0[i], s1[i]));
    mx = fmaxf(mx, __shfl_xor(mx, 32)) * sc;
    const float mnew = fmaxf(mrun, mx), alpha = fexp2(mrun - mnew);
    mrun = mnew;
    float sum = 0.f;
#pragma unroll
    for (int i = 0; i < 16; ++i) { s0[i] = fexp2(s0[i] * sc - mnew); s1[i] = fexp2(s1[i] * sc - mnew); sum += s0[i] + s1[i]; }
    l = l * alpha + sum;
#pragma unroll
    for (int vt = 0; vt < 4; ++vt) O[vt] = O[vt] * alpha;
    bf16x8 pf[2][2];
    pf[0][0] = pack_acc(s0, 0); pf[0][1] = pack_acc(s0, 1); pf[1][0] = pack_acc(s1, 0); pf[1][1] = pack_acc(s1, 1);
#pragma unroll
    for (int vt = 0; vt < 4; ++vt) {
      const bf16_t* vp = MV + (size_t)(32 * vt + r) * 256 + kb * 64 + 4 * h;
#pragma unroll
      for (int st = 0; st < 2; ++st)
#pragma unroll
        for (int s2 = 0; s2 < 2; ++s2) {
          const bf16x8 a = ld8x2(vp + 32 * st + 16 * s2, vp + 32 * st + 16 * s2 + 8);
          O[vt] = MFMA32(a, pf[st][s2], O[vt]);
        }
    }
  }
  l += __shfl_xor(l, 32);
  const float inv = 1.f / l;
  const bf16_t* zp = Zb + (size_t)tok * ldq + hd * 128;
  bf16_t* op = (bf16_t*)(ws + WS_AO) + (size_t)tok * 1536 + 1024 + hd * 128;
#pragma unroll
  for (int vt = 0; vt < 4; ++vt)
#pragma unroll
    for (int g = 0; g < 4; ++g) {
      const int v = 32 * vt + 8 * g + 4 * h;
      const u32x2 z = *(const u32x2*)(zp + v);
      const float o0 = O[vt][4 * g] * inv * siluf_(bflo(z[0])), o1 = O[vt][4 * g + 1] * inv * siluf_(bfhi(z[0]));
      const float o2 = O[vt][4 * g + 2] * inv * siluf_(bflo(z[1])), o3 = O[vt][4 * g + 3] * inv * siluf_(bfhi(z[1]));
      u32x2 o = {pk2(o0, o1), pk2(o2, o3)};
      *(u32x2*)(op + v) = o;
    }
}

DI int next_item(unsigned* ctr, unsigned char* lds_flag_area, int tid) {
  __syncthreads();
  int* sh = (int*)lds_flag_area;
  if (tid == 0) *sh = (int)atomicAdd(ctr, 1u);
  __syncthreads();
  const int v = *sh;
  return v;
}

DI void phase2(const Params& p, unsigned char* lds) {
  unsigned* ctr = (unsigned*)(p.ws + WS_CTR) + 0;
  const bf16_t* PA = (const bf16_t*)(p.ws + WS_R1);
  const int n_ps = 36, n_ss = 576, n_in = NCH * 4, n_ma = NCH;
  for (;;) {
    const int it = next_item(ctr, lds + LDS_BYTES - 16, TIDX);
    if (it >= n_ps + n_ss + n_in + n_ma) break;
    if (it < n_ps) scan_task(p, lds, -1, it / 9, it % 9);
    else if (it < n_ps + n_ss) { const int q = it - n_ps; scan_task(p, lds, q / 36, (q % 36) / 9, q % 9); }
    else if (it < n_ps + n_ss + n_in) { const int q = it - n_ps - n_ss; intra_task(p, q >> 2, q & 3); }
    else { const int q = it - n_ps - n_ss - n_in; memattn_task(p, q, 0, PA + 5120, PA + 5632, 6144); }
  }
}

DI void phase3(const Params& p) {
  const int tid = TIDX, lane = tid & 63, wid = tid >> 6;
  unsigned char* ws = p.ws;
  const int gw = blockIdx.x * 8 + wid, nw = gridDim.x * 8;
  const bf16_t* PA = (const bf16_t*)(ws + WS_R1);
  for (int it = gw; it < TT * 4; it += nw) {
    const int tok = it >> 2, hd = it & 3, cc = tok >> 6, t = tok & 63;
    const size_t off = (size_t)tok * 1024 + hd * 256 + 4 * lane;
    const f32x4 a = *(const f32x4*)((const float*)(ws + WS_HINTER) + off), b = *(const f32x4*)((const float*)(ws + WS_HINTRA) + off);
    const float den = ((const float*)(ws + WS_DENI))[tok * 4 + hd] + ((const float*)(ws + WS_DENA))[tok * 4 + hd];
    const float mt = ((const float*)(ws + WS_MT))[((size_t)cc * 4 + hd) * 64 + t];
    const float dn = 1.f / fmaxf(fabsf(den), __expf(-mt));
    const u32x2 ou = *(const u32x2*)(PA + (size_t)tok * 6144 + 3072 + hd * 256 + 4 * lane);
    const u32x2 zu = *(const u32x2*)(PA + (size_t)tok * 6144 + 4096 + hd * 256 + 4 * lane);
    f32x4 hv = (a + b) * dn;
    hv[0] *= sigmoidf_(bflo(ou[0])); hv[1] *= sigmoidf_(bfhi(ou[0])); hv[2] *= sigmoidf_(bflo(ou[1])); hv[3] *= sigmoidf_(bfhi(ou[1]));
    float ss = hv[0] * hv[0] + hv[1] * hv[1] + hv[2] * hv[2] + hv[3] * hv[3];
    ss = wave_sum(ss);
    const float rstd = __builtin_amdgcn_rsqf(ss * (1.f / 256.f) + EPS);
    const f32x4 hg = *(const f32x4*)(p.in[I_HGA] + hd * 256 + 4 * lane);
    hv = hv * rstd * hg;
    hv[0] *= siluf_(bflo(zu[0])); hv[1] *= siluf_(bfhi(zu[0])); hv[2] *= siluf_(bflo(zu[1])); hv[3] *= siluf_(bfhi(zu[1]));
    u32x2 o = {pk2(hv[0], hv[1]), pk2(hv[2], hv[3])};
    *(u32x2*)((bf16_t*)(ws + WS_AO) + (size_t)tok * 1536 + hd * 256 + 4 * lane) = o;
  }
}

DI void phase_outproj(const Params& p, unsigned char* lds, int layer) {
  const int tid = TIDX, lane = tid & 63, wid = tid >> 6, r = lane & 31, h = lane >> 5, wr = wid >> 1, wc = wid & 1;
  unsigned char* ws = p.ws;
  const bf16_t* W = (const bf16_t*)(ws + (layer == 0 ? WS_WOA : WS_WOB));
  for (int t = blockIdx.x; t < 68 * 8; t += gridDim.x) {
    const int tm = t >> 3, tn = t & 7, m0 = tm * 256, n0 = tn * 128;
    GemmAcc acc;
    gemm_tile((const bf16_t*)(ws + WS_AO) + (size_t)m0 * 1536, 1536, W + (size_t)n0 * 1536, 1536, 1536, lds, acc, tid);
#pragma unroll
    for (int a = 0; a < 2; ++a)
#pragma unroll
      for (int b = 0; b < 2; ++b) {
        const int n = n0 + wc * 64 + 32 * b + r, mb = m0 + wr * 64 + 32 * a;
#pragma unroll
        for (int i = 0; i < 16; ++i) {
          const int m = mb + crow(i, h);
          if (layer == 0) {
            const float xv = m < TP ? p.in[I_XP][(size_t)m * 1024 + n] : p.in[I_XS][(size_t)(m - TP) * 1024 + n];
            ((float*)(ws + WS_Y1))[(size_t)m * 1024 + n] = xv + acc.a[a][b][i];
          } else {
            p.out[O_Y + (size_t)m * 1024 + n] = ((const float*)(ws + WS_Y1))[(size_t)m * 1024 + n] + acc.a[a][b][i];
          }
        }
      }
  }
}

DI void phase5(const Params& p, unsigned char* lds) {
  const int tid = TIDX, lane = tid & 63, wid = tid >> 6;
  unsigned char* ws = p.ws;
  const int gw = blockIdx.x * 8 + wid, nw = gridDim.x * 8;
  for (int r = gw; r < TT; r += nw) {
    f32x4 v[4];
    const float rstd = row_load_rstd((const float*)(ws + WS_Y1) + (size_t)r * 1024, v, lane);
    bf16_t* xn = (bf16_t*)(ws + WS_XN) + (size_t)r * 1024;
#pragma unroll
    for (int j = 0; j < 4; ++j) { const f32x4 xs = v[j] * rstd; u32x2 o = {pk2(xs[0], xs[1]), pk2(xs[2], xs[3])}; *(u32x2*)(xn + 4 * lane + 256 * j) = o; }
  }
  {
    const size_t n8 = (size_t)16 * PAST * 1024 / 8;
    for (size_t i = (size_t)blockIdx.x * NTHREADS + tid; i < n8; i += (size_t)gridDim.x * NTHREADS) {
      const size_t e = i * 8; const size_t b = e / ((size_t)PAST * 1024), rem = e - b * PAST * 1024;
      const f32x4 a = *(const f32x4*)(p.in[I_CK] + e), c = *(const f32x4*)(p.in[I_CK] + e + 4);
      u32x4 o = {pk2(a[0], a[1]), pk2(a[2], a[3]), pk2(c[0], c[1]), pk2(c[2], c[3])};
      *(u32x4*)((bf16_t*)(ws + WS_KBS) + b * SKV * 1024 + rem) = o;
    }
  }
  __syncthreads();
  for (int t = blockIdx.x; t < 128 * 128; t += gridDim.x) {
    const int jb = t >> 7, tile = t & 127, b = jb >> 3, hd = jb & 7;
    TJob j = {p.in[I_CV] + (size_t)b * PAST * 1024 + hd * 128, 1024, (bf16_t*)(ws + WS_VTS) + ((size_t)(b * 8 + hd) * 128) * SKV, SKV, nullptr, 64, 2};
    run_tjob_tile(j, tile, (float*)lds, tid);
  }
}

DI void phase6(const Params& p, unsigned char* lds) {
  const int tid = TIDX, lane = tid & 63, wid = tid >> 6, r = lane & 31, h = lane >> 5, wr = wid >> 1, wc = wid & 1;
  unsigned char* ws = p.ws;
  for (int t = blockIdx.x; t < 68 * 40; t += gridDim.x) {
    const int tm = t / 40, tn = t % 40, m0 = tm * 256, n0 = tn * 128;
    GemmAcc acc;
    gemm_tile((const bf16_t*)(ws + WS_XN) + (size_t)m0 * 1024, 1024, (const bf16_t*)(ws + WS_WKB) + (size_t)n0 * 1024, 1024, 1024, lds, acc, tid);
    const int sec = n0 >> 10;
    const bool samp = m0 >= TP;
#pragma unroll
    for (int a = 0; a < 2; ++a)
#pragma unroll
      for (int b = 0; b < 2; ++b) {
        const int n = n0 + wc * 64 + 32 * b + r, mb = m0 + wr * 64 + 32 * a;
        if (sec == 0) {
          const int f = n;
#pragma unroll
          for (int i = 0; i < 16; ++i) {
            const int m = mb + crow(i, h);
            const float v = acc.a[a][b][i];
            if (!samp) { p.out[O_PK + (size_t)m * 1024 + f] = v; ((bf16_t*)(ws + WS_KBP))[(size_t)m * 1024 + f] = f2bf(v); }
            else { const int ms = m - TP, bb = ms >> 6, s = ms & 63; p.out[O_SK + (size_t)ms * 1024 + f] = v;
                   ((bf16_t*)(ws + WS_KBS))[((size_t)bb * SKV + PAST + s) * 1024 + f] = f2bf(v); }
          }
        } else if (sec == 1) {
          const int f = n - 1024, hd = f >> 7, vd = f & 127;
#pragma unroll
          for (int i = 0; i < 16; ++i) {
            const int m = mb + crow(i, h);
            if (!samp) p.out[O_PV + (size_t)m * 1024 + f] = acc.a[a][b][i]; else p.out[O_SV + (size_t)(m - TP) * 1024 + f] = acc.a[a][b][i];
          }
#pragma unroll
          for (int g = 0; g < 4; ++g) {
            const int m = mb + 8 * g + 4 * h;
            u32x2 o = {pk2(acc.a[a][b][4 * g], acc.a[a][b][4 * g + 1]), pk2(acc.a[a][b][4 * g + 2], acc.a[a][b][4 * g + 3])};
            if (!samp) *(u32x2*)((bf16_t*)(ws + WS_VTP) + ((size_t)hd * 128 + vd) * TP + m) = o;
            else { const int ms = m - TP, bb = ms >> 6, s = ms & 63; *(u32x2*)((bf16_t*)(ws + WS_VTS) + ((size_t)(bb * 8 + hd) * 128 + vd) * SKV + PAST + s) = o; }
          }
        } else {
          const float sc = sec == 2 ? 0.125f * LOG2E : 1.f;
          bf16_t* PB = (bf16_t*)(ws + WS_PB);
#pragma unroll
          for (int i = 0; i < 16; ++i) PB[(size_t)(mb + crow(i, h)) * 3072 + (n - 2048)] = f2bf(acc.a[a][b][i] * sc);
        }
      }
  }
}

constexpr int A_KROW = 272, A_VROW = 136, A_KB = 64 * A_KROW, A_BUF = A_KB + 128 * A_VROW;

DI void diffattn_task(const Params& p, unsigned char* lds, int sb  , int qt  , int hd, float lam) {
  const int tid = TIDX, lane = tid & 63, wid = __builtin_amdgcn_readfirstlane(tid >> 6), r = lane & 31, h = lane >> 5;
  unsigned char* ws = p.ws;
  const int cq = wid >> 2, sub = (wid >> 1) & 1, map = wid & 1;
  const int ncq = sb < 0 ? 2 : 1;
  const int base_chunk = sb < 0 ? 2 * qt : 64;
  const int tok0 = sb < 0 ? qt * 128 : TP + sb * 64;
  const bool wvalid = cq < ncq;
  const int qc = base_chunk + cq;
  const int tl = 32 * sub + r;
  const int tok = tok0 + 64 * (wvalid ? cq : 0) + tl;
  const bf16_t* Kb = sb < 0 ? (const bf16_t*)(ws + WS_KBP) + hd * 128 : (const bf16_t*)(ws + WS_KBS) + (size_t)sb * SKV * 1024 + hd * 128;
  const bf16_t* Vb = sb < 0 ? (const bf16_t*)(ws + WS_VTP) + (size_t)hd * 128 * TP : (const bf16_t*)(ws + WS_VTS) + (size_t)(sb * 8 + hd) * 128 * SKV;
  const size_t ldv = sb < 0 ? TP : SKV;
  const bf16_t* PB = (const bf16_t*)(ws + WS_PB);
  bf16x8 qf[4];
  {
    const unsigned qo = (unsigned)tok * 3072u + hd * 128 + map * 64 + 8 * h;
#pragma unroll
    for (int kk = 0; kk < 4; ++kk) qf[kk] = ld16(PB + (qo + 16 * kk));
  }
  const float sl2 = exp2f(-(float)(hd + 1)) * LOG2E;
  const float bh0 = sl2 * (float)(4 * h), bh1 = bh0 + 32.f * sl2;
  float cs[16];
#pragma unroll
  for (int i = 0; i < 16; ++i) cs[i] = __uint_as_float(__builtin_amdgcn_readfirstlane(__float_as_uint(sl2 * (float)((i & 3) + 8 * (i >> 2)))));
  f32x16 O[4];
#pragma unroll
  for (int vt = 0; vt < 4; ++vt) O[vt] = zero16();
  float mrun = -1e30f, l = 0.f;
  const int jmax = base_chunk + ncq - 1, nit = jmax + 1;
  u32x4 rk[2], rv[2];
  const unsigned kofs = (unsigned)((tid >> 4) * 1024 + (tid & 15) * 8), vofs = (unsigned)((tid >> 3) * (unsigned)ldv + (tid & 7) * 8);
  auto gload = [&](int j) {
    const bf16_t* kj = Kb + (size_t)j * 65536;
    const bf16_t* vj = Vb + (size_t)j * 64;
#pragma unroll
    for (int e = 0; e < 2; ++e) {
      rk[e] = *(const u32x4*)(kj + (kofs + (unsigned)e * 32768u));
      rv[e] = *(const u32x4*)(vj + (vofs + (unsigned)e * 64u * (unsigned)ldv));
    }
  };
  auto lstore = [&](int buf) {
    unsigned char* base = lds + buf * A_BUF;
#pragma unroll
    for (int e = 0; e < 2; ++e) {
      const int id = tid + 512 * e;
      { const int row = id >> 4, c = id & 15; *(u32x4*)(base + row * A_KROW + 16 * c) = rk[e]; }
      { const int row = id >> 3, c = id & 7; unsigned char* d = base + A_KB + row * A_VROW + 16 * c;
        u32x2 lo = {rv[e][0], rv[e][1]}, hi = {rv[e][2], rv[e][3]}; *(u32x2*)d = lo; *(u32x2*)(d + 8) = hi; }
    }
  };
  gload(jmax);
  __syncthreads();
  lstore(0);
  __syncthreads();
  for (int it = 0; it < nit; ++it) {
    const int j = jmax - it;
    if (it + 1 < nit) gload(j - 1);
    if (wvalid && j <= qc) {
      const unsigned char* base = lds + (it & 1) * A_BUF;
      const unsigned char* kp = base + r * A_KROW + map * 128 + 16 * h;
      f32x16 s0, s1;
      {
        float b0 = bh0, b1 = bh1;
        asm volatile("" : "+v"(b0), "+v"(b1));
#pragma unroll
        for (int i = 0; i < 16; ++i) { s0[i] = b0 + cs[i]; s1[i] = b1 + cs[i]; }
      }
      if (j == qc) {
        int tlv = tl;
        asm volatile("" : "+v"(tlv));
        const float m2 = -2.f * sl2;
#pragma unroll
        for (int i = 0; i < 16; ++i) {
          const int s = crow(i, h);
          s0[i] = fmaf(m2, (float)max(0, s - tlv), s0[i]); s1[i] = fmaf(m2, (float)max(0, 32 + s - tlv), s1[i]);
        }
      }
#pragma unroll
      for (int kk = 0; kk < 4; ++kk) {
        const bf16x8 k0 = ld16(kp + 32 * kk), k1 = ld16(kp + 32 * A_KROW + 32 * kk);
        s0 = MFMA32(k0, qf[kk], s0); s1 = MFMA32(k1, qf[kk], s1);
      }
      const float dofs = sl2 * (float)((qc - j) * 64);
      float mx = -1e30f;
#pragma unroll
      for (int i = 0; i < 16; ++i) mx = fmaxf(mx, fmaxf(s0[i], s1[i]));
      mx = fmaxf(mx, __shfl_xor(mx, 32)) - dofs;
      const float mnew = fmaxf(mrun, mx), alpha = fexp2(mrun - mnew), mm = mnew + dofs;
      mrun = mnew;
      float sum = 0.f;
#pragma unroll
      for (int i = 0; i < 16; ++i) { s0[i] = fexp2(s0[i] - mm); s1[i] = fexp2(s1[i] - mm); sum += s0[i] + s1[i]; }
      l = l * alpha + sum;
#pragma unroll
      for (int vt = 0; vt < 4; ++vt) O[vt] = O[vt] * alpha;
      bf16x8 pf[2][2];
      pf[0][0] = pack_acc(s0, 0); pf[0][1] = pack_acc(s0, 1); pf[1][0] = pack_acc(s1, 0); pf[1][1] = pack_acc(s1, 1);
      const unsigned char* vbase = base + A_KB + r * A_VROW + 8 * h;
      __builtin_amdgcn_sched_barrier(0);
#pragma unroll
      for (int vt = 0; vt < 4; ++vt) {
        if (vt == 2) __builtin_amdgcn_sched_barrier(0);
        const unsigned char* vp = vbase + 32 * vt * A_VROW;
#pragma unroll
        for (int st = 0; st < 2; ++st)
#pragma unroll
          for (int s2 = 0; s2 < 2; ++s2) {
            const bf16x8 a = ld8x2(vp + 64 * st + 32 * s2, vp + 64 * st + 32 * s2 + 16);
            O[vt] = MFMA32(a, pf[st][s2], O[vt]);
          }
      }
    }
    if (it + 1 < nit) lstore((it + 1) & 1);
    __syncthreads();
  }
  l += __shfl_xor(l, 32);
  const float inv = wvalid ? 1.f / l : 0.f;
  float* xch = (float*)lds + (size_t)(wid >> 1) * 4096;
  if (map == 1 && wvalid) {
    const float sc = inv * lam;
#pragma unroll
    for (int vt = 0; vt < 4; ++vt)
#pragma unroll
      for (int i = 0; i < 16; ++i) xch[(vt * 16 + i) * 64 + lane] = O[vt][i] * sc;
  }
  __syncthreads();
  if (map == 0 && wvalid) {
    float ss = 0.f;
#pragma unroll
    for (int vt = 0; vt < 4; ++vt)
#pragma unroll
      for (int i = 0; i < 16; ++i) { const float o = O[vt][i] * inv - xch[(vt * 16 + i) * 64 + lane]; O[vt][i] = o; ss += o * o; }
    ss += __shfl_xor(ss, 32);
    const float lam_init = 0.8f - 0.6f * 0.7408182206817179f;
    const float rs = __builtin_amdgcn_rsqf(ss * (1.f / 128.f) + EPS) * (1.f - lam_init);
    const unsigned zo = (unsigned)tok * 3072u + 1024 + hd * 128, oo = (unsigned)tok * 1536u + hd * 128;
    bf16_t* AOp = (bf16_t*)(ws + WS_AO);
    const float* sg = p.in[I_SUBG];
#pragma unroll
    for (int vt = 0; vt < 4; ++vt)
#pragma unroll
      for (int g = 0; g < 4; ++g) {
        const int v = 32 * vt + 8 * g + 4 * h;
        const u32x2 z = *(const u32x2*)(PB + (zo + v));
        const f32x4 gg = *(const f32x4*)(sg + v);
        const float o0 = O[vt][4 * g] * rs * gg[0] * siluf_(bflo(z[0])), o1 = O[vt][4 * g + 1] * rs * gg[1] * siluf_(bfhi(z[0]));
        const float o2 = O[vt][4 * g + 2] * rs * gg[2] * siluf_(bflo(z[1])), o3 = O[vt][4 * g + 3] * rs * gg[3] * siluf_(bfhi(z[1]));
        u32x2 o = {pk2(o0, o1), pk2(o2, o3)};
        *(u32x2*)(AOp + (oo + v)) = o;
      }
  }
  __syncthreads();
}

DI void phase7(const Params& p, unsigned char* lds) {
  unsigned* ctr = (unsigned*)(p.ws + WS_CTR) + 1;
  const bf16_t* PB = (const bf16_t*)(p.ws + WS_PB);
  float lam;
  {
    const int lane = TIDX & 63;
    const float* lv = p.in[I_LAMB];
    const float a = wave_sum(lv[lane] * lv[64 + lane]), b = wave_sum(lv[128 + lane] * lv[192 + lane]);
    const float lam_init = 0.8f - 0.6f * 0.7408182206817179f;
    lam = __expf(a) - __expf(b) + lam_init;
  }
  const int n_s = 128, n_p = 1024, n_ma = NCH;
  for (;;) {
    const int it = next_item(ctr, lds + LDS_BYTES - 16, TIDX);
    if (it >= n_s + n_p) break;
    const bool pr = it < n_p;
    const int q = it - n_p;
    diffattn_task(p, lds, pr ? -1 : (q >> 3), pr ? 127 - (it >> 3) : 0, it & 7, lam);
  }
  for (;;) {
    const int it = next_item(ctr + 1, lds + LDS_BYTES - 16, TIDX);
    if (it >= n_ma) break;
    memattn_task(p, it, 1, PB + 2048, PB + 2560, 3072);
  }
}

DI void phase9(const Params& p) {
  const int tid = TIDX, lane = tid & 63, wid = tid >> 6;
  const int gw = blockIdx.x * 8 + wid, nw = gridDim.x * 8;
  for (int r = gw; r < TT; r += nw) {
    f32x4 v[4];
    float* row = p.out + O_Y + (size_t)r * 1024;
    const float rstd = row_load_rstd(row, v, lane);
#pragma unroll
    for (int j = 0; j < 4; ++j) {
      const f32x4 g = *(const f32x4*)(p.in[I_FNG] + 4 * lane + 256 * j);
      *(f32x4*)(row + 4 * lane + 256 * j) = v[j] * rstd * g;
    }
  }
}

DI void grid_barrier(unsigned* bar, unsigned target, int tid) {
  __threadfence();
  __syncthreads();
  if (tid == 0) {
    __hip_atomic_fetch_add(bar, 1u, __ATOMIC_RELEASE, __HIP_MEMORY_SCOPE_AGENT);
    while (__hip_atomic_load(bar, __ATOMIC_RELAXED, __HIP_MEMORY_SCOPE_AGENT) < target) __builtin_amdgcn_s_sleep(2);
  }
  __syncthreads();
  __threadfence();
}

__global__ __launch_bounds__(512) void mk(Params pin) {
  extern __shared__ __attribute__((aligned(16))) unsigned char lds[];
  Params p = pin;
  p.wv = __builtin_amdgcn_readfirstlane((int)(__builtin_amdgcn_workitem_id_x() >> 6));
  cg::grid_group grid = cg::this_grid();
  unsigned nbar = 0;
  unsigned* bar = (unsigned*)(p.ws + WS_CTR) + 32;
#define RUN_PHASE(PH, CALL) if (p.ph_lo <= PH && PH < p.ph_hi) { CALL; if (PH + 1 < p.ph_hi) { ++nbar; grid_barrier(bar, nbar * gridDim.x, TIDX); } }
  if (p.ph_lo <= 0 && 0 < p.ph_hi) { phase0(p, lds); if (1 < p.ph_hi) grid.sync(); }
  RUN_PHASE(1, phase1(p, lds))
  RUN_PHASE(2, phase2(p, lds))
  RUN_PHASE(3, phase3(p))
  RUN_PHASE(4, phase_outproj(p, lds, 0))
  RUN_PHASE(5, phase5(p, lds))
  RUN_PHASE(6, phase6(p, lds))
  RUN_PHASE(7, phase7(p, lds))
  RUN_PHASE(8, phase_outproj(p, lds, 1))
  RUN_PHASE(9, phase9(p))
}

extern "C" void kernel_launch(void* const* d_in, const int* in_sizes, int n_in, void* d_out, int out_size,
                              void* d_ws, size_t ws_size, hipStream_t stream) {
  static int grid_blocks = 0;
  if (!grid_blocks) {
    int dev = 0, cus = 0, per_cu = 0;
    (void)hipGetDevice(&dev);
    (void)hipDeviceGetAttribute(&cus, hipDeviceAttributeMultiprocessorCount, dev);
    (void)hipFuncSetAttribute((const void*)mk, hipFuncAttributeMaxDynamicSharedMemorySize, LDS_BYTES);
    (void)hipOccupancyMaxActiveBlocksPerMultiprocessor(&per_cu, (const void*)mk, NTHREADS, LDS_BYTES);
    grid_blocks = cus;
    fprintf(stderr, "kernel_launch: cus=%d per_cu=%d grid=%d ws=%zu need=%zu\n", cus, per_cu, grid_blocks, ws_size, (size_t)WS_END);
  }
  if (ws_size < WS_END) { fprintf(stderr, "workspace too small\n"); return; }
  Params p{};
  for (int i = 0; i < 24; ++i) p.in[i] = (const float*)d_in[i];
  p.out = (float*)d_out; p.ws = (unsigned char*)d_ws; p.ph_lo = 0; p.ph_hi = NPHASE;
  void* args[] = {&p};
  hipError_t e = hipLaunchCooperativeKernel((const void*)mk, dim3(grid_blocks), dim3(NTHREADS), args, LDS_BYTES, stream);
  if (e != hipSuccess) fprintf(stderr, "cooperative launch failed: %s (grid %d)\n", hipGetErrorString(e), grid_blocks);
}
```

```cpp
#include <hip/hip_runtime.h>
#include <hip/hip_cooperative_groups.h>
#include <cstdio>
#include <cstdint>
namespace cg = cooperative_groups;

typedef unsigned short bf16_t;
typedef short bf16x8 __attribute__((ext_vector_type(8)));
typedef short s16x4 __attribute__((ext_vector_type(4)));
typedef float f32x16 __attribute__((ext_vector_type(16)));
typedef float f32x4 __attribute__((ext_vector_type(4)));
typedef float f32x2 __attribute__((ext_vector_type(2)));
typedef __bf16 bf2_t __attribute__((ext_vector_type(2)));
typedef unsigned u32x4 __attribute__((ext_vector_type(4)));
typedef unsigned u32x2 __attribute__((ext_vector_type(2)));
#define DI __device__ __forceinline__
#define MFMA32(a, b, c) __builtin_amdgcn_mfma_f32_32x32x16_bf16((a), (b), (c), 0, 0, 0)

struct Params { const float* in[24]; float* out; unsigned char* ws; int ph_lo, ph_hi; int wv, pad; };
#define TIDX (p.wv * 64 + (int)__builtin_amdgcn_mbcnt_hi(~0u, __builtin_amdgcn_mbcnt_lo(~0u, 0u)))
constexpr int LDS_BYTES = 110592;
constexpr int NTHREADS = 512;
constexpr int NPHASE = 10;
#ifndef PROBE_REP
#define PROBE_REP -1
#endif

constexpr int TP = 16384, TS = 1024, TT = 17408, DM = 1024;
constexpr int NCH = 272;
constexpr int PAST = 4096, SKV = 4160;
constexpr float EPS = 1e-6f;
constexpr float LOG2E = 1.4426950408889634f;
enum { I_XP = 0, I_XS, I_CK, I_CV, I_CMK, I_CMV, I_SC, I_SN, I_SM, I_MEMP, I_NG, I_FNG, I_MNG, I_WMKV, I_WINA, I_BGA, I_HGA, I_WOA,
       I_KVNG, I_WKV, I_WINB, I_LAMB, I_SUBG, I_WOB };
constexpr size_t O_Y = 0, O_PC = 17825792, O_PN = 18087936, O_PM = 18088960, O_PK = 18088964, O_PV = 34866180, O_PMK = 51643396,
                 O_PMV = 51905540, O_SC = 52167684, O_SN = 56361988, O_SM = 56378372, O_SK = 56378436, O_SV = 57427012;
constexpr size_t WS_CTR = 0;
constexpr size_t WS_WA = 4096;
constexpr size_t WS_WOA = WS_WA + (size_t)6144 * 1024 * 2;
constexpr size_t WS_WKB = WS_WOA + (size_t)1024 * 1536 * 2;
constexpr size_t WS_WOB = WS_WKB + (size_t)5120 * 1024 * 2;
constexpr size_t WS_WM = WS_WOB + (size_t)1024 * 1536 * 2;
constexpr size_t WS_MEMN = WS_WM + (size_t)2 * 1024 * 1024 * 2;
constexpr size_t WS_MEMK = WS_MEMN + (size_t)2 * 256 * 1024 * 2;
constexpr size_t WS_MEMVT = WS_MEMK + (size_t)2 * 17 * 256 * 512 * 2;
constexpr size_t WS_GATE = WS_MEMVT + (size_t)2 * 17 * 256 * 512 * 2;
constexpr size_t SZ_CH = (size_t)NCH * 4 * 64 * 4;
constexpr size_t WS_GC = WS_GATE + (size_t)TT * 8 * 4;
constexpr size_t WS_MT = WS_GC + SZ_CH;
constexpr size_t WS_WS = WS_MT + SZ_CH;
constexpr size_t WS_WI = WS_WS + SZ_CH;
constexpr size_t WS_AS = WS_WI + SZ_CH;
constexpr size_t WS_BT = WS_AS + SZ_CH;
constexpr size_t WS_DEC = WS_BT + SZ_CH;
constexpr size_t WS_DENI = WS_DEC + 8192;
constexpr size_t WS_DENA = WS_DENI + (size_t)TT * 4 * 4;
constexpr size_t WS_XN = WS_DENA + (size_t)TT * 4 * 4;
constexpr size_t WS_AO = WS_XN + (size_t)TT * 1024 * 2;
constexpr size_t WS_Y1 = WS_AO + (size_t)TT * 1536 * 2;
constexpr size_t WS_KT = WS_Y1 + (size_t)TT * 1024 * 4;
constexpr size_t WS_VTA = WS_KT + (size_t)NCH * 4 * 256 * 64 * 2;
constexpr size_t WS_R1 = WS_VTA + (size_t)NCH * 4 * 256 * 64 * 2;
constexpr size_t SZ_R1 = (size_t)TT * 6144 * 2;
constexpr size_t WS_PB = WS_R1;
constexpr size_t WS_KBP = WS_PB + (size_t)TT * 3072 * 2;
constexpr size_t WS_VTP = WS_KBP + (size_t)TP * 1024 * 2;
constexpr size_t WS_R2 = WS_R1 + SZ_R1;
constexpr size_t WS_HINTER = WS_R2;
constexpr size_t WS_HINTRA = WS_R2 + (size_t)TT * 1024 * 4;
constexpr size_t WS_KBS = WS_R2;
constexpr size_t WS_VTS = WS_KBS + (size_t)16 * SKV * 1024 * 2;
constexpr size_t WS_LD = WS_VTS + (size_t)16 * SKV * 1024 * 2;
constexpr size_t WS_CLOC = WS_LD + 8192;
constexpr size_t WS_END = WS_CLOC + (size_t)16 * 36 * 8 * 64 * 16 * 4;
constexpr int GRP = 16;
static_assert(WS_VTP + (size_t)TP * 1024 * 2 <= WS_R2, "R1 overflow");

DI unsigned pk2(float lo, float hi) { f32x2 v = {lo, hi}; return __builtin_bit_cast(unsigned, __builtin_convertvector(v, bf2_t)); }
DI bf16_t f2bf(float x) { return (bf16_t)(pk2(x, 0.f) & 0xffffu); }
DI float bf2f(unsigned v16) { return __uint_as_float(v16 << 16); }
DI float bflo(unsigned u) { return __uint_as_float(u << 16); }
DI float bfhi(unsigned u) { return __uint_as_float(u & 0xffff0000u); }
DI float rbf(float x) { return bflo(pk2(x, 0.f) & 0xffffu); }
DI int crow(int i, int h) { return (i & 3) + 8 * (i >> 2) + 4 * h; }
DI float wave_sum(float v) {
#pragma unroll
  for (int o = 32; o >= 1; o >>= 1) v += __shfl_xor(v, o);
  return v;
}
DI float fexp2(float x) { return __builtin_amdgcn_exp2f(x); }
DI float fexp(float x) { return __builtin_amdgcn_exp2f(x * LOG2E); }
DI float sigmoidf_(float x) { return 1.f / (1.f + __expf(-x)); }
DI float siluf_(float x) { return x / (1.f + __expf(-x)); }
DI bf16x8 pack_acc(const f32x16& x, int s) {
  u32x4 p;
  p[0] = pk2(x[8 * s + 0], x[8 * s + 1]); p[1] = pk2(x[8 * s + 2], x[8 * s + 3]);
  p[2] = pk2(x[8 * s + 4], x[8 * s + 5]); p[3] = pk2(x[8 * s + 6], x[8 * s + 7]);
  return __builtin_bit_cast(bf16x8, p);
}
DI bf16x8 ld16(const void* p) { return *(const bf16x8*)p; }
DI bf16x8 ld8x2(const void* p0, const void* p1) {
  u32x2 a = *(const u32x2*)p0, b = *(const u32x2*)p1; u32x4 r = {a[0], a[1], b[0], b[1]};
  return __builtin_bit_cast(bf16x8, r);
}
DI f32x16 zero16() { f32x16 z; for (int i = 0; i < 16; ++i) z[i] = 0.f; return z; }

DI void transpose_tile(const float* __restrict__ src, size_t ld_s, bf16_t* __restrict__ dst, size_t ld_d, const float* __restrict__ scale,
                       float* scr, int t) {
  {
    const int c4 = t & 15, rb = t >> 4;
#pragma unroll
    for (int i = 0; i < 2; ++i) {
      const int r = rb + 32 * i;
      f32x4 v = *(const f32x4*)(src + (size_t)r * ld_s + 4 * c4);
      if (scale) { const float s = scale[r]; v = v * s; }
      float* d = scr + r * 65 + 4 * c4; d[0] = v[0]; d[1] = v[1]; d[2] = v[2]; d[3] = v[3];
    }
  }
  __syncthreads();
  {
    const int c = t >> 3, rg = t & 7;
    const float* s = scr + (8 * rg) * 65 + c;
    u32x4 o; o[0] = pk2(s[0], s[65]); o[1] = pk2(s[2 * 65], s[3 * 65]); o[2] = pk2(s[4 * 65], s[5 * 65]); o[3] = pk2(s[6 * 65], s[7 * 65]);
    *(u32x4*)(dst + (size_t)c * ld_d + 8 * rg) = o;
  }
  __syncthreads();
}

struct TJob { const float* src; size_t ld_s; bf16_t* dst; size_t ld_d; const float* scale; int tr, tc; };

DI void run_tjob_tile(const TJob& j, int tile, float* scr, int tid) {
  const int ir = tile / j.tc, ic = tile % j.tc;
  transpose_tile(j.src + (size_t)(64 * ir) * j.ld_s + 64 * ic, j.ld_s, j.dst + (size_t)(64 * ic) * j.ld_d + 64 * ir, j.ld_d,
                 j.scale ? j.scale + 64 * ir : nullptr, scr, tid);
}

DI float row_load_rstd(const float* xrow, f32x4 (&v)[4], int lane) {
  float ss = 0.f;
#pragma unroll
  for (int j = 0; j < 4; ++j) { v[j] = *(const f32x4*)(xrow + 4 * lane + 256 * j); ss += v[j][0] * v[j][0] + v[j][1] * v[j][1] + v[j][2] * v[j][2] + v[j][3] * v[j][3]; }
  ss = wave_sum(ss);
  return __builtin_amdgcn_rsqf(ss * (1.f / 1024.f) + EPS);
}

DI void phase0(const Params& p, unsigned char* lds) {
  const int tid = TIDX, lane = tid & 63, wid = tid >> 6;
  unsigned char* ws = p.ws;
  if (blockIdx.x == 0 && tid < 64) ((unsigned*)(ws + WS_CTR))[tid] = 0u;
  {
    TJob jobs[8];
    jobs[0] = {p.in[I_WINA], 6152, (bf16_t*)(ws + WS_WA), 1024, p.in[I_NG], 16, 80};
    jobs[1] = {p.in[I_WINA] + 5128, 6152, (bf16_t*)(ws + WS_WA) + (size_t)5120 * 1024, 1024, p.in[I_NG], 16, 16};
    jobs[2] = {p.in[I_WOA], 1024, (bf16_t*)(ws + WS_WOA), 1536, nullptr, 24, 16};
    jobs[3] = {p.in[I_WKV], 2048, (bf16_t*)(ws + WS_WKB), 1024, p.in[I_KVNG], 16, 32};
    jobs[4] = {p.in[I_WINB], 3072, (bf16_t*)(ws + WS_WKB) + (size_t)2048 * 1024, 1024, p.in[I_NG] + 1024, 16, 48};
    jobs[5] = {p.in[I_WOB], 1024, (bf16_t*)(ws + WS_WOB), 1536, nullptr, 24, 16};
    jobs[6] = {p.in[I_WMKV], 1024, (bf16_t*)(ws + WS_WM), 1024, nullptr, 16, 16};
    jobs[7] = {p.in[I_WMKV] + (size_t)1024 * 1024, 1024, (bf16_t*)(ws + WS_WM) + (size_t)1024 * 1024, 1024, nullptr, 16, 16};
    int base = 0;
#pragma unroll
    for (int j = 0; j < 8; ++j) {
      const int n = jobs[j].tr * jobs[j].tc;
      for (int t = blockIdx.x; t < n; t += gridDim.x) run_tjob_tile(jobs[j], t, (float*)lds, tid);
      base += n;
    }
    for (int t = blockIdx.x; t < 128 * 8; t += gridDim.x) {
      const int jb = t >> 3, tile = t & 7, l = jb >> 6, b = (jb >> 2) & 15, h = jb & 3;
      TJob j = {p.in[I_CMV] + ((size_t)(l * 16 + b) * 256) * 512 + h * 128, 512,
                (bf16_t*)(ws + WS_MEMVT) + ((size_t)(l * 17 + 1 + b) * 4 + h) * 128 * 256, 256, nullptr, 4, 2};
      run_tjob_tile(j, tile, (float*)lds, tid);
    }
  }
  {
    const size_t n8 = (size_t)2 * 16 * 256 * 512 / 8;
    for (size_t i = (size_t)blockIdx.x * NTHREADS + tid; i < n8; i += (size_t)gridDim.x * NTHREADS) {
      const size_t e = i * 8; const int l = (int)(e / ((size_t)16 * 131072)); const size_t rem = e - (size_t)l * 16 * 131072;
      const f32x4 a = *(const f32x4*)(p.in[I_CMK] + e), b = *(const f32x4*)(p.in[I_CMK] + e + 4);
      u32x4 o = {pk2(a[0], a[1]), pk2(a[2], a[3]), pk2(b[0], b[1]), pk2(b[2], b[3])};
      *(u32x4*)((bf16_t*)(ws + WS_MEMK) + ((size_t)(l * 17 + 1) * 131072) + rem) = o;
    }
  }
  {
    const int gw = blockIdx.x * 8 + wid, nw = gridDim.x * 8;
    const float* ng = p.in[I_NG];
    for (int r = gw; r < TT; r += nw) {
      const float* xrow = r < TP ? p.in[I_XP] + (size_t)r * 1024 : p.in[I_XS] + (size_t)(r - TP) * 1024;
      f32x4 v[4];
      const float rstd = row_load_rstd(xrow, v, lane);
      float gacc[8];
#pragma unroll
      for (int c = 0; c < 8; ++c) gacc[c] = 0.f;
      bf16_t* xn = (bf16_t*)(ws + WS_XN) + (size_t)r * 1024;
#pragma unroll
      for (int j = 0; j < 4; ++j) {
        const int k0 = 4 * lane + 256 * j;
        const f32x4 xs = v[j] * rstd;
        u32x2 o = {pk2(xs[0], xs[1]), pk2(xs[2], xs[3])};
        *(u32x2*)(xn + k0) = o;
        const f32x4 g = *(const f32x4*)(ng + k0);
#pragma unroll
        for (int e = 0; e < 4; ++e) {
          const float xg = xs[e] * g[e];
          const float* wr = p.in[I_WINA] + (size_t)(k0 + e) * 6152 + 5120;
          const f32x4 w0 = *(const f32x4*)wr, w1 = *(const f32x4*)(wr + 4);
          gacc[0] += xg * w0[0]; gacc[1] += xg * w0[1]; gacc[2] += xg * w0[2]; gacc[3] += xg * w0[3];
          gacc[4] += xg * w1[0]; gacc[5] += xg * w1[1]; gacc[6] += xg * w1[2]; gacc[7] += xg * w1[3];
        }
      }
#pragma unroll
      for (int c = 0; c < 8; ++c) gacc[c] = wave_sum(gacc[c]);
      if (lane < 8) {
        float gv = gacc[0];
#pragma unroll
        for (int c = 1; c < 8; ++c) gv = lane == c ? gacc[c] : gv;
        gv += p.in[I_BGA][lane];
        if (lane >= 4) gv = fminf(gv, 0.f) - log1pf(__expf(-fabsf(gv)));
        ((float*)(ws + WS_GATE))[(size_t)r * 8 + lane] = gv;
      }
    }
    for (int r = gw; r < 512; r += nw) {
      const int l = r >> 8, rr = r & 255;
      f32x4 v[4];
      const float rstd = row_load_rstd(p.in[I_MEMP] + (size_t)rr * 1024, v, lane);
      bf16_t* o = (bf16_t*)(ws + WS_MEMN) + (size_t)r * 1024;
#pragma unroll
      for (int j = 0; j < 4; ++j) {
        const int k0 = 4 * lane + 256 * j;
        const f32x4 g = *(const f32x4*)(p.in[I_MNG] + l * 1024 + k0);
        const f32x4 xs = v[j] * rstd * g;
        u32x2 ov = {pk2(xs[0], xs[1]), pk2(xs[2], xs[3])};
        *(u32x2*)(o + k0) = ov;
      }
    }
  }
}

constexpr int G_ROWB = 144, G_BUF = (256 + 128) * G_ROWB;
struct GemmAcc { f32x16 a[2][2]; };

DI void gemm_tile(const bf16_t* __restrict__ A, size_t lda, const bf16_t* __restrict__ Bt, size_t ldb, int K, unsigned char* lds, GemmAcc& acc, int tid) {
  const int lane = tid & 63, wid = tid >> 6, r = lane & 31, h = lane >> 5;
  const int wr = wid >> 1, wc = wid & 1;
#pragma unroll
  for (int a = 0; a < 2; ++a)
#pragma unroll
    for (int b = 0; b < 2; ++b) acc.a[a][b] = zero16();
  u32x4 ra[4], rb[2];
  const int nk = K / 64;
  auto gload = [&](int kt) {
#pragma unroll
    for (int e = 0; e < 4; ++e) { const int id = tid + 512 * e, row = id >> 3, c = id & 7; ra[e] = *(const u32x4*)(A + (size_t)row * lda + kt * 64 + 8 * c); }
#pragma unroll
    for (int e = 0; e < 2; ++e) { const int id = tid + 512 * e, row = id >> 3, c = id & 7; rb[e] = *(const u32x4*)(Bt + (size_t)row * ldb + kt * 64 + 8 * c); }
  };
  auto lstore = [&](int buf) {
    unsigned char* base = lds + buf * G_BUF;
#pragma unroll
    for (int e = 0; e < 4; ++e) { const int id = tid + 512 * e, row = id >> 3, c = id & 7; *(u32x4*)(base + row * G_ROWB + 16 * c) = ra[e]; }
#pragma unroll
    for (int e = 0; e < 2; ++e) { const int id = tid + 512 * e, row = id >> 3, c = id & 7; *(u32x4*)(base + (256 + row) * G_ROWB + 16 * c) = rb[e]; }
  };
  gload(0);
  __syncthreads();
  lstore(0);
  __syncthreads();
  for (int kt = 0; kt < nk; ++kt) {
    if (kt + 1 < nk) gload(kt + 1);
    const unsigned char* base = lds + (kt & 1) * G_BUF;
    const unsigned char* pa = base + (wr * 64 + r) * G_ROWB + 16 * h;
    const unsigned char* pb = base + (256 + wc * 64 + r) * G_ROWB + 16 * h;
#pragma unroll
    for (int kk = 0; kk < 4; ++kk) {
      const bf16x8 a0 = ld16(pa + 32 * kk), a1 = ld16(pa + 32 * G_ROWB + 32 * kk);
      const bf16x8 b0 = ld16(pb + 32 * kk), b1 = ld16(pb + 32 * G_ROWB + 32 * kk);
      acc.a[0][0] = MFMA32(a0, b0, acc.a[0][0]);
      acc.a[0][1] = MFMA32(a0, b1, acc.a[0][1]);
      acc.a[1][0] = MFMA32(a1, b0, acc.a[1][0]);
      acc.a[1][1] = MFMA32(a1, b1, acc.a[1][1]);
    }
    if (kt + 1 < nk) lstore((kt + 1) & 1);
    __syncthreads();
  }
}

DI void gate_scan(const Params& p, unsigned char* lds) {
  const int tid = TIDX, lane = tid & 63, wid = tid >> 6;
  unsigned char* ws = p.ws;
  const float* gate = (const float*)(ws + WS_GATE);
  float* s_gl = (float*)lds;
  float* s_A = s_gl + NCH * 4;
  float* s_mc = s_A + NCH * 4;
  float* s_mn = s_mc + NCH * 4;
  __syncthreads();
  for (int pr = wid; pr < NCH * 4; pr += 8) {
    const int cc = pr >> 2, hd = pr & 3;
    const float ig = gate[(size_t)(cc * 64 + lane) * 8 + hd], lf = gate[(size_t)(cc * 64 + lane) * 8 + 4 + hd];
    float g = lf;
#pragma unroll
    for (int o = 1; o < 64; o <<= 1) { const float t = __shfl_up(g, o); if (lane >= o) g += t; }
    float a = ig - g;
#pragma unroll
    for (int o = 32; o >= 1; o >>= 1) a = fmaxf(a, __shfl_xor(a, o));
    const float gl = __shfl(g, 63);
    if (lane == 0) { s_gl[pr] = gl; s_A[pr] = a; }
  }
  __syncthreads();
  if (tid < 4) {
    float m = 0.f;
    float ld = 0.f;
    float* LD = (float*)(ws + WS_LD);
    for (int c = 0; c < 256; ++c) {
      s_mc[c * 4 + tid] = m; LD[c * 4 + tid] = ld;
      const float mn = s_gl[c * 4 + tid] + fmaxf(m, s_A[c * 4 + tid]);
      ld += s_gl[c * 4 + tid] + m - mn;
      m = mn; s_mn[c * 4 + tid] = m;
    }
    LD[256 * 4 + tid] = ld;
    p.out[O_PM + tid] = m;
  } else if (tid >= 64 && tid < 128) {
    const int b = (tid - 64) >> 2, hd = tid & 3, pr = (256 + b) * 4 + hd;
    const float m0 = p.in[I_SM][b * 4 + hd];
    const float m = s_gl[pr] + fmaxf(m0, s_A[pr]);
    s_mc[pr] = m0; s_mn[pr] = m;
    p.out[O_SM + b * 4 + hd] = m;
  }
  __syncthreads();
  for (int pr = wid; pr < NCH * 4; pr += 8) {
    const int cc = pr >> 2, hd = pr & 3;
    const float ig = gate[(size_t)(cc * 64 + lane) * 8 + hd], lf = gate[(size_t)(cc * 64 + lane) * 8 + 4 + hd];
    float g = lf;
#pragma unroll
    for (int o = 1; o < 64; o <<= 1) { const float t = __shfl_up(g, o); if (lane >= o) g += t; }
    const float a = ig - g;
    float pm = a;
#pragma unroll
    for (int o = 1; o < 64; o <<= 1) { const float t = __shfl_up(pm, o); if (lane >= o) pm = fmaxf(pm, t); }
    const float mc = s_mc[pr], mn = s_mn[pr], gl = s_gl[pr];
    const float mt = g + fmaxf(mc, pm);
    const size_t o = (size_t)pr * 64 + lane;
    ((float*)(ws + WS_GC))[o] = g;
    ((float*)(ws + WS_MT))[o] = mt;
    ((float*)(ws + WS_WS))[o] = __expf(gl - g + ig - mn);
    ((float*)(ws + WS_WI))[o] = __expf(g + mc - mt);
    ((float*)(ws + WS_AS))[o] = (ig - g) * LOG2E;
    ((float*)(ws + WS_BT))[o] = (g - mt) * LOG2E;
    if (lane == 0) ((float*)(ws + WS_DEC))[pr] = __expf(gl + mc - mn);
  }
  __syncthreads();
}

DI void phase1(const Params& p, unsigned char* lds) {
  const int tid = TIDX, lane = tid & 63, wid = tid >> 6, r = lane & 31, h = lane >> 5, wr = wid >> 1, wc = wid & 1;
  unsigned char* ws = p.ws;
  if (blockIdx.x == gridDim.x - 1) gate_scan(p, lds);
  const int n_main = 68 * 48, n_mem = 16;
  for (int t = blockIdx.x; t < n_main + n_mem; t += gridDim.x) {
    GemmAcc acc;
    if (t < n_main) {
      const int tm = t / 48, tn = t % 48, m0 = tm * 256, n0 = tn * 128;
      gemm_tile((const bf16_t*)(ws + WS_XN) + (size_t)m0 * 1024, 1024, (const bf16_t*)(ws + WS_WA) + (size_t)n0 * 1024, 1024, 1024, lds, acc, tid);
      bf16_t* PA = (bf16_t*)(ws + WS_R1);
      const int sec = n0 >> 10;
#pragma unroll
      for (int a = 0; a < 2; ++a)
#pragma unroll
        for (int b = 0; b < 2; ++b) {
          __builtin_amdgcn_sched_barrier(0);
          const int n = n0 + wc * 64 + 32 * b + r, mb = m0 + wr * 64 + 32 * a;
          if (sec != 2) {
            const float sc = sec == 1 ? 0.0625f : 1.f;
#pragma unroll
            for (int i = 0; i < 16; ++i) PA[(size_t)(mb + crow(i, h)) * 6144 + n] = f2bf(acc.a[a][b][i] * sc);
          }
          if (sec == 1 || sec == 2) {
            const float sc = sec == 1 ? 0.0625f : 1.f;
            const int f = n & 1023, hd = f >> 8, fe = f & 255;
            bf16_t* T = (bf16_t*)(ws + (sec == 1 ? WS_KT : WS_VTA));
#pragma unroll
            for (int g = 0; g < 4; ++g) {
              const int m = mb + 8 * g + 4 * h, cc = m >> 6, s = m & 63;
              u32x2 o = {pk2(acc.a[a][b][4 * g] * sc, acc.a[a][b][4 * g + 1] * sc), pk2(acc.a[a][b][4 * g + 2] * sc, acc.a[a][b][4 * g + 3] * sc)};
              *(u32x2*)(T + (((size_t)cc * 4 + hd) * 256 + fe) * 64 + s) = o;
            }
          }
        }
    } else {
      const int tt = t - n_main, l = tt >> 3, n0 = (tt & 7) * 128;
      gemm_tile((const bf16_t*)(ws + WS_MEMN) + (size_t)l * 256 * 1024, 1024, (const bf16_t*)(ws + WS_WM) + ((size_t)l * 1024 + n0) * 1024, 1024, 1024, lds, acc, tid);
      const bool isv = n0 >= 512;
      float* of = p.out + (isv ? O_PMV : O_PMK) + (size_t)l * 131072;
      bf16_t* mk = (bf16_t*)(ws + WS_MEMK) + (size_t)(l * 17) * 131072;
      bf16_t* mv = (bf16_t*)(ws + WS_MEMVT) + (size_t)(l * 17) * 131072;
#pragma unroll
      for (int a = 0; a < 2; ++a)
#pragma unroll
        for (int b = 0; b < 2; ++b) {
          __builtin_amdgcn_sched_barrier(0);
          const int f = (n0 & 511) + wc * 64 + 32 * b + r, mb = wr * 64 + 32 * a;
#pragma unroll
          for (int g = 0; g < 4; ++g) {
            const int m = mb + 8 * g + 4 * h;
            float* o4 = of + (size_t)m * 512 + f;
            o4[0] = acc.a[a][b][4 * g]; o4[512] = acc.a[a][b][4 * g + 1]; o4[1024] = acc.a[a][b][4 * g + 2]; o4[1536] = acc.a[a][b][4 * g + 3];
            if (!isv) {
              bf16_t* k4 = mk + (size_t)m * 512 + f;
              k4[0] = f2bf(acc.a[a][b][4 * g]); k4[512] = f2bf(acc.a[a][b][4 * g + 1]); k4[1024] = f2bf(acc.a[a][b][4 * g + 2]); k4[1536] = f2bf(acc.a[a][b][4 * g + 3]);
            } else {
              u32x2 o = {pk2(acc.a[a][b][4 * g], acc.a[a][b][4 * g + 1]), pk2(acc.a[a][b][4 * g + 2], acc.a[a][b][4 * g + 3])};
              *(u32x2*)(mv + (size_t)f * 256 + m) = o;
            }
          }
        }
    }
  }
}

DI void scan_task(const Params& p, unsigned char* lds, int sb  , int hd, int j, int grp) {
  const int tid = TIDX, lane = tid & 63, wid = tid >> 6, r = lane & 31, h = lane >> 5;
  unsigned char* ws = p.ws;
  const int cc0 = sb < 0 ? GRP * grp : 256 + sb, nch = sb < 0 ? GRP : 1;
  const bf16_t* PA = (const bf16_t*)(ws + WS_R1);
  const bf16_t* KT = (const bf16_t*)(ws + WS_KT);
  const bf16_t* VT = (const bf16_t*)(ws + WS_VTA);
  const float* WSa = (const float*)(ws + WS_WS);
  const float* WIa = (const float*)(ws + WS_WI);
  const float* DEC = (const float*)(ws + WS_DEC);
  float* red = (float*)lds;
  const bool nsl = j == 8;
  f32x16 S = zero16();
  if (sb >= 0) {
    if (!nsl) {
      const float* C0 = p.in[I_SC] + ((size_t)(sb * 4 + hd) * 256 + 32 * j + r) * 256 + 32 * wid;
#pragma unroll
      for (int g = 0; g < 4; ++g) { const f32x4 c = *(const f32x4*)(C0 + 8 * g + 4 * h); S[4 * g] = c[0]; S[4 * g + 1] = c[1]; S[4 * g + 2] = c[2]; S[4 * g + 3] = c[3]; }
    } else if (r == 0) {
      const float* n0 = p.in[I_SN] + (size_t)(sb * 4 + hd) * 256 + 32 * wid;
#pragma unroll
      for (int g = 0; g < 4; ++g) { const f32x4 c = *(const f32x4*)(n0 + 8 * g + 4 * h); S[4 * g] = c[0]; S[4 * g + 1] = c[1]; S[4 * g + 2] = c[2]; S[4 * g + 3] = c[3]; }
    }
  }
  bf16x8 kt[4], wv[4], qf[2][2];
  auto loadc = [&](int cc) {
    const size_t ch = (size_t)cc * 4 + hd;
    const bf16_t* kp = KT + (ch * 256 + 32 * wid + r) * 64 + 8 * h;
#pragma unroll
    for (int st = 0; st < 4; ++st) kt[st] = ld16(kp + 16 * st);
    const float* wsp = WSa + ch * 64 + 8 * h;
    if (!nsl) {
      const bf16_t* vp = VT + (ch * 256 + 32 * j + r) * 64 + 8 * h;
#pragma unroll
      for (int st = 0; st < 4; ++st) {
        const u32x4 v = *(const u32x4*)(vp + 16 * st);
        const f32x4 w0 = *(const f32x4*)(wsp + 16 * st), w1 = *(const f32x4*)(wsp + 16 * st + 4);
        u32x4 o;
        o[0] = pk2(bflo(v[0]) * w0[0], bfhi(v[0]) * w0[1]); o[1] = pk2(bflo(v[1]) * w0[2], bfhi(v[1]) * w0[3]);
        o[2] = pk2(bflo(v[2]) * w1[0], bfhi(v[2]) * w1[1]); o[3] = pk2(bflo(v[3]) * w1[2], bfhi(v[3]) * w1[3]);
        wv[st] = __builtin_bit_cast(bf16x8, o);
      }
    } else {
#pragma unroll
      for (int st = 0; st < 4; ++st) {
        const f32x4 w0 = *(const f32x4*)(wsp + 16 * st), w1 = *(const f32x4*)(wsp + 16 * st + 4);
        u32x4 o = {pk2(w0[0], w0[1]), pk2(w0[2], w0[3]), pk2(w1[0], w1[1]), pk2(w1[2], w1[3])};
        if (r != 0) o = (u32x4){0u, 0u, 0u, 0u};
        wv[st] = __builtin_bit_cast(bf16x8, o);
      }
    }
#pragma unroll
    for (int tt = 0; tt < 2; ++tt) {
      const bf16_t* qp = PA + (size_t)(cc * 64 + 32 * tt + r) * 6144 + hd * 256 + 32 * wid + 4 * h;
#pragma unroll
      for (int s2 = 0; s2 < 2; ++s2) qf[tt][s2] = ld8x2(qp + 16 * s2, qp + 16 * s2 + 8);
    }
  };
  for (int c = 0; c < nch; ++c) {
    const int cc = cc0 + c;
    loadc(cc);
    const float dec = DEC[cc * 4 + hd];
    const bf16x8 xs0 = pack_acc(S, 0), xs1 = pack_acc(S, 1);
    f32x16 z0 = MFMA32(xs0, qf[0][0], zero16()); z0 = MFMA32(xs1, qf[0][1], z0);
    f32x16 z1 = MFMA32(xs0, qf[1][0], zero16()); z1 = MFMA32(xs1, qf[1][1], z1);
    S = S * dec;
#pragma unroll
    for (int st = 0; st < 4; ++st) S = MFMA32(kt[st], wv[st], S);
    __syncthreads();
    {
      float* rw = red + wid * (64 * 33);
#pragma unroll
      for (int i = 0; i < 16; ++i) { rw[r * 33 + crow(i, h)] = z0[i]; rw[(32 + r) * 33 + crow(i, h)] = z1[i]; }
    }
    __syncthreads();
    {
      const int v = tid & 31;
#pragma unroll
      for (int e = 0; e < 4; ++e) {
        const int t = (tid >> 5) + 16 * e;
        float s = 0.f;
#pragma unroll
        for (int w8 = 0; w8 < 8; ++w8) s += red[w8 * (64 * 33) + t * 33 + v];
        const float wi = WIa[((size_t)cc * 4 + hd) * 64 + t];
        if (!nsl) ((float*)(ws + WS_HINTER))[(size_t)(cc * 64 + t) * 1024 + hd * 256 + 32 * j + v] = s * wi;
        else if (v == 0) ((float*)(ws + WS_DENI))[(size_t)(cc * 64 + t) * 4 + hd] = s * wi;
      }
    }
  }
  if (sb < 0) {
    float* cl = (float*)(ws + WS_CLOC) + ((((size_t)(grp * 4 + hd) * 9 + j) * 8 + wid) * 64 + lane) * 16;
#pragma unroll
    for (int g = 0; g < 4; ++g) { f32x4 c = {S[4 * g], S[4 * g + 1], S[4 * g + 2], S[4 * g + 3]}; *(f32x4*)(cl + 4 * g) = c; }
  } else {
    if (!nsl) {
      float* Co = (sb < 0 ? p.out + O_PC + (size_t)hd * 65536 : p.out + O_SC + (size_t)(sb * 4 + hd) * 65536) + (size_t)(32 * j + r) * 256 + 32 * wid;
#pragma unroll
      for (int g = 0; g < 4; ++g) { f32x4 c = {S[4 * g], S[4 * g + 1], S[4 * g + 2], S[4 * g + 3]}; *(f32x4*)(Co + 8 * g + 4 * h) = c; }
    } else if (r == 0) {
      float* no = (sb < 0 ? p.out + O_PN + (size_t)hd * 256 : p.out + O_SN + (size_t)(sb * 4 + hd) * 256) + 32 * wid;
#pragma unroll
      for (int g = 0; g < 4; ++g) { f32x4 c = {S[4 * g], S[4 * g + 1], S[4 * g + 2], S[4 * g + 3]}; *(f32x4*)(no + 8 * g + 4 * h) = c; }
    }
  }
  __syncthreads();
}

DI void intra_task(const Params& p, int cc, int hd) {
  const int tid = TIDX, lane = tid & 63, wid = tid >> 6, r = lane & 31, h = lane >> 5;
  unsigned char* ws = p.ws;
  const int tt = wid & 1, vq = wid >> 1;
  const bf16_t* PA = (const bf16_t*)(ws + WS_R1);
  const bf16_t* VT = (const bf16_t*)(ws + WS_VTA);
  const size_t ch = (size_t)cc * 4 + hd;
  f32x16 s0 = zero16(), s1 = zero16();
  {
    const bf16_t* qp = PA + (size_t)(cc * 64 + 32 * tt + r) * 6144 + hd * 256 + 8 * h;
    const bf16_t* kp = PA + (size_t)(cc * 64 + r) * 6144 + 1024 + hd * 256 + 8 * h;
#pragma unroll 4
    for (int kk = 0; kk < 16; ++kk) {
      const bf16x8 q = ld16(qp + 16 * kk), k0 = ld16(kp + 16 * kk), k1 = ld16(kp + (size_t)32 * 6144 + 16 * kk);
      s0 = MFMA32(k0, q, s0);
      if (tt == 1) s1 = MFMA32(k1, q, s1);
    }
  }
  const int t = 32 * tt + r;
  const float bt = ((const float*)(ws + WS_BT))[ch * 64 + t];
  const float* asp = (const float*)(ws + WS_AS) + ch * 64;
  float den = 0.f;
#pragma unroll
  for (int g = 0; g < 4; ++g) {
    const f32x4 a0 = *(const f32x4*)(asp + 8 * g + 4 * h);
    const f32x4 a1 = *(const f32x4*)(asp + 32 + 8 * g + 4 * h);
#pragma unroll
    for (int e = 0; e < 4; ++e) {
      const int s = 8 * g + 4 * h + e;
      const float w0 = s <= t ? fexp2(bt + a0[e]) : 0.f;
      const float w1 = (32 + s) <= t ? fexp2(bt + a1[e]) : 0.f;
      s0[4 * g + e] *= w0; s1[4 * g + e] *= w1;
      den += s0[4 * g + e] + s1[4 * g + e];
    }
  }
  den += __shfl_xor(den, 32);
  if (vq == 0 && h == 0) ((float*)(ws + WS_DENA))[(size_t)(cc * 64 + t) * 4 + hd] = den;
  bf16x8 pf[2][2];
  pf[0][0] = pack_acc(s0, 0); pf[0][1] = pack_acc(s0, 1); pf[1][0] = pack_acc(s1, 0); pf[1][1] = pack_acc(s1, 1);
  float* Ho = (float*)(ws + WS_HINTRA) + (size_t)(cc * 64 + t) * 1024 + hd * 256;
#pragma unroll
  for (int vt = 0; vt < 2; ++vt) {
    const int v0 = vq * 64 + vt * 32;
    const bf16_t* vp = VT + (ch * 256 + v0 + r) * 64 + 4 * h;
    f32x16 o = zero16();
#pragma unroll
    for (int st = 0; st < 2; ++st)
#pragma unroll
      for (int s2 = 0; s2 < 2; ++s2) {
        const bf16x8 a = ld8x2(vp + 32 * st + 16 * s2, vp + 32 * st + 16 * s2 + 8);
        o = MFMA32(a, pf[st][s2], o);
      }
#pragma unroll
    for (int g = 0; g < 4; ++g) { f32x4 c = {o[4 * g], o[4 * g + 1], o[4 * g + 2], o[4 * g + 3]}; *(f32x4*)(Ho + v0 + 8 * g + 4 * h) = c; }
  }
}

DI void memattn_task(const Params& p, int tile, int layer, const bf16_t* Qb, const bf16_t* Zb, size_t ldq) {
  const int tid = TIDX, lane = tid & 63, wid = tid >> 6, r = lane & 31, h = lane >> 5;
  unsigned char* ws = p.ws;
  const int hd = wid >> 1, tok = tile * 64 + 32 * (wid & 1) + r;
  const int sbi = tile < 256 ? 0 : 1 + (tile - 256);
  const bf16_t* MK = (const bf16_t*)(ws + WS_MEMK) + (size_t)(layer * 17 + sbi) * 131072 + hd * 128;
  const bf16_t* MV = (const bf16_t*)(ws + WS_MEMVT) + ((size_t)(layer * 17 + sbi) * 4 + hd) * 128 * 256;
  bf16x8 qf[8];
  {
    const bf16_t* qp = Qb + (size_t)tok * ldq + hd * 128 + 8 * h;
#pragma unroll
    for (int kk = 0; kk < 8; ++kk) qf[kk] = ld16(qp + 16 * kk);
  }
  const float sc = 0.08838834764831845f * LOG2E;
  f32x16 O[4];
#pragma unroll
  for (int vt = 0; vt < 4; ++vt) O[vt] = zero16();
  float mrun = -1e30f, l = 0.f;
#pragma unroll 1
  for (int kb = 0; kb < 4; ++kb) {
    f32x16 s0 = zero16(), s1 = zero16();
    const bf16_t* kp = MK + (size_t)(kb * 64 + r) * 512 + 8 * h;
#pragma unroll
    for (int kk = 0; kk < 8; ++kk) {
      const bf16x8 k0 = ld16(kp + 16 * kk), k1 = ld16(kp + (size_t)32 * 512 + 16 * kk);
      s0 = MFMA32(k0, qf[kk], s0); s1 = MFMA32(k1, qf[kk], s1);
    }
    float mx = -1e30f;
#pragma unroll
    for (int i = 0; i < 16; ++i) mx = fmaxf(mx, fmaxf(s0[i], s1[i]));
    mx = fmaxf(mx, __shfl_xor(mx, 32)) * sc;
    const float mnew = fmaxf(mrun, mx), alpha = fexp2(mrun - mnew);
    mrun = mnew;
    float sum = 0.f;
#pragma unroll
    for (int i = 0; i < 16; ++i) { s0[i] = fexp2(s0[i] * sc - mnew); s1[i] = fexp2(s1[i] * sc - mnew); sum += s0[i] + s1[i]; }
    l = l * alpha + sum;
#pragma unroll
    for (int vt = 0; vt < 4; ++vt) O[vt] = O[vt] * alpha;
    bf16x8 pf[2][2];
    pf[0][0] = pack_acc(s0, 0); pf[0][1] = pack_acc(s0, 1); pf[1][0] = pack_acc(s1, 0); pf[1][1] = pack_acc(s1, 1);
#pragma unroll
    for (int vt = 0; vt < 4; ++vt) {
      const bf16_t* vp = MV + (size_t)(32 * vt + r) * 256 + kb * 64 + 4 * h;
#pragma unroll
      for (int st = 0; st < 2; ++st)
#pragma unroll
        for (int s2 = 0; s2 < 2; ++s2) {
          const bf16x8 a = ld8x2(vp + 32 * st + 16 * s2, vp + 32 * st + 16 * s2 + 8);
          O[vt] = MFMA32(a, pf[st][s2], O[vt]);
        }
    }
  }
  l += __shfl_xor(l, 32);
  const float inv = 1.f / l;
  const bf16_t* zp = Zb + (size_t)tok * ldq + hd * 128;
  bf16_t* op = (bf16_t*)(ws + WS_AO) + (size_t)tok * 1536 + 1024 + hd * 128;
#pragma unroll
  for (int vt = 0; vt < 4; ++vt)
#pragma unroll
    for (int g = 0; g < 4; ++g) {
      const int v = 32 * vt + 8 * g + 4 * h;
      const u32x2 z = *(const u32x2*)(zp + v);
      const float o0 = O[vt][4 * g] * inv * siluf_(bflo(z[0])), o1 = O[vt][4 * g + 1] * inv * siluf_(bfhi(z[0]));
      const float o2 = O[vt][4 * g + 2] * inv * siluf_(bflo(z[1])), o3 = O[vt][4 * g + 3] * inv * siluf_(bfhi(z[1]));
      u32x2 o = {pk2(o0, o1), pk2(o2, o3)};
      *(u32x2*)(op + v) = o;
    }
}

DI int next_item(unsigned* ctr, unsigned char* lds_flag_area, int tid) {
  __syncthreads();
  int* sh = (int*)lds_flag_area;
  if (tid == 0) *sh = (int)atomicAdd(ctr, 1u);
  __syncthreads();
  const int v = *sh;
  return v;
}

DI void phase2(const Params& p, unsigned char* lds) {
  unsigned* ctr = (unsigned*)(p.ws + WS_CTR) + 0 + 8 * p.pad;
  const bf16_t* PA = (const bf16_t*)(p.ws + WS_R1);
  const int n_ps = 36 * 16, n_ss = 576, n_in = NCH * 4, n_ma = NCH;
  for (;;) {
    const int it = next_item(ctr, lds + LDS_BYTES - 16, TIDX);
    if (it >= n_ps + n_ss + n_in + n_ma) break;
    if (it < n_ps) scan_task(p, lds, -1, (it % 36) / 9, it % 9, it / 36);
    else if (it < n_ps + n_ss) { const int q = it - n_ps; scan_task(p, lds, q / 36, (q % 36) / 9, q % 9, 0); }
    else if (it < n_ps + n_ss + n_in) { const int q = it - n_ps - n_ss; intra_task(p, q >> 2, q & 3); }
    else { const int q = it - n_ps - n_ss - n_in; memattn_task(p, q, 0, PA + 5120, PA + 5632, 6144); }
  }
}


DI void scanfix_task(const Params& p, unsigned char* lds, int grp, int hd, int j) {
  const int tid = TIDX, lane = tid & 63, wid = tid >> 6, r = lane & 31, h = lane >> 5;
  unsigned char* ws = p.ws;
  const bool nsl = j == 8;
  const float* LD = (const float*)(ws + WS_LD);
  f32x16 S = zero16();
  for (int gp = 0; gp < grp; ++gp) {
    const float dg = __expf(LD[(GRP * (gp + 1)) * 4 + hd] - LD[(GRP * gp) * 4 + hd]);
    const float* cl = (const float*)(ws + WS_CLOC) + ((((size_t)(gp * 4 + hd) * 9 + j) * 8 + wid) * 64 + lane) * 16;
#pragma unroll
    for (int g = 0; g < 4; ++g) { const f32x4 c = *(const f32x4*)(cl + 4 * g);
      S[4 * g] = S[4 * g] * dg + c[0]; S[4 * g + 1] = S[4 * g + 1] * dg + c[1]; S[4 * g + 2] = S[4 * g + 2] * dg + c[2]; S[4 * g + 3] = S[4 * g + 3] * dg + c[3]; }
  }
  if (grp == 16) {
    if (!nsl) {
      float* Co = p.out + O_PC + (size_t)hd * 65536 + (size_t)(32 * j + r) * 256 + 32 * wid;
#pragma unroll
      for (int g = 0; g < 4; ++g) { f32x4 c = {S[4 * g], S[4 * g + 1], S[4 * g + 2], S[4 * g + 3]}; *(f32x4*)(Co + 8 * g + 4 * h) = c; }
    } else if (r == 0) {
      float* no = p.out + O_PN + (size_t)hd * 256 + 32 * wid;
#pragma unroll
      for (int g = 0; g < 4; ++g) { f32x4 c = {S[4 * g], S[4 * g + 1], S[4 * g + 2], S[4 * g + 3]}; *(f32x4*)(no + 8 * g + 4 * h) = c; }
    }
    return;
  }
  u32x4* fr = (u32x4*)lds;
  float* tp = (float*)(lds + 16384) + wid * (64 * 33);
  __syncthreads();
  fr[(wid * 2 + 0) * 64 + lane] = __builtin_bit_cast(u32x4, pack_acc(S, 0));
  fr[(wid * 2 + 1) * 64 + lane] = __builtin_bit_cast(u32x4, pack_acc(S, 1));
  __syncthreads();
  bf16x8 xf[8][2];
#pragma unroll
  for (int kt = 0; kt < 8; ++kt) { xf[kt][0] = __builtin_bit_cast(bf16x8, fr[(kt * 2 + 0) * 64 + lane]); xf[kt][1] = __builtin_bit_cast(bf16x8, fr[(kt * 2 + 1) * 64 + lane]); }
  const bf16_t* PA = (const bf16_t*)(ws + WS_R1);
  const float* WIa = (const float*)(ws + WS_WI);
#pragma unroll 1
  for (int ci = 0; ci < 2; ++ci) {
    const int cc = GRP * grp + wid + 8 * ci;
    const float D = __expf(LD[cc * 4 + hd] - LD[(GRP * grp) * 4 + hd]);
#pragma unroll
    for (int tt = 0; tt < 2; ++tt) {
      const bf16_t* qp = PA + (size_t)(cc * 64 + 32 * tt + r) * 6144 + hd * 256 + 4 * h;
      f32x16 z = zero16();
#pragma unroll
      for (int kt = 0; kt < 8; ++kt)
#pragma unroll
        for (int s2 = 0; s2 < 2; ++s2) {
          const bf16x8 q = ld8x2(qp + 32 * kt + 16 * s2, qp + 32 * kt + 16 * s2 + 8);
          z = MFMA32(xf[kt][s2], q, z);
        }
#pragma unroll
      for (int i = 0; i < 16; ++i) tp[(32 * tt + r) * 33 + crow(i, h)] = z[i];
    }
    const int v = lane & 31;
#pragma unroll 4
    for (int e = 0; e < 32; ++e) {
      const int t = 2 * e + (lane >> 5);
      const float val = tp[t * 33 + v] * (WIa[((size_t)cc * 4 + hd) * 64 + t] * D);
      if (!nsl) { float* d = (float*)(ws + WS_HINTER) + (size_t)(cc * 64 + t) * 1024 + hd * 256 + 32 * j + v; *d += val; }
      else if (v == 0) { float* d = (float*)(ws + WS_DENI) + (size_t)(cc * 64 + t) * 4 + hd; *d += val; }
    }
  }
}

DI void phase2c(const Params& p, unsigned char* lds) {
  unsigned* ctr = (unsigned*)(p.ws + WS_CTR) + 3 + 8 * p.pad;
  for (;;) {
    const int it = next_item(ctr, lds + LDS_BYTES - 16, TIDX);
    if (it >= 16 * 36) break;
    const int g = 16 - it / 36;
    scanfix_task(p, lds, g, (it % 36) / 9, it % 9);
  }
}

DI void phase3(const Params& p) {
  const int tid = TIDX, lane = tid & 63, wid = tid >> 6;
  unsigned char* ws = p.ws;
  const int gw = blockIdx.x * 8 + wid, nw = gridDim.x * 8;
  const bf16_t* PA = (const bf16_t*)(ws + WS_R1);
  for (int it = gw; it < TT * 4; it += nw) {
    const int tok = it >> 2, hd = it & 3, cc = tok >> 6, t = tok & 63;
    const size_t off = (size_t)tok * 1024 + hd * 256 + 4 * lane;
    const f32x4 a = *(const f32x4*)((const float*)(ws + WS_HINTER) + off), b = *(const f32x4*)((const float*)(ws + WS_HINTRA) + off);
    const float den = ((const float*)(ws + WS_DENI))[tok * 4 + hd] + ((const float*)(ws + WS_DENA))[tok * 4 + hd];
    const float mt = ((const float*)(ws + WS_MT))[((size_t)cc * 4 + hd) * 64 + t];
    const float dn = 1.f / fmaxf(fabsf(den), __expf(-mt));
    const u32x2 ou = *(const u32x2*)(PA + (size_t)tok * 6144 + 3072 + hd * 256 + 4 * lane);
    const u32x2 zu = *(const u32x2*)(PA + (size_t)tok * 6144 + 4096 + hd * 256 + 4 * lane);
    f32x4 hv = (a + b) * dn;
    hv[0] *= sigmoidf_(bflo(ou[0])); hv[1] *= sigmoidf_(bfhi(ou[0])); hv[2] *= sigmoidf_(bflo(ou[1])); hv[3] *= sigmoidf_(bfhi(ou[1]));
    float ss = hv[0] * hv[0] + hv[1] * hv[1] + hv[2] * hv[2] + hv[3] * hv[3];
    ss = wave_sum(ss);
    const float rstd = __builtin_amdgcn_rsqf(ss * (1.f / 256.f) + EPS);
    const f32x4 hg = *(const f32x4*)(p.in[I_HGA] + hd * 256 + 4 * lane);
    hv = hv * rstd * hg;
    hv[0] *= siluf_(bflo(zu[0])); hv[1] *= siluf_(bfhi(zu[0])); hv[2] *= siluf_(bflo(zu[1])); hv[3] *= siluf_(bfhi(zu[1]));
    u32x2 o = {pk2(hv[0], hv[1]), pk2(hv[2], hv[3])};
    *(u32x2*)((bf16_t*)(ws + WS_AO) + (size_t)tok * 1536 + hd * 256 + 4 * lane) = o;
  }
}

DI void phase_outproj(const Params& p, unsigned char* lds, int layer) {
  const int tid = TIDX, lane = tid & 63, wid = tid >> 6, r = lane & 31, h = lane >> 5, wr = wid >> 1, wc = wid & 1;
  unsigned char* ws = p.ws;
  const bf16_t* W = (const bf16_t*)(ws + (layer == 0 ? WS_WOA : WS_WOB));
  for (int t = blockIdx.x; t < 68 * 8; t += gridDim.x) {
    const int tm = t >> 3, tn = t & 7, m0 = tm * 256, n0 = tn * 128;
    GemmAcc acc;
    gemm_tile((const bf16_t*)(ws + WS_AO) + (size_t)m0 * 1536, 1536, W + (size_t)n0 * 1536, 1536, 1536, lds, acc, tid);
#pragma unroll
    for (int a = 0; a < 2; ++a)
#pragma unroll
      for (int b = 0; b < 2; ++b) {
        const int n = n0 + wc * 64 + 32 * b + r, mb = m0 + wr * 64 + 32 * a;
#pragma unroll
        for (int i = 0; i < 16; ++i) {
          const int m = mb + crow(i, h);
          if (layer == 0) {
            const float xv = m < TP ? p.in[I_XP][(size_t)m * 1024 + n] : p.in[I_XS][(size_t)(m - TP) * 1024 + n];
            ((float*)(ws + WS_Y1))[(size_t)m * 1024 + n] = xv + acc.a[a][b][i];
          } else {
            p.out[O_Y + (size_t)m * 1024 + n] = ((const float*)(ws + WS_Y1))[(size_t)m * 1024 + n] + acc.a[a][b][i];
          }
        }
      }
  }
}

DI void phase5(const Params& p, unsigned char* lds) {
  const int tid = TIDX, lane = tid & 63, wid = tid >> 6;
  unsigned char* ws = p.ws;
  const int gw = blockIdx.x * 8 + wid, nw = gridDim.x * 8;
  for (int r = gw; r < TT; r += nw) {
    f32x4 v[4];
    const float rstd = row_load_rstd((const float*)(ws + WS_Y1) + (size_t)r * 1024, v, lane);
    bf16_t* xn = (bf16_t*)(ws + WS_XN) + (size_t)r * 1024;
#pragma unroll
    for (int j = 0; j < 4; ++j) { const f32x4 xs = v[j] * rstd; u32x2 o = {pk2(xs[0], xs[1]), pk2(xs[2], xs[3])}; *(u32x2*)(xn + 4 * lane + 256 * j) = o; }
  }
  {
    const size_t n8 = (size_t)16 * PAST * 1024 / 8;
    for (size_t i = (size_t)blockIdx.x * NTHREADS + tid; i < n8; i += (size_t)gridDim.x * NTHREADS) {
      const size_t e = i * 8; const size_t b = e / ((size_t)PAST * 1024), rem = e - b * PAST * 1024;
      const f32x4 a = *(const f32x4*)(p.in[I_CK] + e), c = *(const f32x4*)(p.in[I_CK] + e + 4);
      u32x4 o = {pk2(a[0], a[1]), pk2(a[2], a[3]), pk2(c[0], c[1]), pk2(c[2], c[3])};
      *(u32x4*)((bf16_t*)(ws + WS_KBS) + b * SKV * 1024 + rem) = o;
    }
  }
  __syncthreads();
  for (int t = blockIdx.x; t < 128 * 128; t += gridDim.x) {
    const int jb = t >> 7, tile = t & 127, b = jb >> 3, hd = jb & 7;
    TJob j = {p.in[I_CV] + (size_t)b * PAST * 1024 + hd * 128, 1024, (bf16_t*)(ws + WS_VTS) + ((size_t)(b * 8 + hd) * 128) * SKV, SKV, nullptr, 64, 2};
    run_tjob_tile(j, tile, (float*)lds, tid);
  }
}

DI void phase6(const Params& p, unsigned char* lds) {
  const int tid = TIDX, lane = tid & 63, wid = tid >> 6, r = lane & 31, h = lane >> 5, wr = wid >> 1, wc = wid & 1;
  unsigned char* ws = p.ws;
  for (int t = blockIdx.x; t < 68 * 40; t += gridDim.x) {
    const int tm = t / 40, tn = t % 40, m0 = tm * 256, n0 = tn * 128;
    GemmAcc acc;
    gemm_tile((const bf16_t*)(ws + WS_XN) + (size_t)m0 * 1024, 1024, (const bf16_t*)(ws + WS_WKB) + (size_t)n0 * 1024, 1024, 1024, lds, acc, tid);
    const int sec = n0 >> 10;
    const bool samp = m0 >= TP;
#pragma unroll
    for (int a = 0; a < 2; ++a)
#pragma unroll
      for (int b = 0; b < 2; ++b) {
        const int n = n0 + wc * 64 + 32 * b + r, mb = m0 + wr * 64 + 32 * a;
        if (sec == 0) {
          const int f = n;
#pragma unroll
          for (int i = 0; i < 16; ++i) {
            const int m = mb + crow(i, h);
            const float v = acc.a[a][b][i];
            if (!samp) { p.out[O_PK + (size_t)m * 1024 + f] = v; ((bf16_t*)(ws + WS_KBP))[(size_t)m * 1024 + f] = f2bf(v); }
            else { const int ms = m - TP, bb = ms >> 6, s = ms & 63; p.out[O_SK + (size_t)ms * 1024 + f] = v;
                   ((bf16_t*)(ws + WS_KBS))[((size_t)bb * SKV + PAST + s) * 1024 + f] = f2bf(v); }
          }
        } else if (sec == 1) {
          const int f = n - 1024, hd = f >> 7, vd = f & 127;
#pragma unroll
          for (int i = 0; i < 16; ++i) {
            const int m = mb + crow(i, h);
            if (!samp) p.out[O_PV + (size_t)m * 1024 + f] = acc.a[a][b][i]; else p.out[O_SV + (size_t)(m - TP) * 1024 + f] = acc.a[a][b][i];
          }
#pragma unroll
          for (int g = 0; g < 4; ++g) {
            const int m = mb + 8 * g + 4 * h;
            u32x2 o = {pk2(acc.a[a][b][4 * g], acc.a[a][b][4 * g + 1]), pk2(acc.a[a][b][4 * g + 2], acc.a[a][b][4 * g + 3])};
            if (!samp) *(u32x2*)((bf16_t*)(ws + WS_VTP) + ((size_t)hd * 128 + vd) * TP + m) = o;
            else { const int ms = m - TP, bb = ms >> 6, s = ms & 63; *(u32x2*)((bf16_t*)(ws + WS_VTS) + ((size_t)(bb * 8 + hd) * 128 + vd) * SKV + PAST + s) = o; }
          }
        } else {
          const float sc = sec == 2 ? 0.125f * LOG2E : 1.f;
          bf16_t* PB = (bf16_t*)(ws + WS_PB);
#pragma unroll
          for (int i = 0; i < 16; ++i) PB[(size_t)(mb + crow(i, h)) * 3072 + (n - 2048)] = f2bf(acc.a[a][b][i] * sc);
        }
      }
  }
}

constexpr int A_KROW = 272, A_VROW = 136, A_KB = 64 * A_KROW, A_BUF = A_KB + 128 * A_VROW;

DI void diffattn_task(const Params& p, unsigned char* lds, int sb  , int qt  , int hd, float lam) {
  const int tid = TIDX, lane = tid & 63, wid = __builtin_amdgcn_readfirstlane(tid >> 6), r = lane & 31, h = lane >> 5;
  unsigned char* ws = p.ws;
  const int cq = wid >> 2, sub = (wid >> 1) & 1, map = wid & 1;
  const int ncq = sb < 0 ? 2 : 1;
  const int base_chunk = sb < 0 ? 2 * qt : 64;
  const int tok0 = sb < 0 ? qt * 128 : TP + sb * 64;
  const bool wvalid = cq < ncq;
  const int qc = base_chunk + cq;
  const int tl = 32 * sub + r;
  const int tok = tok0 + 64 * (wvalid ? cq : 0) + tl;
  const bf16_t* Kb = sb < 0 ? (const bf16_t*)(ws + WS_KBP) + hd * 128 : (const bf16_t*)(ws + WS_KBS) + (size_t)sb * SKV * 1024 + hd * 128;
  const bf16_t* Vb = sb < 0 ? (const bf16_t*)(ws + WS_VTP) + (size_t)hd * 128 * TP : (const bf16_t*)(ws + WS_VTS) + (size_t)(sb * 8 + hd) * 128 * SKV;
  const size_t ldv = sb < 0 ? TP : SKV;
  const bf16_t* PB = (const bf16_t*)(ws + WS_PB);
  bf16x8 qf[4];
  {
    const unsigned qo = (unsigned)tok * 3072u + hd * 128 + map * 64 + 8 * h;
#pragma unroll
    for (int kk = 0; kk < 4; ++kk) qf[kk] = ld16(PB + (qo + 16 * kk));
  }
  const float sl2 = exp2f(-(float)(hd + 1)) * LOG2E;
  const float bh0 = sl2 * (float)(4 * h), bh1 = bh0 + 32.f * sl2;
  float cs[16];
#pragma unroll
  for (int i = 0; i < 16; ++i) cs[i] = __uint_as_float(__builtin_amdgcn_readfirstlane(__float_as_uint(sl2 * (float)((i & 3) + 8 * (i >> 2)))));
  f32x16 O[4];
#pragma unroll
  for (int vt = 0; vt < 4; ++vt) O[vt] = zero16();
  float mrun = -1e30f, l = 0.f;
  const int jmax = base_chunk + ncq - 1, nit = jmax + 1;
  u32x4 rk[2], rv[2];
  const unsigned kofs = (unsigned)((tid >> 4) * 1024 + (tid & 15) * 8), vofs = (unsigned)((tid >> 3) * (unsigned)ldv + (tid & 7) * 8);
  auto gload = [&](int j) {
    const bf16_t* kj = Kb + (size_t)j * 65536;
    const bf16_t* vj = Vb + (size_t)j * 64;
#pragma unroll
    for (int e = 0; e < 2; ++e) {
      rk[e] = *(const u32x4*)(kj + (kofs + (unsigned)e * 32768u));
      rv[e] = *(const u32x4*)(vj + (vofs + (unsigned)e * 64u * (unsigned)ldv));
    }
  };
  auto lstore = [&](int buf) {
    unsigned char* base = lds + buf * A_BUF;
#pragma unroll
    for (int e = 0; e < 2; ++e) {
      const int id = tid + 512 * e;
      { const int row = id >> 4, c = id & 15; *(u32x4*)(base + row * A_KROW + 16 * c) = rk[e]; }
      { const int row = id >> 3, c = id & 7; unsigned char* d = base + A_KB + row * A_VROW + 16 * c;
        u32x2 lo = {rv[e][0], rv[e][1]}, hi = {rv[e][2], rv[e][3]}; *(u32x2*)d = lo; *(u32x2*)(d + 8) = hi; }
    }
  };
  gload(jmax);
  __syncthreads();
  lstore(0);
  __syncthreads();
  for (int it = 0; it < nit; ++it) {
    const int j = jmax - it;
    if (it + 1 < nit) gload(j - 1);
    if (wvalid && j <= qc) {
      const unsigned char* base = lds + (it & 1) * A_BUF;
      const unsigned char* kp = base + r * A_KROW + map * 128 + 16 * h;
      f32x16 s0, s1;
      {
        float b0 = bh0, b1 = bh1;
        asm volatile("" : "+v"(b0), "+v"(b1));
#pragma unroll
        for (int i = 0; i < 16; ++i) { s0[i] = b0 + cs[i]; s1[i] = b1 + cs[i]; }
      }
      if (j == qc) {
        int tlv = tl;
        asm volatile("" : "+v"(tlv));
        const float m2 = -2.f * sl2;
#pragma unroll
        for (int i = 0; i < 16; ++i) {
          const int s = crow(i, h);
          s0[i] = fmaf(m2, (float)max(0, s - tlv), s0[i]); s1[i] = fmaf(m2, (float)max(0, 32 + s - tlv), s1[i]);
        }
      }
#pragma unroll
      for (int kk = 0; kk < 4; ++kk) {
        const bf16x8 k0 = ld16(kp + 32 * kk), k1 = ld16(kp + 32 * A_KROW + 32 * kk);
        s0 = MFMA32(k0, qf[kk], s0); s1 = MFMA32(k1, qf[kk], s1);
      }
      const float dofs = sl2 * (float)((qc - j) * 64);
      float mx = -1e30f;
#pragma unroll
      for (int i = 0; i < 16; ++i) mx = fmaxf(mx, fmaxf(s0[i], s1[i]));
      mx = fmaxf(mx, __shfl_xor(mx, 32)) - dofs;
      const float mnew = fmaxf(mrun, mx), alpha = fexp2(mrun - mnew), mm = mnew + dofs;
      mrun = mnew;
      float sum = 0.f;
#pragma unroll
      for (int i = 0; i < 16; ++i) { s0[i] = fexp2(s0[i] - mm); s1[i] = fexp2(s1[i] - mm); sum += s0[i] + s1[i]; }
      l = l * alpha + sum;
#pragma unroll
      for (int vt = 0; vt < 4; ++vt) O[vt] = O[vt] * alpha;
      bf16x8 pf[2][2];
      pf[0][0] = pack_acc(s0, 0); pf[0][1] = pack_acc(s0, 1); pf[1][0] = pack_acc(s1, 0); pf[1][1] = pack_acc(s1, 1);
      const unsigned char* vbase = base + A_KB + r * A_VROW + 8 * h;
      __builtin_amdgcn_sched_barrier(0);
#pragma unroll
      for (int vt = 0; vt < 4; ++vt) {
        if (vt == 2) __builtin_amdgcn_sched_barrier(0);
        const unsigned char* vp = vbase + 32 * vt * A_VROW;
#pragma unroll
        for (int st = 0; st < 2; ++st)
#pragma unroll
          for (int s2 = 0; s2 < 2; ++s2) {
            const bf16x8 a = ld8x2(vp + 64 * st + 32 * s2, vp + 64 * st + 32 * s2 + 16);
            O[vt] = MFMA32(a, pf[st][s2], O[vt]);
          }
      }
    }
    if (it + 1 < nit) lstore((it + 1) & 1);
    __syncthreads();
  }
  l += __shfl_xor(l, 32);
  const float inv = wvalid ? 1.f / l : 0.f;
  float* xch = (float*)lds + (size_t)(wid >> 1) * 4096;
  if (map == 1 && wvalid) {
    const float sc = inv * lam;
#pragma unroll
    for (int vt = 0; vt < 4; ++vt)
#pragma unroll
      for (int i = 0; i < 16; ++i) xch[(vt * 16 + i) * 64 + lane] = O[vt][i] * sc;
  }
  __syncthreads();
  if (map == 0 && wvalid) {
    float ss = 0.f;
#pragma unroll
    for (int vt = 0; vt < 4; ++vt)
#pragma unroll
      for (int i = 0; i < 16; ++i) { const float o = O[vt][i] * inv - xch[(vt * 16 + i) * 64 + lane]; O[vt][i] = o; ss += o * o; }
    ss += __shfl_xor(ss, 32);
    const float lam_init = 0.8f - 0.6f * 0.7408182206817179f;
    const float rs = __builtin_amdgcn_rsqf(ss * (1.f / 128.f) + EPS) * (1.f - lam_init);
    const unsigned zo = (unsigned)tok * 3072u + 1024 + hd * 128, oo = (unsigned)tok * 1536u + hd * 128;
    bf16_t* AOp = (bf16_t*)(ws + WS_AO);
    const float* sg = p.in[I_SUBG];
#pragma unroll
    for (int vt = 0; vt < 4; ++vt)
#pragma unroll
      for (int g = 0; g < 4; ++g) {
        const int v = 32 * vt + 8 * g + 4 * h;
        const u32x2 z = *(const u32x2*)(PB + (zo + v));
        const f32x4 gg = *(const f32x4*)(sg + v);
        const float o0 = O[vt][4 * g] * rs * gg[0] * siluf_(bflo(z[0])), o1 = O[vt][4 * g + 1] * rs * gg[1] * siluf_(bfhi(z[0]));
        const float o2 = O[vt][4 * g + 2] * rs * gg[2] * siluf_(bflo(z[1])), o3 = O[vt][4 * g + 3] * rs * gg[3] * siluf_(bfhi(z[1]));
        u32x2 o = {pk2(o0, o1), pk2(o2, o3)};
        *(u32x2*)(AOp + (oo + v)) = o;
      }
  }
  __syncthreads();
}

DI void phase7(const Params& p, unsigned char* lds) {
  unsigned* ctr = (unsigned*)(p.ws + WS_CTR) + 1 + 8 * p.pad;
  const bf16_t* PB = (const bf16_t*)(p.ws + WS_PB);
  float lam;
  {
    const int lane = TIDX & 63;
    const float* lv = p.in[I_LAMB];
    const float a = wave_sum(lv[lane] * lv[64 + lane]), b = wave_sum(lv[128 + lane] * lv[192 + lane]);
    const float lam_init = 0.8f - 0.6f * 0.7408182206817179f;
    lam = __expf(a) - __expf(b) + lam_init;
  }
  const int n_s = 128, n_p = 1024, n_ma = NCH;
  for (;;) {
    const int it = next_item(ctr, lds + LDS_BYTES - 16, TIDX);
    if (it >= n_s + n_p) break;
    const bool pr = it < n_p;
    const int q = it - n_p;
    diffattn_task(p, lds, pr ? -1 : (q >> 3), pr ? 127 - (it >> 3) : 0, it & 7, lam);
  }
  for (;;) {
    const int it = next_item(ctr + 1, lds + LDS_BYTES - 16, TIDX);
    if (it >= n_ma) break;
    memattn_task(p, it, 1, PB + 2048, PB + 2560, 3072);
  }
}

DI void phase9(const Params& p) {
  const int tid = TIDX, lane = tid & 63, wid = tid >> 6;
  const int gw = blockIdx.x * 8 + wid, nw = gridDim.x * 8;
  for (int r = gw; r < TT; r += nw) {
    f32x4 v[4];
    float* row = p.out + O_Y + (size_t)r * 1024;
    const float rstd = row_load_rstd(row, v, lane);
#pragma unroll
    for (int j = 0; j < 4; ++j) {
      const f32x4 g = *(const f32x4*)(p.in[I_FNG] + 4 * lane + 256 * j);
      *(f32x4*)(row + 4 * lane + 256 * j) = v[j] * rstd * g;
    }
  }
}

DI void grid_barrier(unsigned* bar, unsigned target, int tid) {
  __threadfence();
  __syncthreads();
  if (tid == 0) {
    __hip_atomic_fetch_add(bar, 1u, __ATOMIC_RELEASE, __HIP_MEMORY_SCOPE_AGENT);
    while (__hip_atomic_load(bar, __ATOMIC_RELAXED, __HIP_MEMORY_SCOPE_AGENT) < target) __builtin_amdgcn_s_sleep(2);
  }
  __syncthreads();
  __threadfence();
}

__global__ __launch_bounds__(512) void mk(Params pin) {
  extern __shared__ __attribute__((aligned(16))) unsigned char lds[];
  Params p = pin;
  p.wv = __builtin_amdgcn_readfirstlane((int)(__builtin_amdgcn_workitem_id_x() >> 6));
  cg::grid_group grid = cg::this_grid();
  unsigned nbar = 0;
  unsigned* bar = (unsigned*)(p.ws + WS_CTR) + 32;
#define RUN_PHASE(PH, CALL) if (p.ph_lo <= PH && PH < p.ph_hi) { CALL; if (PH + 1 < p.ph_hi) { ++nbar; grid_barrier(bar, nbar * gridDim.x, TIDX); } }
  if (p.ph_lo <= 0 && 0 < p.ph_hi) { phase0(p, lds); if (1 < p.ph_hi) grid.sync(); }
  RUN_PHASE(1, phase1(p, lds))
  RUN_PHASE(2, phase2(p, lds))
  if (p.ph_lo <= 2 && 2 < p.ph_hi) { phase2c(p, lds); ++nbar; grid_barrier(bar, nbar * gridDim.x, TIDX); }
  RUN_PHASE(3, phase3(p))
  RUN_PHASE(4, phase_outproj(p, lds, 0))
  RUN_PHASE(5, phase5(p, lds))
  RUN_PHASE(6, phase6(p, lds))
  RUN_PHASE(7, phase7(p, lds))
  RUN_PHASE(8, phase_outproj(p, lds, 1))
  RUN_PHASE(9, phase9(p))
}

extern "C" void kernel_launch(void* const* d_in, const int* in_sizes, int n_in, void* d_out, int out_size,
                              void* d_ws, size_t ws_size, hipStream_t stream) {
  static int grid_blocks = 0;
  if (!grid_blocks) {
    int dev = 0, cus = 0, per_cu = 0;
    (void)hipGetDevice(&dev);
    (void)hipDeviceGetAttribute(&cus, hipDeviceAttributeMultiprocessorCount, dev);
    (void)hipFuncSetAttribute((const void*)mk, hipFuncAttributeMaxDynamicSharedMemorySize, LDS_BYTES);
    (void)hipOccupancyMaxActiveBlocksPerMultiprocessor(&per_cu, (const void*)mk, NTHREADS, LDS_BYTES);
    grid_blocks = cus;
    fprintf(stderr, "kernel_launch: cus=%d per_cu=%d grid=%d ws=%zu need=%zu\n", cus, per_cu, grid_blocks, ws_size, (size_t)WS_END);
  }
  if (ws_size < WS_END) { fprintf(stderr, "workspace too small\n"); return; }
  Params p{};
  for (int i = 0; i < 24; ++i) p.in[i] = (const float*)d_in[i];
  p.out = (float*)d_out; p.ws = (unsigned char*)d_ws; p.ph_lo = 0; p.ph_hi = NPHASE;
  void* args[] = {&p};
  hipError_t e = hipLaunchCooperativeKernel((const void*)mk, dim3(grid_blocks), dim3(NTHREADS), args, LDS_BYTES, stream);
  if (e != hipSuccess) fprintf(stderr, "cooperative launch failed: %s (grid %d)\n", hipGetErrorString(e), grid_blocks);
  if (PROBE_REP >= 0) {
    Params q = p;
    q.out = (float*)((unsigned char*)d_ws + WS_END); q.ph_lo = PROBE_REP; q.ph_hi = PROBE_REP + 1; q.pad = 1;
    void* args2[] = {&q};
    (void)hipLaunchCooperativeKernel((const void*)mk, dim3(grid_blocks), dim3(NTHREADS), args2, LDS_BYTES, stream);
  }
}
```

```cpp
#include <hip/hip_runtime.h>
#include <hip/hip_cooperative_groups.h>
#include <cstdio>
#include <cstdint>
namespace cg = cooperative_groups;

typedef unsigned short bf16_t;
typedef short bf16x8 __attribute__((ext_vector_type(8)));
typedef short s16x4 __attribute__((ext_vector_type(4)));
typedef float f32x16 __attribute__((ext_vector_type(16)));
typedef float f32x4 __attribute__((ext_vector_type(4)));
typedef float f32x2 __attribute__((ext_vector_type(2)));
typedef __bf16 bf2_t __attribute__((ext_vector_type(2)));
typedef unsigned u32x4 __attribute__((ext_vector_type(4)));
typedef unsigned u32x2 __attribute__((ext_vector_type(2)));
#define DI __device__ __forceinline__
#define MFMA32(a, b, c) __builtin_amdgcn_mfma_f32_32x32x16_bf16((a), (b), (c), 0, 0, 0)

struct Params { const float* in[24]; float* out; unsigned char* ws; int ph_lo, ph_hi; int wv, pad; };
#define TIDX (p.wv * 64 + (int)__builtin_amdgcn_mbcnt_hi(~0u, __builtin_amdgcn_mbcnt_lo(~0u, 0u)))
constexpr int LDS_BYTES = 110592;
constexpr int NTHREADS = 512;
constexpr int NPHASE = 10;
#ifndef PROBE_REP
#define PROBE_REP -1
#endif

constexpr int TP = 16384, TS = 1024, TT = 17408, DM = 1024;
constexpr int NCH = 272;
constexpr int PAST = 4096, SKV = 4160;
constexpr float EPS = 1e-6f;
constexpr float LOG2E = 1.4426950408889634f;
enum { I_XP = 0, I_XS, I_CK, I_CV, I_CMK, I_CMV, I_SC, I_SN, I_SM, I_MEMP, I_NG, I_FNG, I_MNG, I_WMKV, I_WINA, I_BGA, I_HGA, I_WOA,
       I_KVNG, I_WKV, I_WINB, I_LAMB, I_SUBG, I_WOB };
constexpr size_t O_Y = 0, O_PC = 17825792, O_PN = 18087936, O_PM = 18088960, O_PK = 18088964, O_PV = 34866180, O_PMK = 51643396,
                 O_PMV = 51905540, O_SC = 52167684, O_SN = 56361988, O_SM = 56378372, O_SK = 56378436, O_SV = 57427012;
constexpr size_t WS_CTR = 0;
constexpr size_t WS_KMAX = 1024;
constexpr size_t WS_TORD = 8192;
constexpr size_t WS_WA = 16384;
constexpr size_t WS_WOA = WS_WA + (size_t)6144 * 1024 * 2;
constexpr size_t WS_WKB = WS_WOA + (size_t)1024 * 1536 * 2;
constexpr size_t WS_WOB = WS_WKB + (size_t)5120 * 1024 * 2;
constexpr size_t WS_WM = WS_WOB + (size_t)1024 * 1536 * 2;
constexpr size_t WS_MEMN = WS_WM + (size_t)2 * 1024 * 1024 * 2;
constexpr size_t WS_MEMK = WS_MEMN + (size_t)2 * 256 * 1024 * 2;
constexpr size_t WS_MEMVT = WS_MEMK + (size_t)2 * 17 * 256 * 512 * 2;
constexpr size_t WS_GATE = WS_MEMVT + (size_t)2 * 17 * 256 * 512 * 2;
constexpr size_t SZ_CH = (size_t)NCH * 4 * 64 * 4;
constexpr size_t WS_GC = WS_GATE + (size_t)TT * 8 * 4;
constexpr size_t WS_MT = WS_GC + SZ_CH;
constexpr size_t WS_WS = WS_MT + SZ_CH;
constexpr size_t WS_WI = WS_WS + SZ_CH;
constexpr size_t WS_AS = WS_WI + SZ_CH;
constexpr size_t WS_BT = WS_AS + SZ_CH;
constexpr size_t WS_DEC = WS_BT + SZ_CH;
constexpr size_t WS_DENI = WS_DEC + 8192;
constexpr size_t WS_DENA = WS_DENI + (size_t)TT * 4 * 4;
constexpr size_t WS_XN = WS_DENA + (size_t)TT * 4 * 4;
constexpr size_t WS_AO = WS_XN + (size_t)TT * 1024 * 2;
constexpr size_t WS_Y1 = WS_AO + (size_t)TT * 1536 * 2;
constexpr size_t WS_KT = WS_Y1 + (size_t)TT * 1024 * 4;
constexpr size_t WS_VTA = WS_KT + (size_t)NCH * 4 * 256 * 64 * 2;
constexpr size_t WS_R1 = WS_VTA + (size_t)NCH * 4 * 256 * 64 * 2;
constexpr size_t SZ_R1 = (size_t)TT * 6144 * 2;
constexpr size_t WS_PB = WS_R1;
constexpr size_t WS_KBP = WS_PB + (size_t)TT * 3072 * 2;
constexpr size_t WS_VTP = WS_KBP + (size_t)TP * 1024 * 2;
constexpr size_t WS_R2 = WS_R1 + SZ_R1;
constexpr size_t WS_HINTER = WS_R2;
constexpr size_t WS_HINTRA = WS_R2 + (size_t)TT * 1024 * 4;
constexpr size_t WS_KBS = WS_R2;
constexpr size_t WS_VTS = WS_KBS + (size_t)16 * SKV * 1024 * 2;
constexpr size_t WS_LD = WS_VTS + (size_t)16 * SKV * 1024 * 2;
constexpr size_t WS_CLOC = WS_LD + 8192;
constexpr size_t WS_END = WS_CLOC + (size_t)16 * 36 * 8 * 64 * 16 * 4;
constexpr int GRP = 16;
static_assert(WS_VTP + (size_t)TP * 1024 * 2 <= WS_R2, "R1 overflow");

DI unsigned pk2(float lo, float hi) { f32x2 v = {lo, hi}; return __builtin_bit_cast(unsigned, __builtin_convertvector(v, bf2_t)); }
DI bf16_t f2bf(float x) { return (bf16_t)(pk2(x, 0.f) & 0xffffu); }
DI float bf2f(unsigned v16) { return __uint_as_float(v16 << 16); }
DI float bflo(unsigned u) { return __uint_as_float(u << 16); }
DI float bfhi(unsigned u) { return __uint_as_float(u & 0xffff0000u); }
DI float rbf(float x) { return bflo(pk2(x, 0.f) & 0xffffu); }
DI int crow(int i, int h) { return (i & 3) + 8 * (i >> 2) + 4 * h; }
DI float wave_sum(float v) {
#pragma unroll
  for (int o = 32; o >= 1; o >>= 1) v += __shfl_xor(v, o);
  return v;
}
DI float fexp2(float x) { return __builtin_amdgcn_exp2f(x); }
DI float fexp(float x) { return __builtin_amdgcn_exp2f(x * LOG2E); }
DI float sigmoidf_(float x) { return 1.f / (1.f + __expf(-x)); }
DI float siluf_(float x) { return x / (1.f + __expf(-x)); }
DI bf16x8 pack_acc(const f32x16& x, int s) {
  u32x4 p;
  p[0] = pk2(x[8 * s + 0], x[8 * s + 1]); p[1] = pk2(x[8 * s + 2], x[8 * s + 3]);
  p[2] = pk2(x[8 * s + 4], x[8 * s + 5]); p[3] = pk2(x[8 * s + 6], x[8 * s + 7]);
  return __builtin_bit_cast(bf16x8, p);
}
DI bf16x8 ld16(const void* p) { return *(const bf16x8*)p; }
DI bf16x8 ld8x2(const void* p0, const void* p1) {
  u32x2 a = *(const u32x2*)p0, b = *(const u32x2*)p1; u32x4 r = {a[0], a[1], b[0], b[1]};
  return __builtin_bit_cast(bf16x8, r);
}
DI f32x16 zero16() { f32x16 z; for (int i = 0; i < 16; ++i) z[i] = 0.f; return z; }

DI void transpose_tile(const float* __restrict__ src, size_t ld_s, bf16_t* __restrict__ dst, size_t ld_d, const float* __restrict__ scale,
                       float* scr, int t) {
  {
    const int c4 = t & 15, rb = t >> 4;
#pragma unroll
    for (int i = 0; i < 2; ++i) {
      const int r = rb + 32 * i;
      f32x4 v = *(const f32x4*)(src + (size_t)r * ld_s + 4 * c4);
      if (scale) { const float s = scale[r]; v = v * s; }
      float* d = scr + r * 65 + 4 * c4; d[0] = v[0]; d[1] = v[1]; d[2] = v[2]; d[3] = v[3];
    }
  }
  __syncthreads();
  {
    const int c = t >> 3, rg = t & 7;
    const float* s = scr + (8 * rg) * 65 + c;
    u32x4 o; o[0] = pk2(s[0], s[65]); o[1] = pk2(s[2 * 65], s[3 * 65]); o[2] = pk2(s[4 * 65], s[5 * 65]); o[3] = pk2(s[6 * 65], s[7 * 65]);
    *(u32x4*)(dst + (size_t)c * ld_d + 8 * rg) = o;
  }
  __syncthreads();
}

struct TJob { const float* src; size_t ld_s; bf16_t* dst; size_t ld_d; const float* scale; int tr, tc; };

DI void run_tjob_tile(const TJob& j, int tile, float* scr, int tid) {
  const int ir = tile / j.tc, ic = tile % j.tc;
  transpose_tile(j.src + (size_t)(64 * ir) * j.ld_s + 64 * ic, j.ld_s, j.dst + (size_t)(64 * ic) * j.ld_d + 64 * ir, j.ld_d,
                 j.scale ? j.scale + 64 * ir : nullptr, scr, tid);
}

DI float row_load_rstd(const float* xrow, f32x4 (&v)[4], int lane) {
  float ss = 0.f;
#pragma unroll
  for (int j = 0; j < 4; ++j) { v[j] = *(const f32x4*)(xrow + 4 * lane + 256 * j); ss += v[j][0] * v[j][0] + v[j][1] * v[j][1] + v[j][2] * v[j][2] + v[j][3] * v[j][3]; }
  ss = wave_sum(ss);
  return __builtin_amdgcn_rsqf(ss * (1.f / 1024.f) + EPS);
}

DI int diff_est(int a) {
  const int hd = a & 7;
  const int w = hd == 0 ? 5 : hd == 1 ? 9 : hd == 2 ? 16 : hd == 3 ? 31 : hd == 4 ? 60 : hd == 5 ? 119 : hd == 6 ? 237 : 256;
  const int n = a < 1024 ? 2 * (a >> 3) + 2 : 65;
  return n < w ? n : w;
}

DI void phase0(const Params& p, unsigned char* lds) {
  const int tid = TIDX, lane = tid & 63, wid = tid >> 6;
  unsigned char* ws = p.ws;
  if (blockIdx.x == 0 && tid < 64) ((unsigned*)(ws + WS_CTR))[tid] = 0u;
  if (blockIdx.x == 0 && tid < 272) ((unsigned*)(ws + WS_KMAX))[tid] = 0u;
  if (blockIdx.x == 1) {
    int* est = (int*)lds;
    for (int a = tid; a < 1152; a += NTHREADS) est[a] = diff_est(a);
    __syncthreads();
    for (int a = tid; a < 1152; a += NTHREADS) {
      const int ea = est[a];
      int rank = 0;
      for (int b = 0; b < 1152; ++b) { const int eb = est[b]; rank += (eb > ea) || (eb == ea && b < a); }
      ((int*)(ws + WS_TORD))[rank] = a;
    }
    __syncthreads();
  }
  {
    TJob jobs[8];
    jobs[0] = {p.in[I_WINA], 6152, (bf16_t*)(ws + WS_WA), 1024, p.in[I_NG], 16, 80};
    jobs[1] = {p.in[I_WINA] + 5128, 6152, (bf16_t*)(ws + WS_WA) + (size_t)5120 * 1024, 1024, p.in[I_NG], 16, 16};
    jobs[2] = {p.in[I_WOA], 1024, (bf16_t*)(ws + WS_WOA), 1536, nullptr, 24, 16};
    jobs[3] = {p.in[I_WKV], 2048, (bf16_t*)(ws + WS_WKB), 1024, p.in[I_KVNG], 16, 32};
    jobs[4] = {p.in[I_WINB], 3072, (bf16_t*)(ws + WS_WKB) + (size_t)2048 * 1024, 1024, p.in[I_NG] + 1024, 16, 48};
    jobs[5] = {p.in[I_WOB], 1024, (bf16_t*)(ws + WS_WOB), 1536, nullptr, 24, 16};
    jobs[6] = {p.in[I_WMKV], 1024, (bf16_t*)(ws + WS_WM), 1024, nullptr, 16, 16};
    jobs[7] = {p.in[I_WMKV] + (size_t)1024 * 1024, 1024, (bf16_t*)(ws + WS_WM) + (size_t)1024 * 1024, 1024, nullptr, 16, 16};
    int base = 0;
#pragma unroll
    for (int j = 0; j < 8; ++j) {
      const int n = jobs[j].tr * jobs[j].tc;
      for (int t = blockIdx.x; t < n; t += gridDim.x) run_tjob_tile(jobs[j], t, (float*)lds, tid);
      base += n;
    }
    for (int t = blockIdx.x; t < 128 * 8; t += gridDim.x) {
      const int jb = t >> 3, tile = t & 7, l = jb >> 6, b = (jb >> 2) & 15, h = jb & 3;
      TJob j = {p.in[I_CMV] + ((size_t)(l * 16 + b) * 256) * 512 + h * 128, 512,
                (bf16_t*)(ws + WS_MEMVT) + ((size_t)(l * 17 + 1 + b) * 4 + h) * 128 * 256, 256, nullptr, 4, 2};
      run_tjob_tile(j, tile, (float*)lds, tid);
    }
  }
  {
    const size_t n8 = (size_t)2 * 16 * 256 * 512 / 8;
    for (size_t i = (size_t)blockIdx.x * NTHREADS + tid; i < n8; i += (size_t)gridDim.x * NTHREADS) {
      const size_t e = i * 8; const int l = (int)(e / ((size_t)16 * 131072)); const size_t rem = e - (size_t)l * 16 * 131072;
      const f32x4 a = *(const f32x4*)(p.in[I_CMK] + e), b = *(const f32x4*)(p.in[I_CMK] + e + 4);
      u32x4 o = {pk2(a[0], a[1]), pk2(a[2], a[3]), pk2(b[0], b[1]), pk2(b[2], b[3])};
      *(u32x4*)((bf16_t*)(ws + WS_MEMK) + ((size_t)(l * 17 + 1) * 131072) + rem) = o;
    }
  }
  {
    const int gw = blockIdx.x * 8 + wid, nw = gridDim.x * 8;
    const float* ng = p.in[I_NG];
    for (int r = gw; r < TT; r += nw) {
      const float* xrow = r < TP ? p.in[I_XP] + (size_t)r * 1024 : p.in[I_XS] + (size_t)(r - TP) * 1024;
      f32x4 v[4];
      const float rstd = row_load_rstd(xrow, v, lane);
      float gacc[8];
#pragma unroll
      for (int c = 0; c < 8; ++c) gacc[c] = 0.f;
      bf16_t* xn = (bf16_t*)(ws + WS_XN) + (size_t)r * 1024;
#pragma unroll
      for (int j = 0; j < 4; ++j) {
        const int k0 = 4 * lane + 256 * j;
        const f32x4 xs = v[j] * rstd;
        u32x2 o = {pk2(xs[0], xs[1]), pk2(xs[2], xs[3])};
        *(u32x2*)(xn + k0) = o;
        const f32x4 g = *(const f32x4*)(ng + k0);
#pragma unroll
        for (int e = 0; e < 4; ++e) {
          const float xg = xs[e] * g[e];
          const float* wr = p.in[I_WINA] + (size_t)(k0 + e) * 6152 + 5120;
          const f32x4 w0 = *(const f32x4*)wr, w1 = *(const f32x4*)(wr + 4);
          gacc[0] += xg * w0[0]; gacc[1] += xg * w0[1]; gacc[2] += xg * w0[2]; gacc[3] += xg * w0[3];
          gacc[4] += xg * w1[0]; gacc[5] += xg * w1[1]; gacc[6] += xg * w1[2]; gacc[7] += xg * w1[3];
        }
      }
#pragma unroll
      for (int c = 0; c < 8; ++c) gacc[c] = wave_sum(gacc[c]);
      if (lane < 8) {
        float gv = gacc[0];
#pragma unroll
        for (int c = 1; c < 8; ++c) gv = lane == c ? gacc[c] : gv;
        gv += p.in[I_BGA][lane];
        if (lane >= 4) gv = fminf(gv, 0.f) - log1pf(__expf(-fabsf(gv)));
        ((float*)(ws + WS_GATE))[(size_t)r * 8 + lane] = gv;
      }
    }
    for (int r = gw; r < 512; r += nw) {
      const int l = r >> 8, rr = r & 255;
      f32x4 v[4];
      const float rstd = row_load_rstd(p.in[I_MEMP] + (size_t)rr * 1024, v, lane);
      bf16_t* o = (bf16_t*)(ws + WS_MEMN) + (size_t)r * 1024;
#pragma unroll
      for (int j = 0; j < 4; ++j) {
        const int k0 = 4 * lane + 256 * j;
        const f32x4 g = *(const f32x4*)(p.in[I_MNG] + l * 1024 + k0);
        const f32x4 xs = v[j] * rstd * g;
        u32x2 ov = {pk2(xs[0], xs[1]), pk2(xs[2], xs[3])};
        *(u32x2*)(o + k0) = ov;
      }
    }
  }
}

constexpr int G_ROWB = 144, G_BUF = (256 + 128) * G_ROWB;
struct GemmAcc { f32x16 a[2][2]; };

DI void gemm_tile(const bf16_t* __restrict__ A, size_t lda, const bf16_t* __restrict__ Bt, size_t ldb, int K, unsigned char* lds, GemmAcc& acc, int tid) {
  const int lane = tid & 63, wid = tid >> 6, r = lane & 31, h = lane >> 5;
  const int wr = wid >> 1, wc = wid & 1;
#pragma unroll
  for (int a = 0; a < 2; ++a)
#pragma unroll
    for (int b = 0; b < 2; ++b) acc.a[a][b] = zero16();
  u32x4 ra[4], rb[2];
  const int nk = K / 64;
  auto gload = [&](int kt) {
#pragma unroll
    for (int e = 0; e < 4; ++e) { const int id = tid + 512 * e, row = id >> 3, c = id & 7; ra[e] = *(const u32x4*)(A + (size_t)row * lda + kt * 64 + 8 * c); }
#pragma unroll
    for (int e = 0; e < 2; ++e) { const int id = tid + 512 * e, row = id >> 3, c = id & 7; rb[e] = *(const u32x4*)(Bt + (size_t)row * ldb + kt * 64 + 8 * c); }
  };
  auto lstore = [&](int buf) {
    unsigned char* base = lds + buf * G_BUF;
#pragma unroll
    for (int e = 0; e < 4; ++e) { const int id = tid + 512 * e, row = id >> 3, c = id & 7; *(u32x4*)(base + row * G_ROWB + 16 * c) = ra[e]; }
#pragma unroll
    for (int e = 0; e < 2; ++e) { const int id = tid + 512 * e, row = id >> 3, c = id & 7; *(u32x4*)(base + (256 + row) * G_ROWB + 16 * c) = rb[e]; }
  };
  gload(0);
  __syncthreads();
  lstore(0);
  __syncthreads();
  for (int kt = 0; kt < nk; ++kt) {
    if (kt + 1 < nk) gload(kt + 1);
    const unsigned char* base = lds + (kt & 1) * G_BUF;
    const unsigned char* pa = base + (wr * 64 + r) * G_ROWB + 16 * h;
    const unsigned char* pb = base + (256 + wc * 64 + r) * G_ROWB + 16 * h;
#pragma unroll
    for (int kk = 0; kk < 4; ++kk) {
      const bf16x8 a0 = ld16(pa + 32 * kk), a1 = ld16(pa + 32 * G_ROWB + 32 * kk);
      const bf16x8 b0 = ld16(pb + 32 * kk), b1 = ld16(pb + 32 * G_ROWB + 32 * kk);
      acc.a[0][0] = MFMA32(a0, b0, acc.a[0][0]);
      acc.a[0][1] = MFMA32(a0, b1, acc.a[0][1]);
      acc.a[1][0] = MFMA32(a1, b0, acc.a[1][0]);
      acc.a[1][1] = MFMA32(a1, b1, acc.a[1][1]);
    }
    if (kt + 1 < nk) lstore((kt + 1) & 1);
    __syncthreads();
  }
}

DI void gate_scan(const Params& p, unsigned char* lds) {
  const int tid = TIDX, lane = tid & 63, wid = tid >> 6;
  unsigned char* ws = p.ws;
  const float* gate = (const float*)(ws + WS_GATE);
  float* s_gl = (float*)lds;
  float* s_A = s_gl + NCH * 4;
  float* s_mc = s_A + NCH * 4;
  float* s_mn = s_mc + NCH * 4;
  __syncthreads();
  for (int pr = wid; pr < NCH * 4; pr += 8) {
    const int cc = pr >> 2, hd = pr & 3;
    const float ig = gate[(size_t)(cc * 64 + lane) * 8 + hd], lf = gate[(size_t)(cc * 64 + lane) * 8 + 4 + hd];
    float g = lf;
#pragma unroll
    for (int o = 1; o < 64; o <<= 1) { const float t = __shfl_up(g, o); if (lane >= o) g += t; }
    float a = ig - g;
#pragma unroll
    for (int o = 32; o >= 1; o >>= 1) a = fmaxf(a, __shfl_xor(a, o));
    const float gl = __shfl(g, 63);
    if (lane == 0) { s_gl[pr] = gl; s_A[pr] = a; }
  }
  __syncthreads();
  if (tid < 4) {
    float m = 0.f;
    float ld = 0.f;
    float* LD = (float*)(ws + WS_LD);
    for (int c = 0; c < 256; ++c) {
      s_mc[c * 4 + tid] = m; LD[c * 4 + tid] = ld;
      const float mn = s_gl[c * 4 + tid] + fmaxf(m, s_A[c * 4 + tid]);
      ld += s_gl[c * 4 + tid] + m - mn;
      m = mn; s_mn[c * 4 + tid] = m;
    }
    LD[256 * 4 + tid] = ld;
    p.out[O_PM + tid] = m;
  } else if (tid >= 64 && tid < 128) {
    const int b = (tid - 64) >> 2, hd = tid & 3, pr = (256 + b) * 4 + hd;
    const float m0 = p.in[I_SM][b * 4 + hd];
    const float m = s_gl[pr] + fmaxf(m0, s_A[pr]);
    s_mc[pr] = m0; s_mn[pr] = m;
    p.out[O_SM + b * 4 + hd] = m;
  }
  __syncthreads();
  for (int pr = wid; pr < NCH * 4; pr += 8) {
    const int cc = pr >> 2, hd = pr & 3;
    const float ig = gate[(size_t)(cc * 64 + lane) * 8 + hd], lf = gate[(size_t)(cc * 64 + lane) * 8 + 4 + hd];
    float g = lf;
#pragma unroll
    for (int o = 1; o < 64; o <<= 1) { const float t = __shfl_up(g, o); if (lane >= o) g += t; }
    const float a = ig - g;
    float pm = a;
#pragma unroll
    for (int o = 1; o < 64; o <<= 1) { const float t = __shfl_up(pm, o); if (lane >= o) pm = fmaxf(pm, t); }
    const float mc = s_mc[pr], mn = s_mn[pr], gl = s_gl[pr];
    const float mt = g + fmaxf(mc, pm);
    const size_t o = (size_t)pr * 64 + lane;
    ((float*)(ws + WS_GC))[o] = g;
    ((float*)(ws + WS_MT))[o] = mt;
    ((float*)(ws + WS_WS))[o] = __expf(gl - g + ig - mn);
    ((float*)(ws + WS_WI))[o] = __expf(g + mc - mt);
    ((float*)(ws + WS_AS))[o] = (ig - g) * LOG2E;
    ((float*)(ws + WS_BT))[o] = (g - mt) * LOG2E;
    if (lane == 0) ((float*)(ws + WS_DEC))[pr] = __expf(gl + mc - mn);
  }
  __syncthreads();
}

DI void phase1(const Params& p, unsigned char* lds) {
  const int tid = TIDX, lane = tid & 63, wid = tid >> 6, r = lane & 31, h = lane >> 5, wr = wid >> 1, wc = wid & 1;
  unsigned char* ws = p.ws;
  if (blockIdx.x == gridDim.x - 1) gate_scan(p, lds);
  const int n_main = 68 * 48, n_mem = 16;
  for (int t = blockIdx.x; t < n_main + n_mem; t += gridDim.x) {
    GemmAcc acc;
    if (t < n_main) {
      const int tm = t / 48, tn = t % 48, m0 = tm * 256, n0 = tn * 128;
      gemm_tile((const bf16_t*)(ws + WS_XN) + (size_t)m0 * 1024, 1024, (const bf16_t*)(ws + WS_WA) + (size_t)n0 * 1024, 1024, 1024, lds, acc, tid);
      bf16_t* PA = (bf16_t*)(ws + WS_R1);
      const int sec = n0 >> 10;
#pragma unroll
      for (int a = 0; a < 2; ++a)
#pragma unroll
        for (int b = 0; b < 2; ++b) {
          __builtin_amdgcn_sched_barrier(0);
          const int n = n0 + wc * 64 + 32 * b + r, mb = m0 + wr * 64 + 32 * a;
          if (sec != 2) {
            const float sc = sec == 1 ? 0.0625f : 1.f;
#pragma unroll
            for (int i = 0; i < 16; ++i) PA[(size_t)(mb + crow(i, h)) * 6144 + n] = f2bf(acc.a[a][b][i] * sc);
          }
          if (sec == 1 || sec == 2) {
            const float sc = sec == 1 ? 0.0625f : 1.f;
            const int f = n & 1023, hd = f >> 8, fe = f & 255;
            bf16_t* T = (bf16_t*)(ws + (sec == 1 ? WS_KT : WS_VTA));
#pragma unroll
            for (int g = 0; g < 4; ++g) {
              const int m = mb + 8 * g + 4 * h, cc = m >> 6, s = m & 63;
              u32x2 o = {pk2(acc.a[a][b][4 * g] * sc, acc.a[a][b][4 * g + 1] * sc), pk2(acc.a[a][b][4 * g + 2] * sc, acc.a[a][b][4 * g + 3] * sc)};
              *(u32x2*)(T + (((size_t)cc * 4 + hd) * 256 + fe) * 64 + s) = o;
            }
          }
        }
    } else {
      const int tt = t - n_main, l = tt >> 3, n0 = (tt & 7) * 128;
      gemm_tile((const bf16_t*)(ws + WS_MEMN) + (size_t)l * 256 * 1024, 1024, (const bf16_t*)(ws + WS_WM) + ((size_t)l * 1024 + n0) * 1024, 1024, 1024, lds, acc, tid);
      const bool isv = n0 >= 512;
      float* of = p.out + (isv ? O_PMV : O_PMK) + (size_t)l * 131072;
      bf16_t* mk = (bf16_t*)(ws + WS_MEMK) + (size_t)(l * 17) * 131072;
      bf16_t* mv = (bf16_t*)(ws + WS_MEMVT) + (size_t)(l * 17) * 131072;
#pragma unroll
      for (int a = 0; a < 2; ++a)
#pragma unroll
        for (int b = 0; b < 2; ++b) {
          __builtin_amdgcn_sched_barrier(0);
          const int f = (n0 & 511) + wc * 64 + 32 * b + r, mb = wr * 64 + 32 * a;
#pragma unroll
          for (int g = 0; g < 4; ++g) {
            const int m = mb + 8 * g + 4 * h;
            float* o4 = of + (size_t)m * 512 + f;
            o4[0] = acc.a[a][b][4 * g]; o4[512] = acc.a[a][b][4 * g + 1]; o4[1024] = acc.a[a][b][4 * g + 2]; o4[1536] = acc.a[a][b][4 * g + 3];
            if (!isv) {
              bf16_t* k4 = mk + (size_t)m * 512 + f;
              k4[0] = f2bf(acc.a[a][b][4 * g]); k4[512] = f2bf(acc.a[a][b][4 * g + 1]); k4[1024] = f2bf(acc.a[a][b][4 * g + 2]); k4[1536] = f2bf(acc.a[a][b][4 * g + 3]);
            } else {
              u32x2 o = {pk2(acc.a[a][b][4 * g], acc.a[a][b][4 * g + 1]), pk2(acc.a[a][b][4 * g + 2], acc.a[a][b][4 * g + 3])};
              *(u32x2*)(mv + (size_t)f * 256 + m) = o;
            }
          }
        }
    }
  }
}

DI void scan_task(const Params& p, unsigned char* lds, int sb  , int hd, int j, int grp) {
  const int tid = TIDX, lane = tid & 63, wid = tid >> 6, r = lane & 31, h = lane >> 5;
  unsigned char* ws = p.ws;
  const int cc0 = sb < 0 ? GRP * grp : 256 + sb, nch = sb < 0 ? GRP : 1;
  const bf16_t* PA = (const bf16_t*)(ws + WS_R1);
  const bf16_t* KT = (const bf16_t*)(ws + WS_KT);
  const bf16_t* VT = (const bf16_t*)(ws + WS_VTA);
  const float* WSa = (const float*)(ws + WS_WS);
  const float* WIa = (const float*)(ws + WS_WI);
  const float* DEC = (const float*)(ws + WS_DEC);
  float* red = (float*)lds;
  const bool nsl = j == 8;
  f32x16 S = zero16();
  if (sb >= 0) {
    if (!nsl) {
      const float* C0 = p.in[I_SC] + ((size_t)(sb * 4 + hd) * 256 + 32 * j + r) * 256 + 32 * wid;
#pragma unroll
      for (int g = 0; g < 4; ++g) { const f32x4 c = *(const f32x4*)(C0 + 8 * g + 4 * h); S[4 * g] = c[0]; S[4 * g + 1] = c[1]; S[4 * g + 2] = c[2]; S[4 * g + 3] = c[3]; }
    } else if (r == 0) {
      const float* n0 = p.in[I_SN] + (size_t)(sb * 4 + hd) * 256 + 32 * wid;
#pragma unroll
      for (int g = 0; g < 4; ++g) { const f32x4 c = *(const f32x4*)(n0 + 8 * g + 4 * h); S[4 * g] = c[0]; S[4 * g + 1] = c[1]; S[4 * g + 2] = c[2]; S[4 * g + 3] = c[3]; }
    }
  }
  bf16x8 kt[4], wv[4], qf[2][2];
  auto loadc = [&](int cc) {
    const size_t ch = (size_t)cc * 4 + hd;
    const bf16_t* kp = KT + (ch * 256 + 32 * wid + r) * 64 + 8 * h;
#pragma unroll
    for (int st = 0; st < 4; ++st) kt[st] = ld16(kp + 16 * st);
    const float* wsp = WSa + ch * 64 + 8 * h;
    if (!nsl) {
      const bf16_t* vp = VT + (ch * 256 + 32 * j + r) * 64 + 8 * h;
#pragma unroll
      for (int st = 0; st < 4; ++st) {
        const u32x4 v = *(const u32x4*)(vp + 16 * st);
        const f32x4 w0 = *(const f32x4*)(wsp + 16 * st), w1 = *(const f32x4*)(wsp + 16 * st + 4);
        u32x4 o;
        o[0] = pk2(bflo(v[0]) * w0[0], bfhi(v[0]) * w0[1]); o[1] = pk2(bflo(v[1]) * w0[2], bfhi(v[1]) * w0[3]);
        o[2] = pk2(bflo(v[2]) * w1[0], bfhi(v[2]) * w1[1]); o[3] = pk2(bflo(v[3]) * w1[2], bfhi(v[3]) * w1[3]);
        wv[st] = __builtin_bit_cast(bf16x8, o);
      }
    } else {
#pragma unroll
      for (int st = 0; st < 4; ++st) {
        const f32x4 w0 = *(const f32x4*)(wsp + 16 * st), w1 = *(const f32x4*)(wsp + 16 * st + 4);
        u32x4 o = {pk2(w0[0], w0[1]), pk2(w0[2], w0[3]), pk2(w1[0], w1[1]), pk2(w1[2], w1[3])};
        if (r != 0) o = (u32x4){0u, 0u, 0u, 0u};
        wv[st] = __builtin_bit_cast(bf16x8, o);
      }
    }
#pragma unroll
    for (int tt = 0; tt < 2; ++tt) {
      const bf16_t* qp = PA + (size_t)(cc * 64 + 32 * tt + r) * 6144 + hd * 256 + 32 * wid + 4 * h;
#pragma unroll
      for (int s2 = 0; s2 < 2; ++s2) qf[tt][s2] = ld8x2(qp + 16 * s2, qp + 16 * s2 + 8);
    }
  };
  for (int c = 0; c < nch; ++c) {
    const int cc = cc0 + c;
    loadc(cc);
    const float dec = DEC[cc * 4 + hd];
    const bf16x8 xs0 = pack_acc(S, 0), xs1 = pack_acc(S, 1);
    f32x16 z0 = MFMA32(xs0, qf[0][0], zero16()); z0 = MFMA32(xs1, qf[0][1], z0);
    f32x16 z1 = MFMA32(xs0, qf[1][0], zero16()); z1 = MFMA32(xs1, qf[1][1], z1);
    S = S * dec;
#pragma unroll
    for (int st = 0; st < 4; ++st) S = MFMA32(kt[st], wv[st], S);
    __syncthreads();
    {
      float* rw = red + wid * (64 * 33);
#pragma unroll
      for (int i = 0; i < 16; ++i) { rw[r * 33 + crow(i, h)] = z0[i]; rw[(32 + r) * 33 + crow(i, h)] = z1[i]; }
    }
    __syncthreads();
    {
      const int v = tid & 31;
#pragma unroll
      for (int e = 0; e < 4; ++e) {
        const int t = (tid >> 5) + 16 * e;
        float s = 0.f;
#pragma unroll
        for (int w8 = 0; w8 < 8; ++w8) s += red[w8 * (64 * 33) + t * 33 + v];
        const float wi = WIa[((size_t)cc * 4 + hd) * 64 + t];
        if (!nsl) ((float*)(ws + WS_HINTER))[(size_t)(cc * 64 + t) * 1024 + hd * 256 + 32 * j + v] = s * wi;
        else if (v == 0) ((float*)(ws + WS_DENI))[(size_t)(cc * 64 + t) * 4 + hd] = s * wi;
      }
    }
  }
  if (sb < 0) {
    float* cl = (float*)(ws + WS_CLOC) + ((((size_t)(grp * 4 + hd) * 9 + j) * 8 + wid) * 64 + lane) * 16;
#pragma unroll
    for (int g = 0; g < 4; ++g) { f32x4 c = {S[4 * g], S[4 * g + 1], S[4 * g + 2], S[4 * g + 3]}; *(f32x4*)(cl + 4 * g) = c; }
  } else {
    if (!nsl) {
      float* Co = (sb < 0 ? p.out + O_PC + (size_t)hd * 65536 : p.out + O_SC + (size_t)(sb * 4 + hd) * 65536) + (size_t)(32 * j + r) * 256 + 32 * wid;
#pragma unroll
      for (int g = 0; g < 4; ++g) { f32x4 c = {S[4 * g], S[4 * g + 1], S[4 * g + 2], S[4 * g + 3]}; *(f32x4*)(Co + 8 * g + 4 * h) = c; }
    } else if (r == 0) {
      float* no = (sb < 0 ? p.out + O_PN + (size_t)hd * 256 : p.out + O_SN + (size_t)(sb * 4 + hd) * 256) + 32 * wid;
#pragma unroll
      for (int g = 0; g < 4; ++g) { f32x4 c = {S[4 * g], S[4 * g + 1], S[4 * g + 2], S[4 * g + 3]}; *(f32x4*)(no + 8 * g + 4 * h) = c; }
    }
  }
  __syncthreads();
}

DI void intra_task(const Params& p, int cc, int hd) {
  const int tid = TIDX, lane = tid & 63, wid = tid >> 6, r = lane & 31, h = lane >> 5;
  unsigned char* ws = p.ws;
  const int tt = wid & 1, vq = wid >> 1;
  const bf16_t* PA = (const bf16_t*)(ws + WS_R1);
  const bf16_t* VT = (const bf16_t*)(ws + WS_VTA);
  const size_t ch = (size_t)cc * 4 + hd;
  f32x16 s0 = zero16(), s1 = zero16();
  {
    const bf16_t* qp = PA + (size_t)(cc * 64 + 32 * tt + r) * 6144 + hd * 256 + 8 * h;
    const bf16_t* kp = PA + (size_t)(cc * 64 + r) * 6144 + 1024 + hd * 256 + 8 * h;
#pragma unroll 4
    for (int kk = 0; kk < 16; ++kk) {
      const bf16x8 q = ld16(qp + 16 * kk), k0 = ld16(kp + 16 * kk), k1 = ld16(kp + (size_t)32 * 6144 + 16 * kk);
      s0 = MFMA32(k0, q, s0);
      if (tt == 1) s1 = MFMA32(k1, q, s1);
    }
  }
  const int t = 32 * tt + r;
  const float bt = ((const float*)(ws + WS_BT))[ch * 64 + t];
  const float* asp = (const float*)(ws + WS_AS) + ch * 64;
  float den = 0.f;
#pragma unroll
  for (int g = 0; g < 4; ++g) {
    const f32x4 a0 = *(const f32x4*)(asp + 8 * g + 4 * h);
    const f32x4 a1 = *(const f32x4*)(asp + 32 + 8 * g + 4 * h);
#pragma unroll
    for (int e = 0; e < 4; ++e) {
      const int s = 8 * g + 4 * h + e;
      const float w0 = s <= t ? fexp2(bt + a0[e]) : 0.f;
      const float w1 = (32 + s) <= t ? fexp2(bt + a1[e]) : 0.f;
      s0[4 * g + e] *= w0; s1[4 * g + e] *= w1;
      den += s0[4 * g + e] + s1[4 * g + e];
    }
  }
  den += __shfl_xor(den, 32);
  if (vq == 0 && h == 0) ((float*)(ws + WS_DENA))[(size_t)(cc * 64 + t) * 4 + hd] = den;
  bf16x8 pf[2][2];
  pf[0][0] = pack_acc(s0, 0); pf[0][1] = pack_acc(s0, 1); pf[1][0] = pack_acc(s1, 0); pf[1][1] = pack_acc(s1, 1);
  float* Ho = (float*)(ws + WS_HINTRA) + (size_t)(cc * 64 + t) * 1024 + hd * 256;
#pragma unroll
  for (int vt = 0; vt < 2; ++vt) {
    const int v0 = vq * 64 + vt * 32;
    const bf16_t* vp = VT + (ch * 256 + v0 + r) * 64 + 4 * h;
    f32x16 o = zero16();
#pragma unroll
    for (int st = 0; st < 2; ++st)
#pragma unroll
      for (int s2 = 0; s2 < 2; ++s2) {
        const bf16x8 a = ld8x2(vp + 32 * st + 16 * s2, vp + 32 * st + 16 * s2 + 8);
        o = MFMA32(a, pf[st][s2], o);
      }
#pragma unroll
    for (int g = 0; g < 4; ++g) { f32x4 c = {o[4 * g], o[4 * g + 1], o[4 * g + 2], o[4 * g + 3]}; *(f32x4*)(Ho + v0 + 8 * g + 4 * h) = c; }
  }
}

DI void memattn_task(const Params& p, int tile, int layer, const bf16_t* Qb, const bf16_t* Zb, size_t ldq) {
  const int tid = TIDX, lane = tid & 63, wid = tid >> 6, r = lane & 31, h = lane >> 5;
  unsigned char* ws = p.ws;
  const int hd = wid >> 1, tok = tile * 64 + 32 * (wid & 1) + r;
  const int sbi = tile < 256 ? 0 : 1 + (tile - 256);
  const bf16_t* MK = (const bf16_t*)(ws + WS_MEMK) + (size_t)(layer * 17 + sbi) * 131072 + hd * 128;
  const bf16_t* MV = (const bf16_t*)(ws + WS_MEMVT) + ((size_t)(layer * 17 + sbi) * 4 + hd) * 128 * 256;
  bf16x8 qf[8];
  {
    const bf16_t* qp = Qb + (size_t)tok * ldq + hd * 128 + 8 * h;
#pragma unroll
    for (int kk = 0; kk < 8; ++kk) qf[kk] = ld16(qp + 16 * kk);
  }
  const float sc = 0.08838834764831845f * LOG2E;
  f32x16 O[4];
#pragma unroll
  for (int vt = 0; vt < 4; ++vt) O[vt] = zero16();
  float mrun = -1e30f, l = 0.f;
#pragma unroll 1
  for (int kb = 0; kb < 4; ++kb) {
    f32x16 s0 = zero16(), s1 = zero16();
    const bf16_t* kp = MK + (size_t)(kb * 64 + r) * 512 + 8 * h;
#pragma unroll
    for (int kk = 0; kk < 8; ++kk) {
      const bf16x8 k0 = ld16(kp + 16 * kk), k1 = ld16(kp + (size_t)32 * 512 + 16 * kk);
      s0 = MFMA32(k0, qf[kk], s0); s1 = MFMA32(k1, qf[kk], s1);
    }
    float mx = -1e30f;
#pragma unroll
    for (int i = 0; i < 16; ++i) mx = fmaxf(mx, fmaxf(s0[i], s1[i]));
    mx = fmaxf(mx, __shfl_xor(mx, 32)) * sc;
    const float mnew = fmaxf(mrun, mx), alpha = fexp2(mrun - mnew);
    mrun = mnew;
    float sum = 0.f;
#pragma unroll
    for (int i = 0; i < 16; ++i) { s0[i] = fexp2(s0[i] * sc - mnew); s1[i] = fexp2(s1[i] * sc - mnew); sum += s0[i] + s1[i]; }
    l = l * alpha + sum;
#pragma unroll
    for (int vt = 0; vt < 4; ++vt) O[vt] = O[vt] * alpha;
    bf16x8 pf[2][2];
    pf[0][0] = pack_acc(s0, 0); pf[0][1] = pack_acc(s0, 1); pf[1][0] = pack_acc(s1, 0); pf[1][1] = pack_acc(s1, 1);
#pragma unroll
    for (int vt = 0; vt < 4; ++vt) {
      const bf16_t* vp = MV + (size_t)(32 * vt + r) * 256 + kb * 64 + 4 * h;
#pragma unroll
      for (int st = 0; st < 2; ++st)
#pragma unroll
        for (int s2 = 0; s2 < 2; ++s2) {
          const bf16x8 a = ld8x2(vp + 32 * st + 16 * s2, vp + 32 * st + 16 * s2 + 8);
          O[vt] = MFMA32(a, pf[st][s2], O[vt]);
        }
    }
  }
  l += __shfl_xor(l, 32);
  const float inv = 1.f / l;
  const bf16_t* zp = Zb + (size_t)tok * ldq + hd * 128;
  bf16_t* op = (bf16_t*)(ws + WS_AO) + (size_t)tok * 1536 + 1024 + hd * 128;
#pragma unroll
  for (int vt = 0; vt < 4; ++vt)
#pragma unroll
    for (int g = 0; g < 4; ++g) {
      const int v = 32 * vt + 8 * g + 4 * h;
      const u32x2 z = *(const u32x2*)(zp + v);
      const float o0 = O[vt][4 * g] * inv * siluf_(bflo(z[0])), o1 = O[vt][4 * g + 1] * inv * siluf_(bfhi(z[0]));
      const float o2 = O[vt][4 * g + 2] * inv * siluf_(bflo(z[1])), o3 = O[vt][4 * g + 3] * inv * siluf_(bfhi(z[1]));
      u32x2 o = {pk2(o0, o1), pk2(o2, o3)};
      *(u32x2*)(op + v) = o;
    }
}

DI int next_item(unsigned* ctr, unsigned char* lds_flag_area, int tid) {
  __syncthreads();
  int* sh = (int*)lds_flag_area;
  if (tid == 0) *sh = (int)atomicAdd(ctr, 1u);
  __syncthreads();
  const int v = *sh;
  return v;
}

DI void phase2(const Params& p, unsigned char* lds) {
  unsigned* ctr = (unsigned*)(p.ws + WS_CTR) + 0 + 8 * p.pad;
  const bf16_t* PA = (const bf16_t*)(p.ws + WS_R1);
  const int n_ps = 36 * 16, n_ss = 576, n_in = NCH * 4, n_ma = NCH;
  for (;;) {
    const int it = next_item(ctr, lds + LDS_BYTES - 16, TIDX);
    if (it >= n_ps + n_ss + n_in + n_ma) break;
    if (it < n_ps) scan_task(p, lds, -1, (it % 36) / 9, it % 9, it / 36);
    else if (it < n_ps + n_ss) { const int q = it - n_ps; scan_task(p, lds, q / 36, (q % 36) / 9, q % 9, 0); }
    else if (it < n_ps + n_ss + n_in) { const int q = it - n_ps - n_ss; intra_task(p, q >> 2, q & 3); }
    else { const int q = it - n_ps - n_ss - n_in; memattn_task(p, q, 0, PA + 5120, PA + 5632, 6144); }
  }
}


DI void scanfix_task(const Params& p, unsigned char* lds, int grp, int hd, int j) {
  const int tid = TIDX, lane = tid & 63, wid = tid >> 6, r = lane & 31, h = lane >> 5;
  unsigned char* ws = p.ws;
  const bool nsl = j == 8;
  const float* LD = (const float*)(ws + WS_LD);
  f32x16 S = zero16();
  for (int gp = 0; gp < grp; ++gp) {
    const float dg = __expf(LD[(GRP * (gp + 1)) * 4 + hd] - LD[(GRP * gp) * 4 + hd]);
    const float* cl = (const float*)(ws + WS_CLOC) + ((((size_t)(gp * 4 + hd) * 9 + j) * 8 + wid) * 64 + lane) * 16;
#pragma unroll
    for (int g = 0; g < 4; ++g) { const f32x4 c = *(const f32x4*)(cl + 4 * g);
      S[4 * g] = S[4 * g] * dg + c[0]; S[4 * g + 1] = S[4 * g + 1] * dg + c[1]; S[4 * g + 2] = S[4 * g + 2] * dg + c[2]; S[4 * g + 3] = S[4 * g + 3] * dg + c[3]; }
  }
  if (grp == 16) {
    if (!nsl) {
      float* Co = p.out + O_PC + (size_t)hd * 65536 + (size_t)(32 * j + r) * 256 + 32 * wid;
#pragma unroll
      for (int g = 0; g < 4; ++g) { f32x4 c = {S[4 * g], S[4 * g + 1], S[4 * g + 2], S[4 * g + 3]}; *(f32x4*)(Co + 8 * g + 4 * h) = c; }
    } else if (r == 0) {
      float* no = p.out + O_PN + (size_t)hd * 256 + 32 * wid;
#pragma unroll
      for (int g = 0; g < 4; ++g) { f32x4 c = {S[4 * g], S[4 * g + 1], S[4 * g + 2], S[4 * g + 3]}; *(f32x4*)(no + 8 * g + 4 * h) = c; }
    }
    return;
  }
  u32x4* fr = (u32x4*)lds;
  float* tp = (float*)(lds + 16384) + wid * (64 * 33);
  __syncthreads();
  fr[(wid * 2 + 0) * 64 + lane] = __builtin_bit_cast(u32x4, pack_acc(S, 0));
  fr[(wid * 2 + 1) * 64 + lane] = __builtin_bit_cast(u32x4, pack_acc(S, 1));
  __syncthreads();
  bf16x8 xf[8][2];
#pragma unroll
  for (int kt = 0; kt < 8; ++kt) { xf[kt][0] = __builtin_bit_cast(bf16x8, fr[(kt * 2 + 0) * 64 + lane]); xf[kt][1] = __builtin_bit_cast(bf16x8, fr[(kt * 2 + 1) * 64 + lane]); }
  const bf16_t* PA = (const bf16_t*)(ws + WS_R1);
  const float* WIa = (const float*)(ws + WS_WI);
#pragma unroll 1
  for (int ci = 0; ci < 2; ++ci) {
    const int cc = GRP * grp + wid + 8 * ci;
    const float D = __expf(LD[cc * 4 + hd] - LD[(GRP * grp) * 4 + hd]);
#pragma unroll
    for (int tt = 0; tt < 2; ++tt) {
      const bf16_t* qp = PA + (size_t)(cc * 64 + 32 * tt + r) * 6144 + hd * 256 + 4 * h;
      f32x16 z = zero16();
#pragma unroll
      for (int kt = 0; kt < 8; ++kt)
#pragma unroll
        for (int s2 = 0; s2 < 2; ++s2) {
          const bf16x8 q = ld8x2(qp + 32 * kt + 16 * s2, qp + 32 * kt + 16 * s2 + 8);
          z = MFMA32(xf[kt][s2], q, z);
        }
#pragma unroll
      for (int i = 0; i < 16; ++i) tp[(32 * tt + r) * 33 + crow(i, h)] = z[i];
    }
    const int v = lane & 31;
#pragma unroll 4
    for (int e = 0; e < 32; ++e) {
      const int t = 2 * e + (lane >> 5);
      const float val = tp[t * 33 + v] * (WIa[((size_t)cc * 4 + hd) * 64 + t] * D);
      if (!nsl) { float* d = (float*)(ws + WS_HINTER) + (size_t)(cc * 64 + t) * 1024 + hd * 256 + 32 * j + v; *d += val; }
      else if (v == 0) { float* d = (float*)(ws + WS_DENI) + (size_t)(cc * 64 + t) * 4 + hd; *d += val; }
    }
  }
}

DI void phase2c(const Params& p, unsigned char* lds) {
  unsigned* ctr = (unsigned*)(p.ws + WS_CTR) + 3 + 8 * p.pad;
  for (;;) {
    const int it = next_item(ctr, lds + LDS_BYTES - 16, TIDX);
    if (it >= 16 * 36) break;
    const int g = 16 - it / 36;
    scanfix_task(p, lds, g, (it % 36) / 9, it % 9);
  }
}

DI void phase3(const Params& p) {
  const int tid = TIDX, lane = tid & 63, wid = tid >> 6;
  unsigned char* ws = p.ws;
  const int gw = blockIdx.x * 8 + wid, nw = gridDim.x * 8;
  const bf16_t* PA = (const bf16_t*)(ws + WS_R1);
  for (int it = gw; it < TT * 4; it += nw) {
    const int tok = it >> 2, hd = it & 3, cc = tok >> 6, t = tok & 63;
    const size_t off = (size_t)tok * 1024 + hd * 256 + 4 * lane;
    const f32x4 a = *(const f32x4*)((const float*)(ws + WS_HINTER) + off), b = *(const f32x4*)((const float*)(ws + WS_HINTRA) + off);
    const float den = ((const float*)(ws + WS_DENI))[tok * 4 + hd] + ((const float*)(ws + WS_DENA))[tok * 4 + hd];
    const float mt = ((const float*)(ws + WS_MT))[((size_t)cc * 4 + hd) * 64 + t];
    const float dn = 1.f / fmaxf(fabsf(den), __expf(-mt));
    const u32x2 ou = *(const u32x2*)(PA + (size_t)tok * 6144 + 3072 + hd * 256 + 4 * lane);
    const u32x2 zu = *(const u32x2*)(PA + (size_t)tok * 6144 + 4096 + hd * 256 + 4 * lane);
    f32x4 hv = (a + b) * dn;
    hv[0] *= sigmoidf_(bflo(ou[0])); hv[1] *= sigmoidf_(bfhi(ou[0])); hv[2] *= sigmoidf_(bflo(ou[1])); hv[3] *= sigmoidf_(bfhi(ou[1]));
    float ss = hv[0] * hv[0] + hv[1] * hv[1] + hv[2] * hv[2] + hv[3] * hv[3];
    ss = wave_sum(ss);
    const float rstd = __builtin_amdgcn_rsqf(ss * (1.f / 256.f) + EPS);
    const f32x4 hg = *(const f32x4*)(p.in[I_HGA] + hd * 256 + 4 * lane);
    hv = hv * rstd * hg;
    hv[0] *= siluf_(bflo(zu[0])); hv[1] *= siluf_(bfhi(zu[0])); hv[2] *= siluf_(bflo(zu[1])); hv[3] *= siluf_(bfhi(zu[1]));
    u32x2 o = {pk2(hv[0], hv[1]), pk2(hv[2], hv[3])};
    *(u32x2*)((bf16_t*)(ws + WS_AO) + (size_t)tok * 1536 + hd * 256 + 4 * lane) = o;
  }
}

DI void phase_outproj(const Params& p, unsigned char* lds, int layer) {
  const int tid = TIDX, lane = tid & 63, wid = tid >> 6, r = lane & 31, h = lane >> 5, wr = wid >> 1, wc = wid & 1;
  unsigned char* ws = p.ws;
  const bf16_t* W = (const bf16_t*)(ws + (layer == 0 ? WS_WOA : WS_WOB));
  for (int t = blockIdx.x; t < 68 * 8; t += gridDim.x) {
    const int tm = t >> 3, tn = t & 7, m0 = tm * 256, n0 = tn * 128;
    GemmAcc acc;
    gemm_tile((const bf16_t*)(ws + WS_AO) + (size_t)m0 * 1536, 1536, W + (size_t)n0 * 1536, 1536, 1536, lds, acc, tid);
#pragma unroll
    for (int a = 0; a < 2; ++a)
#pragma unroll
      for (int b = 0; b < 2; ++b) {
        const int n = n0 + wc * 64 + 32 * b + r, mb = m0 + wr * 64 + 32 * a;
#pragma unroll
        for (int i = 0; i < 16; ++i) {
          const int m = mb + crow(i, h);
          if (layer == 0) {
            const float xv = m < TP ? p.in[I_XP][(size_t)m * 1024 + n] : p.in[I_XS][(size_t)(m - TP) * 1024 + n];
            ((float*)(ws + WS_Y1))[(size_t)m * 1024 + n] = xv + acc.a[a][b][i];
          } else {
            p.out[O_Y + (size_t)m * 1024 + n] = ((const float*)(ws + WS_Y1))[(size_t)m * 1024 + n] + acc.a[a][b][i];
          }
        }
      }
  }
}

DI void phase5(const Params& p, unsigned char* lds) {
  const int tid = TIDX, lane = tid & 63, wid = tid >> 6;
  unsigned char* ws = p.ws;
  const int gw = blockIdx.x * 8 + wid, nw = gridDim.x * 8;
  for (int r = gw; r < TT; r += nw) {
    f32x4 v[4];
    const float rstd = row_load_rstd((const float*)(ws + WS_Y1) + (size_t)r * 1024, v, lane);
    bf16_t* xn = (bf16_t*)(ws + WS_XN) + (size_t)r * 1024;
#pragma unroll
    for (int j = 0; j < 4; ++j) { const f32x4 xs = v[j] * rstd; u32x2 o = {pk2(xs[0], xs[1]), pk2(xs[2], xs[3])}; *(u32x2*)(xn + 4 * lane + 256 * j) = o; }
  }
  {
    float* smax = (float*)lds;
    const int hm = (tid & 127) >> 3;
    for (int b = 0; b < 16; ++b) {
      __syncthreads();
      if (tid < 16) smax[tid] = 0.f;
      __syncthreads();
      float mx = 0.f;
      const size_t n8 = (size_t)PAST * 1024 / 8;
      const float* src = p.in[I_CK] + (size_t)b * PAST * 1024;
      bf16_t* dst = (bf16_t*)(ws + WS_KBS) + (size_t)b * SKV * 1024;
      for (size_t i = (size_t)blockIdx.x * NTHREADS + tid; i < n8; i += (size_t)gridDim.x * NTHREADS) {
        const size_t e = i * 8;
        const f32x4 a = *(const f32x4*)(src + e), c = *(const f32x4*)(src + e + 4);
        u32x4 o = {pk2(a[0], a[1]), pk2(a[2], a[3]), pk2(c[0], c[1]), pk2(c[2], c[3])};
        *(u32x4*)(dst + e) = o;
        float ss = a[0] * a[0] + a[1] * a[1] + a[2] * a[2] + a[3] * a[3] + c[0] * c[0] + c[1] * c[1] + c[2] * c[2] + c[3] * c[3];
        ss += __shfl_xor(ss, 1); ss += __shfl_xor(ss, 2); ss += __shfl_xor(ss, 4);
        mx = fmaxf(mx, ss);
      }
      if ((tid & 7) == 0) atomicMax((unsigned*)smax + hm, __float_as_uint(mx));
      __syncthreads();
      if (tid < 16) atomicMax((unsigned*)(ws + WS_KMAX) + (1 + b) * 16 + tid, __float_as_uint(sqrtf(smax[tid])));
    }
  }
  __syncthreads();
  for (int t = blockIdx.x; t < 128 * 128; t += gridDim.x) {
    const int jb = t >> 7, tile = t & 127, b = jb >> 3, hd = jb & 7;
    TJob j = {p.in[I_CV] + (size_t)b * PAST * 1024 + hd * 128, 1024, (bf16_t*)(ws + WS_VTS) + ((size_t)(b * 8 + hd) * 128) * SKV, SKV, nullptr, 64, 2};
    run_tjob_tile(j, tile, (float*)lds, tid);
  }
}

DI void phase6(const Params& p, unsigned char* lds) {
  const int tid = TIDX, lane = tid & 63, wid = tid >> 6, r = lane & 31, h = lane >> 5, wr = wid >> 1, wc = wid & 1;
  unsigned char* ws = p.ws;
  for (int t = blockIdx.x; t < 68 * 40; t += gridDim.x) {
    const int tm = t / 40, tn = t % 40, m0 = tm * 256, n0 = tn * 128;
    GemmAcc acc;
    gemm_tile((const bf16_t*)(ws + WS_XN) + (size_t)m0 * 1024, 1024, (const bf16_t*)(ws + WS_WKB) + (size_t)n0 * 1024, 1024, 1024, lds, acc, tid);
    const int sec = n0 >> 10;
    const bool samp = m0 >= TP;
#pragma unroll
    for (int a = 0; a < 2; ++a)
#pragma unroll
      for (int b = 0; b < 2; ++b) {
        const int n = n0 + wc * 64 + 32 * b + r, mb = m0 + wr * 64 + 32 * a;
        if (sec == 0) {
          const int f = n;
          if (b == 1) {
            float mx = 0.f;
#pragma unroll
            for (int i = 0; i < 16; ++i) {
              float ss = acc.a[a][0][i] * acc.a[a][0][i] + acc.a[a][1][i] * acc.a[a][1][i];
              ss += __shfl_xor(ss, 1); ss += __shfl_xor(ss, 2); ss += __shfl_xor(ss, 4); ss += __shfl_xor(ss, 8); ss += __shfl_xor(ss, 16);
              mx = fmaxf(mx, ss);
            }
            mx = fmaxf(mx, __shfl_xor(mx, 32));
            if (lane == 0) {
              const int strm = samp ? 1 + ((mb - TP) >> 6) : 0;
              atomicMax((unsigned*)(ws + WS_KMAX) + strm * 16 + ((n0 + wc * 64) >> 6), __float_as_uint(sqrtf(mx)));
            }
          }
#pragma unroll
          for (int i = 0; i < 16; ++i) {
            const int m = mb + crow(i, h);
            const float v = acc.a[a][b][i];
            if (!samp) { p.out[O_PK + (size_t)m * 1024 + f] = v; ((bf16_t*)(ws + WS_KBP))[(size_t)m * 1024 + f] = f2bf(v); }
            else { const int ms = m - TP, bb = ms >> 6, s = ms & 63; p.out[O_SK + (size_t)ms * 1024 + f] = v;
                   ((bf16_t*)(ws + WS_KBS))[((size_t)bb * SKV + PAST + s) * 1024 + f] = f2bf(v); }
          }
        } else if (sec == 1) {
          const int f = n - 1024, hd = f >> 7, vd = f & 127;
#pragma unroll
          for (int i = 0; i < 16; ++i) {
            const int m = mb + crow(i, h);
            if (!samp) p.out[O_PV + (size_t)m * 1024 + f] = acc.a[a][b][i]; else p.out[O_SV + (size_t)(m - TP) * 1024 + f] = acc.a[a][b][i];
          }
#pragma unroll
          for (int g = 0; g < 4; ++g) {
            const int m = mb + 8 * g + 4 * h;
            u32x2 o = {pk2(acc.a[a][b][4 * g], acc.a[a][b][4 * g + 1]), pk2(acc.a[a][b][4 * g + 2], acc.a[a][b][4 * g + 3])};
            if (!samp) *(u32x2*)((bf16_t*)(ws + WS_VTP) + ((size_t)hd * 128 + vd) * TP + m) = o;
            else { const int ms = m - TP, bb = ms >> 6, s = ms & 63; *(u32x2*)((bf16_t*)(ws + WS_VTS) + ((size_t)(bb * 8 + hd) * 128 + vd) * SKV + PAST + s) = o; }
          }
        } else {
          const float sc = sec == 2 ? 0.125f * LOG2E : 1.f;
          bf16_t* PB = (bf16_t*)(ws + WS_PB);
#pragma unroll
          for (int i = 0; i < 16; ++i) PB[(size_t)(mb + crow(i, h)) * 3072 + (n - 2048)] = f2bf(acc.a[a][b][i] * sc);
        }
      }
  }
}

constexpr int A_KROW = 272, A_VROW = 144, A_KB = 64 * A_KROW, A_BUF = A_KB + 128 * A_VROW, A_FLAGS = 2 * A_BUF;

DI void diffattn_task(const Params& p, unsigned char* lds, int sb  , int qt  , int hd, float lam) {
  const int tid = TIDX, lane = tid & 63, wid = __builtin_amdgcn_readfirstlane(tid >> 6), r = lane & 31, h = lane >> 5;
  unsigned char* ws = p.ws;
  const int cq = wid >> 2, sub = (wid >> 1) & 1, map = wid & 1;
  const int ncq = sb < 0 ? 2 : 1;
  const int base_chunk = sb < 0 ? 2 * qt : 64;
  const int tok0 = sb < 0 ? qt * 128 : TP + sb * 64;
  const bool wvalid = cq < ncq;
  const int qc = base_chunk + cq;
  const int tl = 32 * sub + r;
  const int tok = tok0 + 64 * (wvalid ? cq : 0) + tl;
  const bf16_t* Kb = sb < 0 ? (const bf16_t*)(ws + WS_KBP) + hd * 128 : (const bf16_t*)(ws + WS_KBS) + (size_t)sb * SKV * 1024 + hd * 128;
  const bf16_t* Vb = sb < 0 ? (const bf16_t*)(ws + WS_VTP) + (size_t)hd * 128 * TP : (const bf16_t*)(ws + WS_VTS) + (size_t)(sb * 8 + hd) * 128 * SKV;
  const size_t ldv = sb < 0 ? TP : SKV;
  const bf16_t* PB = (const bf16_t*)(ws + WS_PB);
  bf16x8 qf[4];
  float qn = 0.f;
  {
    const unsigned qo = (unsigned)tok * 3072u + hd * 128 + map * 64 + 8 * h;
#pragma unroll
    for (int kk = 0; kk < 4; ++kk) {
      const u32x4 u = *(const u32x4*)(PB + (qo + 16 * kk));
      qf[kk] = __builtin_bit_cast(bf16x8, u);
#pragma unroll
      for (int e = 0; e < 4; ++e) { const float a = bflo(u[e]), b = bfhi(u[e]); qn += a * a + b * b; }
    }
    qn += __shfl_xor(qn, 32);
    qn = sqrtf(qn);
  }
  const float kmax = ((const float*)(ws + WS_KMAX))[(sb < 0 ? 0 : 1 + sb) * 16 + hd * 2 + map];
  const float sbound = qn * kmax * 1.02f + 0.5f;
  const float sl2 = exp2f(-(float)(hd + 1)) * LOG2E;
  const float bh0 = sl2 * (float)(4 * h), bh1 = bh0 + 32.f * sl2;
  float cs[16];
#pragma unroll
  for (int i = 0; i < 16; ++i) cs[i] = __uint_as_float(__builtin_amdgcn_readfirstlane(__float_as_uint(sl2 * (float)((i & 3) + 8 * (i >> 2)))));
  f32x16 O[4];
#pragma unroll
  for (int vt = 0; vt < 4; ++vt) O[vt] = zero16();
  float mrun = -1e30f, l = 0.f;
  const int jmax = base_chunk + ncq - 1, nit = jmax + 1;
  u32x4 rk[2], rv[2];
  const unsigned kofs = (unsigned)((tid >> 4) * 1024 + (tid & 15) * 8), vofs = (unsigned)((tid >> 3) * (unsigned)ldv + (tid & 7) * 8);
  auto gload = [&](int j) {
    const bf16_t* kj = Kb + (size_t)j * 65536;
    const bf16_t* vj = Vb + (size_t)j * 64;
#pragma unroll
    for (int e = 0; e < 2; ++e) {
      rk[e] = *(const u32x4*)(kj + (kofs + (unsigned)e * 32768u));
      rv[e] = *(const u32x4*)(vj + (vofs + (unsigned)e * 64u * (unsigned)ldv));
    }
  };
  auto lstore = [&](int buf) {
    unsigned char* base = lds + buf * A_BUF;
#pragma unroll
    for (int e = 0; e < 2; ++e) {
      const int id = tid + 512 * e;
      { const int row = id >> 4, c = id & 15; *(u32x4*)(base + row * A_KROW + 16 * c) = rk[e]; }
      { const int row = id >> 3, c = id & 7; unsigned char* d = base + A_KB + row * A_VROW + 32 * (c >> 1) + 8 * (c & 1);
        u32x2 lo = {rv[e][0], rv[e][1]}, hi = {rv[e][2], rv[e][3]}; *(u32x2*)d = lo; *(u32x2*)(d + 16) = hi; }
    }
  };
  int* flags = (int*)(lds + A_FLAGS);
  gload(jmax);
  __syncthreads();
  lstore(0);
  __syncthreads();
  for (int it = 0; it < nit; ++it) {
    const int j = jmax - it;
    if (it + 1 < nit) gload(j - 1);
    bool stop = true;
    if (wvalid && j <= qc) {
      const unsigned char* base = lds + (it & 1) * A_BUF;
      const unsigned char* kp = base + r * A_KROW + map * 128 + 16 * h;
      f32x16 s0, s1;
      {
        float b0 = bh0, b1 = bh1;
        asm volatile("" : "+v"(b0), "+v"(b1));
#pragma unroll
        for (int i = 0; i < 16; ++i) { s0[i] = b0 + cs[i]; s1[i] = b1 + cs[i]; }
      }
      if (j == qc) {
        int tlv = tl;
        asm volatile("" : "+v"(tlv));
        const float m2 = -2.f * sl2;
#pragma unroll
        for (int i = 0; i < 16; ++i) {
          const int s = crow(i, h);
          s0[i] = fmaf(m2, (float)max(0, s - tlv), s0[i]); s1[i] = fmaf(m2, (float)max(0, 32 + s - tlv), s1[i]);
        }
      }
#pragma unroll
      for (int kk = 0; kk < 4; ++kk) {
        const bf16x8 k0 = ld16(kp + 32 * kk), k1 = ld16(kp + 32 * A_KROW + 32 * kk);
        s0 = MFMA32(k0, qf[kk], s0); s1 = MFMA32(k1, qf[kk], s1);
      }
      const float dofs = sl2 * (float)((qc - j) * 64);
      float mx = -1e30f;
#pragma unroll
      for (int i = 0; i < 16; ++i) mx = fmaxf(mx, fmaxf(s0[i], s1[i]));
      mx = fmaxf(mx, __shfl_xor(mx, 32)) - dofs;
      const float mnew = fmaxf(mrun, mx), mm = mnew + dofs;
      if (__builtin_amdgcn_ballot_w64(mnew > mrun) != 0ull) {
        const float alpha = fexp2(mrun - mnew);
        l *= alpha;
#pragma unroll
        for (int vt = 0; vt < 4; ++vt) O[vt] = O[vt] * alpha;
      }
      mrun = mnew;
      float sum = 0.f;
#pragma unroll
      for (int i = 0; i < 16; ++i) { s0[i] = fexp2(s0[i] - mm); s1[i] = fexp2(s1[i] - mm); sum += s0[i] + s1[i]; }
      l += sum;
      bf16x8 pf[2][2];
      pf[0][0] = pack_acc(s0, 0); pf[0][1] = pack_acc(s0, 1); pf[1][0] = pack_acc(s1, 0); pf[1][1] = pack_acc(s1, 1);
      const unsigned char* vbase = base + A_KB + r * A_VROW + 16 * h;
#pragma unroll
      for (int vt = 0; vt < 4; ++vt) {
        const unsigned char* vp = vbase + 32 * vt * A_VROW;
#pragma unroll
        for (int st = 0; st < 2; ++st)
#pragma unroll
          for (int s2 = 0; s2 < 2; ++s2) O[vt] = MFMA32(ld16(vp + 64 * st + 32 * s2), pf[st][s2], O[vt]);
      }
      const float nb = sbound + sl2 * (float)(63 - (qc - j + 1) * 64) - mrun;
      stop = __builtin_amdgcn_ballot_w64(nb >= -152.f) == 0ull;
    } else if (wvalid) stop = false;
    if (lane == 0) flags[(it & 1) * 8 + wid] = stop ? 1 : 0;
    if (it + 1 < nit) lstore((it + 1) & 1);
    __syncthreads();
    {
      const int* f = flags + (it & 1) * 8;
      if ((f[0] & f[1] & f[2] & f[3] & f[4] & f[5] & f[6] & f[7]) != 0) break;
    }
  }
  __syncthreads();
  l += __shfl_xor(l, 32);
  const float inv = wvalid ? 1.f / l : 0.f;
  float* xch = (float*)lds + (size_t)(wid >> 1) * 4096;
  if (map == 1 && wvalid) {
    const float sc = inv * lam;
#pragma unroll
    for (int vt = 0; vt < 4; ++vt)
#pragma unroll
      for (int i = 0; i < 16; ++i) xch[(vt * 16 + i) * 64 + lane] = O[vt][i] * sc;
  }
  __syncthreads();
  if (map == 0 && wvalid) {
    float ss = 0.f;
#pragma unroll
    for (int vt = 0; vt < 4; ++vt)
#pragma unroll
      for (int i = 0; i < 16; ++i) { const float o = O[vt][i] * inv - xch[(vt * 16 + i) * 64 + lane]; O[vt][i] = o; ss += o * o; }
    ss += __shfl_xor(ss, 32);
    const float lam_init = 0.8f - 0.6f * 0.7408182206817179f;
    const float rs = __builtin_amdgcn_rsqf(ss * (1.f / 128.f) + EPS) * (1.f - lam_init);
    const unsigned zo = (unsigned)tok * 3072u + 1024 + hd * 128, oo = (unsigned)tok * 1536u + hd * 128;
    bf16_t* AOp = (bf16_t*)(ws + WS_AO);
    const float* sg = p.in[I_SUBG];
#pragma unroll
    for (int vt = 0; vt < 4; ++vt)
#pragma unroll
      for (int g = 0; g < 4; ++g) {
        const int v = 32 * vt + 8 * g + 4 * h;
        const u32x2 z = *(const u32x2*)(PB + (zo + v));
        const f32x4 gg = *(const f32x4*)(sg + v);
        const float o0 = O[vt][4 * g] * rs * gg[0] * siluf_(bflo(z[0])), o1 = O[vt][4 * g + 1] * rs * gg[1] * siluf_(bfhi(z[0]));
        const float o2 = O[vt][4 * g + 2] * rs * gg[2] * siluf_(bflo(z[1])), o3 = O[vt][4 * g + 3] * rs * gg[3] * siluf_(bfhi(z[1]));
        u32x2 o = {pk2(o0, o1), pk2(o2, o3)};
        *(u32x2*)(AOp + (oo + v)) = o;
      }
  }
  __syncthreads();
}

DI void phase7(const Params& p, unsigned char* lds) {
  unsigned* ctr = (unsigned*)(p.ws + WS_CTR) + 1 + 8 * p.pad;
  const bf16_t* PB = (const bf16_t*)(p.ws + WS_PB);
  float lam;
  {
    const int lane = TIDX & 63;
    const float* lv = p.in[I_LAMB];
    const float a = wave_sum(lv[lane] * lv[64 + lane]), b = wave_sum(lv[128 + lane] * lv[192 + lane]);
    const float lam_init = 0.8f - 0.6f * 0.7408182206817179f;
    lam = __expf(a) - __expf(b) + lam_init;
  }
  const int n_s = 128, n_p = 1024, n_ma = NCH;
  const int* tord = (const int*)(p.ws + WS_TORD);
  for (;;) {
    const int it = next_item(ctr, lds + LDS_BYTES - 16, TIDX);
    if (it >= n_s + n_p) break;
    const int a = tord[it];
    const bool pr = a < n_p;
    diffattn_task(p, lds, pr ? -1 : ((a - n_p) >> 3), pr ? (a >> 3) : 0, a & 7, lam);
  }
  for (;;) {
    const int it = next_item(ctr + 1, lds + LDS_BYTES - 16, TIDX);
    if (it >= n_ma) break;
    memattn_task(p, it, 1, PB + 2048, PB + 2560, 3072);
  }
}

DI void phase9(const Params& p) {
  const int tid = TIDX, lane = tid & 63, wid = tid >> 6;
  const int gw = blockIdx.x * 8 + wid, nw = gridDim.x * 8;
  for (int r = gw; r < TT; r += nw) {
    f32x4 v[4];
    float* row = p.out + O_Y + (size_t)r * 1024;
    const float rstd = row_load_rstd(row, v, lane);
#pragma unroll
    for (int j = 0; j < 4; ++j) {
      const f32x4 g = *(const f32x4*)(p.in[I_FNG] + 4 * lane + 256 * j);
      *(f32x4*)(row + 4 * lane + 256 * j) = v[j] * rstd * g;
    }
  }
}

DI void grid_barrier(unsigned* bar, unsigned target, int tid) {
  __threadfence();
  __syncthreads();
  if (tid == 0) {
    __hip_atomic_fetch_add(bar, 1u, __ATOMIC_RELEASE, __HIP_MEMORY_SCOPE_AGENT);
    while (__hip_atomic_load(bar, __ATOMIC_RELAXED, __HIP_MEMORY_SCOPE_AGENT) < target) __builtin_amdgcn_s_sleep(2);
  }
  __syncthreads();
  __threadfence();
}

__global__ __launch_bounds__(512) void mk(Params pin) {
  extern __shared__ __attribute__((aligned(16))) unsigned char lds[];
  Params p = pin;
  p.wv = __builtin_amdgcn_readfirstlane((int)(__builtin_amdgcn_workitem_id_x() >> 6));
  cg::grid_group grid = cg::this_grid();
  unsigned nbar = 0;
  unsigned* bar = (unsigned*)(p.ws + WS_CTR) + 32;
#define RUN_PHASE(PH, CALL) if (p.ph_lo <= PH && PH < p.ph_hi) { CALL; if (PH + 1 < p.ph_hi) { ++nbar; grid_barrier(bar, nbar * gridDim.x, TIDX); } }
  if (p.ph_lo <= 0 && 0 < p.ph_hi) { phase0(p, lds); if (1 < p.ph_hi) grid.sync(); }
  RUN_PHASE(1, phase1(p, lds))
  RUN_PHASE(2, phase2(p, lds))
  if (p.ph_lo <= 2 && 2 < p.ph_hi) { phase2c(p, lds); ++nbar; grid_barrier(bar, nbar * gridDim.x, TIDX); }
  RUN_PHASE(3, phase3(p))
  RUN_PHASE(4, phase_outproj(p, lds, 0))
  RUN_PHASE(5, phase5(p, lds))
  RUN_PHASE(6, phase6(p, lds))
  RUN_PHASE(7, phase7(p, lds))
  RUN_PHASE(8, phase_outproj(p, lds, 1))
  RUN_PHASE(9, phase9(p))
}

extern "C" void kernel_launch(void* const* d_in, const int* in_sizes, int n_in, void* d_out, int out_size,
                              void* d_ws, size_t ws_size, hipStream_t stream) {
  static int grid_blocks = 0;
  if (!grid_blocks) {
    int dev = 0, cus = 0, per_cu = 0;
    (void)hipGetDevice(&dev);
    (void)hipDeviceGetAttribute(&cus, hipDeviceAttributeMultiprocessorCount, dev);
    (void)hipFuncSetAttribute((const void*)mk, hipFuncAttributeMaxDynamicSharedMemorySize, LDS_BYTES);
    (void)hipOccupancyMaxActiveBlocksPerMultiprocessor(&per_cu, (const void*)mk, NTHREADS, LDS_BYTES);
    grid_blocks = cus;
    fprintf(stderr, "kernel_launch: cus=%d per_cu=%d grid=%d ws=%zu need=%zu\n", cus, per_cu, grid_blocks, ws_size, (size_t)WS_END);
  }
  if (ws_size < WS_END) { fprintf(stderr, "workspace too small\n"); return; }
  Params p{};
  for (int i = 0; i < 24; ++i) p.in[i] = (const float*)d_in[i];
  p.out = (float*)d_out; p.ws = (unsigned char*)d_ws; p.ph_lo = 0; p.ph_hi = NPHASE;
  void* args[] = {&p};
  hipError_t e = hipLaunchCooperativeKernel((const void*)mk, dim3(grid_blocks), dim3(NTHREADS), args, LDS_BYTES, stream);
  if (e != hipSuccess) fprintf(stderr, "cooperative launch failed: %s (grid %d)\n", hipGetErrorString(e), grid_blocks);
  if (PROBE_REP >= 0) {
    Params q = p;
    q.out = (float*)((unsigned char*)d_ws + WS_END); q.ph_lo = PROBE_REP; q.ph_hi = PROBE_REP + 1; q.pad = 1;
    void* args2[] = {&q};
    (void)hipLaunchCooperativeKernel((const void*)mk, dim3(grid_blocks), dim3(NTHREADS), args2, LDS_BYTES, stream);
  }
}
```

```cpp
#include <hip/hip_runtime.h>
#include <hip/hip_cooperative_groups.h>
#include <cstdio>
#include <cstdint>
namespace cg = cooperative_groups;

typedef unsigned short bf16_t;
typedef short bf16x8 __attribute__((ext_vector_type(8)));
typedef short s16x4 __attribute__((ext_vector_type(4)));
typedef float f32x16 __attribute__((ext_vector_type(16)));
typedef float f32x4 __attribute__((ext_vector_type(4)));
typedef float f32x2 __attribute__((ext_vector_type(2)));
typedef __bf16 bf2_t __attribute__((ext_vector_type(2)));
typedef unsigned u32x4 __attribute__((ext_vector_type(4)));
typedef unsigned u32x2 __attribute__((ext_vector_type(2)));
#define DI __device__ __forceinline__
#define MFMA32(a, b, c) __builtin_amdgcn_mfma_f32_32x32x16_bf16((a), (b), (c), 0, 0, 0)

struct Params { const float* in[24]; float* out; unsigned char* ws; int ph_lo, ph_hi; int wv, pad; };
#define TIDX (p.wv * 64 + (int)__builtin_amdgcn_mbcnt_hi(~0u, __builtin_amdgcn_mbcnt_lo(~0u, 0u)))
constexpr int LDS_BYTES = 148480;
constexpr int NTHREADS = 512;
constexpr int NPHASE = 10;
#ifndef PROBE_REP
#define PROBE_REP -1
#endif

constexpr int TP = 16384, TS = 1024, TT = 17408, DM = 1024;
constexpr int NCH = 272;
constexpr int PAST = 4096, SKV = 4160;
constexpr float EPS = 1e-6f;
constexpr float LOG2E = 1.4426950408889634f;
enum { I_XP = 0, I_XS, I_CK, I_CV, I_CMK, I_CMV, I_SC, I_SN, I_SM, I_MEMP, I_NG, I_FNG, I_MNG, I_WMKV, I_WINA, I_BGA, I_HGA, I_WOA,
       I_KVNG, I_WKV, I_WINB, I_LAMB, I_SUBG, I_WOB };
constexpr size_t O_Y = 0, O_PC = 17825792, O_PN = 18087936, O_PM = 18088960, O_PK = 18088964, O_PV = 34866180, O_PMK = 51643396,
                 O_PMV = 51905540, O_SC = 52167684, O_SN = 56361988, O_SM = 56378372, O_SK = 56378436, O_SV = 57427012;
constexpr size_t WS_CTR = 0;
constexpr size_t WS_KMAX = 1024;
constexpr size_t WS_TORD = 8192;
constexpr size_t WS_WA = 16384;
constexpr size_t WS_WOA = WS_WA + (size_t)6144 * 1024 * 2;
constexpr size_t WS_WKB = WS_WOA + (size_t)1024 * 1536 * 2;
constexpr size_t WS_WOB = WS_WKB + (size_t)5120 * 1024 * 2;
constexpr size_t WS_WM = WS_WOB + (size_t)1024 * 1536 * 2;
constexpr size_t WS_MEMN = WS_WM + (size_t)2 * 1024 * 1024 * 2;
constexpr size_t WS_MEMK = WS_MEMN + (size_t)2 * 256 * 1024 * 2;
constexpr size_t WS_MEMVT = WS_MEMK + (size_t)2 * 17 * 256 * 512 * 2;
constexpr size_t WS_GATE = WS_MEMVT + (size_t)2 * 17 * 256 * 512 * 2;
constexpr size_t SZ_CH = (size_t)NCH * 4 * 64 * 4;
constexpr size_t WS_GC = WS_GATE + (size_t)TT * 8 * 4;
constexpr size_t WS_MT = WS_GC + SZ_CH;
constexpr size_t WS_WS = WS_MT + SZ_CH;
constexpr size_t WS_WI = WS_WS + SZ_CH;
constexpr size_t WS_AS = WS_WI + SZ_CH;
constexpr size_t WS_BT = WS_AS + SZ_CH;
constexpr size_t WS_DEC = WS_BT + SZ_CH;
constexpr size_t WS_DENI = WS_DEC + 8192;
constexpr size_t WS_DENA = WS_DENI + (size_t)TT * 4 * 4;
constexpr size_t WS_XN = WS_DENA + (size_t)TT * 4 * 4;
constexpr size_t WS_AO = WS_XN + (size_t)TT * 1024 * 2;
constexpr size_t WS_Y1 = WS_AO + (size_t)TT * 1536 * 2;
constexpr size_t WS_KT = WS_Y1 + (size_t)TT * 1024 * 4;
constexpr size_t WS_VTA = WS_KT + (size_t)NCH * 4 * 256 * 64 * 2;
constexpr size_t WS_R1 = WS_VTA + (size_t)NCH * 4 * 256 * 64 * 2;
constexpr size_t SZ_R1 = (size_t)TT * 6144 * 2;
constexpr size_t WS_PB = WS_R1;
constexpr size_t WS_KBP = WS_PB + (size_t)TT * 3072 * 2;
constexpr size_t WS_VTP = WS_KBP + (size_t)TP * 1024 * 2;
constexpr size_t WS_R2 = WS_R1 + SZ_R1;
constexpr size_t WS_HINTER = WS_R2;
constexpr size_t WS_HINTRA = WS_R2 + (size_t)TT * 1024 * 4;
constexpr size_t WS_KBS = WS_R2;
constexpr size_t WS_VTS = WS_KBS + (size_t)16 * SKV * 1024 * 2;
constexpr size_t WS_LD = WS_VTS + (size_t)16 * SKV * 1024 * 2;
constexpr size_t WS_CLOC = WS_LD + 8192;
constexpr size_t WS_END = WS_CLOC + (size_t)16 * 36 * 8 * 64 * 16 * 4;
constexpr int GRP = 16;
static_assert(WS_VTP + (size_t)TP * 1024 * 2 <= WS_R2, "R1 overflow");

DI unsigned pk2(float lo, float hi) { f32x2 v = {lo, hi}; return __builtin_bit_cast(unsigned, __builtin_convertvector(v, bf2_t)); }
DI bf16_t f2bf(float x) { return (bf16_t)(pk2(x, 0.f) & 0xffffu); }
DI float bf2f(unsigned v16) { return __uint_as_float(v16 << 16); }
DI float bflo(unsigned u) { return __uint_as_float(u << 16); }
DI float bfhi(unsigned u) { return __uint_as_float(u & 0xffff0000u); }
DI float rbf(float x) { return bflo(pk2(x, 0.f) & 0xffffu); }
DI int crow(int i, int h) { return (i & 3) + 8 * (i >> 2) + 4 * h; }
DI float wave_sum(float v) {
#pragma unroll
  for (int o = 32; o >= 1; o >>= 1) v += __shfl_xor(v, o);
  return v;
}
DI float fexp2(float x) { return __builtin_amdgcn_exp2f(x); }
DI float fexp(float x) { return __builtin_amdgcn_exp2f(x * LOG2E); }
DI float sigmoidf_(float x) { return 1.f / (1.f + __expf(-x)); }
DI float siluf_(float x) { return x / (1.f + __expf(-x)); }
DI bf16x8 pack_acc(const f32x16& x, int s) {
  u32x4 p;
  p[0] = pk2(x[8 * s + 0], x[8 * s + 1]); p[1] = pk2(x[8 * s + 2], x[8 * s + 3]);
  p[2] = pk2(x[8 * s + 4], x[8 * s + 5]); p[3] = pk2(x[8 * s + 6], x[8 * s + 7]);
  return __builtin_bit_cast(bf16x8, p);
}
DI bf16x8 ld16(const void* p) { return *(const bf16x8*)p; }
DI bf16x8 ld8x2(const void* p0, const void* p1) {
  u32x2 a = *(const u32x2*)p0, b = *(const u32x2*)p1; u32x4 r = {a[0], a[1], b[0], b[1]};
  return __builtin_bit_cast(bf16x8, r);
}
DI f32x16 zero16() { f32x16 z; for (int i = 0; i < 16; ++i) z[i] = 0.f; return z; }

DI void transpose_tile(const float* __restrict__ src, size_t ld_s, bf16_t* __restrict__ dst, size_t ld_d, const float* __restrict__ scale,
                       float* scr, int t) {
  {
    const int c4 = t & 15, rb = t >> 4;
#pragma unroll
    for (int i = 0; i < 2; ++i) {
      const int r = rb + 32 * i;
      f32x4 v = *(const f32x4*)(src + (size_t)r * ld_s + 4 * c4);
      if (scale) { const float s = scale[r]; v = v * s; }
      float* d = scr + r * 65 + 4 * c4; d[0] = v[0]; d[1] = v[1]; d[2] = v[2]; d[3] = v[3];
    }
  }
  __syncthreads();
  {
    const int c = t >> 3, rg = t & 7;
    const float* s = scr + (8 * rg) * 65 + c;
    u32x4 o; o[0] = pk2(s[0], s[65]); o[1] = pk2(s[2 * 65], s[3 * 65]); o[2] = pk2(s[4 * 65], s[5 * 65]); o[3] = pk2(s[6 * 65], s[7 * 65]);
    *(u32x4*)(dst + (size_t)c * ld_d + 8 * rg) = o;
  }
  __syncthreads();
}

struct TJob { const float* src; size_t ld_s; bf16_t* dst; size_t ld_d; const float* scale; int tr, tc; };

DI void run_tjob_tile(const TJob& j, int tile, float* scr, int tid) {
  const int ir = tile / j.tc, ic = tile % j.tc;
  transpose_tile(j.src + (size_t)(64 * ir) * j.ld_s + 64 * ic, j.ld_s, j.dst + (size_t)(64 * ic) * j.ld_d + 64 * ir, j.ld_d,
                 j.scale ? j.scale + 64 * ir : nullptr, scr, tid);
}

DI float row_load_rstd(const float* xrow, f32x4 (&v)[4], int lane) {
  float ss = 0.f;
#pragma unroll
  for (int j = 0; j < 4; ++j) { v[j] = *(const f32x4*)(xrow + 4 * lane + 256 * j); ss += v[j][0] * v[j][0] + v[j][1] * v[j][1] + v[j][2] * v[j][2] + v[j][3] * v[j][3]; }
  ss = wave_sum(ss);
  return __builtin_amdgcn_rsqf(ss * (1.f / 1024.f) + EPS);
}

DI int diff_est(int a) {
  const int hd = a & 7;
  const int w = hd == 0 ? 5 : hd == 1 ? 9 : hd == 2 ? 16 : hd == 3 ? 31 : hd == 4 ? 60 : hd == 5 ? 119 : hd == 6 ? 237 : 256;
  const int n = a < 1024 ? 2 * (a >> 3) + 2 : 65;
  return n < w ? n : w;
}

DI void phase0(const Params& p, unsigned char* lds) {
  const int tid = TIDX, lane = tid & 63, wid = tid >> 6;
  unsigned char* ws = p.ws;
  if (blockIdx.x == 0 && tid < 64) ((unsigned*)(ws + WS_CTR))[tid] = 0u;
  if (blockIdx.x == 0 && tid < 272) ((unsigned*)(ws + WS_KMAX))[tid] = 0u;
  if (blockIdx.x == 1) {
    int* est = (int*)lds;
    for (int a = tid; a < 1152; a += NTHREADS) est[a] = diff_est(a);
    __syncthreads();
    for (int a = tid; a < 1152; a += NTHREADS) {
      const int ea = est[a];
      int rank = 0;
      for (int b = 0; b < 1152; ++b) { const int eb = est[b]; rank += (eb > ea) || (eb == ea && b < a); }
      ((int*)(ws + WS_TORD))[rank] = a;
    }
    __syncthreads();
  }
  {
    TJob jobs[8];
    jobs[0] = {p.in[I_WINA], 6152, (bf16_t*)(ws + WS_WA), 1024, p.in[I_NG], 16, 80};
    jobs[1] = {p.in[I_WINA] + 5128, 6152, (bf16_t*)(ws + WS_WA) + (size_t)5120 * 1024, 1024, p.in[I_NG], 16, 16};
    jobs[2] = {p.in[I_WOA], 1024, (bf16_t*)(ws + WS_WOA), 1536, nullptr, 24, 16};
    jobs[3] = {p.in[I_WKV], 2048, (bf16_t*)(ws + WS_WKB), 1024, p.in[I_KVNG], 16, 32};
    jobs[4] = {p.in[I_WINB], 3072, (bf16_t*)(ws + WS_WKB) + (size_t)2048 * 1024, 1024, p.in[I_NG] + 1024, 16, 48};
    jobs[5] = {p.in[I_WOB], 1024, (bf16_t*)(ws + WS_WOB), 1536, nullptr, 24, 16};
    jobs[6] = {p.in[I_WMKV], 1024, (bf16_t*)(ws + WS_WM), 1024, nullptr, 16, 16};
    jobs[7] = {p.in[I_WMKV] + (size_t)1024 * 1024, 1024, (bf16_t*)(ws + WS_WM) + (size_t)1024 * 1024, 1024, nullptr, 16, 16};
    int base = 0;
#pragma unroll
    for (int j = 0; j < 8; ++j) {
      const int n = jobs[j].tr * jobs[j].tc;
      for (int t = blockIdx.x; t < n; t += gridDim.x) run_tjob_tile(jobs[j], t, (float*)lds, tid);
      base += n;
    }
    for (int t = blockIdx.x; t < 128 * 8; t += gridDim.x) {
      const int jb = t >> 3, tile = t & 7, l = jb >> 6, b = (jb >> 2) & 15, h = jb & 3;
      TJob j = {p.in[I_CMV] + ((size_t)(l * 16 + b) * 256) * 512 + h * 128, 512,
                (bf16_t*)(ws + WS_MEMVT) + ((size_t)(l * 17 + 1 + b) * 4 + h) * 128 * 256, 256, nullptr, 4, 2};
      run_tjob_tile(j, tile, (float*)lds, tid);
    }
  }
  {
    const size_t n8 = (size_t)2 * 16 * 256 * 512 / 8;
    for (size_t i = (size_t)blockIdx.x * NTHREADS + tid; i < n8; i += (size_t)gridDim.x * NTHREADS) {
      const size_t e = i * 8; const int l = (int)(e / ((size_t)16 * 131072)); const size_t rem = e - (size_t)l * 16 * 131072;
      const f32x4 a = *(const f32x4*)(p.in[I_CMK] + e), b = *(const f32x4*)(p.in[I_CMK] + e + 4);
      u32x4 o = {pk2(a[0], a[1]), pk2(a[2], a[3]), pk2(b[0], b[1]), pk2(b[2], b[3])};
      *(u32x4*)((bf16_t*)(ws + WS_MEMK) + ((size_t)(l * 17 + 1) * 131072) + rem) = o;
    }
  }
  {
    const int gw = blockIdx.x * 8 + wid, nw = gridDim.x * 8;
    const float* ng = p.in[I_NG];
    for (int r = gw; r < TT; r += nw) {
      const float* xrow = r < TP ? p.in[I_XP] + (size_t)r * 1024 : p.in[I_XS] + (size_t)(r - TP) * 1024;
      f32x4 v[4];
      const float rstd = row_load_rstd(xrow, v, lane);
      float gacc[8];
#pragma unroll
      for (int c = 0; c < 8; ++c) gacc[c] = 0.f;
      bf16_t* xn = (bf16_t*)(ws + WS_XN) + (size_t)r * 1024;
#pragma unroll
      for (int j = 0; j < 4; ++j) {
        const int k0 = 4 * lane + 256 * j;
        const f32x4 xs = v[j] * rstd;
        u32x2 o = {pk2(xs[0], xs[1]), pk2(xs[2], xs[3])};
        *(u32x2*)(xn + k0) = o;
        const f32x4 g = *(const f32x4*)(ng + k0);
#pragma unroll
        for (int e = 0; e < 4; ++e) {
          const float xg = xs[e] * g[e];
          const float* wr = p.in[I_WINA] + (size_t)(k0 + e) * 6152 + 5120;
          const f32x4 w0 = *(const f32x4*)wr, w1 = *(const f32x4*)(wr + 4);
          gacc[0] += xg * w0[0]; gacc[1] += xg * w0[1]; gacc[2] += xg * w0[2]; gacc[3] += xg * w0[3];
          gacc[4] += xg * w1[0]; gacc[5] += xg * w1[1]; gacc[6] += xg * w1[2]; gacc[7] += xg * w1[3];
        }
      }
#pragma unroll
      for (int c = 0; c < 8; ++c) gacc[c] = wave_sum(gacc[c]);
      if (lane < 8) {
        float gv = gacc[0];
#pragma unroll
        for (int c = 1; c < 8; ++c) gv = lane == c ? gacc[c] : gv;
        gv += p.in[I_BGA][lane];
        if (lane >= 4) gv = fminf(gv, 0.f) - log1pf(__expf(-fabsf(gv)));
        ((float*)(ws + WS_GATE))[(size_t)r * 8 + lane] = gv;
      }
    }
    for (int r = gw; r < 512; r += nw) {
      const int l = r >> 8, rr = r & 255;
      f32x4 v[4];
      const float rstd = row_load_rstd(p.in[I_MEMP] + (size_t)rr * 1024, v, lane);
      bf16_t* o = (bf16_t*)(ws + WS_MEMN) + (size_t)r * 1024;
#pragma unroll
      for (int j = 0; j < 4; ++j) {
        const int k0 = 4 * lane + 256 * j;
        const f32x4 g = *(const f32x4*)(p.in[I_MNG] + l * 1024 + k0);
        const f32x4 xs = v[j] * rstd * g;
        u32x2 ov = {pk2(xs[0], xs[1]), pk2(xs[2], xs[3])};
        *(u32x2*)(o + k0) = ov;
      }
    }
  }
}

constexpr int G_STAGE = 49152;
struct GemmAcc { f32x16 a[2][2]; };
DI void dma16(const void* g, unsigned char* l) { __builtin_amdgcn_global_load_lds((const unsigned*)g, (unsigned*)l, 16, 0, 0); }

DI void gemm_tile(const bf16_t* __restrict__ A, size_t lda, const bf16_t* __restrict__ Bt, size_t ldb, int K, unsigned char* lds, GemmAcc& acc, int tid) {
  const int lane = tid & 63, wid = __builtin_amdgcn_readfirstlane(tid >> 6), r = lane & 31, h = lane >> 5;
  const int wr = wid >> 1, wc = wid & 1;
#pragma unroll
  for (int a = 0; a < 2; ++a)
#pragma unroll
    for (int b = 0; b < 2; ++b) acc.a[a][b] = zero16();
  const int nk = K / 64;
  unsigned aoff[4], boff[2];
#pragma unroll
  for (int e = 0; e < 4; ++e) { const int row = 8 * (wid * 4 + e) + (lane >> 3), lc = (lane & 7) ^ ((row >> 1) & 7); aoff[e] = (unsigned)row * (unsigned)lda + 8u * lc; }
#pragma unroll
  for (int e = 0; e < 2; ++e) { const int row = 8 * (wid * 2 + e) + (lane >> 3), lc = (lane & 7) ^ ((row >> 1) & 7); boff[e] = (unsigned)row * (unsigned)ldb + 8u * lc; }
  auto issue = [&](int kt, int buf) {
    unsigned char* base = lds + buf * G_STAGE;
#pragma unroll
    for (int e = 0; e < 4; ++e) dma16(A + (aoff[e] + 64u * kt), base + (wid * 4 + e) * 1024);
#pragma unroll
    for (int e = 0; e < 2; ++e) dma16(Bt + (boff[e] + 64u * kt), base + 32768 + (wid * 2 + e) * 1024);
  };
  asm volatile("s_waitcnt vmcnt(0)" ::: "memory");
  __syncthreads();
  issue(0, 0);
  if (nk > 1) issue(1, 1);
  const unsigned sw = (r >> 1) & 7;
  unsigned co[4];
#pragma unroll
  for (int kk = 0; kk < 4; ++kk) co[kk] = (((2 * kk + h) ^ sw) << 4);
  const unsigned ra = (wr * 64 + r) * 128, rb = 32768 + (wc * 64 + r) * 128;
  for (int kt = 0; kt < nk; ++kt) {
    if (kt + 1 < nk) asm volatile("s_waitcnt vmcnt(6)" ::: "memory"); else asm volatile("s_waitcnt vmcnt(0)" ::: "memory");
    asm volatile("s_waitcnt lgkmcnt(0)" ::: "memory");
    __builtin_amdgcn_s_barrier();
    if (kt + 2 < nk) issue(kt + 2, (kt + 2) % 3);
    const unsigned char* base = lds + (kt % 3) * G_STAGE;
    const unsigned char* pa = base + ra;
    const unsigned char* pb = base + rb;
#pragma unroll
    for (int kk = 0; kk < 4; ++kk) {
      const bf16x8 a0 = ld16(pa + co[kk]), a1 = ld16(pa + 4096 + co[kk]);
      const bf16x8 b0 = ld16(pb + co[kk]), b1 = ld16(pb + 4096 + co[kk]);
      acc.a[0][0] = MFMA32(a0, b0, acc.a[0][0]);
      acc.a[0][1] = MFMA32(a0, b1, acc.a[0][1]);
      acc.a[1][0] = MFMA32(a1, b0, acc.a[1][0]);
      acc.a[1][1] = MFMA32(a1, b1, acc.a[1][1]);
    }
  }
}

DI void gate_scan(const Params& p, unsigned char* lds) {
  const int tid = TIDX, lane = tid & 63, wid = tid >> 6;
  unsigned char* ws = p.ws;
  const float* gate = (const float*)(ws + WS_GATE);
  float* s_gl = (float*)lds;
  float* s_A = s_gl + NCH * 4;
  float* s_mc = s_A + NCH * 4;
  float* s_mn = s_mc + NCH * 4;
  __syncthreads();
  for (int pr = wid; pr < NCH * 4; pr += 8) {
    const int cc = pr >> 2, hd = pr & 3;
    const float ig = gate[(size_t)(cc * 64 + lane) * 8 + hd], lf = gate[(size_t)(cc * 64 + lane) * 8 + 4 + hd];
    float g = lf;
#pragma unroll
    for (int o = 1; o < 64; o <<= 1) { const float t = __shfl_up(g, o); if (lane >= o) g += t; }
    float a = ig - g;
#pragma unroll
    for (int o = 32; o >= 1; o >>= 1) a = fmaxf(a, __shfl_xor(a, o));
    const float gl = __shfl(g, 63);
    if (lane == 0) { s_gl[pr] = gl; s_A[pr] = a; }
  }
  __syncthreads();
  if (tid < 4) {
    float m = 0.f;
    float ld = 0.f;
    float* LD = (float*)(ws + WS_LD);
    for (int c = 0; c < 256; ++c) {
      s_mc[c * 4 + tid] = m; LD[c * 4 + tid] = ld;
      const float mn = s_gl[c * 4 + tid] + fmaxf(m, s_A[c * 4 + tid]);
      ld += s_gl[c * 4 + tid] + m - mn;
      m = mn; s_mn[c * 4 + tid] = m;
    }
    LD[256 * 4 + tid] = ld;
    p.out[O_PM + tid] = m;
  } else if (tid >= 64 && tid < 128) {
    const int b = (tid - 64) >> 2, hd = tid & 3, pr = (256 + b) * 4 + hd;
    const float m0 = p.in[I_SM][b * 4 + hd];
    const float m = s_gl[pr] + fmaxf(m0, s_A[pr]);
    s_mc[pr] = m0; s_mn[pr] = m;
    p.out[O_SM + b * 4 + hd] = m;
  }
  __syncthreads();
  for (int pr = wid; pr < NCH * 4; pr += 8) {
    const int cc = pr >> 2, hd = pr & 3;
    const float ig = gate[(size_t)(cc * 64 + lane) * 8 + hd], lf = gate[(size_t)(cc * 64 + lane) * 8 + 4 + hd];
    float g = lf;
#pragma unroll
    for (int o = 1; o < 64; o <<= 1) { const float t = __shfl_up(g, o); if (lane >= o) g += t; }
    const float a = ig - g;
    float pm = a;
#pragma unroll
    for (int o = 1; o < 64; o <<= 1) { const float t = __shfl_up(pm, o); if (lane >= o) pm = fmaxf(pm, t); }
    const float mc = s_mc[pr], mn = s_mn[pr], gl = s_gl[pr];
    const float mt = g + fmaxf(mc, pm);
    const size_t o = (size_t)pr * 64 + lane;
    ((float*)(ws + WS_GC))[o] = g;
    ((float*)(ws + WS_MT))[o] = mt;
    ((float*)(ws + WS_WS))[o] = __expf(gl - g + ig - mn);
    ((float*)(ws + WS_WI))[o] = __expf(g + mc - mt);
    ((float*)(ws + WS_AS))[o] = (ig - g) * LOG2E;
    ((float*)(ws + WS_BT))[o] = (g - mt) * LOG2E;
    if (lane == 0) ((float*)(ws + WS_DEC))[pr] = __expf(gl + mc - mn);
  }
  __syncthreads();
}

DI void phase1(const Params& p, unsigned char* lds) {
  const int tid = TIDX, lane = tid & 63, wid = tid >> 6, r = lane & 31, h = lane >> 5, wr = wid >> 1, wc = wid & 1;
  unsigned char* ws = p.ws;
  if (blockIdx.x == gridDim.x - 1) gate_scan(p, lds);
  const int n_main = 68 * 48, n_mem = 16;
  for (int t = blockIdx.x; t < n_main + n_mem; t += gridDim.x) {
    GemmAcc acc;
    if (t < n_main) {
      const int tm = t / 48, tn = t % 48, m0 = tm * 256, n0 = tn * 128;
      gemm_tile((const bf16_t*)(ws + WS_XN) + (size_t)m0 * 1024, 1024, (const bf16_t*)(ws + WS_WA) + (size_t)n0 * 1024, 1024, 1024, lds, acc, tid);
      bf16_t* PA = (bf16_t*)(ws + WS_R1);
      const int sec = n0 >> 10;
#pragma unroll
      for (int a = 0; a < 2; ++a)
#pragma unroll
        for (int b = 0; b < 2; ++b) {
          __builtin_amdgcn_sched_barrier(0);
          const int n = n0 + wc * 64 + 32 * b + r, mb = m0 + wr * 64 + 32 * a;
          if (sec != 2) {
            const float sc = sec == 1 ? 0.0625f : 1.f;
#pragma unroll
            for (int i = 0; i < 16; ++i) PA[(size_t)(mb + crow(i, h)) * 6144 + n] = f2bf(acc.a[a][b][i] * sc);
          }
          if (sec == 1 || sec == 2) {
            const float sc = sec == 1 ? 0.0625f : 1.f;
            const int f = n & 1023, hd = f >> 8, fe = f & 255;
            bf16_t* T = (bf16_t*)(ws + (sec == 1 ? WS_KT : WS_VTA));
#pragma unroll
            for (int g = 0; g < 4; ++g) {
              const int m = mb + 8 * g + 4 * h, cc = m >> 6, s = m & 63;
              u32x2 o = {pk2(acc.a[a][b][4 * g] * sc, acc.a[a][b][4 * g + 1] * sc), pk2(acc.a[a][b][4 * g + 2] * sc, acc.a[a][b][4 * g + 3] * sc)};
              *(u32x2*)(T + (((size_t)cc * 4 + hd) * 256 + fe) * 64 + s) = o;
            }
          }
        }
    } else {
      const int tt = t - n_main, l = tt >> 3, n0 = (tt & 7) * 128;
      gemm_tile((const bf16_t*)(ws + WS_MEMN) + (size_t)l * 256 * 1024, 1024, (const bf16_t*)(ws + WS_WM) + ((size_t)l * 1024 + n0) * 1024, 1024, 1024, lds, acc, tid);
      const bool isv = n0 >= 512;
      float* of = p.out + (isv ? O_PMV : O_PMK) + (size_t)l * 131072;
      bf16_t* mk = (bf16_t*)(ws + WS_MEMK) + (size_t)(l * 17) * 131072;
      bf16_t* mv = (bf16_t*)(ws + WS_MEMVT) + (size_t)(l * 17) * 131072;
#pragma unroll
      for (int a = 0; a < 2; ++a)
#pragma unroll
        for (int b = 0; b < 2; ++b) {
          __builtin_amdgcn_sched_barrier(0);
          const int f = (n0 & 511) + wc * 64 + 32 * b + r, mb = wr * 64 + 32 * a;
#pragma unroll
          for (int g = 0; g < 4; ++g) {
            const int m = mb + 8 * g + 4 * h;
            float* o4 = of + (size_t)m * 512 + f;
            o4[0] = acc.a[a][b][4 * g]; o4[512] = acc.a[a][b][4 * g + 1]; o4[1024] = acc.a[a][b][4 * g + 2]; o4[1536] = acc.a[a][b][4 * g + 3];
            if (!isv) {
              bf16_t* k4 = mk + (size_t)m * 512 + f;
              k4[0] = f2bf(acc.a[a][b][4 * g]); k4[512] = f2bf(acc.a[a][b][4 * g + 1]); k4[1024] = f2bf(acc.a[a][b][4 * g + 2]); k4[1536] = f2bf(acc.a[a][b][4 * g + 3]);
            } else {
              u32x2 o = {pk2(acc.a[a][b][4 * g], acc.a[a][b][4 * g + 1]), pk2(acc.a[a][b][4 * g + 2], acc.a[a][b][4 * g + 3])};
              *(u32x2*)(mv + (size_t)f * 256 + m) = o;
            }
          }
        }
    }
  }
}

DI void scan_task(const Params& p, unsigned char* lds, int sb  , int hd, int j, int grp) {
  const int tid = TIDX, lane = tid & 63, wid = tid >> 6, r = lane & 31, h = lane >> 5;
  unsigned char* ws = p.ws;
  const int cc0 = sb < 0 ? GRP * grp : 256 + sb, nch = sb < 0 ? GRP : 1;
  const bf16_t* PA = (const bf16_t*)(ws + WS_R1);
  const bf16_t* KT = (const bf16_t*)(ws + WS_KT);
  const bf16_t* VT = (const bf16_t*)(ws + WS_VTA);
  const float* WSa = (const float*)(ws + WS_WS);
  const float* WIa = (const float*)(ws + WS_WI);
  const float* DEC = (const float*)(ws + WS_DEC);
  float* red = (float*)lds;
  const bool nsl = j == 8;
  f32x16 S = zero16();
  if (sb >= 0) {
    if (!nsl) {
      const float* C0 = p.in[I_SC] + ((size_t)(sb * 4 + hd) * 256 + 32 * j + r) * 256 + 32 * wid;
#pragma unroll
      for (int g = 0; g < 4; ++g) { const f32x4 c = *(const f32x4*)(C0 + 8 * g + 4 * h); S[4 * g] = c[0]; S[4 * g + 1] = c[1]; S[4 * g + 2] = c[2]; S[4 * g + 3] = c[3]; }
    } else if (r == 0) {
      const float* n0 = p.in[I_SN] + (size_t)(sb * 4 + hd) * 256 + 32 * wid;
#pragma unroll
      for (int g = 0; g < 4; ++g) { const f32x4 c = *(const f32x4*)(n0 + 8 * g + 4 * h); S[4 * g] = c[0]; S[4 * g + 1] = c[1]; S[4 * g + 2] = c[2]; S[4 * g + 3] = c[3]; }
    }
  }
  bf16x8 kt[4], wv[4], qf[2][2];
  auto loadc = [&](int cc) {
    const size_t ch = (size_t)cc * 4 + hd;
    const bf16_t* kp = KT + (ch * 256 + 32 * wid + r) * 64 + 8 * h;
#pragma unroll
    for (int st = 0; st < 4; ++st) kt[st] = ld16(kp + 16 * st);
    const float* wsp = WSa + ch * 64 + 8 * h;
    if (!nsl) {
      const bf16_t* vp = VT + (ch * 256 + 32 * j + r) * 64 + 8 * h;
#pragma unroll
      for (int st = 0; st < 4; ++st) {
        const u32x4 v = *(const u32x4*)(vp + 16 * st);
        const f32x4 w0 = *(const f32x4*)(wsp + 16 * st), w1 = *(const f32x4*)(wsp + 16 * st + 4);
        u32x4 o;
        o[0] = pk2(bflo(v[0]) * w0[0], bfhi(v[0]) * w0[1]); o[1] = pk2(bflo(v[1]) * w0[2], bfhi(v[1]) * w0[3]);
        o[2] = pk2(bflo(v[2]) * w1[0], bfhi(v[2]) * w1[1]); o[3] = pk2(bflo(v[3]) * w1[2], bfhi(v[3]) * w1[3]);
        wv[st] = __builtin_bit_cast(bf16x8, o);
      }
    } else {
#pragma unroll
      for (int st = 0; st < 4; ++st) {
        const f32x4 w0 = *(const f32x4*)(wsp + 16 * st), w1 = *(const f32x4*)(wsp + 16 * st + 4);
        u32x4 o = {pk2(w0[0], w0[1]), pk2(w0[2], w0[3]), pk2(w1[0], w1[1]), pk2(w1[2], w1[3])};
        if (r != 0) o = (u32x4){0u, 0u, 0u, 0u};
        wv[st] = __builtin_bit_cast(bf16x8, o);
      }
    }
#pragma unroll
    for (int tt = 0; tt < 2; ++tt) {
      const bf16_t* qp = PA + (size_t)(cc * 64 + 32 * tt + r) * 6144 + hd * 256 + 32 * wid + 4 * h;
#pragma unroll
      for (int s2 = 0; s2 < 2; ++s2) qf[tt][s2] = ld8x2(qp + 16 * s2, qp + 16 * s2 + 8);
    }
  };
  for (int c = 0; c < nch; ++c) {
    const int cc = cc0 + c;
    loadc(cc);
    const float dec = DEC[cc * 4 + hd];
    const bf16x8 xs0 = pack_acc(S, 0), xs1 = pack_acc(S, 1);
    f32x16 z0 = MFMA32(xs0, qf[0][0], zero16()); z0 = MFMA32(xs1, qf[0][1], z0);
    f32x16 z1 = MFMA32(xs0, qf[1][0], zero16()); z1 = MFMA32(xs1, qf[1][1], z1);
    S = S * dec;
#pragma unroll
    for (int st = 0; st < 4; ++st) S = MFMA32(kt[st], wv[st], S);
    __syncthreads();
    {
      float* rw = red + wid * (64 * 33);
#pragma unroll
      for (int i = 0; i < 16; ++i) { rw[r * 33 + crow(i, h)] = z0[i]; rw[(32 + r) * 33 + crow(i, h)] = z1[i]; }
    }
    __syncthreads();
    {
      const int v = tid & 31;
#pragma unroll
      for (int e = 0; e < 4; ++e) {
        const int t = (tid >> 5) + 16 * e;
        float s = 0.f;
#pragma unroll
        for (int w8 = 0; w8 < 8; ++w8) s += red[w8 * (64 * 33) + t * 33 + v];
        const float wi = WIa[((size_t)cc * 4 + hd) * 64 + t];
        if (!nsl) ((float*)(ws + WS_HINTER))[(size_t)(cc * 64 + t) * 1024 + hd * 256 + 32 * j + v] = s * wi;
        else if (v == 0) ((float*)(ws + WS_DENI))[(size_t)(cc * 64 + t) * 4 + hd] = s * wi;
      }
    }
  }
  if (sb < 0) {
    float* cl = (float*)(ws + WS_CLOC) + ((((size_t)(grp * 4 + hd) * 9 + j) * 8 + wid) * 64 + lane) * 16;
#pragma unroll
    for (int g = 0; g < 4; ++g) { f32x4 c = {S[4 * g], S[4 * g + 1], S[4 * g + 2], S[4 * g + 3]}; *(f32x4*)(cl + 4 * g) = c; }
  } else {
    if (!nsl) {
      float* Co = (sb < 0 ? p.out + O_PC + (size_t)hd * 65536 : p.out + O_SC + (size_t)(sb * 4 + hd) * 65536) + (size_t)(32 * j + r) * 256 + 32 * wid;
#pragma unroll
      for (int g = 0; g < 4; ++g) { f32x4 c = {S[4 * g], S[4 * g + 1], S[4 * g + 2], S[4 * g + 3]}; *(f32x4*)(Co + 8 * g + 4 * h) = c; }
    } else if (r == 0) {
      float* no = (sb < 0 ? p.out + O_PN + (size_t)hd * 256 : p.out + O_SN + (size_t)(sb * 4 + hd) * 256) + 32 * wid;
#pragma unroll
      for (int g = 0; g < 4; ++g) { f32x4 c = {S[4 * g], S[4 * g + 1], S[4 * g + 2], S[4 * g + 3]}; *(f32x4*)(no + 8 * g + 4 * h) = c; }
    }
  }
  __syncthreads();
}

DI void intra_task(const Params& p, int cc, int hd) {
  const int tid = TIDX, lane = tid & 63, wid = tid >> 6, r = lane & 31, h = lane >> 5;
  unsigned char* ws = p.ws;
  const int tt = wid & 1, vq = wid >> 1;
  const bf16_t* PA = (const bf16_t*)(ws + WS_R1);
  const bf16_t* VT = (const bf16_t*)(ws + WS_VTA);
  const size_t ch = (size_t)cc * 4 + hd;
  f32x16 s0 = zero16(), s1 = zero16();
  {
    const bf16_t* qp = PA + (size_t)(cc * 64 + 32 * tt + r) * 6144 + hd * 256 + 8 * h;
    const bf16_t* kp = PA + (size_t)(cc * 64 + r) * 6144 + 1024 + hd * 256 + 8 * h;
#pragma unroll 4
    for (int kk = 0; kk < 16; ++kk) {
      const bf16x8 q = ld16(qp + 16 * kk), k0 = ld16(kp + 16 * kk), k1 = ld16(kp + (size_t)32 * 6144 + 16 * kk);
      s0 = MFMA32(k0, q, s0);
      if (tt == 1) s1 = MFMA32(k1, q, s1);
    }
  }
  const int t = 32 * tt + r;
  const float bt = ((const float*)(ws + WS_BT))[ch * 64 + t];
  const float* asp = (const float*)(ws + WS_AS) + ch * 64;
  float den = 0.f;
#pragma unroll
  for (int g = 0; g < 4; ++g) {
    const f32x4 a0 = *(const f32x4*)(asp + 8 * g + 4 * h);
    const f32x4 a1 = *(const f32x4*)(asp + 32 + 8 * g + 4 * h);
#pragma unroll
    for (int e = 0; e < 4; ++e) {
      const int s = 8 * g + 4 * h + e;
      const float w0 = s <= t ? fexp2(bt + a0[e]) : 0.f;
      const float w1 = (32 + s) <= t ? fexp2(bt + a1[e]) : 0.f;
      s0[4 * g + e] *= w0; s1[4 * g + e] *= w1;
      den += s0[4 * g + e] + s1[4 * g + e];
    }
  }
  den += __shfl_xor(den, 32);
  if (vq == 0 && h == 0) ((float*)(ws + WS_DENA))[(size_t)(cc * 64 + t) * 4 + hd] = den;
  bf16x8 pf[2][2];
  pf[0][0] = pack_acc(s0, 0); pf[0][1] = pack_acc(s0, 1); pf[1][0] = pack_acc(s1, 0); pf[1][1] = pack_acc(s1, 1);
  float* Ho = (float*)(ws + WS_HINTRA) + (size_t)(cc * 64 + t) * 1024 + hd * 256;
#pragma unroll
  for (int vt = 0; vt < 2; ++vt) {
    const int v0 = vq * 64 + vt * 32;
    const bf16_t* vp = VT + (ch * 256 + v0 + r) * 64 + 4 * h;
    f32x16 o = zero16();
#pragma unroll
    for (int st = 0; st < 2; ++st)
#pragma unroll
      for (int s2 = 0; s2 < 2; ++s2) {
        const bf16x8 a = ld8x2(vp + 32 * st + 16 * s2, vp + 32 * st + 16 * s2 + 8);
        o = MFMA32(a, pf[st][s2], o);
      }
#pragma unroll
    for (int g = 0; g < 4; ++g) { f32x4 c = {o[4 * g], o[4 * g + 1], o[4 * g + 2], o[4 * g + 3]}; *(f32x4*)(Ho + v0 + 8 * g + 4 * h) = c; }
  }
}

DI void memattn_task(const Params& p, int tile, int layer, const bf16_t* Qb, const bf16_t* Zb, size_t ldq) {
  const int tid = TIDX, lane = tid & 63, wid = tid >> 6, r = lane & 31, h = lane >> 5;
  unsigned char* ws = p.ws;
  const int hd = wid >> 1, tok = tile * 64 + 32 * (wid & 1) + r;
  const int sbi = tile < 256 ? 0 : 1 + (tile - 256);
  const bf16_t* MK = (const bf16_t*)(ws + WS_MEMK) + (size_t)(layer * 17 + sbi) * 131072 + hd * 128;
  const bf16_t* MV = (const bf16_t*)(ws + WS_MEMVT) + ((size_t)(layer * 17 + sbi) * 4 + hd) * 128 * 256;
  bf16x8 qf[8];
  {
    const bf16_t* qp = Qb + (size_t)tok * ldq + hd * 128 + 8 * h;
#pragma unroll
    for (int kk = 0; kk < 8; ++kk) qf[kk] = ld16(qp + 16 * kk);
  }
  const float sc = 0.08838834764831845f * LOG2E;
  f32x16 O[4];
#pragma unroll
  for (int vt = 0; vt < 4; ++vt) O[vt] = zero16();
  float mrun = -1e30f, l = 0.f;
#pragma unroll 1
  for (int kb = 0; kb < 4; ++kb) {
    f32x16 s0 = zero16(), s1 = zero16();
    const bf16_t* kp = MK + (size_t)(kb * 64 + r) * 512 + 8 * h;
#pragma unroll
    for (int kk = 0; kk < 8; ++kk) {
      const bf16x8 k0 = ld16(kp + 16 * kk), k1 = ld16(kp + (size_t)32 * 512 + 16 * kk);
      s0 = MFMA32(k0, qf[kk], s0); s1 = MFMA32(k1, qf[kk], s1);
    }
    float mx = -1e30f;
#pragma unroll
    for (int i = 0; i < 16; ++i) mx = fmaxf(mx, fmaxf(s0[i], s1[i]));
    mx = fmaxf(mx, __shfl_xor(mx, 32)) * sc;
    const float mnew = fmaxf(mrun, mx), alpha = fexp2(mrun - mnew);
    mrun = mnew;
    float sum = 0.f;
#pragma unroll
    for (int i = 0; i < 16; ++i) { s0[i] = fexp2(s0[i] * sc - mnew); s1[i] = fexp2(s1[i] * sc - mnew); sum += s0[i] + s1[i]; }
    l = l * alpha + sum;
#pragma unroll
    for (int vt = 0; vt < 4; ++vt) O[vt] = O[vt] * alpha;
    bf16x8 pf[2][2];
    pf[0][0] = pack_acc(s0, 0); pf[0][1] = pack_acc(s0, 1); pf[1][0] = pack_acc(s1, 0); pf[1][1] = pack_acc(s1, 1);
#pragma unroll
    for (int vt = 0; vt < 4; ++vt) {
      const bf16_t* vp = MV + (size_t)(32 * vt + r) * 256 + kb * 64 + 4 * h;
#pragma unroll
      for (int st = 0; st < 2; ++st)
#pragma unroll
        for (int s2 = 0; s2 < 2; ++s2) {
          const bf16x8 a = ld8x2(vp + 32 * st + 16 * s2, vp + 32 * st + 16 * s2 + 8);
          O[vt] = MFMA32(a, pf[st][s2], O[vt]);
        }
    }
  }
  l += __shfl_xor(l, 32);
  const float inv = 1.f / l;
  const bf16_t* zp = Zb + (size_t)tok * ldq + hd * 128;
  bf16_t* op = (bf16_t*)(ws + WS_AO) + (size_t)tok * 1536 + 1024 + hd * 128;
#pragma unroll
  for (int vt = 0; vt < 4; ++vt)
#pragma unroll
    for (int g = 0; g < 4; ++g) {
      const int v = 32 * vt + 8 * g + 4 * h;
      const u32x2 z = *(const u32x2*)(zp + v);
      const float o0 = O[vt][4 * g] * inv * siluf_(bflo(z[0])), o1 = O[vt][4 * g + 1] * inv * siluf_(bfhi(z[0]));
      const float o2 = O[vt][4 * g + 2] * inv * siluf_(bflo(z[1])), o3 = O[vt][4 * g + 3] * inv * siluf_(bfhi(z[1]));
      u32x2 o = {pk2(o0, o1), pk2(o2, o3)};
      *(u32x2*)(op + v) = o;
    }
}

DI int next_item(unsigned* ctr, unsigned char* lds_flag_area, int tid) {
  __syncthreads();
  int* sh = (int*)lds_flag_area;
  if (tid == 0) *sh = (int)atomicAdd(ctr, 1u);
  __syncthreads();
  const int v = *sh;
  return v;
}

DI void phase2(const Params& p, unsigned char* lds) {
  unsigned* ctr = (unsigned*)(p.ws + WS_CTR) + 0 + 8 * p.pad;
  const bf16_t* PA = (const bf16_t*)(p.ws + WS_R1);
  const int n_ps = 36 * 16, n_ss = 576, n_in = NCH * 4, n_ma = NCH;
  for (;;) {
    const int it = next_item(ctr, lds + LDS_BYTES - 16, TIDX);
    if (it >= n_ps + n_ss + n_in + n_ma) break;
    if (it < n_ps) scan_task(p, lds, -1, (it % 36) / 9, it % 9, it / 36);
    else if (it < n_ps + n_ss) { const int q = it - n_ps; scan_task(p, lds, q / 36, (q % 36) / 9, q % 9, 0); }
    else if (it < n_ps + n_ss + n_in) { const int q = it - n_ps - n_ss; intra_task(p, q >> 2, q & 3); }
    else { const int q = it - n_ps - n_ss - n_in; memattn_task(p, q, 0, PA + 5120, PA + 5632, 6144); }
  }
}


DI void scanfix_task(const Params& p, unsigned char* lds, int grp, int hd, int j) {
  const int tid = TIDX, lane = tid & 63, wid = tid >> 6, r = lane & 31, h = lane >> 5;
  unsigned char* ws = p.ws;
  const bool nsl = j == 8;
  const float* LD = (const float*)(ws + WS_LD);
  f32x16 S = zero16();
  for (int gp = 0; gp < grp; ++gp) {
    const float dg = __expf(LD[(GRP * (gp + 1)) * 4 + hd] - LD[(GRP * gp) * 4 + hd]);
    const float* cl = (const float*)(ws + WS_CLOC) + ((((size_t)(gp * 4 + hd) * 9 + j) * 8 + wid) * 64 + lane) * 16;
#pragma unroll
    for (int g = 0; g < 4; ++g) { const f32x4 c = *(const f32x4*)(cl + 4 * g);
      S[4 * g] = S[4 * g] * dg + c[0]; S[4 * g + 1] = S[4 * g + 1] * dg + c[1]; S[4 * g + 2] = S[4 * g + 2] * dg + c[2]; S[4 * g + 3] = S[4 * g + 3] * dg + c[3]; }
  }
  if (grp == 16) {
    if (!nsl) {
      float* Co = p.out + O_PC + (size_t)hd * 65536 + (size_t)(32 * j + r) * 256 + 32 * wid;
#pragma unroll
      for (int g = 0; g < 4; ++g) { f32x4 c = {S[4 * g], S[4 * g + 1], S[4 * g + 2], S[4 * g + 3]}; *(f32x4*)(Co + 8 * g + 4 * h) = c; }
    } else if (r == 0) {
      float* no = p.out + O_PN + (size_t)hd * 256 + 32 * wid;
#pragma unroll
      for (int g = 0; g < 4; ++g) { f32x4 c = {S[4 * g], S[4 * g + 1], S[4 * g + 2], S[4 * g + 3]}; *(f32x4*)(no + 8 * g + 4 * h) = c; }
    }
    return;
  }
  u32x4* fr = (u32x4*)lds;
  float* tp = (float*)(lds + 16384) + wid * (64 * 33);
  __syncthreads();
  fr[(wid * 2 + 0) * 64 + lane] = __builtin_bit_cast(u32x4, pack_acc(S, 0));
  fr[(wid * 2 + 1) * 64 + lane] = __builtin_bit_cast(u32x4, pack_acc(S, 1));
  __syncthreads();
  bf16x8 xf[8][2];
#pragma unroll
  for (int kt = 0; kt < 8; ++kt) { xf[kt][0] = __builtin_bit_cast(bf16x8, fr[(kt * 2 + 0) * 64 + lane]); xf[kt][1] = __builtin_bit_cast(bf16x8, fr[(kt * 2 + 1) * 64 + lane]); }
  const bf16_t* PA = (const bf16_t*)(ws + WS_R1);
  const float* WIa = (const float*)(ws + WS_WI);
#pragma unroll 1
  for (int ci = 0; ci < 2; ++ci) {
    const int cc = GRP * grp + wid + 8 * ci;
    const float D = __expf(LD[cc * 4 + hd] - LD[(GRP * grp) * 4 + hd]);
#pragma unroll
    for (int tt = 0; tt < 2; ++tt) {
      const bf16_t* qp = PA + (size_t)(cc * 64 + 32 * tt + r) * 6144 + hd * 256 + 4 * h;
      f32x16 z = zero16();
#pragma unroll
      for (int kt = 0; kt < 8; ++kt)
#pragma unroll
        for (int s2 = 0; s2 < 2; ++s2) {
          const bf16x8 q = ld8x2(qp + 32 * kt + 16 * s2, qp + 32 * kt + 16 * s2 + 8);
          z = MFMA32(xf[kt][s2], q, z);
        }
#pragma unroll
      for (int i = 0; i < 16; ++i) tp[(32 * tt + r) * 33 + crow(i, h)] = z[i];
    }
    const int v = lane & 31;
#pragma unroll 4
    for (int e = 0; e < 32; ++e) {
      const int t = 2 * e + (lane >> 5);
      const float val = tp[t * 33 + v] * (WIa[((size_t)cc * 4 + hd) * 64 + t] * D);
      if (!nsl) { float* d = (float*)(ws + WS_HINTER) + (size_t)(cc * 64 + t) * 1024 + hd * 256 + 32 * j + v; *d += val; }
      else if (v == 0) { float* d = (float*)(ws + WS_DENI) + (size_t)(cc * 64 + t) * 4 + hd; *d += val; }
    }
  }
}

DI void phase2c(const Params& p, unsigned char* lds) {
  unsigned* ctr = (unsigned*)(p.ws + WS_CTR) + 3 + 8 * p.pad;
  for (;;) {
    const int it = next_item(ctr, lds + LDS_BYTES - 16, TIDX);
    if (it >= 16 * 36) break;
    const int g = 16 - it / 36;
    scanfix_task(p, lds, g, (it % 36) / 9, it % 9);
  }
}

DI void phase3(const Params& p) {
  const int tid = TIDX, lane = tid & 63, wid = tid >> 6;
  unsigned char* ws = p.ws;
  const int gw = blockIdx.x * 8 + wid, nw = gridDim.x * 8;
  const bf16_t* PA = (const bf16_t*)(ws + WS_R1);
  for (int it = gw; it < TT * 4; it += nw) {
    const int tok = it >> 2, hd = it & 3, cc = tok >> 6, t = tok & 63;
    const size_t off = (size_t)tok * 1024 + hd * 256 + 4 * lane;
    const f32x4 a = *(const f32x4*)((const float*)(ws + WS_HINTER) + off), b = *(const f32x4*)((const float*)(ws + WS_HINTRA) + off);
    const float den = ((const float*)(ws + WS_DENI))[tok * 4 + hd] + ((const float*)(ws + WS_DENA))[tok * 4 + hd];
    const float mt = ((const float*)(ws + WS_MT))[((size_t)cc * 4 + hd) * 64 + t];
    const float dn = 1.f / fmaxf(fabsf(den), __expf(-mt));
    const u32x2 ou = *(const u32x2*)(PA + (size_t)tok * 6144 + 3072 + hd * 256 + 4 * lane);
    const u32x2 zu = *(const u32x2*)(PA + (size_t)tok * 6144 + 4096 + hd * 256 + 4 * lane);
    f32x4 hv = (a + b) * dn;
    hv[0] *= sigmoidf_(bflo(ou[0])); hv[1] *= sigmoidf_(bfhi(ou[0])); hv[2] *= sigmoidf_(bflo(ou[1])); hv[3] *= sigmoidf_(bfhi(ou[1]));
    float ss = hv[0] * hv[0] + hv[1] * hv[1] + hv[2] * hv[2] + hv[3] * hv[3];
    ss = wave_sum(ss);
    const float rstd = __builtin_amdgcn_rsqf(ss * (1.f / 256.f) + EPS);
    const f32x4 hg = *(const f32x4*)(p.in[I_HGA] + hd * 256 + 4 * lane);
    hv = hv * rstd * hg;
    hv[0] *= siluf_(bflo(zu[0])); hv[1] *= siluf_(bfhi(zu[0])); hv[2] *= siluf_(bflo(zu[1])); hv[3] *= siluf_(bfhi(zu[1]));
    u32x2 o = {pk2(hv[0], hv[1]), pk2(hv[2], hv[3])};
    *(u32x2*)((bf16_t*)(ws + WS_AO) + (size_t)tok * 1536 + hd * 256 + 4 * lane) = o;
  }
}

DI void phase_outproj(const Params& p, unsigned char* lds, int layer) {
  const int tid = TIDX, lane = tid & 63, wid = tid >> 6, r = lane & 31, h = lane >> 5, wr = wid >> 1, wc = wid & 1;
  unsigned char* ws = p.ws;
  const bf16_t* W = (const bf16_t*)(ws + (layer == 0 ? WS_WOA : WS_WOB));
  for (int t = blockIdx.x; t < 68 * 8; t += gridDim.x) {
    const int tm = t >> 3, tn = t & 7, m0 = tm * 256, n0 = tn * 128;
    GemmAcc acc;
    gemm_tile((const bf16_t*)(ws + WS_AO) + (size_t)m0 * 1536, 1536, W + (size_t)n0 * 1536, 1536, 1536, lds, acc, tid);
#pragma unroll
    for (int a = 0; a < 2; ++a)
#pragma unroll
      for (int b = 0; b < 2; ++b) {
        const int n = n0 + wc * 64 + 32 * b + r, mb = m0 + wr * 64 + 32 * a;
#pragma unroll
        for (int i = 0; i < 16; ++i) {
          const int m = mb + crow(i, h);
          if (layer == 0) {
            const float xv = m < TP ? p.in[I_XP][(size_t)m * 1024 + n] : p.in[I_XS][(size_t)(m - TP) * 1024 + n];
            ((float*)(ws + WS_Y1))[(size_t)m * 1024 + n] = xv + acc.a[a][b][i];
          } else {
            p.out[O_Y + (size_t)m * 1024 + n] = ((const float*)(ws + WS_Y1))[(size_t)m * 1024 + n] + acc.a[a][b][i];
          }
        }
      }
  }
}

DI void phase5(const Params& p, unsigned char* lds) {
  const int tid = TIDX, lane = tid & 63, wid = tid >> 6;
  unsigned char* ws = p.ws;
  const int gw = blockIdx.x * 8 + wid, nw = gridDim.x * 8;
  for (int r = gw; r < TT; r += nw) {
    f32x4 v[4];
    const float rstd = row_load_rstd((const float*)(ws + WS_Y1) + (size_t)r * 1024, v, lane);
    bf16_t* xn = (bf16_t*)(ws + WS_XN) + (size_t)r * 1024;
#pragma unroll
    for (int j = 0; j < 4; ++j) { const f32x4 xs = v[j] * rstd; u32x2 o = {pk2(xs[0], xs[1]), pk2(xs[2], xs[3])}; *(u32x2*)(xn + 4 * lane + 256 * j) = o; }
  }
  {
    float* smax = (float*)lds;
    const int hm = (tid & 127) >> 3;
    for (int b = 0; b < 16; ++b) {
      __syncthreads();
      if (tid < 16) smax[tid] = 0.f;
      __syncthreads();
      float mx = 0.f;
      const size_t n8 = (size_t)PAST * 1024 / 8;
      const float* src = p.in[I_CK] + (size_t)b * PAST * 1024;
      bf16_t* dst = (bf16_t*)(ws + WS_KBS) + (size_t)b * SKV * 1024;
      for (size_t i = (size_t)blockIdx.x * NTHREADS + tid; i < n8; i += (size_t)gridDim.x * NTHREADS) {
        const size_t e = i * 8;
        const f32x4 a = *(const f32x4*)(src + e), c = *(const f32x4*)(src + e + 4);
        u32x4 o = {pk2(a[0], a[1]), pk2(a[2], a[3]), pk2(c[0], c[1]), pk2(c[2], c[3])};
        *(u32x4*)(dst + e) = o;
        float ss = a[0] * a[0] + a[1] * a[1] + a[2] * a[2] + a[3] * a[3] + c[0] * c[0] + c[1] * c[1] + c[2] * c[2] + c[3] * c[3];
        ss += __shfl_xor(ss, 1); ss += __shfl_xor(ss, 2); ss += __shfl_xor(ss, 4);
        mx = fmaxf(mx, ss);
      }
      if ((tid & 7) == 0) atomicMax((unsigned*)smax + hm, __float_as_uint(mx));
      __syncthreads();
      if (tid < 16) atomicMax((unsigned*)(ws + WS_KMAX) + (1 + b) * 16 + tid, __float_as_uint(sqrtf(smax[tid])));
    }
  }
  __syncthreads();
  for (int t = blockIdx.x; t < 128 * 128; t += gridDim.x) {
    const int jb = t >> 7, tile = t & 127, b = jb >> 3, hd = jb & 7;
    TJob j = {p.in[I_CV] + (size_t)b * PAST * 1024 + hd * 128, 1024, (bf16_t*)(ws + WS_VTS) + ((size_t)(b * 8 + hd) * 128) * SKV, SKV, nullptr, 64, 2};
    run_tjob_tile(j, tile, (float*)lds, tid);
  }
}

DI void phase6(const Params& p, unsigned char* lds) {
  const int tid = TIDX, lane = tid & 63, wid = tid >> 6, r = lane & 31, h = lane >> 5, wr = wid >> 1, wc = wid & 1;
  unsigned char* ws = p.ws;
  for (int t = blockIdx.x; t < 68 * 40; t += gridDim.x) {
    const int tm = t / 40, tn = t % 40, m0 = tm * 256, n0 = tn * 128;
    GemmAcc acc;
    gemm_tile((const bf16_t*)(ws + WS_XN) + (size_t)m0 * 1024, 1024, (const bf16_t*)(ws + WS_WKB) + (size_t)n0 * 1024, 1024, 1024, lds, acc, tid);
    const int sec = n0 >> 10;
    const bool samp = m0 >= TP;
#pragma unroll
    for (int a = 0; a < 2; ++a)
#pragma unroll
      for (int b = 0; b < 2; ++b) {
        const int n = n0 + wc * 64 + 32 * b + r, mb = m0 + wr * 64 + 32 * a;
        if (sec == 0) {
          const int f = n;
          if (b == 1) {
            float mx = 0.f;
#pragma unroll
            for (int i = 0; i < 16; ++i) {
              float ss = acc.a[a][0][i] * acc.a[a][0][i] + acc.a[a][1][i] * acc.a[a][1][i];
              ss += __shfl_xor(ss, 1); ss += __shfl_xor(ss, 2); ss += __shfl_xor(ss, 4); ss += __shfl_xor(ss, 8); ss += __shfl_xor(ss, 16);
              mx = fmaxf(mx, ss);
            }
            mx = fmaxf(mx, __shfl_xor(mx, 32));
            if (lane == 0) {
              const int strm = samp ? 1 + ((mb - TP) >> 6) : 0;
              atomicMax((unsigned*)(ws + WS_KMAX) + strm * 16 + ((n0 + wc * 64) >> 6), __float_as_uint(sqrtf(mx)));
            }
          }
#pragma unroll
          for (int i = 0; i < 16; ++i) {
            const int m = mb + crow(i, h);
            const float v = acc.a[a][b][i];
            if (!samp) { p.out[O_PK + (size_t)m * 1024 + f] = v; ((bf16_t*)(ws + WS_KBP))[(size_t)m * 1024 + f] = f2bf(v); }
            else { const int ms = m - TP, bb = ms >> 6, s = ms & 63; p.out[O_SK + (size_t)ms * 1024 + f] = v;
                   ((bf16_t*)(ws + WS_KBS))[((size_t)bb * SKV + PAST + s) * 1024 + f] = f2bf(v); }
          }
        } else if (sec == 1) {
          const int f = n - 1024, hd = f >> 7, vd = f & 127;
#pragma unroll
          for (int i = 0; i < 16; ++i) {
            const int m = mb + crow(i, h);
            if (!samp) p.out[O_PV + (size_t)m * 1024 + f] = acc.a[a][b][i]; else p.out[O_SV + (size_t)(m - TP) * 1024 + f] = acc.a[a][b][i];
          }
#pragma unroll
          for (int g = 0; g < 4; ++g) {
            const int m = mb + 8 * g + 4 * h;
            u32x2 o = {pk2(acc.a[a][b][4 * g], acc.a[a][b][4 * g + 1]), pk2(acc.a[a][b][4 * g + 2], acc.a[a][b][4 * g + 3])};
            if (!samp) *(u32x2*)((bf16_t*)(ws + WS_VTP) + ((size_t)hd * 128 + vd) * TP + m) = o;
            else { const int ms = m - TP, bb = ms >> 6, s = ms & 63; *(u32x2*)((bf16_t*)(ws + WS_VTS) + ((size_t)(bb * 8 + hd) * 128 + vd) * SKV + PAST + s) = o; }
          }
        } else {
          const float sc = sec == 2 ? 0.125f * LOG2E : 1.f;
          bf16_t* PB = (bf16_t*)(ws + WS_PB);
#pragma unroll
          for (int i = 0; i < 16; ++i) PB[(size_t)(mb + crow(i, h)) * 3072 + (n - 2048)] = f2bf(acc.a[a][b][i] * sc);
        }
      }
  }
}

constexpr int A_KROW = 272, A_VROW = 144, A_KB = 64 * A_KROW, A_BUF = A_KB + 128 * A_VROW, A_FLAGS = 2 * A_BUF;

DI void diffattn_task(const Params& p, unsigned char* lds, int sb  , int qt  , int hd, float lam) {
  const int tid = TIDX, lane = tid & 63, wid = __builtin_amdgcn_readfirstlane(tid >> 6), r = lane & 31, h = lane >> 5;
  unsigned char* ws = p.ws;
  const int cq = wid >> 2, sub = (wid >> 1) & 1, map = wid & 1;
  const int ncq = sb < 0 ? 2 : 1;
  const int base_chunk = sb < 0 ? 2 * qt : 64;
  const int tok0 = sb < 0 ? qt * 128 : TP + sb * 64;
  const bool wvalid = cq < ncq;
  const int qc = base_chunk + cq;
  const int tl = 32 * sub + r;
  const int tok = tok0 + 64 * (wvalid ? cq : 0) + tl;
  const bf16_t* Kb = sb < 0 ? (const bf16_t*)(ws + WS_KBP) + hd * 128 : (const bf16_t*)(ws + WS_KBS) + (size_t)sb * SKV * 1024 + hd * 128;
  const bf16_t* Vb = sb < 0 ? (const bf16_t*)(ws + WS_VTP) + (size_t)hd * 128 * TP : (const bf16_t*)(ws + WS_VTS) + (size_t)(sb * 8 + hd) * 128 * SKV;
  const size_t ldv = sb < 0 ? TP : SKV;
  const bf16_t* PB = (const bf16_t*)(ws + WS_PB);
  bf16x8 qf[4];
  float qn = 0.f;
  {
    const unsigned qo = (unsigned)tok * 3072u + hd * 128 + map * 64 + 8 * h;
#pragma unroll
    for (int kk = 0; kk < 4; ++kk) {
      const u32x4 u = *(const u32x4*)(PB + (qo + 16 * kk));
      qf[kk] = __builtin_bit_cast(bf16x8, u);
#pragma unroll
      for (int e = 0; e < 4; ++e) { const float a = bflo(u[e]), b = bfhi(u[e]); qn += a * a + b * b; }
    }
    qn += __shfl_xor(qn, 32);
    qn = sqrtf(qn);
  }
  const float kmax = ((const float*)(ws + WS_KMAX))[(sb < 0 ? 0 : 1 + sb) * 16 + hd * 2 + map];
  const float sbound = qn * kmax * 1.02f + 0.5f;
  const float sl2 = exp2f(-(float)(hd + 1)) * LOG2E;
  const float bh0 = sl2 * (float)(4 * h), bh1 = bh0 + 32.f * sl2;
  float cs[16];
#pragma unroll
  for (int i = 0; i < 16; ++i) cs[i] = __uint_as_float(__builtin_amdgcn_readfirstlane(__float_as_uint(sl2 * (float)((i & 3) + 8 * (i >> 2)))));
  f32x16 O[4];
#pragma unroll
  for (int vt = 0; vt < 4; ++vt) O[vt] = zero16();
  float mrun = -1e30f, l = 0.f;
  const int jmax = base_chunk + ncq - 1, nit = jmax + 1;
  u32x4 rk[2], rv[2];
  const unsigned kofs = (unsigned)((tid >> 4) * 1024 + (tid & 15) * 8), vofs = (unsigned)((tid >> 3) * (unsigned)ldv + (tid & 7) * 8);
  auto gload = [&](int j) {
    const bf16_t* kj = Kb + (size_t)j * 65536;
    const bf16_t* vj = Vb + (size_t)j * 64;
#pragma unroll
    for (int e = 0; e < 2; ++e) {
      rk[e] = *(const u32x4*)(kj + (kofs + (unsigned)e * 32768u));
      rv[e] = *(const u32x4*)(vj + (vofs + (unsigned)e * 64u * (unsigned)ldv));
    }
  };
  auto lstore = [&](int buf) {
    unsigned char* base = lds + buf * A_BUF;
#pragma unroll
    for (int e = 0; e < 2; ++e) {
      const int id = tid + 512 * e;
      { const int row = id >> 4, c = id & 15; *(u32x4*)(base + row * A_KROW + 16 * c) = rk[e]; }
      { const int row = id >> 3, c = id & 7; unsigned char* d = base + A_KB + row * A_VROW + 32 * (c >> 1) + 8 * (c & 1);
        u32x2 lo = {rv[e][0], rv[e][1]}, hi = {rv[e][2], rv[e][3]}; *(u32x2*)d = lo; *(u32x2*)(d + 16) = hi; }
    }
  };
  int* flags = (int*)(lds + A_FLAGS);
  gload(jmax);
  __syncthreads();
  lstore(0);
  __syncthreads();
  for (int it = 0; it < nit; ++it) {
    const int j = jmax - it;
    if (it + 1 < nit) gload(j - 1);
    bool stop = true;
    if (wvalid && j <= qc) {
      const unsigned char* base = lds + (it & 1) * A_BUF;
      const unsigned char* kp = base + r * A_KROW + map * 128 + 16 * h;
      f32x16 s0, s1;
      {
        float b0 = bh0, b1 = bh1;
        asm volatile("" : "+v"(b0), "+v"(b1));
#pragma unroll
        for (int i = 0; i < 16; ++i) { s0[i] = b0 + cs[i]; s1[i] = b1 + cs[i]; }
      }
      if (j == qc) {
        int tlv = tl;
        asm volatile("" : "+v"(tlv));
        const float m2 = -2.f * sl2;
#pragma unroll
        for (int i = 0; i < 16; ++i) {
          const int s = crow(i, h);
          s0[i] = fmaf(m2, (float)max(0, s - tlv), s0[i]); s1[i] = fmaf(m2, (float)max(0, 32 + s - tlv), s1[i]);
        }
      }
#pragma unroll
      for (int kk = 0; kk < 4; ++kk) {
        const bf16x8 k0 = ld16(kp + 32 * kk), k1 = ld16(kp + 32 * A_KROW + 32 * kk);
        s0 = MFMA32(k0, qf[kk], s0); s1 = MFMA32(k1, qf[kk], s1);
      }
      const float dofs = sl2 * (float)((qc - j) * 64);
      float mx = -1e30f;
#pragma unroll
      for (int i = 0; i < 16; ++i) mx = fmaxf(mx, fmaxf(s0[i], s1[i]));
      mx = fmaxf(mx, __shfl_xor(mx, 32)) - dofs;
      const float mnew = fmaxf(mrun, mx), mm = mnew + dofs;
      if (__builtin_amdgcn_ballot_w64(mnew > mrun) != 0ull) {
        const float alpha = fexp2(mrun - mnew);
        l *= alpha;
#pragma unroll
        for (int vt = 0; vt < 4; ++vt) O[vt] = O[vt] * alpha;
      }
      mrun = mnew;
      float sum = 0.f;
#pragma unroll
      for (int i = 0; i < 16; ++i) { s0[i] = fexp2(s0[i] - mm); s1[i] = fexp2(s1[i] - mm); sum += s0[i] + s1[i]; }
      l += sum;
      bf16x8 pf[2][2];
      pf[0][0] = pack_acc(s0, 0); pf[0][1] = pack_acc(s0, 1); pf[1][0] = pack_acc(s1, 0); pf[1][1] = pack_acc(s1, 1);
      const unsigned char* vbase = base + A_KB + r * A_VROW + 16 * h;
#pragma unroll
      for (int vt = 0; vt < 4; ++vt) {
        const unsigned char* vp = vbase + 32 * vt * A_VROW;
#pragma unroll
        for (int st = 0; st < 2; ++st)
#pragma unroll
          for (int s2 = 0; s2 < 2; ++s2) O[vt] = MFMA32(ld16(vp + 64 * st + 32 * s2), pf[st][s2], O[vt]);
      }
      const float nb = sbound + sl2 * (float)(63 - (qc - j + 1) * 64) - mrun;
      stop = __builtin_amdgcn_ballot_w64(nb >= -152.f) == 0ull;
    } else if (wvalid) stop = false;
    if (lane == 0) flags[(it & 1) * 8 + wid] = stop ? 1 : 0;
    if (it + 1 < nit) lstore((it + 1) & 1);
    __syncthreads();
    {
      const int* f = flags + (it & 1) * 8;
      if ((f[0] & f[1] & f[2] & f[3] & f[4] & f[5] & f[6] & f[7]) != 0) break;
    }
  }
  __syncthreads();
  l += __shfl_xor(l, 32);
  const float inv = wvalid ? 1.f / l : 0.f;
  float* xch = (float*)lds + (size_t)(wid >> 1) * 4096;
  if (map == 1 && wvalid) {
    const float sc = inv * lam;
#pragma unroll
    for (int vt = 0; vt < 4; ++vt)
#pragma unroll
      for (int i = 0; i < 16; ++i) xch[(vt * 16 + i) * 64 + lane] = O[vt][i] * sc;
  }
  __syncthreads();
  if (map == 0 && wvalid) {
    float ss = 0.f;
#pragma unroll
    for (int vt = 0; vt < 4; ++vt)
#pragma unroll
      for (int i = 0; i < 16; ++i) { const float o = O[vt][i] * inv - xch[(vt * 16 + i) * 64 + lane]; O[vt][i] = o; ss += o * o; }
    ss += __shfl_xor(ss, 32);
    const float lam_init = 0.8f - 0.6f * 0.7408182206817179f;
    const float rs = __builtin_amdgcn_rsqf(ss * (1.f / 128.f) + EPS) * (1.f - lam_init);
    const unsigned zo = (unsigned)tok * 3072u + 1024 + hd * 128, oo = (unsigned)tok * 1536u + hd * 128;
    bf16_t* AOp = (bf16_t*)(ws + WS_AO);
    const float* sg = p.in[I_SUBG];
#pragma unroll
    for (int vt = 0; vt < 4; ++vt)
#pragma unroll
      for (int g = 0; g < 4; ++g) {
        const int v = 32 * vt + 8 * g + 4 * h;
        const u32x2 z = *(const u32x2*)(PB + (zo + v));
        const f32x4 gg = *(const f32x4*)(sg + v);
        const float o0 = O[vt][4 * g] * rs * gg[0] * siluf_(bflo(z[0])), o1 = O[vt][4 * g + 1] * rs * gg[1] * siluf_(bfhi(z[0]));
        const float o2 = O[vt][4 * g + 2] * rs * gg[2] * siluf_(bflo(z[1])), o3 = O[vt][4 * g + 3] * rs * gg[3] * siluf_(bfhi(z[1]));
        u32x2 o = {pk2(o0, o1), pk2(o2, o3)};
        *(u32x2*)(AOp + (oo + v)) = o;
      }
  }
  __syncthreads();
}

DI void phase7(const Params& p, unsigned char* lds) {
  unsigned* ctr = (unsigned*)(p.ws + WS_CTR) + 1 + 8 * p.pad;
  const bf16_t* PB = (const bf16_t*)(p.ws + WS_PB);
  float lam;
  {
    const int lane = TIDX & 63;
    const float* lv = p.in[I_LAMB];
    const float a = wave_sum(lv[lane] * lv[64 + lane]), b = wave_sum(lv[128 + lane] * lv[192 + lane]);
    const float lam_init = 0.8f - 0.6f * 0.7408182206817179f;
    lam = __expf(a) - __expf(b) + lam_init;
  }
  const int n_s = 128, n_p = 1024, n_ma = NCH;
  const int* tord = (const int*)(p.ws + WS_TORD);
  for (;;) {
    const int it = next_item(ctr, lds + LDS_BYTES - 16, TIDX);
    if (it >= n_s + n_p) break;
    const int a = tord[it];
    const bool pr = a < n_p;
    diffattn_task(p, lds, pr ? -1 : ((a - n_p) >> 3), pr ? (a >> 3) : 0, a & 7, lam);
  }
  for (;;) {
    const int it = next_item(ctr + 1, lds + LDS_BYTES - 16, TIDX);
    if (it >= n_ma) break;
    memattn_task(p, it, 1, PB + 2048, PB + 2560, 3072);
  }
}

DI void phase9(const Params& p) {
  const int tid = TIDX, lane = tid & 63, wid = tid >> 6;
  const int gw = blockIdx.x * 8 + wid, nw = gridDim.x * 8;
  for (int r = gw; r < TT; r += nw) {
    f32x4 v[4];
    float* row = p.out + O_Y + (size_t)r * 1024;
    const float rstd = row_load_rstd(row, v, lane);
#pragma unroll
    for (int j = 0; j < 4; ++j) {
      const f32x4 g = *(const f32x4*)(p.in[I_FNG] + 4 * lane + 256 * j);
      *(f32x4*)(row + 4 * lane + 256 * j) = v[j] * rstd * g;
    }
  }
}

DI void grid_barrier(unsigned* bar, unsigned target, int tid) {
  __threadfence();
  __syncthreads();
  if (tid == 0) {
    __hip_atomic_fetch_add(bar, 1u, __ATOMIC_RELEASE, __HIP_MEMORY_SCOPE_AGENT);
    while (__hip_atomic_load(bar, __ATOMIC_RELAXED, __HIP_MEMORY_SCOPE_AGENT) < target) __builtin_amdgcn_s_sleep(2);
  }
  __syncthreads();
  __threadfence();
}

__global__ __launch_bounds__(512) void mk(Params pin) {
  extern __shared__ __attribute__((aligned(16))) unsigned char lds[];
  Params p = pin;
  p.wv = __builtin_amdgcn_readfirstlane((int)(__builtin_amdgcn_workitem_id_x() >> 6));
  cg::grid_group grid = cg::this_grid();
  unsigned nbar = 0;
  unsigned* bar = (unsigned*)(p.ws + WS_CTR) + 32;
#define RUN_PHASE(PH, CALL) if (p.ph_lo <= PH && PH < p.ph_hi) { CALL; if (PH + 1 < p.ph_hi) { ++nbar; grid_barrier(bar, nbar * gridDim.x, TIDX); } }
  if (p.ph_lo <= 0 && 0 < p.ph_hi) { phase0(p, lds); if (1 < p.ph_hi) grid.sync(); }
  RUN_PHASE(1, phase1(p, lds))
  RUN_PHASE(2, phase2(p, lds))
  if (p.ph_lo <= 2 && 2 < p.ph_hi) { phase2c(p, lds); ++nbar; grid_barrier(bar, nbar * gridDim.x, TIDX); }
  RUN_PHASE(3, phase3(p))
  RUN_PHASE(4, phase_outproj(p, lds, 0))
  RUN_PHASE(5, phase5(p, lds))
  RUN_PHASE(6, phase6(p, lds))
  RUN_PHASE(7, phase7(p, lds))
  RUN_PHASE(8, phase_outproj(p, lds, 1))
  RUN_PHASE(9, phase9(p))
}

extern "C" void kernel_launch(void* const* d_in, const int* in_sizes, int n_in, void* d_out, int out_size,
                              void* d_ws, size_t ws_size, hipStream_t stream) {
  static int grid_blocks = 0;
  if (!grid_blocks) {
    int dev = 0, cus = 0, per_cu = 0;
    (void)hipGetDevice(&dev);
    (void)hipDeviceGetAttribute(&cus, hipDeviceAttributeMultiprocessorCount, dev);
    (void)hipFuncSetAttribute((const void*)mk, hipFuncAttributeMaxDynamicSharedMemorySize, LDS_BYTES);
    (void)hipOccupancyMaxActiveBlocksPerMultiprocessor(&per_cu, (const void*)mk, NTHREADS, LDS_BYTES);
    grid_blocks = cus;
    fprintf(stderr, "kernel_launch: cus=%d per_cu=%d grid=%d ws=%zu need=%zu\n", cus, per_cu, grid_blocks, ws_size, (size_t)WS_END);
  }
  if (ws_size < WS_END) { fprintf(stderr, "workspace too small\n"); return; }
  Params p{};
  for (int i = 0; i < 24; ++i) p.in[i] = (const float*)d_in[i];
  p.out = (float*)d_out; p.ws = (unsigned char*)d_ws; p.ph_lo = 0; p.ph_hi = NPHASE;
  void* args[] = {&p};
  hipError_t e = hipLaunchCooperativeKernel((const void*)mk, dim3(grid_blocks), dim3(NTHREADS), args, LDS_BYTES, stream);
  if (e != hipSuccess) fprintf(stderr, "cooperative launch failed: %s (grid %d)\n", hipGetErrorString(e), grid_blocks);
  if (PROBE_REP >= 0) {
    Params q = p;
    q.out = (float*)((unsigned char*)d_ws + WS_END); q.ph_lo = PROBE_REP; q.ph_hi = PROBE_REP + 1; q.pad = 1;
    void* args2[] = {&q};
    (void)hipLaunchCooperativeKernel((const void*)mk, dim3(grid_blocks), dim3(NTHREADS), args2, LDS_BYTES, stream);
  }
}
```

```cpp
#include <hip/hip_runtime.h>
#include <hip/hip_cooperative_groups.h>
#include <cstdio>
#include <cstdint>
namespace cg = cooperative_groups;

typedef unsigned short bf16_t;
typedef short bf16x8 __attribute__((ext_vector_type(8)));
typedef short s16x4 __attribute__((ext_vector_type(4)));
typedef float f32x16 __attribute__((ext_vector_type(16)));
typedef float f32x4 __attribute__((ext_vector_type(4)));
typedef float f32x2 __attribute__((ext_vector_type(2)));
typedef __bf16 bf2_t __attribute__((ext_vector_type(2)));
typedef unsigned u32x4 __attribute__((ext_vector_type(4)));
typedef unsigned u32x2 __attribute__((ext_vector_type(2)));
#define DI __device__ __forceinline__
#define MFMA32(a, b, c) __builtin_amdgcn_mfma_f32_32x32x16_bf16((a), (b), (c), 0, 0, 0)

struct Params { const float* in[24]; float* out; unsigned char* ws; int ph_lo, ph_hi; int wv, pad; };
#define TIDX (p.wv * 64 + (int)__builtin_amdgcn_mbcnt_hi(~0u, __builtin_amdgcn_mbcnt_lo(~0u, 0u)))
constexpr int LDS_BYTES = 148480;
constexpr int NTHREADS = 512;
constexpr int NPHASE = 10;
#ifndef PROBE_REP
#define PROBE_REP -1
#endif

constexpr int TP = 16384, TS = 1024, TT = 17408, DM = 1024;
constexpr int NCH = 272;
constexpr int PAST = 4096, SKV = 4160;
constexpr float EPS = 1e-6f;
constexpr float LOG2E = 1.4426950408889634f;
enum { I_XP = 0, I_XS, I_CK, I_CV, I_CMK, I_CMV, I_SC, I_SN, I_SM, I_MEMP, I_NG, I_FNG, I_MNG, I_WMKV, I_WINA, I_BGA, I_HGA, I_WOA,
       I_KVNG, I_WKV, I_WINB, I_LAMB, I_SUBG, I_WOB };
constexpr size_t O_Y = 0, O_PC = 17825792, O_PN = 18087936, O_PM = 18088960, O_PK = 18088964, O_PV = 34866180, O_PMK = 51643396,
                 O_PMV = 51905540, O_SC = 52167684, O_SN = 56361988, O_SM = 56378372, O_SK = 56378436, O_SV = 57427012;
constexpr size_t WS_CTR = 0;
constexpr size_t WS_KMAX = 1024;
constexpr size_t WS_TORD = 8192;
constexpr size_t WS_WA = 16384;
constexpr size_t WS_WOA = WS_WA + (size_t)6144 * 1024 * 2;
constexpr size_t WS_WKB = WS_WOA + (size_t)1024 * 1536 * 2;
constexpr size_t WS_WOB = WS_WKB + (size_t)5120 * 1024 * 2;
constexpr size_t WS_WM = WS_WOB + (size_t)1024 * 1536 * 2;
constexpr size_t WS_MEMN = WS_WM + (size_t)2 * 1024 * 1024 * 2;
constexpr size_t WS_MEMK = WS_MEMN + (size_t)2 * 256 * 1024 * 2;
constexpr size_t WS_MEMVT = WS_MEMK + (size_t)2 * 17 * 256 * 512 * 2;
constexpr size_t WS_GATE = WS_MEMVT + (size_t)2 * 17 * 256 * 512 * 2;
constexpr size_t SZ_CH = (size_t)NCH * 4 * 64 * 4;
constexpr size_t WS_GC = WS_GATE + (size_t)TT * 8 * 4;
constexpr size_t WS_MT = WS_GC + SZ_CH;
constexpr size_t WS_WS = WS_MT + SZ_CH;
constexpr size_t WS_WI = WS_WS + SZ_CH;
constexpr size_t WS_AS = WS_WI + SZ_CH;
constexpr size_t WS_BT = WS_AS + SZ_CH;
constexpr size_t WS_DEC = WS_BT + SZ_CH;
constexpr size_t WS_DENI = WS_DEC + 8192;
constexpr size_t WS_DENA = WS_DENI + (size_t)TT * 4 * 4;
constexpr size_t WS_XN = WS_DENA + (size_t)TT * 4 * 4;
constexpr size_t WS_AO = WS_XN + (size_t)TT * 1024 * 2;
constexpr size_t WS_Y1 = WS_AO + (size_t)TT * 1536 * 2;
constexpr size_t WS_KT = WS_Y1 + (size_t)TT * 1024 * 4;
constexpr size_t WS_VTA = WS_KT + (size_t)NCH * 4 * 256 * 64 * 2;
constexpr size_t WS_R1 = WS_VTA + (size_t)NCH * 4 * 256 * 64 * 2;
constexpr size_t SZ_R1 = (size_t)TT * 6144 * 2;
constexpr size_t WS_PB = WS_R1;
constexpr size_t WS_KBP = WS_PB + (size_t)TT * 3072 * 2;
constexpr size_t WS_VTP = WS_KBP + (size_t)TP * 1024 * 2;
constexpr size_t WS_R2 = WS_R1 + SZ_R1;
constexpr size_t WS_HINTER = WS_R2;
constexpr size_t WS_HINTRA = WS_R2 + (size_t)TT * 1024 * 4;
constexpr size_t WS_KBS = WS_R2;
constexpr size_t WS_VTS = WS_KBS + (size_t)16 * SKV * 1024 * 2;
constexpr size_t WS_LD = WS_VTS + (size_t)16 * SKV * 1024 * 2;
constexpr size_t WS_CLOC = WS_LD + 8192;
constexpr size_t WS_END = WS_CLOC + (size_t)16 * 36 * 8 * 64 * 16 * 4;
constexpr int GRP = 16;
static_assert(WS_VTP + (size_t)TP * 1024 * 2 <= WS_R2, "R1 overflow");

DI unsigned pk2(float lo, float hi) { f32x2 v = {lo, hi}; return __builtin_bit_cast(unsigned, __builtin_convertvector(v, bf2_t)); }
DI bf16_t f2bf(float x) { return (bf16_t)(pk2(x, 0.f) & 0xffffu); }
DI float bf2f(unsigned v16) { return __uint_as_float(v16 << 16); }
DI float bflo(unsigned u) { return __uint_as_float(u << 16); }
DI float bfhi(unsigned u) { return __uint_as_float(u & 0xffff0000u); }
DI float rbf(float x) { return bflo(pk2(x, 0.f) & 0xffffu); }
DI int crow(int i, int h) { return (i & 3) + 8 * (i >> 2) + 4 * h; }
DI float wave_sum(float v) {
#pragma unroll
  for (int o = 32; o >= 1; o >>= 1) v += __shfl_xor(v, o);
  return v;
}
DI float fexp2(float x) { return __builtin_amdgcn_exp2f(x); }
DI float fexp(float x) { return __builtin_amdgcn_exp2f(x * LOG2E); }
DI float sigmoidf_(float x) { return 1.f / (1.f + __expf(-x)); }
DI float siluf_(float x) { return x / (1.f + __expf(-x)); }
DI bf16x8 pack_acc(const f32x16& x, int s) {
  u32x4 p;
  p[0] = pk2(x[8 * s + 0], x[8 * s + 1]); p[1] = pk2(x[8 * s + 2], x[8 * s + 3]);
  p[2] = pk2(x[8 * s + 4], x[8 * s + 5]); p[3] = pk2(x[8 * s + 6], x[8 * s + 7]);
  return __builtin_bit_cast(bf16x8, p);
}
DI bf16x8 ld16(const void* p) { return *(const bf16x8*)p; }
DI bf16x8 ld8x2(const void* p0, const void* p1) {
  u32x2 a = *(const u32x2*)p0, b = *(const u32x2*)p1; u32x4 r = {a[0], a[1], b[0], b[1]};
  return __builtin_bit_cast(bf16x8, r);
}
DI f32x16 zero16() { f32x16 z; for (int i = 0; i < 16; ++i) z[i] = 0.f; return z; }

DI void transpose_tile(const float* __restrict__ src, size_t ld_s, bf16_t* __restrict__ dst, size_t ld_d, const float* __restrict__ scale,
                       float* scr, int t) {
  {
    const int c4 = t & 15, rb = t >> 4;
#pragma unroll
    for (int i = 0; i < 2; ++i) {
      const int r = rb + 32 * i;
      f32x4 v = *(const f32x4*)(src + (size_t)r * ld_s + 4 * c4);
      if (scale) { const float s = scale[r]; v = v * s; }
      float* d = scr + r * 65 + 4 * c4; d[0] = v[0]; d[1] = v[1]; d[2] = v[2]; d[3] = v[3];
    }
  }
  __syncthreads();
  {
    const int c = t >> 3, rg = t & 7;
    const float* s = scr + (8 * rg) * 65 + c;
    u32x4 o; o[0] = pk2(s[0], s[65]); o[1] = pk2(s[2 * 65], s[3 * 65]); o[2] = pk2(s[4 * 65], s[5 * 65]); o[3] = pk2(s[6 * 65], s[7 * 65]);
    *(u32x4*)(dst + (size_t)c * ld_d + 8 * rg) = o;
  }
  __syncthreads();
}

struct TJob { const float* src; size_t ld_s; bf16_t* dst; size_t ld_d; const float* scale; int tr, tc; };

DI void run_tjob_tile(const TJob& j, int tile, float* scr, int tid) {
  const int ir = tile / j.tc, ic = tile % j.tc;
  transpose_tile(j.src + (size_t)(64 * ir) * j.ld_s + 64 * ic, j.ld_s, j.dst + (size_t)(64 * ic) * j.ld_d + 64 * ir, j.ld_d,
                 j.scale ? j.scale + 64 * ir : nullptr, scr, tid);
}

DI float row_load_rstd(const float* xrow, f32x4 (&v)[4], int lane) {
  float ss = 0.f;
#pragma unroll
  for (int j = 0; j < 4; ++j) { v[j] = *(const f32x4*)(xrow + 4 * lane + 256 * j); ss += v[j][0] * v[j][0] + v[j][1] * v[j][1] + v[j][2] * v[j][2] + v[j][3] * v[j][3]; }
  ss = wave_sum(ss);
  return __builtin_amdgcn_rsqf(ss * (1.f / 1024.f) + EPS);
}

DI int diff_est(int a) {
  const int hd = a & 7;
  const int w = hd == 0 ? 5 : hd == 1 ? 9 : hd == 2 ? 16 : hd == 3 ? 31 : hd == 4 ? 60 : hd == 5 ? 119 : hd == 6 ? 237 : 256;
  const int n = a < 1024 ? 2 * (a >> 3) + 2 : 65;
  return n < w ? n : w;
}

DI void phase0(const Params& p, unsigned char* lds) {
  const int tid = TIDX, lane = tid & 63, wid = tid >> 6;
  unsigned char* ws = p.ws;
  if (blockIdx.x == 0 && tid < 64) ((unsigned*)(ws + WS_CTR))[tid] = 0u;
  if (blockIdx.x == 0 && tid < 272) ((unsigned*)(ws + WS_KMAX))[tid] = 0u;
  if (blockIdx.x == 1) {
    int* est = (int*)lds;
    for (int a = tid; a < 1152; a += NTHREADS) est[a] = diff_est(a);
    __syncthreads();
    for (int a = tid; a < 1152; a += NTHREADS) {
      const int ea = est[a];
      int rank = 0;
      for (int b = 0; b < 1152; ++b) { const int eb = est[b]; rank += (eb > ea) || (eb == ea && b < a); }
      ((int*)(ws + WS_TORD))[rank] = a;
    }
    __syncthreads();
  }
  {
    TJob jobs[8];
    jobs[0] = {p.in[I_WINA], 6152, (bf16_t*)(ws + WS_WA), 1024, p.in[I_NG], 16, 80};
    jobs[1] = {p.in[I_WINA] + 5128, 6152, (bf16_t*)(ws + WS_WA) + (size_t)5120 * 1024, 1024, p.in[I_NG], 16, 16};
    jobs[2] = {p.in[I_WOA], 1024, (bf16_t*)(ws + WS_WOA), 1536, nullptr, 24, 16};
    jobs[3] = {p.in[I_WKV], 2048, (bf16_t*)(ws + WS_WKB), 1024, p.in[I_KVNG], 16, 32};
    jobs[4] = {p.in[I_WINB], 3072, (bf16_t*)(ws + WS_WKB) + (size_t)2048 * 1024, 1024, p.in[I_NG] + 1024, 16, 48};
    jobs[5] = {p.in[I_WOB], 1024, (bf16_t*)(ws + WS_WOB), 1536, nullptr, 24, 16};
    jobs[6] = {p.in[I_WMKV], 1024, (bf16_t*)(ws + WS_WM), 1024, nullptr, 16, 16};
    jobs[7] = {p.in[I_WMKV] + (size_t)1024 * 1024, 1024, (bf16_t*)(ws + WS_WM) + (size_t)1024 * 1024, 1024, nullptr, 16, 16};
    int base = 0;
#pragma unroll
    for (int j = 0; j < 8; ++j) {
      const int n = jobs[j].tr * jobs[j].tc;
      for (int t = blockIdx.x; t < n; t += gridDim.x) run_tjob_tile(jobs[j], t, (float*)lds, tid);
      base += n;
    }
    for (int t = blockIdx.x; t < 128 * 8; t += gridDim.x) {
      const int jb = t >> 3, tile = t & 7, l = jb >> 6, b = (jb >> 2) & 15, h = jb & 3;
      TJob j = {p.in[I_CMV] + ((size_t)(l * 16 + b) * 256) * 512 + h * 128, 512,
                (bf16_t*)(ws + WS_MEMVT) + ((size_t)(l * 17 + 1 + b) * 4 + h) * 128 * 256, 256, nullptr, 4, 2};
      run_tjob_tile(j, tile, (float*)lds, tid);
    }
  }
  {
    const size_t n8 = (size_t)2 * 16 * 256 * 512 / 8;
    for (size_t i = (size_t)blockIdx.x * NTHREADS + tid; i < n8; i += (size_t)gridDim.x * NTHREADS) {
      const size_t e = i * 8; const int l = (int)(e / ((size_t)16 * 131072)); const size_t rem = e - (size_t)l * 16 * 131072;
      const f32x4 a = *(const f32x4*)(p.in[I_CMK] + e), b = *(const f32x4*)(p.in[I_CMK] + e + 4);
      u32x4 o = {pk2(a[0], a[1]), pk2(a[2], a[3]), pk2(b[0], b[1]), pk2(b[2], b[3])};
      *(u32x4*)((bf16_t*)(ws + WS_MEMK) + ((size_t)(l * 17 + 1) * 131072) + rem) = o;
    }
  }
  {
    const int gw = blockIdx.x * 8 + wid, nw = gridDim.x * 8;
    const float* ng = p.in[I_NG];
    for (int r = gw; r < TT; r += nw) {
      const float* xrow = r < TP ? p.in[I_XP] + (size_t)r * 1024 : p.in[I_XS] + (size_t)(r - TP) * 1024;
      f32x4 v[4];
      const float rstd = row_load_rstd(xrow, v, lane);
      float gacc[8];
#pragma unroll
      for (int c = 0; c < 8; ++c) gacc[c] = 0.f;
      bf16_t* xn = (bf16_t*)(ws + WS_XN) + (size_t)r * 1024;
#pragma unroll
      for (int j = 0; j < 4; ++j) {
        const int k0 = 4 * lane + 256 * j;
        const f32x4 xs = v[j] * rstd;
        u32x2 o = {pk2(xs[0], xs[1]), pk2(xs[2], xs[3])};
        *(u32x2*)(xn + k0) = o;
        const f32x4 g = *(const f32x4*)(ng + k0);
#pragma unroll
        for (int e = 0; e < 4; ++e) {
          const float xg = xs[e] * g[e];
          const float* wr = p.in[I_WINA] + (size_t)(k0 + e) * 6152 + 5120;
          const f32x4 w0 = *(const f32x4*)wr, w1 = *(const f32x4*)(wr + 4);
          gacc[0] += xg * w0[0]; gacc[1] += xg * w0[1]; gacc[2] += xg * w0[2]; gacc[3] += xg * w0[3];
          gacc[4] += xg * w1[0]; gacc[5] += xg * w1[1]; gacc[6] += xg * w1[2]; gacc[7] += xg * w1[3];
        }
      }
#pragma unroll
      for (int c = 0; c < 8; ++c) gacc[c] = wave_sum(gacc[c]);
      if (lane < 8) {
        float gv = gacc[0];
#pragma unroll
        for (int c = 1; c < 8; ++c) gv = lane == c ? gacc[c] : gv;
        gv += p.in[I_BGA][lane];
        if (lane >= 4) gv = fminf(gv, 0.f) - log1pf(__expf(-fabsf(gv)));
        ((float*)(ws + WS_GATE))[(size_t)r * 8 + lane] = gv;
      }
    }
    for (int r = gw; r < 512; r += nw) {
      const int l = r >> 8, rr = r & 255;
      f32x4 v[4];
      const float rstd = row_load_rstd(p.in[I_MEMP] + (size_t)rr * 1024, v, lane);
      bf16_t* o = (bf16_t*)(ws + WS_MEMN) + (size_t)r * 1024;
#pragma unroll
      for (int j = 0; j < 4; ++j) {
        const int k0 = 4 * lane + 256 * j;
        const f32x4 g = *(const f32x4*)(p.in[I_MNG] + l * 1024 + k0);
        const f32x4 xs = v[j] * rstd * g;
        u32x2 ov = {pk2(xs[0], xs[1]), pk2(xs[2], xs[3])};
        *(u32x2*)(o + k0) = ov;
      }
    }
  }
}

constexpr int G_STAGE = 49152;
struct GemmAcc { f32x16 a[2][2]; };
DI void dma16(const void* g, unsigned char* l) { __builtin_amdgcn_global_load_lds((const unsigned*)g, (unsigned*)l, 16, 0, 0); }

DI void gemm_tile(const bf16_t* __restrict__ A, size_t lda, const bf16_t* __restrict__ Bt, size_t ldb, int K, unsigned char* lds, GemmAcc& acc, int tid) {
  const int lane = tid & 63, wid = __builtin_amdgcn_readfirstlane(tid >> 6), r = lane & 31, h = lane >> 5;
  const int wr = wid >> 1, wc = wid & 1;
#pragma unroll
  for (int a = 0; a < 2; ++a)
#pragma unroll
    for (int b = 0; b < 2; ++b) acc.a[a][b] = zero16();
  const int nk = K / 64;
  unsigned aoff[4], boff[2];
#pragma unroll
  for (int e = 0; e < 4; ++e) { const int row = 8 * (wid * 4 + e) + (lane >> 3), lc = (lane & 7) ^ ((row >> 1) & 7); aoff[e] = (unsigned)row * (unsigned)lda + 8u * lc; }
#pragma unroll
  for (int e = 0; e < 2; ++e) { const int row = 8 * (wid * 2 + e) + (lane >> 3), lc = (lane & 7) ^ ((row >> 1) & 7); boff[e] = (unsigned)row * (unsigned)ldb + 8u * lc; }
  auto issue = [&](int kt, int buf) {
    unsigned char* base = lds + buf * G_STAGE;
#pragma unroll
    for (int e = 0; e < 4; ++e) dma16(A + (aoff[e] + 64u * kt), base + (wid * 4 + e) * 1024);
#pragma unroll
    for (int e = 0; e < 2; ++e) dma16(Bt + (boff[e] + 64u * kt), base + 32768 + (wid * 2 + e) * 1024);
  };
  asm volatile("s_waitcnt vmcnt(0)" ::: "memory");
  __syncthreads();
  issue(0, 0);
  if (nk > 1) issue(1, 1);
  const unsigned sw = (r >> 1) & 7;
  unsigned co[4];
#pragma unroll
  for (int kk = 0; kk < 4; ++kk) co[kk] = (((2 * kk + h) ^ sw) << 4);
  const unsigned ra = (wr * 64 + r) * 128, rb = 32768 + (wc * 64 + r) * 128;
  for (int kt = 0; kt < nk; ++kt) {
    if (kt + 1 < nk) asm volatile("s_waitcnt vmcnt(6)" ::: "memory"); else asm volatile("s_waitcnt vmcnt(0)" ::: "memory");
    asm volatile("s_waitcnt lgkmcnt(0)" ::: "memory");
    __builtin_amdgcn_s_barrier();
    if (kt + 2 < nk) issue(kt + 2, (kt + 2) % 3);
    const unsigned char* base = lds + (kt % 3) * G_STAGE;
    const unsigned char* pa = base + ra;
    const unsigned char* pb = base + rb;
#pragma unroll
    for (int kk = 0; kk < 4; ++kk) {
      const bf16x8 a0 = ld16(pa + co[kk]), a1 = ld16(pa + 4096 + co[kk]);
      const bf16x8 b0 = ld16(pb + co[kk]), b1 = ld16(pb + 4096 + co[kk]);
      acc.a[0][0] = MFMA32(a0, b0, acc.a[0][0]);
      acc.a[0][1] = MFMA32(a0, b1, acc.a[0][1]);
      acc.a[1][0] = MFMA32(a1, b0, acc.a[1][0]);
      acc.a[1][1] = MFMA32(a1, b1, acc.a[1][1]);
    }
  }
}

DI void gate_scan(const Params& p, unsigned char* lds) {
  const int tid = TIDX, lane = tid & 63, wid = tid >> 6;
  unsigned char* ws = p.ws;
  const float* gate = (const float*)(ws + WS_GATE);
  float* s_gl = (float*)lds;
  float* s_A = s_gl + NCH * 4;
  float* s_mc = s_A + NCH * 4;
  float* s_mn = s_mc + NCH * 4;
  __syncthreads();
  for (int pr = wid; pr < NCH * 4; pr += 8) {
    const int cc = pr >> 2, hd = pr & 3;
    const float ig = gate[(size_t)(cc * 64 + lane) * 8 + hd], lf = gate[(size_t)(cc * 64 + lane) * 8 + 4 + hd];
    float g = lf;
#pragma unroll
    for (int o = 1; o < 64; o <<= 1) { const float t = __shfl_up(g, o); if (lane >= o) g += t; }
    float a = ig - g;
#pragma unroll
    for (int o = 32; o >= 1; o >>= 1) a = fmaxf(a, __shfl_xor(a, o));
    const float gl = __shfl(g, 63);
    if (lane == 0) { s_gl[pr] = gl; s_A[pr] = a; }
  }
  __syncthreads();
  if (tid < 4) {
    float m = 0.f;
    float ld = 0.f;
    float* LD = (float*)(ws + WS_LD);
    for (int c = 0; c < 256; ++c) {
      s_mc[c * 4 + tid] = m; LD[c * 4 + tid] = ld;
      const float mn = s_gl[c * 4 + tid] + fmaxf(m, s_A[c * 4 + tid]);
      ld += s_gl[c * 4 + tid] + m - mn;
      m = mn; s_mn[c * 4 + tid] = m;
    }
    LD[256 * 4 + tid] = ld;
    p.out[O_PM + tid] = m;
  } else if (tid >= 64 && tid < 128) {
    const int b = (tid - 64) >> 2, hd = tid & 3, pr = (256 + b) * 4 + hd;
    const float m0 = p.in[I_SM][b * 4 + hd];
    const float m = s_gl[pr] + fmaxf(m0, s_A[pr]);
    s_mc[pr] = m0; s_mn[pr] = m;
    p.out[O_SM + b * 4 + hd] = m;
  }
  __syncthreads();
  for (int pr = wid; pr < NCH * 4; pr += 8) {
    const int cc = pr >> 2, hd = pr & 3;
    const float ig = gate[(size_t)(cc * 64 + lane) * 8 + hd], lf = gate[(size_t)(cc * 64 + lane) * 8 + 4 + hd];
    float g = lf;
#pragma unroll
    for (int o = 1; o < 64; o <<= 1) { const float t = __shfl_up(g, o); if (lane >= o) g += t; }
    const float a = ig - g;
    float pm = a;
#pragma unroll
    for (int o = 1; o < 64; o <<= 1) { const float t = __shfl_up(pm, o); if (lane >= o) pm = fmaxf(pm, t); }
    const float mc = s_mc[pr], mn = s_mn[pr], gl = s_gl[pr];
    const float mt = g + fmaxf(mc, pm);
    const size_t o = (size_t)pr * 64 + lane;
    ((float*)(ws + WS_GC))[o] = g;
    ((float*)(ws + WS_MT))[o] = mt;
    ((float*)(ws + WS_WS))[o] = __expf(gl - g + ig - mn);
    ((float*)(ws + WS_WI))[o] = __expf(g + mc - mt);
    ((float*)(ws + WS_AS))[o] = (ig - g) * LOG2E;
    ((float*)(ws + WS_BT))[o] = (g - mt) * LOG2E;
    if (lane == 0) ((float*)(ws + WS_DEC))[pr] = __expf(gl + mc - mn);
  }
  __syncthreads();
}

DI void phase1(const Params& p, unsigned char* lds) {
  const int tid = TIDX, lane = tid & 63, wid = tid >> 6, r = lane & 31, h = lane >> 5, wr = wid >> 1, wc = wid & 1;
  unsigned char* ws = p.ws;
  if (blockIdx.x == gridDim.x - 1) gate_scan(p, lds);
  const int n_main = 68 * 48, n_mem = 16;
  for (int t = blockIdx.x; t < n_main + n_mem; t += gridDim.x) {
    GemmAcc acc;
    if (t < n_main) {
      const int tm = t / 48, tn = t % 48, m0 = tm * 256, n0 = tn * 128;
      gemm_tile((const bf16_t*)(ws + WS_XN) + (size_t)m0 * 1024, 1024, (const bf16_t*)(ws + WS_WA) + (size_t)n0 * 1024, 1024, 1024, lds, acc, tid);
      bf16_t* PA = (bf16_t*)(ws + WS_R1);
      const int sec = n0 >> 10;
#pragma unroll
      for (int a = 0; a < 2; ++a)
#pragma unroll
        for (int b = 0; b < 2; ++b) {
          __builtin_amdgcn_sched_barrier(0);
          const int n = n0 + wc * 64 + 32 * b + r, mb = m0 + wr * 64 + 32 * a;
          if (sec != 2) {
            const float sc = sec == 1 ? 0.0625f : 1.f;
#pragma unroll
            for (int i = 0; i < 16; ++i) PA[(size_t)(mb + crow(i, h)) * 6144 + n] = f2bf(acc.a[a][b][i] * sc);
          }
          if (sec == 1 || sec == 2) {
            const float sc = sec == 1 ? 0.0625f : 1.f;
            const int f = n & 1023, hd = f >> 8, fe = f & 255;
            bf16_t* T = (bf16_t*)(ws + (sec == 1 ? WS_KT : WS_VTA));
#pragma unroll
            for (int g = 0; g < 4; ++g) {
              const int m = mb + 8 * g + 4 * h, cc = m >> 6, s = m & 63;
              u32x2 o = {pk2(acc.a[a][b][4 * g] * sc, acc.a[a][b][4 * g + 1] * sc), pk2(acc.a[a][b][4 * g + 2] * sc, acc.a[a][b][4 * g + 3] * sc)};
              *(u32x2*)(T + (((size_t)cc * 4 + hd) * 256 + fe) * 64 + s) = o;
            }
          }
        }
    } else {
      const int tt = t - n_main, l = tt >> 3, n0 = (tt & 7) * 128;
      gemm_tile((const bf16_t*)(ws + WS_MEMN) + (size_t)l * 256 * 1024, 1024, (const bf16_t*)(ws + WS_WM) + ((size_t)l * 1024 + n0) * 1024, 1024, 1024, lds, acc, tid);
      const bool isv = n0 >= 512;
      float* of = p.out + (isv ? O_PMV : O_PMK) + (size_t)l * 131072;
      bf16_t* mk = (bf16_t*)(ws + WS_MEMK) + (size_t)(l * 17) * 131072;
      bf16_t* mv = (bf16_t*)(ws + WS_MEMVT) + (size_t)(l * 17) * 131072;
#pragma unroll
      for (int a = 0; a < 2; ++a)
#pragma unroll
        for (int b = 0; b < 2; ++b) {
          __builtin_amdgcn_sched_barrier(0);
          const int f = (n0 & 511) + wc * 64 + 32 * b + r, mb = wr * 64 + 32 * a;
#pragma unroll
          for (int g = 0; g < 4; ++g) {
            const int m = mb + 8 * g + 4 * h;
            float* o4 = of + (size_t)m * 512 + f;
            o4[0] = acc.a[a][b][4 * g]; o4[512] = acc.a[a][b][4 * g + 1]; o4[1024] = acc.a[a][b][4 * g + 2]; o4[1536] = acc.a[a][b][4 * g + 3];
            if (!isv) {
              bf16_t* k4 = mk + (size_t)m * 512 + f;
              k4[0] = f2bf(acc.a[a][b][4 * g]); k4[512] = f2bf(acc.a[a][b][4 * g + 1]); k4[1024] = f2bf(acc.a[a][b][4 * g + 2]); k4[1536] = f2bf(acc.a[a][b][4 * g + 3]);
            } else {
              u32x2 o = {pk2(acc.a[a][b][4 * g], acc.a[a][b][4 * g + 1]), pk2(acc.a[a][b][4 * g + 2], acc.a[a][b][4 * g + 3])};
              *(u32x2*)(mv + (size_t)f * 256 + m) = o;
            }
          }
        }
    }
  }
}

DI void scan_task(const Params& p, unsigned char* lds, int sb  , int hd, int j, int grp) {
  const int tid = TIDX, lane = tid & 63, wid = tid >> 6, r = lane & 31, h = lane >> 5;
  unsigned char* ws = p.ws;
  const int cc0 = sb < 0 ? GRP * grp : 256 + sb, nch = sb < 0 ? GRP : 1;
  const bf16_t* PA = (const bf16_t*)(ws + WS_R1);
  const bf16_t* KT = (const bf16_t*)(ws + WS_KT);
  const bf16_t* VT = (const bf16_t*)(ws + WS_VTA);
  const float* WSa = (const float*)(ws + WS_WS);
  const float* WIa = (const float*)(ws + WS_WI);
  const float* DEC = (const float*)(ws + WS_DEC);
  float* red = (float*)lds;
  const bool nsl = j == 8;
  f32x16 S = zero16();
  if (sb >= 0) {
    if (!nsl) {
      const float* C0 = p.in[I_SC] + ((size_t)(sb * 4 + hd) * 256 + 32 * j + r) * 256 + 32 * wid;
#pragma unroll
      for (int g = 0; g < 4; ++g) { const f32x4 c = *(const f32x4*)(C0 + 8 * g + 4 * h); S[4 * g] = c[0]; S[4 * g + 1] = c[1]; S[4 * g + 2] = c[2]; S[4 * g + 3] = c[3]; }
    } else if (r == 0) {
      const float* n0 = p.in[I_SN] + (size_t)(sb * 4 + hd) * 256 + 32 * wid;
#pragma unroll
      for (int g = 0; g < 4; ++g) { const f32x4 c = *(const f32x4*)(n0 + 8 * g + 4 * h); S[4 * g] = c[0]; S[4 * g + 1] = c[1]; S[4 * g + 2] = c[2]; S[4 * g + 3] = c[3]; }
    }
  }
  bf16x8 kt[4], wv[4], qf[2][2];
  auto loadc = [&](int cc) {
    const size_t ch = (size_t)cc * 4 + hd;
    const bf16_t* kp = KT + (ch * 256 + 32 * wid + r) * 64 + 8 * h;
#pragma unroll
    for (int st = 0; st < 4; ++st) kt[st] = ld16(kp + 16 * st);
    const float* wsp = WSa + ch * 64 + 8 * h;
    if (!nsl) {
      const bf16_t* vp = VT + (ch * 256 + 32 * j + r) * 64 + 8 * h;
#pragma unroll
      for (int st = 0; st < 4; ++st) {
        const u32x4 v = *(const u32x4*)(vp + 16 * st);
        const f32x4 w0 = *(const f32x4*)(wsp + 16 * st), w1 = *(const f32x4*)(wsp + 16 * st + 4);
        u32x4 o;
        o[0] = pk2(bflo(v[0]) * w0[0], bfhi(v[0]) * w0[1]); o[1] = pk2(bflo(v[1]) * w0[2], bfhi(v[1]) * w0[3]);
        o[2] = pk2(bflo(v[2]) * w1[0], bfhi(v[2]) * w1[1]); o[3] = pk2(bflo(v[3]) * w1[2], bfhi(v[3]) * w1[3]);
        wv[st] = __builtin_bit_cast(bf16x8, o);
      }
    } else {
#pragma unroll
      for (int st = 0; st < 4; ++st) {
        const f32x4 w0 = *(const f32x4*)(wsp + 16 * st), w1 = *(const f32x4*)(wsp + 16 * st + 4);
        u32x4 o = {pk2(w0[0], w0[1]), pk2(w0[2], w0[3]), pk2(w1[0], w1[1]), pk2(w1[2], w1[3])};
        if (r != 0) o = (u32x4){0u, 0u, 0u, 0u};
        wv[st] = __builtin_bit_cast(bf16x8, o);
      }
    }
#pragma unroll
    for (int tt = 0; tt < 2; ++tt) {
      const bf16_t* qp = PA + (size_t)(cc * 64 + 32 * tt + r) * 6144 + hd * 256 + 32 * wid + 4 * h;
#pragma unroll
      for (int s2 = 0; s2 < 2; ++s2) qf[tt][s2] = ld8x2(qp + 16 * s2, qp + 16 * s2 + 8);
    }
  };
  for (int c = 0; c < nch; ++c) {
    const int cc = cc0 + c;
    loadc(cc);
    const float dec = DEC[cc * 4 + hd];
    const bf16x8 xs0 = pack_acc(S, 0), xs1 = pack_acc(S, 1);
    f32x16 z0 = MFMA32(xs0, qf[0][0], zero16()); z0 = MFMA32(xs1, qf[0][1], z0);
    f32x16 z1 = MFMA32(xs0, qf[1][0], zero16()); z1 = MFMA32(xs1, qf[1][1], z1);
    S = S * dec;
#pragma unroll
    for (int st = 0; st < 4; ++st) S = MFMA32(kt[st], wv[st], S);
    __syncthreads();
    {
      float* rw = red + wid * (64 * 33);
#pragma unroll
      for (int i = 0; i < 16; ++i) { rw[r * 33 + crow(i, h)] = z0[i]; rw[(32 + r) * 33 + crow(i, h)] = z1[i]; }
    }
    __syncthreads();
    {
      const int v = tid & 31;
#pragma unroll
      for (int e = 0; e < 4; ++e) {
        const int t = (tid >> 5) + 16 * e;
        float s = 0.f;
#pragma unroll
        for (int w8 = 0; w8 < 8; ++w8) s += red[w8 * (64 * 33) + t * 33 + v];
        const float wi = WIa[((size_t)cc * 4 + hd) * 64 + t];
        if (!nsl) ((float*)(ws + WS_HINTER))[(size_t)(cc * 64 + t) * 1024 + hd * 256 + 32 * j + v] = s * wi;
        else if (v == 0) ((float*)(ws + WS_DENI))[(size_t)(cc * 64 + t) * 4 + hd] = s * wi;
      }
    }
  }
  if (sb < 0) {
    float* cl = (float*)(ws + WS_CLOC) + ((((size_t)(grp * 4 + hd) * 9 + j) * 8 + wid) * 64 + lane) * 16;
#pragma unroll
    for (int g = 0; g < 4; ++g) { f32x4 c = {S[4 * g], S[4 * g + 1], S[4 * g + 2], S[4 * g + 3]}; *(f32x4*)(cl + 4 * g) = c; }
  } else {
    if (!nsl) {
      float* Co = (sb < 0 ? p.out + O_PC + (size_t)hd * 65536 : p.out + O_SC + (size_t)(sb * 4 + hd) * 65536) + (size_t)(32 * j + r) * 256 + 32 * wid;
#pragma unroll
      for (int g = 0; g < 4; ++g) { f32x4 c = {S[4 * g], S[4 * g + 1], S[4 * g + 2], S[4 * g + 3]}; *(f32x4*)(Co + 8 * g + 4 * h) = c; }
    } else if (r == 0) {
      float* no = (sb < 0 ? p.out + O_PN + (size_t)hd * 256 : p.out + O_SN + (size_t)(sb * 4 + hd) * 256) + 32 * wid;
#pragma unroll
      for (int g = 0; g < 4; ++g) { f32x4 c = {S[4 * g], S[4 * g + 1], S[4 * g + 2], S[4 * g + 3]}; *(f32x4*)(no + 8 * g + 4 * h) = c; }
    }
  }
  __syncthreads();
}

DI void intra_task(const Params& p, int cc, int hd) {
  const int tid = TIDX, lane = tid & 63, wid = tid >> 6, r = lane & 31, h = lane >> 5;
  unsigned char* ws = p.ws;
  const int tt = wid & 1, vq = wid >> 1;
  const bf16_t* PA = (const bf16_t*)(ws + WS_R1);
  const bf16_t* VT = (const bf16_t*)(ws + WS_VTA);
  const size_t ch = (size_t)cc * 4 + hd;
  f32x16 s0 = zero16(), s1 = zero16();
  {
    const bf16_t* qp = PA + (size_t)(cc * 64 + 32 * tt + r) * 6144 + hd * 256 + 8 * h;
    const bf16_t* kp = PA + (size_t)(cc * 64 + r) * 6144 + 1024 + hd * 256 + 8 * h;
#pragma unroll 4
    for (int kk = 0; kk < 16; ++kk) {
      const bf16x8 q = ld16(qp + 16 * kk), k0 = ld16(kp + 16 * kk), k1 = ld16(kp + (size_t)32 * 6144 + 16 * kk);
      s0 = MFMA32(k0, q, s0);
      if (tt == 1) s1 = MFMA32(k1, q, s1);
    }
  }
  const int t = 32 * tt + r;
  const float bt = ((const float*)(ws + WS_BT))[ch * 64 + t];
  const float* asp = (const float*)(ws + WS_AS) + ch * 64;
  float den = 0.f;
#pragma unroll
  for (int g = 0; g < 4; ++g) {
    const f32x4 a0 = *(const f32x4*)(asp + 8 * g + 4 * h);
    const f32x4 a1 = *(const f32x4*)(asp + 32 + 8 * g + 4 * h);
#pragma unroll
    for (int e = 0; e < 4; ++e) {
      const int s = 8 * g + 4 * h + e;
      const float w0 = s <= t ? fexp2(bt + a0[e]) : 0.f;
      const float w1 = (32 + s) <= t ? fexp2(bt + a1[e]) : 0.f;
      s0[4 * g + e] *= w0; s1[4 * g + e] *= w1;
      den += s0[4 * g + e] + s1[4 * g + e];
    }
  }
  den += __shfl_xor(den, 32);
  if (vq == 0 && h == 0) ((float*)(ws + WS_DENA))[(size_t)(cc * 64 + t) * 4 + hd] = den;
  bf16x8 pf[2][2];
  pf[0][0] = pack_acc(s0, 0); pf[0][1] = pack_acc(s0, 1); pf[1][0] = pack_acc(s1, 0); pf[1][1] = pack_acc(s1, 1);
  float* Ho = (float*)(ws + WS_HINTRA) + (size_t)(cc * 64 + t) * 1024 + hd * 256;
#pragma unroll
  for (int vt = 0; vt < 2; ++vt) {
    const int v0 = vq * 64 + vt * 32;
    const bf16_t* vp = VT + (ch * 256 + v0 + r) * 64 + 4 * h;
    f32x16 o = zero16();
#pragma unroll
    for (int st = 0; st < 2; ++st)
#pragma unroll
      for (int s2 = 0; s2 < 2; ++s2) {
        const bf16x8 a = ld8x2(vp + 32 * st + 16 * s2, vp + 32 * st + 16 * s2 + 8);
        o = MFMA32(a, pf[st][s2], o);
      }
#pragma unroll
    for (int g = 0; g < 4; ++g) { f32x4 c = {o[4 * g], o[4 * g + 1], o[4 * g + 2], o[4 * g + 3]}; *(f32x4*)(Ho + v0 + 8 * g + 4 * h) = c; }
  }
}

DI void memattn_task(const Params& p, int tile, int layer, const bf16_t* Qb, const bf16_t* Zb, size_t ldq) {
  const int tid = TIDX, lane = tid & 63, wid = tid >> 6, r = lane & 31, h = lane >> 5;
  unsigned char* ws = p.ws;
  const int hd = wid >> 1, tok = tile * 64 + 32 * (wid & 1) + r;
  const int sbi = tile < 256 ? 0 : 1 + (tile - 256);
  const bf16_t* MK = (const bf16_t*)(ws + WS_MEMK) + (size_t)(layer * 17 + sbi) * 131072 + hd * 128;
  const bf16_t* MV = (const bf16_t*)(ws + WS_MEMVT) + ((size_t)(layer * 17 + sbi) * 4 + hd) * 128 * 256;
  bf16x8 qf[8];
  {
    const bf16_t* qp = Qb + (size_t)tok * ldq + hd * 128 + 8 * h;
#pragma unroll
    for (int kk = 0; kk < 8; ++kk) qf[kk] = ld16(qp + 16 * kk);
  }
  const float sc = 0.08838834764831845f * LOG2E;
  f32x16 O[4];
#pragma unroll
  for (int vt = 0; vt < 4; ++vt) O[vt] = zero16();
  float mrun = -1e30f, l = 0.f;
#pragma unroll 1
  for (int kb = 0; kb < 4; ++kb) {
    f32x16 s0 = zero16(), s1 = zero16();
    const bf16_t* kp = MK + (size_t)(kb * 64 + r) * 512 + 8 * h;
#pragma unroll
    for (int kk = 0; kk < 8; ++kk) {
      const bf16x8 k0 = ld16(kp + 16 * kk), k1 = ld16(kp + (size_t)32 * 512 + 16 * kk);
      s0 = MFMA32(k0, qf[kk], s0); s1 = MFMA32(k1, qf[kk], s1);
    }
    float mx = -1e30f;
#pragma unroll
    for (int i = 0; i < 16; ++i) mx = fmaxf(mx, fmaxf(s0[i], s1[i]));
    mx = fmaxf(mx, __shfl_xor(mx, 32)) * sc;
    const float mnew = fmaxf(mrun, mx), alpha = fexp2(mrun - mnew);
    mrun = mnew;
    float sum = 0.f;
#pragma unroll
    for (int i = 0; i < 16; ++i) { s0[i] = fexp2(s0[i] * sc - mnew); s1[i] = fexp2(s1[i] * sc - mnew); sum += s0[i] + s1[i]; }
    l = l * alpha + sum;
#pragma unroll
    for (int vt = 0; vt < 4; ++vt) O[vt] = O[vt] * alpha;
    bf16x8 pf[2][2];
    pf[0][0] = pack_acc(s0, 0); pf[0][1] = pack_acc(s0, 1); pf[1][0] = pack_acc(s1, 0); pf[1][1] = pack_acc(s1, 1);
#pragma unroll
    for (int vt = 0; vt < 4; ++vt) {
      const bf16_t* vp = MV + (size_t)(32 * vt + r) * 256 + kb * 64 + 4 * h;
#pragma unroll
      for (int st = 0; st < 2; ++st)
#pragma unroll
        for (int s2 = 0; s2 < 2; ++s2) {
          const bf16x8 a = ld8x2(vp + 32 * st + 16 * s2, vp + 32 * st + 16 * s2 + 8);
          O[vt] = MFMA32(a, pf[st][s2], O[vt]);
        }
    }
  }
  l += __shfl_xor(l, 32);
  const float inv = 1.f / l;
  const bf16_t* zp = Zb + (size_t)tok * ldq + hd * 128;
  bf16_t* op = (bf16_t*)(ws + WS_AO) + (size_t)tok * 1536 + 1024 + hd * 128;
#pragma unroll
  for (int vt = 0; vt < 4; ++vt)
#pragma unroll
    for (int g = 0; g < 4; ++g) {
      const int v = 32 * vt + 8 * g + 4 * h;
      const u32x2 z = *(const u32x2*)(zp + v);
      const float o0 = O[vt][4 * g] * inv * siluf_(bflo(z[0])), o1 = O[vt][4 * g + 1] * inv * siluf_(bfhi(z[0]));
      const float o2 = O[vt][4 * g + 2] * inv * siluf_(bflo(z[1])), o3 = O[vt][4 * g + 3] * inv * siluf_(bfhi(z[1]));
      u32x2 o = {pk2(o0, o1), pk2(o2, o3)};
      *(u32x2*)(op + v) = o;
    }
}

DI int next_item(unsigned* ctr, unsigned char* lds_flag_area, int tid) {
  __syncthreads();
  int* sh = (int*)lds_flag_area;
  if (tid == 0) *sh = (int)atomicAdd(ctr, 1u);
  __syncthreads();
  const int v = *sh;
  return v;
}

DI void phase2(const Params& p, unsigned char* lds) {
  unsigned* ctr = (unsigned*)(p.ws + WS_CTR) + 0 + 8 * p.pad;
  const bf16_t* PA = (const bf16_t*)(p.ws + WS_R1);
  const int n_ps = 36 * 16, n_ss = 576, n_in = NCH * 4, n_ma = NCH;
  for (;;) {
    const int it = next_item(ctr, lds + LDS_BYTES - 16, TIDX);
    if (it >= n_ps + n_ss + n_in + n_ma) break;
    if (it < n_ps) scan_task(p, lds, -1, (it % 36) / 9, it % 9, it / 36);
    else if (it < n_ps + n_ss) { const int q = it - n_ps; scan_task(p, lds, q / 36, (q % 36) / 9, q % 9, 0); }
    else if (it < n_ps + n_ss + n_in) { const int q = it - n_ps - n_ss; intra_task(p, q >> 2, q & 3); }
    else { const int q = it - n_ps - n_ss - n_in; memattn_task(p, q, 0, PA + 5120, PA + 5632, 6144); }
  }
}


DI void scanfix_task(const Params& p, unsigned char* lds, int grp, int hd, int j) {
  const int tid = TIDX, lane = tid & 63, wid = tid >> 6, r = lane & 31, h = lane >> 5;
  unsigned char* ws = p.ws;
  const bool nsl = j == 8;
  const float* LD = (const float*)(ws + WS_LD);
  f32x16 S = zero16();
  for (int gp = 0; gp < grp; ++gp) {
    const float dg = __expf(LD[(GRP * (gp + 1)) * 4 + hd] - LD[(GRP * gp) * 4 + hd]);
    const float* cl = (const float*)(ws + WS_CLOC) + ((((size_t)(gp * 4 + hd) * 9 + j) * 8 + wid) * 64 + lane) * 16;
#pragma unroll
    for (int g = 0; g < 4; ++g) { const f32x4 c = *(const f32x4*)(cl + 4 * g);
      S[4 * g] = S[4 * g] * dg + c[0]; S[4 * g + 1] = S[4 * g + 1] * dg + c[1]; S[4 * g + 2] = S[4 * g + 2] * dg + c[2]; S[4 * g + 3] = S[4 * g + 3] * dg + c[3]; }
  }
  if (grp == 16) {
    if (!nsl) {
      float* Co = p.out + O_PC + (size_t)hd * 65536 + (size_t)(32 * j + r) * 256 + 32 * wid;
#pragma unroll
      for (int g = 0; g < 4; ++g) { f32x4 c = {S[4 * g], S[4 * g + 1], S[4 * g + 2], S[4 * g + 3]}; *(f32x4*)(Co + 8 * g + 4 * h) = c; }
    } else if (r == 0) {
      float* no = p.out + O_PN + (size_t)hd * 256 + 32 * wid;
#pragma unroll
      for (int g = 0; g < 4; ++g) { f32x4 c = {S[4 * g], S[4 * g + 1], S[4 * g + 2], S[4 * g + 3]}; *(f32x4*)(no + 8 * g + 4 * h) = c; }
    }
    return;
  }
  u32x4* fr = (u32x4*)lds;
  float* tp = (float*)(lds + 16384) + wid * (64 * 33);
  __syncthreads();
  fr[(wid * 2 + 0) * 64 + lane] = __builtin_bit_cast(u32x4, pack_acc(S, 0));
  fr[(wid * 2 + 1) * 64 + lane] = __builtin_bit_cast(u32x4, pack_acc(S, 1));
  __syncthreads();
  bf16x8 xf[8][2];
#pragma unroll
  for (int kt = 0; kt < 8; ++kt) { xf[kt][0] = __builtin_bit_cast(bf16x8, fr[(kt * 2 + 0) * 64 + lane]); xf[kt][1] = __builtin_bit_cast(bf16x8, fr[(kt * 2 + 1) * 64 + lane]); }
  const bf16_t* PA = (const bf16_t*)(ws + WS_R1);
  const float* WIa = (const float*)(ws + WS_WI);
#pragma unroll 1
  for (int ci = 0; ci < 2; ++ci) {
    const int cc = GRP * grp + wid + 8 * ci;
    const float D = __expf(LD[cc * 4 + hd] - LD[(GRP * grp) * 4 + hd]);
#pragma unroll
    for (int tt = 0; tt < 2; ++tt) {
      const bf16_t* qp = PA + (size_t)(cc * 64 + 32 * tt + r) * 6144 + hd * 256 + 4 * h;
      f32x16 z = zero16();
#pragma unroll
      for (int kt = 0; kt < 8; ++kt)
#pragma unroll
        for (int s2 = 0; s2 < 2; ++s2) {
          const bf16x8 q = ld8x2(qp + 32 * kt + 16 * s2, qp + 32 * kt + 16 * s2 + 8);
          z = MFMA32(xf[kt][s2], q, z);
        }
#pragma unroll
      for (int i = 0; i < 16; ++i) tp[(32 * tt + r) * 33 + crow(i, h)] = z[i];
    }
    const int v = lane & 31;
#pragma unroll 4
    for (int e = 0; e < 32; ++e) {
      const int t = 2 * e + (lane >> 5);
      const float val = tp[t * 33 + v] * (WIa[((size_t)cc * 4 + hd) * 64 + t] * D);
      if (!nsl) { float* d = (float*)(ws + WS_HINTER) + (size_t)(cc * 64 + t) * 1024 + hd * 256 + 32 * j + v; *d += val; }
      else if (v == 0) { float* d = (float*)(ws + WS_DENI) + (size_t)(cc * 64 + t) * 4 + hd; *d += val; }
    }
  }
}

DI void phase2c(const Params& p, unsigned char* lds) {
  unsigned* ctr = (unsigned*)(p.ws + WS_CTR) + 3 + 8 * p.pad;
  for (;;) {
    const int it = next_item(ctr, lds + LDS_BYTES - 16, TIDX);
    if (it >= 16 * 36) break;
    const int g = 16 - it / 36;
    scanfix_task(p, lds, g, (it % 36) / 9, it % 9);
  }
}

DI void phase3(const Params& p) {
  const int tid = TIDX, lane = tid & 63, wid = tid >> 6;
  unsigned char* ws = p.ws;
  const int gw = blockIdx.x * 8 + wid, nw = gridDim.x * 8;
  const bf16_t* PA = (const bf16_t*)(ws + WS_R1);
  for (int it = gw; it < TT * 4; it += nw) {
    const int tok = it >> 2, hd = it & 3, cc = tok >> 6, t = tok & 63;
    const size_t off = (size_t)tok * 1024 + hd * 256 + 4 * lane;
    const f32x4 a = *(const f32x4*)((const float*)(ws + WS_HINTER) + off), b = *(const f32x4*)((const float*)(ws + WS_HINTRA) + off);
    const float den = ((const float*)(ws + WS_DENI))[tok * 4 + hd] + ((const float*)(ws + WS_DENA))[tok * 4 + hd];
    const float mt = ((const float*)(ws + WS_MT))[((size_t)cc * 4 + hd) * 64 + t];
    const float dn = 1.f / fmaxf(fabsf(den), __expf(-mt));
    const u32x2 ou = *(const u32x2*)(PA + (size_t)tok * 6144 + 3072 + hd * 256 + 4 * lane);
    const u32x2 zu = *(const u32x2*)(PA + (size_t)tok * 6144 + 4096 + hd * 256 + 4 * lane);
    f32x4 hv = (a + b) * dn;
    hv[0] *= sigmoidf_(bflo(ou[0])); hv[1] *= sigmoidf_(bfhi(ou[0])); hv[2] *= sigmoidf_(bflo(ou[1])); hv[3] *= sigmoidf_(bfhi(ou[1]));
    float ss = hv[0] * hv[0] + hv[1] * hv[1] + hv[2] * hv[2] + hv[3] * hv[3];
    ss = wave_sum(ss);
    const float rstd = __builtin_amdgcn_rsqf(ss * (1.f / 256.f) + EPS);
    const f32x4 hg = *(const f32x4*)(p.in[I_HGA] + hd * 256 + 4 * lane);
    hv = hv * rstd * hg;
    hv[0] *= siluf_(bflo(zu[0])); hv[1] *= siluf_(bfhi(zu[0])); hv[2] *= siluf_(bflo(zu[1])); hv[3] *= siluf_(bfhi(zu[1]));
    u32x2 o = {pk2(hv[0], hv[1]), pk2(hv[2], hv[3])};
    *(u32x2*)((bf16_t*)(ws + WS_AO) + (size_t)tok * 1536 + hd * 256 + 4 * lane) = o;
  }
}

DI void phase_outproj(const Params& p, unsigned char* lds, int layer) {
  const int tid = TIDX, lane = tid & 63, wid = tid >> 6, r = lane & 31, h = lane >> 5, wr = wid >> 1, wc = wid & 1;
  unsigned char* ws = p.ws;
  const bf16_t* W = (const bf16_t*)(ws + (layer == 0 ? WS_WOA : WS_WOB));
  for (int t = blockIdx.x; t < 68 * 8; t += gridDim.x) {
    const int tm = t >> 3, tn = t & 7, m0 = tm * 256, n0 = tn * 128;
    GemmAcc acc;
    gemm_tile((const bf16_t*)(ws + WS_AO) + (size_t)m0 * 1536, 1536, W + (size_t)n0 * 1536, 1536, 1536, lds, acc, tid);
#pragma unroll
    for (int a = 0; a < 2; ++a)
#pragma unroll
      for (int b = 0; b < 2; ++b) {
        const int n = n0 + wc * 64 + 32 * b + r, mb = m0 + wr * 64 + 32 * a;
#pragma unroll
        for (int i = 0; i < 16; ++i) {
          const int m = mb + crow(i, h);
          if (layer == 0) {
            const float xv = m < TP ? p.in[I_XP][(size_t)m * 1024 + n] : p.in[I_XS][(size_t)(m - TP) * 1024 + n];
            ((float*)(ws + WS_Y1))[(size_t)m * 1024 + n] = xv + acc.a[a][b][i];
          } else {
            p.out[O_Y + (size_t)m * 1024 + n] = ((const float*)(ws + WS_Y1))[(size_t)m * 1024 + n] + acc.a[a][b][i];
          }
        }
      }
  }
}

DI void phase5(const Params& p, unsigned char* lds) {
  const int tid = TIDX, lane = tid & 63, wid = tid >> 6;
  unsigned char* ws = p.ws;
  const int gw = blockIdx.x * 8 + wid, nw = gridDim.x * 8;
  for (int r = gw; r < TT; r += nw) {
    f32x4 v[4];
    const float rstd = row_load_rstd((const float*)(ws + WS_Y1) + (size_t)r * 1024, v, lane);
    bf16_t* xn = (bf16_t*)(ws + WS_XN) + (size_t)r * 1024;
#pragma unroll
    for (int j = 0; j < 4; ++j) { const f32x4 xs = v[j] * rstd; u32x2 o = {pk2(xs[0], xs[1]), pk2(xs[2], xs[3])}; *(u32x2*)(xn + 4 * lane + 256 * j) = o; }
  }
  {
    float* smax = (float*)lds;
    const int hm = (tid & 127) >> 3;
    for (int b = 0; b < 16; ++b) {
      __syncthreads();
      if (tid < 16) smax[tid] = 0.f;
      __syncthreads();
      float mx = 0.f;
      const size_t n8 = (size_t)PAST * 1024 / 8;
      const float* src = p.in[I_CK] + (size_t)b * PAST * 1024;
      bf16_t* dst = (bf16_t*)(ws + WS_KBS) + (size_t)b * SKV * 1024;
      for (size_t i = (size_t)blockIdx.x * NTHREADS + tid; i < n8; i += (size_t)gridDim.x * NTHREADS) {
        const size_t e = i * 8;
        const f32x4 a = *(const f32x4*)(src + e), c = *(const f32x4*)(src + e + 4);
        u32x4 o = {pk2(a[0], a[1]), pk2(a[2], a[3]), pk2(c[0], c[1]), pk2(c[2], c[3])};
        *(u32x4*)(dst + e) = o;
        float ss = a[0] * a[0] + a[1] * a[1] + a[2] * a[2] + a[3] * a[3] + c[0] * c[0] + c[1] * c[1] + c[2] * c[2] + c[3] * c[3];
        ss += __shfl_xor(ss, 1); ss += __shfl_xor(ss, 2); ss += __shfl_xor(ss, 4);
        mx = fmaxf(mx, ss);
      }
      if ((tid & 7) == 0) atomicMax((unsigned*)smax + hm, __float_as_uint(mx));
      __syncthreads();
      if (tid < 16) atomicMax((unsigned*)(ws + WS_KMAX) + (1 + b) * 16 + tid, __float_as_uint(sqrtf(smax[tid])));
    }
  }
  __syncthreads();
  for (int t = blockIdx.x; t < 128 * 128; t += gridDim.x) {
    const int jb = t >> 7, tile = t & 127, b = jb >> 3, hd = jb & 7;
    TJob j = {p.in[I_CV] + (size_t)b * PAST * 1024 + hd * 128, 1024, (bf16_t*)(ws + WS_VTS) + ((size_t)(b * 8 + hd) * 128) * SKV, SKV, nullptr, 64, 2};
    run_tjob_tile(j, tile, (float*)lds, tid);
  }
}

DI void phase6(const Params& p, unsigned char* lds) {
  const int tid = TIDX, lane = tid & 63, wid = tid >> 6, r = lane & 31, h = lane >> 5, wr = wid >> 1, wc = wid & 1;
  unsigned char* ws = p.ws;
  for (int t = blockIdx.x; t < 68 * 40; t += gridDim.x) {
    const int tm = t / 40, tn = t % 40, m0 = tm * 256, n0 = tn * 128;
    GemmAcc acc;
    gemm_tile((const bf16_t*)(ws + WS_XN) + (size_t)m0 * 1024, 1024, (const bf16_t*)(ws + WS_WKB) + (size_t)n0 * 1024, 1024, 1024, lds, acc, tid);
    const int sec = n0 >> 10;
    const bool samp = m0 >= TP;
#pragma unroll
    for (int a = 0; a < 2; ++a)
#pragma unroll
      for (int b = 0; b < 2; ++b) {
        const int n = n0 + wc * 64 + 32 * b + r, mb = m0 + wr * 64 + 32 * a;
        if (sec == 0) {
          const int f = n;
          if (b == 1) {
            float mx = 0.f;
#pragma unroll
            for (int i = 0; i < 16; ++i) {
              float ss = acc.a[a][0][i] * acc.a[a][0][i] + acc.a[a][1][i] * acc.a[a][1][i];
              ss += __shfl_xor(ss, 1); ss += __shfl_xor(ss, 2); ss += __shfl_xor(ss, 4); ss += __shfl_xor(ss, 8); ss += __shfl_xor(ss, 16);
              mx = fmaxf(mx, ss);
            }
            mx = fmaxf(mx, __shfl_xor(mx, 32));
            if (lane == 0) {
              const int strm = samp ? 1 + ((mb - TP) >> 6) : 0;
              atomicMax((unsigned*)(ws + WS_KMAX) + strm * 16 + ((n0 + wc * 64) >> 6), __float_as_uint(sqrtf(mx)));
            }
          }
#pragma unroll
          for (int i = 0; i < 16; ++i) {
            const int m = mb + crow(i, h);
            const float v = acc.a[a][b][i];
            if (!samp) { p.out[O_PK + (size_t)m * 1024 + f] = v; ((bf16_t*)(ws + WS_KBP))[(size_t)m * 1024 + f] = f2bf(v); }
            else { const int ms = m - TP, bb = ms >> 6, s = ms & 63; p.out[O_SK + (size_t)ms * 1024 + f] = v;
                   ((bf16_t*)(ws + WS_KBS))[((size_t)bb * SKV + PAST + s) * 1024 + f] = f2bf(v); }
          }
        } else if (sec == 1) {
          const int f = n - 1024, hd = f >> 7, vd = f & 127;
#pragma unroll
          for (int i = 0; i < 16; ++i) {
            const int m = mb + crow(i, h);
            if (!samp) p.out[O_PV + (size_t)m * 1024 + f] = acc.a[a][b][i]; else p.out[O_SV + (size_t)(m - TP) * 1024 + f] = acc.a[a][b][i];
          }
#pragma unroll
          for (int g = 0; g < 4; ++g) {
            const int m = mb + 8 * g + 4 * h;
            u32x2 o = {pk2(acc.a[a][b][4 * g], acc.a[a][b][4 * g + 1]), pk2(acc.a[a][b][4 * g + 2], acc.a[a][b][4 * g + 3])};
            if (!samp) *(u32x2*)((bf16_t*)(ws + WS_VTP) + ((size_t)hd * 128 + vd) * TP + m) = o;
            else { const int ms = m - TP, bb = ms >> 6, s = ms & 63; *(u32x2*)((bf16_t*)(ws + WS_VTS) + ((size_t)(bb * 8 + hd) * 128 + vd) * SKV + PAST + s) = o; }
          }
        } else {
          const float sc = sec == 2 ? 0.125f * LOG2E : 1.f;
          bf16_t* PB = (bf16_t*)(ws + WS_PB);
#pragma unroll
          for (int i = 0; i < 16; ++i) PB[(size_t)(mb + crow(i, h)) * 3072 + (n - 2048)] = f2bf(acc.a[a][b][i] * sc);
        }
      }
  }
}

constexpr int A_KROW = 272, A_VROW = 144, A_KB = 64 * A_KROW, A_BUF = A_KB + 128 * A_VROW, A_FLAGS = 2 * A_BUF;

DI void diffattn_task(const Params& p, unsigned char* lds, int sb  , int qt  , int hd, float lam) {
  const int tid = TIDX, lane = tid & 63, wid = __builtin_amdgcn_readfirstlane(tid >> 6), r = lane & 31, h = lane >> 5;
  unsigned char* ws = p.ws;
  const int cq = wid >> 2, sub = (wid >> 1) & 1, map = wid & 1;
  const int ncq = sb < 0 ? 2 : 1;
  const int base_chunk = sb < 0 ? 2 * qt : 64;
  const int tok0 = sb < 0 ? qt * 128 : TP + sb * 64;
  const bool wvalid = cq < ncq;
  const int qc = base_chunk + cq;
  const int tl = 32 * sub + r;
  const int tok = tok0 + 64 * (wvalid ? cq : 0) + tl;
  const bf16_t* Kb = sb < 0 ? (const bf16_t*)(ws + WS_KBP) + hd * 128 : (const bf16_t*)(ws + WS_KBS) + (size_t)sb * SKV * 1024 + hd * 128;
  const bf16_t* Vb = sb < 0 ? (const bf16_t*)(ws + WS_VTP) + (size_t)hd * 128 * TP : (const bf16_t*)(ws + WS_VTS) + (size_t)(sb * 8 + hd) * 128 * SKV;
  const size_t ldv = sb < 0 ? TP : SKV;
  const bf16_t* PB = (const bf16_t*)(ws + WS_PB);
  bf16x8 qf[4];
  float qn = 0.f;
  {
    const unsigned qo = (unsigned)tok * 3072u + hd * 128 + map * 64 + 8 * h;
#pragma unroll
    for (int kk = 0; kk < 4; ++kk) {
      const u32x4 u = *(const u32x4*)(PB + (qo + 16 * kk));
      qf[kk] = __builtin_bit_cast(bf16x8, u);
#pragma unroll
      for (int e = 0; e < 4; ++e) { const float a = bflo(u[e]), b = bfhi(u[e]); qn += a * a + b * b; }
    }
    qn += __shfl_xor(qn, 32);
    qn = sqrtf(qn);
  }
  const float kmax = ((const float*)(ws + WS_KMAX))[(sb < 0 ? 0 : 1 + sb) * 16 + hd * 2 + map];
  const float sbound = qn * kmax * 1.02f + 0.5f;
  const float sl2 = exp2f(-(float)(hd + 1)) * LOG2E;
  const float bh0 = sl2 * (float)(4 * h), bh1 = bh0 + 32.f * sl2;
  float cs[16];
#pragma unroll
  for (int i = 0; i < 16; ++i) cs[i] = __uint_as_float(__builtin_amdgcn_readfirstlane(__float_as_uint(sl2 * (float)((i & 3) + 8 * (i >> 2)))));
  f32x16 O[4];
#pragma unroll
  for (int vt = 0; vt < 4; ++vt) O[vt] = zero16();
  float mrun = -1e30f, l = 0.f;
  const int jmax = base_chunk + ncq - 1, nit = jmax + 1;
  u32x4 rk[2], rv[2];
  const unsigned kofs = (unsigned)((tid >> 4) * 1024 + (tid & 15) * 8), vofs = (unsigned)((tid >> 3) * (unsigned)ldv + (tid & 7) * 8);
  auto gload = [&](int j) {
    const bf16_t* kj = Kb + (size_t)j * 65536;
    const bf16_t* vj = Vb + (size_t)j * 64;
#pragma unroll
    for (int e = 0; e < 2; ++e) {
      rk[e] = *(const u32x4*)(kj + (kofs + (unsigned)e * 32768u));
      rv[e] = *(const u32x4*)(vj + (vofs + (unsigned)e * 64u * (unsigned)ldv));
    }
  };
  auto lstore = [&](int buf) {
    unsigned char* base = lds + buf * A_BUF;
#pragma unroll
    for (int e = 0; e < 2; ++e) {
      const int id = tid + 512 * e;
      { const int row = id >> 4, c = id & 15; *(u32x4*)(base + row * A_KROW + 16 * c) = rk[e]; }
      { const int row = id >> 3, c = id & 7; unsigned char* d = base + A_KB + row * A_VROW + 32 * (c >> 1) + 8 * (c & 1);
        u32x2 lo = {rv[e][0], rv[e][1]}, hi = {rv[e][2], rv[e][3]}; *(u32x2*)d = lo; *(u32x2*)(d + 16) = hi; }
    }
  };
  int* flags = (int*)(lds + A_FLAGS);
  gload(jmax);
  __syncthreads();
  lstore(0);
  __syncthreads();
  for (int it = 0; it < nit; ++it) {
    const int j = jmax - it;
    if (it + 1 < nit) gload(j - 1);
    bool stop = true;
    if (wvalid && j <= qc) {
      const unsigned char* base = lds + (it & 1) * A_BUF;
      const unsigned char* kp = base + r * A_KROW + map * 128 + 16 * h;
      f32x16 s0, s1;
      {
        float b0 = bh0, b1 = bh1;
        asm volatile("" : "+v"(b0), "+v"(b1));
#pragma unroll
        for (int i = 0; i < 16; ++i) { s0[i] = b0 + cs[i]; s1[i] = b1 + cs[i]; }
      }
      if (j == qc) {
        int tlv = tl;
        asm volatile("" : "+v"(tlv));
        const float m2 = -2.f * sl2;
#pragma unroll
        for (int i = 0; i < 16; ++i) {
          const int s = crow(i, h);
          s0[i] = fmaf(m2, (float)max(0, s - tlv), s0[i]); s1[i] = fmaf(m2, (float)max(0, 32 + s - tlv), s1[i]);
        }
      }
#pragma unroll
      for (int kk = 0; kk < 4; ++kk) {
        const bf16x8 k0 = ld16(kp + 32 * kk), k1 = ld16(kp + 32 * A_KROW + 32 * kk);
        s0 = MFMA32(k0, qf[kk], s0); s1 = MFMA32(k1, qf[kk], s1);
      }
      const float dofs = sl2 * (float)((qc - j) * 64);
      float mx = -1e30f;
#pragma unroll
      for (int i = 0; i < 16; ++i) mx = fmaxf(mx, fmaxf(s0[i], s1[i]));
      mx = fmaxf(mx, __shfl_xor(mx, 32)) - dofs;
      const float mnew = fmaxf(mrun, mx), mm = mnew + dofs;
      if (__builtin_amdgcn_ballot_w64(mnew > mrun) != 0ull) {
        const float alpha = fexp2(mrun - mnew);
        l *= alpha;
#pragma unroll
        for (int vt = 0; vt < 4; ++vt) O[vt] = O[vt] * alpha;
      }
      mrun = mnew;
      float sum = 0.f;
#pragma unroll
      for (int i = 0; i < 16; ++i) { s0[i] = fexp2(s0[i] - mm); s1[i] = fexp2(s1[i] - mm); sum += s0[i] + s1[i]; }
      l += sum;
      bf16x8 pf[2][2];
      pf[0][0] = pack_acc(s0, 0); pf[0][1] = pack_acc(s0, 1); pf[1][0] = pack_acc(s1, 0); pf[1][1] = pack_acc(s1, 1);
      const unsigned char* vbase = base + A_KB + r * A_VROW + 16 * h;
#pragma unroll
      for (int vt = 0; vt < 4; ++vt) {
        const unsigned char* vp = vbase + 32 * vt * A_VROW;
#pragma unroll
        for (int st = 0; st < 2; ++st)
#pragma unroll
          for (int s2 = 0; s2 < 2; ++s2) O[vt] = MFMA32(ld16(vp + 64 * st + 32 * s2), pf[st][s2], O[vt]);
      }
      const float nb = sbound + sl2 * (float)(63 - (qc - j + 1) * 64) - mrun;
      stop = __builtin_amdgcn_ballot_w64(nb >= -152.f) == 0ull;
    } else if (wvalid) stop = false;
    if (lane == 0) flags[(it & 1) * 8 + wid] = stop ? 1 : 0;
    if (it + 1 < nit) lstore((it + 1) & 1);
    __syncthreads();
    {
      const int* f = flags + (it & 1) * 8;
      if ((f[0] & f[1] & f[2] & f[3] & f[4] & f[5] & f[6] & f[7]) != 0) break;
    }
  }
  __syncthreads();
  l += __shfl_xor(l, 32);
  const float inv = wvalid ? 1.f / l : 0.f;
  float* xch = (float*)lds + (size_t)(wid >> 1) * 4096;
  if (map == 1 && wvalid) {
    const float sc = inv * lam;
#pragma unroll
    for (int vt = 0; vt < 4; ++vt)
#pragma unroll
      for (int i = 0; i < 16; ++i) xch[(vt * 16 + i) * 64 + lane] = O[vt][i] * sc;
  }
  __syncthreads();
  if (map == 0 && wvalid) {
    float ss = 0.f;
#pragma unroll
    for (int vt = 0; vt < 4; ++vt)
#pragma unroll
      for (int i = 0; i < 16; ++i) { const float o = O[vt][i] * inv - xch[(vt * 16 + i) * 64 + lane]; O[vt][i] = o; ss += o * o; }
    ss += __shfl_xor(ss, 32);
    const float lam_init = 0.8f - 0.6f * 0.7408182206817179f;
    const float rs = __builtin_amdgcn_rsqf(ss * (1.f / 128.f) + EPS) * (1.f - lam_init);
    const unsigned zo = (unsigned)tok * 3072u + 1024 + hd * 128, oo = (unsigned)tok * 1536u + hd * 128;
    bf16_t* AOp = (bf16_t*)(ws + WS_AO);
    const float* sg = p.in[I_SUBG];
#pragma unroll
    for (int vt = 0; vt < 4; ++vt)
#pragma unroll
      for (int g = 0; g < 4; ++g) {
        const int v = 32 * vt + 8 * g + 4 * h;
        const u32x2 z = *(const u32x2*)(PB + (zo + v));
        const f32x4 gg = *(const f32x4*)(sg + v);
        const float o0 = O[vt][4 * g] * rs * gg[0] * siluf_(bflo(z[0])), o1 = O[vt][4 * g + 1] * rs * gg[1] * siluf_(bfhi(z[0]));
        const float o2 = O[vt][4 * g + 2] * rs * gg[2] * siluf_(bflo(z[1])), o3 = O[vt][4 * g + 3] * rs * gg[3] * siluf_(bfhi(z[1]));
        u32x2 o = {pk2(o0, o1), pk2(o2, o3)};
        *(u32x2*)(AOp + (oo + v)) = o;
      }
  }
  __syncthreads();
}

DI void phase7(const Params& p, unsigned char* lds) {
  unsigned* ctr = (unsigned*)(p.ws + WS_CTR) + 1 + 8 * p.pad;
  const bf16_t* PB = (const bf16_t*)(p.ws + WS_PB);
  float lam;
  {
    const int lane = TIDX & 63;
    const float* lv = p.in[I_LAMB];
    const float a = wave_sum(lv[lane] * lv[64 + lane]), b = wave_sum(lv[128 + lane] * lv[192 + lane]);
    const float lam_init = 0.8f - 0.6f * 0.7408182206817179f;
    lam = __expf(a) - __expf(b) + lam_init;
  }
  const int n_s = 128, n_p = 1024, n_ma = NCH;
  const int* tord = (const int*)(p.ws + WS_TORD);
  for (;;) {
    const int it = next_item(ctr, lds + LDS_BYTES - 16, TIDX);
    if (it >= n_s + n_p) break;
    const int a = tord[it];
    const bool pr = a < n_p;
    diffattn_task(p, lds, pr ? -1 : ((a - n_p) >> 3), pr ? (a >> 3) : 0, a & 7, lam);
  }
  for (;;) {
    const int it = next_item(ctr + 1, lds + LDS_BYTES - 16, TIDX);
    if (it >= n_ma) break;
    memattn_task(p, it, 1, PB + 2048, PB + 2560, 3072);
  }
}

DI void phase9(const Params& p) {
  const int tid = TIDX, lane = tid & 63, wid = tid >> 6;
  const int gw = blockIdx.x * 8 + wid, nw = gridDim.x * 8;
  for (int r = gw; r < TT; r += nw) {
    f32x4 v[4];
    float* row = p.out + O_Y + (size_t)r * 1024;
    const float rstd = row_load_rstd(row, v, lane);
#pragma unroll
    for (int j = 0; j < 4; ++j) {
      const f32x4 g = *(const f32x4*)(p.in[I_FNG] + 4 * lane + 256 * j);
      *(f32x4*)(row + 4 * lane + 256 * j) = v[j] * rstd * g;
    }
  }
}

DI void grid_barrier(unsigned* bar, unsigned target, int tid) {
  asm volatile("s_waitcnt vmcnt(0)" ::: "memory");
  __syncthreads();
  if (tid == 0) {
    __builtin_amdgcn_fence(__ATOMIC_RELEASE, "agent");
    asm volatile("s_waitcnt vmcnt(0)" ::: "memory");
    __hip_atomic_fetch_add(bar, 1u, __ATOMIC_RELAXED, __HIP_MEMORY_SCOPE_AGENT);
    while (__hip_atomic_load(bar, __ATOMIC_RELAXED, __HIP_MEMORY_SCOPE_AGENT) < target) __builtin_amdgcn_s_sleep(1);
    __builtin_amdgcn_fence(__ATOMIC_ACQUIRE, "agent");
    asm volatile("s_waitcnt vmcnt(0)" ::: "memory");
  }
  __syncthreads();
}

__global__ __launch_bounds__(512) void mk(Params pin) {
  extern __shared__ __attribute__((aligned(16))) unsigned char lds[];
  Params p = pin;
  p.wv = __builtin_amdgcn_readfirstlane((int)(__builtin_amdgcn_workitem_id_x() >> 6));
  cg::grid_group grid = cg::this_grid();
  unsigned nbar = 0;
  unsigned* bar = (unsigned*)(p.ws + WS_CTR) + 32;
#define RUN_PHASE(PH, CALL) if (p.ph_lo <= PH && PH < p.ph_hi) { CALL; if (PH + 1 < p.ph_hi) { ++nbar; grid_barrier(bar, nbar * gridDim.x, TIDX); } }
  if (p.ph_lo <= 0 && 0 < p.ph_hi) { phase0(p, lds); if (1 < p.ph_hi) grid.sync(); }
  RUN_PHASE(1, phase1(p, lds))
  RUN_PHASE(2, phase2(p, lds))
  if (p.ph_lo <= 2 && 2 < p.ph_hi) { phase2c(p, lds); ++nbar; grid_barrier(bar, nbar * gridDim.x, TIDX); }
  RUN_PHASE(3, phase3(p))
  RUN_PHASE(4, phase_outproj(p, lds, 0))
  RUN_PHASE(5, phase5(p, lds))
  RUN_PHASE(6, phase6(p, lds))
  RUN_PHASE(7, phase7(p, lds))
  RUN_PHASE(8, phase_outproj(p, lds, 1))
  RUN_PHASE(9, phase9(p))
}

extern "C" void kernel_launch(void* const* d_in, const int* in_sizes, int n_in, void* d_out, int out_size,
                              void* d_ws, size_t ws_size, hipStream_t stream) {
  static int grid_blocks = 0;
  if (!grid_blocks) {
    int dev = 0, cus = 0, per_cu = 0;
    (void)hipGetDevice(&dev);
    (void)hipDeviceGetAttribute(&cus, hipDeviceAttributeMultiprocessorCount, dev);
    (void)hipFuncSetAttribute((const void*)mk, hipFuncAttributeMaxDynamicSharedMemorySize, LDS_BYTES);
    (void)hipOccupancyMaxActiveBlocksPerMultiprocessor(&per_cu, (const void*)mk, NTHREADS, LDS_BYTES);
    grid_blocks = cus;
    fprintf(stderr, "kernel_launch: cus=%d per_cu=%d grid=%d ws=%zu need=%zu\n", cus, per_cu, grid_blocks, ws_size, (size_t)WS_END);
  }
  if (ws_size < WS_END) { fprintf(stderr, "workspace too small\n"); return; }
  Params p{};
  for (int i = 0; i < 24; ++i) p.in[i] = (const float*)d_in[i];
  p.out = (float*)d_out; p.ws = (unsigned char*)d_ws; p.ph_lo = 0; p.ph_hi = NPHASE;
  void* args[] = {&p};
  hipError_t e = hipLaunchCooperativeKernel((const void*)mk, dim3(grid_blocks), dim3(NTHREADS), args, LDS_BYTES, stream);
  if (e != hipSuccess) fprintf(stderr, "cooperative launch failed: %s (grid %d)\n", hipGetErrorString(e), grid_blocks);
  if (PROBE_REP >= 0) {
    Params q = p;
    q.out = (float*)((unsigned char*)d_ws + WS_END); q.ph_lo = PROBE_REP; q.ph_hi = PROBE_REP + 1; q.pad = 1;
    void* args2[] = {&q};
    (void)hipLaunchCooperativeKernel((const void*)mk, dim3(grid_blocks), dim3(NTHREADS), args2, LDS_BYTES, stream);
  }
}
```

```cpp
#include <hip/hip_runtime.h>
#include <hip/hip_cooperative_groups.h>
#include <cstdio>
#include <cstdint>
namespace cg = cooperative_groups;

typedef unsigned short bf16_t;
typedef short bf16x8 __attribute__((ext_vector_type(8)));
typedef short s16x4 __attribute__((ext_vector_type(4)));
typedef float f32x16 __attribute__((ext_vector_type(16)));
typedef float f32x4 __attribute__((ext_vector_type(4)));
typedef float f32x2 __attribute__((ext_vector_type(2)));
typedef __bf16 bf2_t __attribute__((ext_vector_type(2)));
typedef unsigned u32x4 __attribute__((ext_vector_type(4)));
typedef unsigned u32x2 __attribute__((ext_vector_type(2)));
#define DI __device__ __forceinline__
#define MFMA32(a, b, c) __builtin_amdgcn_mfma_f32_32x32x16_bf16((a), (b), (c), 0, 0, 0)

struct Params { const float* in[24]; float* out; unsigned char* ws; int ph_lo, ph_hi; int wv, pad; };
#define TIDX (p.wv * 64 + (int)__builtin_amdgcn_mbcnt_hi(~0u, __builtin_amdgcn_mbcnt_lo(~0u, 0u)))
constexpr int LDS_BYTES = 148480;
constexpr int NTHREADS = 512;
constexpr int NPHASE = 10;
#ifndef PROBE_REP
#define PROBE_REP -1
#endif

constexpr int TP = 16384, TS = 1024, TT = 17408, DM = 1024;
constexpr int NCH = 272;
constexpr int PAST = 4096, SKV = 4160;
constexpr float EPS = 1e-6f;
constexpr float LOG2E = 1.4426950408889634f;
enum { I_XP = 0, I_XS, I_CK, I_CV, I_CMK, I_CMV, I_SC, I_SN, I_SM, I_MEMP, I_NG, I_FNG, I_MNG, I_WMKV, I_WINA, I_BGA, I_HGA, I_WOA,
       I_KVNG, I_WKV, I_WINB, I_LAMB, I_SUBG, I_WOB };
constexpr size_t O_Y = 0, O_PC = 17825792, O_PN = 18087936, O_PM = 18088960, O_PK = 18088964, O_PV = 34866180, O_PMK = 51643396,
                 O_PMV = 51905540, O_SC = 52167684, O_SN = 56361988, O_SM = 56378372, O_SK = 56378436, O_SV = 57427012;
constexpr size_t WS_CTR = 0;
constexpr size_t WS_KMAX = 1024;
constexpr size_t WS_TORD = 8192;
constexpr size_t WS_WA = 16384;
constexpr size_t WS_WOA = WS_WA + (size_t)6144 * 1024 * 2;
constexpr size_t WS_WKB = WS_WOA + (size_t)1024 * 1536 * 2;
constexpr size_t WS_WOB = WS_WKB + (size_t)5120 * 1024 * 2;
constexpr size_t WS_WM = WS_WOB + (size_t)1024 * 1536 * 2;
constexpr size_t WS_MEMN = WS_WM + (size_t)2 * 1024 * 1024 * 2;
constexpr size_t WS_MEMK = WS_MEMN + (size_t)2 * 256 * 1024 * 2;
constexpr size_t WS_MEMVT = WS_MEMK + (size_t)2 * 17 * 256 * 512 * 2;
constexpr size_t WS_GATE = WS_MEMVT + (size_t)2 * 17 * 256 * 512 * 2;
constexpr size_t SZ_CH = (size_t)NCH * 4 * 64 * 4;
constexpr size_t WS_GC = WS_GATE + (size_t)TT * 8 * 4;
constexpr size_t WS_MT = WS_GC + SZ_CH;
constexpr size_t WS_WS = WS_MT + SZ_CH;
constexpr size_t WS_WI = WS_WS + SZ_CH;
constexpr size_t WS_AS = WS_WI + SZ_CH;
constexpr size_t WS_BT = WS_AS + SZ_CH;
constexpr size_t WS_DEC = WS_BT + SZ_CH;
constexpr size_t WS_DENI = WS_DEC + 8192;
constexpr size_t WS_DENA = WS_DENI + (size_t)TT * 4 * 4;
constexpr size_t WS_XN = WS_DENA + (size_t)TT * 4 * 4;
constexpr size_t WS_AO = WS_XN + (size_t)TT * 1024 * 2;
constexpr size_t WS_Y1 = WS_AO + (size_t)TT * 1536 * 2;
constexpr size_t WS_KT = WS_Y1 + (size_t)TT * 1024 * 4;
constexpr size_t WS_VTA = WS_KT + (size_t)NCH * 4 * 256 * 64 * 2;
constexpr size_t WS_R1 = WS_VTA + (size_t)NCH * 4 * 256 * 64 * 2;
constexpr size_t SZ_R1 = (size_t)TT * 6144 * 2;
constexpr size_t WS_PB = WS_R1;
constexpr size_t WS_KBP = WS_PB + (size_t)TT * 3072 * 2;
constexpr size_t WS_VTP = WS_KBP + (size_t)TP * 1024 * 2;
constexpr size_t WS_R2 = WS_R1 + SZ_R1;
constexpr size_t WS_HINTER = WS_R2;
constexpr size_t WS_HINTRA = WS_R2 + (size_t)TT * 1024 * 4;
constexpr size_t WS_KBS = WS_R2;
constexpr size_t WS_VTS = WS_KBS + (size_t)16 * SKV * 1024 * 2;
constexpr size_t WS_LD = WS_VTS + (size_t)16 * SKV * 1024 * 2;
constexpr size_t WS_CLOC = WS_LD + 8192;
constexpr size_t WS_END = WS_CLOC + (size_t)16 * 36 * 8 * 64 * 16 * 4;
constexpr int GRP = 16;
static_assert(WS_VTP + (size_t)TP * 1024 * 2 <= WS_R2, "R1 overflow");

DI unsigned pk2(float lo, float hi) { f32x2 v = {lo, hi}; return __builtin_bit_cast(unsigned, __builtin_convertvector(v, bf2_t)); }
DI bf16_t f2bf(float x) { return (bf16_t)(pk2(x, 0.f) & 0xffffu); }
DI float bf2f(unsigned v16) { return __uint_as_float(v16 << 16); }
DI float bflo(unsigned u) { return __uint_as_float(u << 16); }
DI float bfhi(unsigned u) { return __uint_as_float(u & 0xffff0000u); }
DI float rbf(float x) { return bflo(pk2(x, 0.f) & 0xffffu); }
DI int crow(int i, int h) { return (i & 3) + 8 * (i >> 2) + 4 * h; }
DI float wave_sum(float v) {
#pragma unroll
  for (int o = 32; o >= 1; o >>= 1) v += __shfl_xor(v, o);
  return v;
}
DI float fexp2(float x) { return __builtin_amdgcn_exp2f(x); }
DI float fexp(float x) { return __builtin_amdgcn_exp2f(x * LOG2E); }
DI float sigmoidf_(float x) { return 1.f / (1.f + __expf(-x)); }
DI float siluf_(float x) { return x / (1.f + __expf(-x)); }
DI bf16x8 pack_acc(const f32x16& x, int s) {
  u32x4 p;
  p[0] = pk2(x[8 * s + 0], x[8 * s + 1]); p[1] = pk2(x[8 * s + 2], x[8 * s + 3]);
  p[2] = pk2(x[8 * s + 4], x[8 * s + 5]); p[3] = pk2(x[8 * s + 6], x[8 * s + 7]);
  return __builtin_bit_cast(bf16x8, p);
}
DI bf16x8 ld16(const void* p) { return *(const bf16x8*)p; }
DI bf16x8 ld8x2(const void* p0, const void* p1) {
  u32x2 a = *(const u32x2*)p0, b = *(const u32x2*)p1; u32x4 r = {a[0], a[1], b[0], b[1]};
  return __builtin_bit_cast(bf16x8, r);
}
DI f32x16 zero16() { f32x16 z; for (int i = 0; i < 16; ++i) z[i] = 0.f; return z; }

DI void transpose_tile(const float* __restrict__ src, size_t ld_s, bf16_t* __restrict__ dst, size_t ld_d, const float* __restrict__ scale,
                       float* scr, int t, bool perm = false) {
  {
    const int c4 = t & 15, rb = t >> 4;
#pragma unroll
    for (int i = 0; i < 2; ++i) {
      const int r = rb + 32 * i;
      f32x4 v = *(const f32x4*)(src + (size_t)r * ld_s + 4 * c4);
      if (scale) { const float s = scale[r]; v = v * s; }
      float* d = scr + r * 65 + 4 * c4; d[0] = v[0]; d[1] = v[1]; d[2] = v[2]; d[3] = v[3];
    }
  }
  __syncthreads();
  {
    const int c = t >> 3, rg = t & 7;
    const float* s = scr + (8 * rg) * 65 + c;
    u32x4 o; o[0] = pk2(s[0], s[65]); o[1] = pk2(s[2 * 65], s[3 * 65]); o[2] = pk2(s[4 * 65], s[5 * 65]); o[3] = pk2(s[6 * 65], s[7 * 65]);
    if (!perm) *(u32x4*)(dst + (size_t)c * ld_d + 8 * rg) = o;
    else {
      bf16_t* d = dst + (size_t)c * ld_d + 16 * (rg >> 1) + 4 * (rg & 1);
      u32x2 lo = {o[0], o[1]}, hi = {o[2], o[3]};
      *(u32x2*)d = lo; *(u32x2*)(d + 8) = hi;
    }
  }
  __syncthreads();
}

struct TJob { const float* src; size_t ld_s; bf16_t* dst; size_t ld_d; const float* scale; int tr, tc; };

DI void run_tjob_tile(const TJob& j, int tile, float* scr, int tid, bool perm = false) {
  const int ir = tile / j.tc, ic = tile % j.tc;
  transpose_tile(j.src + (size_t)(64 * ir) * j.ld_s + 64 * ic, j.ld_s, j.dst + (size_t)(64 * ic) * j.ld_d + 64 * ir, j.ld_d,
                 j.scale ? j.scale + 64 * ir : nullptr, scr, tid, perm);
}

DI float row_load_rstd(const float* xrow, f32x4 (&v)[4], int lane) {
  float ss = 0.f;
#pragma unroll
  for (int j = 0; j < 4; ++j) { v[j] = *(const f32x4*)(xrow + 4 * lane + 256 * j); ss += v[j][0] * v[j][0] + v[j][1] * v[j][1] + v[j][2] * v[j][2] + v[j][3] * v[j][3]; }
  ss = wave_sum(ss);
  return __builtin_amdgcn_rsqf(ss * (1.f / 1024.f) + EPS);
}

DI int diff_est(int a) {
  const int hd = a & 7;
  const int w = hd == 0 ? 5 : hd == 1 ? 9 : hd == 2 ? 16 : hd == 3 ? 31 : hd == 4 ? 60 : hd == 5 ? 119 : hd == 6 ? 237 : 256;
  const int n = a < 1024 ? 2 * (a >> 3) + 2 : 65;
  return n < w ? n : w;
}

DI void phase0(const Params& p, unsigned char* lds) {
  const int tid = TIDX, lane = tid & 63, wid = tid >> 6;
  unsigned char* ws = p.ws;
  if (blockIdx.x == 0 && tid < 64) ((unsigned*)(ws + WS_CTR))[tid] = 0u;
  if (blockIdx.x == 0 && tid < 272) ((unsigned*)(ws + WS_KMAX))[tid] = 0u;
  if (blockIdx.x == 1) {
    int* est = (int*)lds;
    for (int a = tid; a < 1152; a += NTHREADS) est[a] = diff_est(a);
    __syncthreads();
    for (int a = tid; a < 1152; a += NTHREADS) {
      const int ea = est[a];
      int rank = 0;
      for (int b = 0; b < 1152; ++b) { const int eb = est[b]; rank += (eb > ea) || (eb == ea && b < a); }
      ((int*)(ws + WS_TORD))[rank] = a;
    }
    __syncthreads();
  }
  {
    TJob jobs[8];
    jobs[0] = {p.in[I_WINA], 6152, (bf16_t*)(ws + WS_WA), 1024, p.in[I_NG], 16, 80};
    jobs[1] = {p.in[I_WINA] + 5128, 6152, (bf16_t*)(ws + WS_WA) + (size_t)5120 * 1024, 1024, p.in[I_NG], 16, 16};
    jobs[2] = {p.in[I_WOA], 1024, (bf16_t*)(ws + WS_WOA), 1536, nullptr, 24, 16};
    jobs[3] = {p.in[I_WKV], 2048, (bf16_t*)(ws + WS_WKB), 1024, p.in[I_KVNG], 16, 32};
    jobs[4] = {p.in[I_WINB], 3072, (bf16_t*)(ws + WS_WKB) + (size_t)2048 * 1024, 1024, p.in[I_NG] + 1024, 16, 48};
    jobs[5] = {p.in[I_WOB], 1024, (bf16_t*)(ws + WS_WOB), 1536, nullptr, 24, 16};
    jobs[6] = {p.in[I_WMKV], 1024, (bf16_t*)(ws + WS_WM), 1024, nullptr, 16, 16};
    jobs[7] = {p.in[I_WMKV] + (size_t)1024 * 1024, 1024, (bf16_t*)(ws + WS_WM) + (size_t)1024 * 1024, 1024, nullptr, 16, 16};
    int base = 0;
#pragma unroll
    for (int j = 0; j < 8; ++j) {
      const int n = jobs[j].tr * jobs[j].tc;
      for (int t = blockIdx.x; t < n; t += gridDim.x) run_tjob_tile(jobs[j], t, (float*)lds, tid);
      base += n;
    }
    for (int t = blockIdx.x; t < 128 * 8; t += gridDim.x) {
      const int jb = t >> 3, tile = t & 7, l = jb >> 6, b = (jb >> 2) & 15, h = jb & 3;
      TJob j = {p.in[I_CMV] + ((size_t)(l * 16 + b) * 256) * 512 + h * 128, 512,
                (bf16_t*)(ws + WS_MEMVT) + ((size_t)(l * 17 + 1 + b) * 4 + h) * 128 * 256, 256, nullptr, 4, 2};
      run_tjob_tile(j, tile, (float*)lds, tid, true);
    }
  }
  {
    const size_t n8 = (size_t)2 * 16 * 256 * 512 / 8;
    for (size_t i = (size_t)blockIdx.x * NTHREADS + tid; i < n8; i += (size_t)gridDim.x * NTHREADS) {
      const size_t e = i * 8; const int l = (int)(e / ((size_t)16 * 131072)); const size_t rem = e - (size_t)l * 16 * 131072;
      const f32x4 a = *(const f32x4*)(p.in[I_CMK] + e), b = *(const f32x4*)(p.in[I_CMK] + e + 4);
      u32x4 o = {pk2(a[0], a[1]), pk2(a[2], a[3]), pk2(b[0], b[1]), pk2(b[2], b[3])};
      *(u32x4*)((bf16_t*)(ws + WS_MEMK) + ((size_t)(l * 17 + 1) * 131072) + rem) = o;
    }
  }
  {
    const int gw = blockIdx.x * 8 + wid, nw = gridDim.x * 8;
    const float* ng = p.in[I_NG];
    for (int r = gw; r < TT; r += nw) {
      const float* xrow = r < TP ? p.in[I_XP] + (size_t)r * 1024 : p.in[I_XS] + (size_t)(r - TP) * 1024;
      f32x4 v[4];
      const float rstd = row_load_rstd(xrow, v, lane);
      float gacc[8];
#pragma unroll
      for (int c = 0; c < 8; ++c) gacc[c] = 0.f;
      bf16_t* xn = (bf16_t*)(ws + WS_XN) + (size_t)r * 1024;
#pragma unroll
      for (int j = 0; j < 4; ++j) {
        const int k0 = 4 * lane + 256 * j;
        const f32x4 xs = v[j] * rstd;
        u32x2 o = {pk2(xs[0], xs[1]), pk2(xs[2], xs[3])};
        *(u32x2*)(xn + k0) = o;
        const f32x4 g = *(const f32x4*)(ng + k0);
#pragma unroll
        for (int e = 0; e < 4; ++e) {
          const float xg = xs[e] * g[e];
          const float* wr = p.in[I_WINA] + (size_t)(k0 + e) * 6152 + 5120;
          const f32x4 w0 = *(const f32x4*)wr, w1 = *(const f32x4*)(wr + 4);
          gacc[0] += xg * w0[0]; gacc[1] += xg * w0[1]; gacc[2] += xg * w0[2]; gacc[3] += xg * w0[3];
          gacc[4] += xg * w1[0]; gacc[5] += xg * w1[1]; gacc[6] += xg * w1[2]; gacc[7] += xg * w1[3];
        }
      }
#pragma unroll
      for (int c = 0; c < 8; ++c) gacc[c] = wave_sum(gacc[c]);
      if (lane < 8) {
        float gv = gacc[0];
#pragma unroll
        for (int c = 1; c < 8; ++c) gv = lane == c ? gacc[c] : gv;
        gv += p.in[I_BGA][lane];
        if (lane >= 4) gv = fminf(gv, 0.f) - log1pf(__expf(-fabsf(gv)));
        ((float*)(ws + WS_GATE))[(size_t)r * 8 + lane] = gv;
      }
    }
    for (int r = gw; r < 512; r += nw) {
      const int l = r >> 8, rr = r & 255;
      f32x4 v[4];
      const float rstd = row_load_rstd(p.in[I_MEMP] + (size_t)rr * 1024, v, lane);
      bf16_t* o = (bf16_t*)(ws + WS_MEMN) + (size_t)r * 1024;
#pragma unroll
      for (int j = 0; j < 4; ++j) {
        const int k0 = 4 * lane + 256 * j;
        const f32x4 g = *(const f32x4*)(p.in[I_MNG] + l * 1024 + k0);
        const f32x4 xs = v[j] * rstd * g;
        u32x2 ov = {pk2(xs[0], xs[1]), pk2(xs[2], xs[3])};
        *(u32x2*)(o + k0) = ov;
      }
    }
  }
}

constexpr int G_STAGE = 49152;
struct GemmAcc { f32x16 a[2][2]; };
DI void dma16(const void* g, unsigned char* l) { __builtin_amdgcn_global_load_lds((const unsigned*)g, (unsigned*)l, 16, 0, 0); }

DI void gemm_tile(const bf16_t* __restrict__ A, size_t lda, const bf16_t* __restrict__ Bt, size_t ldb, int K, unsigned char* lds, GemmAcc& acc, int tid) {
  const int lane = tid & 63, wid = __builtin_amdgcn_readfirstlane(tid >> 6), r = lane & 31, h = lane >> 5;
  const int wr = wid >> 1, wc = wid & 1;
#pragma unroll
  for (int a = 0; a < 2; ++a)
#pragma unroll
    for (int b = 0; b < 2; ++b) acc.a[a][b] = zero16();
  const int nk = K / 64;
  unsigned aoff[4], boff[2];
#pragma unroll
  for (int e = 0; e < 4; ++e) { const int row = 8 * (wid * 4 + e) + (lane >> 3), lc = (lane & 7) ^ ((row >> 1) & 7); aoff[e] = (unsigned)row * (unsigned)lda + 8u * lc; }
#pragma unroll
  for (int e = 0; e < 2; ++e) { const int row = 8 * (wid * 2 + e) + (lane >> 3), lc = (lane & 7) ^ ((row >> 1) & 7); boff[e] = (unsigned)row * (unsigned)ldb + 8u * lc; }
  auto issue = [&](int kt, int buf) {
    unsigned char* base = lds + buf * G_STAGE;
#pragma unroll
    for (int e = 0; e < 4; ++e) dma16(A + (aoff[e] + 64u * kt), base + (wid * 4 + e) * 1024);
#pragma unroll
    for (int e = 0; e < 2; ++e) dma16(Bt + (boff[e] + 64u * kt), base + 32768 + (wid * 2 + e) * 1024);
  };
  asm volatile("s_waitcnt vmcnt(0)" ::: "memory");
  __syncthreads();
  issue(0, 0);
  if (nk > 1) issue(1, 1);
  const unsigned sw = (r >> 1) & 7;
  unsigned co[4];
#pragma unroll
  for (int kk = 0; kk < 4; ++kk) co[kk] = (((2 * kk + h) ^ sw) << 4);
  const unsigned ra = (wr * 64 + r) * 128, rb = 32768 + (wc * 64 + r) * 128;
  for (int kt = 0; kt < nk; ++kt) {
    if (kt + 1 < nk) asm volatile("s_waitcnt vmcnt(6)" ::: "memory"); else asm volatile("s_waitcnt vmcnt(0)" ::: "memory");
    asm volatile("s_waitcnt lgkmcnt(0)" ::: "memory");
    __builtin_amdgcn_s_barrier();
    if (kt + 2 < nk) issue(kt + 2, (kt + 2) % 3);
    const unsigned char* base = lds + (kt % 3) * G_STAGE;
    const unsigned char* pa = base + ra;
    const unsigned char* pb = base + rb;
#pragma unroll
    for (int kk = 0; kk < 4; ++kk) {
      const bf16x8 a0 = ld16(pa + co[kk]), a1 = ld16(pa + 4096 + co[kk]);
      const bf16x8 b0 = ld16(pb + co[kk]), b1 = ld16(pb + 4096 + co[kk]);
      acc.a[0][0] = MFMA32(a0, b0, acc.a[0][0]);
      acc.a[0][1] = MFMA32(a0, b1, acc.a[0][1]);
      acc.a[1][0] = MFMA32(a1, b0, acc.a[1][0]);
      acc.a[1][1] = MFMA32(a1, b1, acc.a[1][1]);
    }
  }
}

DI void gate_scan(const Params& p, unsigned char* lds) {
  const int tid = TIDX, lane = tid & 63, wid = tid >> 6;
  unsigned char* ws = p.ws;
  const float* gate = (const float*)(ws + WS_GATE);
  float* s_gl = (float*)lds;
  float* s_A = s_gl + NCH * 4;
  float* s_mc = s_A + NCH * 4;
  float* s_mn = s_mc + NCH * 4;
  __syncthreads();
  for (int pr = wid; pr < NCH * 4; pr += 8) {
    const int cc = pr >> 2, hd = pr & 3;
    const float ig = gate[(size_t)(cc * 64 + lane) * 8 + hd], lf = gate[(size_t)(cc * 64 + lane) * 8 + 4 + hd];
    float g = lf;
#pragma unroll
    for (int o = 1; o < 64; o <<= 1) { const float t = __shfl_up(g, o); if (lane >= o) g += t; }
    float a = ig - g;
#pragma unroll
    for (int o = 32; o >= 1; o >>= 1) a = fmaxf(a, __shfl_xor(a, o));
    const float gl = __shfl(g, 63);
    if (lane == 0) { s_gl[pr] = gl; s_A[pr] = a; }
  }
  __syncthreads();
  if (tid < 4) {
    float m = 0.f;
    float ld = 0.f;
    float* LD = (float*)(ws + WS_LD);
    for (int c = 0; c < 256; ++c) {
      s_mc[c * 4 + tid] = m; LD[c * 4 + tid] = ld;
      const float mn = s_gl[c * 4 + tid] + fmaxf(m, s_A[c * 4 + tid]);
      ld += s_gl[c * 4 + tid] + m - mn;
      m = mn; s_mn[c * 4 + tid] = m;
    }
    LD[256 * 4 + tid] = ld;
    p.out[O_PM + tid] = m;
  } else if (tid >= 64 && tid < 128) {
    const int b = (tid - 64) >> 2, hd = tid & 3, pr = (256 + b) * 4 + hd;
    const float m0 = p.in[I_SM][b * 4 + hd];
    const float m = s_gl[pr] + fmaxf(m0, s_A[pr]);
    s_mc[pr] = m0; s_mn[pr] = m;
    p.out[O_SM + b * 4 + hd] = m;
  }
  __syncthreads();
  for (int pr = wid; pr < NCH * 4; pr += 8) {
    const int cc = pr >> 2, hd = pr & 3;
    const float ig = gate[(size_t)(cc * 64 + lane) * 8 + hd], lf = gate[(size_t)(cc * 64 + lane) * 8 + 4 + hd];
    float g = lf;
#pragma unroll
    for (int o = 1; o < 64; o <<= 1) { const float t = __shfl_up(g, o); if (lane >= o) g += t; }
    const float a = ig - g;
    float pm = a;
#pragma unroll
    for (int o = 1; o < 64; o <<= 1) { const float t = __shfl_up(pm, o); if (lane >= o) pm = fmaxf(pm, t); }
    const float mc = s_mc[pr], mn = s_mn[pr], gl = s_gl[pr];
    const float mt = g + fmaxf(mc, pm);
    const size_t o = (size_t)pr * 64 + lane;
    ((float*)(ws + WS_GC))[o] = g;
    ((float*)(ws + WS_MT))[o] = mt;
    ((float*)(ws + WS_WS))[o] = __expf(gl - g + ig - mn);
    ((float*)(ws + WS_WI))[o] = __expf(g + mc - mt);
    ((float*)(ws + WS_AS))[o] = (ig - g) * LOG2E;
    ((float*)(ws + WS_BT))[o] = (g - mt) * LOG2E;
    if (lane == 0) ((float*)(ws + WS_DEC))[pr] = __expf(gl + mc - mn);
  }
  __syncthreads();
}

DI void phase1(const Params& p, unsigned char* lds) {
  const int tid = TIDX, lane = tid & 63, wid = tid >> 6, r = lane & 31, h = lane >> 5, wr = wid >> 1, wc = wid & 1;
  unsigned char* ws = p.ws;
  if (blockIdx.x == gridDim.x - 1) gate_scan(p, lds);
  const int n_main = 68 * 48, n_mem = 16;
  for (int t = blockIdx.x; t < n_main + n_mem; t += gridDim.x) {
    GemmAcc acc;
    if (t < n_main) {
      const int tm = t / 48, tn = t % 48, m0 = tm * 256, n0 = tn * 128;
      gemm_tile((const bf16_t*)(ws + WS_XN) + (size_t)m0 * 1024, 1024, (const bf16_t*)(ws + WS_WA) + (size_t)n0 * 1024, 1024, 1024, lds, acc, tid);
      bf16_t* PA = (bf16_t*)(ws + WS_R1);
      const int sec = n0 >> 10;
#pragma unroll
      for (int a = 0; a < 2; ++a)
#pragma unroll
        for (int b = 0; b < 2; ++b) {
          __builtin_amdgcn_sched_barrier(0);
          const int n = n0 + wc * 64 + 32 * b + r, mb = m0 + wr * 64 + 32 * a;
          if (sec != 2) {
            const float sc = sec == 1 ? 0.0625f : 1.f;
#pragma unroll
            for (int i = 0; i < 16; ++i) PA[(size_t)(mb + crow(i, h)) * 6144 + n] = f2bf(acc.a[a][b][i] * sc);
          }
          if (sec == 1 || sec == 2) {
            const float sc = sec == 1 ? 0.0625f : 1.f;
            const int f = n & 1023, hd = f >> 8, fe = f & 255;
            bf16_t* T = (bf16_t*)(ws + (sec == 1 ? WS_KT : WS_VTA));
#pragma unroll
            for (int g = 0; g < 4; ++g) {
              const int m = mb + 8 * g + 4 * h, cc = m >> 6, s = m & 63;
              u32x2 o = {pk2(acc.a[a][b][4 * g] * sc, acc.a[a][b][4 * g + 1] * sc), pk2(acc.a[a][b][4 * g + 2] * sc, acc.a[a][b][4 * g + 3] * sc)};
              *(u32x2*)(T + (((size_t)cc * 4 + hd) * 256 + fe) * 64 + s) = o;
            }
          }
        }
    } else {
      const int tt = t - n_main, l = tt >> 3, n0 = (tt & 7) * 128;
      gemm_tile((const bf16_t*)(ws + WS_MEMN) + (size_t)l * 256 * 1024, 1024, (const bf16_t*)(ws + WS_WM) + ((size_t)l * 1024 + n0) * 1024, 1024, 1024, lds, acc, tid);
      const bool isv = n0 >= 512;
      float* of = p.out + (isv ? O_PMV : O_PMK) + (size_t)l * 131072;
      bf16_t* mk = (bf16_t*)(ws + WS_MEMK) + (size_t)(l * 17) * 131072;
      bf16_t* mv = (bf16_t*)(ws + WS_MEMVT) + (size_t)(l * 17) * 131072;
#pragma unroll
      for (int a = 0; a < 2; ++a)
#pragma unroll
        for (int b = 0; b < 2; ++b) {
          __builtin_amdgcn_sched_barrier(0);
          const int f = (n0 & 511) + wc * 64 + 32 * b + r, mb = wr * 64 + 32 * a;
#pragma unroll
          for (int g = 0; g < 4; ++g) {
            const int m = mb + 8 * g + 4 * h;
            float* o4 = of + (size_t)m * 512 + f;
            o4[0] = acc.a[a][b][4 * g]; o4[512] = acc.a[a][b][4 * g + 1]; o4[1024] = acc.a[a][b][4 * g + 2]; o4[1536] = acc.a[a][b][4 * g + 3];
            if (!isv) {
              bf16_t* k4 = mk + (size_t)m * 512 + f;
              k4[0] = f2bf(acc.a[a][b][4 * g]); k4[512] = f2bf(acc.a[a][b][4 * g + 1]); k4[1024] = f2bf(acc.a[a][b][4 * g + 2]); k4[1536] = f2bf(acc.a[a][b][4 * g + 3]);
            } else {
              u32x2 o = {pk2(acc.a[a][b][4 * g], acc.a[a][b][4 * g + 1]), pk2(acc.a[a][b][4 * g + 2], acc.a[a][b][4 * g + 3])};
              const int pq = (m >> 2) & 3, mp = (m & ~15) + 4 * (((pq & 1) << 1) | (pq >> 1));
              *(u32x2*)(mv + (size_t)f * 256 + mp) = o;
            }
          }
        }
    }
  }
}

DI void scan_task(const Params& p, unsigned char* lds, int sb  , int hd, int j, int grp) {
  const int tid = TIDX, lane = tid & 63, wid = tid >> 6, r = lane & 31, h = lane >> 5;
  unsigned char* ws = p.ws;
  const int cc0 = sb < 0 ? GRP * grp : 256 + sb, nch = sb < 0 ? GRP : 1;
  const bf16_t* PA = (const bf16_t*)(ws + WS_R1);
  const bf16_t* KT = (const bf16_t*)(ws + WS_KT);
  const bf16_t* VT = (const bf16_t*)(ws + WS_VTA);
  const float* WSa = (const float*)(ws + WS_WS);
  const float* WIa = (const float*)(ws + WS_WI);
  const float* DEC = (const float*)(ws + WS_DEC);
  float* red = (float*)lds;
  const bool nsl = j == 8;
  f32x16 S = zero16();
  if (sb >= 0) {
    if (!nsl) {
      const float* C0 = p.in[I_SC] + ((size_t)(sb * 4 + hd) * 256 + 32 * j + r) * 256 + 32 * wid;
#pragma unroll
      for (int g = 0; g < 4; ++g) { const f32x4 c = *(const f32x4*)(C0 + 8 * g + 4 * h); S[4 * g] = c[0]; S[4 * g + 1] = c[1]; S[4 * g + 2] = c[2]; S[4 * g + 3] = c[3]; }
    } else if (r == 0) {
      const float* n0 = p.in[I_SN] + (size_t)(sb * 4 + hd) * 256 + 32 * wid;
#pragma unroll
      for (int g = 0; g < 4; ++g) { const f32x4 c = *(const f32x4*)(n0 + 8 * g + 4 * h); S[4 * g] = c[0]; S[4 * g + 1] = c[1]; S[4 * g + 2] = c[2]; S[4 * g + 3] = c[3]; }
    }
  }
  bf16x8 kt[4], wv[4], qf[2][2];
  auto loadc = [&](int cc) {
    const size_t ch = (size_t)cc * 4 + hd;
    const bf16_t* kp = KT + (ch * 256 + 32 * wid + r) * 64 + 8 * h;
#pragma unroll
    for (int st = 0; st < 4; ++st) kt[st] = ld16(kp + 16 * st);
    const float* wsp = WSa + ch * 64 + 8 * h;
    if (!nsl) {
      const bf16_t* vp = VT + (ch * 256 + 32 * j + r) * 64 + 8 * h;
#pragma unroll
      for (int st = 0; st < 4; ++st) {
        const u32x4 v = *(const u32x4*)(vp + 16 * st);
        const f32x4 w0 = *(const f32x4*)(wsp + 16 * st), w1 = *(const f32x4*)(wsp + 16 * st + 4);
        u32x4 o;
        o[0] = pk2(bflo(v[0]) * w0[0], bfhi(v[0]) * w0[1]); o[1] = pk2(bflo(v[1]) * w0[2], bfhi(v[1]) * w0[3]);
        o[2] = pk2(bflo(v[2]) * w1[0], bfhi(v[2]) * w1[1]); o[3] = pk2(bflo(v[3]) * w1[2], bfhi(v[3]) * w1[3]);
        wv[st] = __builtin_bit_cast(bf16x8, o);
      }
    } else {
#pragma unroll
      for (int st = 0; st < 4; ++st) {
        const f32x4 w0 = *(const f32x4*)(wsp + 16 * st), w1 = *(const f32x4*)(wsp + 16 * st + 4);
        u32x4 o = {pk2(w0[0], w0[1]), pk2(w0[2], w0[3]), pk2(w1[0], w1[1]), pk2(w1[2], w1[3])};
        if (r != 0) o = (u32x4){0u, 0u, 0u, 0u};
        wv[st] = __builtin_bit_cast(bf16x8, o);
      }
    }
#pragma unroll
    for (int tt = 0; tt < 2; ++tt) {
      const bf16_t* qp = PA + (size_t)(cc * 64 + 32 * tt + r) * 6144 + hd * 256 + 32 * wid + 4 * h;
#pragma unroll
      for (int s2 = 0; s2 < 2; ++s2) qf[tt][s2] = ld8x2(qp + 16 * s2, qp + 16 * s2 + 8);
    }
  };
  for (int c = 0; c < nch; ++c) {
    const int cc = cc0 + c;
    loadc(cc);
    const float dec = DEC[cc * 4 + hd];
    const bf16x8 xs0 = pack_acc(S, 0), xs1 = pack_acc(S, 1);
    f32x16 z0 = MFMA32(xs0, qf[0][0], zero16()); z0 = MFMA32(xs1, qf[0][1], z0);
    f32x16 z1 = MFMA32(xs0, qf[1][0], zero16()); z1 = MFMA32(xs1, qf[1][1], z1);
    S = S * dec;
#pragma unroll
    for (int st = 0; st < 4; ++st) S = MFMA32(kt[st], wv[st], S);
    __syncthreads();
    {
      float* rw = red + wid * (64 * 33);
#pragma unroll
      for (int i = 0; i < 16; ++i) { rw[r * 33 + crow(i, h)] = z0[i]; rw[(32 + r) * 33 + crow(i, h)] = z1[i]; }
    }
    __syncthreads();
    {
      const int v = tid & 31;
#pragma unroll
      for (int e = 0; e < 4; ++e) {
        const int t = (tid >> 5) + 16 * e;
        float s = 0.f;
#pragma unroll
        for (int w8 = 0; w8 < 8; ++w8) s += red[w8 * (64 * 33) + t * 33 + v];
        const float wi = WIa[((size_t)cc * 4 + hd) * 64 + t];
        if (!nsl) ((float*)(ws + WS_HINTER))[(size_t)(cc * 64 + t) * 1024 + hd * 256 + 32 * j + v] = s * wi;
        else if (v == 0) ((float*)(ws + WS_DENI))[(size_t)(cc * 64 + t) * 4 + hd] = s * wi;
      }
    }
  }
  if (sb < 0) {
    float* cl = (float*)(ws + WS_CLOC) + ((((size_t)(grp * 4 + hd) * 9 + j) * 8 + wid) * 64 + lane) * 16;
#pragma unroll
    for (int g = 0; g < 4; ++g) { f32x4 c = {S[4 * g], S[4 * g + 1], S[4 * g + 2], S[4 * g + 3]}; *(f32x4*)(cl + 4 * g) = c; }
  } else {
    if (!nsl) {
      float* Co = (sb < 0 ? p.out + O_PC + (size_t)hd * 65536 : p.out + O_SC + (size_t)(sb * 4 + hd) * 65536) + (size_t)(32 * j + r) * 256 + 32 * wid;
#pragma unroll
      for (int g = 0; g < 4; ++g) { f32x4 c = {S[4 * g], S[4 * g + 1], S[4 * g + 2], S[4 * g + 3]}; *(f32x4*)(Co + 8 * g + 4 * h) = c; }
    } else if (r == 0) {
      float* no = (sb < 0 ? p.out + O_PN + (size_t)hd * 256 : p.out + O_SN + (size_t)(sb * 4 + hd) * 256) + 32 * wid;
#pragma unroll
      for (int g = 0; g < 4; ++g) { f32x4 c = {S[4 * g], S[4 * g + 1], S[4 * g + 2], S[4 * g + 3]}; *(f32x4*)(no + 8 * g + 4 * h) = c; }
    }
  }
  __syncthreads();
}

DI void intra_task(const Params& p, int cc, int hd) {
  const int tid = TIDX, lane = tid & 63, wid = tid >> 6, r = lane & 31, h = lane >> 5;
  unsigned char* ws = p.ws;
  const int tt = wid & 1, vq = wid >> 1;
  const bf16_t* PA = (const bf16_t*)(ws + WS_R1);
  const bf16_t* VT = (const bf16_t*)(ws + WS_VTA);
  const size_t ch = (size_t)cc * 4 + hd;
  f32x16 s0 = zero16(), s1 = zero16();
  {
    const bf16_t* qp = PA + (size_t)(cc * 64 + 32 * tt + r) * 6144 + hd * 256 + 8 * h;
    const bf16_t* kp = PA + (size_t)(cc * 64 + r) * 6144 + 1024 + hd * 256 + 8 * h;
#pragma unroll 4
    for (int kk = 0; kk < 16; ++kk) {
      const bf16x8 q = ld16(qp + 16 * kk), k0 = ld16(kp + 16 * kk), k1 = ld16(kp + (size_t)32 * 6144 + 16 * kk);
      s0 = MFMA32(k0, q, s0);
      if (tt == 1) s1 = MFMA32(k1, q, s1);
    }
  }
  const int t = 32 * tt + r;
  const float bt = ((const float*)(ws + WS_BT))[ch * 64 + t];
  const float* asp = (const float*)(ws + WS_AS) + ch * 64;
  float den = 0.f;
#pragma unroll
  for (int g = 0; g < 4; ++g) {
    const f32x4 a0 = *(const f32x4*)(asp + 8 * g + 4 * h);
    const f32x4 a1 = *(const f32x4*)(asp + 32 + 8 * g + 4 * h);
#pragma unroll
    for (int e = 0; e < 4; ++e) {
      const int s = 8 * g + 4 * h + e;
      const float w0 = s <= t ? fexp2(bt + a0[e]) : 0.f;
      const float w1 = (32 + s) <= t ? fexp2(bt + a1[e]) : 0.f;
      s0[4 * g + e] *= w0; s1[4 * g + e] *= w1;
      den += s0[4 * g + e] + s1[4 * g + e];
    }
  }
  den += __shfl_xor(den, 32);
  if (vq == 0 && h == 0) ((float*)(ws + WS_DENA))[(size_t)(cc * 64 + t) * 4 + hd] = den;
  bf16x8 pf[2][2];
  pf[0][0] = pack_acc(s0, 0); pf[0][1] = pack_acc(s0, 1); pf[1][0] = pack_acc(s1, 0); pf[1][1] = pack_acc(s1, 1);
  float* Ho = (float*)(ws + WS_HINTRA) + (size_t)(cc * 64 + t) * 1024 + hd * 256;
#pragma unroll
  for (int vt = 0; vt < 2; ++vt) {
    const int v0 = vq * 64 + vt * 32;
    const bf16_t* vp = VT + (ch * 256 + v0 + r) * 64 + 4 * h;
    f32x16 o = zero16();
#pragma unroll
    for (int st = 0; st < 2; ++st)
#pragma unroll
      for (int s2 = 0; s2 < 2; ++s2) {
        const bf16x8 a = ld8x2(vp + 32 * st + 16 * s2, vp + 32 * st + 16 * s2 + 8);
        o = MFMA32(a, pf[st][s2], o);
      }
#pragma unroll
    for (int g = 0; g < 4; ++g) { f32x4 c = {o[4 * g], o[4 * g + 1], o[4 * g + 2], o[4 * g + 3]}; *(f32x4*)(Ho + v0 + 8 * g + 4 * h) = c; }
  }
}

DI void memattn_task(const Params& p, unsigned char* lds, int task, int layer, const bf16_t* Qb, const bf16_t* Zb, unsigned ldq) {
  const int tid = TIDX, lane = tid & 63, wid = __builtin_amdgcn_readfirstlane(tid >> 6), r = lane & 31, h = lane >> 5;
  unsigned char* ws = p.ws;
  const bool prm = task < 256;
  const int hd = task & 3, ti = prm ? task >> 2 : (task - 256) >> 2;
  const int sbi = prm ? 0 : 1 + ti, tok0 = prm ? ti * 256 : TP + ti * 64, nact = prm ? 8 : 2;
  const bf16_t* MK = (const bf16_t*)(ws + WS_MEMK) + (size_t)(layer * 17 + sbi) * 131072 + hd * 128;
  const bf16_t* MV = (const bf16_t*)(ws + WS_MEMVT) + ((size_t)(layer * 17 + sbi) * 4 + hd) * 128 * 256;
  asm volatile("s_waitcnt vmcnt(0)" ::: "memory");
  __syncthreads();
#pragma unroll
  for (int e = 0; e < 8; ++e) {
    const int q = wid * 8 + e;
    { const int row = 4 * q + (lane >> 4), lc = (lane & 15) ^ (row & 15); dma16(MK + ((unsigned)row * 512u + 8u * lc), lds + q * 1024); }
    { const int row = 2 * q + (lane >> 5), lc = (lane & 31) ^ (row & 15); dma16(MV + ((unsigned)row * 256u + 8u * lc), lds + 65536 + q * 1024); }
  }
  const int tok = tok0 + (wid < nact ? wid : 0) * 32 + r;
  bf16x8 qf[8];
  {
    const bf16_t* qp = Qb + ((unsigned)tok * ldq + hd * 128 + 8 * h);
#pragma unroll
    for (int kk = 0; kk < 8; ++kk) qf[kk] = ld16(qp + 16 * kk);
  }
  asm volatile("s_waitcnt vmcnt(0)" ::: "memory");
  __syncthreads();
  if (wid >= nact) return;
  const float sc = 0.08838834764831845f * LOG2E;
  f32x16 O[4];
#pragma unroll
  for (int vt = 0; vt < 4; ++vt) O[vt] = zero16();
  float mrun = -1e30f, l = 0.f;
  const unsigned sw = r & 15;
#pragma unroll 1
  for (int kb = 0; kb < 4; ++kb) {
    f32x16 s0 = zero16(), s1 = zero16();
    const unsigned char* kp = lds + (kb * 64 + r) * 256;
#pragma unroll
    for (int kk = 0; kk < 8; ++kk) {
      const unsigned co = ((unsigned)(2 * kk + h) ^ sw) << 4;
      const bf16x8 k0 = ld16(kp + co), k1 = ld16(kp + 8192 + co);
      s0 = MFMA32(k0, qf[kk], s0); s1 = MFMA32(k1, qf[kk], s1);
    }
    float mx = -1e30f;
#pragma unroll
    for (int i = 0; i < 16; ++i) mx = fmaxf(mx, fmaxf(s0[i], s1[i]));
    mx = fmaxf(mx, __shfl_xor(mx, 32)) * sc;
    const float mnew = fmaxf(mrun, mx), alpha = fexp2(mrun - mnew);
    mrun = mnew;
    float sum = 0.f;
#pragma unroll
    for (int i = 0; i < 16; ++i) { s0[i] = fexp2(s0[i] * sc - mnew); s1[i] = fexp2(s1[i] * sc - mnew); sum += s0[i] + s1[i]; }
    l = l * alpha + sum;
#pragma unroll
    for (int vt = 0; vt < 4; ++vt) O[vt] = O[vt] * alpha;
    bf16x8 pf[2][2];
    pf[0][0] = pack_acc(s0, 0); pf[0][1] = pack_acc(s0, 1); pf[1][0] = pack_acc(s1, 0); pf[1][1] = pack_acc(s1, 1);
#pragma unroll
    for (int vt = 0; vt < 4; ++vt) {
      const unsigned char* vp = lds + 65536 + (32 * vt + r) * 512;
#pragma unroll
      for (int st = 0; st < 2; ++st)
#pragma unroll
        for (int s2 = 0; s2 < 2; ++s2) {
          const unsigned co = ((unsigned)(8 * kb + 4 * st + 2 * s2 + h) ^ sw) << 4;
          O[vt] = MFMA32(ld16(vp + co), pf[st][s2], O[vt]);
        }
    }
  }
  l += __shfl_xor(l, 32);
  const float inv = 1.f / l;
  const bf16_t* zp = Zb + ((unsigned)tok * ldq + hd * 128);
  bf16_t* op = (bf16_t*)(ws + WS_AO) + ((unsigned)tok * 1536u + 1024 + hd * 128);
#pragma unroll
  for (int vt = 0; vt < 4; ++vt)
#pragma unroll
    for (int g = 0; g < 4; ++g) {
      const int v = 32 * vt + 8 * g + 4 * h;
      const u32x2 z = *(const u32x2*)(zp + v);
      const float o0 = O[vt][4 * g] * inv * siluf_(bflo(z[0])), o1 = O[vt][4 * g + 1] * inv * siluf_(bfhi(z[0]));
      const float o2 = O[vt][4 * g + 2] * inv * siluf_(bflo(z[1])), o3 = O[vt][4 * g + 3] * inv * siluf_(bfhi(z[1]));
      u32x2 o = {pk2(o0, o1), pk2(o2, o3)};
      *(u32x2*)(op + v) = o;
    }
}

DI int next_item(unsigned* ctr, unsigned char* lds_flag_area, int tid) {
  __syncthreads();
  int* sh = (int*)lds_flag_area;
  if (tid == 0) *sh = (int)atomicAdd(ctr, 1u);
  __syncthreads();
  const int v = *sh;
  return v;
}

DI void phase2(const Params& p, unsigned char* lds) {
  unsigned* ctr = (unsigned*)(p.ws + WS_CTR) + 0 + 8 * p.pad;
  const bf16_t* PA = (const bf16_t*)(p.ws + WS_R1);
  const int n_ps = 36 * 16, n_ss = 576, n_in = NCH * 4, n_ma = 256 + 64;
  for (;;) {
    const int it = next_item(ctr, lds + LDS_BYTES - 16, TIDX);
    if (it >= n_ps + n_ss + n_in + n_ma) break;
    if (it < n_ps) scan_task(p, lds, -1, (it % 36) / 9, it % 9, it / 36);
    else if (it < n_ps + n_ss) { const int q = it - n_ps; scan_task(p, lds, q / 36, (q % 36) / 9, q % 9, 0); }
    else if (it < n_ps + n_ss + n_in) { const int q = it - n_ps - n_ss; intra_task(p, q >> 2, q & 3); }
    else { const int q = it - n_ps - n_ss - n_in; memattn_task(p, lds, q, 0, PA + 5120, PA + 5632, 6144); }
  }
}


DI void scanfix_task(const Params& p, unsigned char* lds, int grp, int hd, int j) {
  const int tid = TIDX, lane = tid & 63, wid = tid >> 6, r = lane & 31, h = lane >> 5;
  unsigned char* ws = p.ws;
  const bool nsl = j == 8;
  const float* LD = (const float*)(ws + WS_LD);
  f32x16 S = zero16();
  for (int gp = 0; gp < grp; ++gp) {
    const float dg = __expf(LD[(GRP * (gp + 1)) * 4 + hd] - LD[(GRP * gp) * 4 + hd]);
    const float* cl = (const float*)(ws + WS_CLOC) + ((((size_t)(gp * 4 + hd) * 9 + j) * 8 + wid) * 64 + lane) * 16;
#pragma unroll
    for (int g = 0; g < 4; ++g) { const f32x4 c = *(const f32x4*)(cl + 4 * g);
      S[4 * g] = S[4 * g] * dg + c[0]; S[4 * g + 1] = S[4 * g + 1] * dg + c[1]; S[4 * g + 2] = S[4 * g + 2] * dg + c[2]; S[4 * g + 3] = S[4 * g + 3] * dg + c[3]; }
  }
  if (grp == 16) {
    if (!nsl) {
      float* Co = p.out + O_PC + (size_t)hd * 65536 + (size_t)(32 * j + r) * 256 + 32 * wid;
#pragma unroll
      for (int g = 0; g < 4; ++g) { f32x4 c = {S[4 * g], S[4 * g + 1], S[4 * g + 2], S[4 * g + 3]}; *(f32x4*)(Co + 8 * g + 4 * h) = c; }
    } else if (r == 0) {
      float* no = p.out + O_PN + (size_t)hd * 256 + 32 * wid;
#pragma unroll
      for (int g = 0; g < 4; ++g) { f32x4 c = {S[4 * g], S[4 * g + 1], S[4 * g + 2], S[4 * g + 3]}; *(f32x4*)(no + 8 * g + 4 * h) = c; }
    }
    return;
  }
  u32x4* fr = (u32x4*)lds;
  float* tp = (float*)(lds + 16384) + wid * (64 * 33);
  __syncthreads();
  fr[(wid * 2 + 0) * 64 + lane] = __builtin_bit_cast(u32x4, pack_acc(S, 0));
  fr[(wid * 2 + 1) * 64 + lane] = __builtin_bit_cast(u32x4, pack_acc(S, 1));
  __syncthreads();
  bf16x8 xf[8][2];
#pragma unroll
  for (int kt = 0; kt < 8; ++kt) { xf[kt][0] = __builtin_bit_cast(bf16x8, fr[(kt * 2 + 0) * 64 + lane]); xf[kt][1] = __builtin_bit_cast(bf16x8, fr[(kt * 2 + 1) * 64 + lane]); }
  const bf16_t* PA = (const bf16_t*)(ws + WS_R1);
  const float* WIa = (const float*)(ws + WS_WI);
#pragma unroll 1
  for (int ci = 0; ci < 2; ++ci) {
    const int cc = GRP * grp + wid + 8 * ci;
    const float D = __expf(LD[cc * 4 + hd] - LD[(GRP * grp) * 4 + hd]);
#pragma unroll
    for (int tt = 0; tt < 2; ++tt) {
      const bf16_t* qp = PA + (size_t)(cc * 64 + 32 * tt + r) * 6144 + hd * 256 + 4 * h;
      f32x16 z = zero16();
#pragma unroll
      for (int kt = 0; kt < 8; ++kt)
#pragma unroll
        for (int s2 = 0; s2 < 2; ++s2) {
          const bf16x8 q = ld8x2(qp + 32 * kt + 16 * s2, qp + 32 * kt + 16 * s2 + 8);
          z = MFMA32(xf[kt][s2], q, z);
        }
#pragma unroll
      for (int i = 0; i < 16; ++i) tp[(32 * tt + r) * 33 + crow(i, h)] = z[i];
    }
    const int v = lane & 31;
#pragma unroll 4
    for (int e = 0; e < 32; ++e) {
      const int t = 2 * e + (lane >> 5);
      const float val = tp[t * 33 + v] * (WIa[((size_t)cc * 4 + hd) * 64 + t] * D);
      if (!nsl) { float* d = (float*)(ws + WS_HINTER) + (size_t)(cc * 64 + t) * 1024 + hd * 256 + 32 * j + v; *d += val; }
      else if (v == 0) { float* d = (float*)(ws + WS_DENI) + (size_t)(cc * 64 + t) * 4 + hd; *d += val; }
    }
  }
}

DI void phase2c(const Params& p, unsigned char* lds) {
  unsigned* ctr = (unsigned*)(p.ws + WS_CTR) + 3 + 8 * p.pad;
  for (;;) {
    const int it = next_item(ctr, lds + LDS_BYTES - 16, TIDX);
    if (it >= 16 * 36) break;
    const int g = 16 - it / 36;
    scanfix_task(p, lds, g, (it % 36) / 9, it % 9);
  }
}

DI void phase3(const Params& p) {
  const int tid = TIDX, lane = tid & 63, wid = tid >> 6;
  unsigned char* ws = p.ws;
  const int gw = blockIdx.x * 8 + wid, nw = gridDim.x * 8;
  const bf16_t* PA = (const bf16_t*)(ws + WS_R1);
  for (int it = gw; it < TT * 4; it += nw) {
    const int tok = it >> 2, hd = it & 3, cc = tok >> 6, t = tok & 63;
    const size_t off = (size_t)tok * 1024 + hd * 256 + 4 * lane;
    const f32x4 a = *(const f32x4*)((const float*)(ws + WS_HINTER) + off), b = *(const f32x4*)((const float*)(ws + WS_HINTRA) + off);
    const float den = ((const float*)(ws + WS_DENI))[tok * 4 + hd] + ((const float*)(ws + WS_DENA))[tok * 4 + hd];
    const float mt = ((const float*)(ws + WS_MT))[((size_t)cc * 4 + hd) * 64 + t];
    const float dn = 1.f / fmaxf(fabsf(den), __expf(-mt));
    const u32x2 ou = *(const u32x2*)(PA + (size_t)tok * 6144 + 3072 + hd * 256 + 4 * lane);
    const u32x2 zu = *(const u32x2*)(PA + (size_t)tok * 6144 + 4096 + hd * 256 + 4 * lane);
    f32x4 hv = (a + b) * dn;
    hv[0] *= sigmoidf_(bflo(ou[0])); hv[1] *= sigmoidf_(bfhi(ou[0])); hv[2] *= sigmoidf_(bflo(ou[1])); hv[3] *= sigmoidf_(bfhi(ou[1]));
    float ss = hv[0] * hv[0] + hv[1] * hv[1] + hv[2] * hv[2] + hv[3] * hv[3];
    ss = wave_sum(ss);
    const float rstd = __builtin_amdgcn_rsqf(ss * (1.f / 256.f) + EPS);
    const f32x4 hg = *(const f32x4*)(p.in[I_HGA] + hd * 256 + 4 * lane);
    hv = hv * rstd * hg;
    hv[0] *= siluf_(bflo(zu[0])); hv[1] *= siluf_(bfhi(zu[0])); hv[2] *= siluf_(bflo(zu[1])); hv[3] *= siluf_(bfhi(zu[1]));
    u32x2 o = {pk2(hv[0], hv[1]), pk2(hv[2], hv[3])};
    *(u32x2*)((bf16_t*)(ws + WS_AO) + (size_t)tok * 1536 + hd * 256 + 4 * lane) = o;
  }
}

DI void phase_outproj(const Params& p, unsigned char* lds, int layer) {
  const int tid = TIDX, lane = tid & 63, wid = tid >> 6, r = lane & 31, h = lane >> 5, wr = wid >> 1, wc = wid & 1;
  unsigned char* ws = p.ws;
  const bf16_t* W = (const bf16_t*)(ws + (layer == 0 ? WS_WOA : WS_WOB));
  for (int t = blockIdx.x; t < 68 * 8; t += gridDim.x) {
    const int tm = t >> 3, tn = t & 7, m0 = tm * 256, n0 = tn * 128;
    GemmAcc acc;
    gemm_tile((const bf16_t*)(ws + WS_AO) + (size_t)m0 * 1536, 1536, W + (size_t)n0 * 1536, 1536, 1536, lds, acc, tid);
#pragma unroll
    for (int a = 0; a < 2; ++a)
#pragma unroll
      for (int b = 0; b < 2; ++b) {
        const int n = n0 + wc * 64 + 32 * b + r, mb = m0 + wr * 64 + 32 * a;
#pragma unroll
        for (int i = 0; i < 16; ++i) {
          const int m = mb + crow(i, h);
          if (layer == 0) {
            const float xv = m < TP ? p.in[I_XP][(size_t)m * 1024 + n] : p.in[I_XS][(size_t)(m - TP) * 1024 + n];
            ((float*)(ws + WS_Y1))[(size_t)m * 1024 + n] = xv + acc.a[a][b][i];
          } else {
            p.out[O_Y + (size_t)m * 1024 + n] = ((const float*)(ws + WS_Y1))[(size_t)m * 1024 + n] + acc.a[a][b][i];
          }
        }
      }
  }
}

DI void phase5(const Params& p, unsigned char* lds) {
  const int tid = TIDX, lane = tid & 63, wid = tid >> 6;
  unsigned char* ws = p.ws;
  const int gw = blockIdx.x * 8 + wid, nw = gridDim.x * 8;
  for (int r = gw; r < TT; r += nw) {
    f32x4 v[4];
    const float rstd = row_load_rstd((const float*)(ws + WS_Y1) + (size_t)r * 1024, v, lane);
    bf16_t* xn = (bf16_t*)(ws + WS_XN) + (size_t)r * 1024;
#pragma unroll
    for (int j = 0; j < 4; ++j) { const f32x4 xs = v[j] * rstd; u32x2 o = {pk2(xs[0], xs[1]), pk2(xs[2], xs[3])}; *(u32x2*)(xn + 4 * lane + 256 * j) = o; }
  }
  {
    float* smax = (float*)lds;
    const int hm = (tid & 127) >> 3;
    for (int b = 0; b < 16; ++b) {
      __syncthreads();
      if (tid < 16) smax[tid] = 0.f;
      __syncthreads();
      float mx = 0.f;
      const size_t n8 = (size_t)PAST * 1024 / 8;
      const float* src = p.in[I_CK] + (size_t)b * PAST * 1024;
      bf16_t* dst = (bf16_t*)(ws + WS_KBS) + (size_t)b * SKV * 1024;
      for (size_t i = (size_t)blockIdx.x * NTHREADS + tid; i < n8; i += (size_t)gridDim.x * NTHREADS) {
        const size_t e = i * 8;
        const f32x4 a = *(const f32x4*)(src + e), c = *(const f32x4*)(src + e + 4);
        u32x4 o = {pk2(a[0], a[1]), pk2(a[2], a[3]), pk2(c[0], c[1]), pk2(c[2], c[3])};
        *(u32x4*)(dst + e) = o;
        float ss = a[0] * a[0] + a[1] * a[1] + a[2] * a[2] + a[3] * a[3] + c[0] * c[0] + c[1] * c[1] + c[2] * c[2] + c[3] * c[3];
        ss += __shfl_xor(ss, 1); ss += __shfl_xor(ss, 2); ss += __shfl_xor(ss, 4);
        mx = fmaxf(mx, ss);
      }
      if ((tid & 7) == 0) atomicMax((unsigned*)smax + hm, __float_as_uint(mx));
      __syncthreads();
      if (tid < 16) atomicMax((unsigned*)(ws + WS_KMAX) + (1 + b) * 16 + tid, __float_as_uint(sqrtf(smax[tid])));
    }
  }
  __syncthreads();
  for (int t = blockIdx.x; t < 128 * 128; t += gridDim.x) {
    const int jb = t >> 7, tile = t & 127, b = jb >> 3, hd = jb & 7;
    TJob j = {p.in[I_CV] + (size_t)b * PAST * 1024 + hd * 128, 1024, (bf16_t*)(ws + WS_VTS) + ((size_t)(b * 8 + hd) * 128) * SKV, SKV, nullptr, 64, 2};
    run_tjob_tile(j, tile, (float*)lds, tid, true);
  }
}

DI void phase6(const Params& p, unsigned char* lds) {
  const int tid = TIDX, lane = tid & 63, wid = tid >> 6, r = lane & 31, h = lane >> 5, wr = wid >> 1, wc = wid & 1;
  unsigned char* ws = p.ws;
  for (int t = blockIdx.x; t < 68 * 40; t += gridDim.x) {
    const int tm = t / 40, tn = t % 40, m0 = tm * 256, n0 = tn * 128;
    GemmAcc acc;
    gemm_tile((const bf16_t*)(ws + WS_XN) + (size_t)m0 * 1024, 1024, (const bf16_t*)(ws + WS_WKB) + (size_t)n0 * 1024, 1024, 1024, lds, acc, tid);
    const int sec = n0 >> 10;
    const bool samp = m0 >= TP;
#pragma unroll
    for (int a = 0; a < 2; ++a)
#pragma unroll
      for (int b = 0; b < 2; ++b) {
        const int n = n0 + wc * 64 + 32 * b + r, mb = m0 + wr * 64 + 32 * a;
        if (sec == 0) {
          const int f = n;
          if (b == 1) {
            float mx = 0.f;
#pragma unroll
            for (int i = 0; i < 16; ++i) {
              float ss = acc.a[a][0][i] * acc.a[a][0][i] + acc.a[a][1][i] * acc.a[a][1][i];
              ss += __shfl_xor(ss, 1); ss += __shfl_xor(ss, 2); ss += __shfl_xor(ss, 4); ss += __shfl_xor(ss, 8); ss += __shfl_xor(ss, 16);
              mx = fmaxf(mx, ss);
            }
            mx = fmaxf(mx, __shfl_xor(mx, 32));
            if (lane == 0) {
              const int strm = samp ? 1 + ((mb - TP) >> 6) : 0;
              atomicMax((unsigned*)(ws + WS_KMAX) + strm * 16 + ((n0 + wc * 64) >> 6), __float_as_uint(sqrtf(mx)));
            }
          }
#pragma unroll
          for (int i = 0; i < 16; ++i) {
            const int m = mb + crow(i, h);
            const float v = acc.a[a][b][i];
            if (!samp) { p.out[O_PK + (size_t)m * 1024 + f] = v; ((bf16_t*)(ws + WS_KBP))[(size_t)m * 1024 + f] = f2bf(v); }
            else { const int ms = m - TP, bb = ms >> 6, s = ms & 63; p.out[O_SK + (size_t)ms * 1024 + f] = v;
                   ((bf16_t*)(ws + WS_KBS))[((size_t)bb * SKV + PAST + s) * 1024 + f] = f2bf(v); }
          }
        } else if (sec == 1) {
          const int f = n - 1024, hd = f >> 7, vd = f & 127;
#pragma unroll
          for (int i = 0; i < 16; ++i) {
            const int m = mb + crow(i, h);
            if (!samp) p.out[O_PV + (size_t)m * 1024 + f] = acc.a[a][b][i]; else p.out[O_SV + (size_t)(m - TP) * 1024 + f] = acc.a[a][b][i];
          }
#pragma unroll
          for (int g = 0; g < 4; ++g) {
            const int m0r = mb + 8 * g + 4 * h, pq = (m0r >> 2) & 3;
            const int m = (m0r & ~15) + 4 * (((pq & 1) << 1) | (pq >> 1));
            u32x2 o = {pk2(acc.a[a][b][4 * g], acc.a[a][b][4 * g + 1]), pk2(acc.a[a][b][4 * g + 2], acc.a[a][b][4 * g + 3])};
            if (!samp) *(u32x2*)((bf16_t*)(ws + WS_VTP) + ((size_t)hd * 128 + vd) * TP + m) = o;
            else { const int ms = m - TP, bb = ms >> 6, s = ms & 63; *(u32x2*)((bf16_t*)(ws + WS_VTS) + ((size_t)(bb * 8 + hd) * 128 + vd) * SKV + PAST + s) = o; }
          }
        } else {
          const float sc = sec == 2 ? 0.125f * LOG2E : 1.f;
          bf16_t* PB = (bf16_t*)(ws + WS_PB);
#pragma unroll
          for (int i = 0; i < 16; ++i) PB[(size_t)(mb + crow(i, h)) * 3072 + (n - 2048)] = f2bf(acc.a[a][b][i] * sc);
        }
      }
  }
}

constexpr int A_BUF = 32768, A_KB = 16384, A_FLAGS = 3 * A_BUF;

DI void diffattn_task(const Params& p, unsigned char* lds, int sb  , int qt  , int hd, float lam) {
  const int tid = TIDX, lane = tid & 63, wid = __builtin_amdgcn_readfirstlane(tid >> 6), r = lane & 31, h = lane >> 5;
  unsigned char* ws = p.ws;
  const int cq = wid >> 2, sub = (wid >> 1) & 1, map = wid & 1;
  const int ncq = sb < 0 ? 2 : 1;
  const int base_chunk = sb < 0 ? 2 * qt : 64;
  const int tok0 = sb < 0 ? qt * 128 : TP + sb * 64;
  const bool wvalid = cq < ncq;
  const int qc = base_chunk + cq;
  const int tl = 32 * sub + r;
  const int tok = tok0 + 64 * (wvalid ? cq : 0) + tl;
  const bf16_t* Kb = sb < 0 ? (const bf16_t*)(ws + WS_KBP) + hd * 128 : (const bf16_t*)(ws + WS_KBS) + (size_t)sb * SKV * 1024 + hd * 128;
  const bf16_t* Vb = sb < 0 ? (const bf16_t*)(ws + WS_VTP) + (size_t)hd * 128 * TP : (const bf16_t*)(ws + WS_VTS) + (size_t)(sb * 8 + hd) * 128 * SKV;
  const unsigned ldv = sb < 0 ? TP : SKV;
  const bf16_t* PB = (const bf16_t*)(ws + WS_PB);
  bf16x8 qf[4];
  float qn = 0.f;
  {
    const unsigned qo = (unsigned)tok * 3072u + hd * 128 + map * 64 + 8 * h;
#pragma unroll
    for (int kk = 0; kk < 4; ++kk) {
      const u32x4 u = *(const u32x4*)(PB + (qo + 16 * kk));
      qf[kk] = __builtin_bit_cast(bf16x8, u);
#pragma unroll
      for (int e = 0; e < 4; ++e) { const float a = bflo(u[e]), b = bfhi(u[e]); qn += a * a + b * b; }
    }
    qn += __shfl_xor(qn, 32);
    qn = sqrtf(qn);
  }
  const float kmax = ((const float*)(ws + WS_KMAX))[(sb < 0 ? 0 : 1 + sb) * 16 + hd * 2 + map];
  const float sbound = qn * kmax * 1.02f + 0.5f;
  const float sl2 = exp2f(-(float)(hd + 1)) * LOG2E;
  const float bh0 = sl2 * (float)(4 * h), bh1 = bh0 + 32.f * sl2;
  float cs[16];
#pragma unroll
  for (int i = 0; i < 16; ++i) cs[i] = __uint_as_float(__builtin_amdgcn_readfirstlane(__float_as_uint(sl2 * (float)((i & 3) + 8 * (i >> 2)))));
  f32x16 O[4];
#pragma unroll
  for (int vt = 0; vt < 4; ++vt) O[vt] = zero16();
  float mrun = -1e30f, l = 0.f;
  const int jmax = base_chunk + ncq - 1, nit = jmax + 1;
  unsigned kofs[2], vofs[2];
#pragma unroll
  for (int e = 0; e < 2; ++e) {
    const int q = wid * 2 + e;
    { const int row = 4 * q + (lane >> 4), lc = (lane & 15) ^ (row & 15); kofs[e] = (unsigned)row * 1024u + 8u * lc; }
    { const int row = 8 * q + (lane >> 3), lc = (lane & 7) ^ ((row >> 1) & 7); vofs[e] = (unsigned)row * ldv + 8u * lc; }
  }
  auto issue = [&](int j, int buf) {
    const bf16_t* kj = Kb + (size_t)j * 65536;
    const bf16_t* vj = Vb + (size_t)j * 64;
    unsigned char* base = lds + buf * A_BUF;
#pragma unroll
    for (int e = 0; e < 2; ++e) {
      dma16(kj + kofs[e], base + (wid * 2 + e) * 1024);
      dma16(vj + vofs[e], base + A_KB + (wid * 2 + e) * 1024);
    }
  };
  int* flags = (int*)(lds + A_FLAGS);
  unsigned kco[4], vco[4];
#pragma unroll
  for (int kk = 0; kk < 4; ++kk) kco[kk] = (unsigned)r * 256u + ((((unsigned)(8 * map + 2 * kk + h)) ^ (unsigned)(r & 15)) << 4);
#pragma unroll
  for (int sx = 0; sx < 4; ++sx) vco[sx] = A_KB + (unsigned)r * 128u + ((((unsigned)(2 * sx + h)) ^ (unsigned)((r >> 1) & 7)) << 4);
  asm volatile("s_waitcnt vmcnt(0)" ::: "memory");
  __syncthreads();
  issue(jmax, 0);
  if (nit > 1) issue(jmax - 1, 1);
  for (int it = 0; it < nit; ++it) {
    const int j = jmax - it;
    if (it + 1 < nit) asm volatile("s_waitcnt vmcnt(4)" ::: "memory"); else asm volatile("s_waitcnt vmcnt(0)" ::: "memory");
    asm volatile("s_waitcnt lgkmcnt(0)" ::: "memory");
    __builtin_amdgcn_s_barrier();
    if (it > 0) {
      const int* f = flags + ((it - 1) & 1) * 8;
      if ((f[0] & f[1] & f[2] & f[3] & f[4] & f[5] & f[6] & f[7]) != 0) break;
    }
    if (it + 2 < nit) issue(j - 2, (it + 2) % 3);
    bool stop = true;
    if (wvalid && j <= qc) {
      const unsigned char* base = lds + (it % 3) * A_BUF;
      f32x16 s0, s1;
      {
        float b0 = bh0, b1 = bh1;
        asm volatile("" : "+v"(b0), "+v"(b1));
#pragma unroll
        for (int i = 0; i < 16; ++i) { s0[i] = b0 + cs[i]; s1[i] = b1 + cs[i]; }
      }
      if (j == qc) {
        int tlv = tl;
        asm volatile("" : "+v"(tlv));
        const float m2 = -2.f * sl2;
#pragma unroll
        for (int i = 0; i < 16; ++i) {
          const int s = crow(i, h);
          s0[i] = fmaf(m2, (float)max(0, s - tlv), s0[i]); s1[i] = fmaf(m2, (float)max(0, 32 + s - tlv), s1[i]);
        }
      }
#pragma unroll
      for (int kk = 0; kk < 4; ++kk) {
        const bf16x8 k0 = ld16(base + kco[kk]), k1 = ld16(base + 8192 + kco[kk]);
        s0 = MFMA32(k0, qf[kk], s0); s1 = MFMA32(k1, qf[kk], s1);
      }
      const float dofs = sl2 * (float)((qc - j) * 64);
      float mx = -1e30f;
#pragma unroll
      for (int i = 0; i < 16; ++i) mx = fmaxf(mx, fmaxf(s0[i], s1[i]));
      mx = fmaxf(mx, __shfl_xor(mx, 32)) - dofs;
      const float mnew = fmaxf(mrun, mx), mm = mnew + dofs;
      if (__builtin_amdgcn_ballot_w64(mnew > mrun) != 0ull) {
        const float alpha = fexp2(mrun - mnew);
        l *= alpha;
#pragma unroll
        for (int vt = 0; vt < 4; ++vt) O[vt] = O[vt] * alpha;
      }
      mrun = mnew;
      float sum = 0.f;
#pragma unroll
      for (int i = 0; i < 16; ++i) { s0[i] = fexp2(s0[i] - mm); s1[i] = fexp2(s1[i] - mm); sum += s0[i] + s1[i]; }
      l += sum;
      bf16x8 pf[2][2];
      pf[0][0] = pack_acc(s0, 0); pf[0][1] = pack_acc(s0, 1); pf[1][0] = pack_acc(s1, 0); pf[1][1] = pack_acc(s1, 1);
#pragma unroll
      for (int vt = 0; vt < 4; ++vt) {
#pragma unroll
        for (int st = 0; st < 2; ++st)
#pragma unroll
          for (int s2 = 0; s2 < 2; ++s2) O[vt] = MFMA32(ld16(base + 4096 * vt + vco[2 * st + s2]), pf[st][s2], O[vt]);
      }
      const float nb = sbound + sl2 * (float)(63 - (qc - j + 1) * 64) - mrun;
      stop = __builtin_amdgcn_ballot_w64(nb >= -152.f) == 0ull;
    } else if (wvalid) stop = false;
    if (lane == 0) flags[(it & 1) * 8 + wid] = stop ? 1 : 0;
  }
  asm volatile("s_waitcnt vmcnt(0)" ::: "memory");
  __syncthreads();
  l += __shfl_xor(l, 32);
  const float inv = wvalid ? 1.f / l : 0.f;
  float* xch = (float*)lds + (size_t)(wid >> 1) * 4096;
  if (map == 1 && wvalid) {
    const float sc = inv * lam;
#pragma unroll
    for (int vt = 0; vt < 4; ++vt)
#pragma unroll
      for (int i = 0; i < 16; ++i) xch[(vt * 16 + i) * 64 + lane] = O[vt][i] * sc;
  }
  __syncthreads();
  if (map == 0 && wvalid) {
    float ss = 0.f;
#pragma unroll
    for (int vt = 0; vt < 4; ++vt)
#pragma unroll
      for (int i = 0; i < 16; ++i) { const float o = O[vt][i] * inv - xch[(vt * 16 + i) * 64 + lane]; O[vt][i] = o; ss += o * o; }
    ss += __shfl_xor(ss, 32);
    const float lam_init = 0.8f - 0.6f * 0.7408182206817179f;
    const float rs = __builtin_amdgcn_rsqf(ss * (1.f / 128.f) + EPS) * (1.f - lam_init);
    const unsigned zo = (unsigned)tok * 3072u + 1024 + hd * 128, oo = (unsigned)tok * 1536u + hd * 128;
    bf16_t* AOp = (bf16_t*)(ws + WS_AO);
    const float* sg = p.in[I_SUBG];
#pragma unroll
    for (int vt = 0; vt < 4; ++vt)
#pragma unroll
      for (int g = 0; g < 4; ++g) {
        const int v = 32 * vt + 8 * g + 4 * h;
        const u32x2 z = *(const u32x2*)(PB + (zo + v));
        const f32x4 gg = *(const f32x4*)(sg + v);
        const float o0 = O[vt][4 * g] * rs * gg[0] * siluf_(bflo(z[0])), o1 = O[vt][4 * g + 1] * rs * gg[1] * siluf_(bfhi(z[0]));
        const float o2 = O[vt][4 * g + 2] * rs * gg[2] * siluf_(bflo(z[1])), o3 = O[vt][4 * g + 3] * rs * gg[3] * siluf_(bfhi(z[1]));
        u32x2 o = {pk2(o0, o1), pk2(o2, o3)};
        *(u32x2*)(AOp + (oo + v)) = o;
      }
  }
  __syncthreads();
}

DI void phase7(const Params& p, unsigned char* lds) {
  unsigned* ctr = (unsigned*)(p.ws + WS_CTR) + 1 + 8 * p.pad;
  const bf16_t* PB = (const bf16_t*)(p.ws + WS_PB);
  float lam;
  {
    const int lane = TIDX & 63;
    const float* lv = p.in[I_LAMB];
    const float a = wave_sum(lv[lane] * lv[64 + lane]), b = wave_sum(lv[128 + lane] * lv[192 + lane]);
    const float lam_init = 0.8f - 0.6f * 0.7408182206817179f;
    lam = __expf(a) - __expf(b) + lam_init;
  }
  const int n_s = 128, n_p = 1024, n_ma = 256 + 64;
  const int* tord = (const int*)(p.ws + WS_TORD);
  for (;;) {
    const int it = next_item(ctr, lds + LDS_BYTES - 16, TIDX);
    if (it >= n_s + n_p) break;
    const int a = tord[it];
    const bool pr = a < n_p;
    diffattn_task(p, lds, pr ? -1 : ((a - n_p) >> 3), pr ? (a >> 3) : 0, a & 7, lam);
  }
  for (;;) {
    const int it = next_item(ctr + 1, lds + LDS_BYTES - 16, TIDX);
    if (it >= n_ma) break;
    memattn_task(p, lds, it, 1, PB + 2048, PB + 2560, 3072);
  }
}

DI void phase9(const Params& p) {
  const int tid = TIDX, lane = tid & 63, wid = tid >> 6;
  const int gw = blockIdx.x * 8 + wid, nw = gridDim.x * 8;
  for (int r = gw; r < TT; r += nw) {
    f32x4 v[4];
    float* row = p.out + O_Y + (size_t)r * 1024;
    const float rstd = row_load_rstd(row, v, lane);
#pragma unroll
    for (int j = 0; j < 4; ++j) {
      const f32x4 g = *(const f32x4*)(p.in[I_FNG] + 4 * lane + 256 * j);
      *(f32x4*)(row + 4 * lane + 256 * j) = v[j] * rstd * g;
    }
  }
}

DI void grid_barrier(unsigned* bar, unsigned target, int tid) {
  asm volatile("s_waitcnt vmcnt(0)" ::: "memory");
  __syncthreads();
  if (tid == 0) {
    __builtin_amdgcn_fence(__ATOMIC_RELEASE, "agent");
    asm volatile("s_waitcnt vmcnt(0)" ::: "memory");
    __hip_atomic_fetch_add(bar, 1u, __ATOMIC_RELAXED, __HIP_MEMORY_SCOPE_AGENT);
    while (__hip_atomic_load(bar, __ATOMIC_RELAXED, __HIP_MEMORY_SCOPE_AGENT) < target) __builtin_amdgcn_s_sleep(1);
    __builtin_amdgcn_fence(__ATOMIC_ACQUIRE, "agent");
    asm volatile("s_waitcnt vmcnt(0)" ::: "memory");
  }
  __syncthreads();
}

__global__ __launch_bounds__(512) void mk(Params pin) {
  extern __shared__ __attribute__((aligned(16))) unsigned char lds[];
  Params p = pin;
  p.wv = __builtin_amdgcn_readfirstlane((int)(__builtin_amdgcn_workitem_id_x() >> 6));
  cg::grid_group grid = cg::this_grid();
  unsigned nbar = 0;
  unsigned* bar = (unsigned*)(p.ws + WS_CTR) + 32;
#define RUN_PHASE(PH, CALL) if (p.ph_lo <= PH && PH < p.ph_hi) { CALL; if (PH + 1 < p.ph_hi) { ++nbar; grid_barrier(bar, nbar * gridDim.x, TIDX); } }
  if (p.ph_lo <= 0 && 0 < p.ph_hi) { phase0(p, lds); if (1 < p.ph_hi) grid.sync(); }
  RUN_PHASE(1, phase1(p, lds))
  RUN_PHASE(2, phase2(p, lds))
  if (p.ph_lo <= 2 && 2 < p.ph_hi) { phase2c(p, lds); ++nbar; grid_barrier(bar, nbar * gridDim.x, TIDX); }
  RUN_PHASE(3, phase3(p))
  RUN_PHASE(4, phase_outproj(p, lds, 0))
  RUN_PHASE(5, phase5(p, lds))
  RUN_PHASE(6, phase6(p, lds))
  RUN_PHASE(7, phase7(p, lds))
  RUN_PHASE(8, phase_outproj(p, lds, 1))
  RUN_PHASE(9, phase9(p))
}

extern "C" void kernel_launch(void* const* d_in, const int* in_sizes, int n_in, void* d_out, int out_size,
                              void* d_ws, size_t ws_size, hipStream_t stream) {
  static int grid_blocks = 0;
  if (!grid_blocks) {
    int dev = 0, cus = 0, per_cu = 0;
    (void)hipGetDevice(&dev);
    (void)hipDeviceGetAttribute(&cus, hipDeviceAttributeMultiprocessorCount, dev);
    (void)hipFuncSetAttribute((const void*)mk, hipFuncAttributeMaxDynamicSharedMemorySize, LDS_BYTES);
    (void)hipOccupancyMaxActiveBlocksPerMultiprocessor(&per_cu, (const void*)mk, NTHREADS, LDS_BYTES);
    grid_blocks = cus;
    fprintf(stderr, "kernel_launch: cus=%d per_cu=%d grid=%d ws=%zu need=%zu\n", cus, per_cu, grid_blocks, ws_size, (size_t)WS_END);
  }
  if (ws_size < WS_END) { fprintf(stderr, "workspace too small\n"); return; }
  Params p{};
  for (int i = 0; i < 24; ++i) p.in[i] = (const float*)d_in[i];
  p.out = (float*)d_out; p.ws = (unsigned char*)d_ws; p.ph_lo = 0; p.ph_hi = NPHASE;
  void* args[] = {&p};
  hipError_t e = hipLaunchCooperativeKernel((const void*)mk, dim3(grid_blocks), dim3(NTHREADS), args, LDS_BYTES, stream);
  if (e != hipSuccess) fprintf(stderr, "cooperative launch failed: %s (grid %d)\n", hipGetErrorString(e), grid_blocks);
  if (PROBE_REP >= 0) {
    Params q = p;
    q.out = (float*)((unsigned char*)d_ws + WS_END); q.ph_lo = PROBE_REP; q.ph_hi = PROBE_REP + 1; q.pad = 1;
    void* args2[] = {&q};
    (void)hipLaunchCooperativeKernel((const void*)mk, dim3(grid_blocks), dim3(NTHREADS), args2, LDS_BYTES, stream);
  }
}
```

```cpp
#include <hip/hip_runtime.h>
#include <hip/hip_cooperative_groups.h>
#include <cstdio>
#include <cstdint>
namespace cg = cooperative_groups;

typedef unsigned short bf16_t;
typedef short bf16x8 __attribute__((ext_vector_type(8)));
typedef short s16x4 __attribute__((ext_vector_type(4)));
typedef float f32x16 __attribute__((ext_vector_type(16)));
typedef float f32x4 __attribute__((ext_vector_type(4)));
typedef float f32x2 __attribute__((ext_vector_type(2)));
typedef __bf16 bf2_t __attribute__((ext_vector_type(2)));
typedef unsigned u32x4 __attribute__((ext_vector_type(4)));
typedef unsigned u32x2 __attribute__((ext_vector_type(2)));
#define DI __device__ __forceinline__
#define MFMA32(a, b, c) __builtin_amdgcn_mfma_f32_32x32x16_bf16((a), (b), (c), 0, 0, 0)

struct Params { const float* in[24]; float* out; unsigned char* ws; int ph_lo, ph_hi; int wv, pad; };
#define TIDX (p.wv * 64 + (int)__builtin_amdgcn_mbcnt_hi(~0u, __builtin_amdgcn_mbcnt_lo(~0u, 0u)))
constexpr int LDS_BYTES = 148480;
constexpr int NTHREADS = 512;
constexpr int NPHASE = 10;
#ifndef PROBE_REP
#define PROBE_REP -1
#endif

constexpr int TP = 16384, TS = 1024, TT = 17408, DM = 1024;
constexpr int NCH = 272;
constexpr int PAST = 4096, SKV = 4160;
constexpr float EPS = 1e-6f;
constexpr float LOG2E = 1.4426950408889634f;
enum { I_XP = 0, I_XS, I_CK, I_CV, I_CMK, I_CMV, I_SC, I_SN, I_SM, I_MEMP, I_NG, I_FNG, I_MNG, I_WMKV, I_WINA, I_BGA, I_HGA, I_WOA,
       I_KVNG, I_WKV, I_WINB, I_LAMB, I_SUBG, I_WOB };
constexpr size_t O_Y = 0, O_PC = 17825792, O_PN = 18087936, O_PM = 18088960, O_PK = 18088964, O_PV = 34866180, O_PMK = 51643396,
                 O_PMV = 51905540, O_SC = 52167684, O_SN = 56361988, O_SM = 56378372, O_SK = 56378436, O_SV = 57427012;
constexpr size_t WS_CTR = 0;
constexpr size_t WS_KMAX = 1024;
constexpr size_t WS_TORD = 8192;
constexpr size_t WS_WA = 16384;
constexpr size_t WS_WOA = WS_WA + (size_t)6144 * 1024 * 2;
constexpr size_t WS_WKB = WS_WOA + (size_t)1024 * 1536 * 2;
constexpr size_t WS_WOB = WS_WKB + (size_t)5120 * 1024 * 2;
constexpr size_t WS_WM = WS_WOB + (size_t)1024 * 1536 * 2;
constexpr size_t WS_MEMN = WS_WM + (size_t)2 * 1024 * 1024 * 2;
constexpr size_t WS_MEMK = WS_MEMN + (size_t)2 * 256 * 1024 * 2;
constexpr size_t WS_MEMVT = WS_MEMK + (size_t)2 * 17 * 256 * 512 * 2;
constexpr size_t WS_GATE = WS_MEMVT + (size_t)2 * 17 * 256 * 512 * 2;
constexpr size_t SZ_CH = (size_t)NCH * 4 * 64 * 4;
constexpr size_t WS_GC = WS_GATE + (size_t)TT * 8 * 4;
constexpr size_t WS_MT = WS_GC + SZ_CH;
constexpr size_t WS_WS = WS_MT + SZ_CH;
constexpr size_t WS_WI = WS_WS + SZ_CH;
constexpr size_t WS_AS = WS_WI + SZ_CH;
constexpr size_t WS_BT = WS_AS + SZ_CH;
constexpr size_t WS_DEC = WS_BT + SZ_CH;
constexpr size_t WS_DENI = WS_DEC + 8192;
constexpr size_t WS_DENA = WS_DENI + (size_t)TT * 4 * 4;
constexpr size_t WS_XN = WS_DENA + (size_t)TT * 4 * 4;
constexpr size_t WS_AO = WS_XN + (size_t)TT * 1024 * 2;
constexpr size_t WS_Y1 = WS_AO + (size_t)TT * 1536 * 2;
constexpr size_t WS_KT = WS_Y1 + (size_t)TT * 1024 * 4;
constexpr size_t WS_VTA = WS_KT + (size_t)NCH * 4 * 256 * 64 * 2;
constexpr size_t WS_R1 = WS_VTA + (size_t)NCH * 4 * 256 * 64 * 2;
constexpr size_t SZ_R1 = (size_t)TT * 6144 * 2;
constexpr size_t WS_PB = WS_R1;
constexpr size_t WS_KBP = WS_PB + (size_t)TT * 3072 * 2;
constexpr size_t WS_VTP = WS_KBP + (size_t)TP * 1024 * 2;
constexpr size_t WS_R2 = WS_R1 + SZ_R1;
constexpr size_t WS_HINTER = WS_R2;
constexpr size_t WS_HINTRA = WS_R2 + (size_t)TT * 1024 * 4;
constexpr size_t WS_KBS = WS_R2;
constexpr size_t WS_VTS = WS_KBS + (size_t)16 * SKV * 1024 * 2;
constexpr size_t WS_PM = WS_VTS + (size_t)16 * SKV * 1024 * 2;
constexpr size_t WS_CHS = WS_PM + SZ_CH;
constexpr size_t WS_LD = WS_CHS + 16384;
constexpr size_t WS_CLOC = WS_LD + 8192;
constexpr size_t WS_END = WS_CLOC + (size_t)16 * 36 * 8 * 64 * 16 * 4;
constexpr int GRP = 16;
static_assert(WS_VTP + (size_t)TP * 1024 * 2 <= WS_R2, "R1 overflow");

DI unsigned pk2(float lo, float hi) { f32x2 v = {lo, hi}; return __builtin_bit_cast(unsigned, __builtin_convertvector(v, bf2_t)); }
DI bf16_t f2bf(float x) { return (bf16_t)(pk2(x, 0.f) & 0xffffu); }
DI float bf2f(unsigned v16) { return __uint_as_float(v16 << 16); }
DI float bflo(unsigned u) { return __uint_as_float(u << 16); }
DI float bfhi(unsigned u) { return __uint_as_float(u & 0xffff0000u); }
DI float rbf(float x) { return bflo(pk2(x, 0.f) & 0xffffu); }
DI int crow(int i, int h) { return (i & 3) + 8 * (i >> 2) + 4 * h; }
DI float wave_sum(float v) {
#pragma unroll
  for (int o = 32; o >= 1; o >>= 1) v += __shfl_xor(v, o);
  return v;
}
DI float fexp2(float x) { return __builtin_amdgcn_exp2f(x); }
DI float fexp(float x) { return __builtin_amdgcn_exp2f(x * LOG2E); }
DI float sigmoidf_(float x) { return 1.f / (1.f + __expf(-x)); }
DI float siluf_(float x) { return x / (1.f + __expf(-x)); }
DI bf16x8 pack_acc(const f32x16& x, int s) {
  u32x4 p;
  p[0] = pk2(x[8 * s + 0], x[8 * s + 1]); p[1] = pk2(x[8 * s + 2], x[8 * s + 3]);
  p[2] = pk2(x[8 * s + 4], x[8 * s + 5]); p[3] = pk2(x[8 * s + 6], x[8 * s + 7]);
  return __builtin_bit_cast(bf16x8, p);
}
DI bf16x8 ld16(const void* p) { return *(const bf16x8*)p; }
DI bf16x8 ld8x2(const void* p0, const void* p1) {
  u32x2 a = *(const u32x2*)p0, b = *(const u32x2*)p1; u32x4 r = {a[0], a[1], b[0], b[1]};
  return __builtin_bit_cast(bf16x8, r);
}
DI f32x16 zero16() { f32x16 z; for (int i = 0; i < 16; ++i) z[i] = 0.f; return z; }

DI void transpose_tile(const float* __restrict__ src, size_t ld_s, bf16_t* __restrict__ dst, size_t ld_d, const float* __restrict__ scale,
                       float* scr, int t, bool perm = false) {
  {
    const int c4 = t & 15, rb = t >> 4;
#pragma unroll
    for (int i = 0; i < 2; ++i) {
      const int r = rb + 32 * i;
      f32x4 v = *(const f32x4*)(src + (size_t)r * ld_s + 4 * c4);
      if (scale) { const float s = scale[r]; v = v * s; }
      float* d = scr + r * 65 + 4 * c4; d[0] = v[0]; d[1] = v[1]; d[2] = v[2]; d[3] = v[3];
    }
  }
  __syncthreads();
  {
    const int c = t >> 3, rg = t & 7;
    const float* s = scr + (8 * rg) * 65 + c;
    u32x4 o; o[0] = pk2(s[0], s[65]); o[1] = pk2(s[2 * 65], s[3 * 65]); o[2] = pk2(s[4 * 65], s[5 * 65]); o[3] = pk2(s[6 * 65], s[7 * 65]);
    if (!perm) *(u32x4*)(dst + (size_t)c * ld_d + 8 * rg) = o;
    else {
      bf16_t* d = dst + (size_t)c * ld_d + 16 * (rg >> 1) + 4 * (rg & 1);
      u32x2 lo = {o[0], o[1]}, hi = {o[2], o[3]};
      *(u32x2*)d = lo; *(u32x2*)(d + 8) = hi;
    }
  }
  __syncthreads();
}

struct TJob { const float* src; size_t ld_s; bf16_t* dst; size_t ld_d; const float* scale; int tr, tc; };

DI void run_tjob_tile(const TJob& j, int tile, float* scr, int tid, bool perm = false) {
  const int ir = tile / j.tc, ic = tile % j.tc;
  transpose_tile(j.src + (size_t)(64 * ir) * j.ld_s + 64 * ic, j.ld_s, j.dst + (size_t)(64 * ic) * j.ld_d + 64 * ir, j.ld_d,
                 j.scale ? j.scale + 64 * ir : nullptr, scr, tid, perm);
}

DI float row_load_rstd(const float* xrow, f32x4 (&v)[4], int lane) {
  float ss = 0.f;
#pragma unroll
  for (int j = 0; j < 4; ++j) { v[j] = *(const f32x4*)(xrow + 4 * lane + 256 * j); ss += v[j][0] * v[j][0] + v[j][1] * v[j][1] + v[j][2] * v[j][2] + v[j][3] * v[j][3]; }
  ss = wave_sum(ss);
  return __builtin_amdgcn_rsqf(ss * (1.f / 1024.f) + EPS);
}

DI int diff_window(int hd) { const float sl2 = exp2f(-(float)(hd + 1)) * LOG2E; return (int)floorf((63.f + 192.f / sl2) * (1.f / 64.f)); }
DI int diff_est(int a) {
  const int hd = a & 7;
  const int w = diff_window(hd) + (a < 1024 ? 2 : 1);
  const int n = a < 1024 ? 2 * (a >> 3) + 2 : 65;
  return n < w ? n : w;
}

DI void phase0(const Params& p, unsigned char* lds) {
  const int tid = TIDX, lane = tid & 63, wid = tid >> 6;
  unsigned char* ws = p.ws;
  if (blockIdx.x == 0 && tid < 64) ((unsigned*)(ws + WS_CTR))[tid] = 0u;
  if (blockIdx.x == 0 && tid < 272) ((unsigned*)(ws + WS_KMAX))[tid] = 0u;
  if (blockIdx.x == 1) {
    int* est = (int*)lds;
    for (int a = tid; a < 1152; a += NTHREADS) est[a] = diff_est(a);
    __syncthreads();
    for (int a = tid; a < 1152; a += NTHREADS) {
      const int ea = est[a];
      int rank = 0;
      for (int b = 0; b < 1152; ++b) { const int eb = est[b]; rank += (eb > ea) || (eb == ea && b < a); }
      ((int*)(ws + WS_TORD))[rank] = a;
    }
    __syncthreads();
  }
  {
    TJob jobs[8];
    jobs[0] = {p.in[I_WINA], 6152, (bf16_t*)(ws + WS_WA), 1024, p.in[I_NG], 16, 80};
    jobs[1] = {p.in[I_WINA] + 5128, 6152, (bf16_t*)(ws + WS_WA) + (size_t)5120 * 1024, 1024, p.in[I_NG], 16, 16};
    jobs[2] = {p.in[I_WOA], 1024, (bf16_t*)(ws + WS_WOA), 1536, nullptr, 24, 16};
    jobs[3] = {p.in[I_WKV], 2048, (bf16_t*)(ws + WS_WKB), 1024, p.in[I_KVNG], 16, 32};
    jobs[4] = {p.in[I_WINB], 3072, (bf16_t*)(ws + WS_WKB) + (size_t)2048 * 1024, 1024, p.in[I_NG] + 1024, 16, 48};
    jobs[5] = {p.in[I_WOB], 1024, (bf16_t*)(ws + WS_WOB), 1536, nullptr, 24, 16};
    jobs[6] = {p.in[I_WMKV], 1024, (bf16_t*)(ws + WS_WM), 1024, nullptr, 16, 16};
    jobs[7] = {p.in[I_WMKV] + (size_t)1024 * 1024, 1024, (bf16_t*)(ws + WS_WM) + (size_t)1024 * 1024, 1024, nullptr, 16, 16};
    int base = 0;
#pragma unroll
    for (int j = 0; j < 8; ++j) {
      const int n = jobs[j].tr * jobs[j].tc;
      for (int t = blockIdx.x; t < n; t += gridDim.x) run_tjob_tile(jobs[j], t, (float*)lds, tid);
      base += n;
    }
    for (int t = blockIdx.x; t < 128 * 8; t += gridDim.x) {
      const int jb = t >> 3, tile = t & 7, l = jb >> 6, b = (jb >> 2) & 15, h = jb & 3;
      TJob j = {p.in[I_CMV] + ((size_t)(l * 16 + b) * 256) * 512 + h * 128, 512,
                (bf16_t*)(ws + WS_MEMVT) + ((size_t)(l * 17 + 1 + b) * 4 + h) * 128 * 256, 256, nullptr, 4, 2};
      run_tjob_tile(j, tile, (float*)lds, tid, true);
    }
  }
  {
    const size_t n8 = (size_t)2 * 16 * 256 * 512 / 8;
    for (size_t i = (size_t)blockIdx.x * NTHREADS + tid; i < n8; i += (size_t)gridDim.x * NTHREADS) {
      const size_t e = i * 8; const int l = (int)(e / ((size_t)16 * 131072)); const size_t rem = e - (size_t)l * 16 * 131072;
      const f32x4 a = *(const f32x4*)(p.in[I_CMK] + e), b = *(const f32x4*)(p.in[I_CMK] + e + 4);
      u32x4 o = {pk2(a[0], a[1]), pk2(a[2], a[3]), pk2(b[0], b[1]), pk2(b[2], b[3])};
      *(u32x4*)((bf16_t*)(ws + WS_MEMK) + ((size_t)(l * 17 + 1) * 131072) + rem) = o;
    }
  }
  {
    const int gw = blockIdx.x * 8 + wid, nw = gridDim.x * 8;
    const float* ng = p.in[I_NG];
    float* gwt = (float*)(lds + 32768);
    float* sg = (float*)(lds + 65536);
    __syncthreads();
    for (int i = tid; i < 8192; i += NTHREADS) { const int k = i >> 3, c = i & 7; gwt[i] = p.in[I_WINA][(size_t)k * 6152 + 5120 + c] * ng[k]; }
    __syncthreads();
    for (int cc = blockIdx.x; cc < NCH; cc += gridDim.x) {
      for (int ri = 0; ri < 8; ++ri) {
        const int r = cc * 64 + wid * 8 + ri;
        const float* xrow = r < TP ? p.in[I_XP] + (size_t)r * 1024 : p.in[I_XS] + (size_t)(r - TP) * 1024;
        f32x4 v[4];
        const float rstd = row_load_rstd(xrow, v, lane);
        float gacc[8];
#pragma unroll
        for (int c = 0; c < 8; ++c) gacc[c] = 0.f;
        bf16_t* xn = (bf16_t*)(ws + WS_XN) + (size_t)r * 1024;
#pragma unroll
        for (int j = 0; j < 4; ++j) {
          const int k0 = 4 * lane + 256 * j;
          const f32x4 xs = v[j] * rstd;
          u32x2 o = {pk2(xs[0], xs[1]), pk2(xs[2], xs[3])};
          *(u32x2*)(xn + k0) = o;
#pragma unroll
          for (int e = 0; e < 4; ++e) {
            const float* wr = gwt + (k0 + e) * 8;
            const f32x4 w0 = *(const f32x4*)wr, w1 = *(const f32x4*)(wr + 4);
            gacc[0] += xs[e] * w0[0]; gacc[1] += xs[e] * w0[1]; gacc[2] += xs[e] * w0[2]; gacc[3] += xs[e] * w0[3];
            gacc[4] += xs[e] * w1[0]; gacc[5] += xs[e] * w1[1]; gacc[6] += xs[e] * w1[2]; gacc[7] += xs[e] * w1[3];
          }
        }
#pragma unroll
        for (int c = 0; c < 8; ++c) gacc[c] = wave_sum(gacc[c]);
        if (lane < 8) {
          float gv = gacc[0];
#pragma unroll
          for (int c = 1; c < 8; ++c) gv = lane == c ? gacc[c] : gv;
          gv += p.in[I_BGA][lane];
          if (lane >= 4) gv = fminf(gv, 0.f) - log1pf(__expf(-fabsf(gv)));
          sg[(wid * 8 + ri) * 8 + lane] = gv;
        }
      }
      __syncthreads();
      if (wid < 4) {
        const int hd = wid, pr = cc * 4 + hd;
        const float ig = sg[lane * 8 + hd], lf = sg[lane * 8 + 4 + hd];
        float g = lf;
#pragma unroll
        for (int o = 1; o < 64; o <<= 1) { const float t = __shfl_up(g, o); if (lane >= o) g += t; }
        const float a = ig - g;
        float pm = a;
#pragma unroll
        for (int o = 1; o < 64; o <<= 1) { const float t = __shfl_up(pm, o); if (lane >= o) pm = fmaxf(pm, t); }
        const size_t o = (size_t)pr * 64 + lane;
        ((float*)(ws + WS_GC))[o] = g;
        ((float*)(ws + WS_AS))[o] = a;
        ((float*)(ws + WS_PM))[o] = pm;
        if (lane == 63) { ((float*)(ws + WS_CHS))[pr * 2] = g; ((float*)(ws + WS_CHS))[pr * 2 + 1] = pm; }
      }
      __syncthreads();
    }
    for (int r = gw; r < 512; r += nw) {
      const int l = r >> 8, rr = r & 255;
      f32x4 v[4];
      const float rstd = row_load_rstd(p.in[I_MEMP] + (size_t)rr * 1024, v, lane);
      bf16_t* o = (bf16_t*)(ws + WS_MEMN) + (size_t)r * 1024;
#pragma unroll
      for (int j = 0; j < 4; ++j) {
        const int k0 = 4 * lane + 256 * j;
        const f32x4 g = *(const f32x4*)(p.in[I_MNG] + l * 1024 + k0);
        const f32x4 xs = v[j] * rstd * g;
        u32x2 ov = {pk2(xs[0], xs[1]), pk2(xs[2], xs[3])};
        *(u32x2*)(o + k0) = ov;
      }
    }
  }
}

constexpr int G_STAGE = 49152;
struct GemmAcc { f32x16 a[2][2]; };
DI void dma16(const void* g, unsigned char* l) { __builtin_amdgcn_global_load_lds((const unsigned*)g, (unsigned*)l, 16, 0, 0); }

DI void gemm_tile(const bf16_t* __restrict__ A, size_t lda, const bf16_t* __restrict__ Bt, size_t ldb, int K, unsigned char* lds, GemmAcc& acc, int tid) {
  const int lane = tid & 63, wid = __builtin_amdgcn_readfirstlane(tid >> 6), r = lane & 31, h = lane >> 5;
  const int wr = wid >> 1, wc = wid & 1;
#pragma unroll
  for (int a = 0; a < 2; ++a)
#pragma unroll
    for (int b = 0; b < 2; ++b) acc.a[a][b] = zero16();
  const int nk = K / 64;
  unsigned aoff[4], boff[2];
#pragma unroll
  for (int e = 0; e < 4; ++e) { const int row = 8 * (wid * 4 + e) + (lane >> 3), lc = (lane & 7) ^ ((row >> 1) & 7); aoff[e] = (unsigned)row * (unsigned)lda + 8u * lc; }
#pragma unroll
  for (int e = 0; e < 2; ++e) { const int row = 8 * (wid * 2 + e) + (lane >> 3), lc = (lane & 7) ^ ((row >> 1) & 7); boff[e] = (unsigned)row * (unsigned)ldb + 8u * lc; }
  auto issue = [&](int kt, int buf) {
    unsigned char* base = lds + buf * G_STAGE;
#pragma unroll
    for (int e = 0; e < 4; ++e) dma16(A + (aoff[e] + 64u * kt), base + (wid * 4 + e) * 1024);
#pragma unroll
    for (int e = 0; e < 2; ++e) dma16(Bt + (boff[e] + 64u * kt), base + 32768 + (wid * 2 + e) * 1024);
  };
  asm volatile("s_waitcnt vmcnt(0)" ::: "memory");
  __syncthreads();
  issue(0, 0);
  if (nk > 1) issue(1, 1);
  const unsigned sw = (r >> 1) & 7;
  unsigned co[4];
#pragma unroll
  for (int kk = 0; kk < 4; ++kk) co[kk] = (((2 * kk + h) ^ sw) << 4);
  const unsigned ra = (wr * 64 + r) * 128, rb = 32768 + (wc * 64 + r) * 128;
  for (int kt = 0; kt < nk; ++kt) {
    if (kt + 1 < nk) asm volatile("s_waitcnt vmcnt(6)" ::: "memory"); else asm volatile("s_waitcnt vmcnt(0)" ::: "memory");
    asm volatile("s_waitcnt lgkmcnt(0)" ::: "memory");
    __builtin_amdgcn_s_barrier();
    if (kt + 2 < nk) issue(kt + 2, (kt + 2) % 3);
    const unsigned char* base = lds + (kt % 3) * G_STAGE;
    const unsigned char* pa = base + ra;
    const unsigned char* pb = base + rb;
#pragma unroll
    for (int kk = 0; kk < 4; ++kk) {
      const bf16x8 a0 = ld16(pa + co[kk]), a1 = ld16(pa + 4096 + co[kk]);
      const bf16x8 b0 = ld16(pb + co[kk]), b1 = ld16(pb + 4096 + co[kk]);
      acc.a[0][0] = MFMA32(a0, b0, acc.a[0][0]);
      acc.a[0][1] = MFMA32(a0, b1, acc.a[0][1]);
      acc.a[1][0] = MFMA32(a1, b0, acc.a[1][0]);
      acc.a[1][1] = MFMA32(a1, b1, acc.a[1][1]);
    }
  }
}

DI void gate_scan(const Params& p, unsigned char* lds) {
  const int tid = TIDX, lane = tid & 63, wid = tid >> 6;
  unsigned char* ws = p.ws;
  float* s_ch = (float*)lds;
  float* s_mc = s_ch + NCH * 8;
  float* s_mn = s_mc + NCH * 4;
  __syncthreads();
  for (int i = tid; i < NCH * 8; i += NTHREADS) s_ch[i] = ((const float*)(ws + WS_CHS))[i];
  __syncthreads();
  if (tid < 4) {
    float m = 0.f, ld = 0.f;
    float* LD = (float*)(ws + WS_LD);
    const bool wr = blockIdx.x == 0;
    for (int c = 0; c < 256; ++c) {
      s_mc[c * 4 + tid] = m; if (wr) LD[c * 4 + tid] = ld;
      const float gl = s_ch[(c * 4 + tid) * 2], mn = gl + fmaxf(m, s_ch[(c * 4 + tid) * 2 + 1]);
      ld += gl + m - mn;
      m = mn; s_mn[c * 4 + tid] = m;
    }
    if (wr) { LD[256 * 4 + tid] = ld; p.out[O_PM + tid] = m; }
  } else if (tid >= 64 && tid < 128) {
    const int b = (tid - 64) >> 2, hd = tid & 3, pr = (256 + b) * 4 + hd;
    const float m0 = p.in[I_SM][b * 4 + hd];
    const float m = s_ch[pr * 2] + fmaxf(m0, s_ch[pr * 2 + 1]);
    s_mc[pr] = m0; s_mn[pr] = m;
    if (blockIdx.x == 0) p.out[O_SM + b * 4 + hd] = m;
  }
  __syncthreads();
  for (int cc = blockIdx.x; cc < NCH; cc += gridDim.x) {
    if (wid < 4) {
      const int hd = wid, pr = cc * 4 + hd;
      const size_t o = (size_t)pr * 64 + lane;
      const float g = ((const float*)(ws + WS_GC))[o], a = ((const float*)(ws + WS_AS))[o], pm = ((const float*)(ws + WS_PM))[o];
      const float mc = s_mc[pr], mn = s_mn[pr], gl = s_ch[pr * 2];
      const float mt = g + fmaxf(mc, pm);
      ((float*)(ws + WS_MT))[o] = mt;
      ((float*)(ws + WS_WS))[o] = __expf(gl + a - mn);
      ((float*)(ws + WS_WI))[o] = __expf(g + mc - mt);
      ((float*)(ws + WS_AS))[o] = a * LOG2E;
      ((float*)(ws + WS_BT))[o] = (g - mt) * LOG2E;
      if (lane == 0) ((float*)(ws + WS_DEC))[pr] = __expf(gl + mc - mn);
    }
  }
  __syncthreads();
}

DI void phase1(const Params& p, unsigned char* lds) {
  const int tid = TIDX, lane = tid & 63, wid = tid >> 6, r = lane & 31, h = lane >> 5, wr = wid >> 1, wc = wid & 1;
  unsigned char* ws = p.ws;
  gate_scan(p, lds);
  const int n_main = 68 * 48, n_mem = 16;
  for (int t = blockIdx.x; t < n_main + n_mem; t += gridDim.x) {
    GemmAcc acc;
    if (t < n_main) {
      const int tm = t / 48, tn = t % 48, m0 = tm * 256, n0 = tn * 128;
      gemm_tile((const bf16_t*)(ws + WS_XN) + (size_t)m0 * 1024, 1024, (const bf16_t*)(ws + WS_WA) + (size_t)n0 * 1024, 1024, 1024, lds, acc, tid);
      bf16_t* PA = (bf16_t*)(ws + WS_R1);
      const int sec = n0 >> 10;
#pragma unroll
      for (int a = 0; a < 2; ++a)
#pragma unroll
        for (int b = 0; b < 2; ++b) {
          __builtin_amdgcn_sched_barrier(0);
          const int n = n0 + wc * 64 + 32 * b + r, mb = m0 + wr * 64 + 32 * a;
          if (sec != 2) {
            const float sc = sec == 1 ? 0.0625f : 1.f;
#pragma unroll
            for (int i = 0; i < 16; ++i) PA[(size_t)(mb + crow(i, h)) * 6144 + n] = f2bf(acc.a[a][b][i] * sc);
          }
          if (sec == 1 || sec == 2) {
            const float sc = sec == 1 ? 0.0625f : 1.f;
            const int f = n & 1023, hd = f >> 8, fe = f & 255;
            bf16_t* T = (bf16_t*)(ws + (sec == 1 ? WS_KT : WS_VTA));
#pragma unroll
            for (int g = 0; g < 4; ++g) {
              const int m = mb + 8 * g + 4 * h, cc = m >> 6, s = m & 63;
              u32x2 o = {pk2(acc.a[a][b][4 * g] * sc, acc.a[a][b][4 * g + 1] * sc), pk2(acc.a[a][b][4 * g + 2] * sc, acc.a[a][b][4 * g + 3] * sc)};
              *(u32x2*)(T + (((size_t)cc * 4 + hd) * 256 + fe) * 64 + s) = o;
            }
          }
        }
    } else {
      const int tt = t - n_main, l = tt >> 3, n0 = (tt & 7) * 128;
      gemm_tile((const bf16_t*)(ws + WS_MEMN) + (size_t)l * 256 * 1024, 1024, (const bf16_t*)(ws + WS_WM) + ((size_t)l * 1024 + n0) * 1024, 1024, 1024, lds, acc, tid);
      const bool isv = n0 >= 512;
      float* of = p.out + (isv ? O_PMV : O_PMK) + (size_t)l * 131072;
      bf16_t* mk = (bf16_t*)(ws + WS_MEMK) + (size_t)(l * 17) * 131072;
      bf16_t* mv = (bf16_t*)(ws + WS_MEMVT) + (size_t)(l * 17) * 131072;
#pragma unroll
      for (int a = 0; a < 2; ++a)
#pragma unroll
        for (int b = 0; b < 2; ++b) {
          __builtin_amdgcn_sched_barrier(0);
          const int f = (n0 & 511) + wc * 64 + 32 * b + r, mb = wr * 64 + 32 * a;
#pragma unroll
          for (int g = 0; g < 4; ++g) {
            const int m = mb + 8 * g + 4 * h;
            float* o4 = of + (size_t)m * 512 + f;
            o4[0] = acc.a[a][b][4 * g]; o4[512] = acc.a[a][b][4 * g + 1]; o4[1024] = acc.a[a][b][4 * g + 2]; o4[1536] = acc.a[a][b][4 * g + 3];
            if (!isv) {
              bf16_t* k4 = mk + (size_t)m * 512 + f;
              k4[0] = f2bf(acc.a[a][b][4 * g]); k4[512] = f2bf(acc.a[a][b][4 * g + 1]); k4[1024] = f2bf(acc.a[a][b][4 * g + 2]); k4[1536] = f2bf(acc.a[a][b][4 * g + 3]);
            } else {
              u32x2 o = {pk2(acc.a[a][b][4 * g], acc.a[a][b][4 * g + 1]), pk2(acc.a[a][b][4 * g + 2], acc.a[a][b][4 * g + 3])};
              const int pq = (m >> 2) & 3, mp = (m & ~15) + 4 * (((pq & 1) << 1) | (pq >> 1));
              *(u32x2*)(mv + (size_t)f * 256 + mp) = o;
            }
          }
        }
    }
  }
}

DI void scan_task(const Params& p, unsigned char* lds, int sb  , int hd, int j, int grp) {
  const int tid = TIDX, lane = tid & 63, wid = tid >> 6, r = lane & 31, h = lane >> 5;
  unsigned char* ws = p.ws;
  const int cc0 = sb < 0 ? GRP * grp : 256 + sb, nch = sb < 0 ? GRP : 1;
  const bf16_t* PA = (const bf16_t*)(ws + WS_R1);
  const bf16_t* KT = (const bf16_t*)(ws + WS_KT);
  const bf16_t* VT = (const bf16_t*)(ws + WS_VTA);
  const float* WSa = (const float*)(ws + WS_WS);
  const float* WIa = (const float*)(ws + WS_WI);
  const float* DEC = (const float*)(ws + WS_DEC);
  float* red = (float*)lds;
  const bool nsl = j == 8;
  f32x16 S = zero16();
  if (sb >= 0) {
    if (!nsl) {
      const float* C0 = p.in[I_SC] + ((size_t)(sb * 4 + hd) * 256 + 32 * j + r) * 256 + 32 * wid;
#pragma unroll
      for (int g = 0; g < 4; ++g) { const f32x4 c = *(const f32x4*)(C0 + 8 * g + 4 * h); S[4 * g] = c[0]; S[4 * g + 1] = c[1]; S[4 * g + 2] = c[2]; S[4 * g + 3] = c[3]; }
    } else if (r == 0) {
      const float* n0 = p.in[I_SN] + (size_t)(sb * 4 + hd) * 256 + 32 * wid;
#pragma unroll
      for (int g = 0; g < 4; ++g) { const f32x4 c = *(const f32x4*)(n0 + 8 * g + 4 * h); S[4 * g] = c[0]; S[4 * g + 1] = c[1]; S[4 * g + 2] = c[2]; S[4 * g + 3] = c[3]; }
    }
  }
  bf16x8 kt[4], wv[4], qf[2][2];
  auto loadc = [&](int cc) {
    const size_t ch = (size_t)cc * 4 + hd;
    const bf16_t* kp = KT + (ch * 256 + 32 * wid + r) * 64 + 8 * h;
#pragma unroll
    for (int st = 0; st < 4; ++st) kt[st] = ld16(kp + 16 * st);
    const float* wsp = WSa + ch * 64 + 8 * h;
    if (!nsl) {
      const bf16_t* vp = VT + (ch * 256 + 32 * j + r) * 64 + 8 * h;
#pragma unroll
      for (int st = 0; st < 4; ++st) {
        const u32x4 v = *(const u32x4*)(vp + 16 * st);
        const f32x4 w0 = *(const f32x4*)(wsp + 16 * st), w1 = *(const f32x4*)(wsp + 16 * st + 4);
        u32x4 o;
        o[0] = pk2(bflo(v[0]) * w0[0], bfhi(v[0]) * w0[1]); o[1] = pk2(bflo(v[1]) * w0[2], bfhi(v[1]) * w0[3]);
        o[2] = pk2(bflo(v[2]) * w1[0], bfhi(v[2]) * w1[1]); o[3] = pk2(bflo(v[3]) * w1[2], bfhi(v[3]) * w1[3]);
        wv[st] = __builtin_bit_cast(bf16x8, o);
      }
    } else {
#pragma unroll
      for (int st = 0; st < 4; ++st) {
        const f32x4 w0 = *(const f32x4*)(wsp + 16 * st), w1 = *(const f32x4*)(wsp + 16 * st + 4);
        u32x4 o = {pk2(w0[0], w0[1]), pk2(w0[2], w0[3]), pk2(w1[0], w1[1]), pk2(w1[2], w1[3])};
        if (r != 0) o = (u32x4){0u, 0u, 0u, 0u};
        wv[st] = __builtin_bit_cast(bf16x8, o);
      }
    }
#pragma unroll
    for (int tt = 0; tt < 2; ++tt) {
      const bf16_t* qp = PA + (size_t)(cc * 64 + 32 * tt + r) * 6144 + hd * 256 + 32 * wid + 4 * h;
#pragma unroll
      for (int s2 = 0; s2 < 2; ++s2) qf[tt][s2] = ld8x2(qp + 16 * s2, qp + 16 * s2 + 8);
    }
  };
  for (int c = 0; c < nch; ++c) {
    const int cc = cc0 + c;
    loadc(cc);
    const float dec = DEC[cc * 4 + hd];
    const bf16x8 xs0 = pack_acc(S, 0), xs1 = pack_acc(S, 1);
    f32x16 z0 = MFMA32(xs0, qf[0][0], zero16()); z0 = MFMA32(xs1, qf[0][1], z0);
    f32x16 z1 = MFMA32(xs0, qf[1][0], zero16()); z1 = MFMA32(xs1, qf[1][1], z1);
    S = S * dec;
#pragma unroll
    for (int st = 0; st < 4; ++st) S = MFMA32(kt[st], wv[st], S);
    __syncthreads();
    {
      float* rw = red + wid * (64 * 33);
#pragma unroll
      for (int i = 0; i < 16; ++i) { rw[r * 33 + crow(i, h)] = z0[i]; rw[(32 + r) * 33 + crow(i, h)] = z1[i]; }
    }
    __syncthreads();
    {
      const int v = tid & 31;
#pragma unroll
      for (int e = 0; e < 4; ++e) {
        const int t = (tid >> 5) + 16 * e;
        float s = 0.f;
#pragma unroll
        for (int w8 = 0; w8 < 8; ++w8) s += red[w8 * (64 * 33) + t * 33 + v];
        const float wi = WIa[((size_t)cc * 4 + hd) * 64 + t];
        if (!nsl) ((float*)(ws + WS_HINTER))[(size_t)(cc * 64 + t) * 1024 + hd * 256 + 32 * j + v] = s * wi;
        else if (v == 0) ((float*)(ws + WS_DENI))[(size_t)(cc * 64 + t) * 4 + hd] = s * wi;
      }
    }
  }
  if (sb < 0) {
    float* cl = (float*)(ws + WS_CLOC) + ((((size_t)(grp * 4 + hd) * 9 + j) * 8 + wid) * 64 + lane) * 16;
#pragma unroll
    for (int g = 0; g < 4; ++g) { f32x4 c = {S[4 * g], S[4 * g + 1], S[4 * g + 2], S[4 * g + 3]}; *(f32x4*)(cl + 4 * g) = c; }
  } else {
    if (!nsl) {
      float* Co = (sb < 0 ? p.out + O_PC + (size_t)hd * 65536 : p.out + O_SC + (size_t)(sb * 4 + hd) * 65536) + (size_t)(32 * j + r) * 256 + 32 * wid;
#pragma unroll
      for (int g = 0; g < 4; ++g) { f32x4 c = {S[4 * g], S[4 * g + 1], S[4 * g + 2], S[4 * g + 3]}; *(f32x4*)(Co + 8 * g + 4 * h) = c; }
    } else if (r == 0) {
      float* no = (sb < 0 ? p.out + O_PN + (size_t)hd * 256 : p.out + O_SN + (size_t)(sb * 4 + hd) * 256) + 32 * wid;
#pragma unroll
      for (int g = 0; g < 4; ++g) { f32x4 c = {S[4 * g], S[4 * g + 1], S[4 * g + 2], S[4 * g + 3]}; *(f32x4*)(no + 8 * g + 4 * h) = c; }
    }
  }
  __syncthreads();
}

DI void intra_task(const Params& p, int cc, int hd) {
  const int tid = TIDX, lane = tid & 63, wid = tid >> 6, r = lane & 31, h = lane >> 5;
  unsigned char* ws = p.ws;
  const int tt = wid & 1, vq = wid >> 1;
  const bf16_t* PA = (const bf16_t*)(ws + WS_R1);
  const bf16_t* VT = (const bf16_t*)(ws + WS_VTA);
  const size_t ch = (size_t)cc * 4 + hd;
  f32x16 s0 = zero16(), s1 = zero16();
  {
    const bf16_t* qp = PA + (size_t)(cc * 64 + 32 * tt + r) * 6144 + hd * 256 + 8 * h;
    const bf16_t* kp = PA + (size_t)(cc * 64 + r) * 6144 + 1024 + hd * 256 + 8 * h;
#pragma unroll 4
    for (int kk = 0; kk < 16; ++kk) {
      const bf16x8 q = ld16(qp + 16 * kk), k0 = ld16(kp + 16 * kk), k1 = ld16(kp + (size_t)32 * 6144 + 16 * kk);
      s0 = MFMA32(k0, q, s0);
      if (tt == 1) s1 = MFMA32(k1, q, s1);
    }
  }
  const int t = 32 * tt + r;
  const float bt = ((const float*)(ws + WS_BT))[ch * 64 + t];
  const float* asp = (const float*)(ws + WS_AS) + ch * 64;
  float den = 0.f;
#pragma unroll
  for (int g = 0; g < 4; ++g) {
    const f32x4 a0 = *(const f32x4*)(asp + 8 * g + 4 * h);
    const f32x4 a1 = *(const f32x4*)(asp + 32 + 8 * g + 4 * h);
#pragma unroll
    for (int e = 0; e < 4; ++e) {
      const int s = 8 * g + 4 * h + e;
      const float w0 = s <= t ? fexp2(bt + a0[e]) : 0.f;
      const float w1 = (32 + s) <= t ? fexp2(bt + a1[e]) : 0.f;
      s0[4 * g + e] *= w0; s1[4 * g + e] *= w1;
      den += s0[4 * g + e] + s1[4 * g + e];
    }
  }
  den += __shfl_xor(den, 32);
  if (vq == 0 && h == 0) ((float*)(ws + WS_DENA))[(size_t)(cc * 64 + t) * 4 + hd] = den;
  bf16x8 pf[2][2];
  pf[0][0] = pack_acc(s0, 0); pf[0][1] = pack_acc(s0, 1); pf[1][0] = pack_acc(s1, 0); pf[1][1] = pack_acc(s1, 1);
  float* Ho = (float*)(ws + WS_HINTRA) + (size_t)(cc * 64 + t) * 1024 + hd * 256;
#pragma unroll
  for (int vt = 0; vt < 2; ++vt) {
    const int v0 = vq * 64 + vt * 32;
    const bf16_t* vp = VT + (ch * 256 + v0 + r) * 64 + 4 * h;
    f32x16 o = zero16();
#pragma unroll
    for (int st = 0; st < 2; ++st)
#pragma unroll
      for (int s2 = 0; s2 < 2; ++s2) {
        const bf16x8 a = ld8x2(vp + 32 * st + 16 * s2, vp + 32 * st + 16 * s2 + 8);
        o = MFMA32(a, pf[st][s2], o);
      }
#pragma unroll
    for (int g = 0; g < 4; ++g) { f32x4 c = {o[4 * g], o[4 * g + 1], o[4 * g + 2], o[4 * g + 3]}; *(f32x4*)(Ho + v0 + 8 * g + 4 * h) = c; }
  }
}

DI void memattn_task(const Params& p, unsigned char* lds, int task, int layer, const bf16_t* Qb, const bf16_t* Zb, unsigned ldq) {
  const int tid = TIDX, lane = tid & 63, wid = __builtin_amdgcn_readfirstlane(tid >> 6), r = lane & 31, h = lane >> 5;
  unsigned char* ws = p.ws;
  const bool prm = task < 256;
  const int hd = task & 3, ti = prm ? task >> 2 : (task - 256) >> 2;
  const int sbi = prm ? 0 : 1 + ti, tok0 = prm ? ti * 256 : TP + ti * 64, nact = prm ? 8 : 2;
  const bf16_t* MK = (const bf16_t*)(ws + WS_MEMK) + (size_t)(layer * 17 + sbi) * 131072 + hd * 128;
  const bf16_t* MV = (const bf16_t*)(ws + WS_MEMVT) + ((size_t)(layer * 17 + sbi) * 4 + hd) * 128 * 256;
  asm volatile("s_waitcnt vmcnt(0)" ::: "memory");
  __syncthreads();
#pragma unroll
  for (int e = 0; e < 8; ++e) {
    const int q = wid * 8 + e;
    { const int row = 4 * q + (lane >> 4), lc = (lane & 15) ^ (row & 15); dma16(MK + ((unsigned)row * 512u + 8u * lc), lds + q * 1024); }
    { const int row = 2 * q + (lane >> 5), lc = (lane & 31) ^ (row & 15); dma16(MV + ((unsigned)row * 256u + 8u * lc), lds + 65536 + q * 1024); }
  }
  const int tok = tok0 + (wid < nact ? wid : 0) * 32 + r;
  bf16x8 qf[8];
  {
    const bf16_t* qp = Qb + ((unsigned)tok * ldq + hd * 128 + 8 * h);
#pragma unroll
    for (int kk = 0; kk < 8; ++kk) qf[kk] = ld16(qp + 16 * kk);
  }
  asm volatile("s_waitcnt vmcnt(0)" ::: "memory");
  __syncthreads();
  if (wid >= nact) return;
  const float sc = 0.08838834764831845f * LOG2E;
  f32x16 O[4];
#pragma unroll
  for (int vt = 0; vt < 4; ++vt) O[vt] = zero16();
  float mrun = -1e30f, l = 0.f;
  const unsigned sw = r & 15;
#pragma unroll 1
  for (int kb = 0; kb < 4; ++kb) {
    f32x16 s0 = zero16(), s1 = zero16();
    const unsigned char* kp = lds + (kb * 64 + r) * 256;
#pragma unroll
    for (int kk = 0; kk < 8; ++kk) {
      const unsigned co = ((unsigned)(2 * kk + h) ^ sw) << 4;
      const bf16x8 k0 = ld16(kp + co), k1 = ld16(kp + 8192 + co);
      s0 = MFMA32(k0, qf[kk], s0); s1 = MFMA32(k1, qf[kk], s1);
    }
    float mx = -1e30f;
#pragma unroll
    for (int i = 0; i < 16; ++i) mx = fmaxf(mx, fmaxf(s0[i], s1[i]));
    mx = fmaxf(mx, __shfl_xor(mx, 32)) * sc;
    const float mnew = fmaxf(mrun, mx), alpha = fexp2(mrun - mnew);
    mrun = mnew;
    float sum = 0.f;
#pragma unroll
    for (int i = 0; i < 16; ++i) { s0[i] = fexp2(s0[i] * sc - mnew); s1[i] = fexp2(s1[i] * sc - mnew); sum += s0[i] + s1[i]; }
    l = l * alpha + sum;
#pragma unroll
    for (int vt = 0; vt < 4; ++vt) O[vt] = O[vt] * alpha;
    bf16x8 pf[2][2];
    pf[0][0] = pack_acc(s0, 0); pf[0][1] = pack_acc(s0, 1); pf[1][0] = pack_acc(s1, 0); pf[1][1] = pack_acc(s1, 1);
#pragma unroll
    for (int vt = 0; vt < 4; ++vt) {
      const unsigned char* vp = lds + 65536 + (32 * vt + r) * 512;
#pragma unroll
      for (int st = 0; st < 2; ++st)
#pragma unroll
        for (int s2 = 0; s2 < 2; ++s2) {
          const unsigned co = ((unsigned)(8 * kb + 4 * st + 2 * s2 + h) ^ sw) << 4;
          O[vt] = MFMA32(ld16(vp + co), pf[st][s2], O[vt]);
        }
    }
  }
  l += __shfl_xor(l, 32);
  const float inv = 1.f / l;
  const bf16_t* zp = Zb + ((unsigned)tok * ldq + hd * 128);
  bf16_t* op = (bf16_t*)(ws + WS_AO) + ((unsigned)tok * 1536u + 1024 + hd * 128);
#pragma unroll
  for (int vt = 0; vt < 4; ++vt)
#pragma unroll
    for (int g = 0; g < 4; ++g) {
      const int v = 32 * vt + 8 * g + 4 * h;
      const u32x2 z = *(const u32x2*)(zp + v);
      const float o0 = O[vt][4 * g] * inv * siluf_(bflo(z[0])), o1 = O[vt][4 * g + 1] * inv * siluf_(bfhi(z[0]));
      const float o2 = O[vt][4 * g + 2] * inv * siluf_(bflo(z[1])), o3 = O[vt][4 * g + 3] * inv * siluf_(bfhi(z[1]));
      u32x2 o = {pk2(o0, o1), pk2(o2, o3)};
      *(u32x2*)(op + v) = o;
    }
}

DI int next_item(unsigned* ctr, unsigned char* lds_flag_area, int tid) {
  __syncthreads();
  int* sh = (int*)lds_flag_area;
  if (tid == 0) *sh = (int)atomicAdd(ctr, 1u);
  __syncthreads();
  const int v = *sh;
  return v;
}

DI void phase2(const Params& p, unsigned char* lds) {
  unsigned* ctr = (unsigned*)(p.ws + WS_CTR) + 0 + 8 * p.pad;
  const bf16_t* PA = (const bf16_t*)(p.ws + WS_R1);
  const int n_ps = 36 * 16, n_ss = 576, n_in = NCH * 4, n_ma = 256 + 64;
  for (;;) {
    const int it = next_item(ctr, lds + LDS_BYTES - 16, TIDX);
    if (it >= n_ps + n_ss + n_in + n_ma) break;
    if (it < n_ps) scan_task(p, lds, -1, (it % 36) / 9, it % 9, it / 36);
    else if (it < n_ps + n_ss) { const int q = it - n_ps; scan_task(p, lds, q / 36, (q % 36) / 9, q % 9, 0); }
    else if (it < n_ps + n_ss + n_in) { const int q = it - n_ps - n_ss; intra_task(p, q >> 2, q & 3); }
    else { const int q = it - n_ps - n_ss - n_in; memattn_task(p, lds, q, 0, PA + 5120, PA + 5632, 6144); }
  }
}


DI void scanfix_task(const Params& p, unsigned char* lds, int grp, int hd, int j) {
  const int tid = TIDX, lane = tid & 63, wid = tid >> 6, r = lane & 31, h = lane >> 5;
  unsigned char* ws = p.ws;
  const bool nsl = j == 8;
  const float* LD = (const float*)(ws + WS_LD);
  f32x16 S = zero16();
  for (int gp = 0; gp < grp; ++gp) {
    const float dg = __expf(LD[(GRP * (gp + 1)) * 4 + hd] - LD[(GRP * gp) * 4 + hd]);
    const float* cl = (const float*)(ws + WS_CLOC) + ((((size_t)(gp * 4 + hd) * 9 + j) * 8 + wid) * 64 + lane) * 16;
#pragma unroll
    for (int g = 0; g < 4; ++g) { const f32x4 c = *(const f32x4*)(cl + 4 * g);
      S[4 * g] = S[4 * g] * dg + c[0]; S[4 * g + 1] = S[4 * g + 1] * dg + c[1]; S[4 * g + 2] = S[4 * g + 2] * dg + c[2]; S[4 * g + 3] = S[4 * g + 3] * dg + c[3]; }
  }
  if (grp == 16) {
    if (!nsl) {
      float* Co = p.out + O_PC + (size_t)hd * 65536 + (size_t)(32 * j + r) * 256 + 32 * wid;
#pragma unroll
      for (int g = 0; g < 4; ++g) { f32x4 c = {S[4 * g], S[4 * g + 1], S[4 * g + 2], S[4 * g + 3]}; *(f32x4*)(Co + 8 * g + 4 * h) = c; }
    } else if (r == 0) {
      float* no = p.out + O_PN + (size_t)hd * 256 + 32 * wid;
#pragma unroll
      for (int g = 0; g < 4; ++g) { f32x4 c = {S[4 * g], S[4 * g + 1], S[4 * g + 2], S[4 * g + 3]}; *(f32x4*)(no + 8 * g + 4 * h) = c; }
    }
    return;
  }
  u32x4* fr = (u32x4*)lds;
  float* tp = (float*)(lds + 16384) + wid * (64 * 33);
  __syncthreads();
  fr[(wid * 2 + 0) * 64 + lane] = __builtin_bit_cast(u32x4, pack_acc(S, 0));
  fr[(wid * 2 + 1) * 64 + lane] = __builtin_bit_cast(u32x4, pack_acc(S, 1));
  __syncthreads();
  bf16x8 xf[8][2];
#pragma unroll
  for (int kt = 0; kt < 8; ++kt) { xf[kt][0] = __builtin_bit_cast(bf16x8, fr[(kt * 2 + 0) * 64 + lane]); xf[kt][1] = __builtin_bit_cast(bf16x8, fr[(kt * 2 + 1) * 64 + lane]); }
  const bf16_t* PA = (const bf16_t*)(ws + WS_R1);
  const float* WIa = (const float*)(ws + WS_WI);
#pragma unroll 1
  for (int ci = 0; ci < 2; ++ci) {
    const int cc = GRP * grp + wid + 8 * ci;
    const float D = __expf(LD[cc * 4 + hd] - LD[(GRP * grp) * 4 + hd]);
#pragma unroll
    for (int tt = 0; tt < 2; ++tt) {
      const bf16_t* qp = PA + (size_t)(cc * 64 + 32 * tt + r) * 6144 + hd * 256 + 4 * h;
      f32x16 z = zero16();
#pragma unroll
      for (int kt = 0; kt < 8; ++kt)
#pragma unroll
        for (int s2 = 0; s2 < 2; ++s2) {
          const bf16x8 q = ld8x2(qp + 32 * kt + 16 * s2, qp + 32 * kt + 16 * s2 + 8);
          z = MFMA32(xf[kt][s2], q, z);
        }
#pragma unroll
      for (int i = 0; i < 16; ++i) tp[(32 * tt + r) * 33 + crow(i, h)] = z[i];
    }
    const int v = lane & 31;
#pragma unroll 4
    for (int e = 0; e < 32; ++e) {
      const int t = 2 * e + (lane >> 5);
      const float val = tp[t * 33 + v] * (WIa[((size_t)cc * 4 + hd) * 64 + t] * D);
      if (!nsl) { float* d = (float*)(ws + WS_HINTER) + (size_t)(cc * 64 + t) * 1024 + hd * 256 + 32 * j + v; *d += val; }
      else if (v == 0) { float* d = (float*)(ws + WS_DENI) + (size_t)(cc * 64 + t) * 4 + hd; *d += val; }
    }
  }
}

DI void phase2c(const Params& p, unsigned char* lds) {
  unsigned* ctr = (unsigned*)(p.ws + WS_CTR) + 3 + 8 * p.pad;
  for (;;) {
    const int it = next_item(ctr, lds + LDS_BYTES - 16, TIDX);
    if (it >= 16 * 36) break;
    const int g = 16 - it / 36;
    scanfix_task(p, lds, g, (it % 36) / 9, it % 9);
  }
}

DI void phase3(const Params& p) {
  const int tid = TIDX, lane = tid & 63, wid = tid >> 6;
  unsigned char* ws = p.ws;
  const int gw = blockIdx.x * 8 + wid, nw = gridDim.x * 8;
  const bf16_t* PA = (const bf16_t*)(ws + WS_R1);
  for (int it = gw; it < TT * 4; it += nw) {
    const int tok = it >> 2, hd = it & 3, cc = tok >> 6, t = tok & 63;
    const size_t off = (size_t)tok * 1024 + hd * 256 + 4 * lane;
    const f32x4 a = *(const f32x4*)((const float*)(ws + WS_HINTER) + off), b = *(const f32x4*)((const float*)(ws + WS_HINTRA) + off);
    const float den = ((const float*)(ws + WS_DENI))[tok * 4 + hd] + ((const float*)(ws + WS_DENA))[tok * 4 + hd];
    const float mt = ((const float*)(ws + WS_MT))[((size_t)cc * 4 + hd) * 64 + t];
    const float dn = 1.f / fmaxf(fabsf(den), __expf(-mt));
    const u32x2 ou = *(const u32x2*)(PA + (size_t)tok * 6144 + 3072 + hd * 256 + 4 * lane);
    const u32x2 zu = *(const u32x2*)(PA + (size_t)tok * 6144 + 4096 + hd * 256 + 4 * lane);
    f32x4 hv = (a + b) * dn;
    hv[0] *= sigmoidf_(bflo(ou[0])); hv[1] *= sigmoidf_(bfhi(ou[0])); hv[2] *= sigmoidf_(bflo(ou[1])); hv[3] *= sigmoidf_(bfhi(ou[1]));
    float ss = hv[0] * hv[0] + hv[1] * hv[1] + hv[2] * hv[2] + hv[3] * hv[3];
    ss = wave_sum(ss);
    const float rstd = __builtin_amdgcn_rsqf(ss * (1.f / 256.f) + EPS);
    const f32x4 hg = *(const f32x4*)(p.in[I_HGA] + hd * 256 + 4 * lane);
    hv = hv * rstd * hg;
    hv[0] *= siluf_(bflo(zu[0])); hv[1] *= siluf_(bfhi(zu[0])); hv[2] *= siluf_(bflo(zu[1])); hv[3] *= siluf_(bfhi(zu[1]));
    u32x2 o = {pk2(hv[0], hv[1]), pk2(hv[2], hv[3])};
    *(u32x2*)((bf16_t*)(ws + WS_AO) + (size_t)tok * 1536 + hd * 256 + 4 * lane) = o;
  }
}

DI void phase_outproj(const Params& p, unsigned char* lds, int layer) {
  const int tid = TIDX, lane = tid & 63, wid = tid >> 6, r = lane & 31, h = lane >> 5, wr = wid >> 1, wc = wid & 1;
  unsigned char* ws = p.ws;
  const bf16_t* W = (const bf16_t*)(ws + (layer == 0 ? WS_WOA : WS_WOB));
  for (int t = blockIdx.x; t < 68 * 8; t += gridDim.x) {
    const int tm = t >> 3, tn = t & 7, m0 = tm * 256, n0 = tn * 128;
    GemmAcc acc;
    gemm_tile((const bf16_t*)(ws + WS_AO) + (size_t)m0 * 1536, 1536, W + (size_t)n0 * 1536, 1536, 1536, lds, acc, tid);
#pragma unroll
    for (int a = 0; a < 2; ++a)
#pragma unroll
      for (int b = 0; b < 2; ++b) {
        const int n = n0 + wc * 64 + 32 * b + r, mb = m0 + wr * 64 + 32 * a;
#pragma unroll
        for (int i = 0; i < 16; ++i) {
          const int m = mb + crow(i, h);
          if (layer == 0) {
            const float xv = m < TP ? p.in[I_XP][(size_t)m * 1024 + n] : p.in[I_XS][(size_t)(m - TP) * 1024 + n];
            ((float*)(ws + WS_Y1))[(size_t)m * 1024 + n] = xv + acc.a[a][b][i];
          } else {
            p.out[O_Y + (size_t)m * 1024 + n] = ((const float*)(ws + WS_Y1))[(size_t)m * 1024 + n] + acc.a[a][b][i];
          }
        }
      }
  }
}

DI void phase5(const Params& p, unsigned char* lds) {
  const int tid = TIDX, lane = tid & 63, wid = tid >> 6;
  unsigned char* ws = p.ws;
  const int gw = blockIdx.x * 8 + wid, nw = gridDim.x * 8;
  for (int r = gw; r < TT; r += nw) {
    f32x4 v[4];
    const float rstd = row_load_rstd((const float*)(ws + WS_Y1) + (size_t)r * 1024, v, lane);
    bf16_t* xn = (bf16_t*)(ws + WS_XN) + (size_t)r * 1024;
#pragma unroll
    for (int j = 0; j < 4; ++j) { const f32x4 xs = v[j] * rstd; u32x2 o = {pk2(xs[0], xs[1]), pk2(xs[2], xs[3])}; *(u32x2*)(xn + 4 * lane + 256 * j) = o; }
  }
  {
    float* smax = (float*)lds;
    const int hm = (tid & 127) >> 3;
    for (int b = 0; b < 16; ++b) {
      __syncthreads();
      if (tid < 16) smax[tid] = 0.f;
      __syncthreads();
      float mx = 0.f;
      const size_t n8 = (size_t)PAST * 1024 / 8;
      const float* src = p.in[I_CK] + (size_t)b * PAST * 1024;
      bf16_t* dst = (bf16_t*)(ws + WS_KBS) + (size_t)b * SKV * 1024;
      for (size_t i = (size_t)blockIdx.x * NTHREADS + tid; i < n8; i += (size_t)gridDim.x * NTHREADS) {
        const size_t e = i * 8;
        const f32x4 a = *(const f32x4*)(src + e), c = *(const f32x4*)(src + e + 4);
        u32x4 o = {pk2(a[0], a[1]), pk2(a[2], a[3]), pk2(c[0], c[1]), pk2(c[2], c[3])};
        *(u32x4*)(dst + e) = o;
        float ss = a[0] * a[0] + a[1] * a[1] + a[2] * a[2] + a[3] * a[3] + c[0] * c[0] + c[1] * c[1] + c[2] * c[2] + c[3] * c[3];
        ss += __shfl_xor(ss, 1); ss += __shfl_xor(ss, 2); ss += __shfl_xor(ss, 4);
        mx = fmaxf(mx, ss);
      }
      if ((tid & 7) == 0) atomicMax((unsigned*)smax + hm, __float_as_uint(mx));
      __syncthreads();
      if (tid < 16) atomicMax((unsigned*)(ws + WS_KMAX) + (1 + b) * 16 + tid, __float_as_uint(sqrtf(smax[tid])));
    }
  }
  __syncthreads();
  for (int t = blockIdx.x; t < 128 * 128; t += gridDim.x) {
    const int jb = t >> 7, tile = t & 127, b = jb >> 3, hd = jb & 7;
    TJob j = {p.in[I_CV] + (size_t)b * PAST * 1024 + hd * 128, 1024, (bf16_t*)(ws + WS_VTS) + ((size_t)(b * 8 + hd) * 128) * SKV, SKV, nullptr, 64, 2};
    run_tjob_tile(j, tile, (float*)lds, tid, true);
  }
}

DI void phase6(const Params& p, unsigned char* lds) {
  const int tid = TIDX, lane = tid & 63, wid = tid >> 6, r = lane & 31, h = lane >> 5, wr = wid >> 1, wc = wid & 1;
  unsigned char* ws = p.ws;
  for (int t = blockIdx.x; t < 68 * 40; t += gridDim.x) {
    const int tm = t / 40, tn = t % 40, m0 = tm * 256, n0 = tn * 128;
    GemmAcc acc;
    gemm_tile((const bf16_t*)(ws + WS_XN) + (size_t)m0 * 1024, 1024, (const bf16_t*)(ws + WS_WKB) + (size_t)n0 * 1024, 1024, 1024, lds, acc, tid);
    const int sec = n0 >> 10;
    const bool samp = m0 >= TP;
#pragma unroll
    for (int a = 0; a < 2; ++a)
#pragma unroll
      for (int b = 0; b < 2; ++b) {
        const int n = n0 + wc * 64 + 32 * b + r, mb = m0 + wr * 64 + 32 * a;
        if (sec == 0) {
          const int f = n;
          if (b == 1) {
            float mx = 0.f;
#pragma unroll
            for (int i = 0; i < 16; ++i) {
              float ss = acc.a[a][0][i] * acc.a[a][0][i] + acc.a[a][1][i] * acc.a[a][1][i];
              ss += __shfl_xor(ss, 1); ss += __shfl_xor(ss, 2); ss += __shfl_xor(ss, 4); ss += __shfl_xor(ss, 8); ss += __shfl_xor(ss, 16);
              mx = fmaxf(mx, ss);
            }
            mx = fmaxf(mx, __shfl_xor(mx, 32));
            if (lane == 0) {
              const int strm = samp ? 1 + ((mb - TP) >> 6) : 0;
              atomicMax((unsigned*)(ws + WS_KMAX) + strm * 16 + ((n0 + wc * 64) >> 6), __float_as_uint(sqrtf(mx)));
            }
          }
#pragma unroll
          for (int i = 0; i < 16; ++i) {
            const int m = mb + crow(i, h);
            const float v = acc.a[a][b][i];
            if (!samp) { p.out[O_PK + (size_t)m * 1024 + f] = v; ((bf16_t*)(ws + WS_KBP))[(size_t)m * 1024 + f] = f2bf(v); }
            else { const int ms = m - TP, bb = ms >> 6, s = ms & 63; p.out[O_SK + (size_t)ms * 1024 + f] = v;
                   ((bf16_t*)(ws + WS_KBS))[((size_t)bb * SKV + PAST + s) * 1024 + f] = f2bf(v); }
          }
        } else if (sec == 1) {
          const int f = n - 1024, hd = f >> 7, vd = f & 127;
#pragma unroll
          for (int i = 0; i < 16; ++i) {
            const int m = mb + crow(i, h);
            if (!samp) p.out[O_PV + (size_t)m * 1024 + f] = acc.a[a][b][i]; else p.out[O_SV + (size_t)(m - TP) * 1024 + f] = acc.a[a][b][i];
          }
#pragma unroll
          for (int g = 0; g < 4; ++g) {
            const int m0r = mb + 8 * g + 4 * h, pq = (m0r >> 2) & 3;
            const int m = (m0r & ~15) + 4 * (((pq & 1) << 1) | (pq >> 1));
            u32x2 o = {pk2(acc.a[a][b][4 * g], acc.a[a][b][4 * g + 1]), pk2(acc.a[a][b][4 * g + 2], acc.a[a][b][4 * g + 3])};
            if (!samp) *(u32x2*)((bf16_t*)(ws + WS_VTP) + ((size_t)hd * 128 + vd) * TP + m) = o;
            else { const int ms = m - TP, bb = ms >> 6, s = ms & 63; *(u32x2*)((bf16_t*)(ws + WS_VTS) + ((size_t)(bb * 8 + hd) * 128 + vd) * SKV + PAST + s) = o; }
          }
        } else {
          const float sc = sec == 2 ? 0.125f * LOG2E : 1.f;
          bf16_t* PB = (bf16_t*)(ws + WS_PB);
#pragma unroll
          for (int i = 0; i < 16; ++i) PB[(size_t)(mb + crow(i, h)) * 3072 + (n - 2048)] = f2bf(acc.a[a][b][i] * sc);
        }
      }
  }
}

constexpr int A_BUF = 32768, A_KB = 16384, A_FLAGS = 3 * A_BUF;

DI void diffattn_task(const Params& p, unsigned char* lds, int sb  , int qt  , int hd, float lam) {
  const int tid = TIDX, lane = tid & 63, wid = __builtin_amdgcn_readfirstlane(tid >> 6), r = lane & 31, h = lane >> 5;
  unsigned char* ws = p.ws;
  const int cq = wid >> 2, sub = (wid >> 1) & 1, map = wid & 1;
  const int ncq = sb < 0 ? 2 : 1;
  const int base_chunk = sb < 0 ? 2 * qt : 64;
  const int tok0 = sb < 0 ? qt * 128 : TP + sb * 64;
  const bool wvalid = cq < ncq;
  const int qc = base_chunk + cq;
  const int tl = 32 * sub + r;
  const int tok = tok0 + 64 * (wvalid ? cq : 0) + tl;
  const bf16_t* Kb = sb < 0 ? (const bf16_t*)(ws + WS_KBP) + hd * 128 : (const bf16_t*)(ws + WS_KBS) + (size_t)sb * SKV * 1024 + hd * 128;
  const bf16_t* Vb = sb < 0 ? (const bf16_t*)(ws + WS_VTP) + (size_t)hd * 128 * TP : (const bf16_t*)(ws + WS_VTS) + (size_t)(sb * 8 + hd) * 128 * SKV;
  const unsigned ldv = sb < 0 ? TP : SKV;
  const bf16_t* PB = (const bf16_t*)(ws + WS_PB);
  bf16x8 qf[4];
  float qn = 0.f;
  {
    const unsigned qo = (unsigned)tok * 3072u + hd * 128 + map * 64 + 8 * h;
#pragma unroll
    for (int kk = 0; kk < 4; ++kk) {
      const u32x4 u = *(const u32x4*)(PB + (qo + 16 * kk));
      qf[kk] = __builtin_bit_cast(bf16x8, u);
#pragma unroll
      for (int e = 0; e < 4; ++e) { const float a = bflo(u[e]), b = bfhi(u[e]); qn += a * a + b * b; }
    }
    qn += __shfl_xor(qn, 32);
    qn = sqrtf(qn);
  }
  const float kmax = ((const float*)(ws + WS_KMAX))[(sb < 0 ? 0 : 1 + sb) * 16 + hd * 2 + map];
  const float shift = qn * kmax * 1.02f + 0.5f - 40.f;
  const float sl2 = exp2f(-(float)(hd + 1)) * LOG2E;
  const int wd = diff_window(hd);
  const float bh0 = sl2 * (float)(4 * h) - sl2 * (float)tl - shift, bh1 = bh0 + 32.f * sl2;
  float cs[16];
#pragma unroll
  for (int i = 0; i < 16; ++i) cs[i] = __uint_as_float(__builtin_amdgcn_readfirstlane(__float_as_uint(sl2 * (float)((i & 3) + 8 * (i >> 2)))));
  f32x16 O[4];
#pragma unroll
  for (int vt = 0; vt < 4; ++vt) O[vt] = zero16();
  float l = 0.f;
  const int jmax = base_chunk + ncq - 1;
  const int jmin = max(0, base_chunk - wd);
  const int nit = jmax - jmin + 1;
  unsigned kofs[2], vofs[2];
#pragma unroll
  for (int e = 0; e < 2; ++e) {
    const int q = wid * 2 + e;
    { const int row = 4 * q + (lane >> 4), lc = (lane & 15) ^ (row & 15); kofs[e] = (unsigned)row * 1024u + 8u * lc; }
    { const int row = 8 * q + (lane >> 3), lc = (lane & 7) ^ ((row >> 1) & 7); vofs[e] = (unsigned)row * ldv + 8u * lc; }
  }
  auto issue = [&](int j, int buf) {
    const bf16_t* kj = Kb + (size_t)j * 65536;
    const bf16_t* vj = Vb + (size_t)j * 64;
    unsigned char* base = lds + buf * A_BUF;
#pragma unroll
    for (int e = 0; e < 2; ++e) {
      dma16(kj + kofs[e], base + (wid * 2 + e) * 1024);
      dma16(vj + vofs[e], base + A_KB + (wid * 2 + e) * 1024);
    }
  };
  unsigned kco[4], vco[4];
#pragma unroll
  for (int kk = 0; kk < 4; ++kk) kco[kk] = (unsigned)r * 256u + ((((unsigned)(8 * map + 2 * kk + h)) ^ (unsigned)(r & 15)) << 4);
#pragma unroll
  for (int sx = 0; sx < 4; ++sx) vco[sx] = A_KB + (unsigned)r * 128u + ((((unsigned)(2 * sx + h)) ^ (unsigned)((r >> 1) & 7)) << 4);
  asm volatile("s_waitcnt vmcnt(0)" ::: "memory");
  __syncthreads();
  issue(jmax, 0);
  if (nit > 1) issue(jmax - 1, 1);
  for (int it = 0; it < nit; ++it) {
    const int j = jmax - it;
    if (it + 1 < nit) asm volatile("s_waitcnt vmcnt(4)" ::: "memory"); else asm volatile("s_waitcnt vmcnt(0)" ::: "memory");
    asm volatile("s_waitcnt lgkmcnt(0)" ::: "memory");
    __builtin_amdgcn_s_barrier();
    if (it + 2 < nit) issue(j - 2, (it + 2) % 3);
    if (wvalid && j <= qc && qc - j <= wd) {
      const unsigned char* base = lds + (it % 3) * A_BUF;
      f32x16 s0, s1;
      {
        const float dofs = sl2 * (float)((qc - j) * 64);
        float b0 = bh0 - dofs, b1 = bh1 - dofs;
        asm volatile("" : "+v"(b0), "+v"(b1));
#pragma unroll
        for (int i = 0; i < 16; ++i) { s0[i] = b0 + cs[i]; s1[i] = b1 + cs[i]; }
      }
      if (j == qc) {
        int tlv = tl;
        asm volatile("" : "+v"(tlv));
        const float m2 = -2.f * sl2, xt = (float)(4 * h - tlv);
#pragma unroll
        for (int i = 0; i < 16; ++i) {
          const float c = (float)((i & 3) + 8 * (i >> 2));
          s0[i] = fmaf(m2, fmaxf(xt + c, 0.f), s0[i]); s1[i] = fmaf(m2, fmaxf(xt + (c + 32.f), 0.f), s1[i]);
        }
      }
#pragma unroll
      for (int kk = 0; kk < 4; ++kk) s0 = MFMA32(ld16(base + kco[kk]), qf[kk], s0);
#pragma unroll
      for (int kk = 0; kk < 4; ++kk) s1 = MFMA32(ld16(base + 8192 + kco[kk]), qf[kk], s1);
      float sum0 = 0.f, sum1 = 0.f;
#pragma unroll
      for (int i = 0; i < 16; ++i) { s0[i] = fexp2(s0[i]); sum0 += s0[i]; }
      const bf16x8 p00 = pack_acc(s0, 0), p01 = pack_acc(s0, 1);
#pragma unroll
      for (int vt = 0; vt < 4; ++vt) { O[vt] = MFMA32(ld16(base + 4096 * vt + vco[0]), p00, O[vt]); O[vt] = MFMA32(ld16(base + 4096 * vt + vco[1]), p01, O[vt]); }
#pragma unroll
      for (int i = 0; i < 16; ++i) { s1[i] = fexp2(s1[i]); sum1 += s1[i]; }
      const bf16x8 p10 = pack_acc(s1, 0), p11 = pack_acc(s1, 1);
#pragma unroll
      for (int vt = 0; vt < 4; ++vt) { O[vt] = MFMA32(ld16(base + 4096 * vt + vco[2]), p10, O[vt]); O[vt] = MFMA32(ld16(base + 4096 * vt + vco[3]), p11, O[vt]); }
      l += sum0 + sum1;
      __builtin_amdgcn_sched_group_barrier(0x100, 2, 0);
#pragma unroll
      for (int g = 0; g < 4; ++g) { __builtin_amdgcn_sched_group_barrier(0x008, 1, 0); __builtin_amdgcn_sched_group_barrier(0x100, 1, 0); }
#pragma unroll
      for (int g = 0; g < 4; ++g) { __builtin_amdgcn_sched_group_barrier(0x008, 1, 0); __builtin_amdgcn_sched_group_barrier(0x100, 1, 0); __builtin_amdgcn_sched_group_barrier(0x002, 10, 0); }
#pragma unroll
      for (int g = 0; g < 8; ++g) { __builtin_amdgcn_sched_group_barrier(0x008, 1, 0); __builtin_amdgcn_sched_group_barrier(0x100, 1, 0); __builtin_amdgcn_sched_group_barrier(0x002, 5, 0); }
#pragma unroll
      for (int g = 0; g < 6; ++g) { __builtin_amdgcn_sched_group_barrier(0x008, 1, 0); __builtin_amdgcn_sched_group_barrier(0x100, 1, 0); }
      __builtin_amdgcn_sched_group_barrier(0x008, 2, 0);
    }
  }
  asm volatile("s_waitcnt vmcnt(0)" ::: "memory");
  __syncthreads();
  l += __shfl_xor(l, 32);
  const float inv = wvalid ? 1.f / l : 0.f;
  float* xch = (float*)lds + (size_t)(wid >> 1) * 4096;
  if (map == 1 && wvalid) {
    const float sc = inv * lam;
#pragma unroll
    for (int vt = 0; vt < 4; ++vt)
#pragma unroll
      for (int i = 0; i < 16; ++i) xch[(vt * 16 + i) * 64 + lane] = O[vt][i] * sc;
  }
  __syncthreads();
  if (map == 0 && wvalid) {
    float ss = 0.f;
#pragma unroll
    for (int vt = 0; vt < 4; ++vt)
#pragma unroll
      for (int i = 0; i < 16; ++i) { const float o = O[vt][i] * inv - xch[(vt * 16 + i) * 64 + lane]; O[vt][i] = o; ss += o * o; }
    ss += __shfl_xor(ss, 32);
    const float lam_init = 0.8f - 0.6f * 0.7408182206817179f;
    const float rs = __builtin_amdgcn_rsqf(ss * (1.f / 128.f) + EPS) * (1.f - lam_init);
    const unsigned zo = (unsigned)tok * 3072u + 1024 + hd * 128, oo = (unsigned)tok * 1536u + hd * 128;
    bf16_t* AOp = (bf16_t*)(ws + WS_AO);
    const float* sg = p.in[I_SUBG];
#pragma unroll
    for (int vt = 0; vt < 4; ++vt)
#pragma unroll
      for (int g = 0; g < 4; ++g) {
        const int v = 32 * vt + 8 * g + 4 * h;
        const u32x2 z = *(const u32x2*)(PB + (zo + v));
        const f32x4 gg = *(const f32x4*)(sg + v);
        const float o0 = O[vt][4 * g] * rs * gg[0] * siluf_(bflo(z[0])), o1 = O[vt][4 * g + 1] * rs * gg[1] * siluf_(bfhi(z[0]));
        const float o2 = O[vt][4 * g + 2] * rs * gg[2] * siluf_(bflo(z[1])), o3 = O[vt][4 * g + 3] * rs * gg[3] * siluf_(bfhi(z[1]));
        u32x2 o = {pk2(o0, o1), pk2(o2, o3)};
        *(u32x2*)(AOp + (oo + v)) = o;
      }
  }
  __syncthreads();
}

DI void phase7(const Params& p, unsigned char* lds) {
  unsigned* ctr = (unsigned*)(p.ws + WS_CTR) + 1 + 8 * p.pad;
  const bf16_t* PB = (const bf16_t*)(p.ws + WS_PB);
  float lam;
  {
    const int lane = TIDX & 63;
    const float* lv = p.in[I_LAMB];
    const float a = wave_sum(lv[lane] * lv[64 + lane]), b = wave_sum(lv[128 + lane] * lv[192 + lane]);
    const float lam_init = 0.8f - 0.6f * 0.7408182206817179f;
    lam = __expf(a) - __expf(b) + lam_init;
  }
  const int n_s = 128, n_p = 1024, n_ma = 256 + 64;
  const int* tord = (const int*)(p.ws + WS_TORD);
  for (;;) {
    const int it = next_item(ctr, lds + LDS_BYTES - 16, TIDX);
    if (it >= n_s + n_p) break;
    const int a = tord[it];
    const bool pr = a < n_p;
    diffattn_task(p, lds, pr ? -1 : ((a - n_p) >> 3), pr ? (a >> 3) : 0, a & 7, lam);
  }
  for (;;) {
    const int it = next_item(ctr + 1, lds + LDS_BYTES - 16, TIDX);
    if (it >= n_ma) break;
    memattn_task(p, lds, it, 1, PB + 2048, PB + 2560, 3072);
  }
}

DI void phase9(const Params& p) {
  const int tid = TIDX, lane = tid & 63, wid = tid >> 6;
  const int gw = blockIdx.x * 8 + wid, nw = gridDim.x * 8;
  for (int r = gw; r < TT; r += nw) {
    f32x4 v[4];
    float* row = p.out + O_Y + (size_t)r * 1024;
    const float rstd = row_load_rstd(row, v, lane);
#pragma unroll
    for (int j = 0; j < 4; ++j) {
      const f32x4 g = *(const f32x4*)(p.in[I_FNG] + 4 * lane + 256 * j);
      *(f32x4*)(row + 4 * lane + 256 * j) = v[j] * rstd * g;
    }
  }
}

DI void grid_barrier(unsigned* bar, unsigned target, int tid) {
  asm volatile("s_waitcnt vmcnt(0)" ::: "memory");
  __syncthreads();
  if (tid == 0) {
    __builtin_amdgcn_fence(__ATOMIC_RELEASE, "agent");
    asm volatile("s_waitcnt vmcnt(0)" ::: "memory");
    __hip_atomic_fetch_add(bar, 1u, __ATOMIC_RELAXED, __HIP_MEMORY_SCOPE_AGENT);
    while (__hip_atomic_load(bar, __ATOMIC_RELAXED, __HIP_MEMORY_SCOPE_AGENT) < target) __builtin_amdgcn_s_sleep(1);
    __builtin_amdgcn_fence(__ATOMIC_ACQUIRE, "agent");
    asm volatile("s_waitcnt vmcnt(0)" ::: "memory");
  }
  __syncthreads();
}

__global__ __launch_bounds__(512) void mk(Params pin) {
  extern __shared__ __attribute__((aligned(16))) unsigned char lds[];
  Params p = pin;
  p.wv = __builtin_amdgcn_readfirstlane((int)(__builtin_amdgcn_workitem_id_x() >> 6));
  cg::grid_group grid = cg::this_grid();
  unsigned nbar = 0;
  unsigned* bar = (unsigned*)(p.ws + WS_CTR) + 32;
#define RUN_PHASE(PH, CALL) if (p.ph_lo <= PH && PH < p.ph_hi) { CALL; if (PH + 1 < p.ph_hi) { ++nbar; grid_barrier(bar, nbar * gridDim.x, TIDX); } }
  if (p.ph_lo <= 0 && 0 < p.ph_hi) { phase0(p, lds); if (1 < p.ph_hi) grid.sync(); }
  RUN_PHASE(1, phase1(p, lds))
  RUN_PHASE(2, phase2(p, lds))
  if (p.ph_lo <= 2 && 2 < p.ph_hi) { phase2c(p, lds); ++nbar; grid_barrier(bar, nbar * gridDim.x, TIDX); }
  RUN_PHASE(3, phase3(p))
  RUN_PHASE(4, phase_outproj(p, lds, 0))
  RUN_PHASE(5, phase5(p, lds))
  RUN_PHASE(6, phase6(p, lds))
  RUN_PHASE(7, phase7(p, lds))
  RUN_PHASE(8, phase_outproj(p, lds, 1))
  RUN_PHASE(9, phase9(p))
}

extern "C" void kernel_launch(void* const* d_in, const int* in_sizes, int n_in, void* d_out, int out_size,
                              void* d_ws, size_t ws_size, hipStream_t stream) {
  static int grid_blocks = 0;
  if (!grid_blocks) {
    int dev = 0, cus = 0, per_cu = 0;
    (void)hipGetDevice(&dev);
    (void)hipDeviceGetAttribute(&cus, hipDeviceAttributeMultiprocessorCount, dev);
    (void)hipFuncSetAttribute((const void*)mk, hipFuncAttributeMaxDynamicSharedMemorySize, LDS_BYTES);
    (void)hipOccupancyMaxActiveBlocksPerMultiprocessor(&per_cu, (const void*)mk, NTHREADS, LDS_BYTES);
    grid_blocks = cus;
    fprintf(stderr, "kernel_launch: cus=%d per_cu=%d grid=%d ws=%zu need=%zu\n", cus, per_cu, grid_blocks, ws_size, (size_t)WS_END);
  }
  if (ws_size < WS_END) { fprintf(stderr, "workspace too small\n"); return; }
  Params p{};
  for (int i = 0; i < 24; ++i) p.in[i] = (const float*)d_in[i];
  p.out = (float*)d_out; p.ws = (unsigned char*)d_ws; p.ph_lo = 0; p.ph_hi = NPHASE;
  void* args[] = {&p};
  hipError_t e = hipLaunchCooperativeKernel((const void*)mk, dim3(grid_blocks), dim3(NTHREADS), args, LDS_BYTES, stream);
  if (e != hipSuccess) fprintf(stderr, "cooperative launch failed: %s (grid %d)\n", hipGetErrorString(e), grid_blocks);
  if (PROBE_REP >= 0) {
    Params q = p;
    q.out = (float*)((unsigned char*)d_ws + WS_END); q.ph_lo = PROBE_REP; q.ph_hi = PROBE_REP + 1; q.pad = 1;
    void* args2[] = {&q};
    (void)hipLaunchCooperativeKernel((const void*)mk, dim3(grid_blocks), dim3(NTHREADS), args2, LDS_BYTES, stream);
  }
}
```

```cpp
#include <hip/hip_runtime.h>
#include <hip/hip_cooperative_groups.h>
#include <cstdio>
#include <cstdint>
namespace cg = cooperative_groups;

typedef unsigned short bf16_t;
typedef short bf16x8 __attribute__((ext_vector_type(8)));
typedef short s16x4 __attribute__((ext_vector_type(4)));
typedef float f32x16 __attribute__((ext_vector_type(16)));
typedef float f32x4 __attribute__((ext_vector_type(4)));
typedef float f32x2 __attribute__((ext_vector_type(2)));
typedef __bf16 bf2_t __attribute__((ext_vector_type(2)));
typedef unsigned u32x4 __attribute__((ext_vector_type(4)));
typedef unsigned u32x2 __attribute__((ext_vector_type(2)));
#define DI __device__ __forceinline__
#define MFMA32(a, b, c) __builtin_amdgcn_mfma_f32_32x32x16_bf16((a), (b), (c), 0, 0, 0)

struct Params { const float* in[24]; float* out; unsigned char* ws; int ph_lo, ph_hi; int wv, pad; };
#define TIDX (p.wv * 64 + (int)__builtin_amdgcn_mbcnt_hi(~0u, __builtin_amdgcn_mbcnt_lo(~0u, 0u)))
constexpr int LDS_BYTES = 148480;
constexpr int NTHREADS = 512;
constexpr int NPHASE = 10;
#ifndef PROBE_REP
#define PROBE_REP -1
#endif

constexpr int TP = 16384, TS = 1024, TT = 17408, DM = 1024;
constexpr int NCH = 272;
constexpr int PAST = 4096, SKV = 4160;
constexpr float EPS = 1e-6f;
constexpr float LOG2E = 1.4426950408889634f;
enum { I_XP = 0, I_XS, I_CK, I_CV, I_CMK, I_CMV, I_SC, I_SN, I_SM, I_MEMP, I_NG, I_FNG, I_MNG, I_WMKV, I_WINA, I_BGA, I_HGA, I_WOA,
       I_KVNG, I_WKV, I_WINB, I_LAMB, I_SUBG, I_WOB };
constexpr size_t O_Y = 0, O_PC = 17825792, O_PN = 18087936, O_PM = 18088960, O_PK = 18088964, O_PV = 34866180, O_PMK = 51643396,
                 O_PMV = 51905540, O_SC = 52167684, O_SN = 56361988, O_SM = 56378372, O_SK = 56378436, O_SV = 57427012;
constexpr size_t WS_CTR = 0;
constexpr size_t WS_KMAX = 1024;
constexpr size_t WS_TORD = 8192;
constexpr size_t WS_WA = 16384;
constexpr size_t WS_WOA = WS_WA + (size_t)6144 * 1024 * 2;
constexpr size_t WS_WKB = WS_WOA + (size_t)1024 * 1536 * 2;
constexpr size_t WS_WOB = WS_WKB + (size_t)5120 * 1024 * 2;
constexpr size_t WS_WM = WS_WOB + (size_t)1024 * 1536 * 2;
constexpr size_t WS_MEMN = WS_WM + (size_t)2 * 1024 * 1024 * 2;
constexpr size_t WS_MEMK = WS_MEMN + (size_t)2 * 256 * 1024 * 2;
constexpr size_t WS_MEMVT = WS_MEMK + (size_t)2 * 17 * 256 * 512 * 2;
constexpr size_t WS_GATE = WS_MEMVT + (size_t)2 * 17 * 256 * 512 * 2;
constexpr size_t SZ_CH = (size_t)NCH * 4 * 64 * 4;
constexpr size_t WS_GC = WS_GATE + (size_t)TT * 8 * 4;
constexpr size_t WS_MT = WS_GC + SZ_CH;
constexpr size_t WS_WS = WS_MT + SZ_CH;
constexpr size_t WS_WI = WS_WS + SZ_CH;
constexpr size_t WS_AS = WS_WI + SZ_CH;
constexpr size_t WS_BT = WS_AS + SZ_CH;
constexpr size_t WS_DEC = WS_BT + SZ_CH;
constexpr size_t WS_DENI = WS_DEC + 8192;
constexpr size_t WS_DENA = WS_DENI + (size_t)TT * 4 * 4;
constexpr size_t WS_XN = WS_DENA + (size_t)TT * 4 * 4;
constexpr size_t WS_AO = WS_XN + (size_t)TT * 1024 * 2;
constexpr size_t WS_Y1 = WS_AO + (size_t)TT * 1536 * 2;
constexpr size_t WS_KT = WS_Y1 + (size_t)TT * 1024 * 4;
constexpr size_t WS_VTA = WS_KT + (size_t)NCH * 4 * 256 * 64 * 2;
constexpr size_t WS_R1 = WS_VTA + (size_t)NCH * 4 * 256 * 64 * 2;
constexpr size_t SZ_R1 = (size_t)TT * 6144 * 2;
constexpr size_t WS_PB = WS_R1;
constexpr size_t WS_KBP = WS_PB + (size_t)TT * 3072 * 2;
constexpr size_t WS_VTP = WS_KBP + (size_t)TP * 1024 * 2;
constexpr size_t WS_R2 = WS_R1 + SZ_R1;
constexpr size_t WS_HINTER = WS_R2;
constexpr size_t WS_HINTRA = WS_R2 + (size_t)TT * 1024 * 4;
constexpr size_t WS_KBS = WS_R2;
constexpr size_t WS_VTS = WS_KBS + (size_t)16 * SKV * 1024 * 2;
constexpr size_t WS_PM = WS_VTS + (size_t)16 * SKV * 1024 * 2;
constexpr size_t WS_CHS = WS_PM + SZ_CH;
constexpr size_t WS_LD = WS_CHS + 16384;
constexpr size_t WS_CLOC = WS_LD + 8192;
constexpr size_t WS_END = WS_CLOC + (size_t)16 * 36 * 8 * 64 * 16 * 4;
constexpr int GRP = 16;
static_assert(WS_VTP + (size_t)TP * 1024 * 2 <= WS_R2, "R1 overflow");

DI unsigned pk2(float lo, float hi) { f32x2 v = {lo, hi}; return __builtin_bit_cast(unsigned, __builtin_convertvector(v, bf2_t)); }
DI bf16_t f2bf(float x) { return (bf16_t)(pk2(x, 0.f) & 0xffffu); }
DI float bf2f(unsigned v16) { return __uint_as_float(v16 << 16); }
DI float bflo(unsigned u) { return __uint_as_float(u << 16); }
DI float bfhi(unsigned u) { return __uint_as_float(u & 0xffff0000u); }
DI float rbf(float x) { return bflo(pk2(x, 0.f) & 0xffffu); }
DI int crow(int i, int h) { return (i & 3) + 8 * (i >> 2) + 4 * h; }
DI float wave_sum(float v) {
#pragma unroll
  for (int o = 32; o >= 1; o >>= 1) v += __shfl_xor(v, o);
  return v;
}
DI float fexp2(float x) { return __builtin_amdgcn_exp2f(x); }
DI float fexp(float x) { return __builtin_amdgcn_exp2f(x * LOG2E); }
DI float sigmoidf_(float x) { return 1.f / (1.f + __expf(-x)); }
DI float siluf_(float x) { return x / (1.f + __expf(-x)); }
DI bf16x8 pack_acc(const f32x16& x, int s) {
  u32x4 p;
  p[0] = pk2(x[8 * s + 0], x[8 * s + 1]); p[1] = pk2(x[8 * s + 2], x[8 * s + 3]);
  p[2] = pk2(x[8 * s + 4], x[8 * s + 5]); p[3] = pk2(x[8 * s + 6], x[8 * s + 7]);
  return __builtin_bit_cast(bf16x8, p);
}
DI bf16x8 ld16(const void* p) { return *(const bf16x8*)p; }
DI bf16x8 ld8x2(const void* p0, const void* p1) {
  u32x2 a = *(const u32x2*)p0, b = *(const u32x2*)p1; u32x4 r = {a[0], a[1], b[0], b[1]};
  return __builtin_bit_cast(bf16x8, r);
}
DI f32x16 zero16() { f32x16 z; for (int i = 0; i < 16; ++i) z[i] = 0.f; return z; }

DI void transpose_tile(const float* __restrict__ src, size_t ld_s, bf16_t* __restrict__ dst, size_t ld_d, const float* __restrict__ scale,
                       float* scr, int t, bool perm = false) {
  {
    const int c4 = t & 31, rb = t >> 5;
    f32x4 v[4];
#pragma unroll
    for (int i = 0; i < 4; ++i) v[i] = *(const f32x4*)(src + (size_t)(rb + 16 * i) * ld_s + 4 * c4);
#pragma unroll
    for (int i = 0; i < 4; ++i) {
      const int r = rb + 16 * i;
      f32x4 x = v[i];
      if (scale) { const float sc = scale[r]; x = x * sc; }
      float* d = scr + r * 129 + 4 * c4; d[0] = x[0]; d[1] = x[1]; d[2] = x[2]; d[3] = x[3];
    }
  }
  __syncthreads();
#pragma unroll
  for (int i = 0; i < 2; ++i) {
    const int id = t + 512 * i, c = id >> 3, rg = id & 7;
    const float* s = scr + (8 * rg) * 129 + c;
    u32x4 o; o[0] = pk2(s[0], s[129]); o[1] = pk2(s[2 * 129], s[3 * 129]); o[2] = pk2(s[4 * 129], s[5 * 129]); o[3] = pk2(s[6 * 129], s[7 * 129]);
    if (!perm) *(u32x4*)(dst + (size_t)c * ld_d + 8 * rg) = o;
    else {
      bf16_t* d = dst + (size_t)c * ld_d + 16 * (rg >> 1) + 4 * (rg & 1);
      u32x2 lo = {o[0], o[1]}, hi = {o[2], o[3]};
      *(u32x2*)d = lo; *(u32x2*)(d + 8) = hi;
    }
  }
  __syncthreads();
}

struct TJob { const float* src; size_t ld_s; bf16_t* dst; size_t ld_d; const float* scale; int tr, tc; };

DI void run_tjob_tile(const TJob& j, int tile, float* scr, int tid, bool perm = false) {
  const int ir = tile / j.tc, ic = tile % j.tc;
  transpose_tile(j.src + (size_t)(64 * ir) * j.ld_s + 128 * ic, j.ld_s, j.dst + (size_t)(128 * ic) * j.ld_d + 64 * ir, j.ld_d,
                 j.scale ? j.scale + 64 * ir : nullptr, scr, tid, perm);
}

DI float row_load_rstd(const float* xrow, f32x4 (&v)[4], int lane) {
  float ss = 0.f;
#pragma unroll
  for (int j = 0; j < 4; ++j) { v[j] = *(const f32x4*)(xrow + 4 * lane + 256 * j); ss += v[j][0] * v[j][0] + v[j][1] * v[j][1] + v[j][2] * v[j][2] + v[j][3] * v[j][3]; }
  ss = wave_sum(ss);
  return __builtin_amdgcn_rsqf(ss * (1.f / 1024.f) + EPS);
}

DI int diff_window(int hd) { const float sl2 = exp2f(-(float)(hd + 1)) * LOG2E; return (int)floorf((63.f + 192.f / sl2) * (1.f / 64.f)); }
DI int diff_est(int a) {
  const int hd = a & 7;
  const int w = diff_window(hd) + (a < 1024 ? 2 : 1);
  const int n = a < 1024 ? 2 * (a >> 3) + 2 : 65;
  return n < w ? n : w;
}

DI void phase0(const Params& p, unsigned char* lds) {
  const int tid = TIDX, lane = tid & 63, wid = tid >> 6;
  unsigned char* ws = p.ws;
  if (blockIdx.x == 0 && tid < 64) ((unsigned*)(ws + WS_CTR))[tid] = 0u;
  if (blockIdx.x == 0 && tid < 272) ((unsigned*)(ws + WS_KMAX))[tid] = 0u;
  if (blockIdx.x == 1) {
    int* est = (int*)lds;
    for (int a = tid; a < 1152; a += NTHREADS) est[a] = diff_est(a);
    __syncthreads();
    for (int a = tid; a < 1152; a += NTHREADS) {
      const int ea = est[a];
      int rank = 0;
      for (int b = 0; b < 1152; ++b) { const int eb = est[b]; rank += (eb > ea) || (eb == ea && b < a); }
      ((int*)(ws + WS_TORD))[rank] = a;
    }
    __syncthreads();
  }
  {
    TJob jobs[8];
    jobs[0] = {p.in[I_WINA], 6152, (bf16_t*)(ws + WS_WA), 1024, p.in[I_NG], 16, 40};
    jobs[1] = {p.in[I_WINA] + 5128, 6152, (bf16_t*)(ws + WS_WA) + (size_t)5120 * 1024, 1024, p.in[I_NG], 16, 8};
    jobs[2] = {p.in[I_WOA], 1024, (bf16_t*)(ws + WS_WOA), 1536, nullptr, 24, 8};
    jobs[3] = {p.in[I_WKV], 2048, (bf16_t*)(ws + WS_WKB), 1024, p.in[I_KVNG], 16, 16};
    jobs[4] = {p.in[I_WINB], 3072, (bf16_t*)(ws + WS_WKB) + (size_t)2048 * 1024, 1024, p.in[I_NG] + 1024, 16, 24};
    jobs[5] = {p.in[I_WOB], 1024, (bf16_t*)(ws + WS_WOB), 1536, nullptr, 24, 8};
    jobs[6] = {p.in[I_WMKV], 1024, (bf16_t*)(ws + WS_WM), 1024, nullptr, 16, 8};
    jobs[7] = {p.in[I_WMKV] + (size_t)1024 * 1024, 1024, (bf16_t*)(ws + WS_WM) + (size_t)1024 * 1024, 1024, nullptr, 16, 8};
    int base = 0;
#pragma unroll
    for (int j = 0; j < 8; ++j) {
      const int n = jobs[j].tr * jobs[j].tc;
      for (int t = blockIdx.x; t < n; t += gridDim.x) run_tjob_tile(jobs[j], t, (float*)lds, tid);
      base += n;
    }
    for (int t = blockIdx.x; t < 128 * 4; t += gridDim.x) {
      const int jb = t >> 2, tile = t & 3, l = jb >> 6, b = (jb >> 2) & 15, h = jb & 3;
      TJob j = {p.in[I_CMV] + ((size_t)(l * 16 + b) * 256) * 512 + h * 128, 512,
                (bf16_t*)(ws + WS_MEMVT) + ((size_t)(l * 17 + 1 + b) * 4 + h) * 128 * 256, 256, nullptr, 4, 1};
      run_tjob_tile(j, tile, (float*)lds, tid, true);
    }
  }
  {
    const size_t n8 = (size_t)2 * 16 * 256 * 512 / 8;
    for (size_t i = (size_t)blockIdx.x * NTHREADS + tid; i < n8; i += (size_t)gridDim.x * NTHREADS) {
      const size_t e = i * 8; const int l = (int)(e / ((size_t)16 * 131072)); const size_t rem = e - (size_t)l * 16 * 131072;
      const f32x4 a = *(const f32x4*)(p.in[I_CMK] + e), b = *(const f32x4*)(p.in[I_CMK] + e + 4);
      u32x4 o = {pk2(a[0], a[1]), pk2(a[2], a[3]), pk2(b[0], b[1]), pk2(b[2], b[3])};
      *(u32x4*)((bf16_t*)(ws + WS_MEMK) + ((size_t)(l * 17 + 1) * 131072) + rem) = o;
    }
  }
  {
    const int gw = blockIdx.x * 8 + wid, nw = gridDim.x * 8;
    const float* ng = p.in[I_NG];
    float* gwt = (float*)(lds + 32768);
    float* sg = (float*)(lds + 65536);
    __syncthreads();
    for (int i = tid; i < 8192; i += NTHREADS) { const int k = i >> 3, c = i & 7; gwt[i] = p.in[I_WINA][(size_t)k * 6152 + 5120 + c] * ng[k]; }
    __syncthreads();
    for (int cc = blockIdx.x; cc < NCH; cc += gridDim.x) {
      for (int ri = 0; ri < 8; ++ri) {
        const int r = cc * 64 + wid * 8 + ri;
        const float* xrow = r < TP ? p.in[I_XP] + (size_t)r * 1024 : p.in[I_XS] + (size_t)(r - TP) * 1024;
        f32x4 v[4];
        const float rstd = row_load_rstd(xrow, v, lane);
        float gacc[8];
#pragma unroll
        for (int c = 0; c < 8; ++c) gacc[c] = 0.f;
        bf16_t* xn = (bf16_t*)(ws + WS_XN) + (size_t)r * 1024;
#pragma unroll
        for (int j = 0; j < 4; ++j) {
          const int k0 = 4 * lane + 256 * j;
          const f32x4 xs = v[j] * rstd;
          u32x2 o = {pk2(xs[0], xs[1]), pk2(xs[2], xs[3])};
          *(u32x2*)(xn + k0) = o;
#pragma unroll
          for (int e = 0; e < 4; ++e) {
            const float* wr = gwt + (k0 + e) * 8;
            const f32x4 w0 = *(const f32x4*)wr, w1 = *(const f32x4*)(wr + 4);
            gacc[0] += xs[e] * w0[0]; gacc[1] += xs[e] * w0[1]; gacc[2] += xs[e] * w0[2]; gacc[3] += xs[e] * w0[3];
            gacc[4] += xs[e] * w1[0]; gacc[5] += xs[e] * w1[1]; gacc[6] += xs[e] * w1[2]; gacc[7] += xs[e] * w1[3];
          }
        }
#pragma unroll
        for (int c = 0; c < 8; ++c) gacc[c] = wave_sum(gacc[c]);
        if (lane < 8) {
          float gv = gacc[0];
#pragma unroll
          for (int c = 1; c < 8; ++c) gv = lane == c ? gacc[c] : gv;
          gv += p.in[I_BGA][lane];
          if (lane >= 4) gv = fminf(gv, 0.f) - log1pf(__expf(-fabsf(gv)));
          sg[(wid * 8 + ri) * 8 + lane] = gv;
        }
      }
      __syncthreads();
      if (wid < 4) {
        const int hd = wid, pr = cc * 4 + hd;
        const float ig = sg[lane * 8 + hd], lf = sg[lane * 8 + 4 + hd];
        float g = lf;
#pragma unroll
        for (int o = 1; o < 64; o <<= 1) { const float t = __shfl_up(g, o); if (lane >= o) g += t; }
        const float a = ig - g;
        float pm = a;
#pragma unroll
        for (int o = 1; o < 64; o <<= 1) { const float t = __shfl_up(pm, o); if (lane >= o) pm = fmaxf(pm, t); }
        const size_t o = (size_t)pr * 64 + lane;
        ((float*)(ws + WS_GC))[o] = g;
        ((float*)(ws + WS_AS))[o] = a;
        ((float*)(ws + WS_PM))[o] = pm;
        if (lane == 63) { ((float*)(ws + WS_CHS))[pr * 2] = g; ((float*)(ws + WS_CHS))[pr * 2 + 1] = pm; }
      }
      __syncthreads();
    }
    for (int r = gw; r < 512; r += nw) {
      const int l = r >> 8, rr = r & 255;
      f32x4 v[4];
      const float rstd = row_load_rstd(p.in[I_MEMP] + (size_t)rr * 1024, v, lane);
      bf16_t* o = (bf16_t*)(ws + WS_MEMN) + (size_t)r * 1024;
#pragma unroll
      for (int j = 0; j < 4; ++j) {
        const int k0 = 4 * lane + 256 * j;
        const f32x4 g = *(const f32x4*)(p.in[I_MNG] + l * 1024 + k0);
        const f32x4 xs = v[j] * rstd * g;
        u32x2 ov = {pk2(xs[0], xs[1]), pk2(xs[2], xs[3])};
        *(u32x2*)(o + k0) = ov;
      }
    }
  }
}

constexpr int G_STAGE = 49152;
struct GemmAcc { f32x16 a[2][2]; };
DI void dma16(const void* g, unsigned char* l) { __builtin_amdgcn_global_load_lds((const unsigned*)g, (unsigned*)l, 16, 0, 0); }

template <int NB = 2>
DI void gemm_tile(const bf16_t* __restrict__ A, size_t lda, const bf16_t* __restrict__ Bt, size_t ldb, int K, unsigned char* lds, GemmAcc& acc, int tid) {
  const int lane = tid & 63, wid = __builtin_amdgcn_readfirstlane(tid >> 6), r = lane & 31, h = lane >> 5;
  const int wr = wid >> 1, wc = wid & 1;
#pragma unroll
  for (int a = 0; a < 2; ++a)
#pragma unroll
    for (int b = 0; b < 2; ++b) acc.a[a][b] = zero16();
  const int nk = K / 64;
  unsigned aoff[4], boff[2];
#pragma unroll
  for (int e = 0; e < 4; ++e) { const int row = 8 * (wid * 4 + e) + (lane >> 3), lc = (lane & 7) ^ ((row >> 1) & 7); aoff[e] = (unsigned)row * (unsigned)lda + 8u * lc; }
#pragma unroll
  for (int e = 0; e < NB; ++e) { const int row = 8 * (wid * NB + e) + (lane >> 3), lc = (lane & 7) ^ ((row >> 1) & 7); boff[e] = (unsigned)row * (unsigned)ldb + 8u * lc; }
  auto issue = [&](int kt, int buf) {
    unsigned char* base = lds + buf * G_STAGE;
#pragma unroll
    for (int e = 0; e < 4; ++e) dma16(A + (aoff[e] + 64u * kt), base + (wid * 4 + e) * 1024);
#pragma unroll
    for (int e = 0; e < NB; ++e) dma16(Bt + (boff[e] + 64u * kt), base + 32768 + (wid * NB + e) * 1024);
  };
  asm volatile("s_waitcnt vmcnt(0)" ::: "memory");
  __syncthreads();
  issue(0, 0);
  if (nk > 1) issue(1, 1);
  const unsigned sw = (r >> 1) & 7;
  unsigned co[4];
#pragma unroll
  for (int kk = 0; kk < 4; ++kk) co[kk] = (((2 * kk + h) ^ sw) << 4);
  const unsigned ra = (wr * 64 + r) * 128, rb = 32768 + (wc * 32 * NB + r) * 128;
  for (int kt = 0; kt < nk; ++kt) {
    if (kt + 1 < nk) { if (NB == 2) asm volatile("s_waitcnt vmcnt(6)" ::: "memory"); else asm volatile("s_waitcnt vmcnt(5)" ::: "memory"); }
    else asm volatile("s_waitcnt vmcnt(0)" ::: "memory");
    asm volatile("s_waitcnt lgkmcnt(0)" ::: "memory");
    __builtin_amdgcn_s_barrier();
    if (kt + 2 < nk) issue(kt + 2, (kt + 2) % 3);
    const unsigned char* base = lds + (kt % 3) * G_STAGE;
    const unsigned char* pa = base + ra;
    const unsigned char* pb = base + rb;
#pragma unroll
    for (int kk = 0; kk < 4; ++kk) {
      const bf16x8 a0 = ld16(pa + co[kk]), a1 = ld16(pa + 4096 + co[kk]);
      const bf16x8 b0 = ld16(pb + co[kk]);
      acc.a[0][0] = MFMA32(a0, b0, acc.a[0][0]);
      acc.a[1][0] = MFMA32(a1, b0, acc.a[1][0]);
      if (NB == 2) {
        const bf16x8 b1 = ld16(pb + 4096 + co[kk]);
        acc.a[0][1] = MFMA32(a0, b1, acc.a[0][1]);
        acc.a[1][1] = MFMA32(a1, b1, acc.a[1][1]);
      }
    }
  }
}

DI void gate_scan(const Params& p, unsigned char* lds) {
  const int tid = TIDX, lane = tid & 63, wid = tid >> 6;
  unsigned char* ws = p.ws;
  float* s_ch = (float*)lds;
  float* s_mc = s_ch + NCH * 8;
  float* s_mn = s_mc + NCH * 4;
  __syncthreads();
  for (int i = tid; i < NCH * 8; i += NTHREADS) s_ch[i] = ((const float*)(ws + WS_CHS))[i];
  __syncthreads();
  if (tid < 4) {
    float m = 0.f, ld = 0.f;
    float* LD = (float*)(ws + WS_LD);
    const bool wr = blockIdx.x == 0;
    for (int c = 0; c < 256; ++c) {
      s_mc[c * 4 + tid] = m; if (wr) LD[c * 4 + tid] = ld;
      const float gl = s_ch[(c * 4 + tid) * 2], mn = gl + fmaxf(m, s_ch[(c * 4 + tid) * 2 + 1]);
      ld += gl + m - mn;
      m = mn; s_mn[c * 4 + tid] = m;
    }
    if (wr) { LD[256 * 4 + tid] = ld; p.out[O_PM + tid] = m; }
  } else if (tid >= 64 && tid < 128) {
    const int b = (tid - 64) >> 2, hd = tid & 3, pr = (256 + b) * 4 + hd;
    const float m0 = p.in[I_SM][b * 4 + hd];
    const float m = s_ch[pr * 2] + fmaxf(m0, s_ch[pr * 2 + 1]);
    s_mc[pr] = m0; s_mn[pr] = m;
    if (blockIdx.x == 0) p.out[O_SM + b * 4 + hd] = m;
  }
  __syncthreads();
  for (int cc = blockIdx.x; cc < NCH; cc += gridDim.x) {
    if (wid < 4) {
      const int hd = wid, pr = cc * 4 + hd;
      const size_t o = (size_t)pr * 64 + lane;
      const float g = ((const float*)(ws + WS_GC))[o], a = ((const float*)(ws + WS_AS))[o], pm = ((const float*)(ws + WS_PM))[o];
      const float mc = s_mc[pr], mn = s_mn[pr], gl = s_ch[pr * 2];
      const float mt = g + fmaxf(mc, pm);
      ((float*)(ws + WS_MT))[o] = mt;
      ((float*)(ws + WS_WS))[o] = __expf(gl + a - mn);
      ((float*)(ws + WS_WI))[o] = __expf(g + mc - mt);
      ((float*)(ws + WS_AS))[o] = a * LOG2E;
      ((float*)(ws + WS_BT))[o] = (g - mt) * LOG2E;
      if (lane == 0) ((float*)(ws + WS_DEC))[pr] = __expf(gl + mc - mn);
    }
  }
  __syncthreads();
}

DI void phase1(const Params& p, unsigned char* lds) {
  const int tid = TIDX, lane = tid & 63, wid = tid >> 6, r = lane & 31, h = lane >> 5, wr = wid >> 1, wc = wid & 1;
  unsigned char* ws = p.ws;
  gate_scan(p, lds);
  const int n_main = 68 * 48, n_mem = 16;
  for (int t = blockIdx.x; t < n_main + n_mem; t += gridDim.x) {
    GemmAcc acc;
    if (t < n_main) {
      const int tm = t / 48, tn = t % 48, m0 = tm * 256, n0 = tn * 128;
      gemm_tile((const bf16_t*)(ws + WS_XN) + (size_t)m0 * 1024, 1024, (const bf16_t*)(ws + WS_WA) + (size_t)n0 * 1024, 1024, 1024, lds, acc, tid);
      bf16_t* PA = (bf16_t*)(ws + WS_R1);
      const int sec = n0 >> 10;
#pragma unroll
      for (int a = 0; a < 2; ++a)
#pragma unroll
        for (int b = 0; b < 2; ++b) {
          __builtin_amdgcn_sched_barrier(0);
          const int n = n0 + wc * 64 + 32 * b + r, mb = m0 + wr * 64 + 32 * a;
          if (sec != 2) {
            const float sc = sec == 1 ? 0.0625f : 1.f;
            const int pc = (n >> 2) & 3, np = sec <= 1 ? (n & ~15) + 4 * (((pc & 1) << 1) | (pc >> 1)) + (n & 3) : n;
#pragma unroll
            for (int i = 0; i < 16; ++i) PA[(size_t)(mb + crow(i, h)) * 6144 + np] = f2bf(acc.a[a][b][i] * sc);
          }
          if (sec == 1 || sec == 2) {
            const float sc = sec == 1 ? 0.0625f : 1.f;
            const int f = n & 1023, hd = f >> 8, fe = f & 255;
            bf16_t* T = (bf16_t*)(ws + (sec == 1 ? WS_KT : WS_VTA));
#pragma unroll
            for (int g = 0; g < 4; ++g) {
              const int m = mb + 8 * g + 4 * h, cc = m >> 6, s = m & 63;
              u32x2 o = {pk2(acc.a[a][b][4 * g] * sc, acc.a[a][b][4 * g + 1] * sc), pk2(acc.a[a][b][4 * g + 2] * sc, acc.a[a][b][4 * g + 3] * sc)};
              *(u32x2*)(T + (((size_t)cc * 4 + hd) * 256 + fe) * 64 + s) = o;
            }
          }
        }
    } else {
      const int tt = t - n_main, l = tt >> 3, n0 = (tt & 7) * 128;
      gemm_tile((const bf16_t*)(ws + WS_MEMN) + (size_t)l * 256 * 1024, 1024, (const bf16_t*)(ws + WS_WM) + ((size_t)l * 1024 + n0) * 1024, 1024, 1024, lds, acc, tid);
      const bool isv = n0 >= 512;
      float* of = p.out + (isv ? O_PMV : O_PMK) + (size_t)l * 131072;
      bf16_t* mk = (bf16_t*)(ws + WS_MEMK) + (size_t)(l * 17) * 131072;
      bf16_t* mv = (bf16_t*)(ws + WS_MEMVT) + (size_t)(l * 17) * 131072;
#pragma unroll
      for (int a = 0; a < 2; ++a)
#pragma unroll
        for (int b = 0; b < 2; ++b) {
          __builtin_amdgcn_sched_barrier(0);
          const int f = (n0 & 511) + wc * 64 + 32 * b + r, mb = wr * 64 + 32 * a;
#pragma unroll
          for (int g = 0; g < 4; ++g) {
            const int m = mb + 8 * g + 4 * h;
            float* o4 = of + (size_t)m * 512 + f;
            o4[0] = acc.a[a][b][4 * g]; o4[512] = acc.a[a][b][4 * g + 1]; o4[1024] = acc.a[a][b][4 * g + 2]; o4[1536] = acc.a[a][b][4 * g + 3];
            if (!isv) {
              bf16_t* k4 = mk + (size_t)m * 512 + f;
              k4[0] = f2bf(acc.a[a][b][4 * g]); k4[512] = f2bf(acc.a[a][b][4 * g + 1]); k4[1024] = f2bf(acc.a[a][b][4 * g + 2]); k4[1536] = f2bf(acc.a[a][b][4 * g + 3]);
            } else {
              u32x2 o = {pk2(acc.a[a][b][4 * g], acc.a[a][b][4 * g + 1]), pk2(acc.a[a][b][4 * g + 2], acc.a[a][b][4 * g + 3])};
              const int pq = (m >> 2) & 3, mp = (m & ~15) + 4 * (((pq & 1) << 1) | (pq >> 1));
              *(u32x2*)(mv + (size_t)f * 256 + mp) = o;
            }
          }
        }
    }
  }
}

DI void scan_task(const Params& p, unsigned char* lds, int sb  , int hd, int j, int grp) {
  const int tid = TIDX, lane = tid & 63, wid = tid >> 6, r = lane & 31, h = lane >> 5;
  unsigned char* ws = p.ws;
  const int cc0 = sb < 0 ? GRP * grp : 256 + sb, nch = sb < 0 ? GRP : 1;
  const bf16_t* PA = (const bf16_t*)(ws + WS_R1);
  const bf16_t* KT = (const bf16_t*)(ws + WS_KT);
  const bf16_t* VT = (const bf16_t*)(ws + WS_VTA);
  const float* WSa = (const float*)(ws + WS_WS);
  const float* WIa = (const float*)(ws + WS_WI);
  const float* DEC = (const float*)(ws + WS_DEC);
  float* red = (float*)lds;
  const bool nsl = j == 8;
  f32x16 S = zero16();
  if (sb >= 0) {
    if (!nsl) {
      const float* C0 = p.in[I_SC] + ((size_t)(sb * 4 + hd) * 256 + 32 * j + r) * 256 + 32 * wid;
#pragma unroll
      for (int g = 0; g < 4; ++g) { const f32x4 c = *(const f32x4*)(C0 + 8 * g + 4 * h); S[4 * g] = c[0]; S[4 * g + 1] = c[1]; S[4 * g + 2] = c[2]; S[4 * g + 3] = c[3]; }
    } else if (r == 0) {
      const float* n0 = p.in[I_SN] + (size_t)(sb * 4 + hd) * 256 + 32 * wid;
#pragma unroll
      for (int g = 0; g < 4; ++g) { const f32x4 c = *(const f32x4*)(n0 + 8 * g + 4 * h); S[4 * g] = c[0]; S[4 * g + 1] = c[1]; S[4 * g + 2] = c[2]; S[4 * g + 3] = c[3]; }
    }
  }
  bf16x8 kt[4], wv[4], qf[2][2];
  u32x4 ktn[4], vn[4], qn[2][2];
  float wsn;
  float* wsl = (float*)(lds + 69632);
  auto loadraw = [&](int cc) {
    const size_t ch = (size_t)cc * 4 + hd;
    const bf16_t* kp = KT + (ch * 256 + 32 * wid + r) * 64 + 8 * h;
#pragma unroll
    for (int st = 0; st < 4; ++st) ktn[st] = *(const u32x4*)(kp + 16 * st);
    wsn = WSa[ch * 64 + lane];
    if (!nsl) {
      const bf16_t* vp = VT + (ch * 256 + 32 * j + r) * 64 + 8 * h;
#pragma unroll
      for (int st = 0; st < 4; ++st) vn[st] = *(const u32x4*)(vp + 16 * st);
    }
#pragma unroll
    for (int tt = 0; tt < 2; ++tt) {
      const bf16_t* qp = PA + (size_t)(cc * 64 + 32 * tt + r) * 6144 + hd * 256 + 32 * wid + 8 * h;
#pragma unroll
      for (int s2 = 0; s2 < 2; ++s2) qn[tt][s2] = *(const u32x4*)(qp + 16 * s2);
    }
  };
  auto convert = [&]() {
    __syncthreads();
    if (wid == 0) wsl[lane] = wsn;
    __syncthreads();
#pragma unroll
    for (int st = 0; st < 4; ++st) {
      kt[st] = __builtin_bit_cast(bf16x8, ktn[st]);
      const f32x4 w0 = *(const f32x4*)(wsl + 16 * st + 8 * h), w1 = *(const f32x4*)(wsl + 16 * st + 8 * h + 4);
      u32x4 o;
      if (!nsl) {
        const u32x4 v = vn[st];
        o[0] = pk2(bflo(v[0]) * w0[0], bfhi(v[0]) * w0[1]); o[1] = pk2(bflo(v[1]) * w0[2], bfhi(v[1]) * w0[3]);
        o[2] = pk2(bflo(v[2]) * w1[0], bfhi(v[2]) * w1[1]); o[3] = pk2(bflo(v[3]) * w1[2], bfhi(v[3]) * w1[3]);
      } else {
        o = (u32x4){pk2(w0[0], w0[1]), pk2(w0[2], w0[3]), pk2(w1[0], w1[1]), pk2(w1[2], w1[3])};
        if (r != 0) o = (u32x4){0u, 0u, 0u, 0u};
      }
      wv[st] = __builtin_bit_cast(bf16x8, o);
    }
#pragma unroll
    for (int tt = 0; tt < 2; ++tt)
#pragma unroll
      for (int s2 = 0; s2 < 2; ++s2) qf[tt][s2] = __builtin_bit_cast(bf16x8, qn[tt][s2]);
  };
  loadraw(cc0);
  convert();
  for (int c = 0; c < nch; ++c) {
    const int cc = cc0 + c;
    if (c + 1 < nch) loadraw(cc + 1);
    const float dec = DEC[cc * 4 + hd];
    const bf16x8 xs0 = pack_acc(S, 0), xs1 = pack_acc(S, 1);
    f32x16 z0 = MFMA32(xs0, qf[0][0], zero16()); z0 = MFMA32(xs1, qf[0][1], z0);
    f32x16 z1 = MFMA32(xs0, qf[1][0], zero16()); z1 = MFMA32(xs1, qf[1][1], z1);
    S = S * dec;
#pragma unroll
    for (int st = 0; st < 4; ++st) S = MFMA32(kt[st], wv[st], S);
    __syncthreads();
    {
      float* rw = red + wid * (64 * 33);
#pragma unroll
      for (int i = 0; i < 16; ++i) { rw[r * 33 + crow(i, h)] = z0[i]; rw[(32 + r) * 33 + crow(i, h)] = z1[i]; }
    }
    __syncthreads();
    {
      const int v = tid & 31;
#pragma unroll
      for (int e = 0; e < 4; ++e) {
        const int t = (tid >> 5) + 16 * e;
        float s = 0.f;
#pragma unroll
        for (int w8 = 0; w8 < 8; ++w8) s += red[w8 * (64 * 33) + t * 33 + v];
        const float wi = WIa[((size_t)cc * 4 + hd) * 64 + t];
        if (!nsl) ((float*)(ws + WS_HINTER))[(size_t)(cc * 64 + t) * 1024 + hd * 256 + 32 * j + v] = s * wi;
        else if (v == 0) ((float*)(ws + WS_DENI))[(size_t)(cc * 64 + t) * 4 + hd] = s * wi;
      }
    }
    if (c + 1 < nch) convert();
  }
  if (sb < 0) {
    float* cl = (float*)(ws + WS_CLOC) + ((((size_t)(grp * 4 + hd) * 9 + j) * 8 + wid) * 64 + lane) * 16;
#pragma unroll
    for (int g = 0; g < 4; ++g) { f32x4 c = {S[4 * g], S[4 * g + 1], S[4 * g + 2], S[4 * g + 3]}; *(f32x4*)(cl + 4 * g) = c; }
  } else {
    if (!nsl) {
      float* Co = (sb < 0 ? p.out + O_PC + (size_t)hd * 65536 : p.out + O_SC + (size_t)(sb * 4 + hd) * 65536) + (size_t)(32 * j + r) * 256 + 32 * wid;
#pragma unroll
      for (int g = 0; g < 4; ++g) { f32x4 c = {S[4 * g], S[4 * g + 1], S[4 * g + 2], S[4 * g + 3]}; *(f32x4*)(Co + 8 * g + 4 * h) = c; }
    } else if (r == 0) {
      float* no = (sb < 0 ? p.out + O_PN + (size_t)hd * 256 : p.out + O_SN + (size_t)(sb * 4 + hd) * 256) + 32 * wid;
#pragma unroll
      for (int g = 0; g < 4; ++g) { f32x4 c = {S[4 * g], S[4 * g + 1], S[4 * g + 2], S[4 * g + 3]}; *(f32x4*)(no + 8 * g + 4 * h) = c; }
    }
  }
  __syncthreads();
}

DI void intra_task(const Params& p, int cc, int hd) {
  const int tid = TIDX, lane = tid & 63, wid = tid >> 6, r = lane & 31, h = lane >> 5;
  unsigned char* ws = p.ws;
  const int tt = wid & 1, vq = wid >> 1;
  const bf16_t* PA = (const bf16_t*)(ws + WS_R1);
  const bf16_t* VT = (const bf16_t*)(ws + WS_VTA);
  const size_t ch = (size_t)cc * 4 + hd;
  f32x16 s0 = zero16(), s1 = zero16();
  {
    const bf16_t* qp = PA + (size_t)(cc * 64 + 32 * tt + r) * 6144 + hd * 256 + 8 * h;
    const bf16_t* kp = PA + (size_t)(cc * 64 + r) * 6144 + 1024 + hd * 256 + 8 * h;
#pragma unroll 4
    for (int kk = 0; kk < 16; ++kk) {
      const bf16x8 q = ld16(qp + 16 * kk), k0 = ld16(kp + 16 * kk), k1 = ld16(kp + (size_t)32 * 6144 + 16 * kk);
      s0 = MFMA32(k0, q, s0);
      if (tt == 1) s1 = MFMA32(k1, q, s1);
    }
  }
  const int t = 32 * tt + r;
  const float bt = ((const float*)(ws + WS_BT))[ch * 64 + t];
  const float* asp = (const float*)(ws + WS_AS) + ch * 64;
  float den = 0.f;
#pragma unroll
  for (int g = 0; g < 4; ++g) {
    const f32x4 a0 = *(const f32x4*)(asp + 8 * g + 4 * h);
    const f32x4 a1 = *(const f32x4*)(asp + 32 + 8 * g + 4 * h);
#pragma unroll
    for (int e = 0; e < 4; ++e) {
      const int s = 8 * g + 4 * h + e;
      const float w0 = s <= t ? fexp2(bt + a0[e]) : 0.f;
      const float w1 = (32 + s) <= t ? fexp2(bt + a1[e]) : 0.f;
      s0[4 * g + e] *= w0; s1[4 * g + e] *= w1;
      den += s0[4 * g + e] + s1[4 * g + e];
    }
  }
  den += __shfl_xor(den, 32);
  if (vq == 0 && h == 0) ((float*)(ws + WS_DENA))[(size_t)(cc * 64 + t) * 4 + hd] = den;
  bf16x8 pf[2][2];
  pf[0][0] = pack_acc(s0, 0); pf[0][1] = pack_acc(s0, 1); pf[1][0] = pack_acc(s1, 0); pf[1][1] = pack_acc(s1, 1);
  float* Ho = (float*)(ws + WS_HINTRA) + (size_t)(cc * 64 + t) * 1024 + hd * 256;
#pragma unroll
  for (int vt = 0; vt < 2; ++vt) {
    const int v0 = vq * 64 + vt * 32;
    const bf16_t* vp = VT + (ch * 256 + v0 + r) * 64 + 4 * h;
    f32x16 o = zero16();
#pragma unroll
    for (int st = 0; st < 2; ++st)
#pragma unroll
      for (int s2 = 0; s2 < 2; ++s2) {
        const bf16x8 a = ld8x2(vp + 32 * st + 16 * s2, vp + 32 * st + 16 * s2 + 8);
        o = MFMA32(a, pf[st][s2], o);
      }
#pragma unroll
    for (int g = 0; g < 4; ++g) { f32x4 c = {o[4 * g], o[4 * g + 1], o[4 * g + 2], o[4 * g + 3]}; *(f32x4*)(Ho + v0 + 8 * g + 4 * h) = c; }
  }
}

DI void memattn_task(const Params& p, unsigned char* lds, int task, int layer, const bf16_t* Qb, const bf16_t* Zb, unsigned ldq) {
  const int tid = TIDX, lane = tid & 63, wid = __builtin_amdgcn_readfirstlane(tid >> 6), r = lane & 31, h = lane >> 5;
  unsigned char* ws = p.ws;
  const bool prm = task < 256;
  const int hd = task & 3, ti = prm ? task >> 2 : (task - 256) >> 2;
  const int sbi = prm ? 0 : 1 + ti, tok0 = prm ? ti * 256 : TP + ti * 64, nact = prm ? 8 : 2;
  const bf16_t* MK = (const bf16_t*)(ws + WS_MEMK) + (size_t)(layer * 17 + sbi) * 131072 + hd * 128;
  const bf16_t* MV = (const bf16_t*)(ws + WS_MEMVT) + ((size_t)(layer * 17 + sbi) * 4 + hd) * 128 * 256;
  asm volatile("s_waitcnt vmcnt(0)" ::: "memory");
  __syncthreads();
#pragma unroll
  for (int e = 0; e < 8; ++e) {
    const int q = wid * 8 + e;
    { const int row = 4 * q + (lane >> 4), lc = (lane & 15) ^ (row & 15); dma16(MK + ((unsigned)row * 512u + 8u * lc), lds + q * 1024); }
    { const int row = 2 * q + (lane >> 5), lc = (lane & 31) ^ (row & 15); dma16(MV + ((unsigned)row * 256u + 8u * lc), lds + 65536 + q * 1024); }
  }
  const int tok = tok0 + (wid < nact ? wid : 0) * 32 + r;
  bf16x8 qf[8];
  {
    const bf16_t* qp = Qb + ((unsigned)tok * ldq + hd * 128 + 8 * h);
#pragma unroll
    for (int kk = 0; kk < 8; ++kk) qf[kk] = ld16(qp + 16 * kk);
  }
  asm volatile("s_waitcnt vmcnt(0)" ::: "memory");
  __syncthreads();
  if (wid >= nact) return;
  const float sc = 0.08838834764831845f * LOG2E;
  f32x16 O[4];
#pragma unroll
  for (int vt = 0; vt < 4; ++vt) O[vt] = zero16();
  float mrun = -1e30f, l = 0.f;
  const unsigned sw = r & 15;
#pragma unroll 1
  for (int kb = 0; kb < 4; ++kb) {
    f32x16 s0 = zero16(), s1 = zero16();
    const unsigned char* kp = lds + (kb * 64 + r) * 256;
#pragma unroll
    for (int kk = 0; kk < 8; ++kk) {
      const unsigned co = ((unsigned)(2 * kk + h) ^ sw) << 4;
      const bf16x8 k0 = ld16(kp + co), k1 = ld16(kp + 8192 + co);
      s0 = MFMA32(k0, qf[kk], s0); s1 = MFMA32(k1, qf[kk], s1);
    }
    float mx = -1e30f;
#pragma unroll
    for (int i = 0; i < 16; ++i) mx = fmaxf(mx, fmaxf(s0[i], s1[i]));
    mx = fmaxf(mx, __shfl_xor(mx, 32)) * sc;
    const float mnew = fmaxf(mrun, mx), alpha = fexp2(mrun - mnew);
    mrun = mnew;
    float sum = 0.f;
#pragma unroll
    for (int i = 0; i < 16; ++i) { s0[i] = fexp2(s0[i] * sc - mnew); s1[i] = fexp2(s1[i] * sc - mnew); sum += s0[i] + s1[i]; }
    l = l * alpha + sum;
#pragma unroll
    for (int vt = 0; vt < 4; ++vt) O[vt] = O[vt] * alpha;
    bf16x8 pf[2][2];
    pf[0][0] = pack_acc(s0, 0); pf[0][1] = pack_acc(s0, 1); pf[1][0] = pack_acc(s1, 0); pf[1][1] = pack_acc(s1, 1);
#pragma unroll
    for (int vt = 0; vt < 4; ++vt) {
      const unsigned char* vp = lds + 65536 + (32 * vt + r) * 512;
#pragma unroll
      for (int st = 0; st < 2; ++st)
#pragma unroll
        for (int s2 = 0; s2 < 2; ++s2) {
          const unsigned co = ((unsigned)(8 * kb + 4 * st + 2 * s2 + h) ^ sw) << 4;
          O[vt] = MFMA32(ld16(vp + co), pf[st][s2], O[vt]);
        }
    }
  }
  l += __shfl_xor(l, 32);
  const float inv = 1.f / l;
  const bf16_t* zp = Zb + ((unsigned)tok * ldq + hd * 128);
  bf16_t* op = (bf16_t*)(ws + WS_AO) + ((unsigned)tok * 1536u + 1024 + hd * 128);
#pragma unroll
  for (int vt = 0; vt < 4; ++vt)
#pragma unroll
    for (int g = 0; g < 4; ++g) {
      const int v = 32 * vt + 8 * g + 4 * h;
      const u32x2 z = *(const u32x2*)(zp + v);
      const float o0 = O[vt][4 * g] * inv * siluf_(bflo(z[0])), o1 = O[vt][4 * g + 1] * inv * siluf_(bfhi(z[0]));
      const float o2 = O[vt][4 * g + 2] * inv * siluf_(bflo(z[1])), o3 = O[vt][4 * g + 3] * inv * siluf_(bfhi(z[1]));
      u32x2 o = {pk2(o0, o1), pk2(o2, o3)};
      *(u32x2*)(op + v) = o;
    }
}

DI int next_item(unsigned* ctr, unsigned char* lds_flag_area, int tid) {
  __syncthreads();
  int* sh = (int*)lds_flag_area;
  if (tid == 0) *sh = (int)atomicAdd(ctr, 1u);
  __syncthreads();
  const int v = *sh;
  return v;
}

DI void phase2(const Params& p, unsigned char* lds) {
  unsigned* ctr = (unsigned*)(p.ws + WS_CTR) + 0 + 8 * p.pad;
  const bf16_t* PA = (const bf16_t*)(p.ws + WS_R1);
  const int n_ps = 36 * 16, n_ss = 576, n_in = NCH * 4, n_ma = 256 + 64;
  for (;;) {
    const int it = next_item(ctr, lds + LDS_BYTES - 16, TIDX);
    if (it >= n_ps + n_ss + n_in + n_ma) break;
    if (it < n_ps) scan_task(p, lds, -1, (it % 36) / 9, it % 9, it / 36);
    else if (it < n_ps + n_ss) { const int q = it - n_ps; scan_task(p, lds, q / 36, (q % 36) / 9, q % 9, 0); }
    else if (it < n_ps + n_ss + n_in) { const int q = it - n_ps - n_ss; intra_task(p, q >> 2, q & 3); }
    else { const int q = it - n_ps - n_ss - n_in; memattn_task(p, lds, q, 0, PA + 5120, PA + 5632, 6144); }
  }
}


DI void scanfix_task(const Params& p, unsigned char* lds, int grp, int hd, int j) {
  const int tid = TIDX, lane = tid & 63, wid = tid >> 6, r = lane & 31, h = lane >> 5;
  unsigned char* ws = p.ws;
  const bool nsl = j == 8;
  const float* LD = (const float*)(ws + WS_LD);
  f32x16 S = zero16();
#pragma unroll 4
  for (int gp = 0; gp < grp; ++gp) {
    const float dg = __expf(LD[(GRP * (gp + 1)) * 4 + hd] - LD[(GRP * gp) * 4 + hd]);
    const float* cl = (const float*)(ws + WS_CLOC) + ((((size_t)(gp * 4 + hd) * 9 + j) * 8 + wid) * 64 + lane) * 16;
#pragma unroll
    for (int g = 0; g < 4; ++g) { const f32x4 c = *(const f32x4*)(cl + 4 * g);
      S[4 * g] = S[4 * g] * dg + c[0]; S[4 * g + 1] = S[4 * g + 1] * dg + c[1]; S[4 * g + 2] = S[4 * g + 2] * dg + c[2]; S[4 * g + 3] = S[4 * g + 3] * dg + c[3]; }
  }
  if (grp == 16) {
    if (!nsl) {
      float* Co = p.out + O_PC + (size_t)hd * 65536 + (size_t)(32 * j + r) * 256 + 32 * wid;
#pragma unroll
      for (int g = 0; g < 4; ++g) { f32x4 c = {S[4 * g], S[4 * g + 1], S[4 * g + 2], S[4 * g + 3]}; *(f32x4*)(Co + 8 * g + 4 * h) = c; }
    } else if (r == 0) {
      float* no = p.out + O_PN + (size_t)hd * 256 + 32 * wid;
#pragma unroll
      for (int g = 0; g < 4; ++g) { f32x4 c = {S[4 * g], S[4 * g + 1], S[4 * g + 2], S[4 * g + 3]}; *(f32x4*)(no + 8 * g + 4 * h) = c; }
    }
    return;
  }
  u32x4* fr = (u32x4*)lds;
  float* tp = (float*)(lds + 16384) + wid * (64 * 33);
  __syncthreads();
  fr[(wid * 2 + 0) * 64 + lane] = __builtin_bit_cast(u32x4, pack_acc(S, 0));
  fr[(wid * 2 + 1) * 64 + lane] = __builtin_bit_cast(u32x4, pack_acc(S, 1));
  __syncthreads();
  bf16x8 xf[8][2];
#pragma unroll
  for (int kt = 0; kt < 8; ++kt) { xf[kt][0] = __builtin_bit_cast(bf16x8, fr[(kt * 2 + 0) * 64 + lane]); xf[kt][1] = __builtin_bit_cast(bf16x8, fr[(kt * 2 + 1) * 64 + lane]); }
  const bf16_t* PA = (const bf16_t*)(ws + WS_R1);
  const float* WIa = (const float*)(ws + WS_WI);
#pragma unroll 1
  for (int ci = 0; ci < 2; ++ci) {
    const int cc = GRP * grp + wid + 8 * ci;
    const float D = __expf(LD[cc * 4 + hd] - LD[(GRP * grp) * 4 + hd]);
#pragma unroll
    for (int tt = 0; tt < 2; ++tt) {
      const bf16_t* qp = PA + (size_t)(cc * 64 + 32 * tt + r) * 6144 + hd * 256 + 8 * h;
      f32x16 z = zero16();
#pragma unroll
      for (int kt = 0; kt < 8; ++kt)
#pragma unroll
        for (int s2 = 0; s2 < 2; ++s2) z = MFMA32(xf[kt][s2], ld16(qp + 32 * kt + 16 * s2), z);
#pragma unroll
      for (int i = 0; i < 16; ++i) tp[(32 * tt + r) * 33 + crow(i, h)] = z[i];
    }
    const int v = lane & 31;
#pragma unroll 4
    for (int e = 0; e < 32; ++e) {
      const int t = 2 * e + (lane >> 5);
      const float val = tp[t * 33 + v] * (WIa[((size_t)cc * 4 + hd) * 64 + t] * D);
      if (!nsl) { float* d = (float*)(ws + WS_HINTER) + (size_t)(cc * 64 + t) * 1024 + hd * 256 + 32 * j + v; *d += val; }
      else if (v == 0) { float* d = (float*)(ws + WS_DENI) + (size_t)(cc * 64 + t) * 4 + hd; *d += val; }
    }
  }
}

DI void phase2c(const Params& p, unsigned char* lds) {
  unsigned* ctr = (unsigned*)(p.ws + WS_CTR) + 3 + 8 * p.pad;
  for (;;) {
    const int it = next_item(ctr, lds + LDS_BYTES - 16, TIDX);
    if (it >= 16 * 36) break;
    const int g = 16 - it / 36;
    scanfix_task(p, lds, g, (it % 36) / 9, it % 9);
  }
}

DI void phase3(const Params& p) {
  const int tid = TIDX, lane = tid & 63, wid = tid >> 6;
  unsigned char* ws = p.ws;
  const int gw = blockIdx.x * 8 + wid, nw = gridDim.x * 8;
  const bf16_t* PA = (const bf16_t*)(ws + WS_R1);
  for (int it = gw; it < TT * 4; it += nw) {
    const int tok = it >> 2, hd = it & 3, cc = tok >> 6, t = tok & 63;
    const size_t off = (size_t)tok * 1024 + hd * 256 + 4 * lane;
    const f32x4 a = *(const f32x4*)((const float*)(ws + WS_HINTER) + off), b = *(const f32x4*)((const float*)(ws + WS_HINTRA) + off);
    const float den = ((const float*)(ws + WS_DENI))[tok * 4 + hd] + ((const float*)(ws + WS_DENA))[tok * 4 + hd];
    const float mt = ((const float*)(ws + WS_MT))[((size_t)cc * 4 + hd) * 64 + t];
    const float dn = 1.f / fmaxf(fabsf(den), __expf(-mt));
    const u32x2 ou = *(const u32x2*)(PA + (size_t)tok * 6144 + 3072 + hd * 256 + 4 * lane);
    const u32x2 zu = *(const u32x2*)(PA + (size_t)tok * 6144 + 4096 + hd * 256 + 4 * lane);
    f32x4 hv = (a + b) * dn;
    hv[0] *= sigmoidf_(bflo(ou[0])); hv[1] *= sigmoidf_(bfhi(ou[0])); hv[2] *= sigmoidf_(bflo(ou[1])); hv[3] *= sigmoidf_(bfhi(ou[1]));
    float ss = hv[0] * hv[0] + hv[1] * hv[1] + hv[2] * hv[2] + hv[3] * hv[3];
    ss = wave_sum(ss);
    const float rstd = __builtin_amdgcn_rsqf(ss * (1.f / 256.f) + EPS);
    const f32x4 hg = *(const f32x4*)(p.in[I_HGA] + hd * 256 + 4 * lane);
    hv = hv * rstd * hg;
    hv[0] *= siluf_(bflo(zu[0])); hv[1] *= siluf_(bfhi(zu[0])); hv[2] *= siluf_(bflo(zu[1])); hv[3] *= siluf_(bfhi(zu[1]));
    u32x2 o = {pk2(hv[0], hv[1]), pk2(hv[2], hv[3])};
    *(u32x2*)((bf16_t*)(ws + WS_AO) + (size_t)tok * 1536 + hd * 256 + 4 * lane) = o;
  }
}

DI void phase_outproj(const Params& p, unsigned char* lds, int layer) {
  const int tid = TIDX, lane = tid & 63, wid = tid >> 6, r = lane & 31, h = lane >> 5, wr = wid >> 1, wc = wid & 1;
  unsigned char* ws = p.ws;
  const bf16_t* W = (const bf16_t*)(ws + (layer == 0 ? WS_WOA : WS_WOB));
  for (int t = blockIdx.x; t < 68 * 16; t += gridDim.x) {
    const int tm = t >> 4, tn = t & 15, m0 = tm * 256, n0 = tn * 64;
    GemmAcc acc;
    gemm_tile<1>((const bf16_t*)(ws + WS_AO) + (size_t)m0 * 1536, 1536, W + (size_t)n0 * 1536, 1536, 1536, lds, acc, tid);
#pragma unroll
    for (int a = 0; a < 2; ++a) {
      const int n = n0 + wc * 32 + r, mb = m0 + wr * 64 + 32 * a;
#pragma unroll
      for (int i = 0; i < 16; ++i) {
        const int m = mb + crow(i, h);
        if (layer == 0) {
          const float xv = m < TP ? p.in[I_XP][(size_t)m * 1024 + n] : p.in[I_XS][(size_t)(m - TP) * 1024 + n];
          ((float*)(ws + WS_Y1))[(size_t)m * 1024 + n] = xv + acc.a[a][0][i];
        } else {
          p.out[O_Y + (size_t)m * 1024 + n] = ((const float*)(ws + WS_Y1))[(size_t)m * 1024 + n] + acc.a[a][0][i];
        }
      }
    }
  }
}

DI void phase5(const Params& p, unsigned char* lds) {
  const int tid = TIDX, lane = tid & 63, wid = tid >> 6;
  unsigned char* ws = p.ws;
  const int gw = blockIdx.x * 8 + wid, nw = gridDim.x * 8;
  for (int r = gw; r < TT; r += nw) {
    f32x4 v[4];
    const float rstd = row_load_rstd((const float*)(ws + WS_Y1) + (size_t)r * 1024, v, lane);
    bf16_t* xn = (bf16_t*)(ws + WS_XN) + (size_t)r * 1024;
#pragma unroll
    for (int j = 0; j < 4; ++j) { const f32x4 xs = v[j] * rstd; u32x2 o = {pk2(xs[0], xs[1]), pk2(xs[2], xs[3])}; *(u32x2*)(xn + 4 * lane + 256 * j) = o; }
  }
  {
    float* smax = (float*)lds;
    const int hm = (tid & 127) >> 3;
    for (int b = 0; b < 16; ++b) {
      __syncthreads();
      if (tid < 16) smax[tid] = 0.f;
      __syncthreads();
      float mx = 0.f;
      const size_t n8 = (size_t)PAST * 1024 / 8;
      const float* src = p.in[I_CK] + (size_t)b * PAST * 1024;
      bf16_t* dst = (bf16_t*)(ws + WS_KBS) + (size_t)b * SKV * 1024;
      for (size_t i = (size_t)blockIdx.x * NTHREADS + tid; i < n8; i += (size_t)gridDim.x * NTHREADS) {
        const size_t e = i * 8;
        const f32x4 a = *(const f32x4*)(src + e), c = *(const f32x4*)(src + e + 4);
        u32x4 o = {pk2(a[0], a[1]), pk2(a[2], a[3]), pk2(c[0], c[1]), pk2(c[2], c[3])};
        *(u32x4*)(dst + e) = o;
        float ss = a[0] * a[0] + a[1] * a[1] + a[2] * a[2] + a[3] * a[3] + c[0] * c[0] + c[1] * c[1] + c[2] * c[2] + c[3] * c[3];
        ss += __shfl_xor(ss, 1); ss += __shfl_xor(ss, 2); ss += __shfl_xor(ss, 4);
        mx = fmaxf(mx, ss);
      }
      if ((tid & 7) == 0) atomicMax((unsigned*)smax + hm, __float_as_uint(mx));
      __syncthreads();
      if (tid < 16) atomicMax((unsigned*)(ws + WS_KMAX) + (1 + b) * 16 + tid, __float_as_uint(sqrtf(smax[tid])));
    }
  }
  __syncthreads();
  for (int t = blockIdx.x; t < 128 * 64; t += gridDim.x) {
    const int jb = t >> 6, tile = t & 63, b = jb >> 3, hd = jb & 7;
    TJob j = {p.in[I_CV] + (size_t)b * PAST * 1024 + hd * 128, 1024, (bf16_t*)(ws + WS_VTS) + ((size_t)(b * 8 + hd) * 128) * SKV, SKV, nullptr, 64, 1};
    run_tjob_tile(j, tile, (float*)lds, tid, true);
  }
}

DI void phase6(const Params& p, unsigned char* lds) {
  const int tid = TIDX, lane = tid & 63, wid = tid >> 6, r = lane & 31, h = lane >> 5, wr = wid >> 1, wc = wid & 1;
  unsigned char* ws = p.ws;
  for (int t = blockIdx.x; t < 68 * 40; t += gridDim.x) {
    const int tm = t / 40, tn = t % 40, m0 = tm * 256, n0 = tn * 128;
    GemmAcc acc;
    gemm_tile((const bf16_t*)(ws + WS_XN) + (size_t)m0 * 1024, 1024, (const bf16_t*)(ws + WS_WKB) + (size_t)n0 * 1024, 1024, 1024, lds, acc, tid);
    const int sec = n0 >> 10;
    const bool samp = m0 >= TP;
#pragma unroll
    for (int a = 0; a < 2; ++a)
#pragma unroll
      for (int b = 0; b < 2; ++b) {
        const int n = n0 + wc * 64 + 32 * b + r, mb = m0 + wr * 64 + 32 * a;
        if (sec == 0) {
          const int f = n;
          if (b == 1) {
            float mx = 0.f;
#pragma unroll
            for (int i = 0; i < 16; ++i) {
              float ss = acc.a[a][0][i] * acc.a[a][0][i] + acc.a[a][1][i] * acc.a[a][1][i];
              ss += __shfl_xor(ss, 1); ss += __shfl_xor(ss, 2); ss += __shfl_xor(ss, 4); ss += __shfl_xor(ss, 8); ss += __shfl_xor(ss, 16);
              mx = fmaxf(mx, ss);
            }
            mx = fmaxf(mx, __shfl_xor(mx, 32));
            if (lane == 0) {
              const int strm = samp ? 1 + ((mb - TP) >> 6) : 0;
              atomicMax((unsigned*)(ws + WS_KMAX) + strm * 16 + ((n0 + wc * 64) >> 6), __float_as_uint(sqrtf(mx)));
            }
          }
#pragma unroll
          for (int i = 0; i < 16; ++i) {
            const int m = mb + crow(i, h);
            const float v = acc.a[a][b][i];
            if (!samp) { p.out[O_PK + (size_t)m * 1024 + f] = v; ((bf16_t*)(ws + WS_KBP))[(size_t)m * 1024 + f] = f2bf(v); }
            else { const int ms = m - TP, bb = ms >> 6, s = ms & 63; p.out[O_SK + (size_t)ms * 1024 + f] = v;
                   ((bf16_t*)(ws + WS_KBS))[((size_t)bb * SKV + PAST + s) * 1024 + f] = f2bf(v); }
          }
        } else if (sec == 1) {
          const int f = n - 1024, hd = f >> 7, vd = f & 127;
#pragma unroll
          for (int i = 0; i < 16; ++i) {
            const int m = mb + crow(i, h);
            if (!samp) p.out[O_PV + (size_t)m * 1024 + f] = acc.a[a][b][i]; else p.out[O_SV + (size_t)(m - TP) * 1024 + f] = acc.a[a][b][i];
          }
#pragma unroll
          for (int g = 0; g < 4; ++g) {
            const int m0r = mb + 8 * g + 4 * h, pq = (m0r >> 2) & 3;
            const int m = (m0r & ~15) + 4 * (((pq & 1) << 1) | (pq >> 1));
            u32x2 o = {pk2(acc.a[a][b][4 * g], acc.a[a][b][4 * g + 1]), pk2(acc.a[a][b][4 * g + 2], acc.a[a][b][4 * g + 3])};
            if (!samp) *(u32x2*)((bf16_t*)(ws + WS_VTP) + ((size_t)hd * 128 + vd) * TP + m) = o;
            else { const int ms = m - TP, bb = ms >> 6, s = ms & 63; *(u32x2*)((bf16_t*)(ws + WS_VTS) + ((size_t)(bb * 8 + hd) * 128 + vd) * SKV + PAST + s) = o; }
          }
        } else {
          const float sc = sec == 2 ? 0.125f * LOG2E : 1.f;
          bf16_t* PB = (bf16_t*)(ws + WS_PB);
#pragma unroll
          for (int i = 0; i < 16; ++i) PB[(size_t)(mb + crow(i, h)) * 3072 + (n - 2048)] = f2bf(acc.a[a][b][i] * sc);
        }
      }
  }
}

constexpr int A_BUF = 32768, A_KB = 16384, A_FLAGS = 3 * A_BUF;

DI void diffattn_task(const Params& p, unsigned char* lds, int sb  , int qt  , int hd, float lam) {
  const int tid = TIDX, lane = tid & 63, wid = __builtin_amdgcn_readfirstlane(tid >> 6), r = lane & 31, h = lane >> 5;
  unsigned char* ws = p.ws;
  const int cq = wid >> 2, sub = (wid >> 1) & 1, map = wid & 1;
  const int ncq = sb < 0 ? 2 : 1;
  const int base_chunk = sb < 0 ? 2 * qt : 64;
  const int tok0 = sb < 0 ? qt * 128 : TP + sb * 64;
  const bool wvalid = cq < ncq;
  const int qc = base_chunk + cq;
  const int tl = 32 * sub + r;
  const int tok = tok0 + 64 * (wvalid ? cq : 0) + tl;
  const bf16_t* Kb = sb < 0 ? (const bf16_t*)(ws + WS_KBP) + hd * 128 : (const bf16_t*)(ws + WS_KBS) + (size_t)sb * SKV * 1024 + hd * 128;
  const bf16_t* Vb = sb < 0 ? (const bf16_t*)(ws + WS_VTP) + (size_t)hd * 128 * TP : (const bf16_t*)(ws + WS_VTS) + (size_t)(sb * 8 + hd) * 128 * SKV;
  const unsigned ldv = sb < 0 ? TP : SKV;
  const bf16_t* PB = (const bf16_t*)(ws + WS_PB);
  bf16x8 qf[4];
  float qn = 0.f;
  {
    const unsigned qo = (unsigned)tok * 3072u + hd * 128 + map * 64 + 8 * h;
#pragma unroll
    for (int kk = 0; kk < 4; ++kk) {
      const u32x4 u = *(const u32x4*)(PB + (qo + 16 * kk));
      qf[kk] = __builtin_bit_cast(bf16x8, u);
#pragma unroll
      for (int e = 0; e < 4; ++e) { const float a = bflo(u[e]), b = bfhi(u[e]); qn += a * a + b * b; }
    }
    qn += __shfl_xor(qn, 32);
    qn = sqrtf(qn);
  }
  const float kmax = ((const float*)(ws + WS_KMAX))[(sb < 0 ? 0 : 1 + sb) * 16 + hd * 2 + map];
  const float shift = qn * kmax * 1.02f + 0.5f - 40.f;
  const float sl2 = exp2f(-(float)(hd + 1)) * LOG2E;
  const int wd = diff_window(hd);
  const float bh0 = sl2 * (float)(4 * h) - sl2 * (float)tl - shift, bh1 = bh0 + 32.f * sl2;
  float cs[16];
#pragma unroll
  for (int i = 0; i < 16; ++i) cs[i] = __uint_as_float(__builtin_amdgcn_readfirstlane(__float_as_uint(sl2 * (float)((i & 3) + 8 * (i >> 2)))));
  f32x16 O[4];
#pragma unroll
  for (int vt = 0; vt < 4; ++vt) O[vt] = zero16();
  float l = 0.f;
  const int jmax = base_chunk + ncq - 1;
  const int jmin = max(0, base_chunk - wd);
  const int nit = jmax - jmin + 1;
  unsigned kofs[2], vofs[2];
#pragma unroll
  for (int e = 0; e < 2; ++e) {
    const int q = wid * 2 + e;
    { const int row = 4 * q + (lane >> 4), lc = (lane & 15) ^ (row & 15); kofs[e] = (unsigned)row * 1024u + 8u * lc; }
    { const int row = 8 * q + (lane >> 3), lc = (lane & 7) ^ ((row >> 1) & 7); vofs[e] = (unsigned)row * ldv + 8u * lc; }
  }
  auto issue = [&](int j, int buf) {
    const bf16_t* kj = Kb + (size_t)j * 65536;
    const bf16_t* vj = Vb + (size_t)j * 64;
    unsigned char* base = lds + buf * A_BUF;
#pragma unroll
    for (int e = 0; e < 2; ++e) {
      dma16(kj + kofs[e], base + (wid * 2 + e) * 1024);
      dma16(vj + vofs[e], base + A_KB + (wid * 2 + e) * 1024);
    }
  };
  unsigned kco[4], vco[4];
#pragma unroll
  for (int kk = 0; kk < 4; ++kk) kco[kk] = (unsigned)r * 256u + ((((unsigned)(8 * map + 2 * kk + h)) ^ (unsigned)(r & 15)) << 4);
#pragma unroll
  for (int sx = 0; sx < 4; ++sx) vco[sx] = A_KB + (unsigned)r * 128u + ((((unsigned)(2 * sx + h)) ^ (unsigned)((r >> 1) & 7)) << 4);
  asm volatile("s_waitcnt vmcnt(0)" ::: "memory");
  __syncthreads();
  issue(jmax, 0);
  if (nit > 1) issue(jmax - 1, 1);
  for (int it = 0; it < nit; ++it) {
    const int j = jmax - it;
    if (it + 1 < nit) asm volatile("s_waitcnt vmcnt(4)" ::: "memory"); else asm volatile("s_waitcnt vmcnt(0)" ::: "memory");
    asm volatile("s_waitcnt lgkmcnt(0)" ::: "memory");
    __builtin_amdgcn_s_barrier();
    if (it + 2 < nit) issue(j - 2, (it + 2) % 3);
    if (wvalid && j <= qc && qc - j <= wd) {
      const unsigned char* base = lds + (it % 3) * A_BUF;
      f32x16 s0, s1;
      {
        const float dofs = sl2 * (float)((qc - j) * 64);
        float b0 = bh0 - dofs, b1 = bh1 - dofs;
        asm volatile("" : "+v"(b0), "+v"(b1));
#pragma unroll
        for (int i = 0; i < 16; ++i) { s0[i] = b0 + cs[i]; s1[i] = b1 + cs[i]; }
      }
      if (j == qc) {
        int tlv = tl;
        asm volatile("" : "+v"(tlv));
        const float m2 = -2.f * sl2, xt = (float)(4 * h - tlv);
#pragma unroll
        for (int i = 0; i < 16; ++i) {
          const float c = (float)((i & 3) + 8 * (i >> 2));
          s0[i] = fmaf(m2, fmaxf(xt + c, 0.f), s0[i]); s1[i] = fmaf(m2, fmaxf(xt + (c + 32.f), 0.f), s1[i]);
        }
      }
#pragma unroll
      for (int kk = 0; kk < 4; ++kk) s0 = MFMA32(ld16(base + kco[kk]), qf[kk], s0);
#pragma unroll
      for (int kk = 0; kk < 4; ++kk) s1 = MFMA32(ld16(base + 8192 + kco[kk]), qf[kk], s1);
      float sum0 = 0.f, sum1 = 0.f;
#pragma unroll
      for (int i = 0; i < 16; ++i) { s0[i] = fexp2(s0[i]); sum0 += s0[i]; }
      const bf16x8 p00 = pack_acc(s0, 0), p01 = pack_acc(s0, 1);
#pragma unroll
      for (int vt = 0; vt < 4; ++vt) { O[vt] = MFMA32(ld16(base + 4096 * vt + vco[0]), p00, O[vt]); O[vt] = MFMA32(ld16(base + 4096 * vt + vco[1]), p01, O[vt]); }
#pragma unroll
      for (int i = 0; i < 16; ++i) { s1[i] = fexp2(s1[i]); sum1 += s1[i]; }
      const bf16x8 p10 = pack_acc(s1, 0), p11 = pack_acc(s1, 1);
#pragma unroll
      for (int vt = 0; vt < 4; ++vt) { O[vt] = MFMA32(ld16(base + 4096 * vt + vco[2]), p10, O[vt]); O[vt] = MFMA32(ld16(base + 4096 * vt + vco[3]), p11, O[vt]); }
      l += sum0 + sum1;
      __builtin_amdgcn_sched_group_barrier(0x100, 2, 0);
#pragma unroll
      for (int g = 0; g < 4; ++g) { __builtin_amdgcn_sched_group_barrier(0x008, 1, 0); __builtin_amdgcn_sched_group_barrier(0x100, 1, 0); }
#pragma unroll
      for (int g = 0; g < 4; ++g) { __builtin_amdgcn_sched_group_barrier(0x008, 1, 0); __builtin_amdgcn_sched_group_barrier(0x100, 1, 0); __builtin_amdgcn_sched_group_barrier(0x002, 10, 0); }
#pragma unroll
      for (int g = 0; g < 8; ++g) { __builtin_amdgcn_sched_group_barrier(0x008, 1, 0); __builtin_amdgcn_sched_group_barrier(0x100, 1, 0); __builtin_amdgcn_sched_group_barrier(0x002, 5, 0); }
#pragma unroll
      for (int g = 0; g < 6; ++g) { __builtin_amdgcn_sched_group_barrier(0x008, 1, 0); __builtin_amdgcn_sched_group_barrier(0x100, 1, 0); }
      __builtin_amdgcn_sched_group_barrier(0x008, 2, 0);
    }
  }
  asm volatile("s_waitcnt vmcnt(0)" ::: "memory");
  __syncthreads();
  l += __shfl_xor(l, 32);
  const float inv = wvalid ? 1.f / l : 0.f;
  float* xch = (float*)lds + (size_t)(wid >> 1) * 4096;
  if (map == 1 && wvalid) {
    const float sc = inv * lam;
#pragma unroll
    for (int vt = 0; vt < 4; ++vt)
#pragma unroll
      for (int i = 0; i < 16; ++i) xch[(vt * 16 + i) * 64 + lane] = O[vt][i] * sc;
  }
  __syncthreads();
  if (map == 0 && wvalid) {
    float ss = 0.f;
#pragma unroll
    for (int vt = 0; vt < 4; ++vt)
#pragma unroll
      for (int i = 0; i < 16; ++i) { const float o = O[vt][i] * inv - xch[(vt * 16 + i) * 64 + lane]; O[vt][i] = o; ss += o * o; }
    ss += __shfl_xor(ss, 32);
    const float lam_init = 0.8f - 0.6f * 0.7408182206817179f;
    const float rs = __builtin_amdgcn_rsqf(ss * (1.f / 128.f) + EPS) * (1.f - lam_init);
    const unsigned zo = (unsigned)tok * 3072u + 1024 + hd * 128, oo = (unsigned)tok * 1536u + hd * 128;
    bf16_t* AOp = (bf16_t*)(ws + WS_AO);
    const float* sg = p.in[I_SUBG];
#pragma unroll
    for (int vt = 0; vt < 4; ++vt)
#pragma unroll
      for (int g = 0; g < 4; ++g) {
        const int v = 32 * vt + 8 * g + 4 * h;
        const u32x2 z = *(const u32x2*)(PB + (zo + v));
        const f32x4 gg = *(const f32x4*)(sg + v);
        const float o0 = O[vt][4 * g] * rs * gg[0] * siluf_(bflo(z[0])), o1 = O[vt][4 * g + 1] * rs * gg[1] * siluf_(bfhi(z[0]));
        const float o2 = O[vt][4 * g + 2] * rs * gg[2] * siluf_(bflo(z[1])), o3 = O[vt][4 * g + 3] * rs * gg[3] * siluf_(bfhi(z[1]));
        u32x2 o = {pk2(o0, o1), pk2(o2, o3)};
        *(u32x2*)(AOp + (oo + v)) = o;
      }
  }
  __syncthreads();
}

DI void phase7(const Params& p, unsigned char* lds) {
  unsigned* ctr = (unsigned*)(p.ws + WS_CTR) + 1 + 8 * p.pad;
  const bf16_t* PB = (const bf16_t*)(p.ws + WS_PB);
  float lam;
  {
    const int lane = TIDX & 63;
    const float* lv = p.in[I_LAMB];
    const float a = wave_sum(lv[lane] * lv[64 + lane]), b = wave_sum(lv[128 + lane] * lv[192 + lane]);
    const float lam_init = 0.8f - 0.6f * 0.7408182206817179f;
    lam = __expf(a) - __expf(b) + lam_init;
  }
  const int n_s = 128, n_p = 1024, n_ma = 256 + 64;
  const int* tord = (const int*)(p.ws + WS_TORD);
  for (;;) {
    const int it = next_item(ctr, lds + LDS_BYTES - 16, TIDX);
    if (it >= n_s + n_p) break;
    const int a = tord[it];
    const bool pr = a < n_p;
    diffattn_task(p, lds, pr ? -1 : ((a - n_p) >> 3), pr ? (a >> 3) : 0, a & 7, lam);
  }
  for (;;) {
    const int it = next_item(ctr + 1, lds + LDS_BYTES - 16, TIDX);
    if (it >= n_ma) break;
    memattn_task(p, lds, it, 1, PB + 2048, PB + 2560, 3072);
  }
}

DI void phase9(const Params& p) {
  const int tid = TIDX, lane = tid & 63, wid = tid >> 6;
  const int gw = blockIdx.x * 8 + wid, nw = gridDim.x * 8;
  for (int r = gw; r < TT; r += nw) {
    f32x4 v[4];
    float* row = p.out + O_Y + (size_t)r * 1024;
    const float rstd = row_load_rstd(row, v, lane);
#pragma unroll
    for (int j = 0; j < 4; ++j) {
      const f32x4 g = *(const f32x4*)(p.in[I_FNG] + 4 * lane + 256 * j);
      *(f32x4*)(row + 4 * lane + 256 * j) = v[j] * rstd * g;
    }
  }
}

DI void grid_barrier(unsigned* bar, unsigned target, int tid) {
  asm volatile("s_waitcnt vmcnt(0)" ::: "memory");
  __syncthreads();
  if (tid == 0) {
    __builtin_amdgcn_fence(__ATOMIC_RELEASE, "agent");
    asm volatile("s_waitcnt vmcnt(0)" ::: "memory");
    __hip_atomic_fetch_add(bar, 1u, __ATOMIC_RELAXED, __HIP_MEMORY_SCOPE_AGENT);
    while (__hip_atomic_load(bar, __ATOMIC_RELAXED, __HIP_MEMORY_SCOPE_AGENT) < target) __builtin_amdgcn_s_sleep(1);
    __builtin_amdgcn_fence(__ATOMIC_ACQUIRE, "agent");
    asm volatile("s_waitcnt vmcnt(0)" ::: "memory");
  }
  __syncthreads();
}

__global__ __launch_bounds__(512) void mk(Params pin) {
  extern __shared__ __attribute__((aligned(16))) unsigned char lds[];
  Params p = pin;
  p.wv = __builtin_amdgcn_readfirstlane((int)(__builtin_amdgcn_workitem_id_x() >> 6));
  cg::grid_group grid = cg::this_grid();
  unsigned nbar = 0;
  unsigned* bar = (unsigned*)(p.ws + WS_CTR) + 32;
#define RUN_PHASE(PH, CALL) if (p.ph_lo <= PH && PH < p.ph_hi) { CALL; if (PH + 1 < p.ph_hi) { ++nbar; grid_barrier(bar, nbar * gridDim.x, TIDX); } }
  if (p.ph_lo <= 0 && 0 < p.ph_hi) { phase0(p, lds); if (1 < p.ph_hi) grid.sync(); }
  RUN_PHASE(1, phase1(p, lds))
  RUN_PHASE(2, phase2(p, lds))
  if (p.ph_lo <= 2 && 2 < p.ph_hi) { phase2c(p, lds); ++nbar; grid_barrier(bar, nbar * gridDim.x, TIDX); }
  RUN_PHASE(3, phase3(p))
  RUN_PHASE(4, phase_outproj(p, lds, 0))
  RUN_PHASE(5, phase5(p, lds))
  RUN_PHASE(6, phase6(p, lds))
  RUN_PHASE(7, phase7(p, lds))
  RUN_PHASE(8, phase_outproj(p, lds, 1))
  RUN_PHASE(9, phase9(p))
}

extern "C" void kernel_launch(void* const* d_in, const int* in_sizes, int n_in, void* d_out, int out_size,
                              void* d_ws, size_t ws_size, hipStream_t stream) {
  static int grid_blocks = 0;
  if (!grid_blocks) {
    int dev = 0, cus = 0, per_cu = 0;
    (void)hipGetDevice(&dev);
    (void)hipDeviceGetAttribute(&cus, hipDeviceAttributeMultiprocessorCount, dev);
    (void)hipFuncSetAttribute((const void*)mk, hipFuncAttributeMaxDynamicSharedMemorySize, LDS_BYTES);
    (void)hipOccupancyMaxActiveBlocksPerMultiprocessor(&per_cu, (const void*)mk, NTHREADS, LDS_BYTES);
    grid_blocks = cus;
    fprintf(stderr, "kernel_launch: cus=%d per_cu=%d grid=%d ws=%zu need=%zu\n", cus, per_cu, grid_blocks, ws_size, (size_t)WS_END);
  }
  if (ws_size < WS_END) { fprintf(stderr, "workspace too small\n"); return; }
  Params p{};
  for (int i = 0; i < 24; ++i) p.in[i] = (const float*)d_in[i];
  p.out = (float*)d_out; p.ws = (unsigned char*)d_ws; p.ph_lo = 0; p.ph_hi = NPHASE;
  void* args[] = {&p};
  hipError_t e = hipLaunchCooperativeKernel((const void*)mk, dim3(grid_blocks), dim3(NTHREADS), args, LDS_BYTES, stream);
  if (e != hipSuccess) fprintf(stderr, "cooperative launch failed: %s (grid %d)\n", hipGetErrorString(e), grid_blocks);
  if (PROBE_REP >= 0) {
    Params q = p;
    q.out = (float*)((unsigned char*)d_ws + WS_END); q.ph_lo = PROBE_REP; q.ph_hi = PROBE_REP + 1; q.pad = 1;
    void* args2[] = {&q};
    (void)hipLaunchCooperativeKernel((const void*)mk, dim3(grid_blocks), dim3(NTHREADS), args2, LDS_BYTES, stream);
  }
}
```

```cpp
#include <hip/hip_runtime.h>
#include <hip/hip_cooperative_groups.h>
#include <cstdio>
#include <cstdint>
namespace cg = cooperative_groups;

typedef unsigned short bf16_t;
typedef short bf16x8 __attribute__((ext_vector_type(8)));
typedef short s16x4 __attribute__((ext_vector_type(4)));
typedef float f32x16 __attribute__((ext_vector_type(16)));
typedef float f32x4 __attribute__((ext_vector_type(4)));
typedef float f32x2 __attribute__((ext_vector_type(2)));
typedef __bf16 bf2_t __attribute__((ext_vector_type(2)));
typedef unsigned u32x4 __attribute__((ext_vector_type(4)));
typedef unsigned u32x2 __attribute__((ext_vector_type(2)));
#define DI __device__ __forceinline__
#define MFMA32(a, b, c) __builtin_amdgcn_mfma_f32_32x32x16_bf16((a), (b), (c), 0, 0, 0)

struct Params { const float* in[24]; float* out; unsigned char* ws; int ph_lo, ph_hi; int wv, pad; };
#define TIDX (p.wv * 64 + (int)__builtin_amdgcn_mbcnt_hi(~0u, __builtin_amdgcn_mbcnt_lo(~0u, 0u)))
constexpr int LDS_BYTES = 148480;
constexpr int NTHREADS = 512;
constexpr int NPHASE = 10;
#ifndef PROBE_REP
#define PROBE_REP -1
#endif

constexpr int TP = 16384, TS = 1024, TT = 17408, DM = 1024;
constexpr int NCH = 272;
constexpr int PAST = 4096, SKV = 4160;
constexpr float EPS = 1e-6f;
constexpr float LOG2E = 1.4426950408889634f;
enum { I_XP = 0, I_XS, I_CK, I_CV, I_CMK, I_CMV, I_SC, I_SN, I_SM, I_MEMP, I_NG, I_FNG, I_MNG, I_WMKV, I_WINA, I_BGA, I_HGA, I_WOA,
       I_KVNG, I_WKV, I_WINB, I_LAMB, I_SUBG, I_WOB };
constexpr size_t O_Y = 0, O_PC = 17825792, O_PN = 18087936, O_PM = 18088960, O_PK = 18088964, O_PV = 34866180, O_PMK = 51643396,
                 O_PMV = 51905540, O_SC = 52167684, O_SN = 56361988, O_SM = 56378372, O_SK = 56378436, O_SV = 57427012;
constexpr size_t WS_CTR = 0;
constexpr size_t WS_KMAX = 1024;
constexpr size_t WS_TORD = 8192;
constexpr size_t WS_WA = 16384;
constexpr size_t WS_WOA = WS_WA + (size_t)6144 * 1024 * 2;
constexpr size_t WS_WKB = WS_WOA + (size_t)1024 * 1536 * 2;
constexpr size_t WS_WOB = WS_WKB + (size_t)5120 * 1024 * 2;
constexpr size_t WS_WM = WS_WOB + (size_t)1024 * 1536 * 2;
constexpr size_t WS_MEMN = WS_WM + (size_t)2 * 1024 * 1024 * 2;
constexpr size_t WS_MEMK = WS_MEMN + (size_t)2 * 256 * 1024 * 2;
constexpr size_t WS_MEMVT = WS_MEMK + (size_t)2 * 17 * 256 * 512 * 2;
constexpr size_t WS_GATE = WS_MEMVT + (size_t)2 * 17 * 256 * 512 * 2;
constexpr size_t SZ_CH = (size_t)NCH * 4 * 64 * 4;
constexpr size_t WS_GC = WS_GATE + (size_t)TT * 8 * 4;
constexpr size_t WS_MT = WS_GC + SZ_CH;
constexpr size_t WS_WS = WS_MT + SZ_CH;
constexpr size_t WS_WI = WS_WS + SZ_CH;
constexpr size_t WS_AS = WS_WI + SZ_CH;
constexpr size_t WS_BT = WS_AS + SZ_CH;
constexpr size_t WS_DEC = WS_BT + SZ_CH;
constexpr size_t WS_DENI = WS_DEC + 8192;
constexpr size_t WS_DENA = WS_DENI + (size_t)TT * 4 * 4;
constexpr size_t WS_XN = WS_DENA + (size_t)TT * 4 * 4;
constexpr size_t WS_AO = WS_XN + (size_t)TT * 1024 * 2;
constexpr size_t WS_Y1 = WS_AO + (size_t)TT * 1536 * 2;
constexpr size_t WS_KT = WS_Y1 + (size_t)TT * 1024 * 4;
constexpr size_t WS_VTA = WS_KT + (size_t)NCH * 4 * 256 * 64 * 2;
constexpr size_t WS_R1 = WS_VTA + (size_t)NCH * 4 * 256 * 64 * 2;
constexpr size_t SZ_R1 = (size_t)TT * 6144 * 2;
constexpr size_t WS_PB = WS_R1;
constexpr size_t WS_KBP = WS_PB + (size_t)TT * 3072 * 2;
constexpr size_t WS_VTP = WS_KBP + (size_t)TP * 1024 * 2;
constexpr size_t WS_R2 = WS_R1 + SZ_R1;
constexpr size_t WS_HINTER = WS_R2;
constexpr size_t WS_HINTRA = WS_R2 + (size_t)TT * 1024 * 4;
constexpr size_t WS_KBS = WS_R2;
constexpr size_t WS_VTS = WS_KBS + (size_t)16 * SKV * 1024 * 2;
constexpr size_t WS_HINTER2 = WS_VTS + (size_t)16 * SKV * 1024 * 2;
constexpr size_t WS_DENI2 = WS_HINTER2 + (size_t)TP * 1024 * 4;
constexpr size_t WS_PM = WS_DENI2 + (size_t)TP * 4 * 4;
constexpr size_t WS_CHS = WS_PM + SZ_CH;
constexpr size_t WS_LD = WS_CHS + 16384;
constexpr size_t WS_CLOC = WS_LD + 8192;
constexpr size_t WS_END = WS_CLOC + (size_t)16 * 36 * 8 * 64 * 16 * 4;
constexpr int GRP = 16;
static_assert(WS_VTP + (size_t)TP * 1024 * 2 <= WS_R2, "R1 overflow");

DI unsigned pk2(float lo, float hi) { f32x2 v = {lo, hi}; return __builtin_bit_cast(unsigned, __builtin_convertvector(v, bf2_t)); }
DI bf16_t f2bf(float x) { return (bf16_t)(pk2(x, 0.f) & 0xffffu); }
DI float bf2f(unsigned v16) { return __uint_as_float(v16 << 16); }
DI float bflo(unsigned u) { return __uint_as_float(u << 16); }
DI float bfhi(unsigned u) { return __uint_as_float(u & 0xffff0000u); }
DI float rbf(float x) { return bflo(pk2(x, 0.f) & 0xffffu); }
DI int crow(int i, int h) { return (i & 3) + 8 * (i >> 2) + 4 * h; }
DI float wave_sum(float v) {
#pragma unroll
  for (int o = 32; o >= 1; o >>= 1) v += __shfl_xor(v, o);
  return v;
}
DI float fexp2(float x) { return __builtin_amdgcn_exp2f(x); }
DI float fexp(float x) { return __builtin_amdgcn_exp2f(x * LOG2E); }
DI float sigmoidf_(float x) { return 1.f / (1.f + __expf(-x)); }
DI float siluf_(float x) { return x / (1.f + __expf(-x)); }
DI bf16x8 pack_acc(const f32x16& x, int s) {
  u32x4 p;
  p[0] = pk2(x[8 * s + 0], x[8 * s + 1]); p[1] = pk2(x[8 * s + 2], x[8 * s + 3]);
  p[2] = pk2(x[8 * s + 4], x[8 * s + 5]); p[3] = pk2(x[8 * s + 6], x[8 * s + 7]);
  return __builtin_bit_cast(bf16x8, p);
}
DI bf16x8 ld16(const void* p) { return *(const bf16x8*)p; }
DI bf16x8 ld8x2(const void* p0, const void* p1) {
  u32x2 a = *(const u32x2*)p0, b = *(const u32x2*)p1; u32x4 r = {a[0], a[1], b[0], b[1]};
  return __builtin_bit_cast(bf16x8, r);
}
DI f32x16 zero16() { f32x16 z; for (int i = 0; i < 16; ++i) z[i] = 0.f; return z; }

DI void transpose_tile(const float* __restrict__ src, size_t ld_s, bf16_t* __restrict__ dst, size_t ld_d, const float* __restrict__ scale,
                       float* scr, int t, bool perm = false) {
  {
    const int c4 = t & 31, rb = t >> 5;
    f32x4 v[4];
#pragma unroll
    for (int i = 0; i < 4; ++i) v[i] = *(const f32x4*)(src + (size_t)(rb + 16 * i) * ld_s + 4 * c4);
#pragma unroll
    for (int i = 0; i < 4; ++i) {
      const int r = rb + 16 * i;
      f32x4 x = v[i];
      if (scale) { const float sc = scale[r]; x = x * sc; }
      float* d = scr + r * 129 + 4 * c4; d[0] = x[0]; d[1] = x[1]; d[2] = x[2]; d[3] = x[3];
    }
  }
  __syncthreads();
#pragma unroll
  for (int i = 0; i < 2; ++i) {
    const int id = t + 512 * i, c = id >> 3, rg = id & 7;
    const float* s = scr + (8 * rg) * 129 + c;
    u32x4 o; o[0] = pk2(s[0], s[129]); o[1] = pk2(s[2 * 129], s[3 * 129]); o[2] = pk2(s[4 * 129], s[5 * 129]); o[3] = pk2(s[6 * 129], s[7 * 129]);
    if (!perm) *(u32x4*)(dst + (size_t)c * ld_d + 8 * rg) = o;
    else {
      bf16_t* d = dst + (size_t)c * ld_d + 16 * (rg >> 1) + 4 * (rg & 1);
      u32x2 lo = {o[0], o[1]}, hi = {o[2], o[3]};
      *(u32x2*)d = lo; *(u32x2*)(d + 8) = hi;
    }
  }
  __syncthreads();
}

struct TJob { const float* src; size_t ld_s; bf16_t* dst; size_t ld_d; const float* scale; int tr, tc; };

DI void run_tjob_tile(const TJob& j, int tile, float* scr, int tid, bool perm = false) {
  const int ir = tile / j.tc, ic = tile % j.tc;
  transpose_tile(j.src + (size_t)(64 * ir) * j.ld_s + 128 * ic, j.ld_s, j.dst + (size_t)(128 * ic) * j.ld_d + 64 * ir, j.ld_d,
                 j.scale ? j.scale + 64 * ir : nullptr, scr, tid, perm);
}

DI float row_load_rstd(const float* xrow, f32x4 (&v)[4], int lane) {
  float ss = 0.f;
#pragma unroll
  for (int j = 0; j < 4; ++j) { v[j] = *(const f32x4*)(xrow + 4 * lane + 256 * j); ss += v[j][0] * v[j][0] + v[j][1] * v[j][1] + v[j][2] * v[j][2] + v[j][3] * v[j][3]; }
  ss = wave_sum(ss);
  return __builtin_amdgcn_rsqf(ss * (1.f / 1024.f) + EPS);
}

DI int diff_window(int hd) { const float sl2 = exp2f(-(float)(hd + 1)) * LOG2E; return (int)floorf((63.f + 192.f / sl2) * (1.f / 64.f)); }
DI int diff_est(int a) {
  const int hd = a & 7;
  const int w = diff_window(hd) + (a < 1024 ? 2 : 1);
  const int n = a < 1024 ? 2 * (a >> 3) + 2 : 65;
  return n < w ? n : w;
}

DI void phase0(const Params& p, unsigned char* lds) {
  const int tid = TIDX, lane = tid & 63, wid = tid >> 6;
  unsigned char* ws = p.ws;
  if (blockIdx.x == 0 && tid < 64) ((unsigned*)(ws + WS_CTR))[tid] = 0u;
  if (blockIdx.x == 0 && tid < 272) ((unsigned*)(ws + WS_KMAX))[tid] = 0u;
  if (blockIdx.x == 1) {
    int* est = (int*)lds;
    for (int a = tid; a < 1152; a += NTHREADS) est[a] = diff_est(a);
    __syncthreads();
    for (int a = tid; a < 1152; a += NTHREADS) {
      const int ea = est[a];
      int rank = 0;
      for (int b = 0; b < 1152; ++b) { const int eb = est[b]; rank += (eb > ea) || (eb == ea && b < a); }
      ((int*)(ws + WS_TORD))[rank] = a;
    }
    __syncthreads();
  }
  {
    TJob jobs[8];
    jobs[0] = {p.in[I_WINA], 6152, (bf16_t*)(ws + WS_WA), 1024, p.in[I_NG], 16, 40};
    jobs[1] = {p.in[I_WINA] + 5128, 6152, (bf16_t*)(ws + WS_WA) + (size_t)5120 * 1024, 1024, p.in[I_NG], 16, 8};
    jobs[2] = {p.in[I_WOA], 1024, (bf16_t*)(ws + WS_WOA), 1536, nullptr, 24, 8};
    jobs[3] = {p.in[I_WKV], 2048, (bf16_t*)(ws + WS_WKB), 1024, p.in[I_KVNG], 16, 16};
    jobs[4] = {p.in[I_WINB], 3072, (bf16_t*)(ws + WS_WKB) + (size_t)2048 * 1024, 1024, p.in[I_NG] + 1024, 16, 24};
    jobs[5] = {p.in[I_WOB], 1024, (bf16_t*)(ws + WS_WOB), 1536, nullptr, 24, 8};
    jobs[6] = {p.in[I_WMKV], 1024, (bf16_t*)(ws + WS_WM), 1024, nullptr, 16, 8};
    jobs[7] = {p.in[I_WMKV] + (size_t)1024 * 1024, 1024, (bf16_t*)(ws + WS_WM) + (size_t)1024 * 1024, 1024, nullptr, 16, 8};
    int base = 0;
#pragma unroll
    for (int j = 0; j < 8; ++j) {
      const int n = jobs[j].tr * jobs[j].tc;
      for (int t = blockIdx.x; t < n; t += gridDim.x) run_tjob_tile(jobs[j], t, (float*)lds, tid);
      base += n;
    }
    for (int t = blockIdx.x; t < 128 * 4; t += gridDim.x) {
      const int jb = t >> 2, tile = t & 3, l = jb >> 6, b = (jb >> 2) & 15, h = jb & 3;
      TJob j = {p.in[I_CMV] + ((size_t)(l * 16 + b) * 256) * 512 + h * 128, 512,
                (bf16_t*)(ws + WS_MEMVT) + ((size_t)(l * 17 + 1 + b) * 4 + h) * 128 * 256, 256, nullptr, 4, 1};
      run_tjob_tile(j, tile, (float*)lds, tid, true);
    }
  }
  {
    const size_t n8 = (size_t)2 * 16 * 256 * 512 / 8;
    for (size_t i = (size_t)blockIdx.x * NTHREADS + tid; i < n8; i += (size_t)gridDim.x * NTHREADS) {
      const size_t e = i * 8; const int l = (int)(e / ((size_t)16 * 131072)); const size_t rem = e - (size_t)l * 16 * 131072;
      const f32x4 a = *(const f32x4*)(p.in[I_CMK] + e), b = *(const f32x4*)(p.in[I_CMK] + e + 4);
      u32x4 o = {pk2(a[0], a[1]), pk2(a[2], a[3]), pk2(b[0], b[1]), pk2(b[2], b[3])};
      *(u32x4*)((bf16_t*)(ws + WS_MEMK) + ((size_t)(l * 17 + 1) * 131072) + rem) = o;
    }
  }
  {
    const int gw = blockIdx.x * 8 + wid, nw = gridDim.x * 8;
    const float* ng = p.in[I_NG];
    float* gwt = (float*)(lds + 32768);
    float* sg = (float*)(lds + 65536);
    __syncthreads();
    for (int i = tid; i < 8192; i += NTHREADS) { const int k = i >> 3, c = i & 7; gwt[i] = p.in[I_WINA][(size_t)k * 6152 + 5120 + c] * ng[k]; }
    __syncthreads();
    for (int cc = blockIdx.x; cc < NCH; cc += gridDim.x) {
      for (int ri = 0; ri < 8; ++ri) {
        const int r = cc * 64 + wid * 8 + ri;
        const float* xrow = r < TP ? p.in[I_XP] + (size_t)r * 1024 : p.in[I_XS] + (size_t)(r - TP) * 1024;
        f32x4 v[4];
        const float rstd = row_load_rstd(xrow, v, lane);
        float gacc[8];
#pragma unroll
        for (int c = 0; c < 8; ++c) gacc[c] = 0.f;
        bf16_t* xn = (bf16_t*)(ws + WS_XN) + (size_t)r * 1024;
#pragma unroll
        for (int j = 0; j < 4; ++j) {
          const int k0 = 4 * lane + 256 * j;
          const f32x4 xs = v[j] * rstd;
          u32x2 o = {pk2(xs[0], xs[1]), pk2(xs[2], xs[3])};
          *(u32x2*)(xn + k0) = o;
#pragma unroll
          for (int e = 0; e < 4; ++e) {
            const float* wr = gwt + (k0 + e) * 8;
            const f32x4 w0 = *(const f32x4*)wr, w1 = *(const f32x4*)(wr + 4);
            gacc[0] += xs[e] * w0[0]; gacc[1] += xs[e] * w0[1]; gacc[2] += xs[e] * w0[2]; gacc[3] += xs[e] * w0[3];
            gacc[4] += xs[e] * w1[0]; gacc[5] += xs[e] * w1[1]; gacc[6] += xs[e] * w1[2]; gacc[7] += xs[e] * w1[3];
          }
        }
#pragma unroll
        for (int c = 0; c < 8; ++c) gacc[c] = wave_sum(gacc[c]);
        if (lane < 8) {
          float gv = gacc[0];
#pragma unroll
          for (int c = 1; c < 8; ++c) gv = lane == c ? gacc[c] : gv;
          gv += p.in[I_BGA][lane];
          if (lane >= 4) gv = fminf(gv, 0.f) - log1pf(__expf(-fabsf(gv)));
          sg[(wid * 8 + ri) * 8 + lane] = gv;
        }
      }
      __syncthreads();
      if (wid < 4) {
        const int hd = wid, pr = cc * 4 + hd;
        const float ig = sg[lane * 8 + hd], lf = sg[lane * 8 + 4 + hd];
        float g = lf;
#pragma unroll
        for (int o = 1; o < 64; o <<= 1) { const float t = __shfl_up(g, o); if (lane >= o) g += t; }
        const float a = ig - g;
        float pm = a;
#pragma unroll
        for (int o = 1; o < 64; o <<= 1) { const float t = __shfl_up(pm, o); if (lane >= o) pm = fmaxf(pm, t); }
        const size_t o = (size_t)pr * 64 + lane;
        ((float*)(ws + WS_GC))[o] = g;
        ((float*)(ws + WS_AS))[o] = a;
        ((float*)(ws + WS_PM))[o] = pm;
        if (lane == 63) { ((float*)(ws + WS_CHS))[pr * 2] = g; ((float*)(ws + WS_CHS))[pr * 2 + 1] = pm; }
      }
      __syncthreads();
    }
    for (int r = gw; r < 512; r += nw) {
      const int l = r >> 8, rr = r & 255;
      f32x4 v[4];
      const float rstd = row_load_rstd(p.in[I_MEMP] + (size_t)rr * 1024, v, lane);
      bf16_t* o = (bf16_t*)(ws + WS_MEMN) + (size_t)r * 1024;
#pragma unroll
      for (int j = 0; j < 4; ++j) {
        const int k0 = 4 * lane + 256 * j;
        const f32x4 g = *(const f32x4*)(p.in[I_MNG] + l * 1024 + k0);
        const f32x4 xs = v[j] * rstd * g;
        u32x2 ov = {pk2(xs[0], xs[1]), pk2(xs[2], xs[3])};
        *(u32x2*)(o + k0) = ov;
      }
    }
  }
}

constexpr int G_STAGE = 49152;
struct GemmAcc { f32x16 a[2][2]; };
DI void dma16(const void* g, unsigned char* l) { __builtin_amdgcn_global_load_lds((const unsigned*)g, (unsigned*)l, 16, 0, 0); }

template <int NB = 2>
DI void gemm_tile(const bf16_t* __restrict__ A, size_t lda, const bf16_t* __restrict__ Bt, size_t ldb, int K, unsigned char* lds, GemmAcc& acc, int tid) {
  const int lane = tid & 63, wid = __builtin_amdgcn_readfirstlane(tid >> 6), r = lane & 31, h = lane >> 5;
  const int wr = wid >> 1, wc = wid & 1;
#pragma unroll
  for (int a = 0; a < 2; ++a)
#pragma unroll
    for (int b = 0; b < 2; ++b) acc.a[a][b] = zero16();
  const int nk = K / 64;
  unsigned aoff[4], boff[2];
#pragma unroll
  for (int e = 0; e < 4; ++e) { const int row = 8 * (wid * 4 + e) + (lane >> 3), lc = (lane & 7) ^ ((row >> 1) & 7); aoff[e] = (unsigned)row * (unsigned)lda + 8u * lc; }
#pragma unroll
  for (int e = 0; e < NB; ++e) { const int row = 8 * (wid * NB + e) + (lane >> 3), lc = (lane & 7) ^ ((row >> 1) & 7); boff[e] = (unsigned)row * (unsigned)ldb + 8u * lc; }
  auto issue = [&](int kt, int buf) {
    unsigned char* base = lds + buf * G_STAGE;
#pragma unroll
    for (int e = 0; e < 4; ++e) dma16(A + (aoff[e] + 64u * kt), base + (wid * 4 + e) * 1024);
#pragma unroll
    for (int e = 0; e < NB; ++e) dma16(Bt + (boff[e] + 64u * kt), base + 32768 + (wid * NB + e) * 1024);
  };
  asm volatile("s_waitcnt vmcnt(0)" ::: "memory");
  __syncthreads();
  issue(0, 0);
  if (nk > 1) issue(1, 1);
  const unsigned sw = (r >> 1) & 7;
  unsigned co[4];
#pragma unroll
  for (int kk = 0; kk < 4; ++kk) co[kk] = (((2 * kk + h) ^ sw) << 4);
  const unsigned ra = (wr * 64 + r) * 128, rb = 32768 + (wc * 32 * NB + r) * 128;
  for (int kt = 0; kt < nk; ++kt) {
    if (kt + 1 < nk) { if (NB == 2) asm volatile("s_waitcnt vmcnt(6)" ::: "memory"); else asm volatile("s_waitcnt vmcnt(5)" ::: "memory"); }
    else asm volatile("s_waitcnt vmcnt(0)" ::: "memory");
    asm volatile("s_waitcnt lgkmcnt(0)" ::: "memory");
    __builtin_amdgcn_s_barrier();
    if (kt + 2 < nk) issue(kt + 2, (kt + 2) % 3);
    const unsigned char* base = lds + (kt % 3) * G_STAGE;
    const unsigned char* pa = base + ra;
    const unsigned char* pb = base + rb;
#pragma unroll
    for (int kk = 0; kk < 4; ++kk) {
      const bf16x8 a0 = ld16(pa + co[kk]), a1 = ld16(pa + 4096 + co[kk]);
      const bf16x8 b0 = ld16(pb + co[kk]);
      acc.a[0][0] = MFMA32(a0, b0, acc.a[0][0]);
      acc.a[1][0] = MFMA32(a1, b0, acc.a[1][0]);
      if (NB == 2) {
        const bf16x8 b1 = ld16(pb + 4096 + co[kk]);
        acc.a[0][1] = MFMA32(a0, b1, acc.a[0][1]);
        acc.a[1][1] = MFMA32(a1, b1, acc.a[1][1]);
      }
    }
  }
}

DI void gate_scan(const Params& p, unsigned char* lds) {
  const int tid = TIDX, lane = tid & 63, wid = tid >> 6;
  unsigned char* ws = p.ws;
  float* s_ch = (float*)lds;
  float* s_mc = s_ch + NCH * 8;
  float* s_mn = s_mc + NCH * 4;
  __syncthreads();
  for (int i = tid; i < NCH * 8; i += NTHREADS) s_ch[i] = ((const float*)(ws + WS_CHS))[i];
  __syncthreads();
  if (tid < 4) {
    float m = 0.f, ld = 0.f;
    float* LD = (float*)(ws + WS_LD);
    const bool wr = blockIdx.x == 0;
    for (int c = 0; c < 256; ++c) {
      s_mc[c * 4 + tid] = m; if (wr) LD[c * 4 + tid] = ld;
      const float gl = s_ch[(c * 4 + tid) * 2], mn = gl + fmaxf(m, s_ch[(c * 4 + tid) * 2 + 1]);
      ld += gl + m - mn;
      m = mn; s_mn[c * 4 + tid] = m;
    }
    if (wr) { LD[256 * 4 + tid] = ld; p.out[O_PM + tid] = m; }
  } else if (tid >= 64 && tid < 128) {
    const int b = (tid - 64) >> 2, hd = tid & 3, pr = (256 + b) * 4 + hd;
    const float m0 = p.in[I_SM][b * 4 + hd];
    const float m = s_ch[pr * 2] + fmaxf(m0, s_ch[pr * 2 + 1]);
    s_mc[pr] = m0; s_mn[pr] = m;
    if (blockIdx.x == 0) p.out[O_SM + b * 4 + hd] = m;
  }
  __syncthreads();
  for (int cc = blockIdx.x; cc < NCH; cc += gridDim.x) {
    if (wid < 4) {
      const int hd = wid, pr = cc * 4 + hd;
      const size_t o = (size_t)pr * 64 + lane;
      const float g = ((const float*)(ws + WS_GC))[o], a = ((const float*)(ws + WS_AS))[o], pm = ((const float*)(ws + WS_PM))[o];
      const float mc = s_mc[pr], mn = s_mn[pr], gl = s_ch[pr * 2];
      const float mt = g + fmaxf(mc, pm);
      ((float*)(ws + WS_MT))[o] = mt;
      ((float*)(ws + WS_WS))[o] = __expf(gl + a - mn);
      ((float*)(ws + WS_WI))[o] = __expf(g + mc - mt);
      ((float*)(ws + WS_AS))[o] = a * LOG2E;
      ((float*)(ws + WS_BT))[o] = (g - mt) * LOG2E;
      if (lane == 0) ((float*)(ws + WS_DEC))[pr] = __expf(gl + mc - mn);
    }
  }
  __syncthreads();
}

DI void phase1(const Params& p, unsigned char* lds) {
  const int tid = TIDX, lane = tid & 63, wid = tid >> 6, r = lane & 31, h = lane >> 5, wr = wid >> 1, wc = wid & 1;
  unsigned char* ws = p.ws;
  gate_scan(p, lds);
  const int n_main = 68 * 48, n_mem = 16;
  for (int t = blockIdx.x; t < n_main + n_mem; t += gridDim.x) {
    GemmAcc acc;
    if (t < n_main) {
      const int tm = t / 48, tn = t % 48, m0 = tm * 256, n0 = tn * 128;
      gemm_tile((const bf16_t*)(ws + WS_XN) + (size_t)m0 * 1024, 1024, (const bf16_t*)(ws + WS_WA) + (size_t)n0 * 1024, 1024, 1024, lds, acc, tid);
      bf16_t* PA = (bf16_t*)(ws + WS_R1);
      const int sec = n0 >> 10;
#pragma unroll
      for (int a = 0; a < 2; ++a)
#pragma unroll
        for (int b = 0; b < 2; ++b) {
          __builtin_amdgcn_sched_barrier(0);
          const int n = n0 + wc * 64 + 32 * b + r, mb = m0 + wr * 64 + 32 * a;
          if (sec != 2) {
            const float sc = sec == 1 ? 0.0625f : 1.f;
            const int pc = (n >> 2) & 3, np = sec <= 1 ? (n & ~15) + 4 * (((pc & 1) << 1) | (pc >> 1)) + (n & 3) : n;
#pragma unroll
            for (int i = 0; i < 16; ++i) PA[(size_t)(mb + crow(i, h)) * 6144 + np] = f2bf(acc.a[a][b][i] * sc);
          }
          if (sec == 1 || sec == 2) {
            const float sc = sec == 1 ? 0.0625f : 1.f;
            const int f = n & 1023, hd = f >> 8, fe = f & 255;
            bf16_t* T = (bf16_t*)(ws + (sec == 1 ? WS_KT : WS_VTA));
#pragma unroll
            for (int g = 0; g < 4; ++g) {
              const int m = mb + 8 * g + 4 * h, cc = m >> 6, s = m & 63;
              u32x2 o = {pk2(acc.a[a][b][4 * g] * sc, acc.a[a][b][4 * g + 1] * sc), pk2(acc.a[a][b][4 * g + 2] * sc, acc.a[a][b][4 * g + 3] * sc)};
              *(u32x2*)(T + (((size_t)cc * 4 + hd) * 256 + fe) * 64 + s) = o;
            }
          }
        }
    } else {
      const int tt = t - n_main, l = tt >> 3, n0 = (tt & 7) * 128;
      gemm_tile((const bf16_t*)(ws + WS_MEMN) + (size_t)l * 256 * 1024, 1024, (const bf16_t*)(ws + WS_WM) + ((size_t)l * 1024 + n0) * 1024, 1024, 1024, lds, acc, tid);
      const bool isv = n0 >= 512;
      float* of = p.out + (isv ? O_PMV : O_PMK) + (size_t)l * 131072;
      bf16_t* mk = (bf16_t*)(ws + WS_MEMK) + (size_t)(l * 17) * 131072;
      bf16_t* mv = (bf16_t*)(ws + WS_MEMVT) + (size_t)(l * 17) * 131072;
#pragma unroll
      for (int a = 0; a < 2; ++a)
#pragma unroll
        for (int b = 0; b < 2; ++b) {
          __builtin_amdgcn_sched_barrier(0);
          const int f = (n0 & 511) + wc * 64 + 32 * b + r, mb = wr * 64 + 32 * a;
#pragma unroll
          for (int g = 0; g < 4; ++g) {
            const int m = mb + 8 * g + 4 * h;
            float* o4 = of + (size_t)m * 512 + f;
            o4[0] = acc.a[a][b][4 * g]; o4[512] = acc.a[a][b][4 * g + 1]; o4[1024] = acc.a[a][b][4 * g + 2]; o4[1536] = acc.a[a][b][4 * g + 3];
            if (!isv) {
              bf16_t* k4 = mk + (size_t)m * 512 + f;
              k4[0] = f2bf(acc.a[a][b][4 * g]); k4[512] = f2bf(acc.a[a][b][4 * g + 1]); k4[1024] = f2bf(acc.a[a][b][4 * g + 2]); k4[1536] = f2bf(acc.a[a][b][4 * g + 3]);
            } else {
              u32x2 o = {pk2(acc.a[a][b][4 * g], acc.a[a][b][4 * g + 1]), pk2(acc.a[a][b][4 * g + 2], acc.a[a][b][4 * g + 3])};
              const int pq = (m >> 2) & 3, mp = (m & ~15) + 4 * (((pq & 1) << 1) | (pq >> 1));
              *(u32x2*)(mv + (size_t)f * 256 + mp) = o;
            }
          }
        }
    }
  }
}

DI void scan_task(const Params& p, unsigned char* lds, int sb  , int hd, int j, int grp) {
  const int tid = TIDX, lane = tid & 63, wid = tid >> 6, r = lane & 31, h = lane >> 5;
  unsigned char* ws = p.ws;
  const int cc0 = sb < 0 ? GRP * grp : 256 + sb, nch = sb < 0 ? GRP : 1;
  const bf16_t* PA = (const bf16_t*)(ws + WS_R1);
  const bf16_t* KT = (const bf16_t*)(ws + WS_KT);
  const bf16_t* VT = (const bf16_t*)(ws + WS_VTA);
  const float* WSa = (const float*)(ws + WS_WS);
  const float* WIa = (const float*)(ws + WS_WI);
  const float* DEC = (const float*)(ws + WS_DEC);
  float* red = (float*)lds;
  const bool nsl = j == 8;
  f32x16 S = zero16();
  if (sb >= 0) {
    if (!nsl) {
      const float* C0 = p.in[I_SC] + ((size_t)(sb * 4 + hd) * 256 + 32 * j + r) * 256 + 32 * wid;
#pragma unroll
      for (int g = 0; g < 4; ++g) { const f32x4 c = *(const f32x4*)(C0 + 8 * g + 4 * h); S[4 * g] = c[0]; S[4 * g + 1] = c[1]; S[4 * g + 2] = c[2]; S[4 * g + 3] = c[3]; }
    } else if (r == 0) {
      const float* n0 = p.in[I_SN] + (size_t)(sb * 4 + hd) * 256 + 32 * wid;
#pragma unroll
      for (int g = 0; g < 4; ++g) { const f32x4 c = *(const f32x4*)(n0 + 8 * g + 4 * h); S[4 * g] = c[0]; S[4 * g + 1] = c[1]; S[4 * g + 2] = c[2]; S[4 * g + 3] = c[3]; }
    }
  }
  bf16x8 kt[4], wv[4], qf[2][2];
  u32x4 ktn[4], vn[4], qn[2][2];
  float wsn;
  float* wsl = (float*)(lds + 69632);
  auto loadraw = [&](int cc) {
    const size_t ch = (size_t)cc * 4 + hd;
    const bf16_t* kp = KT + (ch * 256 + 32 * wid + r) * 64 + 8 * h;
#pragma unroll
    for (int st = 0; st < 4; ++st) ktn[st] = *(const u32x4*)(kp + 16 * st);
    wsn = WSa[ch * 64 + lane];
    if (!nsl) {
      const bf16_t* vp = VT + (ch * 256 + 32 * j + r) * 64 + 8 * h;
#pragma unroll
      for (int st = 0; st < 4; ++st) vn[st] = *(const u32x4*)(vp + 16 * st);
    }
#pragma unroll
    for (int tt = 0; tt < 2; ++tt) {
      const bf16_t* qp = PA + (size_t)(cc * 64 + 32 * tt + r) * 6144 + hd * 256 + 32 * wid + 8 * h;
#pragma unroll
      for (int s2 = 0; s2 < 2; ++s2) qn[tt][s2] = *(const u32x4*)(qp + 16 * s2);
    }
  };
  auto convert = [&]() {
    __syncthreads();
    if (wid == 0) wsl[lane] = wsn;
    __syncthreads();
#pragma unroll
    for (int st = 0; st < 4; ++st) {
      kt[st] = __builtin_bit_cast(bf16x8, ktn[st]);
      const f32x4 w0 = *(const f32x4*)(wsl + 16 * st + 8 * h), w1 = *(const f32x4*)(wsl + 16 * st + 8 * h + 4);
      u32x4 o;
      if (!nsl) {
        const u32x4 v = vn[st];
        o[0] = pk2(bflo(v[0]) * w0[0], bfhi(v[0]) * w0[1]); o[1] = pk2(bflo(v[1]) * w0[2], bfhi(v[1]) * w0[3]);
        o[2] = pk2(bflo(v[2]) * w1[0], bfhi(v[2]) * w1[1]); o[3] = pk2(bflo(v[3]) * w1[2], bfhi(v[3]) * w1[3]);
      } else {
        o = (u32x4){pk2(w0[0], w0[1]), pk2(w0[2], w0[3]), pk2(w1[0], w1[1]), pk2(w1[2], w1[3])};
        if (r != 0) o = (u32x4){0u, 0u, 0u, 0u};
      }
      wv[st] = __builtin_bit_cast(bf16x8, o);
    }
#pragma unroll
    for (int tt = 0; tt < 2; ++tt)
#pragma unroll
      for (int s2 = 0; s2 < 2; ++s2) qf[tt][s2] = __builtin_bit_cast(bf16x8, qn[tt][s2]);
  };
  loadraw(cc0);
  convert();
  for (int c = 0; c < nch; ++c) {
    const int cc = cc0 + c;
    if (c + 1 < nch) loadraw(cc + 1);
    const float dec = DEC[cc * 4 + hd];
    const bf16x8 xs0 = pack_acc(S, 0), xs1 = pack_acc(S, 1);
    f32x16 z0 = MFMA32(xs0, qf[0][0], zero16()); z0 = MFMA32(xs1, qf[0][1], z0);
    f32x16 z1 = MFMA32(xs0, qf[1][0], zero16()); z1 = MFMA32(xs1, qf[1][1], z1);
    S = S * dec;
#pragma unroll
    for (int st = 0; st < 4; ++st) S = MFMA32(kt[st], wv[st], S);
    __syncthreads();
    {
      float* rw = red + wid * (64 * 33);
#pragma unroll
      for (int i = 0; i < 16; ++i) { rw[r * 33 + crow(i, h)] = z0[i]; rw[(32 + r) * 33 + crow(i, h)] = z1[i]; }
    }
    __syncthreads();
    {
      const int v = tid & 31;
#pragma unroll
      for (int e = 0; e < 4; ++e) {
        const int t = (tid >> 5) + 16 * e;
        float s = 0.f;
#pragma unroll
        for (int w8 = 0; w8 < 8; ++w8) s += red[w8 * (64 * 33) + t * 33 + v];
        const float wi = WIa[((size_t)cc * 4 + hd) * 64 + t];
        if (!nsl) ((float*)(ws + WS_HINTER))[(size_t)(cc * 64 + t) * 1024 + hd * 256 + 32 * j + v] = s * wi;
        else if (v == 0) ((float*)(ws + WS_DENI))[(size_t)(cc * 64 + t) * 4 + hd] = s * wi;
      }
    }
    if (c + 1 < nch) convert();
  }
  if (sb < 0) {
    float* cl = (float*)(ws + WS_CLOC) + ((((size_t)(grp * 4 + hd) * 9 + j) * 8 + wid) * 64 + lane) * 16;
#pragma unroll
    for (int g = 0; g < 4; ++g) { f32x4 c = {S[4 * g], S[4 * g + 1], S[4 * g + 2], S[4 * g + 3]}; *(f32x4*)(cl + 4 * g) = c; }
  } else {
    if (!nsl) {
      float* Co = (sb < 0 ? p.out + O_PC + (size_t)hd * 65536 : p.out + O_SC + (size_t)(sb * 4 + hd) * 65536) + (size_t)(32 * j + r) * 256 + 32 * wid;
#pragma unroll
      for (int g = 0; g < 4; ++g) { f32x4 c = {S[4 * g], S[4 * g + 1], S[4 * g + 2], S[4 * g + 3]}; *(f32x4*)(Co + 8 * g + 4 * h) = c; }
    } else if (r == 0) {
      float* no = (sb < 0 ? p.out + O_PN + (size_t)hd * 256 : p.out + O_SN + (size_t)(sb * 4 + hd) * 256) + 32 * wid;
#pragma unroll
      for (int g = 0; g < 4; ++g) { f32x4 c = {S[4 * g], S[4 * g + 1], S[4 * g + 2], S[4 * g + 3]}; *(f32x4*)(no + 8 * g + 4 * h) = c; }
    }
  }
  __syncthreads();
}

DI void intra_task(const Params& p, int cc, int hd) {
  const int tid = TIDX, lane = tid & 63, wid = tid >> 6, r = lane & 31, h = lane >> 5;
  unsigned char* ws = p.ws;
  const int tt = wid & 1, vq = wid >> 1;
  const bf16_t* PA = (const bf16_t*)(ws + WS_R1);
  const bf16_t* VT = (const bf16_t*)(ws + WS_VTA);
  const size_t ch = (size_t)cc * 4 + hd;
  f32x16 s0 = zero16(), s1 = zero16();
  {
    const bf16_t* qp = PA + (size_t)(cc * 64 + 32 * tt + r) * 6144 + hd * 256 + 8 * h;
    const bf16_t* kp = PA + (size_t)(cc * 64 + r) * 6144 + 1024 + hd * 256 + 8 * h;
#pragma unroll 4
    for (int kk = 0; kk < 16; ++kk) {
      const bf16x8 q = ld16(qp + 16 * kk), k0 = ld16(kp + 16 * kk), k1 = ld16(kp + (size_t)32 * 6144 + 16 * kk);
      s0 = MFMA32(k0, q, s0);
      if (tt == 1) s1 = MFMA32(k1, q, s1);
    }
  }
  const int t = 32 * tt + r;
  const float bt = ((const float*)(ws + WS_BT))[ch * 64 + t];
  const float* asp = (const float*)(ws + WS_AS) + ch * 64;
  float den = 0.f;
#pragma unroll
  for (int g = 0; g < 4; ++g) {
    const f32x4 a0 = *(const f32x4*)(asp + 8 * g + 4 * h);
    const f32x4 a1 = *(const f32x4*)(asp + 32 + 8 * g + 4 * h);
#pragma unroll
    for (int e = 0; e < 4; ++e) {
      const int s = 8 * g + 4 * h + e;
      const float w0 = s <= t ? fexp2(bt + a0[e]) : 0.f;
      const float w1 = (32 + s) <= t ? fexp2(bt + a1[e]) : 0.f;
      s0[4 * g + e] *= w0; s1[4 * g + e] *= w1;
      den += s0[4 * g + e] + s1[4 * g + e];
    }
  }
  den += __shfl_xor(den, 32);
  if (vq == 0 && h == 0) ((float*)(ws + WS_DENA))[(size_t)(cc * 64 + t) * 4 + hd] = den;
  bf16x8 pf[2][2];
  pf[0][0] = pack_acc(s0, 0); pf[0][1] = pack_acc(s0, 1); pf[1][0] = pack_acc(s1, 0); pf[1][1] = pack_acc(s1, 1);
  float* Ho = (float*)(ws + WS_HINTRA) + (size_t)(cc * 64 + t) * 1024 + hd * 256;
#pragma unroll
  for (int vt = 0; vt < 2; ++vt) {
    const int v0 = vq * 64 + vt * 32;
    const bf16_t* vp = VT + (ch * 256 + v0 + r) * 64 + 4 * h;
    f32x16 o = zero16();
#pragma unroll
    for (int st = 0; st < 2; ++st)
#pragma unroll
      for (int s2 = 0; s2 < 2; ++s2) {
        const bf16x8 a = ld8x2(vp + 32 * st + 16 * s2, vp + 32 * st + 16 * s2 + 8);
        o = MFMA32(a, pf[st][s2], o);
      }
#pragma unroll
    for (int g = 0; g < 4; ++g) { f32x4 c = {o[4 * g], o[4 * g + 1], o[4 * g + 2], o[4 * g + 3]}; *(f32x4*)(Ho + v0 + 8 * g + 4 * h) = c; }
  }
}

DI void memattn_task(const Params& p, unsigned char* lds, int task, int layer, const bf16_t* Qb, const bf16_t* Zb, unsigned ldq) {
  const int tid = TIDX, lane = tid & 63, wid = __builtin_amdgcn_readfirstlane(tid >> 6), r = lane & 31, h = lane >> 5;
  unsigned char* ws = p.ws;
  const bool prm = task < 256;
  const int hd = task & 3, ti = prm ? task >> 2 : (task - 256) >> 2;
  const int sbi = prm ? 0 : 1 + ti, tok0 = prm ? ti * 256 : TP + ti * 64, nact = prm ? 8 : 2;
  const bf16_t* MK = (const bf16_t*)(ws + WS_MEMK) + (size_t)(layer * 17 + sbi) * 131072 + hd * 128;
  const bf16_t* MV = (const bf16_t*)(ws + WS_MEMVT) + ((size_t)(layer * 17 + sbi) * 4 + hd) * 128 * 256;
  asm volatile("s_waitcnt vmcnt(0)" ::: "memory");
  __syncthreads();
#pragma unroll
  for (int e = 0; e < 8; ++e) {
    const int q = wid * 8 + e;
    { const int row = 4 * q + (lane >> 4), lc = (lane & 15) ^ (row & 15); dma16(MK + ((unsigned)row * 512u + 8u * lc), lds + q * 1024); }
    { const int row = 2 * q + (lane >> 5), lc = (lane & 31) ^ (row & 15); dma16(MV + ((unsigned)row * 256u + 8u * lc), lds + 65536 + q * 1024); }
  }
  const int tok = tok0 + (wid < nact ? wid : 0) * 32 + r;
  bf16x8 qf[8];
  {
    const bf16_t* qp = Qb + ((unsigned)tok * ldq + hd * 128 + 8 * h);
#pragma unroll
    for (int kk = 0; kk < 8; ++kk) qf[kk] = ld16(qp + 16 * kk);
  }
  asm volatile("s_waitcnt vmcnt(0)" ::: "memory");
  __syncthreads();
  if (wid >= nact) return;
  const float sc = 0.08838834764831845f * LOG2E;
  f32x16 O[4];
#pragma unroll
  for (int vt = 0; vt < 4; ++vt) O[vt] = zero16();
  float mrun = -1e30f, l = 0.f;
  const unsigned sw = r & 15;
#pragma unroll 1
  for (int kb = 0; kb < 4; ++kb) {
    f32x16 s0 = zero16(), s1 = zero16();
    const unsigned char* kp = lds + (kb * 64 + r) * 256;
#pragma unroll
    for (int kk = 0; kk < 8; ++kk) {
      const unsigned co = ((unsigned)(2 * kk + h) ^ sw) << 4;
      const bf16x8 k0 = ld16(kp + co), k1 = ld16(kp + 8192 + co);
      s0 = MFMA32(k0, qf[kk], s0); s1 = MFMA32(k1, qf[kk], s1);
    }
    float mx = -1e30f;
#pragma unroll
    for (int i = 0; i < 16; ++i) mx = fmaxf(mx, fmaxf(s0[i], s1[i]));
    mx = fmaxf(mx, __shfl_xor(mx, 32)) * sc;
    const float mnew = fmaxf(mrun, mx), alpha = fexp2(mrun - mnew);
    mrun = mnew;
    float sum = 0.f;
#pragma unroll
    for (int i = 0; i < 16; ++i) { s0[i] = fexp2(s0[i] * sc - mnew); s1[i] = fexp2(s1[i] * sc - mnew); sum += s0[i] + s1[i]; }
    l = l * alpha + sum;
#pragma unroll
    for (int vt = 0; vt < 4; ++vt) O[vt] = O[vt] * alpha;
    bf16x8 pf[2][2];
    pf[0][0] = pack_acc(s0, 0); pf[0][1] = pack_acc(s0, 1); pf[1][0] = pack_acc(s1, 0); pf[1][1] = pack_acc(s1, 1);
#pragma unroll
    for (int vt = 0; vt < 4; ++vt) {
      const unsigned char* vp = lds + 65536 + (32 * vt + r) * 512;
#pragma unroll
      for (int st = 0; st < 2; ++st)
#pragma unroll
        for (int s2 = 0; s2 < 2; ++s2) {
          const unsigned co = ((unsigned)(8 * kb + 4 * st + 2 * s2 + h) ^ sw) << 4;
          O[vt] = MFMA32(ld16(vp + co), pf[st][s2], O[vt]);
        }
    }
  }
  l += __shfl_xor(l, 32);
  const float inv = 1.f / l;
  const bf16_t* zp = Zb + ((unsigned)tok * ldq + hd * 128);
  bf16_t* op = (bf16_t*)(ws + WS_AO) + ((unsigned)tok * 1536u + 1024 + hd * 128);
#pragma unroll
  for (int vt = 0; vt < 4; ++vt)
#pragma unroll
    for (int g = 0; g < 4; ++g) {
      const int v = 32 * vt + 8 * g + 4 * h;
      const u32x2 z = *(const u32x2*)(zp + v);
      const float o0 = O[vt][4 * g] * inv * siluf_(bflo(z[0])), o1 = O[vt][4 * g + 1] * inv * siluf_(bfhi(z[0]));
      const float o2 = O[vt][4 * g + 2] * inv * siluf_(bflo(z[1])), o3 = O[vt][4 * g + 3] * inv * siluf_(bfhi(z[1]));
      u32x2 o = {pk2(o0, o1), pk2(o2, o3)};
      *(u32x2*)(op + v) = o;
    }
}

DI int next_item(unsigned* ctr, unsigned char* lds_flag_area, int tid) {
  __syncthreads();
  int* sh = (int*)lds_flag_area;
  if (tid == 0) *sh = (int)atomicAdd(ctr, 1u);
  __syncthreads();
  const int v = *sh;
  return v;
}

DI void phase2(const Params& p, unsigned char* lds) {
  unsigned* ctr = (unsigned*)(p.ws + WS_CTR) + 0 + 8 * p.pad;
  const bf16_t* PA = (const bf16_t*)(p.ws + WS_R1);
  const int n_ps = 36 * 16, n_ss = 576, n_in = NCH * 4, n_ma = 256 + 64;
  for (;;) {
    const int it = next_item(ctr, lds + LDS_BYTES - 16, TIDX);
    if (it >= n_ps + n_ss + n_in + n_ma) break;
    if (it < n_ps) scan_task(p, lds, -1, (it % 36) / 9, it % 9, it / 36);
    else if (it < n_ps + n_ss) { const int q = it - n_ps; scan_task(p, lds, q / 36, (q % 36) / 9, q % 9, 0); }
    else if (it < n_ps + n_ss + n_in) { const int q = it - n_ps - n_ss; intra_task(p, q >> 2, q & 3); }
    else { const int q = it - n_ps - n_ss - n_in; memattn_task(p, lds, q, 0, PA + 5120, PA + 5632, 6144); }
  }
}


DI void scanfix_task(const Params& p, unsigned char* lds, int grp, int hd, int j) {
  const int tid = TIDX, lane = tid & 63, wid = tid >> 6, r = lane & 31, h = lane >> 5;
  unsigned char* ws = p.ws;
  const bool nsl = j == 8;
  const float* LD = (const float*)(ws + WS_LD);
  f32x16 S = zero16();
#pragma unroll 4
  for (int gp = 0; gp < grp; ++gp) {
    const float dg = __expf(LD[(GRP * (gp + 1)) * 4 + hd] - LD[(GRP * gp) * 4 + hd]);
    const float* cl = (const float*)(ws + WS_CLOC) + ((((size_t)(gp * 4 + hd) * 9 + j) * 8 + wid) * 64 + lane) * 16;
#pragma unroll
    for (int g = 0; g < 4; ++g) { const f32x4 c = *(const f32x4*)(cl + 4 * g);
      S[4 * g] = S[4 * g] * dg + c[0]; S[4 * g + 1] = S[4 * g + 1] * dg + c[1]; S[4 * g + 2] = S[4 * g + 2] * dg + c[2]; S[4 * g + 3] = S[4 * g + 3] * dg + c[3]; }
  }
  if (grp == 16) {
    if (!nsl) {
      float* Co = p.out + O_PC + (size_t)hd * 65536 + (size_t)(32 * j + r) * 256 + 32 * wid;
#pragma unroll
      for (int g = 0; g < 4; ++g) { f32x4 c = {S[4 * g], S[4 * g + 1], S[4 * g + 2], S[4 * g + 3]}; *(f32x4*)(Co + 8 * g + 4 * h) = c; }
    } else if (r == 0) {
      float* no = p.out + O_PN + (size_t)hd * 256 + 32 * wid;
#pragma unroll
      for (int g = 0; g < 4; ++g) { f32x4 c = {S[4 * g], S[4 * g + 1], S[4 * g + 2], S[4 * g + 3]}; *(f32x4*)(no + 8 * g + 4 * h) = c; }
    }
    return;
  }
  u32x4* fr = (u32x4*)lds;
  float* tp = (float*)(lds + 16384) + wid * (64 * 33);
  __syncthreads();
  fr[(wid * 2 + 0) * 64 + lane] = __builtin_bit_cast(u32x4, pack_acc(S, 0));
  fr[(wid * 2 + 1) * 64 + lane] = __builtin_bit_cast(u32x4, pack_acc(S, 1));
  __syncthreads();
  bf16x8 xf[8][2];
#pragma unroll
  for (int kt = 0; kt < 8; ++kt) { xf[kt][0] = __builtin_bit_cast(bf16x8, fr[(kt * 2 + 0) * 64 + lane]); xf[kt][1] = __builtin_bit_cast(bf16x8, fr[(kt * 2 + 1) * 64 + lane]); }
  const bf16_t* PA = (const bf16_t*)(ws + WS_R1);
  const float* WIa = (const float*)(ws + WS_WI);
#pragma unroll 1
  for (int ci = 0; ci < 2; ++ci) {
    const int cc = GRP * grp + wid + 8 * ci;
    const float D = __expf(LD[cc * 4 + hd] - LD[(GRP * grp) * 4 + hd]);
#pragma unroll
    for (int tt = 0; tt < 2; ++tt) {
      const bf16_t* qp = PA + (size_t)(cc * 64 + 32 * tt + r) * 6144 + hd * 256 + 8 * h;
      f32x16 z = zero16();
#pragma unroll
      for (int kt = 0; kt < 8; ++kt)
#pragma unroll
        for (int s2 = 0; s2 < 2; ++s2) z = MFMA32(xf[kt][s2], ld16(qp + 32 * kt + 16 * s2), z);
#pragma unroll
      for (int i = 0; i < 16; ++i) tp[(32 * tt + r) * 33 + crow(i, h)] = z[i];
    }
    const int v = lane & 31;
#pragma unroll 4
    for (int e = 0; e < 32; ++e) {
      const int t = 2 * e + (lane >> 5);
      const float val = tp[t * 33 + v] * (WIa[((size_t)cc * 4 + hd) * 64 + t] * D);
      if (!nsl) ((float*)(ws + WS_HINTER2))[(size_t)(cc * 64 + t) * 1024 + hd * 256 + 32 * j + v] = val;
      else if (v == 0) ((float*)(ws + WS_DENI2))[(size_t)(cc * 64 + t) * 4 + hd] = val;
    }
  }
}

DI void phase2c(const Params& p, unsigned char* lds) {
  unsigned* ctr = (unsigned*)(p.ws + WS_CTR) + 3 + 8 * p.pad;
  for (;;) {
    const int it = next_item(ctr, lds + LDS_BYTES - 16, TIDX);
    if (it >= 16 * 36) break;
    const int g = 16 - it / 36;
    scanfix_task(p, lds, g, (it % 36) / 9, it % 9);
  }
}

DI void phase3(const Params& p) {
  const int tid = TIDX, lane = tid & 63, wid = tid >> 6;
  unsigned char* ws = p.ws;
  const int gw = blockIdx.x * 8 + wid, nw = gridDim.x * 8;
  const bf16_t* PA = (const bf16_t*)(ws + WS_R1);
  for (int it = gw; it < TT * 4; it += nw) {
    const int tok = it >> 2, hd = it & 3, cc = tok >> 6, t = tok & 63;
    const size_t off = (size_t)tok * 1024 + hd * 256 + 4 * lane;
    f32x4 a = *(const f32x4*)((const float*)(ws + WS_HINTER) + off);
    const f32x4 b = *(const f32x4*)((const float*)(ws + WS_HINTRA) + off);
    float den = ((const float*)(ws + WS_DENI))[tok * 4 + hd] + ((const float*)(ws + WS_DENA))[tok * 4 + hd];
    if (cc >= GRP && cc < 256) { a = a + *(const f32x4*)((const float*)(ws + WS_HINTER2) + off); den += ((const float*)(ws + WS_DENI2))[tok * 4 + hd]; }
    const float mt = ((const float*)(ws + WS_MT))[((size_t)cc * 4 + hd) * 64 + t];
    const float dn = 1.f / fmaxf(fabsf(den), __expf(-mt));
    const u32x2 ou = *(const u32x2*)(PA + (size_t)tok * 6144 + 3072 + hd * 256 + 4 * lane);
    const u32x2 zu = *(const u32x2*)(PA + (size_t)tok * 6144 + 4096 + hd * 256 + 4 * lane);
    f32x4 hv = (a + b) * dn;
    hv[0] *= sigmoidf_(bflo(ou[0])); hv[1] *= sigmoidf_(bfhi(ou[0])); hv[2] *= sigmoidf_(bflo(ou[1])); hv[3] *= sigmoidf_(bfhi(ou[1]));
    float ss = hv[0] * hv[0] + hv[1] * hv[1] + hv[2] * hv[2] + hv[3] * hv[3];
    ss = wave_sum(ss);
    const float rstd = __builtin_amdgcn_rsqf(ss * (1.f / 256.f) + EPS);
    const f32x4 hg = *(const f32x4*)(p.in[I_HGA] + hd * 256 + 4 * lane);
    hv = hv * rstd * hg;
    hv[0] *= siluf_(bflo(zu[0])); hv[1] *= siluf_(bfhi(zu[0])); hv[2] *= siluf_(bflo(zu[1])); hv[3] *= siluf_(bfhi(zu[1]));
    u32x2 o = {pk2(hv[0], hv[1]), pk2(hv[2], hv[3])};
    *(u32x2*)((bf16_t*)(ws + WS_AO) + (size_t)tok * 1536 + hd * 256 + 4 * lane) = o;
  }
}

DI void phase_outproj(const Params& p, unsigned char* lds, int layer) {
  const int tid = TIDX, lane = tid & 63, wid = tid >> 6, r = lane & 31, h = lane >> 5, wr = wid >> 1, wc = wid & 1;
  unsigned char* ws = p.ws;
  const bf16_t* W = (const bf16_t*)(ws + (layer == 0 ? WS_WOA : WS_WOB));
  for (int t = blockIdx.x; t < 68 * 8; t += gridDim.x) {
    const int tm = t >> 3, tn = t & 7, m0 = tm * 256, n0 = tn * 128;
    GemmAcc acc;
    gemm_tile<2>((const bf16_t*)(ws + WS_AO) + (size_t)m0 * 1536, 1536, W + (size_t)n0 * 1536, 1536, 1536, lds, acc, tid);
#pragma unroll
    for (int a = 0; a < 2; ++a)
#pragma unroll
      for (int b = 0; b < 2; ++b) {
        const int n = n0 + wc * 64 + 32 * b + r, mb = m0 + wr * 64 + 32 * a;
#pragma unroll
        for (int i = 0; i < 16; ++i) {
          const int m = mb + crow(i, h);
          if (layer == 0) {
            const float xv = m < TP ? p.in[I_XP][(size_t)m * 1024 + n] : p.in[I_XS][(size_t)(m - TP) * 1024 + n];
            ((float*)(ws + WS_Y1))[(size_t)m * 1024 + n] = xv + acc.a[a][b][i];
          } else {
            p.out[O_Y + (size_t)m * 1024 + n] = ((const float*)(ws + WS_Y1))[(size_t)m * 1024 + n] + acc.a[a][b][i];
          }
        }
      }
  }
}

DI void phase5(const Params& p, unsigned char* lds) {
  const int tid = TIDX, lane = tid & 63, wid = tid >> 6;
  unsigned char* ws = p.ws;
  const int gw = blockIdx.x * 8 + wid, nw = gridDim.x * 8;
  for (int r = gw; r < TT; r += nw) {
    f32x4 v[4];
    const float rstd = row_load_rstd((const float*)(ws + WS_Y1) + (size_t)r * 1024, v, lane);
    bf16_t* xn = (bf16_t*)(ws + WS_XN) + (size_t)r * 1024;
#pragma unroll
    for (int j = 0; j < 4; ++j) { const f32x4 xs = v[j] * rstd; u32x2 o = {pk2(xs[0], xs[1]), pk2(xs[2], xs[3])}; *(u32x2*)(xn + 4 * lane + 256 * j) = o; }
  }
  {
    float* smax = (float*)lds;
    const int hm = (tid & 127) >> 3;
    for (int b = 0; b < 16; ++b) {
      __syncthreads();
      if (tid < 16) smax[tid] = 0.f;
      __syncthreads();
      float mx = 0.f;
      const size_t n8 = (size_t)PAST * 1024 / 8;
      const float* src = p.in[I_CK] + (size_t)b * PAST * 1024;
      bf16_t* dst = (bf16_t*)(ws + WS_KBS) + (size_t)b * SKV * 1024;
      for (size_t i = (size_t)blockIdx.x * NTHREADS + tid; i < n8; i += (size_t)gridDim.x * NTHREADS) {
        const size_t e = i * 8;
        const f32x4 a = *(const f32x4*)(src + e), c = *(const f32x4*)(src + e + 4);
        u32x4 o = {pk2(a[0], a[1]), pk2(a[2], a[3]), pk2(c[0], c[1]), pk2(c[2], c[3])};
        *(u32x4*)(dst + e) = o;
        float ss = a[0] * a[0] + a[1] * a[1] + a[2] * a[2] + a[3] * a[3] + c[0] * c[0] + c[1] * c[1] + c[2] * c[2] + c[3] * c[3];
        ss += __shfl_xor(ss, 1); ss += __shfl_xor(ss, 2); ss += __shfl_xor(ss, 4);
        mx = fmaxf(mx, ss);
      }
      if ((tid & 7) == 0) atomicMax((unsigned*)smax + hm, __float_as_uint(mx));
      __syncthreads();
      if (tid < 16) atomicMax((unsigned*)(ws + WS_KMAX) + (1 + b) * 16 + tid, __float_as_uint(sqrtf(smax[tid])));
    }
  }
  __syncthreads();
  for (int t = blockIdx.x; t < 128 * 64; t += gridDim.x) {
    const int jb = t >> 6, tile = t & 63, b = jb >> 3, hd = jb & 7;
    TJob j = {p.in[I_CV] + (size_t)b * PAST * 1024 + hd * 128, 1024, (bf16_t*)(ws + WS_VTS) + ((size_t)(b * 8 + hd) * 128) * SKV, SKV, nullptr, 64, 1};
    run_tjob_tile(j, tile, (float*)lds, tid, true);
  }
}

DI void phase6(const Params& p, unsigned char* lds) {
  const int tid = TIDX, lane = tid & 63, wid = tid >> 6, r = lane & 31, h = lane >> 5, wr = wid >> 1, wc = wid & 1;
  unsigned char* ws = p.ws;
  for (int t = blockIdx.x; t < 68 * 40; t += gridDim.x) {
    const int tm = t / 40, tn = t % 40, m0 = tm * 256, n0 = tn * 128;
    GemmAcc acc;
    gemm_tile((const bf16_t*)(ws + WS_XN) + (size_t)m0 * 1024, 1024, (const bf16_t*)(ws + WS_WKB) + (size_t)n0 * 1024, 1024, 1024, lds, acc, tid);
    const int sec = n0 >> 10;
    const bool samp = m0 >= TP;
#pragma unroll
    for (int a = 0; a < 2; ++a)
#pragma unroll
      for (int b = 0; b < 2; ++b) {
        const int n = n0 + wc * 64 + 32 * b + r, mb = m0 + wr * 64 + 32 * a;
        if (sec == 0) {
          const int f = n;
          if (b == 1) {
            float mx = 0.f;
#pragma unroll
            for (int i = 0; i < 16; ++i) {
              float ss = acc.a[a][0][i] * acc.a[a][0][i] + acc.a[a][1][i] * acc.a[a][1][i];
              ss += __shfl_xor(ss, 1); ss += __shfl_xor(ss, 2); ss += __shfl_xor(ss, 4); ss += __shfl_xor(ss, 8); ss += __shfl_xor(ss, 16);
              mx = fmaxf(mx, ss);
            }
            mx = fmaxf(mx, __shfl_xor(mx, 32));
            if (lane == 0) {
              const int strm = samp ? 1 + ((mb - TP) >> 6) : 0;
              atomicMax((unsigned*)(ws + WS_KMAX) + strm * 16 + ((n0 + wc * 64) >> 6), __float_as_uint(sqrtf(mx)));
            }
          }
#pragma unroll
          for (int i = 0; i < 16; ++i) {
            const int m = mb + crow(i, h);
            const float v = acc.a[a][b][i];
            if (!samp) { p.out[O_PK + (size_t)m * 1024 + f] = v; ((bf16_t*)(ws + WS_KBP))[(size_t)m * 1024 + f] = f2bf(v); }
            else { const int ms = m - TP, bb = ms >> 6, s = ms & 63; p.out[O_SK + (size_t)ms * 1024 + f] = v;
                   ((bf16_t*)(ws + WS_KBS))[((size_t)bb * SKV + PAST + s) * 1024 + f] = f2bf(v); }
          }
        } else if (sec == 1) {
          const int f = n - 1024, hd = f >> 7, vd = f & 127;
#pragma unroll
          for (int i = 0; i < 16; ++i) {
            const int m = mb + crow(i, h);
            if (!samp) p.out[O_PV + (size_t)m * 1024 + f] = acc.a[a][b][i]; else p.out[O_SV + (size_t)(m - TP) * 1024 + f] = acc.a[a][b][i];
          }
#pragma unroll
          for (int g = 0; g < 4; ++g) {
            const int m0r = mb + 8 * g + 4 * h, pq = (m0r >> 2) & 3;
            const int m = (m0r & ~15) + 4 * (((pq & 1) << 1) | (pq >> 1));
            u32x2 o = {pk2(acc.a[a][b][4 * g], acc.a[a][b][4 * g + 1]), pk2(acc.a[a][b][4 * g + 2], acc.a[a][b][4 * g + 3])};
            if (!samp) *(u32x2*)((bf16_t*)(ws + WS_VTP) + ((size_t)hd * 128 + vd) * TP + m) = o;
            else { const int ms = m - TP, bb = ms >> 6, s = ms & 63; *(u32x2*)((bf16_t*)(ws + WS_VTS) + ((size_t)(bb * 8 + hd) * 128 + vd) * SKV + PAST + s) = o; }
          }
        } else {
          const float sc = sec == 2 ? 0.125f * LOG2E : 1.f;
          bf16_t* PB = (bf16_t*)(ws + WS_PB);
#pragma unroll
          for (int i = 0; i < 16; ++i) PB[(size_t)(mb + crow(i, h)) * 3072 + (n - 2048)] = f2bf(acc.a[a][b][i] * sc);
        }
      }
  }
}

constexpr int A_BUF = 32768, A_KB = 16384, A_FLAGS = 3 * A_BUF;

DI void diffattn_task(const Params& p, unsigned char* lds, int sb  , int qt  , int hd, float lam) {
  const int tid = TIDX, lane = tid & 63, wid = __builtin_amdgcn_readfirstlane(tid >> 6), r = lane & 31, h = lane >> 5;
  unsigned char* ws = p.ws;
  const int cq = wid >> 2, sub = (wid >> 1) & 1, map = wid & 1;
  const int ncq = sb < 0 ? 2 : 1;
  const int base_chunk = sb < 0 ? 2 * qt : 64;
  const int tok0 = sb < 0 ? qt * 128 : TP + sb * 64;
  const bool wvalid = cq < ncq;
  const int qc = base_chunk + cq;
  const int tl = 32 * sub + r;
  const int tok = tok0 + 64 * (wvalid ? cq : 0) + tl;
  const bf16_t* Kb = sb < 0 ? (const bf16_t*)(ws + WS_KBP) + hd * 128 : (const bf16_t*)(ws + WS_KBS) + (size_t)sb * SKV * 1024 + hd * 128;
  const bf16_t* Vb = sb < 0 ? (const bf16_t*)(ws + WS_VTP) + (size_t)hd * 128 * TP : (const bf16_t*)(ws + WS_VTS) + (size_t)(sb * 8 + hd) * 128 * SKV;
  const unsigned ldv = sb < 0 ? TP : SKV;
  const bf16_t* PB = (const bf16_t*)(ws + WS_PB);
  bf16x8 qf[4];
  float qn = 0.f;
  {
    const unsigned qo = (unsigned)tok * 3072u + hd * 128 + map * 64 + 8 * h;
#pragma unroll
    for (int kk = 0; kk < 4; ++kk) {
      const u32x4 u = *(const u32x4*)(PB + (qo + 16 * kk));
      qf[kk] = __builtin_bit_cast(bf16x8, u);
#pragma unroll
      for (int e = 0; e < 4; ++e) { const float a = bflo(u[e]), b = bfhi(u[e]); qn += a * a + b * b; }
    }
    qn += __shfl_xor(qn, 32);
    qn = sqrtf(qn);
  }
  const float kmax = ((const float*)(ws + WS_KMAX))[(sb < 0 ? 0 : 1 + sb) * 16 + hd * 2 + map];
  const float shift = qn * kmax * 1.02f + 0.5f - 40.f;
  const float sl2 = exp2f(-(float)(hd + 1)) * LOG2E;
  const int wd = diff_window(hd);
  const float bh0 = sl2 * (float)(4 * h) - sl2 * (float)tl - shift, bh1 = bh0 + 32.f * sl2;
  float cs[16];
#pragma unroll
  for (int i = 0; i < 16; ++i) cs[i] = __uint_as_float(__builtin_amdgcn_readfirstlane(__float_as_uint(sl2 * (float)((i & 3) + 8 * (i >> 2)))));
  f32x16 O[4];
#pragma unroll
  for (int vt = 0; vt < 4; ++vt) O[vt] = zero16();
  float l = 0.f;
  const int jmax = base_chunk + ncq - 1;
  const int jmin = max(0, base_chunk - wd);
  const int nit = jmax - jmin + 1;
  unsigned kofs[2], vofs[2];
#pragma unroll
  for (int e = 0; e < 2; ++e) {
    const int q = wid * 2 + e;
    { const int row = 4 * q + (lane >> 4), lc = (lane & 15) ^ (row & 15); kofs[e] = (unsigned)row * 1024u + 8u * lc; }
    { const int row = 8 * q + (lane >> 3), lc = (lane & 7) ^ ((row >> 1) & 7); vofs[e] = (unsigned)row * ldv + 8u * lc; }
  }
  auto issue = [&](int j, int buf) {
    const bf16_t* kj = Kb + (size_t)j * 65536;
    const bf16_t* vj = Vb + (size_t)j * 64;
    unsigned char* base = lds + buf * A_BUF;
#pragma unroll
    for (int e = 0; e < 2; ++e) {
      dma16(kj + kofs[e], base + (wid * 2 + e) * 1024);
      dma16(vj + vofs[e], base + A_KB + (wid * 2 + e) * 1024);
    }
  };
  unsigned kco[4], vco[4];
#pragma unroll
  for (int kk = 0; kk < 4; ++kk) kco[kk] = (unsigned)r * 256u + ((((unsigned)(8 * map + 2 * kk + h)) ^ (unsigned)(r & 15)) << 4);
#pragma unroll
  for (int sx = 0; sx < 4; ++sx) vco[sx] = A_KB + (unsigned)r * 128u + ((((unsigned)(2 * sx + h)) ^ (unsigned)((r >> 1) & 7)) << 4);
  asm volatile("s_waitcnt vmcnt(0)" ::: "memory");
  __syncthreads();
  issue(jmax, 0);
  if (nit > 1) issue(jmax - 1, 1);
  for (int it = 0; it < nit; ++it) {
    const int j = jmax - it;
    if (it + 1 < nit) asm volatile("s_waitcnt vmcnt(4)" ::: "memory"); else asm volatile("s_waitcnt vmcnt(0)" ::: "memory");
    asm volatile("s_waitcnt lgkmcnt(0)" ::: "memory");
    __builtin_amdgcn_s_barrier();
    if (it + 2 < nit) issue(j - 2, (it + 2) % 3);
    if (wvalid && j <= qc && qc - j <= wd) {
      const unsigned char* base = lds + (it % 3) * A_BUF;
      const float dofs = sl2 * (float)((qc - j) * 64);
      float sum = 0.f;
#pragma unroll
      for (int half = 0; half < 2; ++half) {
        f32x16 sc;
        {
          float b0 = (half ? bh1 : bh0) - dofs;
          asm volatile("" : "+v"(b0));
#pragma unroll
          for (int i = 0; i < 16; ++i) sc[i] = b0 + cs[i];
        }
        if (j == qc) {
          int tlv = tl;
          asm volatile("" : "+v"(tlv));
          const float m2 = -2.f * sl2, xt = (float)(4 * h + 32 * half - tlv);
#pragma unroll
          for (int i = 0; i < 16; ++i) sc[i] = fmaf(m2, fmaxf(xt + (float)((i & 3) + 8 * (i >> 2)), 0.f), sc[i]);
        }
        {
          bf16x8 kf[4];
#pragma unroll
          for (int kk = 0; kk < 4; ++kk) kf[kk] = ld16(base + 8192 * half + kco[kk]);
#pragma unroll
          for (int kk = 0; kk < 4; ++kk) sc = MFMA32(kf[kk], qf[kk], sc);
        }
        bf16x8 vf[8];
#pragma unroll
        for (int vt = 0; vt < 4; ++vt) { vf[2 * vt] = ld16(base + 4096 * vt + vco[2 * half]); vf[2 * vt + 1] = ld16(base + 4096 * vt + vco[2 * half + 1]); }
#pragma unroll
        for (int i = 0; i < 16; ++i) { sc[i] = fexp2(sc[i]); sum += sc[i]; }
        const bf16x8 p0 = pack_acc(sc, 0), p1 = pack_acc(sc, 1);
#pragma unroll
        for (int vt = 0; vt < 4; ++vt) { O[vt] = MFMA32(vf[2 * vt], p0, O[vt]); O[vt] = MFMA32(vf[2 * vt + 1], p1, O[vt]); }
      }
      l += sum;
    }
  }
  asm volatile("s_waitcnt vmcnt(0)" ::: "memory");
  __syncthreads();
  l += __shfl_xor(l, 32);
  const float inv = wvalid ? 1.f / l : 0.f;
  float* xch = (float*)lds + (size_t)(wid >> 1) * 4096;
  if (map == 1 && wvalid) {
    const float sc = inv * lam;
#pragma unroll
    for (int vt = 0; vt < 4; ++vt)
#pragma unroll
      for (int i = 0; i < 16; ++i) xch[(vt * 16 + i) * 64 + lane] = O[vt][i] * sc;
  }
  __syncthreads();
  if (map == 0 && wvalid) {
    float ss = 0.f;
#pragma unroll
    for (int vt = 0; vt < 4; ++vt)
#pragma unroll
      for (int i = 0; i < 16; ++i) { const float o = O[vt][i] * inv - xch[(vt * 16 + i) * 64 + lane]; O[vt][i] = o; ss += o * o; }
    ss += __shfl_xor(ss, 32);
    const float lam_init = 0.8f - 0.6f * 0.7408182206817179f;
    const float rs = __builtin_amdgcn_rsqf(ss * (1.f / 128.f) + EPS) * (1.f - lam_init);
    const unsigned zo = (unsigned)tok * 3072u + 1024 + hd * 128, oo = (unsigned)tok * 1536u + hd * 128;
    bf16_t* AOp = (bf16_t*)(ws + WS_AO);
    const float* sg = p.in[I_SUBG];
#pragma unroll
    for (int vt = 0; vt < 4; ++vt)
#pragma unroll
      for (int g = 0; g < 4; ++g) {
        const int v = 32 * vt + 8 * g + 4 * h;
        const u32x2 z = *(const u32x2*)(PB + (zo + v));
        const f32x4 gg = *(const f32x4*)(sg + v);
        const float o0 = O[vt][4 * g] * rs * gg[0] * siluf_(bflo(z[0])), o1 = O[vt][4 * g + 1] * rs * gg[1] * siluf_(bfhi(z[0]));
        const float o2 = O[vt][4 * g + 2] * rs * gg[2] * siluf_(bflo(z[1])), o3 = O[vt][4 * g + 3] * rs * gg[3] * siluf_(bfhi(z[1]));
        u32x2 o = {pk2(o0, o1), pk2(o2, o3)};
        *(u32x2*)(AOp + (oo + v)) = o;
      }
  }
  __syncthreads();
}

DI void phase7(const Params& p, unsigned char* lds) {
  unsigned* ctr = (unsigned*)(p.ws + WS_CTR) + 1 + 8 * p.pad;
  const bf16_t* PB = (const bf16_t*)(p.ws + WS_PB);
  float lam;
  {
    const int lane = TIDX & 63;
    const float* lv = p.in[I_LAMB];
    const float a = wave_sum(lv[lane] * lv[64 + lane]), b = wave_sum(lv[128 + lane] * lv[192 + lane]);
    const float lam_init = 0.8f - 0.6f * 0.7408182206817179f;
    lam = __expf(a) - __expf(b) + lam_init;
  }
  const int n_s = 128, n_p = 1024, n_ma = 256 + 64;
  const int* tord = (const int*)(p.ws + WS_TORD);
  for (;;) {
    const int it = next_item(ctr, lds + LDS_BYTES - 16, TIDX);
    if (it >= n_s + n_p) break;
    const int a = tord[it];
    const bool pr = a < n_p;
    diffattn_task(p, lds, pr ? -1 : ((a - n_p) >> 3), pr ? (a >> 3) : 0, a & 7, lam);
  }
  for (;;) {
    const int it = next_item(ctr + 1, lds + LDS_BYTES - 16, TIDX);
    if (it >= n_ma) break;
    memattn_task(p, lds, it, 1, PB + 2048, PB + 2560, 3072);
  }
}

DI void phase9(const Params& p) {
  const int tid = TIDX, lane = tid & 63, wid = tid >> 6;
  const int gw = blockIdx.x * 8 + wid, nw = gridDim.x * 8;
  for (int r = gw; r < TT; r += nw) {
    f32x4 v[4];
    float* row = p.out + O_Y + (size_t)r * 1024;
    const float rstd = row_load_rstd(row, v, lane);
#pragma unroll
    for (int j = 0; j < 4; ++j) {
      const f32x4 g = *(const f32x4*)(p.in[I_FNG] + 4 * lane + 256 * j);
      *(f32x4*)(row + 4 * lane + 256 * j) = v[j] * rstd * g;
    }
  }
}

DI void grid_barrier(unsigned* bar, unsigned target, int tid) {
  asm volatile("s_waitcnt vmcnt(0)" ::: "memory");
  __syncthreads();
  if (tid == 0) {
    __builtin_amdgcn_fence(__ATOMIC_RELEASE, "agent");
    asm volatile("s_waitcnt vmcnt(0)" ::: "memory");
    __hip_atomic_fetch_add(bar, 1u, __ATOMIC_RELAXED, __HIP_MEMORY_SCOPE_AGENT);
    while (__hip_atomic_load(bar, __ATOMIC_RELAXED, __HIP_MEMORY_SCOPE_AGENT) < target) __builtin_amdgcn_s_sleep(1);
    __builtin_amdgcn_fence(__ATOMIC_ACQUIRE, "agent");
    asm volatile("s_waitcnt vmcnt(0)" ::: "memory");
  }
  __syncthreads();
}

__global__ __launch_bounds__(512) void mk(Params pin) {
  extern __shared__ __attribute__((aligned(16))) unsigned char lds[];
  Params p = pin;
  p.wv = __builtin_amdgcn_readfirstlane((int)(__builtin_amdgcn_workitem_id_x() >> 6));
  cg::grid_group grid = cg::this_grid();
  unsigned nbar = 0;
  unsigned* bar = (unsigned*)(p.ws + WS_CTR) + 32;
#define RUN_PHASE(PH, CALL) if (p.ph_lo <= PH && PH < p.ph_hi) { CALL; if (PH + 1 < p.ph_hi) { ++nbar; grid_barrier(bar, nbar * gridDim.x, TIDX); } }
  if (p.ph_lo <= 0 && 0 < p.ph_hi) { phase0(p, lds); if (1 < p.ph_hi) grid.sync(); }
  RUN_PHASE(1, phase1(p, lds))
  RUN_PHASE(2, phase2(p, lds))
  if (p.ph_lo <= 2 && 2 < p.ph_hi) { phase2c(p, lds); ++nbar; grid_barrier(bar, nbar * gridDim.x, TIDX); }
  RUN_PHASE(3, phase3(p))
  RUN_PHASE(4, phase_outproj(p, lds, 0))
  RUN_PHASE(5, phase5(p, lds))
  RUN_PHASE(6, phase6(p, lds))
  RUN_PHASE(7, phase7(p, lds))
  RUN_PHASE(8, phase_outproj(p, lds, 1))
  RUN_PHASE(9, phase9(p))
}

extern "C" void kernel_launch(void* const* d_in, const int* in_sizes, int n_in, void* d_out, int out_size,
                              void* d_ws, size_t ws_size, hipStream_t stream) {
  static int grid_blocks = 0;
  if (!grid_blocks) {
    int dev = 0, cus = 0, per_cu = 0;
    (void)hipGetDevice(&dev);
    (void)hipDeviceGetAttribute(&cus, hipDeviceAttributeMultiprocessorCount, dev);
    (void)hipFuncSetAttribute((const void*)mk, hipFuncAttributeMaxDynamicSharedMemorySize, LDS_BYTES);
    (void)hipOccupancyMaxActiveBlocksPerMultiprocessor(&per_cu, (const void*)mk, NTHREADS, LDS_BYTES);
    grid_blocks = cus;
    fprintf(stderr, "kernel_launch: cus=%d per_cu=%d grid=%d ws=%zu need=%zu\n", cus, per_cu, grid_blocks, ws_size, (size_t)WS_END);
  }
  if (ws_size < WS_END) { fprintf(stderr, "workspace too small\n"); return; }
  Params p{};
  for (int i = 0; i < 24; ++i) p.in[i] = (const float*)d_in[i];
  p.out = (float*)d_out; p.ws = (unsigned char*)d_ws; p.ph_lo = 0; p.ph_hi = NPHASE;
  void* args[] = {&p};
  hipError_t e = hipLaunchCooperativeKernel((const void*)mk, dim3(grid_blocks), dim3(NTHREADS), args, LDS_BYTES, stream);
  if (e != hipSuccess) fprintf(stderr, "cooperative launch failed: %s (grid %d)\n", hipGetErrorString(e), grid_blocks);
  if (PROBE_REP >= 0) {
    Params q = p;
    q.out = (float*)((unsigned char*)d_ws + WS_END); q.ph_lo = PROBE_REP; q.ph_hi = PROBE_REP + 1; q.pad = 1;
    void* args2[] = {&q};
    (void)hipLaunchCooperativeKernel((const void*)mk, dim3(grid_blocks), dim3(NTHREADS), args2, LDS_BYTES, stream);
  }
}
```

```cpp
#include <hip/hip_runtime.h>
#include <hip/hip_cooperative_groups.h>
#include <cstdio>
#include <cstdint>
namespace cg = cooperative_groups;

typedef unsigned short bf16_t;
typedef short bf16x8 __attribute__((ext_vector_type(8)));
typedef short s16x4 __attribute__((ext_vector_type(4)));
typedef float f32x16 __attribute__((ext_vector_type(16)));
typedef float f32x4 __attribute__((ext_vector_type(4)));
typedef float f32x2 __attribute__((ext_vector_type(2)));
typedef __bf16 bf2_t __attribute__((ext_vector_type(2)));
typedef unsigned u32x4 __attribute__((ext_vector_type(4)));
typedef unsigned u32x2 __attribute__((ext_vector_type(2)));
#define DI __device__ __forceinline__
#define MFMA32(a, b, c) __builtin_amdgcn_mfma_f32_32x32x16_bf16((a), (b), (c), 0, 0, 0)

struct Params { const float* in[24]; float* out; unsigned char* ws; int ph_lo, ph_hi; int wv, pad; };
#define TIDX (p.wv * 64 + (int)__builtin_amdgcn_mbcnt_hi(~0u, __builtin_amdgcn_mbcnt_lo(~0u, 0u)))
constexpr int LDS_BYTES = 148480;
constexpr int NTHREADS = 512;
constexpr int NPHASE = 10;
#ifndef PROBE_REP
#define PROBE_REP -1
#endif

constexpr int TP = 16384, TS = 1024, TT = 17408, DM = 1024;
constexpr int NCH = 272;
constexpr int PAST = 4096, SKV = 4160;
constexpr float EPS = 1e-6f;
constexpr float LOG2E = 1.4426950408889634f;
enum { I_XP = 0, I_XS, I_CK, I_CV, I_CMK, I_CMV, I_SC, I_SN, I_SM, I_MEMP, I_NG, I_FNG, I_MNG, I_WMKV, I_WINA, I_BGA, I_HGA, I_WOA,
       I_KVNG, I_WKV, I_WINB, I_LAMB, I_SUBG, I_WOB };
constexpr size_t O_Y = 0, O_PC = 17825792, O_PN = 18087936, O_PM = 18088960, O_PK = 18088964, O_PV = 34866180, O_PMK = 51643396,
                 O_PMV = 51905540, O_SC = 52167684, O_SN = 56361988, O_SM = 56378372, O_SK = 56378436, O_SV = 57427012;
constexpr size_t WS_CTR = 0;
constexpr size_t WS_KMAX = 1024;
constexpr size_t WS_TORD = 8192;
constexpr size_t WS_WA = 16384;
constexpr size_t WS_WOA = WS_WA + (size_t)6144 * 1024 * 2;
constexpr size_t WS_WKB = WS_WOA + (size_t)1024 * 1536 * 2;
constexpr size_t WS_WOB = WS_WKB + (size_t)5120 * 1024 * 2;
constexpr size_t WS_WM = WS_WOB + (size_t)1024 * 1536 * 2;
constexpr size_t WS_MEMN = WS_WM + (size_t)2 * 1024 * 1024 * 2;
constexpr size_t WS_MEMK = WS_MEMN + (size_t)2 * 256 * 1024 * 2;
constexpr size_t WS_MEMVT = WS_MEMK + (size_t)2 * 17 * 256 * 512 * 2;
constexpr size_t WS_GATE = WS_MEMVT + (size_t)2 * 17 * 256 * 512 * 2;
constexpr size_t SZ_CH = (size_t)NCH * 4 * 64 * 4;
constexpr size_t WS_GC = WS_GATE + (size_t)TT * 8 * 4;
constexpr size_t WS_MT = WS_GC + SZ_CH;
constexpr size_t WS_WS = WS_MT + SZ_CH;
constexpr size_t WS_WI = WS_WS + SZ_CH;
constexpr size_t WS_AS = WS_WI + SZ_CH;
constexpr size_t WS_BT = WS_AS + SZ_CH;
constexpr size_t WS_DEC = WS_BT + SZ_CH;
constexpr size_t WS_DENI = WS_DEC + 8192;
constexpr size_t WS_DENA = WS_DENI + (size_t)TT * 4 * 4;
constexpr size_t WS_XN = WS_DENA + (size_t)TT * 4 * 4;
constexpr size_t WS_AO = WS_XN + (size_t)TT * 1024 * 2;
constexpr size_t WS_Y1 = WS_AO + (size_t)TT * 1536 * 2;
constexpr size_t WS_KT = WS_Y1 + (size_t)TT * 1024 * 4;
constexpr size_t WS_VTA = WS_KT + (size_t)NCH * 4 * 256 * 64 * 2;
constexpr size_t WS_R1 = WS_VTA + (size_t)NCH * 4 * 256 * 64 * 2;
constexpr size_t SZ_R1 = (size_t)TT * 6144 * 2;
constexpr size_t WS_PB = WS_R1;
constexpr size_t WS_KBP = WS_PB + (size_t)TT * 3072 * 2;
constexpr size_t WS_VTP = WS_KBP + (size_t)TP * 1024 * 2;
constexpr size_t WS_R2 = WS_R1 + SZ_R1;
constexpr size_t WS_HINTER = WS_R2;
constexpr size_t WS_HINTRA = WS_R2 + (size_t)TT * 1024 * 4;
constexpr size_t WS_KBS = WS_R2;
constexpr size_t WS_VTS = WS_KBS + (size_t)16 * SKV * 1024 * 2;
constexpr size_t WS_WVT = WS_VTS + (size_t)16 * SKV * 1024 * 2;
constexpr size_t WS_U = WS_WVT + (size_t)NCH * 4 * 288 * 64 * 2;
constexpr size_t WS_CFAC = WS_U + SZ_CH;
constexpr size_t WS_CLOCC = WS_CFAC + 8192;
constexpr size_t WS_PM = WS_CLOCC + (size_t)256 * 4 * 9 * 8 * 2 * 64 * 16;
constexpr size_t WS_CHS = WS_PM + SZ_CH;
constexpr size_t WS_LD = WS_CHS + 16384;
constexpr size_t WS_CLOC = WS_LD + 8192;
constexpr size_t WS_END = WS_CLOC + (size_t)16 * 36 * 8 * 64 * 16 * 4;
constexpr int GRP = 16;
static_assert(WS_VTP + (size_t)TP * 1024 * 2 <= WS_R2, "R1 overflow");

DI unsigned pk2(float lo, float hi) { f32x2 v = {lo, hi}; return __builtin_bit_cast(unsigned, __builtin_convertvector(v, bf2_t)); }
DI bf16_t f2bf(float x) { return (bf16_t)(pk2(x, 0.f) & 0xffffu); }
DI float bf2f(unsigned v16) { return __uint_as_float(v16 << 16); }
DI float bflo(unsigned u) { return __uint_as_float(u << 16); }
DI float bfhi(unsigned u) { return __uint_as_float(u & 0xffff0000u); }
DI float rbf(float x) { return bflo(pk2(x, 0.f) & 0xffffu); }
DI int crow(int i, int h) { return (i & 3) + 8 * (i >> 2) + 4 * h; }
DI float wave_sum(float v) {
#pragma unroll
  for (int o = 32; o >= 1; o >>= 1) v += __shfl_xor(v, o);
  return v;
}
DI float fexp2(float x) { return __builtin_amdgcn_exp2f(x); }
DI float fexp(float x) { return __builtin_amdgcn_exp2f(x * LOG2E); }
DI float sigmoidf_(float x) { return 1.f / (1.f + __expf(-x)); }
DI float siluf_(float x) { return x / (1.f + __expf(-x)); }
DI bf16x8 pack_acc(const f32x16& x, int s) {
  u32x4 p;
  p[0] = pk2(x[8 * s + 0], x[8 * s + 1]); p[1] = pk2(x[8 * s + 2], x[8 * s + 3]);
  p[2] = pk2(x[8 * s + 4], x[8 * s + 5]); p[3] = pk2(x[8 * s + 6], x[8 * s + 7]);
  return __builtin_bit_cast(bf16x8, p);
}
DI bf16x8 ld16(const void* p) { return *(const bf16x8*)p; }
DI bf16x8 ld8x2(const void* p0, const void* p1) {
  u32x2 a = *(const u32x2*)p0, b = *(const u32x2*)p1; u32x4 r = {a[0], a[1], b[0], b[1]};
  return __builtin_bit_cast(bf16x8, r);
}
DI f32x16 zero16() { f32x16 z; for (int i = 0; i < 16; ++i) z[i] = 0.f; return z; }

DI void transpose_tile(const float* __restrict__ src, size_t ld_s, bf16_t* __restrict__ dst, size_t ld_d, const float* __restrict__ scale,
                       float* scr, int t, bool perm = false) {
  {
    const int c4 = t & 31, rb = t >> 5;
    f32x4 v[4];
#pragma unroll
    for (int i = 0; i < 4; ++i) v[i] = *(const f32x4*)(src + (size_t)(rb + 16 * i) * ld_s + 4 * c4);
#pragma unroll
    for (int i = 0; i < 4; ++i) {
      const int r = rb + 16 * i;
      f32x4 x = v[i];
      if (scale) { const float sc = scale[r]; x = x * sc; }
      float* d = scr + r * 129 + 4 * c4; d[0] = x[0]; d[1] = x[1]; d[2] = x[2]; d[3] = x[3];
    }
  }
  __syncthreads();
#pragma unroll
  for (int i = 0; i < 2; ++i) {
    const int id = t + 512 * i, c = id >> 3, rg = id & 7;
    const float* s = scr + (8 * rg) * 129 + c;
    u32x4 o; o[0] = pk2(s[0], s[129]); o[1] = pk2(s[2 * 129], s[3 * 129]); o[2] = pk2(s[4 * 129], s[5 * 129]); o[3] = pk2(s[6 * 129], s[7 * 129]);
    if (!perm) *(u32x4*)(dst + (size_t)c * ld_d + 8 * rg) = o;
    else {
      bf16_t* d = dst + (size_t)c * ld_d + 16 * (rg >> 1) + 4 * (rg & 1);
      u32x2 lo = {o[0], o[1]}, hi = {o[2], o[3]};
      *(u32x2*)d = lo; *(u32x2*)(d + 8) = hi;
    }
  }
  __syncthreads();
}

struct TJob { const float* src; size_t ld_s; bf16_t* dst; size_t ld_d; const float* scale; int tr, tc; };

DI void run_tjob_tile(const TJob& j, int tile, float* scr, int tid, bool perm = false) {
  const int ir = tile / j.tc, ic = tile % j.tc;
  transpose_tile(j.src + (size_t)(64 * ir) * j.ld_s + 128 * ic, j.ld_s, j.dst + (size_t)(128 * ic) * j.ld_d + 64 * ir, j.ld_d,
                 j.scale ? j.scale + 64 * ir : nullptr, scr, tid, perm);
}

DI float row_load_rstd(const float* xrow, f32x4 (&v)[4], int lane) {
  float ss = 0.f;
#pragma unroll
  for (int j = 0; j < 4; ++j) { v[j] = *(const f32x4*)(xrow + 4 * lane + 256 * j); ss += v[j][0] * v[j][0] + v[j][1] * v[j][1] + v[j][2] * v[j][2] + v[j][3] * v[j][3]; }
  ss = wave_sum(ss);
  return __builtin_amdgcn_rsqf(ss * (1.f / 1024.f) + EPS);
}

DI int diff_window(int hd) { const float sl2 = exp2f(-(float)(hd + 1)) * LOG2E; return (int)floorf((63.f + 192.f / sl2) * (1.f / 64.f)); }
DI int diff_est(int a) {
  const int hd = a & 7;
  const int w = diff_window(hd) + (a < 1024 ? 2 : 1);
  const int n = a < 1024 ? 2 * (a >> 3) + 2 : 65;
  return n < w ? n : w;
}

DI void phase0(const Params& p, unsigned char* lds) {
  const int tid = TIDX, lane = tid & 63, wid = tid >> 6;
  unsigned char* ws = p.ws;
  if (blockIdx.x == 0 && tid < 64) ((unsigned*)(ws + WS_CTR))[tid] = 0u;
  if (blockIdx.x == 0 && tid < 272) ((unsigned*)(ws + WS_KMAX))[tid] = 0u;
  if (blockIdx.x == 1) {
    int* est = (int*)lds;
    for (int a = tid; a < 1152; a += NTHREADS) est[a] = diff_est(a);
    __syncthreads();
    for (int a = tid; a < 1152; a += NTHREADS) {
      const int ea = est[a];
      int rank = 0;
      for (int b = 0; b < 1152; ++b) { const int eb = est[b]; rank += (eb > ea) || (eb == ea && b < a); }
      ((int*)(ws + WS_TORD))[rank] = a;
    }
    __syncthreads();
  }
  {
    TJob jobs[8];
    jobs[0] = {p.in[I_WINA], 6152, (bf16_t*)(ws + WS_WA), 1024, p.in[I_NG], 16, 40};
    jobs[1] = {p.in[I_WINA] + 5128, 6152, (bf16_t*)(ws + WS_WA) + (size_t)5120 * 1024, 1024, p.in[I_NG], 16, 8};
    jobs[2] = {p.in[I_WOA], 1024, (bf16_t*)(ws + WS_WOA), 1536, nullptr, 24, 8};
    jobs[3] = {p.in[I_WKV], 2048, (bf16_t*)(ws + WS_WKB), 1024, p.in[I_KVNG], 16, 16};
    jobs[4] = {p.in[I_WINB], 3072, (bf16_t*)(ws + WS_WKB) + (size_t)2048 * 1024, 1024, p.in[I_NG] + 1024, 16, 24};
    jobs[5] = {p.in[I_WOB], 1024, (bf16_t*)(ws + WS_WOB), 1536, nullptr, 24, 8};
    jobs[6] = {p.in[I_WMKV], 1024, (bf16_t*)(ws + WS_WM), 1024, nullptr, 16, 8};
    jobs[7] = {p.in[I_WMKV] + (size_t)1024 * 1024, 1024, (bf16_t*)(ws + WS_WM) + (size_t)1024 * 1024, 1024, nullptr, 16, 8};
    int base = 0;
#pragma unroll
    for (int j = 0; j < 8; ++j) {
      const int n = jobs[j].tr * jobs[j].tc;
      for (int t = blockIdx.x; t < n; t += gridDim.x) run_tjob_tile(jobs[j], t, (float*)lds, tid);
      base += n;
    }
    for (int t = blockIdx.x; t < 128 * 4; t += gridDim.x) {
      const int jb = t >> 2, tile = t & 3, l = jb >> 6, b = (jb >> 2) & 15, h = jb & 3;
      TJob j = {p.in[I_CMV] + ((size_t)(l * 16 + b) * 256) * 512 + h * 128, 512,
                (bf16_t*)(ws + WS_MEMVT) + ((size_t)(l * 17 + 1 + b) * 4 + h) * 128 * 256, 256, nullptr, 4, 1};
      run_tjob_tile(j, tile, (float*)lds, tid, true);
    }
  }
  {
    const size_t n8 = (size_t)2 * 16 * 256 * 512 / 8;
    for (size_t i = (size_t)blockIdx.x * NTHREADS + tid; i < n8; i += (size_t)gridDim.x * NTHREADS) {
      const size_t e = i * 8; const int l = (int)(e / ((size_t)16 * 131072)); const size_t rem = e - (size_t)l * 16 * 131072;
      const f32x4 a = *(const f32x4*)(p.in[I_CMK] + e), b = *(const f32x4*)(p.in[I_CMK] + e + 4);
      u32x4 o = {pk2(a[0], a[1]), pk2(a[2], a[3]), pk2(b[0], b[1]), pk2(b[2], b[3])};
      *(u32x4*)((bf16_t*)(ws + WS_MEMK) + ((size_t)(l * 17 + 1) * 131072) + rem) = o;
    }
  }
  {
    const int gw = blockIdx.x * 8 + wid, nw = gridDim.x * 8;
    const float* ng = p.in[I_NG];
    float* gwt = (float*)(lds + 32768);
    float* sg = (float*)(lds + 65536);
    __syncthreads();
    for (int i = tid; i < 8192; i += NTHREADS) { const int k = i >> 3, c = i & 7; gwt[i] = p.in[I_WINA][(size_t)k * 6152 + 5120 + c] * ng[k]; }
    __syncthreads();
    for (int cc = blockIdx.x; cc < NCH; cc += gridDim.x) {
      for (int ri = 0; ri < 8; ++ri) {
        const int r = cc * 64 + wid * 8 + ri;
        const float* xrow = r < TP ? p.in[I_XP] + (size_t)r * 1024 : p.in[I_XS] + (size_t)(r - TP) * 1024;
        f32x4 v[4];
        const float rstd = row_load_rstd(xrow, v, lane);
        float gacc[8];
#pragma unroll
        for (int c = 0; c < 8; ++c) gacc[c] = 0.f;
        bf16_t* xn = (bf16_t*)(ws + WS_XN) + (size_t)r * 1024;
#pragma unroll
        for (int j = 0; j < 4; ++j) {
          const int k0 = 4 * lane + 256 * j;
          const f32x4 xs = v[j] * rstd;
          u32x2 o = {pk2(xs[0], xs[1]), pk2(xs[2], xs[3])};
          *(u32x2*)(xn + k0) = o;
#pragma unroll
          for (int e = 0; e < 4; ++e) {
            const float* wr = gwt + (k0 + e) * 8;
            const f32x4 w0 = *(const f32x4*)wr, w1 = *(const f32x4*)(wr + 4);
            gacc[0] += xs[e] * w0[0]; gacc[1] += xs[e] * w0[1]; gacc[2] += xs[e] * w0[2]; gacc[3] += xs[e] * w0[3];
            gacc[4] += xs[e] * w1[0]; gacc[5] += xs[e] * w1[1]; gacc[6] += xs[e] * w1[2]; gacc[7] += xs[e] * w1[3];
          }
        }
#pragma unroll
        for (int c = 0; c < 8; ++c) gacc[c] = wave_sum(gacc[c]);
        if (lane < 8) {
          float gv = gacc[0];
#pragma unroll
          for (int c = 1; c < 8; ++c) gv = lane == c ? gacc[c] : gv;
          gv += p.in[I_BGA][lane];
          if (lane >= 4) gv = fminf(gv, 0.f) - log1pf(__expf(-fabsf(gv)));
          sg[(wid * 8 + ri) * 8 + lane] = gv;
        }
      }
      __syncthreads();
      if (wid < 4) {
        const int hd = wid, pr = cc * 4 + hd;
        const float ig = sg[lane * 8 + hd], lf = sg[lane * 8 + 4 + hd];
        float g = lf;
#pragma unroll
        for (int o = 1; o < 64; o <<= 1) { const float t = __shfl_up(g, o); if (lane >= o) g += t; }
        const float a = ig - g;
        float pm = a;
#pragma unroll
        for (int o = 1; o < 64; o <<= 1) { const float t = __shfl_up(pm, o); if (lane >= o) pm = fmaxf(pm, t); }
        const size_t o = (size_t)pr * 64 + lane;
        ((float*)(ws + WS_GC))[o] = g;
        ((float*)(ws + WS_AS))[o] = a;
        ((float*)(ws + WS_PM))[o] = pm;
        if (lane == 63) { ((float*)(ws + WS_CHS))[pr * 2] = g; ((float*)(ws + WS_CHS))[pr * 2 + 1] = pm; }
        const float u = __expf(a - __shfl(pm, 63));
        ((float*)(ws + WS_U))[o] = u;
        bf16_t* wr = (bf16_t*)(ws + WS_WVT) + ((size_t)pr * 288 + 256) * 64 + lane;
        wr[0] = f2bf(u);
#pragma unroll 4
        for (int rr = 1; rr < 32; ++rr) wr[rr * 64] = 0;
      }
      __syncthreads();
    }
    for (int r = gw; r < 512; r += nw) {
      const int l = r >> 8, rr = r & 255;
      f32x4 v[4];
      const float rstd = row_load_rstd(p.in[I_MEMP] + (size_t)rr * 1024, v, lane);
      bf16_t* o = (bf16_t*)(ws + WS_MEMN) + (size_t)r * 1024;
#pragma unroll
      for (int j = 0; j < 4; ++j) {
        const int k0 = 4 * lane + 256 * j;
        const f32x4 g = *(const f32x4*)(p.in[I_MNG] + l * 1024 + k0);
        const f32x4 xs = v[j] * rstd * g;
        u32x2 ov = {pk2(xs[0], xs[1]), pk2(xs[2], xs[3])};
        *(u32x2*)(o + k0) = ov;
      }
    }
  }
}

constexpr int G_STAGE = 49152;
struct GemmAcc { f32x16 a[2][2]; };
DI void dma16(const void* g, unsigned char* l) { __builtin_amdgcn_global_load_lds((const unsigned*)g, (unsigned*)l, 16, 0, 0); }

template <int NB = 2>
DI void gemm_tile(const bf16_t* __restrict__ A, size_t lda, const bf16_t* __restrict__ Bt, size_t ldb, int K, unsigned char* lds, GemmAcc& acc, int tid) {
  const int lane = tid & 63, wid = __builtin_amdgcn_readfirstlane(tid >> 6), r = lane & 31, h = lane >> 5;
  const int wr = wid >> 1, wc = wid & 1;
#pragma unroll
  for (int a = 0; a < 2; ++a)
#pragma unroll
    for (int b = 0; b < 2; ++b) acc.a[a][b] = zero16();
  const int nk = K / 64;
  unsigned aoff[4], boff[2];
#pragma unroll
  for (int e = 0; e < 4; ++e) { const int row = 8 * (wid * 4 + e) + (lane >> 3), lc = (lane & 7) ^ ((row >> 1) & 7); aoff[e] = (unsigned)row * (unsigned)lda + 8u * lc; }
#pragma unroll
  for (int e = 0; e < NB; ++e) { const int row = 8 * (wid * NB + e) + (lane >> 3), lc = (lane & 7) ^ ((row >> 1) & 7); boff[e] = (unsigned)row * (unsigned)ldb + 8u * lc; }
  auto issue = [&](int kt, int buf) {
    unsigned char* base = lds + buf * G_STAGE;
#pragma unroll
    for (int e = 0; e < 4; ++e) dma16(A + (aoff[e] + 64u * kt), base + (wid * 4 + e) * 1024);
#pragma unroll
    for (int e = 0; e < NB; ++e) dma16(Bt + (boff[e] + 64u * kt), base + 32768 + (wid * NB + e) * 1024);
  };
  asm volatile("s_waitcnt vmcnt(0)" ::: "memory");
  __syncthreads();
  issue(0, 0);
  if (nk > 1) issue(1, 1);
  const unsigned sw = (r >> 1) & 7;
  unsigned co[4];
#pragma unroll
  for (int kk = 0; kk < 4; ++kk) co[kk] = (((2 * kk + h) ^ sw) << 4);
  const unsigned ra = (wr * 64 + r) * 128, rb = 32768 + (wc * 32 * NB + r) * 128;
  for (int kt = 0; kt < nk; ++kt) {
    if (kt + 1 < nk) { if (NB == 2) asm volatile("s_waitcnt vmcnt(6)" ::: "memory"); else asm volatile("s_waitcnt vmcnt(5)" ::: "memory"); }
    else asm volatile("s_waitcnt vmcnt(0)" ::: "memory");
    asm volatile("s_waitcnt lgkmcnt(0)" ::: "memory");
    __builtin_amdgcn_s_barrier();
    if (kt + 2 < nk) issue(kt + 2, (kt + 2) % 3);
    const unsigned char* base = lds + (kt % 3) * G_STAGE;
    const unsigned char* pa = base + ra;
    const unsigned char* pb = base + rb;
#pragma unroll
    for (int kk = 0; kk < 4; ++kk) {
      const bf16x8 a0 = ld16(pa + co[kk]), a1 = ld16(pa + 4096 + co[kk]);
      const bf16x8 b0 = ld16(pb + co[kk]);
      acc.a[0][0] = MFMA32(a0, b0, acc.a[0][0]);
      acc.a[1][0] = MFMA32(a1, b0, acc.a[1][0]);
      if (NB == 2) {
        const bf16x8 b1 = ld16(pb + 4096 + co[kk]);
        acc.a[0][1] = MFMA32(a0, b1, acc.a[0][1]);
        acc.a[1][1] = MFMA32(a1, b1, acc.a[1][1]);
      }
    }
  }
}

DI void gate_scan(const Params& p, unsigned char* lds) {
  const int tid = TIDX, lane = tid & 63, wid = tid >> 6;
  unsigned char* ws = p.ws;
  float* s_ch = (float*)lds;
  float* s_mc = s_ch + NCH * 8;
  float* s_mn = s_mc + NCH * 4;
  __syncthreads();
  for (int i = tid; i < NCH * 8; i += NTHREADS) s_ch[i] = ((const float*)(ws + WS_CHS))[i];
  __syncthreads();
  if (tid < 4) {
    float m = 0.f, ld = 0.f;
    float* LD = (float*)(ws + WS_LD);
    const bool wr = blockIdx.x == 0;
    for (int c = 0; c < 256; ++c) {
      s_mc[c * 4 + tid] = m; if (wr) LD[c * 4 + tid] = ld;
      const float gl = s_ch[(c * 4 + tid) * 2], mn = gl + fmaxf(m, s_ch[(c * 4 + tid) * 2 + 1]);
      ld += gl + m - mn;
      m = mn; s_mn[c * 4 + tid] = m;
    }
    if (wr) { LD[256 * 4 + tid] = ld; p.out[O_PM + tid] = m; }
  } else if (tid >= 64 && tid < 128) {
    const int b = (tid - 64) >> 2, hd = tid & 3, pr = (256 + b) * 4 + hd;
    const float m0 = p.in[I_SM][b * 4 + hd];
    const float m = s_ch[pr * 2] + fmaxf(m0, s_ch[pr * 2 + 1]);
    s_mc[pr] = m0; s_mn[pr] = m;
    if (blockIdx.x == 0) p.out[O_SM + b * 4 + hd] = m;
  }
  __syncthreads();
  for (int cc = blockIdx.x; cc < NCH; cc += gridDim.x) {
    if (wid < 4) {
      const int hd = wid, pr = cc * 4 + hd;
      const size_t o = (size_t)pr * 64 + lane;
      const float g = ((const float*)(ws + WS_GC))[o], a = ((const float*)(ws + WS_AS))[o], pm = ((const float*)(ws + WS_PM))[o];
      const float mc = s_mc[pr], mn = s_mn[pr], gl = s_ch[pr * 2];
      const float mt = g + fmaxf(mc, pm);
      ((float*)(ws + WS_MT))[o] = mt;
      ((float*)(ws + WS_WS))[o] = __expf(gl + a - mn);
      ((float*)(ws + WS_WI))[o] = __expf(g + mc - mt);
      ((float*)(ws + WS_AS))[o] = a * LOG2E;
      ((float*)(ws + WS_BT))[o] = (g - mt) * LOG2E;
      if (lane == 0) { ((float*)(ws + WS_DEC))[pr] = __expf(gl + mc - mn); const float amx = s_ch[pr * 2 + 1]; ((float*)(ws + WS_CFAC))[pr] = __expf(amx - fmaxf(mc, amx)); }
    }
  }
  __syncthreads();
}

DI void phase1(const Params& p, unsigned char* lds) {
  const int tid = TIDX, lane = tid & 63, wid = tid >> 6, r = lane & 31, h = lane >> 5, wr = wid >> 1, wc = wid & 1;
  unsigned char* ws = p.ws;
  gate_scan(p, lds);
  const int n_main = 68 * 48, n_mem = 16;
  for (int t = blockIdx.x; t < n_main + n_mem; t += gridDim.x) {
    GemmAcc acc;
    if (t < n_main) {
      const int tm = t / 48, tn = t % 48, m0 = tm * 256, n0 = tn * 128;
      gemm_tile((const bf16_t*)(ws + WS_XN) + (size_t)m0 * 1024, 1024, (const bf16_t*)(ws + WS_WA) + (size_t)n0 * 1024, 1024, 1024, lds, acc, tid);
      bf16_t* PA = (bf16_t*)(ws + WS_R1);
      const int sec = n0 >> 10;
#pragma unroll
      for (int a = 0; a < 2; ++a)
#pragma unroll
        for (int b = 0; b < 2; ++b) {
          __builtin_amdgcn_sched_barrier(0);
          const int n = n0 + wc * 64 + 32 * b + r, mb = m0 + wr * 64 + 32 * a;
          if (sec != 2) {
            const float sc = sec == 1 ? 0.0625f : 1.f;
            const int pc = (n >> 2) & 3, np = sec <= 1 ? (n & ~15) + 4 * (((pc & 1) << 1) | (pc >> 1)) + (n & 3) : n;
#pragma unroll
            for (int i = 0; i < 16; ++i) PA[(size_t)(mb + crow(i, h)) * 6144 + np] = f2bf(acc.a[a][b][i] * sc);
          }
          if (sec == 1 || sec == 2) {
            const float sc = sec == 1 ? 0.0625f : 1.f;
            const int f = n & 1023, hd = f >> 8, fe = f & 255;
            bf16_t* T = (bf16_t*)(ws + (sec == 1 ? WS_KT : WS_VTA));
#pragma unroll
            for (int g = 0; g < 4; ++g) {
              const int m = mb + 8 * g + 4 * h, cc = m >> 6, s = m & 63;
              u32x2 o = {pk2(acc.a[a][b][4 * g] * sc, acc.a[a][b][4 * g + 1] * sc), pk2(acc.a[a][b][4 * g + 2] * sc, acc.a[a][b][4 * g + 3] * sc)};
              *(u32x2*)(T + (((size_t)cc * 4 + hd) * 256 + fe) * 64 + s) = o;
              if (sec == 2) {
                const f32x4 u = *(const f32x4*)((const float*)(ws + WS_U) + ((size_t)cc * 4 + hd) * 64 + s);
                u32x2 ow = {pk2(acc.a[a][b][4 * g] * u[0], acc.a[a][b][4 * g + 1] * u[1]), pk2(acc.a[a][b][4 * g + 2] * u[2], acc.a[a][b][4 * g + 3] * u[3])};
                *(u32x2*)((bf16_t*)(ws + WS_WVT) + (((size_t)cc * 4 + hd) * 288 + fe) * 64 + s) = ow;
              }
            }
          }
        }
    } else {
      const int tt = t - n_main, l = tt >> 3, n0 = (tt & 7) * 128;
      gemm_tile((const bf16_t*)(ws + WS_MEMN) + (size_t)l * 256 * 1024, 1024, (const bf16_t*)(ws + WS_WM) + ((size_t)l * 1024 + n0) * 1024, 1024, 1024, lds, acc, tid);
      const bool isv = n0 >= 512;
      float* of = p.out + (isv ? O_PMV : O_PMK) + (size_t)l * 131072;
      bf16_t* mk = (bf16_t*)(ws + WS_MEMK) + (size_t)(l * 17) * 131072;
      bf16_t* mv = (bf16_t*)(ws + WS_MEMVT) + (size_t)(l * 17) * 131072;
#pragma unroll
      for (int a = 0; a < 2; ++a)
#pragma unroll
        for (int b = 0; b < 2; ++b) {
          __builtin_amdgcn_sched_barrier(0);
          const int f = (n0 & 511) + wc * 64 + 32 * b + r, mb = wr * 64 + 32 * a;
#pragma unroll
          for (int g = 0; g < 4; ++g) {
            const int m = mb + 8 * g + 4 * h;
            float* o4 = of + (size_t)m * 512 + f;
            o4[0] = acc.a[a][b][4 * g]; o4[512] = acc.a[a][b][4 * g + 1]; o4[1024] = acc.a[a][b][4 * g + 2]; o4[1536] = acc.a[a][b][4 * g + 3];
            if (!isv) {
              bf16_t* k4 = mk + (size_t)m * 512 + f;
              k4[0] = f2bf(acc.a[a][b][4 * g]); k4[512] = f2bf(acc.a[a][b][4 * g + 1]); k4[1024] = f2bf(acc.a[a][b][4 * g + 2]); k4[1536] = f2bf(acc.a[a][b][4 * g + 3]);
            } else {
              u32x2 o = {pk2(acc.a[a][b][4 * g], acc.a[a][b][4 * g + 1]), pk2(acc.a[a][b][4 * g + 2], acc.a[a][b][4 * g + 3])};
              const int pq = (m >> 2) & 3, mp = (m & ~15) + 4 * (((pq & 1) << 1) | (pq >> 1));
              *(u32x2*)(mv + (size_t)f * 256 + mp) = o;
            }
          }
        }
    }
  }
}

DI void scan_task(const Params& p, unsigned char* lds, int sb  , int hd, int j, int grp) {
  const int tid = TIDX, lane = tid & 63, wid = tid >> 6, r = lane & 31, h = lane >> 5;
  unsigned char* ws = p.ws;
  const int cc0 = sb < 0 ? GRP * grp : 256 + sb, nch = sb < 0 ? GRP : 1;
  const bf16_t* PA = (const bf16_t*)(ws + WS_R1);
  const bf16_t* KT = (const bf16_t*)(ws + WS_KT);
  const bf16_t* VT = (const bf16_t*)(ws + WS_VTA);
  const float* WSa = (const float*)(ws + WS_WS);
  const float* WIa = (const float*)(ws + WS_WI);
  const float* DEC = (const float*)(ws + WS_DEC);
  float* red = (float*)lds;
  const bool nsl = j == 8;
  f32x16 S = zero16();
  if (sb >= 0) {
    if (!nsl) {
      const float* C0 = p.in[I_SC] + ((size_t)(sb * 4 + hd) * 256 + 32 * j + r) * 256 + 32 * wid;
#pragma unroll
      for (int g = 0; g < 4; ++g) { const f32x4 c = *(const f32x4*)(C0 + 8 * g + 4 * h); S[4 * g] = c[0]; S[4 * g + 1] = c[1]; S[4 * g + 2] = c[2]; S[4 * g + 3] = c[3]; }
    } else if (r == 0) {
      const float* n0 = p.in[I_SN] + (size_t)(sb * 4 + hd) * 256 + 32 * wid;
#pragma unroll
      for (int g = 0; g < 4; ++g) { const f32x4 c = *(const f32x4*)(n0 + 8 * g + 4 * h); S[4 * g] = c[0]; S[4 * g + 1] = c[1]; S[4 * g + 2] = c[2]; S[4 * g + 3] = c[3]; }
    }
  }
  bf16x8 kt[4], wv[4], qf[2][2];
  u32x4 ktn[4], vn[4], qn[2][2];
  float wsn;
  float* wsl = (float*)(lds + 69632);
  auto loadraw = [&](int cc) {
    const size_t ch = (size_t)cc * 4 + hd;
    const bf16_t* kp = KT + (ch * 256 + 32 * wid + r) * 64 + 8 * h;
#pragma unroll
    for (int st = 0; st < 4; ++st) ktn[st] = *(const u32x4*)(kp + 16 * st);
    wsn = WSa[ch * 64 + lane];
    if (!nsl) {
      const bf16_t* vp = VT + (ch * 256 + 32 * j + r) * 64 + 8 * h;
#pragma unroll
      for (int st = 0; st < 4; ++st) vn[st] = *(const u32x4*)(vp + 16 * st);
    }
#pragma unroll
    for (int tt = 0; tt < 2; ++tt) {
      const bf16_t* qp = PA + (size_t)(cc * 64 + 32 * tt + r) * 6144 + hd * 256 + 32 * wid + 8 * h;
#pragma unroll
      for (int s2 = 0; s2 < 2; ++s2) qn[tt][s2] = *(const u32x4*)(qp + 16 * s2);
    }
  };
  auto convert = [&]() {
    __syncthreads();
    if (wid == 0) wsl[lane] = wsn;
    __syncthreads();
#pragma unroll
    for (int st = 0; st < 4; ++st) {
      kt[st] = __builtin_bit_cast(bf16x8, ktn[st]);
      const f32x4 w0 = *(const f32x4*)(wsl + 16 * st + 8 * h), w1 = *(const f32x4*)(wsl + 16 * st + 8 * h + 4);
      u32x4 o;
      if (!nsl) {
        const u32x4 v = vn[st];
        o[0] = pk2(bflo(v[0]) * w0[0], bfhi(v[0]) * w0[1]); o[1] = pk2(bflo(v[1]) * w0[2], bfhi(v[1]) * w0[3]);
        o[2] = pk2(bflo(v[2]) * w1[0], bfhi(v[2]) * w1[1]); o[3] = pk2(bflo(v[3]) * w1[2], bfhi(v[3]) * w1[3]);
      } else {
        o = (u32x4){pk2(w0[0], w0[1]), pk2(w0[2], w0[3]), pk2(w1[0], w1[1]), pk2(w1[2], w1[3])};
        if (r != 0) o = (u32x4){0u, 0u, 0u, 0u};
      }
      wv[st] = __builtin_bit_cast(bf16x8, o);
    }
#pragma unroll
    for (int tt = 0; tt < 2; ++tt)
#pragma unroll
      for (int s2 = 0; s2 < 2; ++s2) qf[tt][s2] = __builtin_bit_cast(bf16x8, qn[tt][s2]);
  };
  loadraw(cc0);
  convert();
  for (int c = 0; c < nch; ++c) {
    const int cc = cc0 + c;
    if (c + 1 < nch) loadraw(cc + 1);
    const float dec = DEC[cc * 4 + hd];
    const bf16x8 xs0 = pack_acc(S, 0), xs1 = pack_acc(S, 1);
    f32x16 z0 = MFMA32(xs0, qf[0][0], zero16()); z0 = MFMA32(xs1, qf[0][1], z0);
    f32x16 z1 = MFMA32(xs0, qf[1][0], zero16()); z1 = MFMA32(xs1, qf[1][1], z1);
    S = S * dec;
#pragma unroll
    for (int st = 0; st < 4; ++st) S = MFMA32(kt[st], wv[st], S);
    __syncthreads();
    {
      float* rw = red + wid * (64 * 33);
#pragma unroll
      for (int i = 0; i < 16; ++i) { rw[r * 33 + crow(i, h)] = z0[i]; rw[(32 + r) * 33 + crow(i, h)] = z1[i]; }
    }
    __syncthreads();
    {
      const int v = tid & 31;
#pragma unroll
      for (int e = 0; e < 4; ++e) {
        const int t = (tid >> 5) + 16 * e;
        float s = 0.f;
#pragma unroll
        for (int w8 = 0; w8 < 8; ++w8) s += red[w8 * (64 * 33) + t * 33 + v];
        const float wi = WIa[((size_t)cc * 4 + hd) * 64 + t];
        if (!nsl) ((float*)(ws + WS_HINTER))[(size_t)(cc * 64 + t) * 1024 + hd * 256 + 32 * j + v] = s * wi;
        else if (v == 0) ((float*)(ws + WS_DENI))[(size_t)(cc * 64 + t) * 4 + hd] = s * wi;
      }
    }
    if (c + 1 < nch) convert();
  }
  if (sb < 0) {
    float* cl = (float*)(ws + WS_CLOC) + ((((size_t)(grp * 4 + hd) * 9 + j) * 8 + wid) * 64 + lane) * 16;
#pragma unroll
    for (int g = 0; g < 4; ++g) { f32x4 c = {S[4 * g], S[4 * g + 1], S[4 * g + 2], S[4 * g + 3]}; *(f32x4*)(cl + 4 * g) = c; }
  } else {
    if (!nsl) {
      float* Co = (sb < 0 ? p.out + O_PC + (size_t)hd * 65536 : p.out + O_SC + (size_t)(sb * 4 + hd) * 65536) + (size_t)(32 * j + r) * 256 + 32 * wid;
#pragma unroll
      for (int g = 0; g < 4; ++g) { f32x4 c = {S[4 * g], S[4 * g + 1], S[4 * g + 2], S[4 * g + 3]}; *(f32x4*)(Co + 8 * g + 4 * h) = c; }
    } else if (r == 0) {
      float* no = (sb < 0 ? p.out + O_PN + (size_t)hd * 256 : p.out + O_SN + (size_t)(sb * 4 + hd) * 256) + 32 * wid;
#pragma unroll
      for (int g = 0; g < 4; ++g) { f32x4 c = {S[4 * g], S[4 * g + 1], S[4 * g + 2], S[4 * g + 3]}; *(f32x4*)(no + 8 * g + 4 * h) = c; }
    }
  }
  __syncthreads();
}

DI void intra_task(const Params& p, int cc, int hd) {
  const int tid = TIDX, lane = tid & 63, wid = tid >> 6, r = lane & 31, h = lane >> 5;
  unsigned char* ws = p.ws;
  const int tt = wid & 1, vq = wid >> 1;
  const bf16_t* PA = (const bf16_t*)(ws + WS_R1);
  const bf16_t* VT = (const bf16_t*)(ws + WS_VTA);
  const size_t ch = (size_t)cc * 4 + hd;
  f32x16 s0 = zero16(), s1 = zero16();
  {
    const bf16_t* qp = PA + (size_t)(cc * 64 + 32 * tt + r) * 6144 + hd * 256 + 8 * h;
    const bf16_t* kp = PA + (size_t)(cc * 64 + r) * 6144 + 1024 + hd * 256 + 8 * h;
#pragma unroll 4
    for (int kk = 0; kk < 16; ++kk) {
      const bf16x8 q = ld16(qp + 16 * kk), k0 = ld16(kp + 16 * kk), k1 = ld16(kp + (size_t)32 * 6144 + 16 * kk);
      s0 = MFMA32(k0, q, s0);
      if (tt == 1) s1 = MFMA32(k1, q, s1);
    }
  }
  const int t = 32 * tt + r;
  const float bt = ((const float*)(ws + WS_BT))[ch * 64 + t];
  const float* asp = (const float*)(ws + WS_AS) + ch * 64;
  float den = 0.f;
#pragma unroll
  for (int g = 0; g < 4; ++g) {
    const f32x4 a0 = *(const f32x4*)(asp + 8 * g + 4 * h);
    const f32x4 a1 = *(const f32x4*)(asp + 32 + 8 * g + 4 * h);
#pragma unroll
    for (int e = 0; e < 4; ++e) {
      const int s = 8 * g + 4 * h + e;
      const float w0 = s <= t ? fexp2(bt + a0[e]) : 0.f;
      const float w1 = (32 + s) <= t ? fexp2(bt + a1[e]) : 0.f;
      s0[4 * g + e] *= w0; s1[4 * g + e] *= w1;
      den += s0[4 * g + e] + s1[4 * g + e];
    }
  }
  den += __shfl_xor(den, 32);
  if (vq == 0 && h == 0) ((float*)(ws + WS_DENA))[(size_t)(cc * 64 + t) * 4 + hd] = den;
  bf16x8 pf[2][2];
  pf[0][0] = pack_acc(s0, 0); pf[0][1] = pack_acc(s0, 1); pf[1][0] = pack_acc(s1, 0); pf[1][1] = pack_acc(s1, 1);
  float* Ho = (float*)(ws + WS_HINTRA) + (size_t)(cc * 64 + t) * 1024 + hd * 256;
#pragma unroll
  for (int vt = 0; vt < 2; ++vt) {
    const int v0 = vq * 64 + vt * 32;
    const bf16_t* vp = VT + (ch * 256 + v0 + r) * 64 + 4 * h;
    f32x16 o = zero16();
#pragma unroll
    for (int st = 0; st < 2; ++st)
#pragma unroll
      for (int s2 = 0; s2 < 2; ++s2) {
        const bf16x8 a = ld8x2(vp + 32 * st + 16 * s2, vp + 32 * st + 16 * s2 + 8);
        o = MFMA32(a, pf[st][s2], o);
      }
#pragma unroll
    for (int g = 0; g < 4; ++g) { f32x4 c = {o[4 * g], o[4 * g + 1], o[4 * g + 2], o[4 * g + 3]}; *(f32x4*)(Ho + v0 + 8 * g + 4 * h) = c; }
  }
}

DI void memattn_task(const Params& p, unsigned char* lds, int task, int layer, const bf16_t* Qb, const bf16_t* Zb, unsigned ldq) {
  const int tid = TIDX, lane = tid & 63, wid = __builtin_amdgcn_readfirstlane(tid >> 6), r = lane & 31, h = lane >> 5;
  unsigned char* ws = p.ws;
  const bool prm = task < 256;
  const int hd = task & 3, ti = prm ? task >> 2 : (task - 256) >> 2;
  const int sbi = prm ? 0 : 1 + ti, tok0 = prm ? ti * 256 : TP + ti * 64, nact = prm ? 8 : 2;
  const bf16_t* MK = (const bf16_t*)(ws + WS_MEMK) + (size_t)(layer * 17 + sbi) * 131072 + hd * 128;
  const bf16_t* MV = (const bf16_t*)(ws + WS_MEMVT) + ((size_t)(layer * 17 + sbi) * 4 + hd) * 128 * 256;
  asm volatile("s_waitcnt vmcnt(0)" ::: "memory");
  __syncthreads();
#pragma unroll
  for (int e = 0; e < 8; ++e) {
    const int q = wid * 8 + e;
    { const int row = 4 * q + (lane >> 4), lc = (lane & 15) ^ (row & 15); dma16(MK + ((unsigned)row * 512u + 8u * lc), lds + q * 1024); }
    { const int row = 2 * q + (lane >> 5), lc = (lane & 31) ^ (row & 15); dma16(MV + ((unsigned)row * 256u + 8u * lc), lds + 65536 + q * 1024); }
  }
  const int tok = tok0 + (wid < nact ? wid : 0) * 32 + r;
  bf16x8 qf[8];
  {
    const bf16_t* qp = Qb + ((unsigned)tok * ldq + hd * 128 + 8 * h);
#pragma unroll
    for (int kk = 0; kk < 8; ++kk) qf[kk] = ld16(qp + 16 * kk);
  }
  asm volatile("s_waitcnt vmcnt(0)" ::: "memory");
  __syncthreads();
  if (wid >= nact) return;
  const float sc = 0.08838834764831845f * LOG2E;
  f32x16 O[4];
#pragma unroll
  for (int vt = 0; vt < 4; ++vt) O[vt] = zero16();
  float mrun = -1e30f, l = 0.f;
  const unsigned sw = r & 15;
#pragma unroll 1
  for (int kb = 0; kb < 4; ++kb) {
    f32x16 s0 = zero16(), s1 = zero16();
    const unsigned char* kp = lds + (kb * 64 + r) * 256;
#pragma unroll
    for (int kk = 0; kk < 8; ++kk) {
      const unsigned co = ((unsigned)(2 * kk + h) ^ sw) << 4;
      const bf16x8 k0 = ld16(kp + co), k1 = ld16(kp + 8192 + co);
      s0 = MFMA32(k0, qf[kk], s0); s1 = MFMA32(k1, qf[kk], s1);
    }
    float mx = -1e30f;
#pragma unroll
    for (int i = 0; i < 16; ++i) mx = fmaxf(mx, fmaxf(s0[i], s1[i]));
    mx = fmaxf(mx, __shfl_xor(mx, 32)) * sc;
    const float mnew = fmaxf(mrun, mx), alpha = fexp2(mrun - mnew);
    mrun = mnew;
    float sum = 0.f;
#pragma unroll
    for (int i = 0; i < 16; ++i) { s0[i] = fexp2(s0[i] * sc - mnew); s1[i] = fexp2(s1[i] * sc - mnew); sum += s0[i] + s1[i]; }
    l = l * alpha + sum;
#pragma unroll
    for (int vt = 0; vt < 4; ++vt) O[vt] = O[vt] * alpha;
    bf16x8 pf[2][2];
    pf[0][0] = pack_acc(s0, 0); pf[0][1] = pack_acc(s0, 1); pf[1][0] = pack_acc(s1, 0); pf[1][1] = pack_acc(s1, 1);
#pragma unroll
    for (int vt = 0; vt < 4; ++vt) {
      const unsigned char* vp = lds + 65536 + (32 * vt + r) * 512;
#pragma unroll
      for (int st = 0; st < 2; ++st)
#pragma unroll
        for (int s2 = 0; s2 < 2; ++s2) {
          const unsigned co = ((unsigned)(8 * kb + 4 * st + 2 * s2 + h) ^ sw) << 4;
          O[vt] = MFMA32(ld16(vp + co), pf[st][s2], O[vt]);
        }
    }
  }
  l += __shfl_xor(l, 32);
  const float inv = 1.f / l;
  const bf16_t* zp = Zb + ((unsigned)tok * ldq + hd * 128);
  bf16_t* op = (bf16_t*)(ws + WS_AO) + ((unsigned)tok * 1536u + 1024 + hd * 128);
#pragma unroll
  for (int vt = 0; vt < 4; ++vt)
#pragma unroll
    for (int g = 0; g < 4; ++g) {
      const int v = 32 * vt + 8 * g + 4 * h;
      const u32x2 z = *(const u32x2*)(zp + v);
      const float o0 = O[vt][4 * g] * inv * siluf_(bflo(z[0])), o1 = O[vt][4 * g + 1] * inv * siluf_(bfhi(z[0]));
      const float o2 = O[vt][4 * g + 2] * inv * siluf_(bflo(z[1])), o3 = O[vt][4 * g + 3] * inv * siluf_(bfhi(z[1]));
      u32x2 o = {pk2(o0, o1), pk2(o2, o3)};
      *(u32x2*)(op + v) = o;
    }
}

DI int next_item(unsigned* ctr, unsigned char* lds_flag_area, int tid) {
  __syncthreads();
  int* sh = (int*)lds_flag_area;
  if (tid == 0) *sh = (int)atomicAdd(ctr, 1u);
  __syncthreads();
  const int v = *sh;
  return v;
}

DI void scanA_task(const Params& p, int hd, int j, int grp);

DI void phase2(const Params& p, unsigned char* lds) {
  unsigned* ctr = (unsigned*)(p.ws + WS_CTR) + 0 + 8 * p.pad;
  const bf16_t* PA = (const bf16_t*)(p.ws + WS_R1);
  const int n_ps = 36 * 16, n_ss = 576, n_in = NCH * 4, n_ma = 256 + 64;
  for (;;) {
    const int it = next_item(ctr, lds + LDS_BYTES - 16, TIDX);
    if (it >= n_ps + n_ss + n_in + n_ma) break;
    if (it < n_ps) scanA_task(p, (it % 36) / 9, it % 9, it / 36);
    else if (it < n_ps + n_ss) { const int q = it - n_ps; scan_task(p, lds, q / 36, (q % 36) / 9, q % 9, 0); }
    else if (it < n_ps + n_ss + n_in) { const int q = it - n_ps - n_ss; intra_task(p, q >> 2, q & 3); }
    else { const int q = it - n_ps - n_ss - n_in; memattn_task(p, lds, q, 0, PA + 5120, PA + 5632, 6144); }
  }
}


DI void scanA_task(const Params& p, int hd, int j, int grp) {
  const int tid = TIDX, lane = tid & 63, wid = tid >> 6, r = lane & 31, h = lane >> 5;
  unsigned char* ws = p.ws;
  const bf16_t* KT = (const bf16_t*)(ws + WS_KT);
  const bf16_t* WV = (const bf16_t*)(ws + WS_WVT);
  f32x16 S = zero16();
  u32x4 kn[4], vn[4];
  auto load = [&](int cc) {
    const size_t ch = (size_t)cc * 4 + hd;
    const bf16_t* kp = KT + (ch * 256 + 32 * wid + r) * 64 + 8 * h;
    const bf16_t* vp = WV + (ch * 288 + 32 * j + r) * 64 + 8 * h;
#pragma unroll
    for (int st = 0; st < 4; ++st) { kn[st] = *(const u32x4*)(kp + 16 * st); vn[st] = *(const u32x4*)(vp + 16 * st); }
  };
  load(GRP * grp);
#pragma unroll 1
  for (int c = 0; c < GRP; ++c) {
    const int cc = GRP * grp + c;
    bf16x8 kt[4], wv[4];
#pragma unroll
    for (int st = 0; st < 4; ++st) { kt[st] = __builtin_bit_cast(bf16x8, kn[st]); wv[st] = __builtin_bit_cast(bf16x8, vn[st]); }
    if (c + 1 < GRP) load(cc + 1);
    u32x4* cl = (u32x4*)(ws + WS_CLOCC) + ((((size_t)cc * 4 + hd) * 9 + j) * 8 + wid) * 128 + lane;
    cl[0] = __builtin_bit_cast(u32x4, pack_acc(S, 0));
    cl[64] = __builtin_bit_cast(u32x4, pack_acc(S, 1));
    f32x16 D = zero16();
#pragma unroll
    for (int st = 0; st < 4; ++st) D = MFMA32(kt[st], wv[st], D);
    const float dec = ((const float*)(ws + WS_DEC))[cc * 4 + hd], cf = ((const float*)(ws + WS_CFAC))[cc * 4 + hd];
    S = S * dec + D * cf;
  }
  float* cl = (float*)(ws + WS_CLOC) + ((((size_t)(grp * 4 + hd) * 9 + j) * 8 + wid) * 64 + lane) * 16;
#pragma unroll
  for (int g = 0; g < 4; ++g) { f32x4 c = {S[4 * g], S[4 * g + 1], S[4 * g + 2], S[4 * g + 3]}; *(f32x4*)(cl + 4 * g) = c; }
}

DI void scanfix_task(const Params& p, unsigned char* lds, int grp, int hd, int j) {
  const int tid = TIDX, lane = tid & 63, wid = tid >> 6, r = lane & 31, h = lane >> 5;
  unsigned char* ws = p.ws;
  const bool nsl = j == 8;
  const float* LD = (const float*)(ws + WS_LD);
  f32x16 S = zero16();
#pragma unroll 4
  for (int gp = 0; gp < grp; ++gp) {
    const float dg = __expf(LD[(GRP * (gp + 1)) * 4 + hd] - LD[(GRP * gp) * 4 + hd]);
    const float* cl = (const float*)(ws + WS_CLOC) + ((((size_t)(gp * 4 + hd) * 9 + j) * 8 + wid) * 64 + lane) * 16;
#pragma unroll
    for (int g = 0; g < 4; ++g) { const f32x4 c = *(const f32x4*)(cl + 4 * g);
      S[4 * g] = S[4 * g] * dg + c[0]; S[4 * g + 1] = S[4 * g + 1] * dg + c[1]; S[4 * g + 2] = S[4 * g + 2] * dg + c[2]; S[4 * g + 3] = S[4 * g + 3] * dg + c[3]; }
  }
  if (grp == 16) {
    if (!nsl) {
      float* Co = p.out + O_PC + (size_t)hd * 65536 + (size_t)(32 * j + r) * 256 + 32 * wid;
#pragma unroll
      for (int g = 0; g < 4; ++g) { f32x4 c = {S[4 * g], S[4 * g + 1], S[4 * g + 2], S[4 * g + 3]}; *(f32x4*)(Co + 8 * g + 4 * h) = c; }
    } else if (r == 0) {
      float* no = p.out + O_PN + (size_t)hd * 256 + 32 * wid;
#pragma unroll
      for (int g = 0; g < 4; ++g) { f32x4 c = {S[4 * g], S[4 * g + 1], S[4 * g + 2], S[4 * g + 3]}; *(f32x4*)(no + 8 * g + 4 * h) = c; }
    }
    return;
  }
  u32x4* fr = (u32x4*)lds;
  float* tp = (float*)(lds + 16384) + wid * (64 * 33);
  __syncthreads();
  fr[(wid * 2 + 0) * 64 + lane] = __builtin_bit_cast(u32x4, pack_acc(S, 0));
  fr[(wid * 2 + 1) * 64 + lane] = __builtin_bit_cast(u32x4, pack_acc(S, 1));
  __syncthreads();
  const bf16_t* PA = (const bf16_t*)(ws + WS_R1);
  const float* WIa = (const float*)(ws + WS_WI);
  const bool hasg = grp > 0;
#pragma unroll 1
  for (int ci = 0; ci < 2; ++ci) {
    const int cc = GRP * grp + wid + 8 * ci;
    const float D = __expf(LD[cc * 4 + hd] - LD[(GRP * grp) * 4 + hd]);
    const u32x4* clc = (const u32x4*)(ws + WS_CLOCC) + (((size_t)cc * 4 + hd) * 9 + j) * 8 * 128 + lane;
#pragma unroll
    for (int tt = 0; tt < 2; ++tt) {
      const bf16_t* qp = PA + (size_t)(cc * 64 + 32 * tt + r) * 6144 + hd * 256 + 8 * h;
      f32x16 z = zero16(), z2 = zero16();
#pragma unroll
      for (int kt = 0; kt < 8; ++kt)
#pragma unroll
        for (int s2 = 0; s2 < 2; ++s2) {
          const bf16x8 q = ld16(qp + 32 * kt + 16 * s2);
          z = MFMA32(__builtin_bit_cast(bf16x8, clc[(kt * 2 + s2) * 64]), q, z);
          if (hasg) z2 = MFMA32(__builtin_bit_cast(bf16x8, fr[(kt * 2 + s2) * 64 + lane]), q, z2);
        }
#pragma unroll
      for (int i = 0; i < 16; ++i) tp[(32 * tt + r) * 33 + crow(i, h)] = z[i] + D * z2[i];
    }
    const int v = lane & 31;
#pragma unroll 4
    for (int e = 0; e < 32; ++e) {
      const int t = 2 * e + (lane >> 5);
      const float val = tp[t * 33 + v] * WIa[((size_t)cc * 4 + hd) * 64 + t];
      if (!nsl) ((float*)(ws + WS_HINTER))[(size_t)(cc * 64 + t) * 1024 + hd * 256 + 32 * j + v] = val;
      else if (v == 0) ((float*)(ws + WS_DENI))[(size_t)(cc * 64 + t) * 4 + hd] = val;
    }
  }
}

DI void phase2c(const Params& p, unsigned char* lds) {
  unsigned* ctr = (unsigned*)(p.ws + WS_CTR) + 3 + 8 * p.pad;
  for (;;) {
    const int it = next_item(ctr, lds + LDS_BYTES - 16, TIDX);
    if (it >= 17 * 36) break;
    const int g = 16 - it / 36;
    scanfix_task(p, lds, g, (it % 36) / 9, it % 9);
  }
}

DI void phase3(const Params& p) {
  const int tid = TIDX, lane = tid & 63, wid = tid >> 6;
  unsigned char* ws = p.ws;
  const int gw = blockIdx.x * 8 + wid, nw = gridDim.x * 8;
  const bf16_t* PA = (const bf16_t*)(ws + WS_R1);
  for (int it = gw; it < TT * 4; it += nw) {
    const int tok = it >> 2, hd = it & 3, cc = tok >> 6, t = tok & 63;
    const size_t off = (size_t)tok * 1024 + hd * 256 + 4 * lane;
    const f32x4 a = *(const f32x4*)((const float*)(ws + WS_HINTER) + off), b = *(const f32x4*)((const float*)(ws + WS_HINTRA) + off);
    const float den = ((const float*)(ws + WS_DENI))[tok * 4 + hd] + ((const float*)(ws + WS_DENA))[tok * 4 + hd];
    const float mt = ((const float*)(ws + WS_MT))[((size_t)cc * 4 + hd) * 64 + t];
    const float dn = 1.f / fmaxf(fabsf(den), __expf(-mt));
    const u32x2 ou = *(const u32x2*)(PA + (size_t)tok * 6144 + 3072 + hd * 256 + 4 * lane);
    const u32x2 zu = *(const u32x2*)(PA + (size_t)tok * 6144 + 4096 + hd * 256 + 4 * lane);
    f32x4 hv = (a + b) * dn;
    hv[0] *= sigmoidf_(bflo(ou[0])); hv[1] *= sigmoidf_(bfhi(ou[0])); hv[2] *= sigmoidf_(bflo(ou[1])); hv[3] *= sigmoidf_(bfhi(ou[1]));
    float ss = hv[0] * hv[0] + hv[1] * hv[1] + hv[2] * hv[2] + hv[3] * hv[3];
    ss = wave_sum(ss);
    const float rstd = __builtin_amdgcn_rsqf(ss * (1.f / 256.f) + EPS);
    const f32x4 hg = *(const f32x4*)(p.in[I_HGA] + hd * 256 + 4 * lane);
    hv = hv * rstd * hg;
    hv[0] *= siluf_(bflo(zu[0])); hv[1] *= siluf_(bfhi(zu[0])); hv[2] *= siluf_(bflo(zu[1])); hv[3] *= siluf_(bfhi(zu[1]));
    u32x2 o = {pk2(hv[0], hv[1]), pk2(hv[2], hv[3])};
    *(u32x2*)((bf16_t*)(ws + WS_AO) + (size_t)tok * 1536 + hd * 256 + 4 * lane) = o;
  }
}

DI void phase_outproj(const Params& p, unsigned char* lds, int layer) {
  const int tid = TIDX, lane = tid & 63, wid = tid >> 6, r = lane & 31, h = lane >> 5, wr = wid >> 1, wc = wid & 1;
  unsigned char* ws = p.ws;
  const bf16_t* W = (const bf16_t*)(ws + (layer == 0 ? WS_WOA : WS_WOB));
  for (int t = blockIdx.x; t < 68 * 16; t += gridDim.x) {
    const int tm = t >> 4, tn = t & 15, m0 = tm * 256, n0 = tn * 64;
    GemmAcc acc;
    gemm_tile<1>((const bf16_t*)(ws + WS_AO) + (size_t)m0 * 1536, 1536, W + (size_t)n0 * 1536, 1536, 1536, lds, acc, tid);
#pragma unroll
    for (int a = 0; a < 2; ++a) {
      const int n = n0 + wc * 32 + r, mb = m0 + wr * 64 + 32 * a;
#pragma unroll
      for (int i = 0; i < 16; ++i) {
        const int m = mb + crow(i, h);
        if (layer == 0) {
          const float xv = m < TP ? p.in[I_XP][(size_t)m * 1024 + n] : p.in[I_XS][(size_t)(m - TP) * 1024 + n];
          ((float*)(ws + WS_Y1))[(size_t)m * 1024 + n] = xv + acc.a[a][0][i];
        } else {
          p.out[O_Y + (size_t)m * 1024 + n] = ((const float*)(ws + WS_Y1))[(size_t)m * 1024 + n] + acc.a[a][0][i];
        }
      }
    }
  }
}

DI void phase5(const Params& p, unsigned char* lds) {
  const int tid = TIDX, lane = tid & 63, wid = tid >> 6;
  unsigned char* ws = p.ws;
  const int gw = blockIdx.x * 8 + wid, nw = gridDim.x * 8;
  for (int r = gw; r < TT; r += nw) {
    f32x4 v[4];
    const float rstd = row_load_rstd((const float*)(ws + WS_Y1) + (size_t)r * 1024, v, lane);
    bf16_t* xn = (bf16_t*)(ws + WS_XN) + (size_t)r * 1024;
#pragma unroll
    for (int j = 0; j < 4; ++j) { const f32x4 xs = v[j] * rstd; u32x2 o = {pk2(xs[0], xs[1]), pk2(xs[2], xs[3])}; *(u32x2*)(xn + 4 * lane + 256 * j) = o; }
  }
  {
    float* smax = (float*)lds;
    const int hm = (tid & 127) >> 3;
    for (int b = 0; b < 16; ++b) {
      __syncthreads();
      if (tid < 16) smax[tid] = 0.f;
      __syncthreads();
      float mx = 0.f;
      const size_t n8 = (size_t)PAST * 1024 / 8;
      const float* src = p.in[I_CK] + (size_t)b * PAST * 1024;
      bf16_t* dst = (bf16_t*)(ws + WS_KBS) + (size_t)b * SKV * 1024;
      for (size_t i = (size_t)blockIdx.x * NTHREADS + tid; i < n8; i += (size_t)gridDim.x * NTHREADS) {
        const size_t e = i * 8;
        const f32x4 a = *(const f32x4*)(src + e), c = *(const f32x4*)(src + e + 4);
        u32x4 o = {pk2(a[0], a[1]), pk2(a[2], a[3]), pk2(c[0], c[1]), pk2(c[2], c[3])};
        *(u32x4*)(dst + e) = o;
        float ss = a[0] * a[0] + a[1] * a[1] + a[2] * a[2] + a[3] * a[3] + c[0] * c[0] + c[1] * c[1] + c[2] * c[2] + c[3] * c[3];
        ss += __shfl_xor(ss, 1); ss += __shfl_xor(ss, 2); ss += __shfl_xor(ss, 4);
        mx = fmaxf(mx, ss);
      }
      if ((tid & 7) == 0) atomicMax((unsigned*)smax + hm, __float_as_uint(mx));
      __syncthreads();
      if (tid < 16) atomicMax((unsigned*)(ws + WS_KMAX) + (1 + b) * 16 + tid, __float_as_uint(sqrtf(smax[tid])));
    }
  }
  __syncthreads();
  for (int t = blockIdx.x; t < 128 * 64; t += gridDim.x) {
    const int jb = t >> 6, tile = t & 63, b = jb >> 3, hd = jb & 7;
    TJob j = {p.in[I_CV] + (size_t)b * PAST * 1024 + hd * 128, 1024, (bf16_t*)(ws + WS_VTS) + ((size_t)(b * 8 + hd) * 128) * SKV, SKV, nullptr, 64, 1};
    run_tjob_tile(j, tile, (float*)lds, tid, true);
  }
}

DI void phase6(const Params& p, unsigned char* lds) {
  const int tid = TIDX, lane = tid & 63, wid = tid >> 6, r = lane & 31, h = lane >> 5, wr = wid >> 1, wc = wid & 1;
  unsigned char* ws = p.ws;
  for (int t = blockIdx.x; t < 68 * 40; t += gridDim.x) {
    const int tm = t / 40, tn = t % 40, m0 = tm * 256, n0 = tn * 128;
    GemmAcc acc;
    gemm_tile((const bf16_t*)(ws + WS_XN) + (size_t)m0 * 1024, 1024, (const bf16_t*)(ws + WS_WKB) + (size_t)n0 * 1024, 1024, 1024, lds, acc, tid);
    const int sec = n0 >> 10;
    const bool samp = m0 >= TP;
#pragma unroll
    for (int a = 0; a < 2; ++a)
#pragma unroll
      for (int b = 0; b < 2; ++b) {
        const int n = n0 + wc * 64 + 32 * b + r, mb = m0 + wr * 64 + 32 * a;
        if (sec == 0) {
          const int f = n;
          if (b == 1) {
            float mx = 0.f;
#pragma unroll
            for (int i = 0; i < 16; ++i) {
              float ss = acc.a[a][0][i] * acc.a[a][0][i] + acc.a[a][1][i] * acc.a[a][1][i];
              ss += __shfl_xor(ss, 1); ss += __shfl_xor(ss, 2); ss += __shfl_xor(ss, 4); ss += __shfl_xor(ss, 8); ss += __shfl_xor(ss, 16);
              mx = fmaxf(mx, ss);
            }
            mx = fmaxf(mx, __shfl_xor(mx, 32));
            if (lane == 0) {
              const int strm = samp ? 1 + ((mb - TP) >> 6) : 0;
              atomicMax((unsigned*)(ws + WS_KMAX) + strm * 16 + ((n0 + wc * 64) >> 6), __float_as_uint(sqrtf(mx)));
            }
          }
#pragma unroll
          for (int i = 0; i < 16; ++i) {
            const int m = mb + crow(i, h);
            const float v = acc.a[a][b][i];
            if (!samp) { p.out[O_PK + (size_t)m * 1024 + f] = v; ((bf16_t*)(ws + WS_KBP))[(size_t)m * 1024 + f] = f2bf(v); }
            else { const int ms = m - TP, bb = ms >> 6, s = ms & 63; p.out[O_SK + (size_t)ms * 1024 + f] = v;
                   ((bf16_t*)(ws + WS_KBS))[((size_t)bb * SKV + PAST + s) * 1024 + f] = f2bf(v); }
          }
        } else if (sec == 1) {
          const int f = n - 1024, hd = f >> 7, vd = f & 127;
#pragma unroll
          for (int i = 0; i < 16; ++i) {
            const int m = mb + crow(i, h);
            if (!samp) p.out[O_PV + (size_t)m * 1024 + f] = acc.a[a][b][i]; else p.out[O_SV + (size_t)(m - TP) * 1024 + f] = acc.a[a][b][i];
          }
#pragma unroll
          for (int g = 0; g < 4; ++g) {
            const int m0r = mb + 8 * g + 4 * h, pq = (m0r >> 2) & 3;
            const int m = (m0r & ~15) + 4 * (((pq & 1) << 1) | (pq >> 1));
            u32x2 o = {pk2(acc.a[a][b][4 * g], acc.a[a][b][4 * g + 1]), pk2(acc.a[a][b][4 * g + 2], acc.a[a][b][4 * g + 3])};
            if (!samp) *(u32x2*)((bf16_t*)(ws + WS_VTP) + ((size_t)hd * 128 + vd) * TP + m) = o;
            else { const int ms = m - TP, bb = ms >> 6, s = ms & 63; *(u32x2*)((bf16_t*)(ws + WS_VTS) + ((size_t)(bb * 8 + hd) * 128 + vd) * SKV + PAST + s) = o; }
          }
        } else {
          const float sc = sec == 2 ? 0.125f * LOG2E : 1.f;
          bf16_t* PB = (bf16_t*)(ws + WS_PB);
#pragma unroll
          for (int i = 0; i < 16; ++i) PB[(size_t)(mb + crow(i, h)) * 3072 + (n - 2048)] = f2bf(acc.a[a][b][i] * sc);
        }
      }
  }
}

constexpr int A_BUF = 32768, A_KB = 16384, A_FLAGS = 3 * A_BUF;

DI void diffattn_task(const Params& p, unsigned char* lds, int sb  , int qt  , int hd, float lam) {
  const int tid = TIDX, lane = tid & 63, wid = __builtin_amdgcn_readfirstlane(tid >> 6), r = lane & 31, h = lane >> 5;
  unsigned char* ws = p.ws;
  const int cq = wid >> 2, sub = (wid >> 1) & 1, map = wid & 1;
  const int ncq = sb < 0 ? 2 : 1;
  const int base_chunk = sb < 0 ? 2 * qt : 64;
  const int tok0 = sb < 0 ? qt * 128 : TP + sb * 64;
  const bool wvalid = cq < ncq;
  const int qc = base_chunk + cq;
  const int tl = 32 * sub + r;
  const int tok = tok0 + 64 * (wvalid ? cq : 0) + tl;
  const bf16_t* Kb = sb < 0 ? (const bf16_t*)(ws + WS_KBP) + hd * 128 : (const bf16_t*)(ws + WS_KBS) + (size_t)sb * SKV * 1024 + hd * 128;
  const bf16_t* Vb = sb < 0 ? (const bf16_t*)(ws + WS_VTP) + (size_t)hd * 128 * TP : (const bf16_t*)(ws + WS_VTS) + (size_t)(sb * 8 + hd) * 128 * SKV;
  const unsigned ldv = sb < 0 ? TP : SKV;
  const bf16_t* PB = (const bf16_t*)(ws + WS_PB);
  bf16x8 qf[4];
  float qn = 0.f;
  {
    const unsigned qo = (unsigned)tok * 3072u + hd * 128 + map * 64 + 8 * h;
#pragma unroll
    for (int kk = 0; kk < 4; ++kk) {
      const u32x4 u = *(const u32x4*)(PB + (qo + 16 * kk));
      qf[kk] = __builtin_bit_cast(bf16x8, u);
#pragma unroll
      for (int e = 0; e < 4; ++e) { const float a = bflo(u[e]), b = bfhi(u[e]); qn += a * a + b * b; }
    }
    qn += __shfl_xor(qn, 32);
    qn = sqrtf(qn);
  }
  const float kmax = ((const float*)(ws + WS_KMAX))[(sb < 0 ? 0 : 1 + sb) * 16 + hd * 2 + map];
  const float shift = qn * kmax * 1.02f + 0.5f - 40.f;
  const float sl2 = exp2f(-(float)(hd + 1)) * LOG2E;
  const int wd = diff_window(hd);
  const float bh0 = sl2 * (float)(4 * h) - sl2 * (float)tl - shift, bh1 = bh0 + 32.f * sl2;
  float cs[16];
#pragma unroll
  for (int i = 0; i < 16; ++i) cs[i] = __uint_as_float(__builtin_amdgcn_readfirstlane(__float_as_uint(sl2 * (float)((i & 3) + 8 * (i >> 2)))));
  f32x16 O[4];
#pragma unroll
  for (int vt = 0; vt < 4; ++vt) O[vt] = zero16();
  float l = 0.f;
  const int jmax = base_chunk + ncq - 1;
  const int jmin = max(0, base_chunk - wd);
  const int nit = jmax - jmin + 1;
  unsigned kofs[2], vofs[2];
#pragma unroll
  for (int e = 0; e < 2; ++e) {
    const int q = wid * 2 + e;
    { const int row = 4 * q + (lane >> 4), lc = (lane & 15) ^ (row & 15); kofs[e] = (unsigned)row * 1024u + 8u * lc; }
    { const int row = 8 * q + (lane >> 3), lc = (lane & 7) ^ ((row >> 1) & 7); vofs[e] = (unsigned)row * ldv + 8u * lc; }
  }
  auto issue = [&](int j, int buf) {
    const bf16_t* kj = Kb + (size_t)j * 65536;
    const bf16_t* vj = Vb + (size_t)j * 64;
    unsigned char* base = lds + buf * A_BUF;
#pragma unroll
    for (int e = 0; e < 2; ++e) {
      dma16(kj + kofs[e], base + (wid * 2 + e) * 1024);
      dma16(vj + vofs[e], base + A_KB + (wid * 2 + e) * 1024);
    }
  };
  unsigned kco[4], vco[4];
#pragma unroll
  for (int kk = 0; kk < 4; ++kk) kco[kk] = (unsigned)r * 256u + ((((unsigned)(8 * map + 2 * kk + h)) ^ (unsigned)(r & 15)) << 4);
#pragma unroll
  for (int sx = 0; sx < 4; ++sx) vco[sx] = A_KB + (unsigned)r * 128u + ((((unsigned)(2 * sx + h)) ^ (unsigned)((r >> 1) & 7)) << 4);
  asm volatile("s_waitcnt vmcnt(0)" ::: "memory");
  __syncthreads();
  issue(jmax, 0);
  if (nit > 1) issue(jmax - 1, 1);
  for (int it = 0; it < nit; ++it) {
    const int j = jmax - it;
    if (it + 1 < nit) asm volatile("s_waitcnt vmcnt(4)" ::: "memory"); else asm volatile("s_waitcnt vmcnt(0)" ::: "memory");
    asm volatile("s_waitcnt lgkmcnt(0)" ::: "memory");
    __builtin_amdgcn_s_barrier();
    if (it + 2 < nit) issue(j - 2, (it + 2) % 3);
    if (wvalid && j <= qc && qc - j <= wd) {
      const unsigned char* base = lds + (it % 3) * A_BUF;
      const float dofs = sl2 * (float)((qc - j) * 64);
      float sum = 0.f;
#pragma unroll
      for (int half = 0; half < 2; ++half) {
        f32x16 sc;
        {
          float b0 = (half ? bh1 : bh0) - dofs;
          asm volatile("" : "+v"(b0));
#pragma unroll
          for (int i = 0; i < 16; ++i) sc[i] = b0 + cs[i];
        }
        if (j == qc) {
          int tlv = tl;
          asm volatile("" : "+v"(tlv));
          const float m2 = -2.f * sl2, xt = (float)(4 * h + 32 * half - tlv);
#pragma unroll
          for (int i = 0; i < 16; ++i) sc[i] = fmaf(m2, fmaxf(xt + (float)((i & 3) + 8 * (i >> 2)), 0.f), sc[i]);
        }
        {
          bf16x8 kf[4];
#pragma unroll
          for (int kk = 0; kk < 4; ++kk) kf[kk] = ld16(base + 8192 * half + kco[kk]);
#pragma unroll
          for (int kk = 0; kk < 4; ++kk) sc = MFMA32(kf[kk], qf[kk], sc);
        }
        bf16x8 vf[8];
#pragma unroll
        for (int vt = 0; vt < 4; ++vt) { vf[2 * vt] = ld16(base + 4096 * vt + vco[2 * half]); vf[2 * vt + 1] = ld16(base + 4096 * vt + vco[2 * half + 1]); }
#pragma unroll
        for (int i = 0; i < 16; ++i) { sc[i] = fexp2(sc[i]); sum += sc[i]; }
        const bf16x8 p0 = pack_acc(sc, 0), p1 = pack_acc(sc, 1);
#pragma unroll
        for (int vt = 0; vt < 4; ++vt) { O[vt] = MFMA32(vf[2 * vt], p0, O[vt]); O[vt] = MFMA32(vf[2 * vt + 1], p1, O[vt]); }
      }
      l += sum;
    }
  }
  asm volatile("s_waitcnt vmcnt(0)" ::: "memory");
  __syncthreads();
  l += __shfl_xor(l, 32);
  const float inv = wvalid ? 1.f / l : 0.f;
  float* xch = (float*)lds + (size_t)(wid >> 1) * 4096;
  if (map == 1 && wvalid) {
    const float sc = inv * lam;
#pragma unroll
    for (int vt = 0; vt < 4; ++vt)
#pragma unroll
      for (int i = 0; i < 16; ++i) xch[(vt * 16 + i) * 64 + lane] = O[vt][i] * sc;
  }
  __syncthreads();
  if (map == 0 && wvalid) {
    float ss = 0.f;
#pragma unroll
    for (int vt = 0; vt < 4; ++vt)
#pragma unroll
      for (int i = 0; i < 16; ++i) { const float o = O[vt][i] * inv - xch[(vt * 16 + i) * 64 + lane]; O[vt][i] = o; ss += o * o; }
    ss += __shfl_xor(ss, 32);
    const float lam_init = 0.8f - 0.6f * 0.7408182206817179f;
    const float rs = __builtin_amdgcn_rsqf(ss * (1.f / 128.f) + EPS) * (1.f - lam_init);
    const unsigned zo = (unsigned)tok * 3072u + 1024 + hd * 128, oo = (unsigned)tok * 1536u + hd * 128;
    bf16_t* AOp = (bf16_t*)(ws + WS_AO);
    const float* sg = p.in[I_SUBG];
#pragma unroll
    for (int vt = 0; vt < 4; ++vt)
#pragma unroll
      for (int g = 0; g < 4; ++g) {
        const int v = 32 * vt + 8 * g + 4 * h;
        const u32x2 z = *(const u32x2*)(PB + (zo + v));
        const f32x4 gg = *(const f32x4*)(sg + v);
        const float o0 = O[vt][4 * g] * rs * gg[0] * siluf_(bflo(z[0])), o1 = O[vt][4 * g + 1] * rs * gg[1] * siluf_(bfhi(z[0]));
        const float o2 = O[vt][4 * g + 2] * rs * gg[2] * siluf_(bflo(z[1])), o3 = O[vt][4 * g + 3] * rs * gg[3] * siluf_(bfhi(z[1]));
        u32x2 o = {pk2(o0, o1), pk2(o2, o3)};
        *(u32x2*)(AOp + (oo + v)) = o;
      }
  }
  __syncthreads();
}

DI void phase7(const Params& p, unsigned char* lds) {
  unsigned* ctr = (unsigned*)(p.ws + WS_CTR) + 1 + 8 * p.pad;
  const bf16_t* PB = (const bf16_t*)(p.ws + WS_PB);
  float lam;
  {
    const int lane = TIDX & 63;
    const float* lv = p.in[I_LAMB];
    const float a = wave_sum(lv[lane] * lv[64 + lane]), b = wave_sum(lv[128 + lane] * lv[192 + lane]);
    const float lam_init = 0.8f - 0.6f * 0.7408182206817179f;
    lam = __expf(a) - __expf(b) + lam_init;
  }
  const int n_s = 128, n_p = 1024, n_ma = 256 + 64;
  const int* tord = (const int*)(p.ws + WS_TORD);
  for (;;) {
    const int it = next_item(ctr, lds + LDS_BYTES - 16, TIDX);
    if (it >= n_s + n_p) break;
    const int a = tord[it];
    const bool pr = a < n_p;
    diffattn_task(p, lds, pr ? -1 : ((a - n_p) >> 3), pr ? (a >> 3) : 0, a & 7, lam);
  }
  for (;;) {
    const int it = next_item(ctr + 1, lds + LDS_BYTES - 16, TIDX);
    if (it >= n_ma) break;
    memattn_task(p, lds, it, 1, PB + 2048, PB + 2560, 3072);
  }
}

DI void phase9(const Params& p) {
  const int tid = TIDX, lane = tid & 63, wid = tid >> 6;
  const int gw = blockIdx.x * 8 + wid, nw = gridDim.x * 8;
  for (int r = gw; r < TT; r += nw) {
    f32x4 v[4];
    float* row = p.out + O_Y + (size_t)r * 1024;
    const float rstd = row_load_rstd(row, v, lane);
#pragma unroll
    for (int j = 0; j < 4; ++j) {
      const f32x4 g = *(const f32x4*)(p.in[I_FNG] + 4 * lane + 256 * j);
      *(f32x4*)(row + 4 * lane + 256 * j) = v[j] * rstd * g;
    }
  }
}

DI void grid_barrier(unsigned* bar, unsigned target, int tid) {
  asm volatile("s_waitcnt vmcnt(0)" ::: "memory");
  __syncthreads();
  if (tid == 0) {
    __builtin_amdgcn_fence(__ATOMIC_RELEASE, "agent");
    asm volatile("s_waitcnt vmcnt(0)" ::: "memory");
    __hip_atomic_fetch_add(bar, 1u, __ATOMIC_RELAXED, __HIP_MEMORY_SCOPE_AGENT);
    while (__hip_atomic_load(bar, __ATOMIC_RELAXED, __HIP_MEMORY_SCOPE_AGENT) < target) __builtin_amdgcn_s_sleep(1);
    __builtin_amdgcn_fence(__ATOMIC_ACQUIRE, "agent");
    asm volatile("s_waitcnt vmcnt(0)" ::: "memory");
  }
  __syncthreads();
}

__global__ __launch_bounds__(512) void mk(Params pin) {
  extern __shared__ __attribute__((aligned(16))) unsigned char lds[];
  Params p = pin;
  p.wv = __builtin_amdgcn_readfirstlane((int)(__builtin_amdgcn_workitem_id_x() >> 6));
  cg::grid_group grid = cg::this_grid();
  unsigned nbar = 0;
  unsigned* bar = (unsigned*)(p.ws + WS_CTR) + 32;
#define RUN_PHASE(PH, CALL) if (p.ph_lo <= PH && PH < p.ph_hi) { CALL; if (PH + 1 < p.ph_hi) { ++nbar; grid_barrier(bar, nbar * gridDim.x, TIDX); } }
  if (p.ph_lo <= 0 && 0 < p.ph_hi) { phase0(p, lds); if (1 < p.ph_hi) grid.sync(); }
  RUN_PHASE(1, phase1(p, lds))
  RUN_PHASE(2, phase2(p, lds))
  if (p.ph_lo <= 2 && 2 < p.ph_hi) { phase2c(p, lds); ++nbar; grid_barrier(bar, nbar * gridDim.x, TIDX); }
  RUN_PHASE(3, phase3(p))
  RUN_PHASE(4, phase_outproj(p, lds, 0))
  RUN_PHASE(5, phase5(p, lds))
  RUN_PHASE(6, phase6(p, lds))
  RUN_PHASE(7, phase7(p, lds))
  RUN_PHASE(8, phase_outproj(p, lds, 1))
  RUN_PHASE(9, phase9(p))
}

extern "C" void kernel_launch(void* const* d_in, const int* in_sizes, int n_in, void* d_out, int out_size,
                              void* d_ws, size_t ws_size, hipStream_t stream) {
  static int grid_blocks = 0;
  if (!grid_blocks) {
    int dev = 0, cus = 0, per_cu = 0;
    (void)hipGetDevice(&dev);
    (void)hipDeviceGetAttribute(&cus, hipDeviceAttributeMultiprocessorCount, dev);
    (void)hipFuncSetAttribute((const void*)mk, hipFuncAttributeMaxDynamicSharedMemorySize, LDS_BYTES);
    (void)hipOccupancyMaxActiveBlocksPerMultiprocessor(&per_cu, (const void*)mk, NTHREADS, LDS_BYTES);
    grid_blocks = cus;
    fprintf(stderr, "kernel_launch: cus=%d per_cu=%d grid=%d ws=%zu need=%zu\n", cus, per_cu, grid_blocks, ws_size, (size_t)WS_END);
  }
  if (ws_size < WS_END) { fprintf(stderr, "workspace too small\n"); return; }
  Params p{};
  for (int i = 0; i < 24; ++i) p.in[i] = (const float*)d_in[i];
  p.out = (float*)d_out; p.ws = (unsigned char*)d_ws; p.ph_lo = 0; p.ph_hi = NPHASE;
  void* args[] = {&p};
  hipError_t e = hipLaunchCooperativeKernel((const void*)mk, dim3(grid_blocks), dim3(NTHREADS), args, LDS_BYTES, stream);
  if (e != hipSuccess) fprintf(stderr, "cooperative launch failed: %s (grid %d)\n", hipGetErrorString(e), grid_blocks);
  if (PROBE_REP >= 0) {
    Params q = p;
    q.out = (float*)((unsigned char*)d_ws + WS_END); q.ph_lo = PROBE_REP; q.ph_hi = PROBE_REP + 1; q.pad = 1;
    void* args2[] = {&q};
    (void)hipLaunchCooperativeKernel((const void*)mk, dim3(grid_blocks), dim3(NTHREADS), args2, LDS_BYTES, stream);
  }
}
```

```cpp
#include <hip/hip_runtime.h>
#include <hip/hip_cooperative_groups.h>
#include <cstdio>
#include <cstdint>
namespace cg = cooperative_groups;

typedef unsigned short bf16_t;
typedef short bf16x8 __attribute__((ext_vector_type(8)));
typedef short s16x4 __attribute__((ext_vector_type(4)));
typedef float f32x16 __attribute__((ext_vector_type(16)));
typedef float f32x4 __attribute__((ext_vector_type(4)));
typedef float f32x2 __attribute__((ext_vector_type(2)));
typedef __bf16 bf2_t __attribute__((ext_vector_type(2)));
typedef unsigned u32x4 __attribute__((ext_vector_type(4)));
typedef unsigned u32x2 __attribute__((ext_vector_type(2)));
#define DI __device__ __forceinline__
#define MFMA32(a, b, c) __builtin_amdgcn_mfma_f32_32x32x16_bf16((a), (b), (c), 0, 0, 0)

struct Params { const float* in[24]; float* out; unsigned char* ws; int ph_lo, ph_hi; int wv, pad; };
#define TIDX (p.wv * 64 + (int)__builtin_amdgcn_mbcnt_hi(~0u, __builtin_amdgcn_mbcnt_lo(~0u, 0u)))
constexpr int LDS_BYTES = 148480;
constexpr int NTHREADS = 512;
constexpr int NPHASE = 10;
#ifndef PROBE_REP
#define PROBE_REP -1
#endif

constexpr int TP = 16384, TS = 1024, TT = 17408, DM = 1024;
constexpr int NCH = 272;
constexpr int PAST = 4096, SKV = 4160;
constexpr float EPS = 1e-6f;
constexpr float LOG2E = 1.4426950408889634f;
enum { I_XP = 0, I_XS, I_CK, I_CV, I_CMK, I_CMV, I_SC, I_SN, I_SM, I_MEMP, I_NG, I_FNG, I_MNG, I_WMKV, I_WINA, I_BGA, I_HGA, I_WOA,
       I_KVNG, I_WKV, I_WINB, I_LAMB, I_SUBG, I_WOB };
constexpr size_t O_Y = 0, O_PC = 17825792, O_PN = 18087936, O_PM = 18088960, O_PK = 18088964, O_PV = 34866180, O_PMK = 51643396,
                 O_PMV = 51905540, O_SC = 52167684, O_SN = 56361988, O_SM = 56378372, O_SK = 56378436, O_SV = 57427012;
constexpr size_t WS_CTR = 0;
constexpr size_t WS_KMAX = 1024;
constexpr size_t WS_TORD = 8192;
constexpr size_t WS_WA = 16384;
constexpr size_t WS_WOA = WS_WA + (size_t)6144 * 1024 * 2;
constexpr size_t WS_WKB = WS_WOA + (size_t)1024 * 1536 * 2;
constexpr size_t WS_WOB = WS_WKB + (size_t)5120 * 1024 * 2;
constexpr size_t WS_WM = WS_WOB + (size_t)1024 * 1536 * 2;
constexpr size_t WS_MEMN = WS_WM + (size_t)2 * 1024 * 1024 * 2;
constexpr size_t WS_MEMK = WS_MEMN + (size_t)2 * 256 * 1024 * 2;
constexpr size_t WS_MEMVT = WS_MEMK + (size_t)2 * 17 * 256 * 512 * 2;
constexpr size_t WS_GATE = WS_MEMVT + (size_t)2 * 17 * 256 * 512 * 2;
constexpr size_t SZ_CH = (size_t)NCH * 4 * 64 * 4;
constexpr size_t WS_GC = WS_GATE + (size_t)TT * 8 * 4;
constexpr size_t WS_MT = WS_GC + SZ_CH;
constexpr size_t WS_WS = WS_MT + SZ_CH;
constexpr size_t WS_WI = WS_WS + SZ_CH;
constexpr size_t WS_AS = WS_WI + SZ_CH;
constexpr size_t WS_BT = WS_AS + SZ_CH;
constexpr size_t WS_DEC = WS_BT + SZ_CH;
constexpr size_t WS_DENI = WS_DEC + 8192;
constexpr size_t WS_DENA = WS_DENI + (size_t)TT * 4 * 4;
constexpr size_t WS_XN = WS_DENA + (size_t)TT * 4 * 4;
constexpr size_t WS_AO = WS_XN + (size_t)TT * 1024 * 2;
constexpr size_t WS_Y1 = WS_AO + (size_t)TT * 1536 * 2;
constexpr size_t WS_KT = WS_Y1 + (size_t)TT * 1024 * 4;
constexpr size_t WS_VTA = WS_KT + (size_t)NCH * 4 * 256 * 64 * 2;
constexpr size_t WS_R1 = WS_VTA + (size_t)NCH * 4 * 256 * 64 * 2;
constexpr size_t SZ_R1 = (size_t)TT * 6144 * 2;
constexpr size_t WS_PB = WS_R1;
constexpr size_t WS_KBP = WS_PB + (size_t)TT * 3072 * 2;
constexpr size_t WS_VTP = WS_KBP + (size_t)TP * 1024 * 2;
constexpr size_t WS_R2 = WS_R1 + SZ_R1;
constexpr size_t WS_HINTER = WS_R2;
constexpr size_t WS_HINTRA = WS_R2 + (size_t)TT * 1024 * 4;
constexpr size_t WS_KBS = WS_R2;
constexpr size_t WS_VTS = WS_KBS + (size_t)16 * SKV * 1024 * 2;
constexpr size_t WS_WVT = WS_VTS + (size_t)16 * SKV * 1024 * 2;
constexpr size_t WS_U = WS_WVT + (size_t)NCH * 4 * 288 * 64 * 2;
constexpr size_t WS_CFAC = WS_U + SZ_CH;
constexpr size_t WS_CLOCC = WS_CFAC + 8192;
constexpr size_t WS_PM = WS_CLOCC + (size_t)256 * 4 * 9 * 8 * 2 * 64 * 16;
constexpr size_t WS_CHS = WS_PM + SZ_CH;
constexpr size_t WS_LD = WS_CHS + 16384;
constexpr size_t WS_CLOC = WS_LD + 8192;
constexpr size_t WS_END = WS_CLOC + (size_t)16 * 36 * 8 * 64 * 16 * 4;
constexpr int GRP = 16;
static_assert(WS_VTP + (size_t)TP * 1024 * 2 <= WS_R2, "R1 overflow");

DI unsigned pk2(float lo, float hi) { f32x2 v = {lo, hi}; return __builtin_bit_cast(unsigned, __builtin_convertvector(v, bf2_t)); }
DI bf16_t f2bf(float x) { return (bf16_t)(pk2(x, 0.f) & 0xffffu); }
DI float bf2f(unsigned v16) { return __uint_as_float(v16 << 16); }
DI float bflo(unsigned u) { return __uint_as_float(u << 16); }
DI float bfhi(unsigned u) { return __uint_as_float(u & 0xffff0000u); }
DI float rbf(float x) { return bflo(pk2(x, 0.f) & 0xffffu); }
DI int crow(int i, int h) { return (i & 3) + 8 * (i >> 2) + 4 * h; }
DI float wave_sum(float v) {
#pragma unroll
  for (int o = 32; o >= 1; o >>= 1) v += __shfl_xor(v, o);
  return v;
}
DI float fexp2(float x) { return __builtin_amdgcn_exp2f(x); }
DI float fexp(float x) { return __builtin_amdgcn_exp2f(x * LOG2E); }
DI float sigmoidf_(float x) { return 1.f / (1.f + __expf(-x)); }
DI float siluf_(float x) { return x / (1.f + __expf(-x)); }
DI bf16x8 pack_acc(const f32x16& x, int s) {
  u32x4 p;
  p[0] = pk2(x[8 * s + 0], x[8 * s + 1]); p[1] = pk2(x[8 * s + 2], x[8 * s + 3]);
  p[2] = pk2(x[8 * s + 4], x[8 * s + 5]); p[3] = pk2(x[8 * s + 6], x[8 * s + 7]);
  return __builtin_bit_cast(bf16x8, p);
}
DI bf16x8 ld16(const void* p) { return *(const bf16x8*)p; }
DI bf16x8 ld8x2(const void* p0, const void* p1) {
  u32x2 a = *(const u32x2*)p0, b = *(const u32x2*)p1; u32x4 r = {a[0], a[1], b[0], b[1]};
  return __builtin_bit_cast(bf16x8, r);
}
DI f32x16 zero16() { f32x16 z; for (int i = 0; i < 16; ++i) z[i] = 0.f; return z; }

DI void transpose_tile(const float* __restrict__ src, size_t ld_s, bf16_t* __restrict__ dst, size_t ld_d, const float* __restrict__ scale,
                       float* scr, int t, bool perm = false) {
  {
    const int c4 = t & 31, rb = t >> 5;
    f32x4 v[4];
#pragma unroll
    for (int i = 0; i < 4; ++i) v[i] = *(const f32x4*)(src + (size_t)(rb + 16 * i) * ld_s + 4 * c4);
#pragma unroll
    for (int i = 0; i < 4; ++i) {
      const int r = rb + 16 * i;
      f32x4 x = v[i];
      if (scale) { const float sc = scale[r]; x = x * sc; }
      float* d = scr + r * 129 + 4 * c4; d[0] = x[0]; d[1] = x[1]; d[2] = x[2]; d[3] = x[3];
    }
  }
  __syncthreads();
#pragma unroll
  for (int i = 0; i < 2; ++i) {
    const int id = t + 512 * i, c = id >> 3, rg = id & 7;
    const float* s = scr + (8 * rg) * 129 + c;
    u32x4 o; o[0] = pk2(s[0], s[129]); o[1] = pk2(s[2 * 129], s[3 * 129]); o[2] = pk2(s[4 * 129], s[5 * 129]); o[3] = pk2(s[6 * 129], s[7 * 129]);
    if (!perm) *(u32x4*)(dst + (size_t)c * ld_d + 8 * rg) = o;
    else {
      bf16_t* d = dst + (size_t)c * ld_d + 16 * (rg >> 1) + 4 * (rg & 1);
      u32x2 lo = {o[0], o[1]}, hi = {o[2], o[3]};
      *(u32x2*)d = lo; *(u32x2*)(d + 8) = hi;
    }
  }
  __syncthreads();
}

struct TJob { const float* src; size_t ld_s; bf16_t* dst; size_t ld_d; const float* scale; int tr, tc; };

DI void run_tjob_tile(const TJob& j, int tile, float* scr, int tid, bool perm = false) {
  const int ir = tile / j.tc, ic = tile % j.tc;
  transpose_tile(j.src + (size_t)(64 * ir) * j.ld_s + 128 * ic, j.ld_s, j.dst + (size_t)(128 * ic) * j.ld_d + 64 * ir, j.ld_d,
                 j.scale ? j.scale + 64 * ir : nullptr, scr, tid, perm);
}

DI float row_load_rstd(const float* xrow, f32x4 (&v)[4], int lane) {
  float ss = 0.f;
#pragma unroll
  for (int j = 0; j < 4; ++j) { v[j] = *(const f32x4*)(xrow + 4 * lane + 256 * j); ss += v[j][0] * v[j][0] + v[j][1] * v[j][1] + v[j][2] * v[j][2] + v[j][3] * v[j][3]; }
  ss = wave_sum(ss);
  return __builtin_amdgcn_rsqf(ss * (1.f / 1024.f) + EPS);
}

DI int diff_window(int hd) { const float sl2 = exp2f(-(float)(hd + 1)) * LOG2E; return (int)floorf((63.f + 192.f / sl2) * (1.f / 64.f)); }
DI int diff_est(int a) {
  const int hd = a & 7;
  const int w = diff_window(hd) + (a < 1024 ? 2 : 1);
  const int n = a < 1024 ? 2 * (a >> 3) + 2 : 65;
  return n < w ? n : w;
}

DI void phase0(const Params& p, unsigned char* lds) {
  const int tid = TIDX, lane = tid & 63, wid = tid >> 6;
  unsigned char* ws = p.ws;
  if (blockIdx.x == 0 && tid < 64) ((unsigned*)(ws + WS_CTR))[tid] = 0u;
  if (blockIdx.x == 0 && tid < 272) ((unsigned*)(ws + WS_KMAX))[tid] = 0u;
  if (blockIdx.x == 1) {
    int* est = (int*)lds;
    for (int a = tid; a < 1152; a += NTHREADS) est[a] = diff_est(a);
    __syncthreads();
    for (int a = tid; a < 1152; a += NTHREADS) {
      const int ea = est[a];
      int rank = 0;
      for (int b = 0; b < 1152; ++b) { const int eb = est[b]; rank += (eb > ea) || (eb == ea && b < a); }
      ((int*)(ws + WS_TORD))[rank] = a;
    }
    __syncthreads();
  }
  {
    TJob jobs[8];
    jobs[0] = {p.in[I_WINA], 6152, (bf16_t*)(ws + WS_WA), 1024, p.in[I_NG], 16, 40};
    jobs[1] = {p.in[I_WINA] + 5128, 6152, (bf16_t*)(ws + WS_WA) + (size_t)5120 * 1024, 1024, p.in[I_NG], 16, 8};
    jobs[2] = {p.in[I_WOA], 1024, (bf16_t*)(ws + WS_WOA), 1536, nullptr, 24, 8};
    jobs[3] = {p.in[I_WKV], 2048, (bf16_t*)(ws + WS_WKB), 1024, p.in[I_KVNG], 16, 16};
    jobs[4] = {p.in[I_WINB], 3072, (bf16_t*)(ws + WS_WKB) + (size_t)2048 * 1024, 1024, p.in[I_NG] + 1024, 16, 24};
    jobs[5] = {p.in[I_WOB], 1024, (bf16_t*)(ws + WS_WOB), 1536, nullptr, 24, 8};
    jobs[6] = {p.in[I_WMKV], 1024, (bf16_t*)(ws + WS_WM), 1024, nullptr, 16, 8};
    jobs[7] = {p.in[I_WMKV] + (size_t)1024 * 1024, 1024, (bf16_t*)(ws + WS_WM) + (size_t)1024 * 1024, 1024, nullptr, 16, 8};
    int base = 0;
#pragma unroll
    for (int j = 0; j < 8; ++j) {
      const int n = jobs[j].tr * jobs[j].tc;
      for (int t = blockIdx.x; t < n; t += gridDim.x) run_tjob_tile(jobs[j], t, (float*)lds, tid);
      base += n;
    }
    for (int t = blockIdx.x; t < 128 * 4; t += gridDim.x) {
      const int jb = t >> 2, tile = t & 3, l = jb >> 6, b = (jb >> 2) & 15, h = jb & 3;
      TJob j = {p.in[I_CMV] + ((size_t)(l * 16 + b) * 256) * 512 + h * 128, 512,
                (bf16_t*)(ws + WS_MEMVT) + ((size_t)(l * 17 + 1 + b) * 4 + h) * 128 * 256, 256, nullptr, 4, 1};
      run_tjob_tile(j, tile, (float*)lds, tid, true);
    }
  }
  {
    const size_t n8 = (size_t)2 * 16 * 256 * 512 / 8;
    for (size_t i = (size_t)blockIdx.x * NTHREADS + tid; i < n8; i += (size_t)gridDim.x * NTHREADS) {
      const size_t e = i * 8; const int l = (int)(e / ((size_t)16 * 131072)); const size_t rem = e - (size_t)l * 16 * 131072;
      const f32x4 a = *(const f32x4*)(p.in[I_CMK] + e), b = *(const f32x4*)(p.in[I_CMK] + e + 4);
      u32x4 o = {pk2(a[0], a[1]), pk2(a[2], a[3]), pk2(b[0], b[1]), pk2(b[2], b[3])};
      *(u32x4*)((bf16_t*)(ws + WS_MEMK) + ((size_t)(l * 17 + 1) * 131072) + rem) = o;
    }
  }
  {
    const int gw = blockIdx.x * 8 + wid, nw = gridDim.x * 8;
    const float* ng = p.in[I_NG];
    float* gwt = (float*)(lds + 32768);
    float* sg = (float*)(lds + 65536);
    __syncthreads();
    for (int i = tid; i < 8192; i += NTHREADS) { const int k = i >> 3, c = i & 7; gwt[i] = p.in[I_WINA][(size_t)k * 6152 + 5120 + c] * ng[k]; }
    __syncthreads();
    for (int cc = blockIdx.x; cc < NCH; cc += gridDim.x) {
      for (int ri = 0; ri < 8; ++ri) {
        const int r = cc * 64 + wid * 8 + ri;
        const float* xrow = r < TP ? p.in[I_XP] + (size_t)r * 1024 : p.in[I_XS] + (size_t)(r - TP) * 1024;
        f32x4 v[4];
        const float rstd = row_load_rstd(xrow, v, lane);
        float gacc[8];
#pragma unroll
        for (int c = 0; c < 8; ++c) gacc[c] = 0.f;
        bf16_t* xn = (bf16_t*)(ws + WS_XN) + (size_t)r * 1024;
#pragma unroll
        for (int j = 0; j < 4; ++j) {
          const int k0 = 4 * lane + 256 * j;
          const f32x4 xs = v[j] * rstd;
          u32x2 o = {pk2(xs[0], xs[1]), pk2(xs[2], xs[3])};
          *(u32x2*)(xn + k0) = o;
#pragma unroll
          for (int e = 0; e < 4; ++e) {
            const float* wr = gwt + (k0 + e) * 8;
            const f32x4 w0 = *(const f32x4*)wr, w1 = *(const f32x4*)(wr + 4);
            gacc[0] += xs[e] * w0[0]; gacc[1] += xs[e] * w0[1]; gacc[2] += xs[e] * w0[2]; gacc[3] += xs[e] * w0[3];
            gacc[4] += xs[e] * w1[0]; gacc[5] += xs[e] * w1[1]; gacc[6] += xs[e] * w1[2]; gacc[7] += xs[e] * w1[3];
          }
        }
#pragma unroll
        for (int c = 0; c < 8; ++c) gacc[c] = wave_sum(gacc[c]);
        if (lane < 8) {
          float gv = gacc[0];
#pragma unroll
          for (int c = 1; c < 8; ++c) gv = lane == c ? gacc[c] : gv;
          gv += p.in[I_BGA][lane];
          if (lane >= 4) gv = fminf(gv, 0.f) - log1pf(__expf(-fabsf(gv)));
          sg[(wid * 8 + ri) * 8 + lane] = gv;
        }
      }
      __syncthreads();
      if (wid < 4) {
        const int hd = wid, pr = cc * 4 + hd;
        const float ig = sg[lane * 8 + hd], lf = sg[lane * 8 + 4 + hd];
        float g = lf;
#pragma unroll
        for (int o = 1; o < 64; o <<= 1) { const float t = __shfl_up(g, o); if (lane >= o) g += t; }
        const float a = ig - g;
        float pm = a;
#pragma unroll
        for (int o = 1; o < 64; o <<= 1) { const float t = __shfl_up(pm, o); if (lane >= o) pm = fmaxf(pm, t); }
        const size_t o = (size_t)pr * 64 + lane;
        ((float*)(ws + WS_GC))[o] = g;
        ((float*)(ws + WS_AS))[o] = a;
        ((float*)(ws + WS_PM))[o] = pm;
        if (lane == 63) { ((float*)(ws + WS_CHS))[pr * 2] = g; ((float*)(ws + WS_CHS))[pr * 2 + 1] = pm; }
        const float u = __expf(a - __shfl(pm, 63));
        ((float*)(ws + WS_U))[o] = u;
        bf16_t* wr = (bf16_t*)(ws + WS_WVT) + ((size_t)pr * 288 + 256) * 64 + lane;
        wr[0] = f2bf(u);
#pragma unroll 4
        for (int rr = 1; rr < 32; ++rr) wr[rr * 64] = 0;
      }
      __syncthreads();
    }
    for (int r = gw; r < 512; r += nw) {
      const int l = r >> 8, rr = r & 255;
      f32x4 v[4];
      const float rstd = row_load_rstd(p.in[I_MEMP] + (size_t)rr * 1024, v, lane);
      bf16_t* o = (bf16_t*)(ws + WS_MEMN) + (size_t)r * 1024;
#pragma unroll
      for (int j = 0; j < 4; ++j) {
        const int k0 = 4 * lane + 256 * j;
        const f32x4 g = *(const f32x4*)(p.in[I_MNG] + l * 1024 + k0);
        const f32x4 xs = v[j] * rstd * g;
        u32x2 ov = {pk2(xs[0], xs[1]), pk2(xs[2], xs[3])};
        *(u32x2*)(o + k0) = ov;
      }
    }
  }
}

constexpr int G_STAGE = 49152;
struct GemmAcc { f32x16 a[2][2]; };
DI void dma16(const void* g, unsigned char* l) { __builtin_amdgcn_global_load_lds((const unsigned*)g, (unsigned*)l, 16, 0, 0); }

template <int NB = 2>
DI void gemm_tile(const bf16_t* __restrict__ A, size_t lda, const bf16_t* __restrict__ Bt, size_t ldb, int K, unsigned char* lds, GemmAcc& acc, int tid) {
  const int lane = tid & 63, wid = __builtin_amdgcn_readfirstlane(tid >> 6), r = lane & 31, h = lane >> 5;
  const int wr = wid >> 1, wc = wid & 1;
#pragma unroll
  for (int a = 0; a < 2; ++a)
#pragma unroll
    for (int b = 0; b < 2; ++b) acc.a[a][b] = zero16();
  const int nk = K / 64;
  unsigned aoff[4], boff[2];
#pragma unroll
  for (int e = 0; e < 4; ++e) { const int row = 8 * (wid * 4 + e) + (lane >> 3), lc = (lane & 7) ^ ((row >> 1) & 7); aoff[e] = (unsigned)row * (unsigned)lda + 8u * lc; }
#pragma unroll
  for (int e = 0; e < NB; ++e) { const int row = 8 * (wid * NB + e) + (lane >> 3), lc = (lane & 7) ^ ((row >> 1) & 7); boff[e] = (unsigned)row * (unsigned)ldb + 8u * lc; }
  auto issue = [&](int kt, int buf) {
    unsigned char* base = lds + buf * G_STAGE;
#pragma unroll
    for (int e = 0; e < 4; ++e) dma16(A + (aoff[e] + 64u * kt), base + (wid * 4 + e) * 1024);
#pragma unroll
    for (int e = 0; e < NB; ++e) dma16(Bt + (boff[e] + 64u * kt), base + 32768 + (wid * NB + e) * 1024);
  };
  asm volatile("s_waitcnt vmcnt(0)" ::: "memory");
  __syncthreads();
  issue(0, 0);
  if (nk > 1) issue(1, 1);
  const unsigned sw = (r >> 1) & 7;
  unsigned co[4];
#pragma unroll
  for (int kk = 0; kk < 4; ++kk) co[kk] = (((2 * kk + h) ^ sw) << 4);
  const unsigned ra = (wr * 64 + r) * 128, rb = 32768 + (wc * 32 * NB + r) * 128;
  for (int kt = 0; kt < nk; ++kt) {
    if (kt + 1 < nk) { if (NB == 2) asm volatile("s_waitcnt vmcnt(6)" ::: "memory"); else asm volatile("s_waitcnt vmcnt(5)" ::: "memory"); }
    else asm volatile("s_waitcnt vmcnt(0)" ::: "memory");
    asm volatile("s_waitcnt lgkmcnt(0)" ::: "memory");
    __builtin_amdgcn_s_barrier();
    if (kt + 2 < nk) issue(kt + 2, (kt + 2) % 3);
    const unsigned char* base = lds + (kt % 3) * G_STAGE;
    const unsigned char* pa = base + ra;
    const unsigned char* pb = base + rb;
#pragma unroll
    for (int kk = 0; kk < 4; ++kk) {
      const bf16x8 a0 = ld16(pa + co[kk]), a1 = ld16(pa + 4096 + co[kk]);
      const bf16x8 b0 = ld16(pb + co[kk]);
      acc.a[0][0] = MFMA32(a0, b0, acc.a[0][0]);
      acc.a[1][0] = MFMA32(a1, b0, acc.a[1][0]);
      if (NB == 2) {
        const bf16x8 b1 = ld16(pb + 4096 + co[kk]);
        acc.a[0][1] = MFMA32(a0, b1, acc.a[0][1]);
        acc.a[1][1] = MFMA32(a1, b1, acc.a[1][1]);
      }
    }
  }
}

DI void gemm256(const bf16_t* __restrict__ A, size_t lda, const bf16_t* __restrict__ Bt, size_t ldb, int K, unsigned char* lds, GemmAcc (&acc)[2], int tid) {
  const int lane = tid & 63, wid = __builtin_amdgcn_readfirstlane(tid >> 6), r = lane & 31, h = lane >> 5;
  const int wr = wid >> 2, wc = wid & 3;
#pragma unroll
  for (int mh = 0; mh < 2; ++mh)
#pragma unroll
    for (int a = 0; a < 2; ++a)
#pragma unroll
      for (int b = 0; b < 2; ++b) acc[mh].a[a][b] = zero16();
  const int nk = K / 64;
  unsigned aoff[4], boff[4];
#pragma unroll
  for (int e = 0; e < 4; ++e) {
    const int row = 8 * (wid * 4 + e) + (lane >> 3), lc = (lane & 7) ^ ((row >> 1) & 7);
    aoff[e] = (unsigned)row * (unsigned)lda + 8u * lc; boff[e] = (unsigned)row * (unsigned)ldb + 8u * lc;
  }
  auto issue = [&](int kt, int buf) {
    unsigned char* base = lds + buf * 65536;
#pragma unroll
    for (int e = 0; e < 4; ++e) { dma16(A + (aoff[e] + 64u * kt), base + (wid * 4 + e) * 1024); dma16(Bt + (boff[e] + 64u * kt), base + 32768 + (wid * 4 + e) * 1024); }
  };
  asm volatile("s_waitcnt vmcnt(0)" ::: "memory");
  __syncthreads();
  issue(0, 0);
  const unsigned sw = (r >> 1) & 7;
  unsigned co[4];
#pragma unroll
  for (int kk = 0; kk < 4; ++kk) co[kk] = (((2 * kk + h) ^ sw) << 4);
  const unsigned ra = (wr * 128 + r) * 128, rb = 32768 + (wc * 64 + r) * 128;
  for (int kt = 0; kt < nk; ++kt) {
    asm volatile("s_waitcnt vmcnt(0)" ::: "memory");
    asm volatile("s_waitcnt lgkmcnt(0)" ::: "memory");
    __builtin_amdgcn_s_barrier();
    if (kt + 1 < nk) issue(kt + 1, (kt + 1) & 1);
    const unsigned char* base = lds + (kt & 1) * 65536;
    const unsigned char* pa = base + ra;
    const unsigned char* pb = base + rb;
#pragma unroll
    for (int kk = 0; kk < 4; ++kk) {
      const bf16x8 b0 = ld16(pb + co[kk]), b1 = ld16(pb + 4096 + co[kk]);
#pragma unroll
      for (int mh = 0; mh < 2; ++mh) {
        const bf16x8 a0 = ld16(pa + 8192 * mh + co[kk]), a1 = ld16(pa + 8192 * mh + 4096 + co[kk]);
        acc[mh].a[0][0] = MFMA32(a0, b0, acc[mh].a[0][0]);
        acc[mh].a[0][1] = MFMA32(a0, b1, acc[mh].a[0][1]);
        acc[mh].a[1][0] = MFMA32(a1, b0, acc[mh].a[1][0]);
        acc[mh].a[1][1] = MFMA32(a1, b1, acc[mh].a[1][1]);
      }
    }
  }
}

DI void gate_scan(const Params& p, unsigned char* lds) {
  const int tid = TIDX, lane = tid & 63, wid = tid >> 6;
  unsigned char* ws = p.ws;
  float* s_ch = (float*)lds;
  float* s_mc = s_ch + NCH * 8;
  float* s_mn = s_mc + NCH * 4;
  __syncthreads();
  for (int i = tid; i < NCH * 8; i += NTHREADS) s_ch[i] = ((const float*)(ws + WS_CHS))[i];
  __syncthreads();
  if (tid < 4) {
    float m = 0.f, ld = 0.f;
    float* LD = (float*)(ws + WS_LD);
    const bool wr = blockIdx.x == 0;
    for (int c = 0; c < 256; ++c) {
      s_mc[c * 4 + tid] = m; if (wr) LD[c * 4 + tid] = ld;
      const float gl = s_ch[(c * 4 + tid) * 2], mn = gl + fmaxf(m, s_ch[(c * 4 + tid) * 2 + 1]);
      ld += gl + m - mn;
      m = mn; s_mn[c * 4 + tid] = m;
    }
    if (wr) { LD[256 * 4 + tid] = ld; p.out[O_PM + tid] = m; }
  } else if (tid >= 64 && tid < 128) {
    const int b = (tid - 64) >> 2, hd = tid & 3, pr = (256 + b) * 4 + hd;
    const float m0 = p.in[I_SM][b * 4 + hd];
    const float m = s_ch[pr * 2] + fmaxf(m0, s_ch[pr * 2 + 1]);
    s_mc[pr] = m0; s_mn[pr] = m;
    if (blockIdx.x == 0) p.out[O_SM + b * 4 + hd] = m;
  }
  __syncthreads();
  for (int cc = blockIdx.x; cc < NCH; cc += gridDim.x) {
    if (wid < 4) {
      const int hd = wid, pr = cc * 4 + hd;
      const size_t o = (size_t)pr * 64 + lane;
      const float g = ((const float*)(ws + WS_GC))[o], a = ((const float*)(ws + WS_AS))[o], pm = ((const float*)(ws + WS_PM))[o];
      const float mc = s_mc[pr], mn = s_mn[pr], gl = s_ch[pr * 2];
      const float mt = g + fmaxf(mc, pm);
      ((float*)(ws + WS_MT))[o] = mt;
      ((float*)(ws + WS_WS))[o] = __expf(gl + a - mn);
      ((float*)(ws + WS_WI))[o] = __expf(g + mc - mt);
      ((float*)(ws + WS_AS))[o] = a * LOG2E;
      ((float*)(ws + WS_BT))[o] = (g - mt) * LOG2E;
      if (lane == 0) { ((float*)(ws + WS_DEC))[pr] = __expf(gl + mc - mn); const float amx = s_ch[pr * 2 + 1]; ((float*)(ws + WS_CFAC))[pr] = __expf(amx - fmaxf(mc, amx)); }
    }
  }
  __syncthreads();
}

DI void phase1(const Params& p, unsigned char* lds) {
  const int tid = TIDX, lane = tid & 63, wid = tid >> 6, r = lane & 31, h = lane >> 5;
  unsigned char* ws = p.ws;
  gate_scan(p, lds);
  const int n_main = 68 * 24, n_mem = 16;
  for (int t = blockIdx.x; t < n_main + n_mem; t += gridDim.x) {
    if (t < n_main) {
      const int tm = t / 24, tn = t % 24, m0 = tm * 256, n0 = tn * 256;
      GemmAcc acc2[2];
      gemm256((const bf16_t*)(ws + WS_XN) + (size_t)m0 * 1024, 1024, (const bf16_t*)(ws + WS_WA) + (size_t)n0 * 1024, 1024, 1024, lds, acc2, tid);
#pragma unroll
      for (int mh = 0; mh < 2; ++mh) {
      const GemmAcc& acc = acc2[mh];
      const int wr = (wid >> 2) * 2 + mh, wc = wid & 3;
      bf16_t* PA = (bf16_t*)(ws + WS_R1);
      const int sec = n0 >> 10;
#pragma unroll
      for (int a = 0; a < 2; ++a)
#pragma unroll
        for (int b = 0; b < 2; ++b) {
          __builtin_amdgcn_sched_barrier(0);
          const int n = n0 + wc * 64 + 32 * b + r, mb = m0 + wr * 64 + 32 * a;
          if (sec != 2) {
            const float sc = sec == 1 ? 0.0625f : 1.f;
            const int pc = (n >> 2) & 3, np = sec <= 1 ? (n & ~15) + 4 * (((pc & 1) << 1) | (pc >> 1)) + (n & 3) : n;
#pragma unroll
            for (int i = 0; i < 16; ++i) PA[(size_t)(mb + crow(i, h)) * 6144 + np] = f2bf(acc.a[a][b][i] * sc);
          }
          if (sec == 1 || sec == 2) {
            const float sc = sec == 1 ? 0.0625f : 1.f;
            const int f = n & 1023, hd = f >> 8, fe = f & 255;
            bf16_t* T = (bf16_t*)(ws + (sec == 1 ? WS_KT : WS_VTA));
#pragma unroll
            for (int g = 0; g < 4; ++g) {
              const int m = mb + 8 * g + 4 * h, cc = m >> 6, s = m & 63;
              u32x2 o = {pk2(acc.a[a][b][4 * g] * sc, acc.a[a][b][4 * g + 1] * sc), pk2(acc.a[a][b][4 * g + 2] * sc, acc.a[a][b][4 * g + 3] * sc)};
              *(u32x2*)(T + (((size_t)cc * 4 + hd) * 256 + fe) * 64 + s) = o;
              if (sec == 2) {
                const f32x4 u = *(const f32x4*)((const float*)(ws + WS_U) + ((size_t)cc * 4 + hd) * 64 + s);
                u32x2 ow = {pk2(acc.a[a][b][4 * g] * u[0], acc.a[a][b][4 * g + 1] * u[1]), pk2(acc.a[a][b][4 * g + 2] * u[2], acc.a[a][b][4 * g + 3] * u[3])};
                *(u32x2*)((bf16_t*)(ws + WS_WVT) + (((size_t)cc * 4 + hd) * 288 + fe) * 64 + s) = ow;
              }
            }
          }
        }
      }
    } else {
      GemmAcc acc;
      const int wr = wid >> 1, wc = wid & 1;
      const int tt = t - n_main, l = tt >> 3, n0 = (tt & 7) * 128;
      gemm_tile((const bf16_t*)(ws + WS_MEMN) + (size_t)l * 256 * 1024, 1024, (const bf16_t*)(ws + WS_WM) + ((size_t)l * 1024 + n0) * 1024, 1024, 1024, lds, acc, tid);
      const bool isv = n0 >= 512;
      float* of = p.out + (isv ? O_PMV : O_PMK) + (size_t)l * 131072;
      bf16_t* mk = (bf16_t*)(ws + WS_MEMK) + (size_t)(l * 17) * 131072;
      bf16_t* mv = (bf16_t*)(ws + WS_MEMVT) + (size_t)(l * 17) * 131072;
#pragma unroll
      for (int a = 0; a < 2; ++a)
#pragma unroll
        for (int b = 0; b < 2; ++b) {
          __builtin_amdgcn_sched_barrier(0);
          const int f = (n0 & 511) + wc * 64 + 32 * b + r, mb = wr * 64 + 32 * a;
#pragma unroll
          for (int g = 0; g < 4; ++g) {
            const int m = mb + 8 * g + 4 * h;
            float* o4 = of + (size_t)m * 512 + f;
            o4[0] = acc.a[a][b][4 * g]; o4[512] = acc.a[a][b][4 * g + 1]; o4[1024] = acc.a[a][b][4 * g + 2]; o4[1536] = acc.a[a][b][4 * g + 3];
            if (!isv) {
              bf16_t* k4 = mk + (size_t)m * 512 + f;
              k4[0] = f2bf(acc.a[a][b][4 * g]); k4[512] = f2bf(acc.a[a][b][4 * g + 1]); k4[1024] = f2bf(acc.a[a][b][4 * g + 2]); k4[1536] = f2bf(acc.a[a][b][4 * g + 3]);
            } else {
              u32x2 o = {pk2(acc.a[a][b][4 * g], acc.a[a][b][4 * g + 1]), pk2(acc.a[a][b][4 * g + 2], acc.a[a][b][4 * g + 3])};
              const int pq = (m >> 2) & 3, mp = (m & ~15) + 4 * (((pq & 1) << 1) | (pq >> 1));
              *(u32x2*)(mv + (size_t)f * 256 + mp) = o;
            }
          }
        }
    }
  }
}

DI void scan_task(const Params& p, unsigned char* lds, int sb  , int hd, int j, int grp) {
  const int tid = TIDX, lane = tid & 63, wid = tid >> 6, r = lane & 31, h = lane >> 5;
  unsigned char* ws = p.ws;
  const int cc0 = sb < 0 ? GRP * grp : 256 + sb, nch = sb < 0 ? GRP : 1;
  const bf16_t* PA = (const bf16_t*)(ws + WS_R1);
  const bf16_t* KT = (const bf16_t*)(ws + WS_KT);
  const bf16_t* VT = (const bf16_t*)(ws + WS_VTA);
  const float* WSa = (const float*)(ws + WS_WS);
  const float* WIa = (const float*)(ws + WS_WI);
  const float* DEC = (const float*)(ws + WS_DEC);
  float* red = (float*)lds;
  const bool nsl = j == 8;
  f32x16 S = zero16();
  if (sb >= 0) {
    if (!nsl) {
      const float* C0 = p.in[I_SC] + ((size_t)(sb * 4 + hd) * 256 + 32 * j + r) * 256 + 32 * wid;
#pragma unroll
      for (int g = 0; g < 4; ++g) { const f32x4 c = *(const f32x4*)(C0 + 8 * g + 4 * h); S[4 * g] = c[0]; S[4 * g + 1] = c[1]; S[4 * g + 2] = c[2]; S[4 * g + 3] = c[3]; }
    } else if (r == 0) {
      const float* n0 = p.in[I_SN] + (size_t)(sb * 4 + hd) * 256 + 32 * wid;
#pragma unroll
      for (int g = 0; g < 4; ++g) { const f32x4 c = *(const f32x4*)(n0 + 8 * g + 4 * h); S[4 * g] = c[0]; S[4 * g + 1] = c[1]; S[4 * g + 2] = c[2]; S[4 * g + 3] = c[3]; }
    }
  }
  bf16x8 kt[4], wv[4], qf[2][2];
  u32x4 ktn[4], vn[4], qn[2][2];
  float wsn;
  float* wsl = (float*)(lds + 69632);
  auto loadraw = [&](int cc) {
    const size_t ch = (size_t)cc * 4 + hd;
    const bf16_t* kp = KT + (ch * 256 + 32 * wid + r) * 64 + 8 * h;
#pragma unroll
    for (int st = 0; st < 4; ++st) ktn[st] = *(const u32x4*)(kp + 16 * st);
    wsn = WSa[ch * 64 + lane];
    if (!nsl) {
      const bf16_t* vp = VT + (ch * 256 + 32 * j + r) * 64 + 8 * h;
#pragma unroll
      for (int st = 0; st < 4; ++st) vn[st] = *(const u32x4*)(vp + 16 * st);
    }
#pragma unroll
    for (int tt = 0; tt < 2; ++tt) {
      const bf16_t* qp = PA + (size_t)(cc * 64 + 32 * tt + r) * 6144 + hd * 256 + 32 * wid + 8 * h;
#pragma unroll
      for (int s2 = 0; s2 < 2; ++s2) qn[tt][s2] = *(const u32x4*)(qp + 16 * s2);
    }
  };
  auto convert = [&]() {
    __syncthreads();
    if (wid == 0) wsl[lane] = wsn;
    __syncthreads();
#pragma unroll
    for (int st = 0; st < 4; ++st) {
      kt[st] = __builtin_bit_cast(bf16x8, ktn[st]);
      const f32x4 w0 = *(const f32x4*)(wsl + 16 * st + 8 * h), w1 = *(const f32x4*)(wsl + 16 * st + 8 * h + 4);
      u32x4 o;
      if (!nsl) {
        const u32x4 v = vn[st];
        o[0] = pk2(bflo(v[0]) * w0[0], bfhi(v[0]) * w0[1]); o[1] = pk2(bflo(v[1]) * w0[2], bfhi(v[1]) * w0[3]);
        o[2] = pk2(bflo(v[2]) * w1[0], bfhi(v[2]) * w1[1]); o[3] = pk2(bflo(v[3]) * w1[2], bfhi(v[3]) * w1[3]);
      } else {
        o = (u32x4){pk2(w0[0], w0[1]), pk2(w0[2], w0[3]), pk2(w1[0], w1[1]), pk2(w1[2], w1[3])};
        if (r != 0) o = (u32x4){0u, 0u, 0u, 0u};
      }
      wv[st] = __builtin_bit_cast(bf16x8, o);
    }
#pragma unroll
    for (int tt = 0; tt < 2; ++tt)
#pragma unroll
      for (int s2 = 0; s2 < 2; ++s2) qf[tt][s2] = __builtin_bit_cast(bf16x8, qn[tt][s2]);
  };
  loadraw(cc0);
  convert();
  for (int c = 0; c < nch; ++c) {
    const int cc = cc0 + c;
    if (c + 1 < nch) loadraw(cc + 1);
    const float dec = DEC[cc * 4 + hd];
    const bf16x8 xs0 = pack_acc(S, 0), xs1 = pack_acc(S, 1);
    f32x16 z0 = MFMA32(xs0, qf[0][0], zero16()); z0 = MFMA32(xs1, qf[0][1], z0);
    f32x16 z1 = MFMA32(xs0, qf[1][0], zero16()); z1 = MFMA32(xs1, qf[1][1], z1);
    S = S * dec;
#pragma unroll
    for (int st = 0; st < 4; ++st) S = MFMA32(kt[st], wv[st], S);
    __syncthreads();
    {
      float* rw = red + wid * (64 * 33);
#pragma unroll
      for (int i = 0; i < 16; ++i) { rw[r * 33 + crow(i, h)] = z0[i]; rw[(32 + r) * 33 + crow(i, h)] = z1[i]; }
    }
    __syncthreads();
    {
      const int v = tid & 31;
#pragma unroll
      for (int e = 0; e < 4; ++e) {
        const int t = (tid >> 5) + 16 * e;
        float s = 0.f;
#pragma unroll
        for (int w8 = 0; w8 < 8; ++w8) s += red[w8 * (64 * 33) + t * 33 + v];
        const float wi = WIa[((size_t)cc * 4 + hd) * 64 + t];
        if (!nsl) ((float*)(ws + WS_HINTER))[(size_t)(cc * 64 + t) * 1024 + hd * 256 + 32 * j + v] = s * wi;
        else if (v == 0) ((float*)(ws + WS_DENI))[(size_t)(cc * 64 + t) * 4 + hd] = s * wi;
      }
    }
    if (c + 1 < nch) convert();
  }
  if (sb < 0) {
    float* cl = (float*)(ws + WS_CLOC) + ((((size_t)(grp * 4 + hd) * 9 + j) * 8 + wid) * 64 + lane) * 16;
#pragma unroll
    for (int g = 0; g < 4; ++g) { f32x4 c = {S[4 * g], S[4 * g + 1], S[4 * g + 2], S[4 * g + 3]}; *(f32x4*)(cl + 4 * g) = c; }
  } else {
    if (!nsl) {
      float* Co = (sb < 0 ? p.out + O_PC + (size_t)hd * 65536 : p.out + O_SC + (size_t)(sb * 4 + hd) * 65536) + (size_t)(32 * j + r) * 256 + 32 * wid;
#pragma unroll
      for (int g = 0; g < 4; ++g) { f32x4 c = {S[4 * g], S[4 * g + 1], S[4 * g + 2], S[4 * g + 3]}; *(f32x4*)(Co + 8 * g + 4 * h) = c; }
    } else if (r == 0) {
      float* no = (sb < 0 ? p.out + O_PN + (size_t)hd * 256 : p.out + O_SN + (size_t)(sb * 4 + hd) * 256) + 32 * wid;
#pragma unroll
      for (int g = 0; g < 4; ++g) { f32x4 c = {S[4 * g], S[4 * g + 1], S[4 * g + 2], S[4 * g + 3]}; *(f32x4*)(no + 8 * g + 4 * h) = c; }
    }
  }
  __syncthreads();
}

DI void intra_task(const Params& p, int cc, int hd) {
  const int tid = TIDX, lane = tid & 63, wid = tid >> 6, r = lane & 31, h = lane >> 5;
  unsigned char* ws = p.ws;
  const int tt = wid & 1, vq = wid >> 1;
  const bf16_t* PA = (const bf16_t*)(ws + WS_R1);
  const bf16_t* VT = (const bf16_t*)(ws + WS_VTA);
  const size_t ch = (size_t)cc * 4 + hd;
  f32x16 s0 = zero16(), s1 = zero16();
  {
    const bf16_t* qp = PA + (size_t)(cc * 64 + 32 * tt + r) * 6144 + hd * 256 + 8 * h;
    const bf16_t* kp = PA + (size_t)(cc * 64 + r) * 6144 + 1024 + hd * 256 + 8 * h;
#pragma unroll 4
    for (int kk = 0; kk < 16; ++kk) {
      const bf16x8 q = ld16(qp + 16 * kk), k0 = ld16(kp + 16 * kk), k1 = ld16(kp + (size_t)32 * 6144 + 16 * kk);
      s0 = MFMA32(k0, q, s0);
      if (tt == 1) s1 = MFMA32(k1, q, s1);
    }
  }
  const int t = 32 * tt + r;
  const float bt = ((const float*)(ws + WS_BT))[ch * 64 + t];
  const float* asp = (const float*)(ws + WS_AS) + ch * 64;
  float den = 0.f;
#pragma unroll
  for (int g = 0; g < 4; ++g) {
    const f32x4 a0 = *(const f32x4*)(asp + 8 * g + 4 * h);
    const f32x4 a1 = *(const f32x4*)(asp + 32 + 8 * g + 4 * h);
#pragma unroll
    for (int e = 0; e < 4; ++e) {
      const int s = 8 * g + 4 * h + e;
      const float w0 = s <= t ? fexp2(bt + a0[e]) : 0.f;
      const float w1 = (32 + s) <= t ? fexp2(bt + a1[e]) : 0.f;
      s0[4 * g + e] *= w0; s1[4 * g + e] *= w1;
      den += s0[4 * g + e] + s1[4 * g + e];
    }
  }
  den += __shfl_xor(den, 32);
  if (vq == 0 && h == 0) ((float*)(ws + WS_DENA))[(size_t)(cc * 64 + t) * 4 + hd] = den;
  bf16x8 pf[2][2];
  pf[0][0] = pack_acc(s0, 0); pf[0][1] = pack_acc(s0, 1); pf[1][0] = pack_acc(s1, 0); pf[1][1] = pack_acc(s1, 1);
  float* Ho = (float*)(ws + WS_HINTRA) + (size_t)(cc * 64 + t) * 1024 + hd * 256;
#pragma unroll
  for (int vt = 0; vt < 2; ++vt) {
    const int v0 = vq * 64 + vt * 32;
    const bf16_t* vp = VT + (ch * 256 + v0 + r) * 64 + 4 * h;
    f32x16 o = zero16();
#pragma unroll
    for (int st = 0; st < 2; ++st)
#pragma unroll
      for (int s2 = 0; s2 < 2; ++s2) {
        const bf16x8 a = ld8x2(vp + 32 * st + 16 * s2, vp + 32 * st + 16 * s2 + 8);
        o = MFMA32(a, pf[st][s2], o);
      }
#pragma unroll
    for (int g = 0; g < 4; ++g) { f32x4 c = {o[4 * g], o[4 * g + 1], o[4 * g + 2], o[4 * g + 3]}; *(f32x4*)(Ho + v0 + 8 * g + 4 * h) = c; }
  }
}

DI void memattn_task(const Params& p, unsigned char* lds, int task, int layer, const bf16_t* Qb, const bf16_t* Zb, unsigned ldq) {
  const int tid = TIDX, lane = tid & 63, wid = __builtin_amdgcn_readfirstlane(tid >> 6), r = lane & 31, h = lane >> 5;
  unsigned char* ws = p.ws;
  const bool prm = task < 256;
  const int hd = task & 3, ti = prm ? task >> 2 : (task - 256) >> 2;
  const int sbi = prm ? 0 : 1 + ti, tok0 = prm ? ti * 256 : TP + ti * 64, nact = prm ? 8 : 2;
  const bf16_t* MK = (const bf16_t*)(ws + WS_MEMK) + (size_t)(layer * 17 + sbi) * 131072 + hd * 128;
  const bf16_t* MV = (const bf16_t*)(ws + WS_MEMVT) + ((size_t)(layer * 17 + sbi) * 4 + hd) * 128 * 256;
  asm volatile("s_waitcnt vmcnt(0)" ::: "memory");
  __syncthreads();
#pragma unroll
  for (int e = 0; e < 8; ++e) {
    const int q = wid * 8 + e;
    { const int row = 4 * q + (lane >> 4), lc = (lane & 15) ^ (row & 15); dma16(MK + ((unsigned)row * 512u + 8u * lc), lds + q * 1024); }
    { const int row = 2 * q + (lane >> 5), lc = (lane & 31) ^ (row & 15); dma16(MV + ((unsigned)row * 256u + 8u * lc), lds + 65536 + q * 1024); }
  }
  const int tok = tok0 + (wid < nact ? wid : 0) * 32 + r;
  bf16x8 qf[8];
  {
    const bf16_t* qp = Qb + ((unsigned)tok * ldq + hd * 128 + 8 * h);
#pragma unroll
    for (int kk = 0; kk < 8; ++kk) qf[kk] = ld16(qp + 16 * kk);
  }
  asm volatile("s_waitcnt vmcnt(0)" ::: "memory");
  __syncthreads();
  if (wid >= nact) return;
  const float sc = 0.08838834764831845f * LOG2E;
  f32x16 O[4];
#pragma unroll
  for (int vt = 0; vt < 4; ++vt) O[vt] = zero16();
  float mrun = -1e30f, l = 0.f;
  const unsigned sw = r & 15;
#pragma unroll 1
  for (int kb = 0; kb < 4; ++kb) {
    f32x16 s0 = zero16(), s1 = zero16();
    const unsigned char* kp = lds + (kb * 64 + r) * 256;
#pragma unroll
    for (int kk = 0; kk < 8; ++kk) {
      const unsigned co = ((unsigned)(2 * kk + h) ^ sw) << 4;
      const bf16x8 k0 = ld16(kp + co), k1 = ld16(kp + 8192 + co);
      s0 = MFMA32(k0, qf[kk], s0); s1 = MFMA32(k1, qf[kk], s1);
    }
    float mx = -1e30f;
#pragma unroll
    for (int i = 0; i < 16; ++i) mx = fmaxf(mx, fmaxf(s0[i], s1[i]));
    mx = fmaxf(mx, __shfl_xor(mx, 32)) * sc;
    const float mnew = fmaxf(mrun, mx), alpha = fexp2(mrun - mnew);
    mrun = mnew;
    float sum = 0.f;
#pragma unroll
    for (int i = 0; i < 16; ++i) { s0[i] = fexp2(s0[i] * sc - mnew); s1[i] = fexp2(s1[i] * sc - mnew); sum += s0[i] + s1[i]; }
    l = l * alpha + sum;
#pragma unroll
    for (int vt = 0; vt < 4; ++vt) O[vt] = O[vt] * alpha;
    bf16x8 pf[2][2];
    pf[0][0] = pack_acc(s0, 0); pf[0][1] = pack_acc(s0, 1); pf[1][0] = pack_acc(s1, 0); pf[1][1] = pack_acc(s1, 1);
#pragma unroll
    for (int vt = 0; vt < 4; ++vt) {
      const unsigned char* vp = lds + 65536 + (32 * vt + r) * 512;
#pragma unroll
      for (int st = 0; st < 2; ++st)
#pragma unroll
        for (int s2 = 0; s2 < 2; ++s2) {
          const unsigned co = ((unsigned)(8 * kb + 4 * st + 2 * s2 + h) ^ sw) << 4;
          O[vt] = MFMA32(ld16(vp + co), pf[st][s2], O[vt]);
        }
    }
  }
  l += __shfl_xor(l, 32);
  const float inv = 1.f / l;
  const bf16_t* zp = Zb + ((unsigned)tok * ldq + hd * 128);
  bf16_t* op = (bf16_t*)(ws + WS_AO) + ((unsigned)tok * 1536u + 1024 + hd * 128);
#pragma unroll
  for (int vt = 0; vt < 4; ++vt)
#pragma unroll
    for (int g = 0; g < 4; ++g) {
      const int v = 32 * vt + 8 * g + 4 * h;
      const u32x2 z = *(const u32x2*)(zp + v);
      const float o0 = O[vt][4 * g] * inv * siluf_(bflo(z[0])), o1 = O[vt][4 * g + 1] * inv * siluf_(bfhi(z[0]));
      const float o2 = O[vt][4 * g + 2] * inv * siluf_(bflo(z[1])), o3 = O[vt][4 * g + 3] * inv * siluf_(bfhi(z[1]));
      u32x2 o = {pk2(o0, o1), pk2(o2, o3)};
      *(u32x2*)(op + v) = o;
    }
}

DI int next_item(unsigned* ctr, unsigned char* lds_flag_area, int tid) {
  __syncthreads();
  int* sh = (int*)lds_flag_area;
  if (tid == 0) *sh = (int)atomicAdd(ctr, 1u);
  __syncthreads();
  const int v = *sh;
  return v;
}

DI void scanA_task(const Params& p, int hd, int j, int grp);

DI void phase2(const Params& p, unsigned char* lds) {
  unsigned* ctr = (unsigned*)(p.ws + WS_CTR) + 0 + 8 * p.pad;
  const bf16_t* PA = (const bf16_t*)(p.ws + WS_R1);
  const int n_ps = 36 * 16, n_ss = 576, n_in = NCH * 4, n_ma = 256 + 64;
  for (;;) {
    const int it = next_item(ctr, lds + LDS_BYTES - 16, TIDX);
    if (it >= n_ps + n_ss + n_in + n_ma) break;
    if (it < n_ps) scanA_task(p, (it % 36) / 9, it % 9, it / 36);
    else if (it < n_ps + n_ss) { const int q = it - n_ps; scan_task(p, lds, q / 36, (q % 36) / 9, q % 9, 0); }
    else if (it < n_ps + n_ss + n_in) { const int q = it - n_ps - n_ss; intra_task(p, q >> 2, q & 3); }
    else { const int q = it - n_ps - n_ss - n_in; memattn_task(p, lds, q, 0, PA + 5120, PA + 5632, 6144); }
  }
}


DI void scanA_task(const Params& p, int hd, int j, int grp) {
  const int tid = TIDX, lane = tid & 63, wid = tid >> 6, r = lane & 31, h = lane >> 5;
  unsigned char* ws = p.ws;
  const bf16_t* KT = (const bf16_t*)(ws + WS_KT);
  const bf16_t* WV = (const bf16_t*)(ws + WS_WVT);
  f32x16 S = zero16();
  u32x4 kn[4], vn[4];
  auto load = [&](int cc) {
    const size_t ch = (size_t)cc * 4 + hd;
    const bf16_t* kp = KT + (ch * 256 + 32 * wid + r) * 64 + 8 * h;
    const bf16_t* vp = WV + (ch * 288 + 32 * j + r) * 64 + 8 * h;
#pragma unroll
    for (int st = 0; st < 4; ++st) { kn[st] = *(const u32x4*)(kp + 16 * st); vn[st] = *(const u32x4*)(vp + 16 * st); }
  };
  load(GRP * grp);
#pragma unroll 1
  for (int c = 0; c < GRP; ++c) {
    const int cc = GRP * grp + c;
    bf16x8 kt[4], wv[4];
#pragma unroll
    for (int st = 0; st < 4; ++st) { kt[st] = __builtin_bit_cast(bf16x8, kn[st]); wv[st] = __builtin_bit_cast(bf16x8, vn[st]); }
    if (c + 1 < GRP) load(cc + 1);
    u32x4* cl = (u32x4*)(ws + WS_CLOCC) + ((((size_t)cc * 4 + hd) * 9 + j) * 8 + wid) * 128 + lane;
    cl[0] = __builtin_bit_cast(u32x4, pack_acc(S, 0));
    cl[64] = __builtin_bit_cast(u32x4, pack_acc(S, 1));
    f32x16 D = zero16();
#pragma unroll
    for (int st = 0; st < 4; ++st) D = MFMA32(kt[st], wv[st], D);
    const float dec = ((const float*)(ws + WS_DEC))[cc * 4 + hd], cf = ((const float*)(ws + WS_CFAC))[cc * 4 + hd];
    S = S * dec + D * cf;
  }
  float* cl = (float*)(ws + WS_CLOC) + ((((size_t)(grp * 4 + hd) * 9 + j) * 8 + wid) * 64 + lane) * 16;
#pragma unroll
  for (int g = 0; g < 4; ++g) { f32x4 c = {S[4 * g], S[4 * g + 1], S[4 * g + 2], S[4 * g + 3]}; *(f32x4*)(cl + 4 * g) = c; }
}

DI void scanfix_task(const Params& p, unsigned char* lds, int grp, int hd, int j) {
  const int tid = TIDX, lane = tid & 63, wid = tid >> 6, r = lane & 31, h = lane >> 5;
  unsigned char* ws = p.ws;
  const bool nsl = j == 8;
  const float* LD = (const float*)(ws + WS_LD);
  f32x16 S = zero16();
#pragma unroll 4
  for (int gp = 0; gp < grp; ++gp) {
    const float dg = __expf(LD[(GRP * (gp + 1)) * 4 + hd] - LD[(GRP * gp) * 4 + hd]);
    const float* cl = (const float*)(ws + WS_CLOC) + ((((size_t)(gp * 4 + hd) * 9 + j) * 8 + wid) * 64 + lane) * 16;
#pragma unroll
    for (int g = 0; g < 4; ++g) { const f32x4 c = *(const f32x4*)(cl + 4 * g);
      S[4 * g] = S[4 * g] * dg + c[0]; S[4 * g + 1] = S[4 * g + 1] * dg + c[1]; S[4 * g + 2] = S[4 * g + 2] * dg + c[2]; S[4 * g + 3] = S[4 * g + 3] * dg + c[3]; }
  }
  if (grp == 16) {
    if (!nsl) {
      float* Co = p.out + O_PC + (size_t)hd * 65536 + (size_t)(32 * j + r) * 256 + 32 * wid;
#pragma unroll
      for (int g = 0; g < 4; ++g) { f32x4 c = {S[4 * g], S[4 * g + 1], S[4 * g + 2], S[4 * g + 3]}; *(f32x4*)(Co + 8 * g + 4 * h) = c; }
    } else if (r == 0) {
      float* no = p.out + O_PN + (size_t)hd * 256 + 32 * wid;
#pragma unroll
      for (int g = 0; g < 4; ++g) { f32x4 c = {S[4 * g], S[4 * g + 1], S[4 * g + 2], S[4 * g + 3]}; *(f32x4*)(no + 8 * g + 4 * h) = c; }
    }
    return;
  }
  u32x4* fr = (u32x4*)lds;
  float* tp = (float*)(lds + 16384) + wid * (64 * 33);
  __syncthreads();
  fr[(wid * 2 + 0) * 64 + lane] = __builtin_bit_cast(u32x4, pack_acc(S, 0));
  fr[(wid * 2 + 1) * 64 + lane] = __builtin_bit_cast(u32x4, pack_acc(S, 1));
  __syncthreads();
  const bf16_t* PA = (const bf16_t*)(ws + WS_R1);
  const float* WIa = (const float*)(ws + WS_WI);
  const bool hasg = grp > 0;
#pragma unroll 1
  for (int ci = 0; ci < 2; ++ci) {
    const int cc = GRP * grp + wid + 8 * ci;
    const float D = __expf(LD[cc * 4 + hd] - LD[(GRP * grp) * 4 + hd]);
    const u32x4* clc = (const u32x4*)(ws + WS_CLOCC) + (((size_t)cc * 4 + hd) * 9 + j) * 8 * 128 + lane;
#pragma unroll
    for (int tt = 0; tt < 2; ++tt) {
      const bf16_t* qp = PA + (size_t)(cc * 64 + 32 * tt + r) * 6144 + hd * 256 + 8 * h;
      f32x16 z = zero16(), z2 = zero16();
#pragma unroll
      for (int kt = 0; kt < 8; ++kt)
#pragma unroll
        for (int s2 = 0; s2 < 2; ++s2) {
          const bf16x8 q = ld16(qp + 32 * kt + 16 * s2);
          z = MFMA32(__builtin_bit_cast(bf16x8, clc[(kt * 2 + s2) * 64]), q, z);
          if (hasg) z2 = MFMA32(__builtin_bit_cast(bf16x8, fr[(kt * 2 + s2) * 64 + lane]), q, z2);
        }
#pragma unroll
      for (int i = 0; i < 16; ++i) tp[(32 * tt + r) * 33 + crow(i, h)] = z[i] + D * z2[i];
    }
    const int v = lane & 31;
#pragma unroll 4
    for (int e = 0; e < 32; ++e) {
      const int t = 2 * e + (lane >> 5);
      const float val = tp[t * 33 + v] * WIa[((size_t)cc * 4 + hd) * 64 + t];
      if (!nsl) ((float*)(ws + WS_HINTER))[(size_t)(cc * 64 + t) * 1024 + hd * 256 + 32 * j + v] = val;
      else if (v == 0) ((float*)(ws + WS_DENI))[(size_t)(cc * 64 + t) * 4 + hd] = val;
    }
  }
}

DI void phase2c(const Params& p, unsigned char* lds) {
  unsigned* ctr = (unsigned*)(p.ws + WS_CTR) + 3 + 8 * p.pad;
  for (;;) {
    const int it = next_item(ctr, lds + LDS_BYTES - 16, TIDX);
    if (it >= 17 * 36) break;
    const int g = 16 - it / 36;
    scanfix_task(p, lds, g, (it % 36) / 9, it % 9);
  }
}

DI void phase3(const Params& p) {
  const int tid = TIDX, lane = tid & 63, wid = tid >> 6;
  unsigned char* ws = p.ws;
  const int gw = blockIdx.x * 8 + wid, nw = gridDim.x * 8;
  const bf16_t* PA = (const bf16_t*)(ws + WS_R1);
  for (int it = gw; it < TT * 4; it += nw) {
    const int tok = it >> 2, hd = it & 3, cc = tok >> 6, t = tok & 63;
    const size_t off = (size_t)tok * 1024 + hd * 256 + 4 * lane;
    const f32x4 a = *(const f32x4*)((const float*)(ws + WS_HINTER) + off), b = *(const f32x4*)((const float*)(ws + WS_HINTRA) + off);
    const float den = ((const float*)(ws + WS_DENI))[tok * 4 + hd] + ((const float*)(ws + WS_DENA))[tok * 4 + hd];
    const float mt = ((const float*)(ws + WS_MT))[((size_t)cc * 4 + hd) * 64 + t];
    const float dn = 1.f / fmaxf(fabsf(den), __expf(-mt));
    const u32x2 ou = *(const u32x2*)(PA + (size_t)tok * 6144 + 3072 + hd * 256 + 4 * lane);
    const u32x2 zu = *(const u32x2*)(PA + (size_t)tok * 6144 + 4096 + hd * 256 + 4 * lane);
    f32x4 hv = (a + b) * dn;
    hv[0] *= sigmoidf_(bflo(ou[0])); hv[1] *= sigmoidf_(bfhi(ou[0])); hv[2] *= sigmoidf_(bflo(ou[1])); hv[3] *= sigmoidf_(bfhi(ou[1]));
    float ss = hv[0] * hv[0] + hv[1] * hv[1] + hv[2] * hv[2] + hv[3] * hv[3];
    ss = wave_sum(ss);
    const float rstd = __builtin_amdgcn_rsqf(ss * (1.f / 256.f) + EPS);
    const f32x4 hg = *(const f32x4*)(p.in[I_HGA] + hd * 256 + 4 * lane);
    hv = hv * rstd * hg;
    hv[0] *= siluf_(bflo(zu[0])); hv[1] *= siluf_(bfhi(zu[0])); hv[2] *= siluf_(bflo(zu[1])); hv[3] *= siluf_(bfhi(zu[1]));
    u32x2 o = {pk2(hv[0], hv[1]), pk2(hv[2], hv[3])};
    *(u32x2*)((bf16_t*)(ws + WS_AO) + (size_t)tok * 1536 + hd * 256 + 4 * lane) = o;
  }
}

DI void phase_outproj(const Params& p, unsigned char* lds, int layer) {
  const int tid = TIDX, lane = tid & 63, wid = tid >> 6, r = lane & 31, h = lane >> 5, wr = wid >> 1, wc = wid & 1;
  unsigned char* ws = p.ws;
  const bf16_t* W = (const bf16_t*)(ws + (layer == 0 ? WS_WOA : WS_WOB));
  for (int t = blockIdx.x; t < 68 * 16; t += gridDim.x) {
    const int tm = t >> 4, tn = t & 15, m0 = tm * 256, n0 = tn * 64;
    GemmAcc acc;
    gemm_tile<1>((const bf16_t*)(ws + WS_AO) + (size_t)m0 * 1536, 1536, W + (size_t)n0 * 1536, 1536, 1536, lds, acc, tid);
#pragma unroll
    for (int a = 0; a < 2; ++a) {
      const int n = n0 + wc * 32 + r, mb = m0 + wr * 64 + 32 * a;
#pragma unroll
      for (int i = 0; i < 16; ++i) {
        const int m = mb + crow(i, h);
        if (layer == 0) {
          const float xv = m < TP ? p.in[I_XP][(size_t)m * 1024 + n] : p.in[I_XS][(size_t)(m - TP) * 1024 + n];
          ((float*)(ws + WS_Y1))[(size_t)m * 1024 + n] = xv + acc.a[a][0][i];
        } else {
          p.out[O_Y + (size_t)m * 1024 + n] = ((const float*)(ws + WS_Y1))[(size_t)m * 1024 + n] + acc.a[a][0][i];
        }
      }
    }
  }
}

DI void phase5(const Params& p, unsigned char* lds) {
  const int tid = TIDX, lane = tid & 63, wid = tid >> 6;
  unsigned char* ws = p.ws;
  const int gw = blockIdx.x * 8 + wid, nw = gridDim.x * 8;
  for (int r = gw; r < TT; r += nw) {
    f32x4 v[4];
    const float rstd = row_load_rstd((const float*)(ws + WS_Y1) + (size_t)r * 1024, v, lane);
    bf16_t* xn = (bf16_t*)(ws + WS_XN) + (size_t)r * 1024;
#pragma unroll
    for (int j = 0; j < 4; ++j) { const f32x4 xs = v[j] * rstd; u32x2 o = {pk2(xs[0], xs[1]), pk2(xs[2], xs[3])}; *(u32x2*)(xn + 4 * lane + 256 * j) = o; }
  }
  {
    float* smax = (float*)lds;
    const int hm = (tid & 127) >> 3;
    for (int b = 0; b < 16; ++b) {
      __syncthreads();
      if (tid < 16) smax[tid] = 0.f;
      __syncthreads();
      float mx = 0.f;
      const size_t n8 = (size_t)PAST * 1024 / 8;
      const float* src = p.in[I_CK] + (size_t)b * PAST * 1024;
      bf16_t* dst = (bf16_t*)(ws + WS_KBS) + (size_t)b * SKV * 1024;
      for (size_t i = (size_t)blockIdx.x * NTHREADS + tid; i < n8; i += (size_t)gridDim.x * NTHREADS) {
        const size_t e = i * 8;
        const f32x4 a = *(const f32x4*)(src + e), c = *(const f32x4*)(src + e + 4);
        u32x4 o = {pk2(a[0], a[1]), pk2(a[2], a[3]), pk2(c[0], c[1]), pk2(c[2], c[3])};
        *(u32x4*)(dst + e) = o;
        float ss = a[0] * a[0] + a[1] * a[1] + a[2] * a[2] + a[3] * a[3] + c[0] * c[0] + c[1] * c[1] + c[2] * c[2] + c[3] * c[3];
        ss += __shfl_xor(ss, 1); ss += __shfl_xor(ss, 2); ss += __shfl_xor(ss, 4);
        mx = fmaxf(mx, ss);
      }
      if ((tid & 7) == 0) atomicMax((unsigned*)smax + hm, __float_as_uint(mx));
      __syncthreads();
      if (tid < 16) atomicMax((unsigned*)(ws + WS_KMAX) + (1 + b) * 16 + tid, __float_as_uint(sqrtf(smax[tid])));
    }
  }
  __syncthreads();
  for (int t = blockIdx.x; t < 128 * 64; t += gridDim.x) {
    const int jb = t >> 6, tile = t & 63, b = jb >> 3, hd = jb & 7;
    TJob j = {p.in[I_CV] + (size_t)b * PAST * 1024 + hd * 128, 1024, (bf16_t*)(ws + WS_VTS) + ((size_t)(b * 8 + hd) * 128) * SKV, SKV, nullptr, 64, 1};
    run_tjob_tile(j, tile, (float*)lds, tid, true);
  }
}

DI void phase6(const Params& p, unsigned char* lds) {
  const int tid = TIDX, lane = tid & 63, wid = tid >> 6, r = lane & 31, h = lane >> 5;
  unsigned char* ws = p.ws;
  for (int t = blockIdx.x; t < 68 * 20; t += gridDim.x) {
    const int tm = t / 20, tn = t % 20, m0 = tm * 256, n0 = tn * 256;
    GemmAcc acc2[2];
    gemm256((const bf16_t*)(ws + WS_XN) + (size_t)m0 * 1024, 1024, (const bf16_t*)(ws + WS_WKB) + (size_t)n0 * 1024, 1024, 1024, lds, acc2, tid);
    const int sec = n0 >> 10;
    const bool samp = m0 >= TP;
#pragma unroll
    for (int mh = 0; mh < 2; ++mh) {
    const GemmAcc& acc = acc2[mh];
    const int wr = (wid >> 2) * 2 + mh, wc = wid & 3;
#pragma unroll
    for (int a = 0; a < 2; ++a)
#pragma unroll
      for (int b = 0; b < 2; ++b) {
        __builtin_amdgcn_sched_barrier(0);
        const int n = n0 + wc * 64 + 32 * b + r, mb = m0 + wr * 64 + 32 * a;
        if (sec == 0) {
          const int f = n;
          if (b == 1) {
            float mx = 0.f;
#pragma unroll
            for (int i = 0; i < 16; ++i) {
              float ss = acc.a[a][0][i] * acc.a[a][0][i] + acc.a[a][1][i] * acc.a[a][1][i];
              ss += __shfl_xor(ss, 1); ss += __shfl_xor(ss, 2); ss += __shfl_xor(ss, 4); ss += __shfl_xor(ss, 8); ss += __shfl_xor(ss, 16);
              mx = fmaxf(mx, ss);
            }
            mx = fmaxf(mx, __shfl_xor(mx, 32));
            if (lane == 0) {
              const int strm = samp ? 1 + ((mb - TP) >> 6) : 0;
              atomicMax((unsigned*)(ws + WS_KMAX) + strm * 16 + ((n0 + wc * 64) >> 6), __float_as_uint(sqrtf(mx)));
            }
          }
#pragma unroll
          for (int i = 0; i < 16; ++i) {
            const int m = mb + crow(i, h);
            const float v = acc.a[a][b][i];
            if (!samp) { (p.out + O_PK)[(unsigned)(m * 1024 + f)] = v; ((bf16_t*)(ws + WS_KBP))[(unsigned)(m * 1024 + f)] = f2bf(v); }
            else { const int ms = m - TP, bb = ms >> 6, s = ms & 63; (p.out + O_SK)[(unsigned)(ms * 1024 + f)] = v;
                   ((bf16_t*)(ws + WS_KBS))[(unsigned)((bb * SKV + PAST + s) * 1024 + f)] = f2bf(v); }
          }
        } else if (sec == 1) {
          const int f = n - 1024, hd = f >> 7, vd = f & 127;
#pragma unroll
          for (int i = 0; i < 16; ++i) {
            const int m = mb + crow(i, h);
            if (!samp) (p.out + O_PV)[(unsigned)(m * 1024 + f)] = acc.a[a][b][i]; else (p.out + O_SV)[(unsigned)((m - TP) * 1024 + f)] = acc.a[a][b][i];
          }
#pragma unroll
          for (int g = 0; g < 4; ++g) {
            const int m0r = mb + 8 * g + 4 * h, pq = (m0r >> 2) & 3;
            const int m = (m0r & ~15) + 4 * (((pq & 1) << 1) | (pq >> 1));
            u32x2 o = {pk2(acc.a[a][b][4 * g], acc.a[a][b][4 * g + 1]), pk2(acc.a[a][b][4 * g + 2], acc.a[a][b][4 * g + 3])};
            if (!samp) *(u32x2*)((bf16_t*)(ws + WS_VTP) + (unsigned)((hd * 128 + vd) * TP + m)) = o;
            else { const int ms = m - TP, bb = ms >> 6, s = ms & 63; *(u32x2*)((bf16_t*)(ws + WS_VTS) + (unsigned)(((bb * 8 + hd) * 128 + vd) * SKV + PAST + s)) = o; }
          }
        } else {
          const float sc = sec == 2 ? 0.125f * LOG2E : 1.f;
          bf16_t* PB = (bf16_t*)(ws + WS_PB);
#pragma unroll
          for (int i = 0; i < 16; ++i) PB[(unsigned)((mb + crow(i, h)) * 3072 + (n - 2048))] = f2bf(acc.a[a][b][i] * sc);
        }
      }
    }
  }
}

constexpr int A_BUF = 32768, A_KB = 16384, A_FLAGS = 3 * A_BUF;

DI void diffattn_task(const Params& p, unsigned char* lds, int sb  , int qt  , int hd, float lam) {
  const int tid = TIDX, lane = tid & 63, wid = __builtin_amdgcn_readfirstlane(tid >> 6), r = lane & 31, h = lane >> 5;
  unsigned char* ws = p.ws;
  const int cq = wid >> 2, sub = (wid >> 1) & 1, map = wid & 1;
  const int ncq = sb < 0 ? 2 : 1;
  const int base_chunk = sb < 0 ? 2 * qt : 64;
  const int tok0 = sb < 0 ? qt * 128 : TP + sb * 64;
  const bool wvalid = cq < ncq;
  const int qc = base_chunk + cq;
  const int tl = 32 * sub + r;
  const int tok = tok0 + 64 * (wvalid ? cq : 0) + tl;
  const bf16_t* Kb = sb < 0 ? (const bf16_t*)(ws + WS_KBP) + hd * 128 : (const bf16_t*)(ws + WS_KBS) + (size_t)sb * SKV * 1024 + hd * 128;
  const bf16_t* Vb = sb < 0 ? (const bf16_t*)(ws + WS_VTP) + (size_t)hd * 128 * TP : (const bf16_t*)(ws + WS_VTS) + (size_t)(sb * 8 + hd) * 128 * SKV;
  const unsigned ldv = sb < 0 ? TP : SKV;
  const bf16_t* PB = (const bf16_t*)(ws + WS_PB);
  bf16x8 qf[4];
  float qn = 0.f;
  {
    const unsigned qo = (unsigned)tok * 3072u + hd * 128 + map * 64 + 8 * h;
#pragma unroll
    for (int kk = 0; kk < 4; ++kk) {
      const u32x4 u = *(const u32x4*)(PB + (qo + 16 * kk));
      qf[kk] = __builtin_bit_cast(bf16x8, u);
#pragma unroll
      for (int e = 0; e < 4; ++e) { const float a = bflo(u[e]), b = bfhi(u[e]); qn += a * a + b * b; }
    }
    qn += __shfl_xor(qn, 32);
    qn = sqrtf(qn);
  }
  const float kmax = ((const float*)(ws + WS_KMAX))[(sb < 0 ? 0 : 1 + sb) * 16 + hd * 2 + map];
  const float shift = qn * kmax * 1.02f + 0.5f - 40.f;
  const float sl2 = exp2f(-(float)(hd + 1)) * LOG2E;
  const int wd = diff_window(hd);
  const float bh0 = sl2 * (float)(4 * h) - sl2 * (float)tl - shift, bh1 = bh0 + 32.f * sl2;
  float cs[16];
#pragma unroll
  for (int i = 0; i < 16; ++i) cs[i] = __uint_as_float(__builtin_amdgcn_readfirstlane(__float_as_uint(sl2 * (float)((i & 3) + 8 * (i >> 2)))));
  f32x16 O[4];
#pragma unroll
  for (int vt = 0; vt < 4; ++vt) O[vt] = zero16();
  float l = 0.f;
  const int jmax = base_chunk + ncq - 1;
  const int jmin = max(0, base_chunk - wd);
  const int nit = jmax - jmin + 1;
  unsigned kofs[2], vofs[2];
#pragma unroll
  for (int e = 0; e < 2; ++e) {
    const int q = wid * 2 + e;
    { const int row = 4 * q + (lane >> 4), lc = (lane & 15) ^ (row & 15); kofs[e] = (unsigned)row * 1024u + 8u * lc; }
    { const int row = 8 * q + (lane >> 3), lc = (lane & 7) ^ ((row >> 1) & 7); vofs[e] = (unsigned)row * ldv + 8u * lc; }
  }
  auto issue = [&](int j, int buf) {
    const bf16_t* kj = Kb + (size_t)j * 65536;
    const bf16_t* vj = Vb + (size_t)j * 64;
    unsigned char* base = lds + buf * A_BUF;
#pragma unroll
    for (int e = 0; e < 2; ++e) {
      dma16(kj + kofs[e], base + (wid * 2 + e) * 1024);
      dma16(vj + vofs[e], base + A_KB + (wid * 2 + e) * 1024);
    }
  };
  unsigned kco[4], vco[4];
#pragma unroll
  for (int kk = 0; kk < 4; ++kk) kco[kk] = (unsigned)r * 256u + ((((unsigned)(8 * map + 2 * kk + h)) ^ (unsigned)(r & 15)) << 4);
#pragma unroll
  for (int sx = 0; sx < 4; ++sx) vco[sx] = A_KB + (unsigned)r * 128u + ((((unsigned)(2 * sx + h)) ^ (unsigned)((r >> 1) & 7)) << 4);
  asm volatile("s_waitcnt vmcnt(0)" ::: "memory");
  __syncthreads();
  issue(jmax, 0);
  if (nit > 1) issue(jmax - 1, 1);
  for (int it = 0; it < nit; ++it) {
    const int j = jmax - it;
    if (it + 1 < nit) asm volatile("s_waitcnt vmcnt(4)" ::: "memory"); else asm volatile("s_waitcnt vmcnt(0)" ::: "memory");
    asm volatile("s_waitcnt lgkmcnt(0)" ::: "memory");
    __builtin_amdgcn_s_barrier();
    if (it + 2 < nit) issue(j - 2, (it + 2) % 3);
    if (wvalid && j <= qc && qc - j <= wd) {
      const unsigned char* base = lds + (it % 3) * A_BUF;
      const float dofs = sl2 * (float)((qc - j) * 64);
      float sum = 0.f;
#pragma unroll
      for (int half = 0; half < 2; ++half) {
        f32x16 sc;
        {
          float b0 = (half ? bh1 : bh0) - dofs;
          asm volatile("" : "+v"(b0));
#pragma unroll
          for (int i = 0; i < 16; ++i) sc[i] = b0 + cs[i];
        }
        if (j == qc) {
          int tlv = tl;
          asm volatile("" : "+v"(tlv));
          const float m2 = -2.f * sl2, xt = (float)(4 * h + 32 * half - tlv);
#pragma unroll
          for (int i = 0; i < 16; ++i) sc[i] = fmaf(m2, fmaxf(xt + (float)((i & 3) + 8 * (i >> 2)), 0.f), sc[i]);
        }
        {
          bf16x8 kf[4];
#pragma unroll
          for (int kk = 0; kk < 4; ++kk) kf[kk] = ld16(base + 8192 * half + kco[kk]);
#pragma unroll
          for (int kk = 0; kk < 4; ++kk) sc = MFMA32(kf[kk], qf[kk], sc);
        }
        bf16x8 vf[8];
#pragma unroll
        for (int vt = 0; vt < 4; ++vt) { vf[2 * vt] = ld16(base + 4096 * vt + vco[2 * half]); vf[2 * vt + 1] = ld16(base + 4096 * vt + vco[2 * half + 1]); }
#pragma unroll
        for (int i = 0; i < 16; ++i) { sc[i] = fexp2(sc[i]); sum += sc[i]; }
        const bf16x8 p0 = pack_acc(sc, 0), p1 = pack_acc(sc, 1);
#pragma unroll
        for (int vt = 0; vt < 4; ++vt) { O[vt] = MFMA32(vf[2 * vt], p0, O[vt]); O[vt] = MFMA32(vf[2 * vt + 1], p1, O[vt]); }
      }
      l += sum;
    }
  }
  asm volatile("s_waitcnt vmcnt(0)" ::: "memory");
  __syncthreads();
  l += __shfl_xor(l, 32);
  const float inv = wvalid ? 1.f / l : 0.f;
  float* xch = (float*)lds + (size_t)(wid >> 1) * 4096;
  if (map == 1 && wvalid) {
    const float sc = inv * lam;
#pragma unroll
    for (int vt = 0; vt < 4; ++vt)
#pragma unroll
      for (int i = 0; i < 16; ++i) xch[(vt * 16 + i) * 64 + lane] = O[vt][i] * sc;
  }
  __syncthreads();
  if (map == 0 && wvalid) {
    float ss = 0.f;
#pragma unroll
    for (int vt = 0; vt < 4; ++vt)
#pragma unroll
      for (int i = 0; i < 16; ++i) { const float o = O[vt][i] * inv - xch[(vt * 16 + i) * 64 + lane]; O[vt][i] = o; ss += o * o; }
    ss += __shfl_xor(ss, 32);
    const float lam_init = 0.8f - 0.6f * 0.7408182206817179f;
    const float rs = __builtin_amdgcn_rsqf(ss * (1.f / 128.f) + EPS) * (1.f - lam_init);
    const unsigned zo = (unsigned)tok * 3072u + 1024 + hd * 128, oo = (unsigned)tok * 1536u + hd * 128;
    bf16_t* AOp = (bf16_t*)(ws + WS_AO);
    const float* sg = p.in[I_SUBG];
#pragma unroll
    for (int vt = 0; vt < 4; ++vt)
#pragma unroll
      for (int g = 0; g < 4; ++g) {
        const int v = 32 * vt + 8 * g + 4 * h;
        const u32x2 z = *(const u32x2*)(PB + (zo + v));
        const f32x4 gg = *(const f32x4*)(sg + v);
        const float o0 = O[vt][4 * g] * rs * gg[0] * siluf_(bflo(z[0])), o1 = O[vt][4 * g + 1] * rs * gg[1] * siluf_(bfhi(z[0]));
        const float o2 = O[vt][4 * g + 2] * rs * gg[2] * siluf_(bflo(z[1])), o3 = O[vt][4 * g + 3] * rs * gg[3] * siluf_(bfhi(z[1]));
        u32x2 o = {pk2(o0, o1), pk2(o2, o3)};
        *(u32x2*)(AOp + (oo + v)) = o;
      }
  }
  __syncthreads();
}

DI void phase7(const Params& p, unsigned char* lds) {
  unsigned* ctr = (unsigned*)(p.ws + WS_CTR) + 1 + 8 * p.pad;
  const bf16_t* PB = (const bf16_t*)(p.ws + WS_PB);
  float lam;
  {
    const int lane = TIDX & 63;
    const float* lv = p.in[I_LAMB];
    const float a = wave_sum(lv[lane] * lv[64 + lane]), b = wave_sum(lv[128 + lane] * lv[192 + lane]);
    const float lam_init = 0.8f - 0.6f * 0.7408182206817179f;
    lam = __expf(a) - __expf(b) + lam_init;
  }
  const int n_s = 128, n_p = 1024, n_ma = 256 + 64;
  const int* tord = (const int*)(p.ws + WS_TORD);
  for (;;) {
    const int it = next_item(ctr, lds + LDS_BYTES - 16, TIDX);
    if (it >= n_s + n_p) break;
    const int a = tord[it];
    const bool pr = a < n_p;
    diffattn_task(p, lds, pr ? -1 : ((a - n_p) >> 3), pr ? (a >> 3) : 0, a & 7, lam);
  }
  for (;;) {
    const int it = next_item(ctr + 1, lds + LDS_BYTES - 16, TIDX);
    if (it >= n_ma) break;
    memattn_task(p, lds, it, 1, PB + 2048, PB + 2560, 3072);
  }
}

DI void phase9(const Params& p) {
  const int tid = TIDX, lane = tid & 63, wid = tid >> 6;
  const int gw = blockIdx.x * 8 + wid, nw = gridDim.x * 8;
  for (int r = gw; r < TT; r += nw) {
    f32x4 v[4];
    float* row = p.out + O_Y + (size_t)r * 1024;
    const float rstd = row_load_rstd(row, v, lane);
#pragma unroll
    for (int j = 0; j < 4; ++j) {
      const f32x4 g = *(const f32x4*)(p.in[I_FNG] + 4 * lane + 256 * j);
      *(f32x4*)(row + 4 * lane + 256 * j) = v[j] * rstd * g;
    }
  }
}

DI void grid_barrier(unsigned* bar, unsigned target, int tid) {
  asm volatile("s_waitcnt vmcnt(0)" ::: "memory");
  __syncthreads();
  if (tid == 0) {
    __builtin_amdgcn_fence(__ATOMIC_RELEASE, "agent");
    asm volatile("s_waitcnt vmcnt(0)" ::: "memory");
    __hip_atomic_fetch_add(bar, 1u, __ATOMIC_RELAXED, __HIP_MEMORY_SCOPE_AGENT);
    while (__hip_atomic_load(bar, __ATOMIC_RELAXED, __HIP_MEMORY_SCOPE_AGENT) < target) __builtin_amdgcn_s_sleep(1);
    __builtin_amdgcn_fence(__ATOMIC_ACQUIRE, "agent");
    asm volatile("s_waitcnt vmcnt(0)" ::: "memory");
  }
  __syncthreads();
}

__global__ __launch_bounds__(512) void mk(Params pin) {
  extern __shared__ __attribute__((aligned(16))) unsigned char lds[];
  Params p = pin;
  p.wv = __builtin_amdgcn_readfirstlane((int)(__builtin_amdgcn_workitem_id_x() >> 6));
  cg::grid_group grid = cg::this_grid();
  unsigned nbar = 0;
  unsigned* bar = (unsigned*)(p.ws + WS_CTR) + 32;
#define RUN_PHASE(PH, CALL) if (p.ph_lo <= PH && PH < p.ph_hi) { CALL; if (PH + 1 < p.ph_hi) { ++nbar; grid_barrier(bar, nbar * gridDim.x, TIDX); } }
  if (p.ph_lo <= 0 && 0 < p.ph_hi) { phase0(p, lds); if (1 < p.ph_hi) grid.sync(); }
  RUN_PHASE(1, phase1(p, lds))
  RUN_PHASE(2, phase2(p, lds))
  if (p.ph_lo <= 2 && 2 < p.ph_hi) { phase2c(p, lds); ++nbar; grid_barrier(bar, nbar * gridDim.x, TIDX); }
  RUN_PHASE(3, phase3(p))
  RUN_PHASE(4, phase_outproj(p, lds, 0))
  RUN_PHASE(5, phase5(p, lds))
  RUN_PHASE(6, phase6(p, lds))
  RUN_PHASE(7, phase7(p, lds))
  RUN_PHASE(8, phase_outproj(p, lds, 1))
  RUN_PHASE(9, phase9(p))
}

extern "C" void kernel_launch(void* const* d_in, const int* in_sizes, int n_in, void* d_out, int out_size,
                              void* d_ws, size_t ws_size, hipStream_t stream) {
  static int grid_blocks = 0;
  if (!grid_blocks) {
    int dev = 0, cus = 0, per_cu = 0;
    (void)hipGetDevice(&dev);
    (void)hipDeviceGetAttribute(&cus, hipDeviceAttributeMultiprocessorCount, dev);
    (void)hipFuncSetAttribute((const void*)mk, hipFuncAttributeMaxDynamicSharedMemorySize, LDS_BYTES);
    (void)hipOccupancyMaxActiveBlocksPerMultiprocessor(&per_cu, (const void*)mk, NTHREADS, LDS_BYTES);
    grid_blocks = cus;
    fprintf(stderr, "kernel_launch: cus=%d per_cu=%d grid=%d ws=%zu need=%zu\n", cus, per_cu, grid_blocks, ws_size, (size_t)WS_END);
  }
  if (ws_size < WS_END) { fprintf(stderr, "workspace too small\n"); return; }
  Params p{};
  for (int i = 0; i < 24; ++i) p.in[i] = (const float*)d_in[i];
  p.out = (float*)d_out; p.ws = (unsigned char*)d_ws; p.ph_lo = 0; p.ph_hi = NPHASE;
  void* args[] = {&p};
  hipError_t e = hipLaunchCooperativeKernel((const void*)mk, dim3(grid_blocks), dim3(NTHREADS), args, LDS_BYTES, stream);
  if (e != hipSuccess) fprintf(stderr, "cooperative launch failed: %s (grid %d)\n", hipGetErrorString(e), grid_blocks);
  if (PROBE_REP >= 0) {
    Params q = p;
    q.out = (float*)((unsigned char*)d_ws + WS_END); q.ph_lo = PROBE_REP; q.ph_hi = PROBE_REP + 1; q.pad = 1;
    void* args2[] = {&q};
    (void)hipLaunchCooperativeKernel((const void*)mk, dim3(grid_blocks), dim3(NTHREADS), args2, LDS_BYTES, stream);
  }
}
```

```cpp
#include <hip/hip_runtime.h>
#include <hip/hip_cooperative_groups.h>
#include <cstdio>
#include <cstdint>
namespace cg = cooperative_groups;

typedef unsigned short bf16_t;
typedef short bf16x8 __attribute__((ext_vector_type(8)));
typedef short s16x4 __attribute__((ext_vector_type(4)));
typedef float f32x16 __attribute__((ext_vector_type(16)));
typedef float f32x4 __attribute__((ext_vector_type(4)));
typedef float f32x2 __attribute__((ext_vector_type(2)));
typedef __bf16 bf2_t __attribute__((ext_vector_type(2)));
typedef unsigned u32x4 __attribute__((ext_vector_type(4)));
typedef unsigned u32x2 __attribute__((ext_vector_type(2)));
#define DI __device__ __forceinline__
#define MFMA32(a, b, c) __builtin_amdgcn_mfma_f32_32x32x16_bf16((a), (b), (c), 0, 0, 0)

struct Params { const float* in[24]; float* out; unsigned char* ws; int ph_lo, ph_hi; int wv, pad; };
#define TIDX (p.wv * 64 + (int)__builtin_amdgcn_mbcnt_hi(~0u, __builtin_amdgcn_mbcnt_lo(~0u, 0u)))
constexpr int LDS_BYTES = 148480;
constexpr int NTHREADS = 512;
constexpr int NPHASE = 10;
#ifndef PROBE_REP
#define PROBE_REP -1
#endif

constexpr int TP = 16384, TS = 1024, TT = 17408, DM = 1024;
constexpr int NCH = 272;
constexpr int PAST = 4096, SKV = 4160;
constexpr float EPS = 1e-6f;
constexpr float LOG2E = 1.4426950408889634f;
enum { I_XP = 0, I_XS, I_CK, I_CV, I_CMK, I_CMV, I_SC, I_SN, I_SM, I_MEMP, I_NG, I_FNG, I_MNG, I_WMKV, I_WINA, I_BGA, I_HGA, I_WOA,
       I_KVNG, I_WKV, I_WINB, I_LAMB, I_SUBG, I_WOB };
constexpr size_t O_Y = 0, O_PC = 17825792, O_PN = 18087936, O_PM = 18088960, O_PK = 18088964, O_PV = 34866180, O_PMK = 51643396,
                 O_PMV = 51905540, O_SC = 52167684, O_SN = 56361988, O_SM = 56378372, O_SK = 56378436, O_SV = 57427012;
constexpr size_t WS_CTR = 0;
constexpr size_t WS_KMAX = 1024;
constexpr size_t WS_TORD = 8192;
constexpr size_t WS_WA = 16384;
constexpr size_t WS_WOA = WS_WA + (size_t)6144 * 1024 * 2;
constexpr size_t WS_WKB = WS_WOA + (size_t)1024 * 1536 * 2;
constexpr size_t WS_WOB = WS_WKB + (size_t)5120 * 1024 * 2;
constexpr size_t WS_WM = WS_WOB + (size_t)1024 * 1536 * 2;
constexpr size_t WS_MEMN = WS_WM + (size_t)2 * 1024 * 1024 * 2;
constexpr size_t WS_MEMK = WS_MEMN + (size_t)2 * 256 * 1024 * 2;
constexpr size_t WS_MEMVT = WS_MEMK + (size_t)2 * 17 * 256 * 512 * 2;
constexpr size_t WS_GATE = WS_MEMVT + (size_t)2 * 17 * 256 * 512 * 2;
constexpr size_t SZ_CH = (size_t)NCH * 4 * 64 * 4;
constexpr size_t WS_GC = WS_GATE + (size_t)TT * 8 * 4;
constexpr size_t WS_MT = WS_GC + SZ_CH;
constexpr size_t WS_WS = WS_MT + SZ_CH;
constexpr size_t WS_WI = WS_WS + SZ_CH;
constexpr size_t WS_AS = WS_WI + SZ_CH;
constexpr size_t WS_BT = WS_AS + SZ_CH;
constexpr size_t WS_DEC = WS_BT + SZ_CH;
constexpr size_t WS_DENI = WS_DEC + 8192;
constexpr size_t WS_DENA = WS_DENI + (size_t)TT * 4 * 4;
constexpr size_t WS_XN = WS_DENA + (size_t)TT * 4 * 4;
constexpr size_t WS_AO = WS_XN + (size_t)TT * 1024 * 2;
constexpr size_t WS_Y1 = WS_AO + (size_t)TT * 1536 * 2;
constexpr size_t WS_KT = WS_Y1 + (size_t)TT * 1024 * 4;
constexpr size_t WS_VTA = WS_KT + (size_t)NCH * 4 * 256 * 64 * 2;
constexpr size_t WS_R1 = WS_VTA + (size_t)NCH * 4 * 256 * 64 * 2;
constexpr size_t SZ_R1 = (size_t)TT * 6144 * 2;
constexpr size_t WS_PB = WS_R1;
constexpr size_t WS_KBP = WS_PB + (size_t)TT * 3072 * 2;
constexpr size_t WS_VTP = WS_KBP + (size_t)TP * 1024 * 2;
constexpr size_t WS_R2 = WS_R1 + SZ_R1;
constexpr size_t WS_HINTER = WS_R2;
constexpr size_t WS_HINTRA = WS_R2 + (size_t)TT * 1024 * 4;
constexpr size_t WS_KBS = WS_R2;
constexpr size_t WS_VTS = WS_KBS + (size_t)16 * SKV * 1024 * 2;
constexpr size_t WS_WVT = WS_VTS + (size_t)16 * SKV * 1024 * 2;
constexpr size_t WS_U = WS_WVT + (size_t)NCH * 4 * 288 * 64 * 2;
constexpr size_t WS_CFAC = WS_U + SZ_CH;
constexpr size_t WS_CLOCC = WS_CFAC + 8192;
constexpr size_t WS_PM = WS_CLOCC + (size_t)256 * 4 * 9 * 8 * 2 * 64 * 16;
constexpr size_t WS_CHS = WS_PM + SZ_CH;
constexpr size_t WS_LD = WS_CHS + 16384;
constexpr size_t WS_CLOC = WS_LD + 8192;
constexpr size_t WS_END = WS_CLOC + (size_t)16 * 36 * 8 * 64 * 16 * 4;
constexpr int GRP = 16;
static_assert(WS_VTP + (size_t)TP * 1024 * 2 <= WS_R2, "R1 overflow");

DI unsigned pk2(float lo, float hi) { f32x2 v = {lo, hi}; return __builtin_bit_cast(unsigned, __builtin_convertvector(v, bf2_t)); }
DI bf16_t f2bf(float x) { return (bf16_t)(pk2(x, 0.f) & 0xffffu); }
DI float bf2f(unsigned v16) { return __uint_as_float(v16 << 16); }
DI float bflo(unsigned u) { return __uint_as_float(u << 16); }
DI float bfhi(unsigned u) { return __uint_as_float(u & 0xffff0000u); }
DI float rbf(float x) { return bflo(pk2(x, 0.f) & 0xffffu); }
DI int crow(int i, int h) { return (i & 3) + 8 * (i >> 2) + 4 * h; }
DI float wave_sum(float v) {
#pragma unroll
  for (int o = 32; o >= 1; o >>= 1) v += __shfl_xor(v, o);
  return v;
}
DI float fexp2(float x) { return __builtin_amdgcn_exp2f(x); }
DI float fexp(float x) { return __builtin_amdgcn_exp2f(x * LOG2E); }
DI float sigmoidf_(float x) { return 1.f / (1.f + __expf(-x)); }
DI float siluf_(float x) { return x / (1.f + __expf(-x)); }
DI bf16x8 pack_acc(const f32x16& x, int s) {
  u32x4 p;
  p[0] = pk2(x[8 * s + 0], x[8 * s + 1]); p[1] = pk2(x[8 * s + 2], x[8 * s + 3]);
  p[2] = pk2(x[8 * s + 4], x[8 * s + 5]); p[3] = pk2(x[8 * s + 6], x[8 * s + 7]);
  return __builtin_bit_cast(bf16x8, p);
}
DI bf16x8 ld16(const void* p) { return *(const bf16x8*)p; }
DI bf16x8 ld8x2(const void* p0, const void* p1) {
  u32x2 a = *(const u32x2*)p0, b = *(const u32x2*)p1; u32x4 r = {a[0], a[1], b[0], b[1]};
  return __builtin_bit_cast(bf16x8, r);
}
DI f32x16 zero16() { f32x16 z; for (int i = 0; i < 16; ++i) z[i] = 0.f; return z; }

DI void transpose_tile(const float* __restrict__ src, size_t ld_s, bf16_t* __restrict__ dst, size_t ld_d, const float* __restrict__ scale,
                       float* scr, int t, bool perm = false) {
  {
    const int c4 = t & 31, rb = t >> 5;
    f32x4 v[4];
#pragma unroll
    for (int i = 0; i < 4; ++i) v[i] = *(const f32x4*)(src + (size_t)(rb + 16 * i) * ld_s + 4 * c4);
#pragma unroll
    for (int i = 0; i < 4; ++i) {
      const int r = rb + 16 * i;
      f32x4 x = v[i];
      if (scale) { const float sc = scale[r]; x = x * sc; }
      float* d = scr + r * 129 + 4 * c4; d[0] = x[0]; d[1] = x[1]; d[2] = x[2]; d[3] = x[3];
    }
  }
  __syncthreads();
#pragma unroll
  for (int i = 0; i < 2; ++i) {
    const int id = t + 512 * i, c = id >> 3, rg = id & 7;
    const float* s = scr + (8 * rg) * 129 + c;
    u32x4 o; o[0] = pk2(s[0], s[129]); o[1] = pk2(s[2 * 129], s[3 * 129]); o[2] = pk2(s[4 * 129], s[5 * 129]); o[3] = pk2(s[6 * 129], s[7 * 129]);
    if (!perm) *(u32x4*)(dst + (size_t)c * ld_d + 8 * rg) = o;
    else {
      bf16_t* d = dst + (size_t)c * ld_d + 16 * (rg >> 1) + 4 * (rg & 1);
      u32x2 lo = {o[0], o[1]}, hi = {o[2], o[3]};
      *(u32x2*)d = lo; *(u32x2*)(d + 8) = hi;
    }
  }
  __syncthreads();
}

struct TJob { const float* src; size_t ld_s; bf16_t* dst; size_t ld_d; const float* scale; int tr, tc; };

DI void run_tjob_tile(const TJob& j, int tile, float* scr, int tid, bool perm = false) {
  const int ir = tile / j.tc, ic = tile % j.tc;
  transpose_tile(j.src + (size_t)(64 * ir) * j.ld_s + 128 * ic, j.ld_s, j.dst + (size_t)(128 * ic) * j.ld_d + 64 * ir, j.ld_d,
                 j.scale ? j.scale + 64 * ir : nullptr, scr, tid, perm);
}

DI float row_load_rstd(const float* xrow, f32x4 (&v)[4], int lane) {
  float ss = 0.f;
#pragma unroll
  for (int j = 0; j < 4; ++j) { v[j] = *(const f32x4*)(xrow + 4 * lane + 256 * j); ss += v[j][0] * v[j][0] + v[j][1] * v[j][1] + v[j][2] * v[j][2] + v[j][3] * v[j][3]; }
  ss = wave_sum(ss);
  return __builtin_amdgcn_rsqf(ss * (1.f / 1024.f) + EPS);
}

DI int diff_window(int hd) { const float sl2 = exp2f(-(float)(hd + 1)) * LOG2E; return (int)floorf((63.f + 192.f / sl2) * (1.f / 64.f)); }
DI int diff_est(int a) {
  const int hd = a & 7;
  const int w = diff_window(hd) + (a < 1024 ? 2 : 1);
  const int n = a < 1024 ? 2 * (a >> 3) + 2 : 65;
  return n < w ? n : w;
}

DI void phase0(const Params& p, unsigned char* lds) {
  const int tid = TIDX, lane = tid & 63, wid = tid >> 6;
  unsigned char* ws = p.ws;
  if (blockIdx.x == 0 && tid < 64) ((unsigned*)(ws + WS_CTR))[tid] = 0u;
  if (blockIdx.x == 0 && tid < 272) ((unsigned*)(ws + WS_KMAX))[tid] = 0u;
  if (blockIdx.x == 1) {
    int* est = (int*)lds;
    for (int a = tid; a < 1152; a += NTHREADS) est[a] = diff_est(a);
    __syncthreads();
    for (int a = tid; a < 1152; a += NTHREADS) {
      const int ea = est[a];
      int rank = 0;
      for (int b = 0; b < 1152; ++b) { const int eb = est[b]; rank += (eb > ea) || (eb == ea && b < a); }
      ((int*)(ws + WS_TORD))[rank] = a;
    }
    __syncthreads();
  }
  {
    TJob jobs[8];
    jobs[0] = {p.in[I_WINA], 6152, (bf16_t*)(ws + WS_WA), 1024, p.in[I_NG], 16, 40};
    jobs[1] = {p.in[I_WINA] + 5128, 6152, (bf16_t*)(ws + WS_WA) + (size_t)5120 * 1024, 1024, p.in[I_NG], 16, 8};
    jobs[2] = {p.in[I_WOA], 1024, (bf16_t*)(ws + WS_WOA), 1536, nullptr, 24, 8};
    jobs[3] = {p.in[I_WKV], 2048, (bf16_t*)(ws + WS_WKB), 1024, p.in[I_KVNG], 16, 16};
    jobs[4] = {p.in[I_WINB], 3072, (bf16_t*)(ws + WS_WKB) + (size_t)2048 * 1024, 1024, p.in[I_NG] + 1024, 16, 24};
    jobs[5] = {p.in[I_WOB], 1024, (bf16_t*)(ws + WS_WOB), 1536, nullptr, 24, 8};
    jobs[6] = {p.in[I_WMKV], 1024, (bf16_t*)(ws + WS_WM), 1024, nullptr, 16, 8};
    jobs[7] = {p.in[I_WMKV] + (size_t)1024 * 1024, 1024, (bf16_t*)(ws + WS_WM) + (size_t)1024 * 1024, 1024, nullptr, 16, 8};
    int base = 0;
#pragma unroll
    for (int j = 0; j < 8; ++j) {
      const int n = jobs[j].tr * jobs[j].tc;
      for (int t = blockIdx.x; t < n; t += gridDim.x) run_tjob_tile(jobs[j], t, (float*)lds, tid);
      base += n;
    }
    for (int t = blockIdx.x; t < 128 * 4; t += gridDim.x) {
      const int jb = t >> 2, tile = t & 3, l = jb >> 6, b = (jb >> 2) & 15, h = jb & 3;
      TJob j = {p.in[I_CMV] + ((size_t)(l * 16 + b) * 256) * 512 + h * 128, 512,
                (bf16_t*)(ws + WS_MEMVT) + ((size_t)(l * 17 + 1 + b) * 4 + h) * 128 * 256, 256, nullptr, 4, 1};
      run_tjob_tile(j, tile, (float*)lds, tid, true);
    }
  }
  {
    const size_t n8 = (size_t)2 * 16 * 256 * 512 / 8;
    for (size_t i = (size_t)blockIdx.x * NTHREADS + tid; i < n8; i += (size_t)gridDim.x * NTHREADS) {
      const size_t e = i * 8; const int l = (int)(e / ((size_t)16 * 131072)); const size_t rem = e - (size_t)l * 16 * 131072;
      const f32x4 a = *(const f32x4*)(p.in[I_CMK] + e), b = *(const f32x4*)(p.in[I_CMK] + e + 4);
      u32x4 o = {pk2(a[0], a[1]), pk2(a[2], a[3]), pk2(b[0], b[1]), pk2(b[2], b[3])};
      *(u32x4*)((bf16_t*)(ws + WS_MEMK) + ((size_t)(l * 17 + 1) * 131072) + rem) = o;
    }
  }
  {
    const int gw = blockIdx.x * 8 + wid, nw = gridDim.x * 8;
    const float* ng = p.in[I_NG];
    float* gwt = (float*)(lds + 32768);
    float* sg = (float*)(lds + 65536);
    __syncthreads();
    for (int i = tid; i < 8192; i += NTHREADS) { const int k = i >> 3, c = i & 7; gwt[i] = p.in[I_WINA][(size_t)k * 6152 + 5120 + c] * ng[k]; }
    __syncthreads();
    for (int cc = blockIdx.x; cc < NCH; cc += gridDim.x) {
      for (int ri = 0; ri < 8; ++ri) {
        const int r = cc * 64 + wid * 8 + ri;
        const float* xrow = r < TP ? p.in[I_XP] + (size_t)r * 1024 : p.in[I_XS] + (size_t)(r - TP) * 1024;
        f32x4 v[4];
        const float rstd = row_load_rstd(xrow, v, lane);
        float gacc[8];
#pragma unroll
        for (int c = 0; c < 8; ++c) gacc[c] = 0.f;
        bf16_t* xn = (bf16_t*)(ws + WS_XN) + (size_t)r * 1024;
#pragma unroll
        for (int j = 0; j < 4; ++j) {
          const int k0 = 4 * lane + 256 * j;
          const f32x4 xs = v[j] * rstd;
          u32x2 o = {pk2(xs[0], xs[1]), pk2(xs[2], xs[3])};
          *(u32x2*)(xn + k0) = o;
#pragma unroll
          for (int e = 0; e < 4; ++e) {
            const float* wr = gwt + (k0 + e) * 8;
            const f32x4 w0 = *(const f32x4*)wr, w1 = *(const f32x4*)(wr + 4);
            gacc[0] += xs[e] * w0[0]; gacc[1] += xs[e] * w0[1]; gacc[2] += xs[e] * w0[2]; gacc[3] += xs[e] * w0[3];
            gacc[4] += xs[e] * w1[0]; gacc[5] += xs[e] * w1[1]; gacc[6] += xs[e] * w1[2]; gacc[7] += xs[e] * w1[3];
          }
        }
#pragma unroll
        for (int c = 0; c < 8; ++c) gacc[c] = wave_sum(gacc[c]);
        if (lane < 8) {
          float gv = gacc[0];
#pragma unroll
          for (int c = 1; c < 8; ++c) gv = lane == c ? gacc[c] : gv;
          gv += p.in[I_BGA][lane];
          if (lane >= 4) gv = fminf(gv, 0.f) - log1pf(__expf(-fabsf(gv)));
          sg[(wid * 8 + ri) * 8 + lane] = gv;
        }
      }
      __syncthreads();
      if (wid < 4) {
        const int hd = wid, pr = cc * 4 + hd;
        const float ig = sg[lane * 8 + hd], lf = sg[lane * 8 + 4 + hd];
        float g = lf;
#pragma unroll
        for (int o = 1; o < 64; o <<= 1) { const float t = __shfl_up(g, o); if (lane >= o) g += t; }
        const float a = ig - g;
        float pm = a;
#pragma unroll
        for (int o = 1; o < 64; o <<= 1) { const float t = __shfl_up(pm, o); if (lane >= o) pm = fmaxf(pm, t); }
        const size_t o = (size_t)pr * 64 + lane;
        ((float*)(ws + WS_GC))[o] = g;
        ((float*)(ws + WS_AS))[o] = a;
        ((float*)(ws + WS_PM))[o] = pm;
        if (lane == 63) { ((float*)(ws + WS_CHS))[pr * 2] = g; ((float*)(ws + WS_CHS))[pr * 2 + 1] = pm; }
        const float u = __expf(a - __shfl(pm, 63));
        ((float*)(ws + WS_U))[o] = u;
        bf16_t* wr = (bf16_t*)(ws + WS_WVT) + ((size_t)pr * 288 + 256) * 64 + lane;
        wr[0] = f2bf(u);
#pragma unroll 4
        for (int rr = 1; rr < 32; ++rr) wr[rr * 64] = 0;
      }
      __syncthreads();
    }
    for (int r = gw; r < 512; r += nw) {
      const int l = r >> 8, rr = r & 255;
      f32x4 v[4];
      const float rstd = row_load_rstd(p.in[I_MEMP] + (size_t)rr * 1024, v, lane);
      bf16_t* o = (bf16_t*)(ws + WS_MEMN) + (size_t)r * 1024;
#pragma unroll
      for (int j = 0; j < 4; ++j) {
        const int k0 = 4 * lane + 256 * j;
        const f32x4 g = *(const f32x4*)(p.in[I_MNG] + l * 1024 + k0);
        const f32x4 xs = v[j] * rstd * g;
        u32x2 ov = {pk2(xs[0], xs[1]), pk2(xs[2], xs[3])};
        *(u32x2*)(o + k0) = ov;
      }
    }
  }
}

constexpr int G_STAGE = 49152;
struct GemmAcc { f32x16 a[2][2]; };
DI void dma16(const void* g, unsigned char* l) { __builtin_amdgcn_global_load_lds((const unsigned*)g, (unsigned*)l, 16, 0, 0); }

template <int NB = 2>
DI void gemm_tile(const bf16_t* __restrict__ A, size_t lda, const bf16_t* __restrict__ Bt, size_t ldb, int K, unsigned char* lds, GemmAcc& acc, int tid) {
  const int lane = tid & 63, wid = __builtin_amdgcn_readfirstlane(tid >> 6), r = lane & 31, h = lane >> 5;
  const int wr = wid >> 1, wc = wid & 1;
#pragma unroll
  for (int a = 0; a < 2; ++a)
#pragma unroll
    for (int b = 0; b < 2; ++b) acc.a[a][b] = zero16();
  const int nk = K / 64;
  unsigned aoff[4], boff[2];
#pragma unroll
  for (int e = 0; e < 4; ++e) { const int row = 8 * (wid * 4 + e) + (lane >> 3), lc = (lane & 7) ^ ((row >> 1) & 7); aoff[e] = (unsigned)row * (unsigned)lda + 8u * lc; }
#pragma unroll
  for (int e = 0; e < NB; ++e) { const int row = 8 * (wid * NB + e) + (lane >> 3), lc = (lane & 7) ^ ((row >> 1) & 7); boff[e] = (unsigned)row * (unsigned)ldb + 8u * lc; }
  auto issue = [&](int kt, int buf) {
    unsigned char* base = lds + buf * G_STAGE;
#pragma unroll
    for (int e = 0; e < 4; ++e) dma16(A + (aoff[e] + 64u * kt), base + (wid * 4 + e) * 1024);
#pragma unroll
    for (int e = 0; e < NB; ++e) dma16(Bt + (boff[e] + 64u * kt), base + 32768 + (wid * NB + e) * 1024);
  };
  asm volatile("s_waitcnt vmcnt(0)" ::: "memory");
  __syncthreads();
  issue(0, 0);
  if (nk > 1) issue(1, 1);
  const unsigned sw = (r >> 1) & 7;
  unsigned co[4];
#pragma unroll
  for (int kk = 0; kk < 4; ++kk) co[kk] = (((2 * kk + h) ^ sw) << 4);
  const unsigned ra = (wr * 64 + r) * 128, rb = 32768 + (wc * 32 * NB + r) * 128;
  for (int kt = 0; kt < nk; ++kt) {
    if (kt + 1 < nk) { if (NB == 2) asm volatile("s_waitcnt vmcnt(6)" ::: "memory"); else asm volatile("s_waitcnt vmcnt(5)" ::: "memory"); }
    else asm volatile("s_waitcnt vmcnt(0)" ::: "memory");
    asm volatile("s_waitcnt lgkmcnt(0)" ::: "memory");
    __builtin_amdgcn_s_barrier();
    if (kt + 2 < nk) issue(kt + 2, (kt + 2) % 3);
    const unsigned char* base = lds + (kt % 3) * G_STAGE;
    const unsigned char* pa = base + ra;
    const unsigned char* pb = base + rb;
#pragma unroll
    for (int kk = 0; kk < 4; ++kk) {
      const bf16x8 a0 = ld16(pa + co[kk]), a1 = ld16(pa + 4096 + co[kk]);
      const bf16x8 b0 = ld16(pb + co[kk]);
      acc.a[0][0] = MFMA32(a0, b0, acc.a[0][0]);
      acc.a[1][0] = MFMA32(a1, b0, acc.a[1][0]);
      if (NB == 2) {
        const bf16x8 b1 = ld16(pb + 4096 + co[kk]);
        acc.a[0][1] = MFMA32(a0, b1, acc.a[0][1]);
        acc.a[1][1] = MFMA32(a1, b1, acc.a[1][1]);
      }
    }
    __builtin_amdgcn_sched_group_barrier(0x100, 2 + NB, 0);
    __builtin_amdgcn_sched_group_barrier(0x100, 2 + NB, 0); __builtin_amdgcn_sched_group_barrier(0x008, 2 * NB, 0);
    __builtin_amdgcn_sched_group_barrier(0x100, 2 + NB, 0); __builtin_amdgcn_sched_group_barrier(0x008, 2 * NB, 0);
    __builtin_amdgcn_sched_group_barrier(0x100, 2 + NB, 0); __builtin_amdgcn_sched_group_barrier(0x008, 2 * NB, 0);
    __builtin_amdgcn_sched_group_barrier(0x008, 2 * NB, 0);
  }
}

DI void gemm256(const bf16_t* __restrict__ A, size_t lda, const bf16_t* __restrict__ Bt, size_t ldb, int K, unsigned char* lds, GemmAcc (&acc)[2], int tid) {
  const int lane = tid & 63, wid = __builtin_amdgcn_readfirstlane(tid >> 6), r = lane & 31, h = lane >> 5;
  const int wr = wid >> 2, wc = wid & 3;
#pragma unroll
  for (int mh = 0; mh < 2; ++mh)
#pragma unroll
    for (int a = 0; a < 2; ++a)
#pragma unroll
      for (int b = 0; b < 2; ++b) acc[mh].a[a][b] = zero16();
  const int nk = K / 64;
  unsigned aoff[4], boff[4];
#pragma unroll
  for (int e = 0; e < 4; ++e) {
    const int row = 8 * (wid * 4 + e) + (lane >> 3), lc = (lane & 7) ^ ((row >> 1) & 7);
    aoff[e] = (unsigned)row * (unsigned)lda + 8u * lc; boff[e] = (unsigned)row * (unsigned)ldb + 8u * lc;
  }
  auto issue = [&](int kt, int buf) {
    unsigned char* base = lds + buf * 65536;
#pragma unroll
    for (int e = 0; e < 4; ++e) { dma16(A + (aoff[e] + 64u * kt), base + (wid * 4 + e) * 1024); dma16(Bt + (boff[e] + 64u * kt), base + 32768 + (wid * 4 + e) * 1024); }
  };
  asm volatile("s_waitcnt vmcnt(0)" ::: "memory");
  __syncthreads();
  issue(0, 0);
  const unsigned sw = (r >> 1) & 7;
  unsigned co[4];
#pragma unroll
  for (int kk = 0; kk < 4; ++kk) co[kk] = (((2 * kk + h) ^ sw) << 4);
  const unsigned ra = (wr * 128 + r) * 128, rb = 32768 + (wc * 64 + r) * 128;
  for (int kt = 0; kt < nk; ++kt) {
    asm volatile("s_waitcnt vmcnt(0)" ::: "memory");
    asm volatile("s_waitcnt lgkmcnt(0)" ::: "memory");
    __builtin_amdgcn_s_barrier();
    if (kt + 1 < nk) issue(kt + 1, (kt + 1) & 1);
    const unsigned char* base = lds + (kt & 1) * 65536;
    const unsigned char* pa = base + ra;
    const unsigned char* pb = base + rb;
#pragma unroll
    for (int kk = 0; kk < 4; ++kk) {
      const bf16x8 b0 = ld16(pb + co[kk]), b1 = ld16(pb + 4096 + co[kk]);
#pragma unroll
      for (int mh = 0; mh < 2; ++mh) {
        const bf16x8 a0 = ld16(pa + 8192 * mh + co[kk]), a1 = ld16(pa + 8192 * mh + 4096 + co[kk]);
        acc[mh].a[0][0] = MFMA32(a0, b0, acc[mh].a[0][0]);
        acc[mh].a[0][1] = MFMA32(a0, b1, acc[mh].a[0][1]);
        acc[mh].a[1][0] = MFMA32(a1, b0, acc[mh].a[1][0]);
        acc[mh].a[1][1] = MFMA32(a1, b1, acc[mh].a[1][1]);
      }
    }
#define SGB_R(N) __builtin_amdgcn_sched_group_barrier(0x100, N, 0)
#define SGB_M(N) __builtin_amdgcn_sched_group_barrier(0x008, N, 0)
    SGB_R(4);
    SGB_R(2); SGB_M(4); SGB_R(4); SGB_M(4);
    SGB_R(2); SGB_M(4); SGB_R(4); SGB_M(4);
    SGB_R(2); SGB_M(4); SGB_R(4); SGB_M(4);
    SGB_R(2); SGB_M(4); SGB_M(4);
  }
}

DI void gate_scan(const Params& p, unsigned char* lds) {
  const int tid = TIDX, lane = tid & 63, wid = tid >> 6;
  unsigned char* ws = p.ws;
  float* s_ch = (float*)lds;
  float* s_mc = s_ch + NCH * 8;
  float* s_mn = s_mc + NCH * 4;
  __syncthreads();
  for (int i = tid; i < NCH * 8; i += NTHREADS) s_ch[i] = ((const float*)(ws + WS_CHS))[i];
  __syncthreads();
  if (tid < 4) {
    float m = 0.f, ld = 0.f;
    float* LD = (float*)(ws + WS_LD);
    const bool wr = blockIdx.x == 0;
    for (int c = 0; c < 256; ++c) {
      s_mc[c * 4 + tid] = m; if (wr) LD[c * 4 + tid] = ld;
      const float gl = s_ch[(c * 4 + tid) * 2], mn = gl + fmaxf(m, s_ch[(c * 4 + tid) * 2 + 1]);
      ld += gl + m - mn;
      m = mn; s_mn[c * 4 + tid] = m;
    }
    if (wr) { LD[256 * 4 + tid] = ld; p.out[O_PM + tid] = m; }
  } else if (tid >= 64 && tid < 128) {
    const int b = (tid - 64) >> 2, hd = tid & 3, pr = (256 + b) * 4 + hd;
    const float m0 = p.in[I_SM][b * 4 + hd];
    const float m = s_ch[pr * 2] + fmaxf(m0, s_ch[pr * 2 + 1]);
    s_mc[pr] = m0; s_mn[pr] = m;
    if (blockIdx.x == 0) p.out[O_SM + b * 4 + hd] = m;
  }
  __syncthreads();
  for (int cc = blockIdx.x; cc < NCH; cc += gridDim.x) {
    if (wid < 4) {
      const int hd = wid, pr = cc * 4 + hd;
      const size_t o = (size_t)pr * 64 + lane;
      const float g = ((const float*)(ws + WS_GC))[o], a = ((const float*)(ws + WS_AS))[o], pm = ((const float*)(ws + WS_PM))[o];
      const float mc = s_mc[pr], mn = s_mn[pr], gl = s_ch[pr * 2];
      const float mt = g + fmaxf(mc, pm);
      ((float*)(ws + WS_MT))[o] = mt;
      ((float*)(ws + WS_WS))[o] = __expf(gl + a - mn);
      ((float*)(ws + WS_WI))[o] = __expf(g + mc - mt);
      ((float*)(ws + WS_AS))[o] = a * LOG2E;
      ((float*)(ws + WS_BT))[o] = (g - mt) * LOG2E;
      if (lane == 0) { ((float*)(ws + WS_DEC))[pr] = __expf(gl + mc - mn); const float amx = s_ch[pr * 2 + 1]; ((float*)(ws + WS_CFAC))[pr] = __expf(amx - fmaxf(mc, amx)); }
    }
  }
  __syncthreads();
}

DI void phase1(const Params& p, unsigned char* lds) {
  const int tid = TIDX, lane = tid & 63, wid = tid >> 6, r = lane & 31, h = lane >> 5;
  unsigned char* ws = p.ws;
  gate_scan(p, lds);
  const int n_main = 68 * 24, n_mem = 16;
  for (int t = blockIdx.x; t < n_main + n_mem; t += gridDim.x) {
    if (t < n_main) {
      const int tm = t / 24, tn = t % 24, m0 = tm * 256, n0 = tn * 256;
      GemmAcc acc2[2];
      gemm256((const bf16_t*)(ws + WS_XN) + (size_t)m0 * 1024, 1024, (const bf16_t*)(ws + WS_WA) + (size_t)n0 * 1024, 1024, 1024, lds, acc2, tid);
#pragma unroll
      for (int mh = 0; mh < 2; ++mh) {
      const GemmAcc& acc = acc2[mh];
      const int wr = (wid >> 2) * 2 + mh, wc = wid & 3;
      bf16_t* PA = (bf16_t*)(ws + WS_R1);
      const int sec = n0 >> 10;
#pragma unroll
      for (int a = 0; a < 2; ++a)
#pragma unroll
        for (int b = 0; b < 2; ++b) {
          __builtin_amdgcn_sched_barrier(0);
          const int n = n0 + wc * 64 + 32 * b + r, mb = m0 + wr * 64 + 32 * a;
          if (sec != 2) {
            const float sc = sec == 1 ? 0.0625f : 1.f;
            const int pc = (n >> 2) & 3, np = sec <= 1 ? (n & ~15) + 4 * (((pc & 1) << 1) | (pc >> 1)) + (n & 3) : n;
#pragma unroll
            for (int i = 0; i < 16; ++i) PA[(size_t)(mb + crow(i, h)) * 6144 + np] = f2bf(acc.a[a][b][i] * sc);
          }
          if (sec == 1 || sec == 2) {
            const float sc = sec == 1 ? 0.0625f : 1.f;
            const int f = n & 1023, hd = f >> 8, fe = f & 255;
            bf16_t* T = (bf16_t*)(ws + (sec == 1 ? WS_KT : WS_VTA));
#pragma unroll
            for (int g = 0; g < 4; ++g) {
              const int m = mb + 8 * g + 4 * h, cc = m >> 6, s = m & 63;
              u32x2 o = {pk2(acc.a[a][b][4 * g] * sc, acc.a[a][b][4 * g + 1] * sc), pk2(acc.a[a][b][4 * g + 2] * sc, acc.a[a][b][4 * g + 3] * sc)};
              *(u32x2*)(T + (((size_t)cc * 4 + hd) * 256 + fe) * 64 + s) = o;
              if (sec == 2) {
                const f32x4 u = *(const f32x4*)((const float*)(ws + WS_U) + ((size_t)cc * 4 + hd) * 64 + s);
                u32x2 ow = {pk2(acc.a[a][b][4 * g] * u[0], acc.a[a][b][4 * g + 1] * u[1]), pk2(acc.a[a][b][4 * g + 2] * u[2], acc.a[a][b][4 * g + 3] * u[3])};
                *(u32x2*)((bf16_t*)(ws + WS_WVT) + (((size_t)cc * 4 + hd) * 288 + fe) * 64 + s) = ow;
              }
            }
          }
        }
      }
    } else {
      GemmAcc acc;
      const int wr = wid >> 1, wc = wid & 1;
      const int tt = t - n_main, l = tt >> 3, n0 = (tt & 7) * 128;
      gemm_tile((const bf16_t*)(ws + WS_MEMN) + (size_t)l * 256 * 1024, 1024, (const bf16_t*)(ws + WS_WM) + ((size_t)l * 1024 + n0) * 1024, 1024, 1024, lds, acc, tid);
      const bool isv = n0 >= 512;
      float* of = p.out + (isv ? O_PMV : O_PMK) + (size_t)l * 131072;
      bf16_t* mk = (bf16_t*)(ws + WS_MEMK) + (size_t)(l * 17) * 131072;
      bf16_t* mv = (bf16_t*)(ws + WS_MEMVT) + (size_t)(l * 17) * 131072;
#pragma unroll
      for (int a = 0; a < 2; ++a)
#pragma unroll
        for (int b = 0; b < 2; ++b) {
          __builtin_amdgcn_sched_barrier(0);
          const int f = (n0 & 511) + wc * 64 + 32 * b + r, mb = wr * 64 + 32 * a;
#pragma unroll
          for (int g = 0; g < 4; ++g) {
            const int m = mb + 8 * g + 4 * h;
            float* o4 = of + (size_t)m * 512 + f;
            o4[0] = acc.a[a][b][4 * g]; o4[512] = acc.a[a][b][4 * g + 1]; o4[1024] = acc.a[a][b][4 * g + 2]; o4[1536] = acc.a[a][b][4 * g + 3];
            if (!isv) {
              bf16_t* k4 = mk + (size_t)m * 512 + f;
              k4[0] = f2bf(acc.a[a][b][4 * g]); k4[512] = f2bf(acc.a[a][b][4 * g + 1]); k4[1024] = f2bf(acc.a[a][b][4 * g + 2]); k4[1536] = f2bf(acc.a[a][b][4 * g + 3]);
            } else {
              u32x2 o = {pk2(acc.a[a][b][4 * g], acc.a[a][b][4 * g + 1]), pk2(acc.a[a][b][4 * g + 2], acc.a[a][b][4 * g + 3])};
              const int pq = (m >> 2) & 3, mp = (m & ~15) + 4 * (((pq & 1) << 1) | (pq >> 1));
              *(u32x2*)(mv + (size_t)f * 256 + mp) = o;
            }
          }
        }
    }
  }
}

DI void scan_task(const Params& p, unsigned char* lds, int sb  , int hd, int j, int grp) {
  const int tid = TIDX, lane = tid & 63, wid = tid >> 6, r = lane & 31, h = lane >> 5;
  unsigned char* ws = p.ws;
  const int cc0 = sb < 0 ? GRP * grp : 256 + sb, nch = sb < 0 ? GRP : 1;
  const bf16_t* PA = (const bf16_t*)(ws + WS_R1);
  const bf16_t* KT = (const bf16_t*)(ws + WS_KT);
  const bf16_t* VT = (const bf16_t*)(ws + WS_VTA);
  const float* WSa = (const float*)(ws + WS_WS);
  const float* WIa = (const float*)(ws + WS_WI);
  const float* DEC = (const float*)(ws + WS_DEC);
  float* red = (float*)lds;
  const bool nsl = j == 8;
  f32x16 S = zero16();
  if (sb >= 0) {
    if (!nsl) {
      const float* C0 = p.in[I_SC] + ((size_t)(sb * 4 + hd) * 256 + 32 * j + r) * 256 + 32 * wid;
#pragma unroll
      for (int g = 0; g < 4; ++g) { const f32x4 c = *(const f32x4*)(C0 + 8 * g + 4 * h); S[4 * g] = c[0]; S[4 * g + 1] = c[1]; S[4 * g + 2] = c[2]; S[4 * g + 3] = c[3]; }
    } else if (r == 0) {
      const float* n0 = p.in[I_SN] + (size_t)(sb * 4 + hd) * 256 + 32 * wid;
#pragma unroll
      for (int g = 0; g < 4; ++g) { const f32x4 c = *(const f32x4*)(n0 + 8 * g + 4 * h); S[4 * g] = c[0]; S[4 * g + 1] = c[1]; S[4 * g + 2] = c[2]; S[4 * g + 3] = c[3]; }
    }
  }
  bf16x8 kt[4], wv[4], qf[2][2];
  u32x4 ktn[4], vn[4], qn[2][2];
  float wsn;
  float* wsl = (float*)(lds + 69632);
  auto loadraw = [&](int cc) {
    const size_t ch = (size_t)cc * 4 + hd;
    const bf16_t* kp = KT + (ch * 256 + 32 * wid + r) * 64 + 8 * h;
#pragma unroll
    for (int st = 0; st < 4; ++st) ktn[st] = *(const u32x4*)(kp + 16 * st);
    wsn = WSa[ch * 64 + lane];
    if (!nsl) {
      const bf16_t* vp = VT + (ch * 256 + 32 * j + r) * 64 + 8 * h;
#pragma unroll
      for (int st = 0; st < 4; ++st) vn[st] = *(const u32x4*)(vp + 16 * st);
    }
#pragma unroll
    for (int tt = 0; tt < 2; ++tt) {
      const bf16_t* qp = PA + (size_t)(cc * 64 + 32 * tt + r) * 6144 + hd * 256 + 32 * wid + 8 * h;
#pragma unroll
      for (int s2 = 0; s2 < 2; ++s2) qn[tt][s2] = *(const u32x4*)(qp + 16 * s2);
    }
  };
  auto convert = [&]() {
    __syncthreads();
    if (wid == 0) wsl[lane] = wsn;
    __syncthreads();
#pragma unroll
    for (int st = 0; st < 4; ++st) {
      kt[st] = __builtin_bit_cast(bf16x8, ktn[st]);
      const f32x4 w0 = *(const f32x4*)(wsl + 16 * st + 8 * h), w1 = *(const f32x4*)(wsl + 16 * st + 8 * h + 4);
      u32x4 o;
      if (!nsl) {
        const u32x4 v = vn[st];
        o[0] = pk2(bflo(v[0]) * w0[0], bfhi(v[0]) * w0[1]); o[1] = pk2(bflo(v[1]) * w0[2], bfhi(v[1]) * w0[3]);
        o[2] = pk2(bflo(v[2]) * w1[0], bfhi(v[2]) * w1[1]); o[3] = pk2(bflo(v[3]) * w1[2], bfhi(v[3]) * w1[3]);
      } else {
        o = (u32x4){pk2(w0[0], w0[1]), pk2(w0[2], w0[3]), pk2(w1[0], w1[1]), pk2(w1[2], w1[3])};
        if (r != 0) o = (u32x4){0u, 0u, 0u, 0u};
      }
      wv[st] = __builtin_bit_cast(bf16x8, o);
    }
#pragma unroll
    for (int tt = 0; tt < 2; ++tt)
#pragma unroll
      for (int s2 = 0; s2 < 2; ++s2) qf[tt][s2] = __builtin_bit_cast(bf16x8, qn[tt][s2]);
  };
  loadraw(cc0);
  convert();
  for (int c = 0; c < nch; ++c) {
    const int cc = cc0 + c;
    if (c + 1 < nch) loadraw(cc + 1);
    const float dec = DEC[cc * 4 + hd];
    const bf16x8 xs0 = pack_acc(S, 0), xs1 = pack_acc(S, 1);
    f32x16 z0 = MFMA32(xs0, qf[0][0], zero16()); z0 = MFMA32(xs1, qf[0][1], z0);
    f32x16 z1 = MFMA32(xs0, qf[1][0], zero16()); z1 = MFMA32(xs1, qf[1][1], z1);
    S = S * dec;
#pragma unroll
    for (int st = 0; st < 4; ++st) S = MFMA32(kt[st], wv[st], S);
    __syncthreads();
    {
      float* rw = red + wid * (64 * 33);
#pragma unroll
      for (int i = 0; i < 16; ++i) { rw[r * 33 + crow(i, h)] = z0[i]; rw[(32 + r) * 33 + crow(i, h)] = z1[i]; }
    }
    __syncthreads();
    {
      const int v = tid & 31;
#pragma unroll
      for (int e = 0; e < 4; ++e) {
        const int t = (tid >> 5) + 16 * e;
        float s = 0.f;
#pragma unroll
        for (int w8 = 0; w8 < 8; ++w8) s += red[w8 * (64 * 33) + t * 33 + v];
        const float wi = WIa[((size_t)cc * 4 + hd) * 64 + t];
        if (!nsl) ((float*)(ws + WS_HINTER))[(size_t)(cc * 64 + t) * 1024 + hd * 256 + 32 * j + v] = s * wi;
        else if (v == 0) ((float*)(ws + WS_DENI))[(size_t)(cc * 64 + t) * 4 + hd] = s * wi;
      }
    }
    if (c + 1 < nch) convert();
  }
  if (sb < 0) {
    float* cl = (float*)(ws + WS_CLOC) + ((((size_t)(grp * 4 + hd) * 9 + j) * 8 + wid) * 64 + lane) * 16;
#pragma unroll
    for (int g = 0; g < 4; ++g) { f32x4 c = {S[4 * g], S[4 * g + 1], S[4 * g + 2], S[4 * g + 3]}; *(f32x4*)(cl + 4 * g) = c; }
  } else {
    if (!nsl) {
      float* Co = (sb < 0 ? p.out + O_PC + (size_t)hd * 65536 : p.out + O_SC + (size_t)(sb * 4 + hd) * 65536) + (size_t)(32 * j + r) * 256 + 32 * wid;
#pragma unroll
      for (int g = 0; g < 4; ++g) { f32x4 c = {S[4 * g], S[4 * g + 1], S[4 * g + 2], S[4 * g + 3]}; *(f32x4*)(Co + 8 * g + 4 * h) = c; }
    } else if (r == 0) {
      float* no = (sb < 0 ? p.out + O_PN + (size_t)hd * 256 : p.out + O_SN + (size_t)(sb * 4 + hd) * 256) + 32 * wid;
#pragma unroll
      for (int g = 0; g < 4; ++g) { f32x4 c = {S[4 * g], S[4 * g + 1], S[4 * g + 2], S[4 * g + 3]}; *(f32x4*)(no + 8 * g + 4 * h) = c; }
    }
  }
  __syncthreads();
}

DI void intra_task(const Params& p, int cc, int hd) {
  const int tid = TIDX, lane = tid & 63, wid = tid >> 6, r = lane & 31, h = lane >> 5;
  unsigned char* ws = p.ws;
  const int tt = wid & 1, vq = wid >> 1;
  const bf16_t* PA = (const bf16_t*)(ws + WS_R1);
  const bf16_t* VT = (const bf16_t*)(ws + WS_VTA);
  const size_t ch = (size_t)cc * 4 + hd;
  f32x16 s0 = zero16(), s1 = zero16();
  {
    const bf16_t* qp = PA + (size_t)(cc * 64 + 32 * tt + r) * 6144 + hd * 256 + 8 * h;
    const bf16_t* kp = PA + (size_t)(cc * 64 + r) * 6144 + 1024 + hd * 256 + 8 * h;
#pragma unroll 4
    for (int kk = 0; kk < 16; ++kk) {
      const bf16x8 q = ld16(qp + 16 * kk), k0 = ld16(kp + 16 * kk), k1 = ld16(kp + (size_t)32 * 6144 + 16 * kk);
      s0 = MFMA32(k0, q, s0);
      if (tt == 1) s1 = MFMA32(k1, q, s1);
    }
  }
  const int t = 32 * tt + r;
  const float bt = ((const float*)(ws + WS_BT))[ch * 64 + t];
  const float* asp = (const float*)(ws + WS_AS) + ch * 64;
  float den = 0.f;
#pragma unroll
  for (int g = 0; g < 4; ++g) {
    const f32x4 a0 = *(const f32x4*)(asp + 8 * g + 4 * h);
    const f32x4 a1 = *(const f32x4*)(asp + 32 + 8 * g + 4 * h);
#pragma unroll
    for (int e = 0; e < 4; ++e) {
      const int s = 8 * g + 4 * h + e;
      const float w0 = s <= t ? fexp2(bt + a0[e]) : 0.f;
      const float w1 = (32 + s) <= t ? fexp2(bt + a1[e]) : 0.f;
      s0[4 * g + e] *= w0; s1[4 * g + e] *= w1;
      den += s0[4 * g + e] + s1[4 * g + e];
    }
  }
  den += __shfl_xor(den, 32);
  if (vq == 0 && h == 0) ((float*)(ws + WS_DENA))[(size_t)(cc * 64 + t) * 4 + hd] = den;
  bf16x8 pf[2][2];
  pf[0][0] = pack_acc(s0, 0); pf[0][1] = pack_acc(s0, 1); pf[1][0] = pack_acc(s1, 0); pf[1][1] = pack_acc(s1, 1);
  float* Ho = (float*)(ws + WS_HINTRA) + (size_t)(cc * 64 + t) * 1024 + hd * 256;
#pragma unroll
  for (int vt = 0; vt < 2; ++vt) {
    const int v0 = vq * 64 + vt * 32;
    const bf16_t* vp = VT + (ch * 256 + v0 + r) * 64 + 4 * h;
    f32x16 o = zero16();
#pragma unroll
    for (int st = 0; st < 2; ++st)
#pragma unroll
      for (int s2 = 0; s2 < 2; ++s2) {
        const bf16x8 a = ld8x2(vp + 32 * st + 16 * s2, vp + 32 * st + 16 * s2 + 8);
        o = MFMA32(a, pf[st][s2], o);
      }
#pragma unroll
    for (int g = 0; g < 4; ++g) { f32x4 c = {o[4 * g], o[4 * g + 1], o[4 * g + 2], o[4 * g + 3]}; *(f32x4*)(Ho + v0 + 8 * g + 4 * h) = c; }
  }
}

DI void memattn_task(const Params& p, unsigned char* lds, int task, int layer, const bf16_t* Qb, const bf16_t* Zb, unsigned ldq) {
  const int tid = TIDX, lane = tid & 63, wid = __builtin_amdgcn_readfirstlane(tid >> 6), r = lane & 31, h = lane >> 5;
  unsigned char* ws = p.ws;
  const bool prm = task < 256;
  const int hd = task & 3, ti = prm ? task >> 2 : (task - 256) >> 2;
  const int sbi = prm ? 0 : 1 + ti, tok0 = prm ? ti * 256 : TP + ti * 64, nact = prm ? 8 : 2;
  const bf16_t* MK = (const bf16_t*)(ws + WS_MEMK) + (size_t)(layer * 17 + sbi) * 131072 + hd * 128;
  const bf16_t* MV = (const bf16_t*)(ws + WS_MEMVT) + ((size_t)(layer * 17 + sbi) * 4 + hd) * 128 * 256;
  asm volatile("s_waitcnt vmcnt(0)" ::: "memory");
  __syncthreads();
#pragma unroll
  for (int e = 0; e < 8; ++e) {
    const int q = wid * 8 + e;
    { const int row = 4 * q + (lane >> 4), lc = (lane & 15) ^ (row & 15); dma16(MK + ((unsigned)row * 512u + 8u * lc), lds + q * 1024); }
    { const int row = 2 * q + (lane >> 5), lc = (lane & 31) ^ (row & 15); dma16(MV + ((unsigned)row * 256u + 8u * lc), lds + 65536 + q * 1024); }
  }
  const int tok = tok0 + (wid < nact ? wid : 0) * 32 + r;
  bf16x8 qf[8];
  {
    const bf16_t* qp = Qb + ((unsigned)tok * ldq + hd * 128 + 8 * h);
#pragma unroll
    for (int kk = 0; kk < 8; ++kk) qf[kk] = ld16(qp + 16 * kk);
  }
  asm volatile("s_waitcnt vmcnt(0)" ::: "memory");
  __syncthreads();
  if (wid >= nact) return;
  const float sc = 0.08838834764831845f * LOG2E;
  f32x16 O[4];
#pragma unroll
  for (int vt = 0; vt < 4; ++vt) O[vt] = zero16();
  float mrun = -1e30f, l = 0.f;
  const unsigned sw = r & 15;
#pragma unroll 1
  for (int kb = 0; kb < 4; ++kb) {
    f32x16 s0 = zero16(), s1 = zero16();
    const unsigned char* kp = lds + (kb * 64 + r) * 256;
#pragma unroll
    for (int kk = 0; kk < 8; ++kk) {
      const unsigned co = ((unsigned)(2 * kk + h) ^ sw) << 4;
      const bf16x8 k0 = ld16(kp + co), k1 = ld16(kp + 8192 + co);
      s0 = MFMA32(k0, qf[kk], s0); s1 = MFMA32(k1, qf[kk], s1);
    }
    float mx = -1e30f;
#pragma unroll
    for (int i = 0; i < 16; ++i) mx = fmaxf(mx, fmaxf(s0[i], s1[i]));
    mx = fmaxf(mx, __shfl_xor(mx, 32)) * sc;
    const float mnew = fmaxf(mrun, mx), alpha = fexp2(mrun - mnew);
    mrun = mnew;
    float sum = 0.f;
#pragma unroll
    for (int i = 0; i < 16; ++i) { s0[i] = fexp2(s0[i] * sc - mnew); s1[i] = fexp2(s1[i] * sc - mnew); sum += s0[i] + s1[i]; }
    l = l * alpha + sum;
#pragma unroll
    for (int vt = 0; vt < 4; ++vt) O[vt] = O[vt] * alpha;
    bf16x8 pf[2][2];
    pf[0][0] = pack_acc(s0, 0); pf[0][1] = pack_acc(s0, 1); pf[1][0] = pack_acc(s1, 0); pf[1][1] = pack_acc(s1, 1);
#pragma unroll
    for (int vt = 0; vt < 4; ++vt) {
      const unsigned char* vp = lds + 65536 + (32 * vt + r) * 512;
#pragma unroll
      for (int st = 0; st < 2; ++st)
#pragma unroll
        for (int s2 = 0; s2 < 2; ++s2) {
          const unsigned co = ((unsigned)(8 * kb + 4 * st + 2 * s2 + h) ^ sw) << 4;
          O[vt] = MFMA32(ld16(vp + co), pf[st][s2], O[vt]);
        }
    }
  }
  l += __shfl_xor(l, 32);
  const float inv = 1.f / l;
  const bf16_t* zp = Zb + ((unsigned)tok * ldq + hd * 128);
  bf16_t* op = (bf16_t*)(ws + WS_AO) + ((unsigned)tok * 1536u + 1024 + hd * 128);
#pragma unroll
  for (int vt = 0; vt < 4; ++vt)
#pragma unroll
    for (int g = 0; g < 4; ++g) {
      const int v = 32 * vt + 8 * g + 4 * h;
      const u32x2 z = *(const u32x2*)(zp + v);
      const float o0 = O[vt][4 * g] * inv * siluf_(bflo(z[0])), o1 = O[vt][4 * g + 1] * inv * siluf_(bfhi(z[0]));
      const float o2 = O[vt][4 * g + 2] * inv * siluf_(bflo(z[1])), o3 = O[vt][4 * g + 3] * inv * siluf_(bfhi(z[1]));
      u32x2 o = {pk2(o0, o1), pk2(o2, o3)};
      *(u32x2*)(op + v) = o;
    }
}

DI int next_item(unsigned* ctr, unsigned char* lds_flag_area, int tid) {
  __syncthreads();
  int* sh = (int*)lds_flag_area;
  if (tid == 0) *sh = (int)atomicAdd(ctr, 1u);
  __syncthreads();
  const int v = *sh;
  return v;
}

DI void scanA_task(const Params& p, int hd, int j, int grp);

DI void phase2(const Params& p, unsigned char* lds) {
  unsigned* ctr = (unsigned*)(p.ws + WS_CTR) + 0 + 8 * p.pad;
  const bf16_t* PA = (const bf16_t*)(p.ws + WS_R1);
  const int n_ps = 36 * 16, n_ss = 576, n_in = NCH * 4, n_ma = 256 + 64;
  for (;;) {
    const int it = next_item(ctr, lds + LDS_BYTES - 16, TIDX);
    if (it >= n_ps + n_ss + n_in + n_ma) break;
    if (it < n_ps) scanA_task(p, (it % 36) / 9, it % 9, it / 36);
    else if (it < n_ps + n_ss) { const int q = it - n_ps; scan_task(p, lds, q / 36, (q % 36) / 9, q % 9, 0); }
    else if (it < n_ps + n_ss + n_in) { const int q = it - n_ps - n_ss; intra_task(p, q >> 2, q & 3); }
    else { const int q = it - n_ps - n_ss - n_in; memattn_task(p, lds, q, 0, PA + 5120, PA + 5632, 6144); }
  }
}


DI void scanA_task(const Params& p, int hd, int j, int grp) {
  const int tid = TIDX, lane = tid & 63, wid = tid >> 6, r = lane & 31, h = lane >> 5;
  unsigned char* ws = p.ws;
  const bf16_t* KT = (const bf16_t*)(ws + WS_KT);
  const bf16_t* WV = (const bf16_t*)(ws + WS_WVT);
  f32x16 S = zero16();
  u32x4 kn[4], vn[4];
  auto load = [&](int cc) {
    const size_t ch = (size_t)cc * 4 + hd;
    const bf16_t* kp = KT + (ch * 256 + 32 * wid + r) * 64 + 8 * h;
    const bf16_t* vp = WV + (ch * 288 + 32 * j + r) * 64 + 8 * h;
#pragma unroll
    for (int st = 0; st < 4; ++st) { kn[st] = *(const u32x4*)(kp + 16 * st); vn[st] = *(const u32x4*)(vp + 16 * st); }
  };
  load(GRP * grp);
#pragma unroll 1
  for (int c = 0; c < GRP; ++c) {
    const int cc = GRP * grp + c;
    bf16x8 kt[4], wv[4];
#pragma unroll
    for (int st = 0; st < 4; ++st) { kt[st] = __builtin_bit_cast(bf16x8, kn[st]); wv[st] = __builtin_bit_cast(bf16x8, vn[st]); }
    if (c + 1 < GRP) load(cc + 1);
    u32x4* cl = (u32x4*)(ws + WS_CLOCC) + ((((size_t)cc * 4 + hd) * 9 + j) * 8 + wid) * 128 + lane;
    cl[0] = __builtin_bit_cast(u32x4, pack_acc(S, 0));
    cl[64] = __builtin_bit_cast(u32x4, pack_acc(S, 1));
    f32x16 D = zero16();
#pragma unroll
    for (int st = 0; st < 4; ++st) D = MFMA32(kt[st], wv[st], D);
    const float dec = ((const float*)(ws + WS_DEC))[cc * 4 + hd], cf = ((const float*)(ws + WS_CFAC))[cc * 4 + hd];
    S = S * dec + D * cf;
  }
  float* cl = (float*)(ws + WS_CLOC) + ((((size_t)(grp * 4 + hd) * 9 + j) * 8 + wid) * 64 + lane) * 16;
#pragma unroll
  for (int g = 0; g < 4; ++g) { f32x4 c = {S[4 * g], S[4 * g + 1], S[4 * g + 2], S[4 * g + 3]}; *(f32x4*)(cl + 4 * g) = c; }
}

DI void scanfix_task(const Params& p, unsigned char* lds, int grp, int hd, int j) {
  const int tid = TIDX, lane = tid & 63, wid = tid >> 6, r = lane & 31, h = lane >> 5;
  unsigned char* ws = p.ws;
  const bool nsl = j == 8;
  const float* LD = (const float*)(ws + WS_LD);
  f32x16 S = zero16();
#pragma unroll 4
  for (int gp = 0; gp < grp; ++gp) {
    const float dg = __expf(LD[(GRP * (gp + 1)) * 4 + hd] - LD[(GRP * gp) * 4 + hd]);
    const float* cl = (const float*)(ws + WS_CLOC) + ((((size_t)(gp * 4 + hd) * 9 + j) * 8 + wid) * 64 + lane) * 16;
#pragma unroll
    for (int g = 0; g < 4; ++g) { const f32x4 c = *(const f32x4*)(cl + 4 * g);
      S[4 * g] = S[4 * g] * dg + c[0]; S[4 * g + 1] = S[4 * g + 1] * dg + c[1]; S[4 * g + 2] = S[4 * g + 2] * dg + c[2]; S[4 * g + 3] = S[4 * g + 3] * dg + c[3]; }
  }
  if (grp == 16) {
    if (!nsl) {
      float* Co = p.out + O_PC + (size_t)hd * 65536 + (size_t)(32 * j + r) * 256 + 32 * wid;
#pragma unroll
      for (int g = 0; g < 4; ++g) { f32x4 c = {S[4 * g], S[4 * g + 1], S[4 * g + 2], S[4 * g + 3]}; *(f32x4*)(Co + 8 * g + 4 * h) = c; }
    } else if (r == 0) {
      float* no = p.out + O_PN + (size_t)hd * 256 + 32 * wid;
#pragma unroll
      for (int g = 0; g < 4; ++g) { f32x4 c = {S[4 * g], S[4 * g + 1], S[4 * g + 2], S[4 * g + 3]}; *(f32x4*)(no + 8 * g + 4 * h) = c; }
    }
    return;
  }
  u32x4* fr = (u32x4*)lds;
  float* tp = (float*)(lds + 16384) + wid * (64 * 33);
  __syncthreads();
  fr[(wid * 2 + 0) * 64 + lane] = __builtin_bit_cast(u32x4, pack_acc(S, 0));
  fr[(wid * 2 + 1) * 64 + lane] = __builtin_bit_cast(u32x4, pack_acc(S, 1));
  __syncthreads();
  const bf16_t* PA = (const bf16_t*)(ws + WS_R1);
  const float* WIa = (const float*)(ws + WS_WI);
  const bool hasg = grp > 0;
#pragma unroll 1
  for (int ci = 0; ci < 2; ++ci) {
    const int cc = GRP * grp + wid + 8 * ci;
    const float D = __expf(LD[cc * 4 + hd] - LD[(GRP * grp) * 4 + hd]);
    const u32x4* clc = (const u32x4*)(ws + WS_CLOCC) + (((size_t)cc * 4 + hd) * 9 + j) * 8 * 128 + lane;
#pragma unroll
    for (int tt = 0; tt < 2; ++tt) {
      const bf16_t* qp = PA + (size_t)(cc * 64 + 32 * tt + r) * 6144 + hd * 256 + 8 * h;
      f32x16 z = zero16(), z2 = zero16();
#pragma unroll
      for (int kt = 0; kt < 8; ++kt)
#pragma unroll
        for (int s2 = 0; s2 < 2; ++s2) {
          const bf16x8 q = ld16(qp + 32 * kt + 16 * s2);
          z = MFMA32(__builtin_bit_cast(bf16x8, clc[(kt * 2 + s2) * 64]), q, z);
          if (hasg) z2 = MFMA32(__builtin_bit_cast(bf16x8, fr[(kt * 2 + s2) * 64 + lane]), q, z2);
        }
#pragma unroll
      for (int i = 0; i < 16; ++i) tp[(32 * tt + r) * 33 + crow(i, h)] = z[i] + D * z2[i];
    }
    const int v = lane & 31;
#pragma unroll 4
    for (int e = 0; e < 32; ++e) {
      const int t = 2 * e + (lane >> 5);
      const float val = tp[t * 33 + v] * WIa[((size_t)cc * 4 + hd) * 64 + t];
      if (!nsl) ((float*)(ws + WS_HINTER))[(size_t)(cc * 64 + t) * 1024 + hd * 256 + 32 * j + v] = val;
      else if (v == 0) ((float*)(ws + WS_DENI))[(size_t)(cc * 64 + t) * 4 + hd] = val;
    }
  }
}

DI void phase2c(const Params& p, unsigned char* lds) {
  unsigned* ctr = (unsigned*)(p.ws + WS_CTR) + 3 + 8 * p.pad;
  for (;;) {
    const int it = next_item(ctr, lds + LDS_BYTES - 16, TIDX);
    if (it >= 17 * 36) break;
    const int g = 16 - it / 36;
    scanfix_task(p, lds, g, (it % 36) / 9, it % 9);
  }
}

DI void phase3(const Params& p) {
  const int tid = TIDX, lane = tid & 63, wid = tid >> 6;
  unsigned char* ws = p.ws;
  const int gw = blockIdx.x * 8 + wid, nw = gridDim.x * 8;
  const bf16_t* PA = (const bf16_t*)(ws + WS_R1);
  for (int it = gw; it < TT * 4; it += nw) {
    const int tok = it >> 2, hd = it & 3, cc = tok >> 6, t = tok & 63;
    const size_t off = (size_t)tok * 1024 + hd * 256 + 4 * lane;
    const f32x4 a = *(const f32x4*)((const float*)(ws + WS_HINTER) + off), b = *(const f32x4*)((const float*)(ws + WS_HINTRA) + off);
    const float den = ((const float*)(ws + WS_DENI))[tok * 4 + hd] + ((const float*)(ws + WS_DENA))[tok * 4 + hd];
    const float mt = ((const float*)(ws + WS_MT))[((size_t)cc * 4 + hd) * 64 + t];
    const float dn = 1.f / fmaxf(fabsf(den), __expf(-mt));
    const u32x2 ou = *(const u32x2*)(PA + (size_t)tok * 6144 + 3072 + hd * 256 + 4 * lane);
    const u32x2 zu = *(const u32x2*)(PA + (size_t)tok * 6144 + 4096 + hd * 256 + 4 * lane);
    f32x4 hv = (a + b) * dn;
    hv[0] *= sigmoidf_(bflo(ou[0])); hv[1] *= sigmoidf_(bfhi(ou[0])); hv[2] *= sigmoidf_(bflo(ou[1])); hv[3] *= sigmoidf_(bfhi(ou[1]));
    float ss = hv[0] * hv[0] + hv[1] * hv[1] + hv[2] * hv[2] + hv[3] * hv[3];
    ss = wave_sum(ss);
    const float rstd = __builtin_amdgcn_rsqf(ss * (1.f / 256.f) + EPS);
    const f32x4 hg = *(const f32x4*)(p.in[I_HGA] + hd * 256 + 4 * lane);
    hv = hv * rstd * hg;
    hv[0] *= siluf_(bflo(zu[0])); hv[1] *= siluf_(bfhi(zu[0])); hv[2] *= siluf_(bflo(zu[1])); hv[3] *= siluf_(bfhi(zu[1]));
    u32x2 o = {pk2(hv[0], hv[1]), pk2(hv[2], hv[3])};
    *(u32x2*)((bf16_t*)(ws + WS_AO) + (size_t)tok * 1536 + hd * 256 + 4 * lane) = o;
  }
}

DI void cacheconv_item(const Params& p, unsigned char* lds, int it);

DI void phase_outproj(const Params& p, unsigned char* lds, int layer) {
  const int tid = TIDX, lane = tid & 63, wid = tid >> 6, r = lane & 31, h = lane >> 5, wr = wid >> 1, wc = wid & 1;
  unsigned char* ws = p.ws;
  const bf16_t* W = (const bf16_t*)(ws + (layer == 0 ? WS_WOA : WS_WOB));
  for (int t = blockIdx.x; t < 68 * 16; t += gridDim.x) {
    const int tm = t >> 4, tn = t & 15, m0 = tm * 256, n0 = tn * 64;
    GemmAcc acc;
    gemm_tile<1>((const bf16_t*)(ws + WS_AO) + (size_t)m0 * 1536, 1536, W + (size_t)n0 * 1536, 1536, 1536, lds, acc, tid);
#pragma unroll
    for (int a = 0; a < 2; ++a) {
      const int n = n0 + wc * 32 + r, mb = m0 + wr * 64 + 32 * a;
#pragma unroll
      for (int i = 0; i < 16; ++i) {
        const int m = mb + crow(i, h);
        if (layer == 0) {
          const float xv = m < TP ? p.in[I_XP][(size_t)m * 1024 + n] : p.in[I_XS][(size_t)(m - TP) * 1024 + n];
          ((float*)(ws + WS_Y1))[(size_t)m * 1024 + n] = xv + acc.a[a][0][i];
        } else {
          p.out[O_Y + (size_t)m * 1024 + n] = ((const float*)(ws + WS_Y1))[(size_t)m * 1024 + n] + acc.a[a][0][i];
        }
      }
    }
  }
  if (layer == 0) {
    unsigned* ctr = (unsigned*)(p.ws + WS_CTR) + 4 + 8 * p.pad;
    for (;;) {
      const int it = next_item(ctr, lds + LDS_BYTES - 16, TIDX);
      if (it >= 1024) break;
      cacheconv_item(p, lds, it);
    }
  }
}

DI void phase5(const Params& p, unsigned char* lds) {
  const int tid = TIDX, lane = tid & 63, wid = tid >> 6;
  unsigned char* ws = p.ws;
  const int gw = blockIdx.x * 8 + wid, nw = gridDim.x * 8;
  for (int r = gw; r < TT; r += nw) {
    f32x4 v[4];
    const float rstd = row_load_rstd((const float*)(ws + WS_Y1) + (size_t)r * 1024, v, lane);
    bf16_t* xn = (bf16_t*)(ws + WS_XN) + (size_t)r * 1024;
#pragma unroll
    for (int j = 0; j < 4; ++j) { const f32x4 xs = v[j] * rstd; u32x2 o = {pk2(xs[0], xs[1]), pk2(xs[2], xs[3])}; *(u32x2*)(xn + 4 * lane + 256 * j) = o; }
  }
}

DI void cacheconv_item(const Params& p, unsigned char* lds, int it) {
  const int tid = TIDX;
  unsigned char* ws = p.ws;
  if (it < 512) {
    const int b = it >> 5, slab = it & 31;
    float* smax = (float*)lds;
    const int hm = (tid & 127) >> 3;
    __syncthreads();
    if (tid < 16) smax[tid] = 0.f;
    __syncthreads();
    float mx = 0.f;
    const float* src = p.in[I_CK] + ((size_t)b * PAST + slab * 128) * 1024;
    bf16_t* dst = (bf16_t*)(ws + WS_KBS) + ((size_t)b * SKV + slab * 128) * 1024;
#pragma unroll 4
    for (int i = 0; i < 32; ++i) {
      const unsigned e = (unsigned)(i * NTHREADS + tid) * 8u;
      const f32x4 a = *(const f32x4*)(src + e), c = *(const f32x4*)(src + e + 4);
      u32x4 o = {pk2(a[0], a[1]), pk2(a[2], a[3]), pk2(c[0], c[1]), pk2(c[2], c[3])};
      *(u32x4*)(dst + e) = o;
      float ss = a[0] * a[0] + a[1] * a[1] + a[2] * a[2] + a[3] * a[3] + c[0] * c[0] + c[1] * c[1] + c[2] * c[2] + c[3] * c[3];
      ss += __shfl_xor(ss, 1); ss += __shfl_xor(ss, 2); ss += __shfl_xor(ss, 4);
      mx = fmaxf(mx, ss);
    }
    if ((tid & 7) == 0) atomicMax((unsigned*)smax + hm, __float_as_uint(mx));
    __syncthreads();
    if (tid < 16) atomicMax((unsigned*)(ws + WS_KMAX) + (1 + b) * 16 + tid, __float_as_uint(sqrtf(smax[tid])));
  } else {
    const int q = it - 512, jb = q >> 2, part = q & 3, b = jb >> 3, hd = jb & 7;
    TJob j = {p.in[I_CV] + (size_t)b * PAST * 1024 + hd * 128, 1024, (bf16_t*)(ws + WS_VTS) + ((size_t)(b * 8 + hd) * 128) * SKV, SKV, nullptr, 64, 1};
    for (int tile = part * 16; tile < part * 16 + 16; ++tile) run_tjob_tile(j, tile, (float*)lds, tid, true);
  }
}

DI void phase6(const Params& p, unsigned char* lds) {
  const int tid = TIDX, lane = tid & 63, wid = tid >> 6, r = lane & 31, h = lane >> 5;
  unsigned char* ws = p.ws;
  for (int t = blockIdx.x; t < 68 * 20; t += gridDim.x) {
    const int tm = t / 20, tn = t % 20, m0 = tm * 256, n0 = tn * 256;
    GemmAcc acc2[2];
    gemm256((const bf16_t*)(ws + WS_XN) + (size_t)m0 * 1024, 1024, (const bf16_t*)(ws + WS_WKB) + (size_t)n0 * 1024, 1024, 1024, lds, acc2, tid);
    const int sec = n0 >> 10;
    const bool samp = m0 >= TP;
#pragma unroll
    for (int mh = 0; mh < 2; ++mh) {
    const GemmAcc& acc = acc2[mh];
    const int wr = (wid >> 2) * 2 + mh, wc = wid & 3;
#pragma unroll
    for (int a = 0; a < 2; ++a)
#pragma unroll
      for (int b = 0; b < 2; ++b) {
        __builtin_amdgcn_sched_barrier(0);
        const int n = n0 + wc * 64 + 32 * b + r, mb = m0 + wr * 64 + 32 * a;
        if (sec == 0) {
          const int f = n;
          if (b == 1) {
            float mx = 0.f;
#pragma unroll
            for (int i = 0; i < 16; ++i) {
              float ss = acc.a[a][0][i] * acc.a[a][0][i] + acc.a[a][1][i] * acc.a[a][1][i];
              ss += __shfl_xor(ss, 1); ss += __shfl_xor(ss, 2); ss += __shfl_xor(ss, 4); ss += __shfl_xor(ss, 8); ss += __shfl_xor(ss, 16);
              mx = fmaxf(mx, ss);
            }
            mx = fmaxf(mx, __shfl_xor(mx, 32));
            if (lane == 0) {
              const int strm = samp ? 1 + ((mb - TP) >> 6) : 0;
              atomicMax((unsigned*)(ws + WS_KMAX) + strm * 16 + ((n0 + wc * 64) >> 6), __float_as_uint(sqrtf(mx)));
            }
          }
#pragma unroll
          for (int i = 0; i < 16; ++i) {
            const int m = mb + crow(i, h);
            const float v = acc.a[a][b][i];
            if (!samp) { (p.out + O_PK)[(unsigned)(m * 1024 + f)] = v; ((bf16_t*)(ws + WS_KBP))[(unsigned)(m * 1024 + f)] = f2bf(v); }
            else { const int ms = m - TP, bb = ms >> 6, s = ms & 63; (p.out + O_SK)[(unsigned)(ms * 1024 + f)] = v;
                   ((bf16_t*)(ws + WS_KBS))[(unsigned)((bb * SKV + PAST + s) * 1024 + f)] = f2bf(v); }
          }
        } else if (sec == 1) {
          const int f = n - 1024, hd = f >> 7, vd = f & 127;
#pragma unroll
          for (int i = 0; i < 16; ++i) {
            const int m = mb + crow(i, h);
            if (!samp) (p.out + O_PV)[(unsigned)(m * 1024 + f)] = acc.a[a][b][i]; else (p.out + O_SV)[(unsigned)((m - TP) * 1024 + f)] = acc.a[a][b][i];
          }
#pragma unroll
          for (int g = 0; g < 4; ++g) {
            const int m0r = mb + 8 * g + 4 * h, pq = (m0r >> 2) & 3;
            const int m = (m0r & ~15) + 4 * (((pq & 1) << 1) | (pq >> 1));
            u32x2 o = {pk2(acc.a[a][b][4 * g], acc.a[a][b][4 * g + 1]), pk2(acc.a[a][b][4 * g + 2], acc.a[a][b][4 * g + 3])};
            if (!samp) *(u32x2*)((bf16_t*)(ws + WS_VTP) + (unsigned)((hd * 128 + vd) * TP + m)) = o;
            else { const int ms = m - TP, bb = ms >> 6, s = ms & 63; *(u32x2*)((bf16_t*)(ws + WS_VTS) + (unsigned)(((bb * 8 + hd) * 128 + vd) * SKV + PAST + s)) = o; }
          }
        } else {
          const float sc = sec == 2 ? 0.125f * LOG2E : 1.f;
          bf16_t* PB = (bf16_t*)(ws + WS_PB);
#pragma unroll
          for (int i = 0; i < 16; ++i) PB[(unsigned)((mb + crow(i, h)) * 3072 + (n - 2048))] = f2bf(acc.a[a][b][i] * sc);
        }
      }
    }
  }
}

constexpr int A_BUF = 32768, A_KB = 16384, A_FLAGS = 3 * A_BUF;

DI void diffattn_task(const Params& p, unsigned char* lds, int sb  , int qt  , int hd, float lam) {
  const int tid = TIDX, lane = tid & 63, wid = __builtin_amdgcn_readfirstlane(tid >> 6), r = lane & 31, h = lane >> 5;
  unsigned char* ws = p.ws;
  const int cq = wid >> 2, sub = (wid >> 1) & 1, map = wid & 1;
  const int ncq = sb < 0 ? 2 : 1;
  const int base_chunk = sb < 0 ? 2 * qt : 64;
  const int tok0 = sb < 0 ? qt * 128 : TP + sb * 64;
  const bool wvalid = cq < ncq;
  const int qc = base_chunk + cq;
  const int tl = 32 * sub + r;
  const int tok = tok0 + 64 * (wvalid ? cq : 0) + tl;
  const bf16_t* Kb = sb < 0 ? (const bf16_t*)(ws + WS_KBP) + hd * 128 : (const bf16_t*)(ws + WS_KBS) + (size_t)sb * SKV * 1024 + hd * 128;
  const bf16_t* Vb = sb < 0 ? (const bf16_t*)(ws + WS_VTP) + (size_t)hd * 128 * TP : (const bf16_t*)(ws + WS_VTS) + (size_t)(sb * 8 + hd) * 128 * SKV;
  const unsigned ldv = sb < 0 ? TP : SKV;
  const bf16_t* PB = (const bf16_t*)(ws + WS_PB);
  bf16x8 qf[4];
  float qn = 0.f;
  {
    const unsigned qo = (unsigned)tok * 3072u + hd * 128 + map * 64 + 8 * h;
#pragma unroll
    for (int kk = 0; kk < 4; ++kk) {
      const u32x4 u = *(const u32x4*)(PB + (qo + 16 * kk));
      qf[kk] = __builtin_bit_cast(bf16x8, u);
#pragma unroll
      for (int e = 0; e < 4; ++e) { const float a = bflo(u[e]), b = bfhi(u[e]); qn += a * a + b * b; }
    }
    qn += __shfl_xor(qn, 32);
    qn = sqrtf(qn);
  }
  const float kmax = ((const float*)(ws + WS_KMAX))[(sb < 0 ? 0 : 1 + sb) * 16 + hd * 2 + map];
  const float shift = qn * kmax * 1.02f + 0.5f - 40.f;
  const float sl2 = exp2f(-(float)(hd + 1)) * LOG2E;
  const int wd = diff_window(hd);
  const float bh0 = sl2 * (float)(4 * h) - sl2 * (float)tl - shift, bh1 = bh0 + 32.f * sl2;
  float cs[16];
#pragma unroll
  for (int i = 0; i < 16; ++i) cs[i] = __uint_as_float(__builtin_amdgcn_readfirstlane(__float_as_uint(sl2 * (float)((i & 3) + 8 * (i >> 2)))));
  f32x16 O[4];
#pragma unroll
  for (int vt = 0; vt < 4; ++vt) O[vt] = zero16();
  float l = 0.f;
  const int jmax = base_chunk + ncq - 1;
  const int jmin = max(0, base_chunk - wd);
  const int nit = jmax - jmin + 1;
  unsigned kofs[2], vofs[2];
#pragma unroll
  for (int e = 0; e < 2; ++e) {
    const int q = wid * 2 + e;
    { const int row = 4 * q + (lane >> 4), lc = (lane & 15) ^ (row & 15); kofs[e] = (unsigned)row * 1024u + 8u * lc; }
    { const int row = 8 * q + (lane >> 3), lc = (lane & 7) ^ ((row >> 1) & 7); vofs[e] = (unsigned)row * ldv + 8u * lc; }
  }
  auto issue = [&](int j, int buf) {
    const bf16_t* kj = Kb + (size_t)j * 65536;
    const bf16_t* vj = Vb + (size_t)j * 64;
    unsigned char* base = lds + buf * A_BUF;
#pragma unroll
    for (int e = 0; e < 2; ++e) {
      dma16(kj + kofs[e], base + (wid * 2 + e) * 1024);
      dma16(vj + vofs[e], base + A_KB + (wid * 2 + e) * 1024);
    }
  };
  unsigned kco[4], vco[4];
#pragma unroll
  for (int kk = 0; kk < 4; ++kk) kco[kk] = (unsigned)r * 256u + ((((unsigned)(8 * map + 2 * kk + h)) ^ (unsigned)(r & 15)) << 4);
#pragma unroll
  for (int sx = 0; sx < 4; ++sx) vco[sx] = A_KB + (unsigned)r * 128u + ((((unsigned)(2 * sx + h)) ^ (unsigned)((r >> 1) & 7)) << 4);
  asm volatile("s_waitcnt vmcnt(0)" ::: "memory");
  __syncthreads();
  issue(jmax, 0);
  if (nit > 1) issue(jmax - 1, 1);
  for (int it = 0; it < nit; ++it) {
    const int j = jmax - it;
    if (it + 1 < nit) asm volatile("s_waitcnt vmcnt(4)" ::: "memory"); else asm volatile("s_waitcnt vmcnt(0)" ::: "memory");
    asm volatile("s_waitcnt lgkmcnt(0)" ::: "memory");
    __builtin_amdgcn_s_barrier();
    if (it + 2 < nit) issue(j - 2, (it + 2) % 3);
    if (wvalid && j <= qc && qc - j <= wd) {
      const unsigned char* base = lds + (it % 3) * A_BUF;
      const float dofs = sl2 * (float)((qc - j) * 64);
      float sum = 0.f;
#pragma unroll
      for (int half = 0; half < 2; ++half) {
        f32x16 sc;
        {
          float b0 = (half ? bh1 : bh0) - dofs;
          asm volatile("" : "+v"(b0));
#pragma unroll
          for (int i = 0; i < 16; ++i) sc[i] = b0 + cs[i];
        }
        if (j == qc) {
          int tlv = tl;
          asm volatile("" : "+v"(tlv));
          const float m2 = -2.f * sl2, xt = (float)(4 * h + 32 * half - tlv);
#pragma unroll
          for (int i = 0; i < 16; ++i) sc[i] = fmaf(m2, fmaxf(xt + (float)((i & 3) + 8 * (i >> 2)), 0.f), sc[i]);
        }
        {
          bf16x8 kf[4];
#pragma unroll
          for (int kk = 0; kk < 4; ++kk) kf[kk] = ld16(base + 8192 * half + kco[kk]);
#pragma unroll
          for (int kk = 0; kk < 4; ++kk) sc = MFMA32(kf[kk], qf[kk], sc);
        }
        bf16x8 vf[8];
#pragma unroll
        for (int vt = 0; vt < 4; ++vt) { vf[2 * vt] = ld16(base + 4096 * vt + vco[2 * half]); vf[2 * vt + 1] = ld16(base + 4096 * vt + vco[2 * half + 1]); }
#pragma unroll
        for (int i = 0; i < 16; ++i) { sc[i] = fexp2(sc[i]); sum += sc[i]; }
        const bf16x8 p0 = pack_acc(sc, 0), p1 = pack_acc(sc, 1);
#pragma unroll
        for (int vt = 0; vt < 4; ++vt) { O[vt] = MFMA32(vf[2 * vt], p0, O[vt]); O[vt] = MFMA32(vf[2 * vt + 1], p1, O[vt]); }
      }
      l += sum;
    }
  }
  asm volatile("s_waitcnt vmcnt(0)" ::: "memory");
  __syncthreads();
  l += __shfl_xor(l, 32);
  const float inv = wvalid ? 1.f / l : 0.f;
  float* xch = (float*)lds + (size_t)(wid >> 1) * 4096;
  if (map == 1 && wvalid) {
    const float sc = inv * lam;
#pragma unroll
    for (int vt = 0; vt < 4; ++vt)
#pragma unroll
      for (int i = 0; i < 16; ++i) xch[(vt * 16 + i) * 64 + lane] = O[vt][i] * sc;
  }
  __syncthreads();
  if (map == 0 && wvalid) {
    float ss = 0.f;
#pragma unroll
    for (int vt = 0; vt < 4; ++vt)
#pragma unroll
      for (int i = 0; i < 16; ++i) { const float o = O[vt][i] * inv - xch[(vt * 16 + i) * 64 + lane]; O[vt][i] = o; ss += o * o; }
    ss += __shfl_xor(ss, 32);
    const float lam_init = 0.8f - 0.6f * 0.7408182206817179f;
    const float rs = __builtin_amdgcn_rsqf(ss * (1.f / 128.f) + EPS) * (1.f - lam_init);
    const unsigned zo = (unsigned)tok * 3072u + 1024 + hd * 128, oo = (unsigned)tok * 1536u + hd * 128;
    bf16_t* AOp = (bf16_t*)(ws + WS_AO);
    const float* sg = p.in[I_SUBG];
#pragma unroll
    for (int vt = 0; vt < 4; ++vt)
#pragma unroll
      for (int g = 0; g < 4; ++g) {
        const int v = 32 * vt + 8 * g + 4 * h;
        const u32x2 z = *(const u32x2*)(PB + (zo + v));
        const f32x4 gg = *(const f32x4*)(sg + v);
        const float o0 = O[vt][4 * g] * rs * gg[0] * siluf_(bflo(z[0])), o1 = O[vt][4 * g + 1] * rs * gg[1] * siluf_(bfhi(z[0]));
        const float o2 = O[vt][4 * g + 2] * rs * gg[2] * siluf_(bflo(z[1])), o3 = O[vt][4 * g + 3] * rs * gg[3] * siluf_(bfhi(z[1]));
        u32x2 o = {pk2(o0, o1), pk2(o2, o3)};
        *(u32x2*)(AOp + (oo + v)) = o;
      }
  }
  __syncthreads();
}

DI void phase7(const Params& p, unsigned char* lds) {
  unsigned* ctr = (unsigned*)(p.ws + WS_CTR) + 1 + 8 * p.pad;
  const bf16_t* PB = (const bf16_t*)(p.ws + WS_PB);
  float lam;
  {
    const int lane = TIDX & 63;
    const float* lv = p.in[I_LAMB];
    const float a = wave_sum(lv[lane] * lv[64 + lane]), b = wave_sum(lv[128 + lane] * lv[192 + lane]);
    const float lam_init = 0.8f - 0.6f * 0.7408182206817179f;
    lam = __expf(a) - __expf(b) + lam_init;
  }
  const int n_s = 128, n_p = 1024, n_ma = 256 + 64;
  const int* tord = (const int*)(p.ws + WS_TORD);
  for (;;) {
    const int it = next_item(ctr, lds + LDS_BYTES - 16, TIDX);
    if (it >= n_s + n_p) break;
    const int a = tord[it];
    const bool pr = a < n_p;
    diffattn_task(p, lds, pr ? -1 : ((a - n_p) >> 3), pr ? (a >> 3) : 0, a & 7, lam);
  }
  for (;;) {
    const int it = next_item(ctr + 1, lds + LDS_BYTES - 16, TIDX);
    if (it >= n_ma) break;
    memattn_task(p, lds, it, 1, PB + 2048, PB + 2560, 3072);
  }
}

DI void phase9(const Params& p) {
  const int tid = TIDX, lane = tid & 63, wid = tid >> 6;
  const int gw = blockIdx.x * 8 + wid, nw = gridDim.x * 8;
  for (int r = gw; r < TT; r += nw) {
    f32x4 v[4];
    float* row = p.out + O_Y + (size_t)r * 1024;
    const float rstd = row_load_rstd(row, v, lane);
#pragma unroll
    for (int j = 0; j < 4; ++j) {
      const f32x4 g = *(const f32x4*)(p.in[I_FNG] + 4 * lane + 256 * j);
      *(f32x4*)(row + 4 * lane + 256 * j) = v[j] * rstd * g;
    }
  }
}

DI void grid_barrier(unsigned* bar, unsigned target, int tid) {
  asm volatile("s_waitcnt vmcnt(0)" ::: "memory");
  __syncthreads();
  if (tid == 0) {
    __builtin_amdgcn_fence(__ATOMIC_RELEASE, "agent");
    asm volatile("s_waitcnt vmcnt(0)" ::: "memory");
    __hip_atomic_fetch_add(bar, 1u, __ATOMIC_RELAXED, __HIP_MEMORY_SCOPE_AGENT);
    while (__hip_atomic_load(bar, __ATOMIC_RELAXED, __HIP_MEMORY_SCOPE_AGENT) < target) __builtin_amdgcn_s_sleep(1);
    __builtin_amdgcn_fence(__ATOMIC_ACQUIRE, "agent");
    asm volatile("s_waitcnt vmcnt(0)" ::: "memory");
  }
  __syncthreads();
}

__global__ __launch_bounds__(512) void mk(Params pin) {
  extern __shared__ __attribute__((aligned(16))) unsigned char lds[];
  Params p = pin;
  p.wv = __builtin_amdgcn_readfirstlane((int)(__builtin_amdgcn_workitem_id_x() >> 6));
  cg::grid_group grid = cg::this_grid();
  unsigned nbar = 0;
  unsigned* bar = (unsigned*)(p.ws + WS_CTR) + 32;
#define RUN_PHASE(PH, CALL) if (p.ph_lo <= PH && PH < p.ph_hi) { CALL; if (PH + 1 < p.ph_hi) { ++nbar; grid_barrier(bar, nbar * gridDim.x, TIDX); } }
  if (p.ph_lo <= 0 && 0 < p.ph_hi) { phase0(p, lds); if (1 < p.ph_hi) grid.sync(); }
  RUN_PHASE(1, phase1(p, lds))
  RUN_PHASE(2, phase2(p, lds))
  if (p.ph_lo <= 2 && 2 < p.ph_hi) { phase2c(p, lds); ++nbar; grid_barrier(bar, nbar * gridDim.x, TIDX); }
  RUN_PHASE(3, phase3(p))
  RUN_PHASE(4, phase_outproj(p, lds, 0))
  RUN_PHASE(5, phase5(p, lds))
  RUN_PHASE(6, phase6(p, lds))
  RUN_PHASE(7, phase7(p, lds))
  RUN_PHASE(8, phase_outproj(p, lds, 1))
  RUN_PHASE(9, phase9(p))
}

extern "C" void kernel_launch(void* const* d_in, const int* in_sizes, int n_in, void* d_out, int out_size,
                              void* d_ws, size_t ws_size, hipStream_t stream) {
  static int grid_blocks = 0;
  if (!grid_blocks) {
    int dev = 0, cus = 0, per_cu = 0;
    (void)hipGetDevice(&dev);
    (void)hipDeviceGetAttribute(&cus, hipDeviceAttributeMultiprocessorCount, dev);
    (void)hipFuncSetAttribute((const void*)mk, hipFuncAttributeMaxDynamicSharedMemorySize, LDS_BYTES);
    (void)hipOccupancyMaxActiveBlocksPerMultiprocessor(&per_cu, (const void*)mk, NTHREADS, LDS_BYTES);
    grid_blocks = cus;
    fprintf(stderr, "kernel_launch: cus=%d per_cu=%d grid=%d ws=%zu need=%zu\n", cus, per_cu, grid_blocks, ws_size, (size_t)WS_END);
  }
  if (ws_size < WS_END) { fprintf(stderr, "workspace too small\n"); return; }
  Params p{};
  for (int i = 0; i < 24; ++i) p.in[i] = (const float*)d_in[i];
  p.out = (float*)d_out; p.ws = (unsigned char*)d_ws; p.ph_lo = 0; p.ph_hi = NPHASE;
  void* args[] = {&p};
  hipError_t e = hipLaunchCooperativeKernel((const void*)mk, dim3(grid_blocks), dim3(NTHREADS), args, LDS_BYTES, stream);
  if (e != hipSuccess) fprintf(stderr, "cooperative launch failed: %s (grid %d)\n", hipGetErrorString(e), grid_blocks);
  if (PROBE_REP >= 0) {
    Params q = p;
    q.out = (float*)((unsigned char*)d_ws + WS_END); q.ph_lo = PROBE_REP; q.ph_hi = PROBE_REP + 1; q.pad = 1;
    void* args2[] = {&q};
    (void)hipLaunchCooperativeKernel((const void*)mk, dim3(grid_blocks), dim3(NTHREADS), args2, LDS_BYTES, stream);
  }
}
```

```cpp
#include <hip/hip_runtime.h>
#include <hip/hip_cooperative_groups.h>
#include <cstdio>
#include <cstdint>
namespace cg = cooperative_groups;

typedef unsigned short bf16_t;
typedef short bf16x8 __attribute__((ext_vector_type(8)));
typedef short s16x4 __attribute__((ext_vector_type(4)));
typedef float f32x16 __attribute__((ext_vector_type(16)));
typedef float f32x4 __attribute__((ext_vector_type(4)));
typedef float f32x2 __attribute__((ext_vector_type(2)));
typedef __bf16 bf2_t __attribute__((ext_vector_type(2)));
typedef unsigned u32x4 __attribute__((ext_vector_type(4)));
typedef unsigned u32x2 __attribute__((ext_vector_type(2)));
#define DI __device__ __forceinline__
#define MFMA32(a, b, c) __builtin_amdgcn_mfma_f32_32x32x16_bf16((a), (b), (c), 0, 0, 0)

struct Params { const float* in[24]; float* out; unsigned char* ws; int ph_lo, ph_hi; int wv, pad; };
#define TIDX (p.wv * 64 + (int)__builtin_amdgcn_mbcnt_hi(~0u, __builtin_amdgcn_mbcnt_lo(~0u, 0u)))
constexpr int LDS_BYTES = 148480;
constexpr int NTHREADS = 512;
constexpr int NPHASE = 10;
#ifndef PROBE_REP
#define PROBE_REP -1
#endif

constexpr int TP = 16384, TS = 1024, TT = 17408, DM = 1024;
constexpr int NCH = 272;
constexpr int PAST = 4096, SKV = 4160;
constexpr float EPS = 1e-6f;
constexpr float LOG2E = 1.4426950408889634f;
enum { I_XP = 0, I_XS, I_CK, I_CV, I_CMK, I_CMV, I_SC, I_SN, I_SM, I_MEMP, I_NG, I_FNG, I_MNG, I_WMKV, I_WINA, I_BGA, I_HGA, I_WOA,
       I_KVNG, I_WKV, I_WINB, I_LAMB, I_SUBG, I_WOB };
constexpr size_t O_Y = 0, O_PC = 17825792, O_PN = 18087936, O_PM = 18088960, O_PK = 18088964, O_PV = 34866180, O_PMK = 51643396,
                 O_PMV = 51905540, O_SC = 52167684, O_SN = 56361988, O_SM = 56378372, O_SK = 56378436, O_SV = 57427012;
constexpr size_t WS_CTR = 0;
constexpr size_t WS_KMAX = 1024;
constexpr size_t WS_TORD = 8192;
constexpr size_t WS_WA = 16384;
constexpr size_t WS_WOA = WS_WA + (size_t)6144 * 1024 * 2;
constexpr size_t WS_WKB = WS_WOA + (size_t)1024 * 1536 * 2;
constexpr size_t WS_WOB = WS_WKB + (size_t)5120 * 1024 * 2;
constexpr size_t WS_WM = WS_WOB + (size_t)1024 * 1536 * 2;
constexpr size_t WS_MEMN = WS_WM + (size_t)2 * 1024 * 1024 * 2;
constexpr size_t WS_MEMK = WS_MEMN + (size_t)2 * 256 * 1024 * 2;
constexpr size_t WS_MEMVT = WS_MEMK + (size_t)2 * 17 * 256 * 512 * 2;
constexpr size_t WS_GATE = WS_MEMVT + (size_t)2 * 17 * 256 * 512 * 2;
constexpr size_t SZ_CH = (size_t)NCH * 4 * 64 * 4;
constexpr size_t WS_GC = WS_GATE + (size_t)TT * 8 * 4;
constexpr size_t WS_MT = WS_GC + SZ_CH;
constexpr size_t WS_WS = WS_MT + SZ_CH;
constexpr size_t WS_WI = WS_WS + SZ_CH;
constexpr size_t WS_AS = WS_WI + SZ_CH;
constexpr size_t WS_BT = WS_AS + SZ_CH;
constexpr size_t WS_DEC = WS_BT + SZ_CH;
constexpr size_t WS_DENI = WS_DEC + 8192;
constexpr size_t WS_DENA = WS_DENI + (size_t)TT * 4 * 4;
constexpr size_t WS_XN = WS_DENA + (size_t)TT * 4 * 4;
constexpr size_t WS_AO = WS_XN + (size_t)TT * 1024 * 2;
constexpr size_t WS_Y1 = WS_AO + (size_t)TT * 1536 * 2;
constexpr size_t WS_KT = WS_Y1 + (size_t)TT * 1024 * 4;
constexpr size_t WS_VTA = WS_KT + (size_t)NCH * 4 * 256 * 64 * 2;
constexpr size_t WS_R1 = WS_VTA + (size_t)NCH * 4 * 256 * 64 * 2;
constexpr size_t SZ_R1 = (size_t)TT * 6144 * 2;
constexpr size_t WS_PB = WS_R1;
constexpr size_t WS_KBP = WS_PB + (size_t)TT * 3072 * 2;
constexpr size_t WS_VTP = WS_KBP + (size_t)TP * 1024 * 2;
constexpr size_t WS_R2 = WS_R1 + SZ_R1;
constexpr size_t WS_HINTER = WS_R2;
constexpr size_t WS_HINTRA = WS_R2 + (size_t)TT * 1024 * 4;
constexpr size_t WS_KBS = WS_R2;
constexpr size_t WS_VTS = WS_KBS + (size_t)16 * SKV * 1024 * 2;
constexpr size_t WS_WVT = WS_VTS + (size_t)16 * SKV * 1024 * 2;
constexpr size_t WS_U = WS_WVT + (size_t)NCH * 4 * 288 * 64 * 2;
constexpr size_t WS_CFAC = WS_U + SZ_CH;
constexpr size_t WS_CLOCC = WS_CFAC + 8192;
constexpr size_t WS_PM = WS_CLOCC + (size_t)256 * 4 * 9 * 8 * 2 * 64 * 16;
constexpr size_t WS_CHS = WS_PM + SZ_CH;
constexpr size_t WS_LD = WS_CHS + 16384;
constexpr size_t WS_CLOC = WS_LD + 8192;
constexpr size_t WS_END = WS_CLOC + (size_t)16 * 36 * 8 * 64 * 16 * 4;
constexpr int GRP = 16;
static_assert(WS_VTP + (size_t)TP * 1024 * 2 <= WS_R2, "R1 overflow");

DI unsigned pk2(float lo, float hi) { f32x2 v = {lo, hi}; return __builtin_bit_cast(unsigned, __builtin_convertvector(v, bf2_t)); }
DI bf16_t f2bf(float x) { return (bf16_t)(pk2(x, 0.f) & 0xffffu); }
DI float bf2f(unsigned v16) { return __uint_as_float(v16 << 16); }
DI float bflo(unsigned u) { return __uint_as_float(u << 16); }
DI float bfhi(unsigned u) { return __uint_as_float(u & 0xffff0000u); }
DI float rbf(float x) { return bflo(pk2(x, 0.f) & 0xffffu); }
DI int crow(int i, int h) { return (i & 3) + 8 * (i >> 2) + 4 * h; }
DI float wave_sum(float v) {
#pragma unroll
  for (int o = 32; o >= 1; o >>= 1) v += __shfl_xor(v, o);
  return v;
}
DI float fexp2(float x) { return __builtin_amdgcn_exp2f(x); }
DI float fexp(float x) { return __builtin_amdgcn_exp2f(x * LOG2E); }
DI float sigmoidf_(float x) { return 1.f / (1.f + __expf(-x)); }
DI float siluf_(float x) { return x / (1.f + __expf(-x)); }
DI bf16x8 pack_acc(const f32x16& x, int s) {
  u32x4 p;
  p[0] = pk2(x[8 * s + 0], x[8 * s + 1]); p[1] = pk2(x[8 * s + 2], x[8 * s + 3]);
  p[2] = pk2(x[8 * s + 4], x[8 * s + 5]); p[3] = pk2(x[8 * s + 6], x[8 * s + 7]);
  return __builtin_bit_cast(bf16x8, p);
}
DI bf16x8 ld16(const void* p) { return *(const bf16x8*)p; }
DI bf16x8 ld8x2(const void* p0, const void* p1) {
  u32x2 a = *(const u32x2*)p0, b = *(const u32x2*)p1; u32x4 r = {a[0], a[1], b[0], b[1]};
  return __builtin_bit_cast(bf16x8, r);
}
DI f32x16 zero16() { f32x16 z; for (int i = 0; i < 16; ++i) z[i] = 0.f; return z; }

DI void transpose_tile(const float* __restrict__ src, size_t ld_s, bf16_t* __restrict__ dst, size_t ld_d, const float* __restrict__ scale,
                       float* scr, int t, bool perm = false) {
  {
    const int c4 = t & 31, rb = t >> 5;
    f32x4 v[4];
#pragma unroll
    for (int i = 0; i < 4; ++i) v[i] = *(const f32x4*)(src + (size_t)(rb + 16 * i) * ld_s + 4 * c4);
#pragma unroll
    for (int i = 0; i < 4; ++i) {
      const int r = rb + 16 * i;
      f32x4 x = v[i];
      if (scale) { const float sc = scale[r]; x = x * sc; }
      float* d = scr + r * 129 + 4 * c4; d[0] = x[0]; d[1] = x[1]; d[2] = x[2]; d[3] = x[3];
    }
  }
  __syncthreads();
#pragma unroll
  for (int i = 0; i < 2; ++i) {
    const int id = t + 512 * i, c = id >> 3, rg = id & 7;
    const float* s = scr + (8 * rg) * 129 + c;
    u32x4 o; o[0] = pk2(s[0], s[129]); o[1] = pk2(s[2 * 129], s[3 * 129]); o[2] = pk2(s[4 * 129], s[5 * 129]); o[3] = pk2(s[6 * 129], s[7 * 129]);
    if (!perm) *(u32x4*)(dst + (size_t)c * ld_d + 8 * rg) = o;
    else {
      bf16_t* d = dst + (size_t)c * ld_d + 16 * (rg >> 1) + 4 * (rg & 1);
      u32x2 lo = {o[0], o[1]}, hi = {o[2], o[3]};
      *(u32x2*)d = lo; *(u32x2*)(d + 8) = hi;
    }
  }
  __syncthreads();
}

struct TJob { const float* src; size_t ld_s; bf16_t* dst; size_t ld_d; const float* scale; int tr, tc; };

DI void run_tjob_tile(const TJob& j, int tile, float* scr, int tid, bool perm = false) {
  const int ir = tile / j.tc, ic = tile % j.tc;
  transpose_tile(j.src + (size_t)(64 * ir) * j.ld_s + 128 * ic, j.ld_s, j.dst + (size_t)(128 * ic) * j.ld_d + 64 * ir, j.ld_d,
                 j.scale ? j.scale + 64 * ir : nullptr, scr, tid, perm);
}

DI float row_load_rstd(const float* xrow, f32x4 (&v)[4], int lane) {
  float ss = 0.f;
#pragma unroll
  for (int j = 0; j < 4; ++j) { v[j] = *(const f32x4*)(xrow + 4 * lane + 256 * j); ss += v[j][0] * v[j][0] + v[j][1] * v[j][1] + v[j][2] * v[j][2] + v[j][3] * v[j][3]; }
  ss = wave_sum(ss);
  return __builtin_amdgcn_rsqf(ss * (1.f / 1024.f) + EPS);
}

DI int diff_window(int hd) { const float sl2 = exp2f(-(float)(hd + 1)) * LOG2E; return (int)floorf((63.f + 192.f / sl2) * (1.f / 64.f)); }
DI int diff_est(int a) {
  const int hd = a & 7;
  const int w = diff_window(hd) + (a < 1024 ? 2 : 1);
  const int n = a < 1024 ? 2 * (a >> 3) + 2 : 65;
  return n < w ? n : w;
}

DI void phase0(const Params& p, unsigned char* lds) {
  const int tid = TIDX, lane = tid & 63, wid = tid >> 6;
  unsigned char* ws = p.ws;
  if (blockIdx.x == 0 && tid < 64) ((unsigned*)(ws + WS_CTR))[tid] = 0u;
  if (blockIdx.x == 0 && tid < 272) ((unsigned*)(ws + WS_KMAX))[tid] = 0u;
  if (blockIdx.x == 1) {
    int* est = (int*)lds;
    for (int a = tid; a < 1152; a += NTHREADS) est[a] = diff_est(a);
    __syncthreads();
    for (int a = tid; a < 1152; a += NTHREADS) {
      const int ea = est[a];
      int rank = 0;
      for (int b = 0; b < 1152; ++b) { const int eb = est[b]; rank += (eb > ea) || (eb == ea && b < a); }
      ((int*)(ws + WS_TORD))[rank] = a;
    }
    __syncthreads();
  }
  {
    TJob jobs[8];
    jobs[0] = {p.in[I_WINA], 6152, (bf16_t*)(ws + WS_WA), 1024, p.in[I_NG], 16, 40};
    jobs[1] = {p.in[I_WINA] + 5128, 6152, (bf16_t*)(ws + WS_WA) + (size_t)5120 * 1024, 1024, p.in[I_NG], 16, 8};
    jobs[2] = {p.in[I_WOA], 1024, (bf16_t*)(ws + WS_WOA), 1536, nullptr, 24, 8};
    jobs[3] = {p.in[I_WKV], 2048, (bf16_t*)(ws + WS_WKB), 1024, p.in[I_KVNG], 16, 16};
    jobs[4] = {p.in[I_WINB], 3072, (bf16_t*)(ws + WS_WKB) + (size_t)2048 * 1024, 1024, p.in[I_NG] + 1024, 16, 24};
    jobs[5] = {p.in[I_WOB], 1024, (bf16_t*)(ws + WS_WOB), 1536, nullptr, 24, 8};
    jobs[6] = {p.in[I_WMKV], 1024, (bf16_t*)(ws + WS_WM), 1024, nullptr, 16, 8};
    jobs[7] = {p.in[I_WMKV] + (size_t)1024 * 1024, 1024, (bf16_t*)(ws + WS_WM) + (size_t)1024 * 1024, 1024, nullptr, 16, 8};
    int base = 0;
#pragma unroll
    for (int j = 0; j < 8; ++j) {
      if (j >= 2 && j <= 5) continue;
      const int n = jobs[j].tr * jobs[j].tc;
      for (int t = blockIdx.x; t < n; t += gridDim.x) run_tjob_tile(jobs[j], t, (float*)lds, tid);
      base += n;
    }
    for (int t = blockIdx.x; t < 128 * 4; t += gridDim.x) {
      const int jb = t >> 2, tile = t & 3, l = jb >> 6, b = (jb >> 2) & 15, h = jb & 3;
      TJob j = {p.in[I_CMV] + ((size_t)(l * 16 + b) * 256) * 512 + h * 128, 512,
                (bf16_t*)(ws + WS_MEMVT) + ((size_t)(l * 17 + 1 + b) * 4 + h) * 128 * 256, 256, nullptr, 4, 1};
      run_tjob_tile(j, tile, (float*)lds, tid, true);
    }
  }
  {
    const size_t n8 = (size_t)2 * 16 * 256 * 512 / 8;
    for (size_t i = (size_t)blockIdx.x * NTHREADS + tid; i < n8; i += (size_t)gridDim.x * NTHREADS) {
      const size_t e = i * 8; const int l = (int)(e / ((size_t)16 * 131072)); const size_t rem = e - (size_t)l * 16 * 131072;
      const f32x4 a = *(const f32x4*)(p.in[I_CMK] + e), b = *(const f32x4*)(p.in[I_CMK] + e + 4);
      u32x4 o = {pk2(a[0], a[1]), pk2(a[2], a[3]), pk2(b[0], b[1]), pk2(b[2], b[3])};
      *(u32x4*)((bf16_t*)(ws + WS_MEMK) + ((size_t)(l * 17 + 1) * 131072) + rem) = o;
    }
  }
  {
    const int gw = blockIdx.x * 8 + wid, nw = gridDim.x * 8;
    const float* ng = p.in[I_NG];
    float* gwt = (float*)(lds + 32768);
    float* sg = (float*)(lds + 32768 + 36864);
    __syncthreads();
    for (int i = tid; i < 8192; i += NTHREADS) { const int k = i >> 3, c = i & 7; gwt[k * 8 + (k >> 2) * 4 + c] = p.in[I_WINA][(size_t)k * 6152 + 5120 + c] * ng[k]; }
    __syncthreads();
    for (int cc = blockIdx.x; cc < NCH; cc += gridDim.x) {
      f32x4 vn[4];
      {
        const int r0 = cc * 64 + wid * 8;
        const float* x0 = r0 < TP ? p.in[I_XP] + (size_t)r0 * 1024 : p.in[I_XS] + (size_t)(r0 - TP) * 1024;
#pragma unroll
        for (int j = 0; j < 4; ++j) vn[j] = *(const f32x4*)(x0 + 4 * lane + 256 * j);
      }
      for (int ri = 0; ri < 8; ++ri) {
        const int r = cc * 64 + wid * 8 + ri;
        f32x4 v[4];
#pragma unroll
        for (int j = 0; j < 4; ++j) v[j] = vn[j];
        if (ri + 1 < 8) {
          const float* x1 = (r + 1) < TP ? p.in[I_XP] + (size_t)(r + 1) * 1024 : p.in[I_XS] + (size_t)(r + 1 - TP) * 1024;
#pragma unroll
          for (int j = 0; j < 4; ++j) vn[j] = *(const f32x4*)(x1 + 4 * lane + 256 * j);
        }
        float ssq = 0.f;
#pragma unroll
        for (int j = 0; j < 4; ++j) ssq += v[j][0] * v[j][0] + v[j][1] * v[j][1] + v[j][2] * v[j][2] + v[j][3] * v[j][3];
        const float rstd = __builtin_amdgcn_rsqf(wave_sum(ssq) * (1.f / 1024.f) + EPS);
        float gacc[8];
#pragma unroll
        for (int c = 0; c < 8; ++c) gacc[c] = 0.f;
        bf16_t* xn = (bf16_t*)(ws + WS_XN) + (size_t)r * 1024;
#pragma unroll
        for (int j = 0; j < 4; ++j) {
          const int k0 = 4 * lane + 256 * j;
          const f32x4 xs = v[j] * rstd;
          u32x2 o = {pk2(xs[0], xs[1]), pk2(xs[2], xs[3])};
          *(u32x2*)(xn + k0) = o;
#pragma unroll
          for (int e = 0; e < 4; ++e) {
            const float* wr = gwt + (k0 + e) * 8 + (k0 >> 2) * 4;
            const f32x4 w0 = *(const f32x4*)wr, w1 = *(const f32x4*)(wr + 4);
            gacc[0] += xs[e] * w0[0]; gacc[1] += xs[e] * w0[1]; gacc[2] += xs[e] * w0[2]; gacc[3] += xs[e] * w0[3];
            gacc[4] += xs[e] * w1[0]; gacc[5] += xs[e] * w1[1]; gacc[6] += xs[e] * w1[2]; gacc[7] += xs[e] * w1[3];
          }
        }
#pragma unroll
        for (int c = 0; c < 8; ++c) gacc[c] = wave_sum(gacc[c]);
        if (lane < 8) {
          float gv = gacc[0];
#pragma unroll
          for (int c = 1; c < 8; ++c) gv = lane == c ? gacc[c] : gv;
          gv += p.in[I_BGA][lane];
          if (lane >= 4) gv = fminf(gv, 0.f) - log1pf(__expf(-fabsf(gv)));
          sg[(wid * 8 + ri) * 8 + lane] = gv;
        }
      }
      __syncthreads();
      if (wid < 4) {
        const int hd = wid, pr = cc * 4 + hd;
        const float ig = sg[lane * 8 + hd], lf = sg[lane * 8 + 4 + hd];
        float g = lf;
#pragma unroll
        for (int o = 1; o < 64; o <<= 1) { const float t = __shfl_up(g, o); if (lane >= o) g += t; }
        const float a = ig - g;
        float pm = a;
#pragma unroll
        for (int o = 1; o < 64; o <<= 1) { const float t = __shfl_up(pm, o); if (lane >= o) pm = fmaxf(pm, t); }
        const size_t o = (size_t)pr * 64 + lane;
        ((float*)(ws + WS_GC))[o] = g;
        ((float*)(ws + WS_AS))[o] = a;
        ((float*)(ws + WS_PM))[o] = pm;
        if (lane == 63) { ((float*)(ws + WS_CHS))[pr * 2] = g; ((float*)(ws + WS_CHS))[pr * 2 + 1] = pm; }
        const float u = __expf(a - __shfl(pm, 63));
        ((float*)(ws + WS_U))[o] = u;
        bf16_t* wr = (bf16_t*)(ws + WS_WVT) + ((size_t)pr * 288 + 256) * 64 + lane;
        wr[0] = f2bf(u);
#pragma unroll 4
        for (int rr = 1; rr < 32; ++rr) wr[rr * 64] = 0;
      }
      __syncthreads();
    }
    for (int r = gw; r < 512; r += nw) {
      const int l = r >> 8, rr = r & 255;
      f32x4 v[4];
      const float rstd = row_load_rstd(p.in[I_MEMP] + (size_t)rr * 1024, v, lane);
      bf16_t* o = (bf16_t*)(ws + WS_MEMN) + (size_t)r * 1024;
#pragma unroll
      for (int j = 0; j < 4; ++j) {
        const int k0 = 4 * lane + 256 * j;
        const f32x4 g = *(const f32x4*)(p.in[I_MNG] + l * 1024 + k0);
        const f32x4 xs = v[j] * rstd * g;
        u32x2 ov = {pk2(xs[0], xs[1]), pk2(xs[2], xs[3])};
        *(u32x2*)(o + k0) = ov;
      }
    }
  }
}

constexpr int G_STAGE = 49152;
struct GemmAcc { f32x16 a[2][2]; };
DI void dma16(const void* g, unsigned char* l) { __builtin_amdgcn_global_load_lds((const unsigned*)g, (unsigned*)l, 16, 0, 0); }

template <int NB = 2>
DI void gemm_tile(const bf16_t* __restrict__ A, size_t lda, const bf16_t* __restrict__ Bt, size_t ldb, int K, unsigned char* lds, GemmAcc& acc, int tid) {
  const int lane = tid & 63, wid = __builtin_amdgcn_readfirstlane(tid >> 6), r = lane & 31, h = lane >> 5;
  const int wr = wid >> 1, wc = wid & 1;
#pragma unroll
  for (int a = 0; a < 2; ++a)
#pragma unroll
    for (int b = 0; b < 2; ++b) acc.a[a][b] = zero16();
  const int nk = K / 64;
  unsigned aoff[4], boff[2];
#pragma unroll
  for (int e = 0; e < 4; ++e) { const int row = 8 * (wid * 4 + e) + (lane >> 3), lc = (lane & 7) ^ ((row >> 1) & 7); aoff[e] = (unsigned)row * (unsigned)lda + 8u * lc; }
#pragma unroll
  for (int e = 0; e < NB; ++e) { const int row = 8 * (wid * NB + e) + (lane >> 3), lc = (lane & 7) ^ ((row >> 1) & 7); boff[e] = (unsigned)row * (unsigned)ldb + 8u * lc; }
  auto issue = [&](int kt, int buf) {
    unsigned char* base = lds + buf * G_STAGE;
#pragma unroll
    for (int e = 0; e < 4; ++e) dma16(A + (aoff[e] + 64u * kt), base + (wid * 4 + e) * 1024);
#pragma unroll
    for (int e = 0; e < NB; ++e) dma16(Bt + (boff[e] + 64u * kt), base + 32768 + (wid * NB + e) * 1024);
  };
  asm volatile("s_waitcnt vmcnt(0)" ::: "memory");
  __syncthreads();
  issue(0, 0);
  if (nk > 1) issue(1, 1);
  const unsigned sw = (r >> 1) & 7;
  unsigned co[4];
#pragma unroll
  for (int kk = 0; kk < 4; ++kk) co[kk] = (((2 * kk + h) ^ sw) << 4);
  const unsigned ra = (wr * 64 + r) * 128, rb = 32768 + (wc * 32 * NB + r) * 128;
  for (int kt = 0; kt < nk; ++kt) {
    if (kt + 1 < nk) { if (NB == 2) asm volatile("s_waitcnt vmcnt(6)" ::: "memory"); else asm volatile("s_waitcnt vmcnt(5)" ::: "memory"); }
    else asm volatile("s_waitcnt vmcnt(0)" ::: "memory");
    asm volatile("s_waitcnt lgkmcnt(0)" ::: "memory");
    __builtin_amdgcn_s_barrier();
    if (kt + 2 < nk) issue(kt + 2, (kt + 2) % 3);
    const unsigned char* base = lds + (kt % 3) * G_STAGE;
    const unsigned char* pa = base + ra;
    const unsigned char* pb = base + rb;
#pragma unroll
    for (int kk = 0; kk < 4; ++kk) {
      const bf16x8 a0 = ld16(pa + co[kk]), a1 = ld16(pa + 4096 + co[kk]);
      const bf16x8 b0 = ld16(pb + co[kk]);
      acc.a[0][0] = MFMA32(a0, b0, acc.a[0][0]);
      acc.a[1][0] = MFMA32(a1, b0, acc.a[1][0]);
      if (NB == 2) {
        const bf16x8 b1 = ld16(pb + 4096 + co[kk]);
        acc.a[0][1] = MFMA32(a0, b1, acc.a[0][1]);
        acc.a[1][1] = MFMA32(a1, b1, acc.a[1][1]);
      }
    }
    __builtin_amdgcn_sched_group_barrier(0x100, 2 + NB, 0);
    __builtin_amdgcn_sched_group_barrier(0x100, 2 + NB, 0); __builtin_amdgcn_sched_group_barrier(0x008, 2 * NB, 0);
    __builtin_amdgcn_sched_group_barrier(0x100, 2 + NB, 0); __builtin_amdgcn_sched_group_barrier(0x008, 2 * NB, 0);
    __builtin_amdgcn_sched_group_barrier(0x100, 2 + NB, 0); __builtin_amdgcn_sched_group_barrier(0x008, 2 * NB, 0);
    __builtin_amdgcn_sched_group_barrier(0x008, 2 * NB, 0);
  }
}

DI void gemm256(const bf16_t* __restrict__ A, size_t lda, const bf16_t* __restrict__ Bt, size_t ldb, int K, unsigned char* lds, GemmAcc (&acc)[2], int tid) {
  const int lane = tid & 63, wid = __builtin_amdgcn_readfirstlane(tid >> 6), r = lane & 31, h = lane >> 5;
  const int wr = wid >> 2, wc = wid & 3;
#pragma unroll
  for (int mh = 0; mh < 2; ++mh)
#pragma unroll
    for (int a = 0; a < 2; ++a)
#pragma unroll
      for (int b = 0; b < 2; ++b) acc[mh].a[a][b] = zero16();
  const int nk = K / 64;
  unsigned aoff[4], boff[4];
#pragma unroll
  for (int e = 0; e < 4; ++e) {
    const int row = 8 * (wid * 4 + e) + (lane >> 3), lc = (lane & 7) ^ ((row >> 1) & 7);
    aoff[e] = (unsigned)row * (unsigned)lda + 8u * lc; boff[e] = (unsigned)row * (unsigned)ldb + 8u * lc;
  }
  auto issue = [&](int kt, int buf) {
    unsigned char* base = lds + buf * 65536;
#pragma unroll
    for (int e = 0; e < 4; ++e) { dma16(A + (aoff[e] + 64u * kt), base + (wid * 4 + e) * 1024); dma16(Bt + (boff[e] + 64u * kt), base + 32768 + (wid * 4 + e) * 1024); }
  };
  asm volatile("s_waitcnt vmcnt(0)" ::: "memory");
  __syncthreads();
  issue(0, 0);
  const unsigned sw = (r >> 1) & 7;
  unsigned co[4];
#pragma unroll
  for (int kk = 0; kk < 4; ++kk) co[kk] = (((2 * kk + h) ^ sw) << 4);
  const unsigned ra = (wr * 128 + r) * 128, rb = 32768 + (wc * 64 + r) * 128;
  for (int kt = 0; kt < nk; ++kt) {
    asm volatile("s_waitcnt vmcnt(0)" ::: "memory");
    asm volatile("s_waitcnt lgkmcnt(0)" ::: "memory");
    __builtin_amdgcn_s_barrier();
    if (kt + 1 < nk) issue(kt + 1, (kt + 1) & 1);
    const unsigned char* base = lds + (kt & 1) * 65536;
    const unsigned char* pa = base + ra;
    const unsigned char* pb = base + rb;
#pragma unroll
    for (int kk = 0; kk < 4; ++kk) {
      const bf16x8 b0 = ld16(pb + co[kk]), b1 = ld16(pb + 4096 + co[kk]);
#pragma unroll
      for (int mh = 0; mh < 2; ++mh) {
        const bf16x8 a0 = ld16(pa + 8192 * mh + co[kk]), a1 = ld16(pa + 8192 * mh + 4096 + co[kk]);
        acc[mh].a[0][0] = MFMA32(a0, b0, acc[mh].a[0][0]);
        acc[mh].a[0][1] = MFMA32(a0, b1, acc[mh].a[0][1]);
        acc[mh].a[1][0] = MFMA32(a1, b0, acc[mh].a[1][0]);
        acc[mh].a[1][1] = MFMA32(a1, b1, acc[mh].a[1][1]);
      }
    }
#define SGB_R(N) __builtin_amdgcn_sched_group_barrier(0x100, N, 0)
#define SGB_M(N) __builtin_amdgcn_sched_group_barrier(0x008, N, 0)
    SGB_R(4);
    SGB_R(2); SGB_M(4); SGB_R(4); SGB_M(4);
    SGB_R(2); SGB_M(4); SGB_R(4); SGB_M(4);
    SGB_R(2); SGB_M(4); SGB_R(4); SGB_M(4);
    SGB_R(2); SGB_M(4); SGB_M(4);
  }
}

DI void gate_scan(const Params& p, unsigned char* lds) {
  const int tid = TIDX, lane = tid & 63, wid = tid >> 6;
  unsigned char* ws = p.ws;
  float* s_ch = (float*)lds;
  float* s_mc = s_ch + NCH * 8;
  float* s_mn = s_mc + NCH * 4;
  __syncthreads();
  for (int i = tid; i < NCH * 8; i += NTHREADS) s_ch[i] = ((const float*)(ws + WS_CHS))[i];
  __syncthreads();
  if (tid < 4) {
    float m = 0.f, ld = 0.f;
    float* LD = (float*)(ws + WS_LD);
    const bool wr = blockIdx.x == 0;
    for (int c = 0; c < 256; ++c) {
      s_mc[c * 4 + tid] = m; if (wr) LD[c * 4 + tid] = ld;
      const float gl = s_ch[(c * 4 + tid) * 2], mn = gl + fmaxf(m, s_ch[(c * 4 + tid) * 2 + 1]);
      ld += gl + m - mn;
      m = mn; s_mn[c * 4 + tid] = m;
    }
    if (wr) { LD[256 * 4 + tid] = ld; p.out[O_PM + tid] = m; }
  } else if (tid >= 64 && tid < 128) {
    const int b = (tid - 64) >> 2, hd = tid & 3, pr = (256 + b) * 4 + hd;
    const float m0 = p.in[I_SM][b * 4 + hd];
    const float m = s_ch[pr * 2] + fmaxf(m0, s_ch[pr * 2 + 1]);
    s_mc[pr] = m0; s_mn[pr] = m;
    if (blockIdx.x == 0) p.out[O_SM + b * 4 + hd] = m;
  }
  __syncthreads();
  for (int cc = blockIdx.x; cc < NCH; cc += gridDim.x) {
    if (wid < 4) {
      const int hd = wid, pr = cc * 4 + hd;
      const size_t o = (size_t)pr * 64 + lane;
      const float g = ((const float*)(ws + WS_GC))[o], a = ((const float*)(ws + WS_AS))[o], pm = ((const float*)(ws + WS_PM))[o];
      const float mc = s_mc[pr], mn = s_mn[pr], gl = s_ch[pr * 2];
      const float mt = g + fmaxf(mc, pm);
      ((float*)(ws + WS_MT))[o] = mt;
      ((float*)(ws + WS_WS))[o] = __expf(gl + a - mn);
      ((float*)(ws + WS_WI))[o] = __expf(g + mc - mt);
      ((float*)(ws + WS_AS))[o] = a * LOG2E;
      ((float*)(ws + WS_BT))[o] = (g - mt) * LOG2E;
      if (lane == 0) { ((float*)(ws + WS_DEC))[pr] = __expf(gl + mc - mn); const float amx = s_ch[pr * 2 + 1]; ((float*)(ws + WS_CFAC))[pr] = __expf(amx - fmaxf(mc, amx)); }
    }
  }
  __syncthreads();
}

DI void phase1(const Params& p, unsigned char* lds) {
  const int tid = TIDX, lane = tid & 63, wid = tid >> 6, r = lane & 31, h = lane >> 5;
  unsigned char* ws = p.ws;
  gate_scan(p, lds);
  const int n_main = 68 * 24, n_mem = 16;
  for (int t = blockIdx.x; t < n_main + n_mem; t += gridDim.x) {
    if (t < n_main) {
      const int tm = t / 24, tn = t % 24, m0 = tm * 256, n0 = tn * 256;
      GemmAcc acc2[2];
      gemm256((const bf16_t*)(ws + WS_XN) + (size_t)m0 * 1024, 1024, (const bf16_t*)(ws + WS_WA) + (size_t)n0 * 1024, 1024, 1024, lds, acc2, tid);
#pragma unroll
      for (int mh = 0; mh < 2; ++mh) {
      const GemmAcc& acc = acc2[mh];
      const int wr = (wid >> 2) * 2 + mh, wc = wid & 3;
      bf16_t* PA = (bf16_t*)(ws + WS_R1);
      const int sec = n0 >> 10;
#pragma unroll
      for (int a = 0; a < 2; ++a)
#pragma unroll
        for (int b = 0; b < 2; ++b) {
          __builtin_amdgcn_sched_barrier(0);
          const int n = n0 + wc * 64 + 32 * b + r, mb = m0 + wr * 64 + 32 * a;
          if (sec != 2) {
            const float sc = sec == 1 ? 0.0625f : 1.f;
            const int pc = (n >> 2) & 3, np = sec <= 1 ? (n & ~15) + 4 * (((pc & 1) << 1) | (pc >> 1)) + (n & 3) : n;
#pragma unroll
            for (int i = 0; i < 16; ++i) PA[(size_t)(mb + crow(i, h)) * 6144 + np] = f2bf(acc.a[a][b][i] * sc);
          }
          if (sec == 1 || sec == 2) {
            const float sc = sec == 1 ? 0.0625f : 1.f;
            const int f = n & 1023, hd = f >> 8, fe = f & 255;
            bf16_t* T = (bf16_t*)(ws + (sec == 1 ? WS_KT : WS_VTA));
#pragma unroll
            for (int g = 0; g < 4; ++g) {
              const int m = mb + 8 * g + 4 * h, cc = m >> 6, s = m & 63;
              u32x2 o = {pk2(acc.a[a][b][4 * g] * sc, acc.a[a][b][4 * g + 1] * sc), pk2(acc.a[a][b][4 * g + 2] * sc, acc.a[a][b][4 * g + 3] * sc)};
              *(u32x2*)(T + (((size_t)cc * 4 + hd) * 256 + fe) * 64 + s) = o;
              if (sec == 2) {
                const f32x4 u = *(const f32x4*)((const float*)(ws + WS_U) + ((size_t)cc * 4 + hd) * 64 + s);
                u32x2 ow = {pk2(acc.a[a][b][4 * g] * u[0], acc.a[a][b][4 * g + 1] * u[1]), pk2(acc.a[a][b][4 * g + 2] * u[2], acc.a[a][b][4 * g + 3] * u[3])};
                *(u32x2*)((bf16_t*)(ws + WS_WVT) + (((size_t)cc * 4 + hd) * 288 + fe) * 64 + s) = ow;
              }
            }
          }
        }
      }
    } else {
      GemmAcc acc;
      const int wr = wid >> 1, wc = wid & 1;
      const int tt = t - n_main, l = tt >> 3, n0 = (tt & 7) * 128;
      gemm_tile((const bf16_t*)(ws + WS_MEMN) + (size_t)l * 256 * 1024, 1024, (const bf16_t*)(ws + WS_WM) + ((size_t)l * 1024 + n0) * 1024, 1024, 1024, lds, acc, tid);
      const bool isv = n0 >= 512;
      float* of = p.out + (isv ? O_PMV : O_PMK) + (size_t)l * 131072;
      bf16_t* mk = (bf16_t*)(ws + WS_MEMK) + (size_t)(l * 17) * 131072;
      bf16_t* mv = (bf16_t*)(ws + WS_MEMVT) + (size_t)(l * 17) * 131072;
#pragma unroll
      for (int a = 0; a < 2; ++a)
#pragma unroll
        for (int b = 0; b < 2; ++b) {
          __builtin_amdgcn_sched_barrier(0);
          const int f = (n0 & 511) + wc * 64 + 32 * b + r, mb = wr * 64 + 32 * a;
#pragma unroll
          for (int g = 0; g < 4; ++g) {
            const int m = mb + 8 * g + 4 * h;
            float* o4 = of + (size_t)m * 512 + f;
            o4[0] = acc.a[a][b][4 * g]; o4[512] = acc.a[a][b][4 * g + 1]; o4[1024] = acc.a[a][b][4 * g + 2]; o4[1536] = acc.a[a][b][4 * g + 3];
            if (!isv) {
              bf16_t* k4 = mk + (size_t)m * 512 + f;
              k4[0] = f2bf(acc.a[a][b][4 * g]); k4[512] = f2bf(acc.a[a][b][4 * g + 1]); k4[1024] = f2bf(acc.a[a][b][4 * g + 2]); k4[1536] = f2bf(acc.a[a][b][4 * g + 3]);
            } else {
              u32x2 o = {pk2(acc.a[a][b][4 * g], acc.a[a][b][4 * g + 1]), pk2(acc.a[a][b][4 * g + 2], acc.a[a][b][4 * g + 3])};
              const int pq = (m >> 2) & 3, mp = (m & ~15) + 4 * (((pq & 1) << 1) | (pq >> 1));
              *(u32x2*)(mv + (size_t)f * 256 + mp) = o;
            }
          }
        }
    }
  }
}

DI void scan_task(const Params& p, unsigned char* lds, int sb  , int hd, int j, int grp) {
  const int tid = TIDX, lane = tid & 63, wid = tid >> 6, r = lane & 31, h = lane >> 5;
  unsigned char* ws = p.ws;
  const int cc0 = sb < 0 ? GRP * grp : 256 + sb, nch = sb < 0 ? GRP : 1;
  const bf16_t* PA = (const bf16_t*)(ws + WS_R1);
  const bf16_t* KT = (const bf16_t*)(ws + WS_KT);
  const bf16_t* VT = (const bf16_t*)(ws + WS_VTA);
  const float* WSa = (const float*)(ws + WS_WS);
  const float* WIa = (const float*)(ws + WS_WI);
  const float* DEC = (const float*)(ws + WS_DEC);
  float* red = (float*)lds;
  const bool nsl = j == 8;
  f32x16 S = zero16();
  if (sb >= 0) {
    if (!nsl) {
      const float* C0 = p.in[I_SC] + ((size_t)(sb * 4 + hd) * 256 + 32 * j + r) * 256 + 32 * wid;
#pragma unroll
      for (int g = 0; g < 4; ++g) { const f32x4 c = *(const f32x4*)(C0 + 8 * g + 4 * h); S[4 * g] = c[0]; S[4 * g + 1] = c[1]; S[4 * g + 2] = c[2]; S[4 * g + 3] = c[3]; }
    } else if (r == 0) {
      const float* n0 = p.in[I_SN] + (size_t)(sb * 4 + hd) * 256 + 32 * wid;
#pragma unroll
      for (int g = 0; g < 4; ++g) { const f32x4 c = *(const f32x4*)(n0 + 8 * g + 4 * h); S[4 * g] = c[0]; S[4 * g + 1] = c[1]; S[4 * g + 2] = c[2]; S[4 * g + 3] = c[3]; }
    }
  }
  bf16x8 kt[4], wv[4], qf[2][2];
  u32x4 ktn[4], vn[4], qn[2][2];
  float wsn;
  float* wsl = (float*)(lds + 69632);
  auto loadraw = [&](int cc) {
    const size_t ch = (size_t)cc * 4 + hd;
    const bf16_t* kp = KT + (ch * 256 + 32 * wid + r) * 64 + 8 * h;
#pragma unroll
    for (int st = 0; st < 4; ++st) ktn[st] = *(const u32x4*)(kp + 16 * st);
    wsn = WSa[ch * 64 + lane];
    if (!nsl) {
      const bf16_t* vp = VT + (ch * 256 + 32 * j + r) * 64 + 8 * h;
#pragma unroll
      for (int st = 0; st < 4; ++st) vn[st] = *(const u32x4*)(vp + 16 * st);
    }
#pragma unroll
    for (int tt = 0; tt < 2; ++tt) {
      const bf16_t* qp = PA + (size_t)(cc * 64 + 32 * tt + r) * 6144 + hd * 256 + 32 * wid + 8 * h;
#pragma unroll
      for (int s2 = 0; s2 < 2; ++s2) qn[tt][s2] = *(const u32x4*)(qp + 16 * s2);
    }
  };
  auto convert = [&]() {
    __syncthreads();
    if (wid == 0) wsl[lane] = wsn;
    __syncthreads();
#pragma unroll
    for (int st = 0; st < 4; ++st) {
      kt[st] = __builtin_bit_cast(bf16x8, ktn[st]);
      const f32x4 w0 = *(const f32x4*)(wsl + 16 * st + 8 * h), w1 = *(const f32x4*)(wsl + 16 * st + 8 * h + 4);
      u32x4 o;
      if (!nsl) {
        const u32x4 v = vn[st];
        o[0] = pk2(bflo(v[0]) * w0[0], bfhi(v[0]) * w0[1]); o[1] = pk2(bflo(v[1]) * w0[2], bfhi(v[1]) * w0[3]);
        o[2] = pk2(bflo(v[2]) * w1[0], bfhi(v[2]) * w1[1]); o[3] = pk2(bflo(v[3]) * w1[2], bfhi(v[3]) * w1[3]);
      } else {
        o = (u32x4){pk2(w0[0], w0[1]), pk2(w0[2], w0[3]), pk2(w1[0], w1[1]), pk2(w1[2], w1[3])};
        if (r != 0) o = (u32x4){0u, 0u, 0u, 0u};
      }
      wv[st] = __builtin_bit_cast(bf16x8, o);
    }
#pragma unroll
    for (int tt = 0; tt < 2; ++tt)
#pragma unroll
      for (int s2 = 0; s2 < 2; ++s2) qf[tt][s2] = __builtin_bit_cast(bf16x8, qn[tt][s2]);
  };
  loadraw(cc0);
  convert();
  for (int c = 0; c < nch; ++c) {
    const int cc = cc0 + c;
    if (c + 1 < nch) loadraw(cc + 1);
    const float dec = DEC[cc * 4 + hd];
    const bf16x8 xs0 = pack_acc(S, 0), xs1 = pack_acc(S, 1);
    f32x16 z0 = MFMA32(xs0, qf[0][0], zero16()); z0 = MFMA32(xs1, qf[0][1], z0);
    f32x16 z1 = MFMA32(xs0, qf[1][0], zero16()); z1 = MFMA32(xs1, qf[1][1], z1);
    S = S * dec;
#pragma unroll
    for (int st = 0; st < 4; ++st) S = MFMA32(kt[st], wv[st], S);
    __syncthreads();
    {
      float* rw = red + wid * (64 * 33);
#pragma unroll
      for (int i = 0; i < 16; ++i) { rw[r * 33 + crow(i, h)] = z0[i]; rw[(32 + r) * 33 + crow(i, h)] = z1[i]; }
    }
    __syncthreads();
    {
      const int v = tid & 31;
#pragma unroll
      for (int e = 0; e < 4; ++e) {
        const int t = (tid >> 5) + 16 * e;
        float s = 0.f;
#pragma unroll
        for (int w8 = 0; w8 < 8; ++w8) s += red[w8 * (64 * 33) + t * 33 + v];
        const float wi = WIa[((size_t)cc * 4 + hd) * 64 + t];
        if (!nsl) ((float*)(ws + WS_HINTER))[(size_t)(cc * 64 + t) * 1024 + hd * 256 + 32 * j + v] = s * wi;
        else if (v == 0) ((float*)(ws + WS_DENI))[(size_t)(cc * 64 + t) * 4 + hd] = s * wi;
      }
    }
    if (c + 1 < nch) convert();
  }
  if (sb < 0) {
    float* cl = (float*)(ws + WS_CLOC) + ((((size_t)(grp * 4 + hd) * 9 + j) * 8 + wid) * 64 + lane) * 16;
#pragma unroll
    for (int g = 0; g < 4; ++g) { f32x4 c = {S[4 * g], S[4 * g + 1], S[4 * g + 2], S[4 * g + 3]}; *(f32x4*)(cl + 4 * g) = c; }
  } else {
    if (!nsl) {
      float* Co = (sb < 0 ? p.out + O_PC + (size_t)hd * 65536 : p.out + O_SC + (size_t)(sb * 4 + hd) * 65536) + (size_t)(32 * j + r) * 256 + 32 * wid;
#pragma unroll
      for (int g = 0; g < 4; ++g) { f32x4 c = {S[4 * g], S[4 * g + 1], S[4 * g + 2], S[4 * g + 3]}; *(f32x4*)(Co + 8 * g + 4 * h) = c; }
    } else if (r == 0) {
      float* no = (sb < 0 ? p.out + O_PN + (size_t)hd * 256 : p.out + O_SN + (size_t)(sb * 4 + hd) * 256) + 32 * wid;
#pragma unroll
      for (int g = 0; g < 4; ++g) { f32x4 c = {S[4 * g], S[4 * g + 1], S[4 * g + 2], S[4 * g + 3]}; *(f32x4*)(no + 8 * g + 4 * h) = c; }
    }
  }
  __syncthreads();
}

DI void intra_task(const Params& p, int cc, int hd) {
  const int tid = TIDX, lane = tid & 63, wid = tid >> 6, r = lane & 31, h = lane >> 5;
  unsigned char* ws = p.ws;
  const int tt = wid & 1, vq = wid >> 1;
  const bf16_t* PA = (const bf16_t*)(ws + WS_R1);
  const bf16_t* VT = (const bf16_t*)(ws + WS_VTA);
  const size_t ch = (size_t)cc * 4 + hd;
  f32x16 s0 = zero16(), s1 = zero16();
  {
    const bf16_t* qp = PA + (size_t)(cc * 64 + 32 * tt + r) * 6144 + hd * 256 + 8 * h;
    const bf16_t* kp = PA + (size_t)(cc * 64 + r) * 6144 + 1024 + hd * 256 + 8 * h;
#pragma unroll 4
    for (int kk = 0; kk < 16; ++kk) {
      const bf16x8 q = ld16(qp + 16 * kk), k0 = ld16(kp + 16 * kk), k1 = ld16(kp + (size_t)32 * 6144 + 16 * kk);
      s0 = MFMA32(k0, q, s0);
      if (tt == 1) s1 = MFMA32(k1, q, s1);
    }
  }
  const int t = 32 * tt + r;
  const float bt = ((const float*)(ws + WS_BT))[ch * 64 + t];
  const float* asp = (const float*)(ws + WS_AS) + ch * 64;
  float den = 0.f;
#pragma unroll
  for (int g = 0; g < 4; ++g) {
    const f32x4 a0 = *(const f32x4*)(asp + 8 * g + 4 * h);
    const f32x4 a1 = *(const f32x4*)(asp + 32 + 8 * g + 4 * h);
#pragma unroll
    for (int e = 0; e < 4; ++e) {
      const int s = 8 * g + 4 * h + e;
      const float w0 = s <= t ? fexp2(bt + a0[e]) : 0.f;
      const float w1 = (32 + s) <= t ? fexp2(bt + a1[e]) : 0.f;
      s0[4 * g + e] *= w0; s1[4 * g + e] *= w1;
      den += s0[4 * g + e] + s1[4 * g + e];
    }
  }
  den += __shfl_xor(den, 32);
  if (vq == 0 && h == 0) ((float*)(ws + WS_DENA))[(size_t)(cc * 64 + t) * 4 + hd] = den;
  bf16x8 pf[2][2];
  pf[0][0] = pack_acc(s0, 0); pf[0][1] = pack_acc(s0, 1); pf[1][0] = pack_acc(s1, 0); pf[1][1] = pack_acc(s1, 1);
  float* Ho = (float*)(ws + WS_HINTRA) + (size_t)(cc * 64 + t) * 1024 + hd * 256;
#pragma unroll
  for (int vt = 0; vt < 2; ++vt) {
    const int v0 = vq * 64 + vt * 32;
    const bf16_t* vp = VT + (ch * 256 + v0 + r) * 64 + 4 * h;
    f32x16 o = zero16();
#pragma unroll
    for (int st = 0; st < 2; ++st)
#pragma unroll
      for (int s2 = 0; s2 < 2; ++s2) {
        const bf16x8 a = ld8x2(vp + 32 * st + 16 * s2, vp + 32 * st + 16 * s2 + 8);
        o = MFMA32(a, pf[st][s2], o);
      }
#pragma unroll
    for (int g = 0; g < 4; ++g) { f32x4 c = {o[4 * g], o[4 * g + 1], o[4 * g + 2], o[4 * g + 3]}; *(f32x4*)(Ho + v0 + 8 * g + 4 * h) = c; }
  }
}

DI void memattn_task(const Params& p, unsigned char* lds, int task, int layer, const bf16_t* Qb, const bf16_t* Zb, unsigned ldq) {
  const int tid = TIDX, lane = tid & 63, wid = __builtin_amdgcn_readfirstlane(tid >> 6), r = lane & 31, h = lane >> 5;
  unsigned char* ws = p.ws;
  const bool prm = task < 256;
  const int hd = task & 3, ti = prm ? task >> 2 : (task - 256) >> 2;
  const int sbi = prm ? 0 : 1 + ti, tok0 = prm ? ti * 256 : TP + ti * 64, nact = prm ? 8 : 2;
  const bf16_t* MK = (const bf16_t*)(ws + WS_MEMK) + (size_t)(layer * 17 + sbi) * 131072 + hd * 128;
  const bf16_t* MV = (const bf16_t*)(ws + WS_MEMVT) + ((size_t)(layer * 17 + sbi) * 4 + hd) * 128 * 256;
  asm volatile("s_waitcnt vmcnt(0)" ::: "memory");
  __syncthreads();
#pragma unroll
  for (int e = 0; e < 8; ++e) {
    const int q = wid * 8 + e;
    { const int row = 4 * q + (lane >> 4), lc = (lane & 15) ^ (row & 15); dma16(MK + ((unsigned)row * 512u + 8u * lc), lds + q * 1024); }
    { const int row = 2 * q + (lane >> 5), lc = (lane & 31) ^ (row & 15); dma16(MV + ((unsigned)row * 256u + 8u * lc), lds + 65536 + q * 1024); }
  }
  const int tok = tok0 + (wid < nact ? wid : 0) * 32 + r;
  bf16x8 qf[8];
  {
    const bf16_t* qp = Qb + ((unsigned)tok * ldq + hd * 128 + 8 * h);
#pragma unroll
    for (int kk = 0; kk < 8; ++kk) qf[kk] = ld16(qp + 16 * kk);
  }
  asm volatile("s_waitcnt vmcnt(0)" ::: "memory");
  __syncthreads();
  if (wid >= nact) return;
  const float sc = 0.08838834764831845f * LOG2E;
  f32x16 O[4];
#pragma unroll
  for (int vt = 0; vt < 4; ++vt) O[vt] = zero16();
  float mrun = -1e30f, l = 0.f;
  const unsigned sw = r & 15;
#pragma unroll 1
  for (int kb = 0; kb < 4; ++kb) {
    f32x16 s0 = zero16(), s1 = zero16();
    const unsigned char* kp = lds + (kb * 64 + r) * 256;
#pragma unroll
    for (int kk = 0; kk < 8; ++kk) {
      const unsigned co = ((unsigned)(2 * kk + h) ^ sw) << 4;
      const bf16x8 k0 = ld16(kp + co), k1 = ld16(kp + 8192 + co);
      s0 = MFMA32(k0, qf[kk], s0); s1 = MFMA32(k1, qf[kk], s1);
    }
    float mx = -1e30f;
#pragma unroll
    for (int i = 0; i < 16; ++i) mx = fmaxf(mx, fmaxf(s0[i], s1[i]));
    mx = fmaxf(mx, __shfl_xor(mx, 32)) * sc;
    const float mnew = fmaxf(mrun, mx), alpha = fexp2(mrun - mnew);
    mrun = mnew;
    float sum = 0.f;
#pragma unroll
    for (int i = 0; i < 16; ++i) { s0[i] = fexp2(s0[i] * sc - mnew); s1[i] = fexp2(s1[i] * sc - mnew); sum += s0[i] + s1[i]; }
    l = l * alpha + sum;
#pragma unroll
    for (int vt = 0; vt < 4; ++vt) O[vt] = O[vt] * alpha;
    bf16x8 pf[2][2];
    pf[0][0] = pack_acc(s0, 0); pf[0][1] = pack_acc(s0, 1); pf[1][0] = pack_acc(s1, 0); pf[1][1] = pack_acc(s1, 1);
#pragma unroll
    for (int vt = 0; vt < 4; ++vt) {
      const unsigned char* vp = lds + 65536 + (32 * vt + r) * 512;
#pragma unroll
      for (int st = 0; st < 2; ++st)
#pragma unroll
        for (int s2 = 0; s2 < 2; ++s2) {
          const unsigned co = ((unsigned)(8 * kb + 4 * st + 2 * s2 + h) ^ sw) << 4;
          O[vt] = MFMA32(ld16(vp + co), pf[st][s2], O[vt]);
        }
    }
  }
  l += __shfl_xor(l, 32);
  const float inv = 1.f / l;
  const bf16_t* zp = Zb + ((unsigned)tok * ldq + hd * 128);
  bf16_t* op = (bf16_t*)(ws + WS_AO) + ((unsigned)tok * 1536u + 1024 + hd * 128);
#pragma unroll
  for (int vt = 0; vt < 4; ++vt)
#pragma unroll
    for (int g = 0; g < 4; ++g) {
      const int v = 32 * vt + 8 * g + 4 * h;
      const u32x2 z = *(const u32x2*)(zp + v);
      const float o0 = O[vt][4 * g] * inv * siluf_(bflo(z[0])), o1 = O[vt][4 * g + 1] * inv * siluf_(bfhi(z[0]));
      const float o2 = O[vt][4 * g + 2] * inv * siluf_(bflo(z[1])), o3 = O[vt][4 * g + 3] * inv * siluf_(bfhi(z[1]));
      u32x2 o = {pk2(o0, o1), pk2(o2, o3)};
      *(u32x2*)(op + v) = o;
    }
}

DI int next_item(unsigned* ctr, unsigned char* lds_flag_area, int tid) {
  __syncthreads();
  int* sh = (int*)lds_flag_area;
  if (tid == 0) *sh = (int)atomicAdd(ctr, 1u);
  __syncthreads();
  const int v = *sh;
  return v;
}

DI void scanA_task(const Params& p, int hd, int j, int grp);

DI void late_weight_item(const Params& p, unsigned char* lds, int it) {
  unsigned char* ws = p.ws;
  TJob j; int t = it;
  if (t < 192) j = {p.in[I_WOA], 1024, (bf16_t*)(ws + WS_WOA), 1536, nullptr, 24, 8};
  else if (t < 448) { t -= 192; j = {p.in[I_WKV], 2048, (bf16_t*)(ws + WS_WKB), 1024, p.in[I_KVNG], 16, 16}; }
  else if (t < 832) { t -= 448; j = {p.in[I_WINB], 3072, (bf16_t*)(ws + WS_WKB) + (size_t)2048 * 1024, 1024, p.in[I_NG] + 1024, 16, 24}; }
  else { t -= 832; j = {p.in[I_WOB], 1024, (bf16_t*)(ws + WS_WOB), 1536, nullptr, 24, 8}; }
  run_tjob_tile(j, t, (float*)lds, TIDX);
}

DI void phase2(const Params& p, unsigned char* lds) {
  unsigned* ctr = (unsigned*)(p.ws + WS_CTR) + 0 + 8 * p.pad;
  const bf16_t* PA = (const bf16_t*)(p.ws + WS_R1);
  const int n_ps = 36 * 16, n_ss = 576, n_in = NCH * 4, n_ma = 256 + 64;
  for (;;) {
    const int it = next_item(ctr, lds + LDS_BYTES - 16, TIDX);
    if (it >= n_ps + n_ss + n_in + n_ma + 1024) break;
    if (it >= n_ps + n_ss + n_in + n_ma) { late_weight_item(p, lds, it - (n_ps + n_ss + n_in + n_ma)); continue; }
    if (it < n_ps) scanA_task(p, (it % 36) / 9, it % 9, it / 36);
    else if (it < n_ps + n_ss) { const int q = it - n_ps; scan_task(p, lds, q / 36, (q % 36) / 9, q % 9, 0); }
    else if (it < n_ps + n_ss + n_in) { const int q = it - n_ps - n_ss; intra_task(p, q >> 2, q & 3); }
    else { const int q = it - n_ps - n_ss - n_in; memattn_task(p, lds, q, 0, PA + 5120, PA + 5632, 6144); }
  }
}


DI void scanA_task(const Params& p, int hd, int j, int grp) {
  const int tid = TIDX, lane = tid & 63, wid = tid >> 6, r = lane & 31, h = lane >> 5;
  unsigned char* ws = p.ws;
  const bf16_t* KT = (const bf16_t*)(ws + WS_KT);
  const bf16_t* WV = (const bf16_t*)(ws + WS_WVT);
  f32x16 S = zero16();
  u32x4 kn[4], vn[4];
  auto load = [&](int cc) {
    const size_t ch = (size_t)cc * 4 + hd;
    const bf16_t* kp = KT + (ch * 256 + 32 * wid + r) * 64 + 8 * h;
    const bf16_t* vp = WV + (ch * 288 + 32 * j + r) * 64 + 8 * h;
#pragma unroll
    for (int st = 0; st < 4; ++st) { kn[st] = *(const u32x4*)(kp + 16 * st); vn[st] = *(const u32x4*)(vp + 16 * st); }
  };
  load(GRP * grp);
#pragma unroll 1
  for (int c = 0; c < GRP; ++c) {
    const int cc = GRP * grp + c;
    bf16x8 kt[4], wv[4];
#pragma unroll
    for (int st = 0; st < 4; ++st) { kt[st] = __builtin_bit_cast(bf16x8, kn[st]); wv[st] = __builtin_bit_cast(bf16x8, vn[st]); }
    if (c + 1 < GRP) load(cc + 1);
    u32x4* cl = (u32x4*)(ws + WS_CLOCC) + ((((size_t)cc * 4 + hd) * 9 + j) * 8 + wid) * 128 + lane;
    cl[0] = __builtin_bit_cast(u32x4, pack_acc(S, 0));
    cl[64] = __builtin_bit_cast(u32x4, pack_acc(S, 1));
    f32x16 D = zero16();
#pragma unroll
    for (int st = 0; st < 4; ++st) D = MFMA32(kt[st], wv[st], D);
    const float dec = ((const float*)(ws + WS_DEC))[cc * 4 + hd], cf = ((const float*)(ws + WS_CFAC))[cc * 4 + hd];
    S = S * dec + D * cf;
  }
  float* cl = (float*)(ws + WS_CLOC) + ((((size_t)(grp * 4 + hd) * 9 + j) * 8 + wid) * 64 + lane) * 16;
#pragma unroll
  for (int g = 0; g < 4; ++g) { f32x4 c = {S[4 * g], S[4 * g + 1], S[4 * g + 2], S[4 * g + 3]}; *(f32x4*)(cl + 4 * g) = c; }
}

DI void scanfix_task(const Params& p, unsigned char* lds, int grp, int hd, int j) {
  const int tid = TIDX, lane = tid & 63, wid = tid >> 6, r = lane & 31, h = lane >> 5;
  unsigned char* ws = p.ws;
  const bool nsl = j == 8;
  const float* LD = (const float*)(ws + WS_LD);
  f32x16 S = zero16();
#pragma unroll 4
  for (int gp = 0; gp < grp; ++gp) {
    const float dg = __expf(LD[(GRP * (gp + 1)) * 4 + hd] - LD[(GRP * gp) * 4 + hd]);
    const float* cl = (const float*)(ws + WS_CLOC) + ((((size_t)(gp * 4 + hd) * 9 + j) * 8 + wid) * 64 + lane) * 16;
#pragma unroll
    for (int g = 0; g < 4; ++g) { const f32x4 c = *(const f32x4*)(cl + 4 * g);
      S[4 * g] = S[4 * g] * dg + c[0]; S[4 * g + 1] = S[4 * g + 1] * dg + c[1]; S[4 * g + 2] = S[4 * g + 2] * dg + c[2]; S[4 * g + 3] = S[4 * g + 3] * dg + c[3]; }
  }
  if (grp == 16) {
    if (!nsl) {
      float* Co = p.out + O_PC + (size_t)hd * 65536 + (size_t)(32 * j + r) * 256 + 32 * wid;
#pragma unroll
      for (int g = 0; g < 4; ++g) { f32x4 c = {S[4 * g], S[4 * g + 1], S[4 * g + 2], S[4 * g + 3]}; *(f32x4*)(Co + 8 * g + 4 * h) = c; }
    } else if (r == 0) {
      float* no = p.out + O_PN + (size_t)hd * 256 + 32 * wid;
#pragma unroll
      for (int g = 0; g < 4; ++g) { f32x4 c = {S[4 * g], S[4 * g + 1], S[4 * g + 2], S[4 * g + 3]}; *(f32x4*)(no + 8 * g + 4 * h) = c; }
    }
    return;
  }
  u32x4* fr = (u32x4*)lds;
  float* tp = (float*)(lds + 16384) + wid * (64 * 33);
  __syncthreads();
  fr[(wid * 2 + 0) * 64 + lane] = __builtin_bit_cast(u32x4, pack_acc(S, 0));
  fr[(wid * 2 + 1) * 64 + lane] = __builtin_bit_cast(u32x4, pack_acc(S, 1));
  __syncthreads();
  const bf16_t* PA = (const bf16_t*)(ws + WS_R1);
  const float* WIa = (const float*)(ws + WS_WI);
  const bool hasg = grp > 0;
#pragma unroll 1
  for (int ci = 0; ci < 2; ++ci) {
    const int cc = GRP * grp + wid + 8 * ci;
    const float D = __expf(LD[cc * 4 + hd] - LD[(GRP * grp) * 4 + hd]);
    const u32x4* clc = (const u32x4*)(ws + WS_CLOCC) + (((size_t)cc * 4 + hd) * 9 + j) * 8 * 128 + lane;
#pragma unroll
    for (int tt = 0; tt < 2; ++tt) {
      const bf16_t* qp = PA + (size_t)(cc * 64 + 32 * tt + r) * 6144 + hd * 256 + 8 * h;
      f32x16 z = zero16(), z2 = zero16();
#pragma unroll
      for (int kt = 0; kt < 8; ++kt)
#pragma unroll
        for (int s2 = 0; s2 < 2; ++s2) {
          const bf16x8 q = ld16(qp + 32 * kt + 16 * s2);
          z = MFMA32(__builtin_bit_cast(bf16x8, clc[(kt * 2 + s2) * 64]), q, z);
          if (hasg) z2 = MFMA32(__builtin_bit_cast(bf16x8, fr[(kt * 2 + s2) * 64 + lane]), q, z2);
        }
#pragma unroll
      for (int i = 0; i < 16; ++i) tp[(32 * tt + r) * 33 + crow(i, h)] = z[i] + D * z2[i];
    }
    const int v = lane & 31;
#pragma unroll 4
    for (int e = 0; e < 32; ++e) {
      const int t = 2 * e + (lane >> 5);
      const float val = tp[t * 33 + v] * WIa[((size_t)cc * 4 + hd) * 64 + t];
      if (!nsl) ((float*)(ws + WS_HINTER))[(size_t)(cc * 64 + t) * 1024 + hd * 256 + 32 * j + v] = val;
      else if (v == 0) ((float*)(ws + WS_DENI))[(size_t)(cc * 64 + t) * 4 + hd] = val;
    }
  }
}

DI void phase2c(const Params& p, unsigned char* lds) {
  unsigned* ctr = (unsigned*)(p.ws + WS_CTR) + 3 + 8 * p.pad;
  for (;;) {
    const int it = next_item(ctr, lds + LDS_BYTES - 16, TIDX);
    if (it >= 17 * 36) break;
    const int g = 16 - it / 36;
    scanfix_task(p, lds, g, (it % 36) / 9, it % 9);
  }
}

DI void phase3(const Params& p) {
  const int tid = TIDX, lane = tid & 63, wid = tid >> 6;
  unsigned char* ws = p.ws;
  const int gw = blockIdx.x * 8 + wid, nw = gridDim.x * 8;
  const bf16_t* PA = (const bf16_t*)(ws + WS_R1);
  for (int it = gw; it < TT * 4; it += nw) {
    const int tok = it >> 2, hd = it & 3, cc = tok >> 6, t = tok & 63;
    const size_t off = (size_t)tok * 1024 + hd * 256 + 4 * lane;
    const f32x4 a = *(const f32x4*)((const float*)(ws + WS_HINTER) + off), b = *(const f32x4*)((const float*)(ws + WS_HINTRA) + off);
    const float den = ((const float*)(ws + WS_DENI))[tok * 4 + hd] + ((const float*)(ws + WS_DENA))[tok * 4 + hd];
    const float mt = ((const float*)(ws + WS_MT))[((size_t)cc * 4 + hd) * 64 + t];
    const float dn = 1.f / fmaxf(fabsf(den), __expf(-mt));
    const u32x2 ou = *(const u32x2*)(PA + (size_t)tok * 6144 + 3072 + hd * 256 + 4 * lane);
    const u32x2 zu = *(const u32x2*)(PA + (size_t)tok * 6144 + 4096 + hd * 256 + 4 * lane);
    f32x4 hv = (a + b) * dn;
    hv[0] *= sigmoidf_(bflo(ou[0])); hv[1] *= sigmoidf_(bfhi(ou[0])); hv[2] *= sigmoidf_(bflo(ou[1])); hv[3] *= sigmoidf_(bfhi(ou[1]));
    float ss = hv[0] * hv[0] + hv[1] * hv[1] + hv[2] * hv[2] + hv[3] * hv[3];
    ss = wave_sum(ss);
    const float rstd = __builtin_amdgcn_rsqf(ss * (1.f / 256.f) + EPS);
    const f32x4 hg = *(const f32x4*)(p.in[I_HGA] + hd * 256 + 4 * lane);
    hv = hv * rstd * hg;
    hv[0] *= siluf_(bflo(zu[0])); hv[1] *= siluf_(bfhi(zu[0])); hv[2] *= siluf_(bflo(zu[1])); hv[3] *= siluf_(bfhi(zu[1]));
    u32x2 o = {pk2(hv[0], hv[1]), pk2(hv[2], hv[3])};
    *(u32x2*)((bf16_t*)(ws + WS_AO) + (size_t)tok * 1536 + hd * 256 + 4 * lane) = o;
  }
}

DI void cacheconv_item(const Params& p, unsigned char* lds, int it);

DI void phase_outproj(const Params& p, unsigned char* lds, int layer) {
  const int tid = TIDX, lane = tid & 63, wid = tid >> 6, r = lane & 31, h = lane >> 5, wr = wid >> 1, wc = wid & 1;
  unsigned char* ws = p.ws;
  const bf16_t* W = (const bf16_t*)(ws + (layer == 0 ? WS_WOA : WS_WOB));
  for (int t = blockIdx.x; t < 68 * 16; t += gridDim.x) {
    const int tm = t >> 4, tn = t & 15, m0 = tm * 256, n0 = tn * 64;
    GemmAcc acc;
    gemm_tile<1>((const bf16_t*)(ws + WS_AO) + (size_t)m0 * 1536, 1536, W + (size_t)n0 * 1536, 1536, 1536, lds, acc, tid);
#pragma unroll
    for (int a = 0; a < 2; ++a) {
      const int n = n0 + wc * 32 + r, mb = m0 + wr * 64 + 32 * a;
#pragma unroll
      for (int i = 0; i < 16; ++i) {
        const int m = mb + crow(i, h);
        if (layer == 0) {
          const float xv = m < TP ? p.in[I_XP][(size_t)m * 1024 + n] : p.in[I_XS][(size_t)(m - TP) * 1024 + n];
          ((float*)(ws + WS_Y1))[(size_t)m * 1024 + n] = xv + acc.a[a][0][i];
        } else {
          p.out[O_Y + (size_t)m * 1024 + n] = ((const float*)(ws + WS_Y1))[(size_t)m * 1024 + n] + acc.a[a][0][i];
        }
      }
    }
  }
  if (layer == 0) {
    unsigned* ctr = (unsigned*)(p.ws + WS_CTR) + 4 + 8 * p.pad;
    for (;;) {
      const int it = next_item(ctr, lds + LDS_BYTES - 16, TIDX);
      if (it >= 1024) break;
      cacheconv_item(p, lds, it);
    }
  }
}

DI void phase5(const Params& p, unsigned char* lds) {
  const int tid = TIDX, lane = tid & 63, wid = tid >> 6;
  unsigned char* ws = p.ws;
  const int gw = blockIdx.x * 8 + wid, nw = gridDim.x * 8;
  for (int r = gw; r < TT; r += nw) {
    f32x4 v[4];
    const float rstd = row_load_rstd((const float*)(ws + WS_Y1) + (size_t)r * 1024, v, lane);
    bf16_t* xn = (bf16_t*)(ws + WS_XN) + (size_t)r * 1024;
#pragma unroll
    for (int j = 0; j < 4; ++j) { const f32x4 xs = v[j] * rstd; u32x2 o = {pk2(xs[0], xs[1]), pk2(xs[2], xs[3])}; *(u32x2*)(xn + 4 * lane + 256 * j) = o; }
  }
}

DI void cacheconv_item(const Params& p, unsigned char* lds, int it) {
  const int tid = TIDX;
  unsigned char* ws = p.ws;
  if (it < 512) {
    const int b = it >> 5, slab = it & 31;
    float* smax = (float*)lds;
    const int hm = (tid & 127) >> 3;
    __syncthreads();
    if (tid < 16) smax[tid] = 0.f;
    __syncthreads();
    float mx = 0.f;
    const float* src = p.in[I_CK] + ((size_t)b * PAST + slab * 128) * 1024;
    bf16_t* dst = (bf16_t*)(ws + WS_KBS) + ((size_t)b * SKV + slab * 128) * 1024;
#pragma unroll 4
    for (int i = 0; i < 32; ++i) {
      const unsigned e = (unsigned)(i * NTHREADS + tid) * 8u;
      const f32x4 a = *(const f32x4*)(src + e), c = *(const f32x4*)(src + e + 4);
      u32x4 o = {pk2(a[0], a[1]), pk2(a[2], a[3]), pk2(c[0], c[1]), pk2(c[2], c[3])};
      *(u32x4*)(dst + e) = o;
      float ss = a[0] * a[0] + a[1] * a[1] + a[2] * a[2] + a[3] * a[3] + c[0] * c[0] + c[1] * c[1] + c[2] * c[2] + c[3] * c[3];
      ss += __shfl_xor(ss, 1); ss += __shfl_xor(ss, 2); ss += __shfl_xor(ss, 4);
      mx = fmaxf(mx, ss);
    }
    if ((tid & 7) == 0) atomicMax((unsigned*)smax + hm, __float_as_uint(mx));
    __syncthreads();
    if (tid < 16) atomicMax((unsigned*)(ws + WS_KMAX) + (1 + b) * 16 + tid, __float_as_uint(sqrtf(smax[tid])));
  } else {
    const int q = it - 512, jb = q >> 2, part = q & 3, b = jb >> 3, hd = jb & 7;
    TJob j = {p.in[I_CV] + (size_t)b * PAST * 1024 + hd * 128, 1024, (bf16_t*)(ws + WS_VTS) + ((size_t)(b * 8 + hd) * 128) * SKV, SKV, nullptr, 64, 1};
    for (int tile = part * 16; tile < part * 16 + 16; ++tile) run_tjob_tile(j, tile, (float*)lds, tid, true);
  }
}

DI void phase6(const Params& p, unsigned char* lds) {
  const int tid = TIDX, lane = tid & 63, wid = tid >> 6, r = lane & 31, h = lane >> 5;
  unsigned char* ws = p.ws;
  for (int t = blockIdx.x; t < 68 * 20; t += gridDim.x) {
    const int tm = t / 20, tn = t % 20, m0 = tm * 256, n0 = tn * 256;
    GemmAcc acc2[2];
    gemm256((const bf16_t*)(ws + WS_XN) + (size_t)m0 * 1024, 1024, (const bf16_t*)(ws + WS_WKB) + (size_t)n0 * 1024, 1024, 1024, lds, acc2, tid);
    const int sec = n0 >> 10;
    const bool samp = m0 >= TP;
#pragma unroll
    for (int mh = 0; mh < 2; ++mh) {
    const GemmAcc& acc = acc2[mh];
    const int wr = (wid >> 2) * 2 + mh, wc = wid & 3;
#pragma unroll
    for (int a = 0; a < 2; ++a)
#pragma unroll
      for (int b = 0; b < 2; ++b) {
        __builtin_amdgcn_sched_barrier(0);
        const int n = n0 + wc * 64 + 32 * b + r, mb = m0 + wr * 64 + 32 * a;
        if (sec == 0) {
          const int f = n;
          if (b == 1) {
            float mx = 0.f;
#pragma unroll
            for (int i = 0; i < 16; ++i) {
              float ss = acc.a[a][0][i] * acc.a[a][0][i] + acc.a[a][1][i] * acc.a[a][1][i];
              ss += __shfl_xor(ss, 1); ss += __shfl_xor(ss, 2); ss += __shfl_xor(ss, 4); ss += __shfl_xor(ss, 8); ss += __shfl_xor(ss, 16);
              mx = fmaxf(mx, ss);
            }
            mx = fmaxf(mx, __shfl_xor(mx, 32));
            if (lane == 0) {
              const int strm = samp ? 1 + ((mb - TP) >> 6) : 0;
              atomicMax((unsigned*)(ws + WS_KMAX) + strm * 16 + ((n0 + wc * 64) >> 6), __float_as_uint(sqrtf(mx)));
            }
          }
#pragma unroll
          for (int i = 0; i < 16; ++i) {
            const int m = mb + crow(i, h);
            const float v = acc.a[a][b][i];
            if (!samp) { (p.out + O_PK)[(unsigned)(m * 1024 + f)] = v; ((bf16_t*)(ws + WS_KBP))[(unsigned)(m * 1024 + f)] = f2bf(v); }
            else { const int ms = m - TP, bb = ms >> 6, s = ms & 63; (p.out + O_SK)[(unsigned)(ms * 1024 + f)] = v;
                   ((bf16_t*)(ws + WS_KBS))[(unsigned)((bb * SKV + PAST + s) * 1024 + f)] = f2bf(v); }
          }
        } else if (sec == 1) {
          const int f = n - 1024, hd = f >> 7, vd = f & 127;
#pragma unroll
          for (int i = 0; i < 16; ++i) {
            const int m = mb + crow(i, h);
            if (!samp) (p.out + O_PV)[(unsigned)(m * 1024 + f)] = acc.a[a][b][i]; else (p.out + O_SV)[(unsigned)((m - TP) * 1024 + f)] = acc.a[a][b][i];
          }
#pragma unroll
          for (int g = 0; g < 4; ++g) {
            const int m0r = mb + 8 * g + 4 * h, pq = (m0r >> 2) & 3;
            const int m = (m0r & ~15) + 4 * (((pq & 1) << 1) | (pq >> 1));
            u32x2 o = {pk2(acc.a[a][b][4 * g], acc.a[a][b][4 * g + 1]), pk2(acc.a[a][b][4 * g + 2], acc.a[a][b][4 * g + 3])};
            if (!samp) *(u32x2*)((bf16_t*)(ws + WS_VTP) + (unsigned)((hd * 128 + vd) * TP + m)) = o;
            else { const int ms = m - TP, bb = ms >> 6, s = ms & 63; *(u32x2*)((bf16_t*)(ws + WS_VTS) + (unsigned)(((bb * 8 + hd) * 128 + vd) * SKV + PAST + s)) = o; }
          }
        } else {
          const float sc = sec == 2 ? 0.125f * LOG2E : 1.f;
          bf16_t* PB = (bf16_t*)(ws + WS_PB);
#pragma unroll
          for (int i = 0; i < 16; ++i) PB[(unsigned)((mb + crow(i, h)) * 3072 + (n - 2048))] = f2bf(acc.a[a][b][i] * sc);
        }
      }
    }
  }
}

constexpr int A_BUF = 32768, A_KB = 16384, A_FLAGS = 3 * A_BUF;

DI void diffattn_task(const Params& p, unsigned char* lds, int sb  , int qt  , int hd, float lam) {
  const int tid = TIDX, lane = tid & 63, wid = __builtin_amdgcn_readfirstlane(tid >> 6), r = lane & 31, h = lane >> 5;
  unsigned char* ws = p.ws;
  const int cq = wid >> 2, sub = (wid >> 1) & 1, map = wid & 1;
  const int ncq = sb < 0 ? 2 : 1;
  const int base_chunk = sb < 0 ? 2 * qt : 64;
  const int tok0 = sb < 0 ? qt * 128 : TP + sb * 64;
  const bool wvalid = cq < ncq;
  const int qc = base_chunk + cq;
  const int tl = 32 * sub + r;
  const int tok = tok0 + 64 * (wvalid ? cq : 0) + tl;
  const bf16_t* Kb = sb < 0 ? (const bf16_t*)(ws + WS_KBP) + hd * 128 : (const bf16_t*)(ws + WS_KBS) + (size_t)sb * SKV * 1024 + hd * 128;
  const bf16_t* Vb = sb < 0 ? (const bf16_t*)(ws + WS_VTP) + (size_t)hd * 128 * TP : (const bf16_t*)(ws + WS_VTS) + (size_t)(sb * 8 + hd) * 128 * SKV;
  const unsigned ldv = sb < 0 ? TP : SKV;
  const bf16_t* PB = (const bf16_t*)(ws + WS_PB);
  bf16x8 qf[4];
  float qn = 0.f;
  {
    const unsigned qo = (unsigned)tok * 3072u + hd * 128 + map * 64 + 8 * h;
#pragma unroll
    for (int kk = 0; kk < 4; ++kk) {
      const u32x4 u = *(const u32x4*)(PB + (qo + 16 * kk));
      qf[kk] = __builtin_bit_cast(bf16x8, u);
#pragma unroll
      for (int e = 0; e < 4; ++e) { const float a = bflo(u[e]), b = bfhi(u[e]); qn += a * a + b * b; }
    }
    qn += __shfl_xor(qn, 32);
    qn = sqrtf(qn);
  }
  const float kmax = ((const float*)(ws + WS_KMAX))[(sb < 0 ? 0 : 1 + sb) * 16 + hd * 2 + map];
  const float shift = qn * kmax * 1.02f + 0.5f - 40.f;
  const float sl2 = exp2f(-(float)(hd + 1)) * LOG2E;
  const int wd = diff_window(hd);
  const float bh0 = sl2 * (float)(4 * h) - sl2 * (float)tl - shift, bh1 = bh0 + 32.f * sl2;
  float cs[16];
#pragma unroll
  for (int i = 0; i < 16; ++i) cs[i] = __uint_as_float(__builtin_amdgcn_readfirstlane(__float_as_uint(sl2 * (float)((i & 3) + 8 * (i >> 2)))));
  f32x16 O[4];
#pragma unroll
  for (int vt = 0; vt < 4; ++vt) O[vt] = zero16();
  float l = 0.f;
  const int jmax = base_chunk + ncq - 1;
  const int jmin = max(0, base_chunk - wd);
  const int nit = jmax - jmin + 1;
  unsigned kofs[2], vofs[2];
#pragma unroll
  for (int e = 0; e < 2; ++e) {
    const int q = wid * 2 + e;
    { const int row = 4 * q + (lane >> 4), lc = (lane & 15) ^ (row & 15); kofs[e] = (unsigned)row * 1024u + 8u * lc; }
    { const int row = 8 * q + (lane >> 3), lc = (lane & 7) ^ ((row >> 1) & 7); vofs[e] = (unsigned)row * ldv + 8u * lc; }
  }
  auto issue = [&](int j, int buf) {
    const bf16_t* kj = Kb + (size_t)j * 65536;
    const bf16_t* vj = Vb + (size_t)j * 64;
    unsigned char* base = lds + buf * A_BUF;
#pragma unroll
    for (int e = 0; e < 2; ++e) {
      dma16(kj + kofs[e], base + (wid * 2 + e) * 1024);
      dma16(vj + vofs[e], base + A_KB + (wid * 2 + e) * 1024);
    }
  };
  unsigned kco[4], vco[4];
#pragma unroll
  for (int kk = 0; kk < 4; ++kk) kco[kk] = (unsigned)r * 256u + ((((unsigned)(8 * map + 2 * kk + h)) ^ (unsigned)(r & 15)) << 4);
#pragma unroll
  for (int sx = 0; sx < 4; ++sx) vco[sx] = A_KB + (unsigned)r * 128u + ((((unsigned)(2 * sx + h)) ^ (unsigned)((r >> 1) & 7)) << 4);
  asm volatile("s_waitcnt vmcnt(0)" ::: "memory");
  __syncthreads();
  issue(jmax, 0);
  if (nit > 1) issue(jmax - 1, 1);
  for (int it = 0; it < nit; ++it) {
    const int j = jmax - it;
    if (it + 1 < nit) asm volatile("s_waitcnt vmcnt(4)" ::: "memory"); else asm volatile("s_waitcnt vmcnt(0)" ::: "memory");
    asm volatile("s_waitcnt lgkmcnt(0)" ::: "memory");
    __builtin_amdgcn_s_barrier();
    if (it + 2 < nit) issue(j - 2, (it + 2) % 3);
    if (wvalid && j <= qc && qc - j <= wd) {
      const unsigned char* base = lds + (it % 3) * A_BUF;
      const float dofs = sl2 * (float)((qc - j) * 64);
      float sum = 0.f;
#pragma unroll
      for (int half = 0; half < 2; ++half) {
        f32x16 sc;
        {
          float b0 = (half ? bh1 : bh0) - dofs;
          asm volatile("" : "+v"(b0));
#pragma unroll
          for (int i = 0; i < 16; ++i) sc[i] = b0 + cs[i];
        }
        if (j == qc) {
          int tlv = tl;
          asm volatile("" : "+v"(tlv));
          const float m2 = -2.f * sl2, xt = (float)(4 * h + 32 * half - tlv);
#pragma unroll
          for (int i = 0; i < 16; ++i) sc[i] = fmaf(m2, fmaxf(xt + (float)((i & 3) + 8 * (i >> 2)), 0.f), sc[i]);
        }
        {
          bf16x8 kf[4];
#pragma unroll
          for (int kk = 0; kk < 4; ++kk) kf[kk] = ld16(base + 8192 * half + kco[kk]);
#pragma unroll
          for (int kk = 0; kk < 4; ++kk) sc = MFMA32(kf[kk], qf[kk], sc);
        }
        bf16x8 vf[8];
#pragma unroll
        for (int vt = 0; vt < 4; ++vt) { vf[2 * vt] = ld16(base + 4096 * vt + vco[2 * half]); vf[2 * vt + 1] = ld16(base + 4096 * vt + vco[2 * half + 1]); }
#pragma unroll
        for (int i = 0; i < 16; ++i) { sc[i] = fexp2(sc[i]); sum += sc[i]; }
        const bf16x8 p0 = pack_acc(sc, 0), p1 = pack_acc(sc, 1);
#pragma unroll
        for (int vt = 0; vt < 4; ++vt) { O[vt] = MFMA32(vf[2 * vt], p0, O[vt]); O[vt] = MFMA32(vf[2 * vt + 1], p1, O[vt]); }
      }
      l += sum;
    }
  }
  asm volatile("s_waitcnt vmcnt(0)" ::: "memory");
  __syncthreads();
  l += __shfl_xor(l, 32);
  const float inv = wvalid ? 1.f / l : 0.f;
  float* xch = (float*)lds + (size_t)(wid >> 1) * 4096;
  if (map == 1 && wvalid) {
    const float sc = inv * lam;
#pragma unroll
    for (int vt = 0; vt < 4; ++vt)
#pragma unroll
      for (int i = 0; i < 16; ++i) xch[(vt * 16 + i) * 64 + lane] = O[vt][i] * sc;
  }
  __syncthreads();
  if (map == 0 && wvalid) {
    float ss = 0.f;
#pragma unroll
    for (int vt = 0; vt < 4; ++vt)
#pragma unroll
      for (int i = 0; i < 16; ++i) { const float o = O[vt][i] * inv - xch[(vt * 16 + i) * 64 + lane]; O[vt][i] = o; ss += o * o; }
    ss += __shfl_xor(ss, 32);
    const float lam_init = 0.8f - 0.6f * 0.7408182206817179f;
    const float rs = __builtin_amdgcn_rsqf(ss * (1.f / 128.f) + EPS) * (1.f - lam_init);
    const unsigned zo = (unsigned)tok * 3072u + 1024 + hd * 128, oo = (unsigned)tok * 1536u + hd * 128;
    bf16_t* AOp = (bf16_t*)(ws + WS_AO);
    const float* sg = p.in[I_SUBG];
#pragma unroll
    for (int vt = 0; vt < 4; ++vt)
#pragma unroll
      for (int g = 0; g < 4; ++g) {
        const int v = 32 * vt + 8 * g + 4 * h;
        const u32x2 z = *(const u32x2*)(PB + (zo + v));
        const f32x4 gg = *(const f32x4*)(sg + v);
        const float o0 = O[vt][4 * g] * rs * gg[0] * siluf_(bflo(z[0])), o1 = O[vt][4 * g + 1] * rs * gg[1] * siluf_(bfhi(z[0]));
        const float o2 = O[vt][4 * g + 2] * rs * gg[2] * siluf_(bflo(z[1])), o3 = O[vt][4 * g + 3] * rs * gg[3] * siluf_(bfhi(z[1]));
        u32x2 o = {pk2(o0, o1), pk2(o2, o3)};
        *(u32x2*)(AOp + (oo + v)) = o;
      }
  }
  __syncthreads();
}

DI void phase7(const Params& p, unsigned char* lds) {
  unsigned* ctr = (unsigned*)(p.ws + WS_CTR) + 1 + 8 * p.pad;
  const bf16_t* PB = (const bf16_t*)(p.ws + WS_PB);
  float lam;
  {
    const int lane = TIDX & 63;
    const float* lv = p.in[I_LAMB];
    const float a = wave_sum(lv[lane] * lv[64 + lane]), b = wave_sum(lv[128 + lane] * lv[192 + lane]);
    const float lam_init = 0.8f - 0.6f * 0.7408182206817179f;
    lam = __expf(a) - __expf(b) + lam_init;
  }
  const int n_s = 128, n_p = 1024, n_ma = 256 + 64;
  const int* tord = (const int*)(p.ws + WS_TORD);
  for (;;) {
    const int it = next_item(ctr, lds + LDS_BYTES - 16, TIDX);
    if (it >= n_s + n_p) break;
    const int a = tord[it];
    const bool pr = a < n_p;
    diffattn_task(p, lds, pr ? -1 : ((a - n_p) >> 3), pr ? (a >> 3) : 0, a & 7, lam);
  }
  for (;;) {
    const int it = next_item(ctr + 1, lds + LDS_BYTES - 16, TIDX);
    if (it >= n_ma) break;
    memattn_task(p, lds, it, 1, PB + 2048, PB + 2560, 3072);
  }
}

DI void phase9(const Params& p) {
  const int tid = TIDX, lane = tid & 63, wid = tid >> 6;
  const int gw = blockIdx.x * 8 + wid, nw = gridDim.x * 8;
  for (int r = gw; r < TT; r += nw) {
    f32x4 v[4];
    float* row = p.out + O_Y + (size_t)r * 1024;
    const float rstd = row_load_rstd(row, v, lane);
#pragma unroll
    for (int j = 0; j < 4; ++j) {
      const f32x4 g = *(const f32x4*)(p.in[I_FNG] + 4 * lane + 256 * j);
      *(f32x4*)(row + 4 * lane + 256 * j) = v[j] * rstd * g;
    }
  }
}

DI void grid_barrier(unsigned* bar, unsigned target, int tid) {
  asm volatile("s_waitcnt vmcnt(0)" ::: "memory");
  __syncthreads();
  if (tid == 0) {
    __builtin_amdgcn_fence(__ATOMIC_RELEASE, "agent");
    asm volatile("s_waitcnt vmcnt(0)" ::: "memory");
    __hip_atomic_fetch_add(bar, 1u, __ATOMIC_RELAXED, __HIP_MEMORY_SCOPE_AGENT);
    while (__hip_atomic_load(bar, __ATOMIC_RELAXED, __HIP_MEMORY_SCOPE_AGENT) < target) __builtin_amdgcn_s_sleep(1);
    __builtin_amdgcn_fence(__ATOMIC_ACQUIRE, "agent");
    asm volatile("s_waitcnt vmcnt(0)" ::: "memory");
  }
  __syncthreads();
}

__global__ __launch_bounds__(512) void mk(Params pin) {
  extern __shared__ __attribute__((aligned(16))) unsigned char lds[];
  Params p = pin;
  p.wv = __builtin_amdgcn_readfirstlane((int)(__builtin_amdgcn_workitem_id_x() >> 6));
  cg::grid_group grid = cg::this_grid();
  unsigned nbar = 0;
  unsigned* bar = (unsigned*)(p.ws + WS_CTR) + 32;
#define RUN_PHASE(PH, CALL) if (p.ph_lo <= PH && PH < p.ph_hi) { CALL; if (PH + 1 < p.ph_hi) { ++nbar; grid_barrier(bar, nbar * gridDim.x, TIDX); } }
  if (p.ph_lo <= 0 && 0 < p.ph_hi) { phase0(p, lds); if (1 < p.ph_hi) grid.sync(); }
  RUN_PHASE(1, phase1(p, lds))
  RUN_PHASE(2, phase2(p, lds))
  if (p.ph_lo <= 2 && 2 < p.ph_hi) { phase2c(p, lds); ++nbar; grid_barrier(bar, nbar * gridDim.x, TIDX); }
  RUN_PHASE(3, phase3(p))
  RUN_PHASE(4, phase_outproj(p, lds, 0))
  RUN_PHASE(5, phase5(p, lds))
  RUN_PHASE(6, phase6(p, lds))
  RUN_PHASE(7, phase7(p, lds))
  RUN_PHASE(8, phase_outproj(p, lds, 1))
  RUN_PHASE(9, phase9(p))
}

extern "C" void kernel_launch(void* const* d_in, const int* in_sizes, int n_in, void* d_out, int out_size,
                              void* d_ws, size_t ws_size, hipStream_t stream) {
  static int grid_blocks = 0;
  if (!grid_blocks) {
    int dev = 0, cus = 0, per_cu = 0;
    (void)hipGetDevice(&dev);
    (void)hipDeviceGetAttribute(&cus, hipDeviceAttributeMultiprocessorCount, dev);
    (void)hipFuncSetAttribute((const void*)mk, hipFuncAttributeMaxDynamicSharedMemorySize, LDS_BYTES);
    (void)hipOccupancyMaxActiveBlocksPerMultiprocessor(&per_cu, (const void*)mk, NTHREADS, LDS_BYTES);
    grid_blocks = cus;
    fprintf(stderr, "kernel_launch: cus=%d per_cu=%d grid=%d ws=%zu need=%zu\n", cus, per_cu, grid_blocks, ws_size, (size_t)WS_END);
  }
  if (ws_size < WS_END) { fprintf(stderr, "workspace too small\n"); return; }
  Params p{};
  for (int i = 0; i < 24; ++i) p.in[i] = (const float*)d_in[i];
  p.out = (float*)d_out; p.ws = (unsigned char*)d_ws; p.ph_lo = 0; p.ph_hi = NPHASE;
  void* args[] = {&p};
  hipError_t e = hipLaunchCooperativeKernel((const void*)mk, dim3(grid_blocks), dim3(NTHREADS), args, LDS_BYTES, stream);
  if (e != hipSuccess) fprintf(stderr, "cooperative launch failed: %s (grid %d)\n", hipGetErrorString(e), grid_blocks);
  if (PROBE_REP >= 0) {
    Params q = p;
    q.out = (float*)((unsigned char*)d_ws + WS_END); q.ph_lo = PROBE_REP; q.ph_hi = PROBE_REP + 1; q.pad = 1;
    void* args2[] = {&q};
    (void)hipLaunchCooperativeKernel((const void*)mk, dim3(grid_blocks), dim3(NTHREADS), args2, LDS_BYTES, stream);
  }
}
```

```cpp
#include <hip/hip_runtime.h>
#include <hip/hip_cooperative_groups.h>
#include <cstdio>
#include <cstdint>
namespace cg = cooperative_groups;

typedef unsigned short bf16_t;
typedef short bf16x8 __attribute__((ext_vector_type(8)));
typedef short s16x4 __attribute__((ext_vector_type(4)));
typedef float f32x16 __attribute__((ext_vector_type(16)));
typedef float f32x4 __attribute__((ext_vector_type(4)));
typedef float f32x2 __attribute__((ext_vector_type(2)));
typedef __bf16 bf2_t __attribute__((ext_vector_type(2)));
typedef unsigned u32x4 __attribute__((ext_vector_type(4)));
typedef unsigned u32x2 __attribute__((ext_vector_type(2)));
#define DI __device__ __forceinline__
#define MFMA32(a, b, c) __builtin_amdgcn_mfma_f32_32x32x16_bf16((a), (b), (c), 0, 0, 0)

struct Params { const float* in[24]; float* out; unsigned char* ws; int ph_lo, ph_hi; int wv, pad; };
#define TIDX (p.wv * 64 + (int)__builtin_amdgcn_mbcnt_hi(~0u, __builtin_amdgcn_mbcnt_lo(~0u, 0u)))
constexpr int LDS_BYTES = 148480;
constexpr int NTHREADS = 512;
constexpr int NPHASE = 10;
#ifndef PROBE_REP
#define PROBE_REP -1
#endif

constexpr int TP = 16384, TS = 1024, TT = 17408, DM = 1024;
constexpr int NCH = 272;
constexpr int PAST = 4096, SKV = 4160;
constexpr float EPS = 1e-6f;
constexpr float LOG2E = 1.4426950408889634f;
enum { I_XP = 0, I_XS, I_CK, I_CV, I_CMK, I_CMV, I_SC, I_SN, I_SM, I_MEMP, I_NG, I_FNG, I_MNG, I_WMKV, I_WINA, I_BGA, I_HGA, I_WOA,
       I_KVNG, I_WKV, I_WINB, I_LAMB, I_SUBG, I_WOB };
constexpr size_t O_Y = 0, O_PC = 17825792, O_PN = 18087936, O_PM = 18088960, O_PK = 18088964, O_PV = 34866180, O_PMK = 51643396,
                 O_PMV = 51905540, O_SC = 52167684, O_SN = 56361988, O_SM = 56378372, O_SK = 56378436, O_SV = 57427012;
constexpr size_t WS_CTR = 0;
constexpr size_t WS_KMAX = 1024;
constexpr size_t WS_TORD = 8192;
constexpr size_t WS_WA = 16384;
constexpr size_t WS_WOA = WS_WA + (size_t)6144 * 1024 * 2;
constexpr size_t WS_WKB = WS_WOA + (size_t)1024 * 1536 * 2;
constexpr size_t WS_WOB = WS_WKB + (size_t)5120 * 1024 * 2;
constexpr size_t WS_WM = WS_WOB + (size_t)1024 * 1536 * 2;
constexpr size_t WS_MEMN = WS_WM + (size_t)2 * 1024 * 1024 * 2;
constexpr size_t WS_MEMK = WS_MEMN + (size_t)2 * 256 * 1024 * 2;
constexpr size_t WS_MEMVT = WS_MEMK + (size_t)2 * 17 * 256 * 512 * 2;
constexpr size_t WS_GATE = WS_MEMVT + (size_t)2 * 17 * 256 * 512 * 2;
constexpr size_t SZ_CH = (size_t)NCH * 4 * 64 * 4;
constexpr size_t WS_GC = WS_GATE + (size_t)TT * 8 * 4;
constexpr size_t WS_MT = WS_GC + SZ_CH;
constexpr size_t WS_WS = WS_MT + SZ_CH;
constexpr size_t WS_WI = WS_WS + SZ_CH;
constexpr size_t WS_AS = WS_WI + SZ_CH;
constexpr size_t WS_BT = WS_AS + SZ_CH;
constexpr size_t WS_DEC = WS_BT + SZ_CH;
constexpr size_t WS_DENI = WS_DEC + 8192;
constexpr size_t WS_DENA = WS_DENI + (size_t)TT * 4 * 4;
constexpr size_t WS_XN = WS_DENA + (size_t)TT * 4 * 4;
constexpr size_t WS_AO = WS_XN + (size_t)TT * 1024 * 2;
constexpr size_t WS_Y1 = WS_AO + (size_t)TT * 1536 * 2;
constexpr size_t WS_KT = WS_Y1 + (size_t)TT * 1024 * 4;
constexpr size_t WS_VTA = WS_KT + (size_t)NCH * 4 * 256 * 64 * 2;
constexpr size_t WS_R1 = WS_VTA + (size_t)NCH * 4 * 256 * 64 * 2;
constexpr size_t SZ_R1 = (size_t)TT * 6144 * 2;
constexpr size_t WS_PB = WS_R1;
constexpr size_t WS_KBP = WS_PB + (size_t)TT * 3072 * 2;
constexpr size_t WS_VTP = WS_KBP + (size_t)TP * 1024 * 2;
constexpr size_t WS_R2 = WS_R1 + SZ_R1;
constexpr size_t WS_HINTER = WS_R2;
constexpr size_t WS_HINTRA = WS_R2 + (size_t)TT * 1024 * 4;
constexpr size_t WS_KBS = WS_R2;
constexpr size_t WS_VTS = WS_KBS + (size_t)16 * SKV * 1024 * 2;
constexpr size_t WS_WVT = WS_VTS + (size_t)16 * SKV * 1024 * 2;
constexpr size_t WS_U = WS_WVT + (size_t)NCH * 4 * 288 * 64 * 2;
constexpr size_t WS_CFAC = WS_U + SZ_CH;
constexpr size_t WS_CLOCC = WS_CFAC + 8192;
constexpr size_t WS_PM = WS_CLOCC + (size_t)256 * 4 * 9 * 8 * 2 * 64 * 16;
constexpr size_t WS_CHS = WS_PM + SZ_CH;
constexpr size_t WS_LD = WS_CHS + 16384;
constexpr size_t WS_CLOC = WS_LD + 8192;
constexpr size_t WS_END = WS_CLOC + (size_t)16 * 36 * 8 * 64 * 16 * 4;
constexpr int GRP = 16;
static_assert(WS_VTP + (size_t)TP * 1024 * 2 <= WS_R2, "R1 overflow");

DI unsigned pk2(float lo, float hi) { f32x2 v = {lo, hi}; return __builtin_bit_cast(unsigned, __builtin_convertvector(v, bf2_t)); }
DI bf16_t f2bf(float x) { return (bf16_t)(pk2(x, 0.f) & 0xffffu); }
DI float bf2f(unsigned v16) { return __uint_as_float(v16 << 16); }
DI float bflo(unsigned u) { return __uint_as_float(u << 16); }
DI float bfhi(unsigned u) { return __uint_as_float(u & 0xffff0000u); }
DI float rbf(float x) { return bflo(pk2(x, 0.f) & 0xffffu); }
DI int crow(int i, int h) { return (i & 3) + 8 * (i >> 2) + 4 * h; }
DI float wave_sum(float v) {
#pragma unroll
  for (int o = 32; o >= 1; o >>= 1) v += __shfl_xor(v, o);
  return v;
}
DI float fexp2(float x) { return __builtin_amdgcn_exp2f(x); }
DI float fexp(float x) { return __builtin_amdgcn_exp2f(x * LOG2E); }
DI float sigmoidf_(float x) { return 1.f / (1.f + __expf(-x)); }
DI float siluf_(float x) { return x / (1.f + __expf(-x)); }
DI bf16x8 pack_acc(const f32x16& x, int s) {
  u32x4 p;
  p[0] = pk2(x[8 * s + 0], x[8 * s + 1]); p[1] = pk2(x[8 * s + 2], x[8 * s + 3]);
  p[2] = pk2(x[8 * s + 4], x[8 * s + 5]); p[3] = pk2(x[8 * s + 6], x[8 * s + 7]);
  return __builtin_bit_cast(bf16x8, p);
}
DI bf16x8 ld16(const void* p) { return *(const bf16x8*)p; }
DI bf16x8 ld8x2(const void* p0, const void* p1) {
  u32x2 a = *(const u32x2*)p0, b = *(const u32x2*)p1; u32x4 r = {a[0], a[1], b[0], b[1]};
  return __builtin_bit_cast(bf16x8, r);
}
DI f32x16 zero16() { f32x16 z; for (int i = 0; i < 16; ++i) z[i] = 0.f; return z; }

DI void transpose_tile(const float* __restrict__ src, size_t ld_s, bf16_t* __restrict__ dst, size_t ld_d, const float* __restrict__ scale,
                       float* scr, int t, bool perm = false) {
  {
    const int c4 = t & 31, rb = t >> 5;
    f32x4 v[4];
#pragma unroll
    for (int i = 0; i < 4; ++i) v[i] = *(const f32x4*)(src + (size_t)(rb + 16 * i) * ld_s + 4 * c4);
#pragma unroll
    for (int i = 0; i < 4; ++i) {
      const int r = rb + 16 * i;
      f32x4 x = v[i];
      if (scale) { const float sc = scale[r]; x = x * sc; }
      float* d = scr + r * 129 + 4 * c4; d[0] = x[0]; d[1] = x[1]; d[2] = x[2]; d[3] = x[3];
    }
  }
  __syncthreads();
#pragma unroll
  for (int i = 0; i < 2; ++i) {
    const int id = t + 512 * i, c = id >> 3, rg = id & 7;
    const float* s = scr + (8 * rg) * 129 + c;
    u32x4 o; o[0] = pk2(s[0], s[129]); o[1] = pk2(s[2 * 129], s[3 * 129]); o[2] = pk2(s[4 * 129], s[5 * 129]); o[3] = pk2(s[6 * 129], s[7 * 129]);
    if (!perm) *(u32x4*)(dst + (size_t)c * ld_d + 8 * rg) = o;
    else {
      bf16_t* d = dst + (size_t)c * ld_d + 16 * (rg >> 1) + 4 * (rg & 1);
      u32x2 lo = {o[0], o[1]}, hi = {o[2], o[3]};
      *(u32x2*)d = lo; *(u32x2*)(d + 8) = hi;
    }
  }
  __syncthreads();
}

struct TJob { const float* src; size_t ld_s; bf16_t* dst; size_t ld_d; const float* scale; int tr, tc; };

DI void run_tjob_tile(const TJob& j, int tile, float* scr, int tid, bool perm = false) {
  const int ir = tile / j.tc, ic = tile % j.tc;
  transpose_tile(j.src + (size_t)(64 * ir) * j.ld_s + 128 * ic, j.ld_s, j.dst + (size_t)(128 * ic) * j.ld_d + 64 * ir, j.ld_d,
                 j.scale ? j.scale + 64 * ir : nullptr, scr, tid, perm);
}

DI float row_load_rstd(const float* xrow, f32x4 (&v)[4], int lane) {
  float ss = 0.f;
#pragma unroll
  for (int j = 0; j < 4; ++j) { v[j] = *(const f32x4*)(xrow + 4 * lane + 256 * j); ss += v[j][0] * v[j][0] + v[j][1] * v[j][1] + v[j][2] * v[j][2] + v[j][3] * v[j][3]; }
  ss = wave_sum(ss);
  return __builtin_amdgcn_rsqf(ss * (1.f / 1024.f) + EPS);
}

DI int diff_window(int hd) { const float sl2 = exp2f(-(float)(hd + 1)) * LOG2E; return (int)floorf((63.f + 192.f / sl2) * (1.f / 64.f)); }
DI int diff_est(int a) {
  const int hd = a & 7;
  const int w = diff_window(hd) + (a < 1024 ? 2 : 1);
  const int n = a < 1024 ? 2 * (a >> 3) + 2 : 65;
  return n < w ? n : w;
}

DI void phase0(const Params& p, unsigned char* lds) {
  const int tid = TIDX, lane = tid & 63, wid = tid >> 6;
  unsigned char* ws = p.ws;
  if (blockIdx.x == 0 && tid < 64) ((unsigned*)(ws + WS_CTR))[tid] = 0u;
  if (blockIdx.x == 0 && tid < 272) ((unsigned*)(ws + WS_KMAX))[tid] = 0u;
  if (blockIdx.x == 1) {
    int* est = (int*)lds;
    for (int a = tid; a < 1152; a += NTHREADS) est[a] = diff_est(a);
    __syncthreads();
    for (int a = tid; a < 1152; a += NTHREADS) {
      const int ea = est[a];
      int rank = 0;
      for (int b = 0; b < 1152; ++b) { const int eb = est[b]; rank += (eb > ea) || (eb == ea && b < a); }
      ((int*)(ws + WS_TORD))[rank] = a;
    }
    __syncthreads();
  }
  {
    TJob jobs[8];
    jobs[0] = {p.in[I_WINA], 6152, (bf16_t*)(ws + WS_WA), 1024, p.in[I_NG], 16, 40};
    jobs[1] = {p.in[I_WINA] + 5128, 6152, (bf16_t*)(ws + WS_WA) + (size_t)5120 * 1024, 1024, p.in[I_NG], 16, 8};
    jobs[2] = {p.in[I_WOA], 1024, (bf16_t*)(ws + WS_WOA), 1536, nullptr, 24, 8};
    jobs[3] = {p.in[I_WKV], 2048, (bf16_t*)(ws + WS_WKB), 1024, p.in[I_KVNG], 16, 16};
    jobs[4] = {p.in[I_WINB], 3072, (bf16_t*)(ws + WS_WKB) + (size_t)2048 * 1024, 1024, p.in[I_NG] + 1024, 16, 24};
    jobs[5] = {p.in[I_WOB], 1024, (bf16_t*)(ws + WS_WOB), 1536, nullptr, 24, 8};
    jobs[6] = {p.in[I_WMKV], 1024, (bf16_t*)(ws + WS_WM), 1024, nullptr, 16, 8};
    jobs[7] = {p.in[I_WMKV] + (size_t)1024 * 1024, 1024, (bf16_t*)(ws + WS_WM) + (size_t)1024 * 1024, 1024, nullptr, 16, 8};
    int base = 0;
#pragma unroll
    for (int j = 0; j < 8; ++j) {
      if (j >= 2 && j <= 5) continue;
      const int n = jobs[j].tr * jobs[j].tc;
      for (int t = blockIdx.x; t < n; t += gridDim.x) run_tjob_tile(jobs[j], t, (float*)lds, tid);
      base += n;
    }
    for (int t = blockIdx.x; t < 128 * 4; t += gridDim.x) {
      const int jb = t >> 2, tile = t & 3, l = jb >> 6, b = (jb >> 2) & 15, h = jb & 3;
      TJob j = {p.in[I_CMV] + ((size_t)(l * 16 + b) * 256) * 512 + h * 128, 512,
                (bf16_t*)(ws + WS_MEMVT) + ((size_t)(l * 17 + 1 + b) * 4 + h) * 128 * 256, 256, nullptr, 4, 1};
      run_tjob_tile(j, tile, (float*)lds, tid, true);
    }
  }
  {
    const size_t n8 = (size_t)2 * 16 * 256 * 512 / 8;
    for (size_t i = (size_t)blockIdx.x * NTHREADS + tid; i < n8; i += (size_t)gridDim.x * NTHREADS) {
      const size_t e = i * 8; const int l = (int)(e / ((size_t)16 * 131072)); const size_t rem = e - (size_t)l * 16 * 131072;
      const f32x4 a = *(const f32x4*)(p.in[I_CMK] + e), b = *(const f32x4*)(p.in[I_CMK] + e + 4);
      u32x4 o = {pk2(a[0], a[1]), pk2(a[2], a[3]), pk2(b[0], b[1]), pk2(b[2], b[3])};
      *(u32x4*)((bf16_t*)(ws + WS_MEMK) + ((size_t)(l * 17 + 1) * 131072) + rem) = o;
    }
  }
  {
    const int gw = blockIdx.x * 8 + wid, nw = gridDim.x * 8;
    const float* ng = p.in[I_NG];
    float* gwt = (float*)(lds + 32768);
    float* sg = (float*)(lds + 32768 + 36864);
    __syncthreads();
    for (int i = tid; i < 8192; i += NTHREADS) { const int k = i >> 3, c = i & 7; gwt[k * 8 + (k >> 2) * 4 + c] = p.in[I_WINA][(size_t)k * 6152 + 5120 + c] * ng[k]; }
    __syncthreads();
    for (int cc = blockIdx.x; cc < NCH; cc += gridDim.x) {
      f32x4 vn[4];
      {
        const int r0 = cc * 64 + wid * 8;
        const float* x0 = r0 < TP ? p.in[I_XP] + (size_t)r0 * 1024 : p.in[I_XS] + (size_t)(r0 - TP) * 1024;
#pragma unroll
        for (int j = 0; j < 4; ++j) vn[j] = *(const f32x4*)(x0 + 4 * lane + 256 * j);
      }
      for (int ri = 0; ri < 8; ++ri) {
        const int r = cc * 64 + wid * 8 + ri;
        f32x4 v[4];
#pragma unroll
        for (int j = 0; j < 4; ++j) v[j] = vn[j];
        if (ri + 1 < 8) {
          const float* x1 = (r + 1) < TP ? p.in[I_XP] + (size_t)(r + 1) * 1024 : p.in[I_XS] + (size_t)(r + 1 - TP) * 1024;
#pragma unroll
          for (int j = 0; j < 4; ++j) vn[j] = *(const f32x4*)(x1 + 4 * lane + 256 * j);
        }
        float ssq = 0.f;
#pragma unroll
        for (int j = 0; j < 4; ++j) ssq += v[j][0] * v[j][0] + v[j][1] * v[j][1] + v[j][2] * v[j][2] + v[j][3] * v[j][3];
        const float rstd = __builtin_amdgcn_rsqf(wave_sum(ssq) * (1.f / 1024.f) + EPS);
        float gacc[8];
#pragma unroll
        for (int c = 0; c < 8; ++c) gacc[c] = 0.f;
        bf16_t* xn = (bf16_t*)(ws + WS_XN) + (size_t)r * 1024;
#pragma unroll
        for (int j = 0; j < 4; ++j) {
          const int k0 = 4 * lane + 256 * j;
          const f32x4 xs = v[j] * rstd;
          u32x2 o = {pk2(xs[0], xs[1]), pk2(xs[2], xs[3])};
          *(u32x2*)(xn + k0) = o;
#pragma unroll
          for (int e = 0; e < 4; ++e) {
            const float* wr = gwt + (k0 + e) * 8 + (k0 >> 2) * 4;
            const f32x4 w0 = *(const f32x4*)wr, w1 = *(const f32x4*)(wr + 4);
            gacc[0] += xs[e] * w0[0]; gacc[1] += xs[e] * w0[1]; gacc[2] += xs[e] * w0[2]; gacc[3] += xs[e] * w0[3];
            gacc[4] += xs[e] * w1[0]; gacc[5] += xs[e] * w1[1]; gacc[6] += xs[e] * w1[2]; gacc[7] += xs[e] * w1[3];
          }
        }
#pragma unroll
        for (int c = 0; c < 8; ++c) gacc[c] = wave_sum(gacc[c]);
        if (lane < 8) {
          float gv = gacc[0];
#pragma unroll
          for (int c = 1; c < 8; ++c) gv = lane == c ? gacc[c] : gv;
          gv += p.in[I_BGA][lane];
          if (lane >= 4) gv = fminf(gv, 0.f) - log1pf(__expf(-fabsf(gv)));
          sg[(wid * 8 + ri) * 8 + lane] = gv;
        }
      }
      __syncthreads();
      if (wid < 4) {
        const int hd = wid, pr = cc * 4 + hd;
        const float ig = sg[lane * 8 + hd], lf = sg[lane * 8 + 4 + hd];
        float g = lf;
#pragma unroll
        for (int o = 1; o < 64; o <<= 1) { const float t = __shfl_up(g, o); if (lane >= o) g += t; }
        const float a = ig - g;
        float pm = a;
#pragma unroll
        for (int o = 1; o < 64; o <<= 1) { const float t = __shfl_up(pm, o); if (lane >= o) pm = fmaxf(pm, t); }
        const size_t o = (size_t)pr * 64 + lane;
        ((float*)(ws + WS_GC))[o] = g;
        ((float*)(ws + WS_AS))[o] = a;
        ((float*)(ws + WS_PM))[o] = pm;
        if (lane == 63) { ((float*)(ws + WS_CHS))[pr * 2] = g; ((float*)(ws + WS_CHS))[pr * 2 + 1] = pm; }
        const float u = __expf(a - __shfl(pm, 63));
        ((float*)(ws + WS_U))[o] = u;
        bf16_t* wr = (bf16_t*)(ws + WS_WVT) + ((size_t)pr * 288 + 256) * 64 + lane;
        wr[0] = f2bf(u);
#pragma unroll 4
        for (int rr = 1; rr < 32; ++rr) wr[rr * 64] = 0;
      }
      __syncthreads();
    }
    for (int r = gw; r < 512; r += nw) {
      const int l = r >> 8, rr = r & 255;
      f32x4 v[4];
      const float rstd = row_load_rstd(p.in[I_MEMP] + (size_t)rr * 1024, v, lane);
      bf16_t* o = (bf16_t*)(ws + WS_MEMN) + (size_t)r * 1024;
#pragma unroll
      for (int j = 0; j < 4; ++j) {
        const int k0 = 4 * lane + 256 * j;
        const f32x4 g = *(const f32x4*)(p.in[I_MNG] + l * 1024 + k0);
        const f32x4 xs = v[j] * rstd * g;
        u32x2 ov = {pk2(xs[0], xs[1]), pk2(xs[2], xs[3])};
        *(u32x2*)(o + k0) = ov;
      }
    }
  }
}

constexpr int G_STAGE = 49152;
struct GemmAcc { f32x16 a[2][2]; };
DI void dma16(const void* g, unsigned char* l) { __builtin_amdgcn_global_load_lds((const unsigned*)g, (unsigned*)l, 16, 0, 0); }

template <int NB = 2>
DI void gemm_tile(const bf16_t* __restrict__ A, size_t lda, const bf16_t* __restrict__ Bt, size_t ldb, int K, unsigned char* lds, GemmAcc& acc, int tid) {
  const int lane = tid & 63, wid = __builtin_amdgcn_readfirstlane(tid >> 6), r = lane & 31, h = lane >> 5;
  const int wr = wid >> 1, wc = wid & 1;
#pragma unroll
  for (int a = 0; a < 2; ++a)
#pragma unroll
    for (int b = 0; b < 2; ++b) acc.a[a][b] = zero16();
  const int nk = K / 64;
  unsigned aoff[4], boff[2];
#pragma unroll
  for (int e = 0; e < 4; ++e) { const int row = 8 * (wid * 4 + e) + (lane >> 3), lc = (lane & 7) ^ ((row >> 1) & 7); aoff[e] = (unsigned)row * (unsigned)lda + 8u * lc; }
#pragma unroll
  for (int e = 0; e < NB; ++e) { const int row = 8 * (wid * NB + e) + (lane >> 3), lc = (lane & 7) ^ ((row >> 1) & 7); boff[e] = (unsigned)row * (unsigned)ldb + 8u * lc; }
  auto issue = [&](int kt, int buf) {
    unsigned char* base = lds + buf * G_STAGE;
#pragma unroll
    for (int e = 0; e < 4; ++e) dma16(A + (aoff[e] + 64u * kt), base + (wid * 4 + e) * 1024);
#pragma unroll
    for (int e = 0; e < NB; ++e) dma16(Bt + (boff[e] + 64u * kt), base + 32768 + (wid * NB + e) * 1024);
  };
  asm volatile("s_waitcnt vmcnt(0)" ::: "memory");
  __syncthreads();
  issue(0, 0);
  if (nk > 1) issue(1, 1);
  const unsigned sw = (r >> 1) & 7;
  unsigned co[4];
#pragma unroll
  for (int kk = 0; kk < 4; ++kk) co[kk] = (((2 * kk + h) ^ sw) << 4);
  const unsigned ra = (wr * 64 + r) * 128, rb = 32768 + (wc * 32 * NB + r) * 128;
  for (int kt = 0; kt < nk; ++kt) {
    if (kt + 1 < nk) { if (NB == 2) asm volatile("s_waitcnt vmcnt(6)" ::: "memory"); else asm volatile("s_waitcnt vmcnt(5)" ::: "memory"); }
    else asm volatile("s_waitcnt vmcnt(0)" ::: "memory");
    asm volatile("s_waitcnt lgkmcnt(0)" ::: "memory");
    __builtin_amdgcn_s_barrier();
    if (kt + 2 < nk) issue(kt + 2, (kt + 2) % 3);
    const unsigned char* base = lds + (kt % 3) * G_STAGE;
    const unsigned char* pa = base + ra;
    const unsigned char* pb = base + rb;
#pragma unroll
    for (int kk = 0; kk < 4; ++kk) {
      const bf16x8 a0 = ld16(pa + co[kk]), a1 = ld16(pa + 4096 + co[kk]);
      const bf16x8 b0 = ld16(pb + co[kk]);
      acc.a[0][0] = MFMA32(a0, b0, acc.a[0][0]);
      acc.a[1][0] = MFMA32(a1, b0, acc.a[1][0]);
      if (NB == 2) {
        const bf16x8 b1 = ld16(pb + 4096 + co[kk]);
        acc.a[0][1] = MFMA32(a0, b1, acc.a[0][1]);
        acc.a[1][1] = MFMA32(a1, b1, acc.a[1][1]);
      }
    }
    __builtin_amdgcn_sched_group_barrier(0x100, 2 + NB, 0);
    __builtin_amdgcn_sched_group_barrier(0x100, 2 + NB, 0); __builtin_amdgcn_sched_group_barrier(0x008, 2 * NB, 0);
    __builtin_amdgcn_sched_group_barrier(0x100, 2 + NB, 0); __builtin_amdgcn_sched_group_barrier(0x008, 2 * NB, 0);
    __builtin_amdgcn_sched_group_barrier(0x100, 2 + NB, 0); __builtin_amdgcn_sched_group_barrier(0x008, 2 * NB, 0);
    __builtin_amdgcn_sched_group_barrier(0x008, 2 * NB, 0);
  }
}

DI void gemm256(const bf16_t* __restrict__ A, size_t lda, const bf16_t* __restrict__ Bt, size_t ldb, int K, unsigned char* lds, GemmAcc (&acc)[2], int tid) {
  const int lane = tid & 63, wid = __builtin_amdgcn_readfirstlane(tid >> 6), r = lane & 31, h = lane >> 5;
  const int wr = wid >> 2, wc = wid & 3;
#pragma unroll
  for (int mh = 0; mh < 2; ++mh)
#pragma unroll
    for (int a = 0; a < 2; ++a)
#pragma unroll
      for (int b = 0; b < 2; ++b) acc[mh].a[a][b] = zero16();
  const int nk = K / 64;
  unsigned aoff[4], boff[4];
#pragma unroll
  for (int e = 0; e < 4; ++e) {
    const int row = 8 * (wid * 4 + e) + (lane >> 3), lc = (lane & 7) ^ ((row >> 1) & 7);
    aoff[e] = (unsigned)row * (unsigned)lda + 8u * lc; boff[e] = (unsigned)row * (unsigned)ldb + 8u * lc;
  }
  auto issue = [&](int kt, int buf) {
    unsigned char* base = lds + buf * 65536;
#pragma unroll
    for (int e = 0; e < 4; ++e) { dma16(A + (aoff[e] + 64u * kt), base + (wid * 4 + e) * 1024); dma16(Bt + (boff[e] + 64u * kt), base + 32768 + (wid * 4 + e) * 1024); }
  };
  asm volatile("s_waitcnt vmcnt(0)" ::: "memory");
  __syncthreads();
  issue(0, 0);
  const unsigned sw = (r >> 1) & 7;
  unsigned co[4];
#pragma unroll
  for (int kk = 0; kk < 4; ++kk) co[kk] = (((2 * kk + h) ^ sw) << 4);
  const unsigned ra = (wr * 128 + r) * 128, rb = 32768 + (wc * 64 + r) * 128;
  for (int kt = 0; kt < nk; ++kt) {
    asm volatile("s_waitcnt vmcnt(0)" ::: "memory");
    asm volatile("s_waitcnt lgkmcnt(0)" ::: "memory");
    __builtin_amdgcn_s_barrier();
    if (kt + 1 < nk) issue(kt + 1, (kt + 1) & 1);
    const unsigned char* base = lds + (kt & 1) * 65536;
    const unsigned char* pa = base + ra;
    const unsigned char* pb = base + rb;
#pragma unroll
    for (int kk = 0; kk < 4; ++kk) {
      const bf16x8 b0 = ld16(pb + co[kk]), b1 = ld16(pb + 4096 + co[kk]);
#pragma unroll
      for (int mh = 0; mh < 2; ++mh) {
        const bf16x8 a0 = ld16(pa + 8192 * mh + co[kk]), a1 = ld16(pa + 8192 * mh + 4096 + co[kk]);
        acc[mh].a[0][0] = MFMA32(a0, b0, acc[mh].a[0][0]);
        acc[mh].a[0][1] = MFMA32(a0, b1, acc[mh].a[0][1]);
        acc[mh].a[1][0] = MFMA32(a1, b0, acc[mh].a[1][0]);
        acc[mh].a[1][1] = MFMA32(a1, b1, acc[mh].a[1][1]);
      }
    }
#define SGB_R(N) __builtin_amdgcn_sched_group_barrier(0x100, N, 0)
#define SGB_M(N) __builtin_amdgcn_sched_group_barrier(0x008, N, 0)
    SGB_R(4);
    SGB_R(2); SGB_M(4); SGB_R(4); SGB_M(4);
    SGB_R(2); SGB_M(4); SGB_R(4); SGB_M(4);
    SGB_R(2); SGB_M(4); SGB_R(4); SGB_M(4);
    SGB_R(2); SGB_M(4); SGB_M(4);
  }
}

DI void gate_scan(const Params& p, unsigned char* lds) {
  const int tid = TIDX, lane = tid & 63, wid = tid >> 6;
  unsigned char* ws = p.ws;
  float* s_ch = (float*)lds;
  float* s_mc = s_ch + NCH * 8;
  float* s_mn = s_mc + NCH * 4;
  __syncthreads();
  for (int i = tid; i < NCH * 8; i += NTHREADS) s_ch[i] = ((const float*)(ws + WS_CHS))[i];
  __syncthreads();
  if (tid < 4) {
    float m = 0.f, ld = 0.f;
    float* LD = (float*)(ws + WS_LD);
    const bool wr = blockIdx.x == 0;
#pragma unroll 8
    for (int c = 0; c < 256; ++c) {
      s_mc[c * 4 + tid] = m; if (wr) LD[c * 4 + tid] = ld;
      const float gl = s_ch[(c * 4 + tid) * 2], mn = gl + fmaxf(m, s_ch[(c * 4 + tid) * 2 + 1]);
      ld += gl + m - mn;
      m = mn; s_mn[c * 4 + tid] = m;
    }
    if (wr) { LD[256 * 4 + tid] = ld; p.out[O_PM + tid] = m; }
  } else if (tid >= 64 && tid < 128) {
    const int b = (tid - 64) >> 2, hd = tid & 3, pr = (256 + b) * 4 + hd;
    const float m0 = p.in[I_SM][b * 4 + hd];
    const float m = s_ch[pr * 2] + fmaxf(m0, s_ch[pr * 2 + 1]);
    s_mc[pr] = m0; s_mn[pr] = m;
    if (blockIdx.x == 0) p.out[O_SM + b * 4 + hd] = m;
  }
  __syncthreads();
  for (int cc = blockIdx.x; cc < NCH; cc += gridDim.x) {
    if (wid < 4) {
      const int hd = wid, pr = cc * 4 + hd;
      const size_t o = (size_t)pr * 64 + lane;
      const float g = ((const float*)(ws + WS_GC))[o], a = ((const float*)(ws + WS_AS))[o], pm = ((const float*)(ws + WS_PM))[o];
      const float mc = s_mc[pr], mn = s_mn[pr], gl = s_ch[pr * 2];
      const float mt = g + fmaxf(mc, pm);
      ((float*)(ws + WS_MT))[o] = mt;
      ((float*)(ws + WS_WS))[o] = __expf(gl + a - mn);
      ((float*)(ws + WS_WI))[o] = __expf(g + mc - mt);
      ((float*)(ws + WS_AS))[o] = a * LOG2E;
      ((float*)(ws + WS_BT))[o] = (g - mt) * LOG2E;
      if (lane == 0) { ((float*)(ws + WS_DEC))[pr] = __expf(gl + mc - mn); const float amx = s_ch[pr * 2 + 1]; ((float*)(ws + WS_CFAC))[pr] = __expf(amx - fmaxf(mc, amx)); }
    }
  }
  __syncthreads();
}

DI void phase1(const Params& p, unsigned char* lds) {
  const int tid = TIDX, lane = tid & 63, wid = tid >> 6, r = lane & 31, h = lane >> 5;
  unsigned char* ws = p.ws;
  gate_scan(p, lds);
  const int n_main = 68 * 24, n_mem = 16;
  for (int t = blockIdx.x; t < n_main + n_mem; t += gridDim.x) {
    if (t < n_main) {
      const int tm = t / 24, tn = t % 24, m0 = tm * 256, n0 = tn * 256;
      GemmAcc acc2[2];
      gemm256((const bf16_t*)(ws + WS_XN) + (size_t)m0 * 1024, 1024, (const bf16_t*)(ws + WS_WA) + (size_t)n0 * 1024, 1024, 1024, lds, acc2, tid);
#pragma unroll
      for (int mh = 0; mh < 2; ++mh) {
      const GemmAcc& acc = acc2[mh];
      const int wr = (wid >> 2) * 2 + mh, wc = wid & 3;
      bf16_t* PA = (bf16_t*)(ws + WS_R1);
      const int sec = n0 >> 10;
#pragma unroll
      for (int a = 0; a < 2; ++a)
#pragma unroll
        for (int b = 0; b < 2; ++b) {
          __builtin_amdgcn_sched_barrier(0);
          const int n = n0 + wc * 64 + 32 * b + r, mb = m0 + wr * 64 + 32 * a;
          if (sec != 2) {
            const float sc = sec == 1 ? 0.0625f : 1.f;
            const int pc = (n >> 2) & 3, np = sec <= 1 ? (n & ~15) + 4 * (((pc & 1) << 1) | (pc >> 1)) + (n & 3) : n;
#pragma unroll
            for (int i = 0; i < 16; ++i) PA[(size_t)(mb + crow(i, h)) * 6144 + np] = f2bf(acc.a[a][b][i] * sc);
          }
          if (sec == 1 || sec == 2) {
            const float sc = sec == 1 ? 0.0625f : 1.f;
            const int f = n & 1023, hd = f >> 8, fe = f & 255;
            bf16_t* T = (bf16_t*)(ws + (sec == 1 ? WS_KT : WS_VTA));
#pragma unroll
            for (int g = 0; g < 4; ++g) {
              const int m = mb + 8 * g + 4 * h, cc = m >> 6, s = m & 63;
              u32x2 o = {pk2(acc.a[a][b][4 * g] * sc, acc.a[a][b][4 * g + 1] * sc), pk2(acc.a[a][b][4 * g + 2] * sc, acc.a[a][b][4 * g + 3] * sc)};
              *(u32x2*)(T + (((size_t)cc * 4 + hd) * 256 + fe) * 64 + s) = o;
              if (sec == 2) {
                const f32x4 u = *(const f32x4*)((const float*)(ws + WS_U) + ((size_t)cc * 4 + hd) * 64 + s);
                u32x2 ow = {pk2(acc.a[a][b][4 * g] * u[0], acc.a[a][b][4 * g + 1] * u[1]), pk2(acc.a[a][b][4 * g + 2] * u[2], acc.a[a][b][4 * g + 3] * u[3])};
                *(u32x2*)((bf16_t*)(ws + WS_WVT) + (((size_t)cc * 4 + hd) * 288 + fe) * 64 + s) = ow;
              }
            }
          }
        }
      }
    } else {
      GemmAcc acc;
      const int wr = wid >> 1, wc = wid & 1;
      const int tt = t - n_main, l = tt >> 3, n0 = (tt & 7) * 128;
      gemm_tile((const bf16_t*)(ws + WS_MEMN) + (size_t)l * 256 * 1024, 1024, (const bf16_t*)(ws + WS_WM) + ((size_t)l * 1024 + n0) * 1024, 1024, 1024, lds, acc, tid);
      const bool isv = n0 >= 512;
      float* of = p.out + (isv ? O_PMV : O_PMK) + (size_t)l * 131072;
      bf16_t* mk = (bf16_t*)(ws + WS_MEMK) + (size_t)(l * 17) * 131072;
      bf16_t* mv = (bf16_t*)(ws + WS_MEMVT) + (size_t)(l * 17) * 131072;
#pragma unroll
      for (int a = 0; a < 2; ++a)
#pragma unroll
        for (int b = 0; b < 2; ++b) {
          __builtin_amdgcn_sched_barrier(0);
          const int f = (n0 & 511) + wc * 64 + 32 * b + r, mb = wr * 64 + 32 * a;
#pragma unroll
          for (int g = 0; g < 4; ++g) {
            const int m = mb + 8 * g + 4 * h;
            float* o4 = of + (size_t)m * 512 + f;
            o4[0] = acc.a[a][b][4 * g]; o4[512] = acc.a[a][b][4 * g + 1]; o4[1024] = acc.a[a][b][4 * g + 2]; o4[1536] = acc.a[a][b][4 * g + 3];
            if (!isv) {
              bf16_t* k4 = mk + (size_t)m * 512 + f;
              k4[0] = f2bf(acc.a[a][b][4 * g]); k4[512] = f2bf(acc.a[a][b][4 * g + 1]); k4[1024] = f2bf(acc.a[a][b][4 * g + 2]); k4[1536] = f2bf(acc.a[a][b][4 * g + 3]);
            } else {
              u32x2 o = {pk2(acc.a[a][b][4 * g], acc.a[a][b][4 * g + 1]), pk2(acc.a[a][b][4 * g + 2], acc.a[a][b][4 * g + 3])};
              const int pq = (m >> 2) & 3, mp = (m & ~15) + 4 * (((pq & 1) << 1) | (pq >> 1));
              *(u32x2*)(mv + (size_t)f * 256 + mp) = o;
            }
          }
        }
    }
  }
}

DI void scan_task(const Params& p, unsigned char* lds, int sb  , int hd, int j, int grp) {
  const int tid = TIDX, lane = tid & 63, wid = tid >> 6, r = lane & 31, h = lane >> 5;
  unsigned char* ws = p.ws;
  const int cc0 = sb < 0 ? GRP * grp : 256 + sb, nch = sb < 0 ? GRP : 1;
  const bf16_t* PA = (const bf16_t*)(ws + WS_R1);
  const bf16_t* KT = (const bf16_t*)(ws + WS_KT);
  const bf16_t* VT = (const bf16_t*)(ws + WS_VTA);
  const float* WSa = (const float*)(ws + WS_WS);
  const float* WIa = (const float*)(ws + WS_WI);
  const float* DEC = (const float*)(ws + WS_DEC);
  float* red = (float*)lds;
  const bool nsl = j == 8;
  f32x16 S = zero16();
  if (sb >= 0) {
    if (!nsl) {
      const float* C0 = p.in[I_SC] + ((size_t)(sb * 4 + hd) * 256 + 32 * j + r) * 256 + 32 * wid;
#pragma unroll
      for (int g = 0; g < 4; ++g) { const f32x4 c = *(const f32x4*)(C0 + 8 * g + 4 * h); S[4 * g] = c[0]; S[4 * g + 1] = c[1]; S[4 * g + 2] = c[2]; S[4 * g + 3] = c[3]; }
    } else if (r == 0) {
      const float* n0 = p.in[I_SN] + (size_t)(sb * 4 + hd) * 256 + 32 * wid;
#pragma unroll
      for (int g = 0; g < 4; ++g) { const f32x4 c = *(const f32x4*)(n0 + 8 * g + 4 * h); S[4 * g] = c[0]; S[4 * g + 1] = c[1]; S[4 * g + 2] = c[2]; S[4 * g + 3] = c[3]; }
    }
  }
  bf16x8 kt[4], wv[4], qf[2][2];
  u32x4 ktn[4], vn[4], qn[2][2];
  float wsn;
  float* wsl = (float*)(lds + 69632);
  auto loadraw = [&](int cc) {
    const size_t ch = (size_t)cc * 4 + hd;
    const bf16_t* kp = KT + (ch * 256 + 32 * wid + r) * 64 + 8 * h;
#pragma unroll
    for (int st = 0; st < 4; ++st) ktn[st] = *(const u32x4*)(kp + 16 * st);
    wsn = WSa[ch * 64 + lane];
    if (!nsl) {
      const bf16_t* vp = VT + (ch * 256 + 32 * j + r) * 64 + 8 * h;
#pragma unroll
      for (int st = 0; st < 4; ++st) vn[st] = *(const u32x4*)(vp + 16 * st);
    }
#pragma unroll
    for (int tt = 0; tt < 2; ++tt) {
      const bf16_t* qp = PA + (size_t)(cc * 64 + 32 * tt + r) * 6144 + hd * 256 + 32 * wid + 8 * h;
#pragma unroll
      for (int s2 = 0; s2 < 2; ++s2) qn[tt][s2] = *(const u32x4*)(qp + 16 * s2);
    }
  };
  auto convert = [&]() {
    __syncthreads();
    if (wid == 0) wsl[lane] = wsn;
    __syncthreads();
#pragma unroll
    for (int st = 0; st < 4; ++st) {
      kt[st] = __builtin_bit_cast(bf16x8, ktn[st]);
      const f32x4 w0 = *(const f32x4*)(wsl + 16 * st + 8 * h), w1 = *(const f32x4*)(wsl + 16 * st + 8 * h + 4);
      u32x4 o;
      if (!nsl) {
        const u32x4 v = vn[st];
        o[0] = pk2(bflo(v[0]) * w0[0], bfhi(v[0]) * w0[1]); o[1] = pk2(bflo(v[1]) * w0[2], bfhi(v[1]) * w0[3]);
        o[2] = pk2(bflo(v[2]) * w1[0], bfhi(v[2]) * w1[1]); o[3] = pk2(bflo(v[3]) * w1[2], bfhi(v[3]) * w1[3]);
      } else {
        o = (u32x4){pk2(w0[0], w0[1]), pk2(w0[2], w0[3]), pk2(w1[0], w1[1]), pk2(w1[2], w1[3])};
        if (r != 0) o = (u32x4){0u, 0u, 0u, 0u};
      }
      wv[st] = __builtin_bit_cast(bf16x8, o);
    }
#pragma unroll
    for (int tt = 0; tt < 2; ++tt)
#pragma unroll
      for (int s2 = 0; s2 < 2; ++s2) qf[tt][s2] = __builtin_bit_cast(bf16x8, qn[tt][s2]);
  };
  loadraw(cc0);
  convert();
  for (int c = 0; c < nch; ++c) {
    const int cc = cc0 + c;
    if (c + 1 < nch) loadraw(cc + 1);
    const float dec = DEC[cc * 4 + hd];
    const bf16x8 xs0 = pack_acc(S, 0), xs1 = pack_acc(S, 1);
    f32x16 z0 = MFMA32(xs0, qf[0][0], zero16()); z0 = MFMA32(xs1, qf[0][1], z0);
    f32x16 z1 = MFMA32(xs0, qf[1][0], zero16()); z1 = MFMA32(xs1, qf[1][1], z1);
    S = S * dec;
#pragma unroll
    for (int st = 0; st < 4; ++st) S = MFMA32(kt[st], wv[st], S);
    __syncthreads();
    {
      float* rw = red + wid * (64 * 33);
#pragma unroll
      for (int i = 0; i < 16; ++i) { rw[r * 33 + crow(i, h)] = z0[i]; rw[(32 + r) * 33 + crow(i, h)] = z1[i]; }
    }
    __syncthreads();
    {
      const int v = tid & 31;
#pragma unroll
      for (int e = 0; e < 4; ++e) {
        const int t = (tid >> 5) + 16 * e;
        float s = 0.f;
#pragma unroll
        for (int w8 = 0; w8 < 8; ++w8) s += red[w8 * (64 * 33) + t * 33 + v];
        const float wi = WIa[((size_t)cc * 4 + hd) * 64 + t];
        if (!nsl) ((float*)(ws + WS_HINTER))[(size_t)(cc * 64 + t) * 1024 + hd * 256 + 32 * j + v] = s * wi;
        else if (v == 0) ((float*)(ws + WS_DENI))[(size_t)(cc * 64 + t) * 4 + hd] = s * wi;
      }
    }
    if (c + 1 < nch) convert();
  }
  if (sb < 0) {
    float* cl = (float*)(ws + WS_CLOC) + ((((size_t)(grp * 4 + hd) * 9 + j) * 8 + wid) * 64 + lane) * 16;
#pragma unroll
    for (int g = 0; g < 4; ++g) { f32x4 c = {S[4 * g], S[4 * g + 1], S[4 * g + 2], S[4 * g + 3]}; *(f32x4*)(cl + 4 * g) = c; }
  } else {
    if (!nsl) {
      float* Co = (sb < 0 ? p.out + O_PC + (size_t)hd * 65536 : p.out + O_SC + (size_t)(sb * 4 + hd) * 65536) + (size_t)(32 * j + r) * 256 + 32 * wid;
#pragma unroll
      for (int g = 0; g < 4; ++g) { f32x4 c = {S[4 * g], S[4 * g + 1], S[4 * g + 2], S[4 * g + 3]}; *(f32x4*)(Co + 8 * g + 4 * h) = c; }
    } else if (r == 0) {
      float* no = (sb < 0 ? p.out + O_PN + (size_t)hd * 256 : p.out + O_SN + (size_t)(sb * 4 + hd) * 256) + 32 * wid;
#pragma unroll
      for (int g = 0; g < 4; ++g) { f32x4 c = {S[4 * g], S[4 * g + 1], S[4 * g + 2], S[4 * g + 3]}; *(f32x4*)(no + 8 * g + 4 * h) = c; }
    }
  }
  __syncthreads();
}

DI void intra_task(const Params& p, int cc, int hd) {
  const int tid = TIDX, lane = tid & 63, wid = tid >> 6, r = lane & 31, h = lane >> 5;
  unsigned char* ws = p.ws;
  const int tt = wid & 1, vq = wid >> 1;
  const bf16_t* PA = (const bf16_t*)(ws + WS_R1);
  const bf16_t* VT = (const bf16_t*)(ws + WS_VTA);
  const size_t ch = (size_t)cc * 4 + hd;
  f32x16 s0 = zero16(), s1 = zero16();
  {
    const bf16_t* qp = PA + (size_t)(cc * 64 + 32 * tt + r) * 6144 + hd * 256 + 8 * h;
    const bf16_t* kp = PA + (size_t)(cc * 64 + r) * 6144 + 1024 + hd * 256 + 8 * h;
#pragma unroll 4
    for (int kk = 0; kk < 16; ++kk) {
      const bf16x8 q = ld16(qp + 16 * kk), k0 = ld16(kp + 16 * kk), k1 = ld16(kp + (size_t)32 * 6144 + 16 * kk);
      s0 = MFMA32(k0, q, s0);
      if (tt == 1) s1 = MFMA32(k1, q, s1);
    }
  }
  const int t = 32 * tt + r;
  const float bt = ((const float*)(ws + WS_BT))[ch * 64 + t];
  const float* asp = (const float*)(ws + WS_AS) + ch * 64;
  float den = 0.f;
#pragma unroll
  for (int g = 0; g < 4; ++g) {
    const f32x4 a0 = *(const f32x4*)(asp + 8 * g + 4 * h);
    const f32x4 a1 = *(const f32x4*)(asp + 32 + 8 * g + 4 * h);
#pragma unroll
    for (int e = 0; e < 4; ++e) {
      const int s = 8 * g + 4 * h + e;
      const float w0 = s <= t ? fexp2(bt + a0[e]) : 0.f;
      const float w1 = (32 + s) <= t ? fexp2(bt + a1[e]) : 0.f;
      s0[4 * g + e] *= w0; s1[4 * g + e] *= w1;
      den += s0[4 * g + e] + s1[4 * g + e];
    }
  }
  den += __shfl_xor(den, 32);
  if (vq == 0 && h == 0) ((float*)(ws + WS_DENA))[(size_t)(cc * 64 + t) * 4 + hd] = den;
  bf16x8 pf[2][2];
  pf[0][0] = pack_acc(s0, 0); pf[0][1] = pack_acc(s0, 1); pf[1][0] = pack_acc(s1, 0); pf[1][1] = pack_acc(s1, 1);
  float* Ho = (float*)(ws + WS_HINTRA) + (size_t)(cc * 64 + t) * 1024 + hd * 256;
#pragma unroll
  for (int vt = 0; vt < 2; ++vt) {
    const int v0 = vq * 64 + vt * 32;
    const bf16_t* vp = VT + (ch * 256 + v0 + r) * 64 + 4 * h;
    f32x16 o = zero16();
#pragma unroll
    for (int st = 0; st < 2; ++st)
#pragma unroll
      for (int s2 = 0; s2 < 2; ++s2) {
        const bf16x8 a = ld8x2(vp + 32 * st + 16 * s2, vp + 32 * st + 16 * s2 + 8);
        o = MFMA32(a, pf[st][s2], o);
      }
#pragma unroll
    for (int g = 0; g < 4; ++g) { f32x4 c = {o[4 * g], o[4 * g + 1], o[4 * g + 2], o[4 * g + 3]}; *(f32x4*)(Ho + v0 + 8 * g + 4 * h) = c; }
  }
}

DI void memattn_task(const Params& p, unsigned char* lds, int task, int layer, const bf16_t* Qb, const bf16_t* Zb, unsigned ldq) {
  const int tid = TIDX, lane = tid & 63, wid = __builtin_amdgcn_readfirstlane(tid >> 6), r = lane & 31, h = lane >> 5;
  unsigned char* ws = p.ws;
  const bool prm = task < 256;
  const int hd = task & 3, ti = prm ? task >> 2 : (task - 256) >> 2;
  const int sbi = prm ? 0 : 1 + ti, tok0 = prm ? ti * 256 : TP + ti * 64, nact = prm ? 8 : 2;
  const bf16_t* MK = (const bf16_t*)(ws + WS_MEMK) + (size_t)(layer * 17 + sbi) * 131072 + hd * 128;
  const bf16_t* MV = (const bf16_t*)(ws + WS_MEMVT) + ((size_t)(layer * 17 + sbi) * 4 + hd) * 128 * 256;
  asm volatile("s_waitcnt vmcnt(0)" ::: "memory");
  __syncthreads();
#pragma unroll
  for (int e = 0; e < 8; ++e) {
    const int q = wid * 8 + e;
    { const int row = 4 * q + (lane >> 4), lc = (lane & 15) ^ (row & 15); dma16(MK + ((unsigned)row * 512u + 8u * lc), lds + q * 1024); }
    { const int row = 2 * q + (lane >> 5), lc = (lane & 31) ^ (row & 15); dma16(MV + ((unsigned)row * 256u + 8u * lc), lds + 65536 + q * 1024); }
  }
  const int tok = tok0 + (wid < nact ? wid : 0) * 32 + r;
  bf16x8 qf[8];
  {
    const bf16_t* qp = Qb + ((unsigned)tok * ldq + hd * 128 + 8 * h);
#pragma unroll
    for (int kk = 0; kk < 8; ++kk) qf[kk] = ld16(qp + 16 * kk);
  }
  asm volatile("s_waitcnt vmcnt(0)" ::: "memory");
  __syncthreads();
  if (wid >= nact) return;
  const float sc = 0.08838834764831845f * LOG2E;
  f32x16 O[4];
#pragma unroll
  for (int vt = 0; vt < 4; ++vt) O[vt] = zero16();
  float mrun = -1e30f, l = 0.f;
  const unsigned sw = r & 15;
#pragma unroll 1
  for (int kb = 0; kb < 4; ++kb) {
    f32x16 s0 = zero16(), s1 = zero16();
    const unsigned char* kp = lds + (kb * 64 + r) * 256;
#pragma unroll
    for (int kk = 0; kk < 8; ++kk) {
      const unsigned co = ((unsigned)(2 * kk + h) ^ sw) << 4;
      const bf16x8 k0 = ld16(kp + co), k1 = ld16(kp + 8192 + co);
      s0 = MFMA32(k0, qf[kk], s0); s1 = MFMA32(k1, qf[kk], s1);
    }
    float mx = -1e30f;
#pragma unroll
    for (int i = 0; i < 16; ++i) mx = fmaxf(mx, fmaxf(s0[i], s1[i]));
    mx = fmaxf(mx, __shfl_xor(mx, 32)) * sc;
    const float mnew = fmaxf(mrun, mx), alpha = fexp2(mrun - mnew);
    mrun = mnew;
    float sum = 0.f;
#pragma unroll
    for (int i = 0; i < 16; ++i) { s0[i] = fexp2(s0[i] * sc - mnew); s1[i] = fexp2(s1[i] * sc - mnew); sum += s0[i] + s1[i]; }
    l = l * alpha + sum;
#pragma unroll
    for (int vt = 0; vt < 4; ++vt) O[vt] = O[vt] * alpha;
    bf16x8 pf[2][2];
    pf[0][0] = pack_acc(s0, 0); pf[0][1] = pack_acc(s0, 1); pf[1][0] = pack_acc(s1, 0); pf[1][1] = pack_acc(s1, 1);
#pragma unroll
    for (int vt = 0; vt < 4; ++vt) {
      const unsigned char* vp = lds + 65536 + (32 * vt + r) * 512;
#pragma unroll
      for (int st = 0; st < 2; ++st)
#pragma unroll
        for (int s2 = 0; s2 < 2; ++s2) {
          const unsigned co = ((unsigned)(8 * kb + 4 * st + 2 * s2 + h) ^ sw) << 4;
          O[vt] = MFMA32(ld16(vp + co), pf[st][s2], O[vt]);
        }
    }
  }
  l += __shfl_xor(l, 32);
  const float inv = 1.f / l;
  const bf16_t* zp = Zb + ((unsigned)tok * ldq + hd * 128);
  bf16_t* op = (bf16_t*)(ws + WS_AO) + ((unsigned)tok * 1536u + 1024 + hd * 128);
#pragma unroll
  for (int vt = 0; vt < 4; ++vt)
#pragma unroll
    for (int g = 0; g < 4; ++g) {
      const int v = 32 * vt + 8 * g + 4 * h;
      const u32x2 z = *(const u32x2*)(zp + v);
      const float o0 = O[vt][4 * g] * inv * siluf_(bflo(z[0])), o1 = O[vt][4 * g + 1] * inv * siluf_(bfhi(z[0]));
      const float o2 = O[vt][4 * g + 2] * inv * siluf_(bflo(z[1])), o3 = O[vt][4 * g + 3] * inv * siluf_(bfhi(z[1]));
      u32x2 o = {pk2(o0, o1), pk2(o2, o3)};
      *(u32x2*)(op + v) = o;
    }
}

DI int next_item(unsigned* ctr, unsigned char* lds_flag_area, int tid) {
  __syncthreads();
  int* sh = (int*)lds_flag_area;
  if (tid == 0) *sh = (int)atomicAdd(ctr, 1u);
  __syncthreads();
  const int v = *sh;
  return v;
}

DI void scanA_task(const Params& p, int hd, int j, int grp);

DI void late_weight_item(const Params& p, unsigned char* lds, int it) {
  unsigned char* ws = p.ws;
  TJob j; int t = it;
  if (t < 192) j = {p.in[I_WOA], 1024, (bf16_t*)(ws + WS_WOA), 1536, nullptr, 24, 8};
  else if (t < 448) { t -= 192; j = {p.in[I_WKV], 2048, (bf16_t*)(ws + WS_WKB), 1024, p.in[I_KVNG], 16, 16}; }
  else if (t < 832) { t -= 448; j = {p.in[I_WINB], 3072, (bf16_t*)(ws + WS_WKB) + (size_t)2048 * 1024, 1024, p.in[I_NG] + 1024, 16, 24}; }
  else { t -= 832; j = {p.in[I_WOB], 1024, (bf16_t*)(ws + WS_WOB), 1536, nullptr, 24, 8}; }
  run_tjob_tile(j, t, (float*)lds, TIDX);
}

DI void phase2(const Params& p, unsigned char* lds) {
  unsigned* ctr = (unsigned*)(p.ws + WS_CTR) + 0 + 8 * p.pad;
  const bf16_t* PA = (const bf16_t*)(p.ws + WS_R1);
  const int n_ps = 36 * 16, n_ss = 576, n_in = NCH * 4, n_ma = 256 + 64;
  for (;;) {
    const int it = next_item(ctr, lds + LDS_BYTES - 16, TIDX);
    if (it >= n_ps + n_ss + n_in + n_ma + 1024) break;
    if (it >= n_ps + n_ss + n_in + n_ma) { late_weight_item(p, lds, it - (n_ps + n_ss + n_in + n_ma)); continue; }
    if (it < n_ps) scanA_task(p, (it % 36) / 9, it % 9, it / 36);
    else if (it < n_ps + n_ss) { const int q = it - n_ps; scan_task(p, lds, q / 36, (q % 36) / 9, q % 9, 0); }
    else if (it < n_ps + n_ss + n_in) { const int q = it - n_ps - n_ss; intra_task(p, q >> 2, q & 3); }
    else { const int q = it - n_ps - n_ss - n_in; memattn_task(p, lds, q, 0, PA + 5120, PA + 5632, 6144); }
  }
}


DI void scanA_task(const Params& p, int hd, int j, int grp) {
  const int tid = TIDX, lane = tid & 63, wid = tid >> 6, r = lane & 31, h = lane >> 5;
  unsigned char* ws = p.ws;
  const bf16_t* KT = (const bf16_t*)(ws + WS_KT);
  const bf16_t* WV = (const bf16_t*)(ws + WS_WVT);
  f32x16 S = zero16();
  u32x4 kn[4], vn[4];
  auto load = [&](int cc) {
    const size_t ch = (size_t)cc * 4 + hd;
    const bf16_t* kp = KT + (ch * 256 + 32 * wid + r) * 64 + 8 * h;
    const bf16_t* vp = WV + (ch * 288 + 32 * j + r) * 64 + 8 * h;
#pragma unroll
    for (int st = 0; st < 4; ++st) { kn[st] = *(const u32x4*)(kp + 16 * st); vn[st] = *(const u32x4*)(vp + 16 * st); }
  };
  load(GRP * grp);
#pragma unroll 1
  for (int c = 0; c < GRP; ++c) {
    const int cc = GRP * grp + c;
    bf16x8 kt[4], wv[4];
#pragma unroll
    for (int st = 0; st < 4; ++st) { kt[st] = __builtin_bit_cast(bf16x8, kn[st]); wv[st] = __builtin_bit_cast(bf16x8, vn[st]); }
    if (c + 1 < GRP) load(cc + 1);
    u32x4* cl = (u32x4*)(ws + WS_CLOCC) + ((((size_t)cc * 4 + hd) * 9 + j) * 8 + wid) * 128 + lane;
    cl[0] = __builtin_bit_cast(u32x4, pack_acc(S, 0));
    cl[64] = __builtin_bit_cast(u32x4, pack_acc(S, 1));
    f32x16 D = zero16();
#pragma unroll
    for (int st = 0; st < 4; ++st) D = MFMA32(kt[st], wv[st], D);
    const float dec = ((const float*)(ws + WS_DEC))[cc * 4 + hd], cf = ((const float*)(ws + WS_CFAC))[cc * 4 + hd];
    S = S * dec + D * cf;
  }
  float* cl = (float*)(ws + WS_CLOC) + ((((size_t)(grp * 4 + hd) * 9 + j) * 8 + wid) * 64 + lane) * 16;
#pragma unroll
  for (int g = 0; g < 4; ++g) { f32x4 c = {S[4 * g], S[4 * g + 1], S[4 * g + 2], S[4 * g + 3]}; *(f32x4*)(cl + 4 * g) = c; }
}

DI void scanfix_task(const Params& p, unsigned char* lds, int grp, int hd, int j) {
  const int tid = TIDX, lane = tid & 63, wid = tid >> 6, r = lane & 31, h = lane >> 5;
  unsigned char* ws = p.ws;
  const bool nsl = j == 8;
  const float* LD = (const float*)(ws + WS_LD);
  f32x16 S = zero16();
#pragma unroll 4
  for (int gp = 0; gp < grp; ++gp) {
    const float dg = __expf(LD[(GRP * (gp + 1)) * 4 + hd] - LD[(GRP * gp) * 4 + hd]);
    const float* cl = (const float*)(ws + WS_CLOC) + ((((size_t)(gp * 4 + hd) * 9 + j) * 8 + wid) * 64 + lane) * 16;
#pragma unroll
    for (int g = 0; g < 4; ++g) { const f32x4 c = *(const f32x4*)(cl + 4 * g);
      S[4 * g] = S[4 * g] * dg + c[0]; S[4 * g + 1] = S[4 * g + 1] * dg + c[1]; S[4 * g + 2] = S[4 * g + 2] * dg + c[2]; S[4 * g + 3] = S[4 * g + 3] * dg + c[3]; }
  }
  if (grp == 16) {
    if (!nsl) {
      float* Co = p.out + O_PC + (size_t)hd * 65536 + (size_t)(32 * j + r) * 256 + 32 * wid;
#pragma unroll
      for (int g = 0; g < 4; ++g) { f32x4 c = {S[4 * g], S[4 * g + 1], S[4 * g + 2], S[4 * g + 3]}; *(f32x4*)(Co + 8 * g + 4 * h) = c; }
    } else if (r == 0) {
      float* no = p.out + O_PN + (size_t)hd * 256 + 32 * wid;
#pragma unroll
      for (int g = 0; g < 4; ++g) { f32x4 c = {S[4 * g], S[4 * g + 1], S[4 * g + 2], S[4 * g + 3]}; *(f32x4*)(no + 8 * g + 4 * h) = c; }
    }
    return;
  }
  u32x4* fr = (u32x4*)lds;
  float* tp = (float*)(lds + 16384) + wid * (64 * 33);
  __syncthreads();
  fr[(wid * 2 + 0) * 64 + lane] = __builtin_bit_cast(u32x4, pack_acc(S, 0));
  fr[(wid * 2 + 1) * 64 + lane] = __builtin_bit_cast(u32x4, pack_acc(S, 1));
  __syncthreads();
  const bf16_t* PA = (const bf16_t*)(ws + WS_R1);
  const float* WIa = (const float*)(ws + WS_WI);
  const bool hasg = grp > 0;
#pragma unroll
  for (int ci = 0; ci < 2; ++ci) {
    const int cc = GRP * grp + wid + 8 * ci;
    const float D = __expf(LD[cc * 4 + hd] - LD[(GRP * grp) * 4 + hd]);
    const u32x4* clc = (const u32x4*)(ws + WS_CLOCC) + (((size_t)cc * 4 + hd) * 9 + j) * 8 * 128 + lane;
#pragma unroll
    for (int tt = 0; tt < 2; ++tt) {
      const bf16_t* qp = PA + (size_t)(cc * 64 + 32 * tt + r) * 6144 + hd * 256 + 8 * h;
      f32x16 z = zero16(), z2 = zero16();
#pragma unroll
      for (int kt = 0; kt < 8; ++kt)
#pragma unroll
        for (int s2 = 0; s2 < 2; ++s2) {
          const bf16x8 q = ld16(qp + 32 * kt + 16 * s2);
          z = MFMA32(__builtin_bit_cast(bf16x8, clc[(kt * 2 + s2) * 64]), q, z);
          if (hasg) z2 = MFMA32(__builtin_bit_cast(bf16x8, fr[(kt * 2 + s2) * 64 + lane]), q, z2);
        }
#pragma unroll
      for (int i = 0; i < 16; ++i) tp[(32 * tt + r) * 33 + crow(i, h)] = z[i] + D * z2[i];
    }
    const int v = lane & 31;
#pragma unroll 4
    for (int e = 0; e < 32; ++e) {
      const int t = 2 * e + (lane >> 5);
      const float val = tp[t * 33 + v] * WIa[((size_t)cc * 4 + hd) * 64 + t];
      if (!nsl) ((float*)(ws + WS_HINTER))[(size_t)(cc * 64 + t) * 1024 + hd * 256 + 32 * j + v] = val;
      else if (v == 0) ((float*)(ws + WS_DENI))[(size_t)(cc * 64 + t) * 4 + hd] = val;
    }
  }
}

DI void phase2c(const Params& p, unsigned char* lds) {
  unsigned* ctr = (unsigned*)(p.ws + WS_CTR) + 3 + 8 * p.pad;
  for (;;) {
    const int it = next_item(ctr, lds + LDS_BYTES - 16, TIDX);
    if (it >= 17 * 36) break;
    const int g = 16 - it / 36;
    scanfix_task(p, lds, g, (it % 36) / 9, it % 9);
  }
}

DI void phase3(const Params& p) {
  const int tid = TIDX, lane = tid & 63, wid = tid >> 6;
  unsigned char* ws = p.ws;
  const int gw = blockIdx.x * 8 + wid, nw = gridDim.x * 8;
  const bf16_t* PA = (const bf16_t*)(ws + WS_R1);
  for (int it = gw; it < TT * 4; it += nw) {
    const int tok = it >> 2, hd = it & 3, cc = tok >> 6, t = tok & 63;
    const size_t off = (size_t)tok * 1024 + hd * 256 + 4 * lane;
    const f32x4 a = *(const f32x4*)((const float*)(ws + WS_HINTER) + off), b = *(const f32x4*)((const float*)(ws + WS_HINTRA) + off);
    const float den = ((const float*)(ws + WS_DENI))[tok * 4 + hd] + ((const float*)(ws + WS_DENA))[tok * 4 + hd];
    const float mt = ((const float*)(ws + WS_MT))[((size_t)cc * 4 + hd) * 64 + t];
    const float dn = 1.f / fmaxf(fabsf(den), __expf(-mt));
    const u32x2 ou = *(const u32x2*)(PA + (size_t)tok * 6144 + 3072 + hd * 256 + 4 * lane);
    const u32x2 zu = *(const u32x2*)(PA + (size_t)tok * 6144 + 4096 + hd * 256 + 4 * lane);
    f32x4 hv = (a + b) * dn;
    hv[0] *= sigmoidf_(bflo(ou[0])); hv[1] *= sigmoidf_(bfhi(ou[0])); hv[2] *= sigmoidf_(bflo(ou[1])); hv[3] *= sigmoidf_(bfhi(ou[1]));
    float ss = hv[0] * hv[0] + hv[1] * hv[1] + hv[2] * hv[2] + hv[3] * hv[3];
    ss = wave_sum(ss);
    const float rstd = __builtin_amdgcn_rsqf(ss * (1.f / 256.f) + EPS);
    const f32x4 hg = *(const f32x4*)(p.in[I_HGA] + hd * 256 + 4 * lane);
    hv = hv * rstd * hg;
    hv[0] *= siluf_(bflo(zu[0])); hv[1] *= siluf_(bfhi(zu[0])); hv[2] *= siluf_(bflo(zu[1])); hv[3] *= siluf_(bfhi(zu[1]));
    u32x2 o = {pk2(hv[0], hv[1]), pk2(hv[2], hv[3])};
    *(u32x2*)((bf16_t*)(ws + WS_AO) + (size_t)tok * 1536 + hd * 256 + 4 * lane) = o;
  }
}

DI void cacheconv_item(const Params& p, unsigned char* lds, int it);

DI void phase_outproj(const Params& p, unsigned char* lds, int layer) {
  const int tid = TIDX, lane = tid & 63, wid = tid >> 6, r = lane & 31, h = lane >> 5, wr = wid >> 1, wc = wid & 1;
  unsigned char* ws = p.ws;
  const bf16_t* W = (const bf16_t*)(ws + (layer == 0 ? WS_WOA : WS_WOB));
  for (int t = blockIdx.x; t < 68 * 16; t += gridDim.x) {
    const int tm = t >> 4, tn = t & 15, m0 = tm * 256, n0 = tn * 64;
    GemmAcc acc;
    gemm_tile<1>((const bf16_t*)(ws + WS_AO) + (size_t)m0 * 1536, 1536, W + (size_t)n0 * 1536, 1536, 1536, lds, acc, tid);
#pragma unroll
    for (int a = 0; a < 2; ++a) {
      const int n = n0 + wc * 32 + r, mb = m0 + wr * 64 + 32 * a;
#pragma unroll
      for (int i = 0; i < 16; ++i) {
        const int m = mb + crow(i, h);
        if (layer == 0) {
          const float xv = m < TP ? p.in[I_XP][(size_t)m * 1024 + n] : p.in[I_XS][(size_t)(m - TP) * 1024 + n];
          ((float*)(ws + WS_Y1))[(size_t)m * 1024 + n] = xv + acc.a[a][0][i];
        } else {
          p.out[O_Y + (size_t)m * 1024 + n] = ((const float*)(ws + WS_Y1))[(size_t)m * 1024 + n] + acc.a[a][0][i];
        }
      }
    }
  }
  if (layer == 0) {
    unsigned* ctr = (unsigned*)(p.ws + WS_CTR) + 4 + 8 * p.pad;
    for (;;) {
      const int it = next_item(ctr, lds + LDS_BYTES - 16, TIDX);
      if (it >= 1024) break;
      cacheconv_item(p, lds, it);
    }
  }
}

DI void phase5(const Params& p, unsigned char* lds) {
  const int tid = TIDX, lane = tid & 63, wid = tid >> 6;
  unsigned char* ws = p.ws;
  const int gw = blockIdx.x * 8 + wid, nw = gridDim.x * 8;
  for (int r = gw; r < TT; r += nw) {
    f32x4 v[4];
    const float rstd = row_load_rstd((const float*)(ws + WS_Y1) + (size_t)r * 1024, v, lane);
    bf16_t* xn = (bf16_t*)(ws + WS_XN) + (size_t)r * 1024;
#pragma unroll
    for (int j = 0; j < 4; ++j) { const f32x4 xs = v[j] * rstd; u32x2 o = {pk2(xs[0], xs[1]), pk2(xs[2], xs[3])}; *(u32x2*)(xn + 4 * lane + 256 * j) = o; }
  }
}

DI void cacheconv_item(const Params& p, unsigned char* lds, int it) {
  const int tid = TIDX;
  unsigned char* ws = p.ws;
  if (it < 512) {
    const int b = it >> 5, slab = it & 31;
    float* smax = (float*)lds;
    const int hm = (tid & 127) >> 3;
    __syncthreads();
    if (tid < 16) smax[tid] = 0.f;
    __syncthreads();
    float mx = 0.f;
    const float* src = p.in[I_CK] + ((size_t)b * PAST + slab * 128) * 1024;
    bf16_t* dst = (bf16_t*)(ws + WS_KBS) + ((size_t)b * SKV + slab * 128) * 1024;
#pragma unroll 4
    for (int i = 0; i < 32; ++i) {
      const unsigned e = (unsigned)(i * NTHREADS + tid) * 8u;
      const f32x4 a = *(const f32x4*)(src + e), c = *(const f32x4*)(src + e + 4);
      u32x4 o = {pk2(a[0], a[1]), pk2(a[2], a[3]), pk2(c[0], c[1]), pk2(c[2], c[3])};
      *(u32x4*)(dst + e) = o;
      float ss = a[0] * a[0] + a[1] * a[1] + a[2] * a[2] + a[3] * a[3] + c[0] * c[0] + c[1] * c[1] + c[2] * c[2] + c[3] * c[3];
      ss += __shfl_xor(ss, 1); ss += __shfl_xor(ss, 2); ss += __shfl_xor(ss, 4);
      mx = fmaxf(mx, ss);
    }
    if ((tid & 7) == 0) atomicMax((unsigned*)smax + hm, __float_as_uint(mx));
    __syncthreads();
    if (tid < 16) atomicMax((unsigned*)(ws + WS_KMAX) + (1 + b) * 16 + tid, __float_as_uint(sqrtf(smax[tid])));
  } else {
    const int q = it - 512, jb = q >> 2, part = q & 3, b = jb >> 3, hd = jb & 7;
    TJob j = {p.in[I_CV] + (size_t)b * PAST * 1024 + hd * 128, 1024, (bf16_t*)(ws + WS_VTS) + ((size_t)(b * 8 + hd) * 128) * SKV, SKV, nullptr, 64, 1};
    for (int tile = part * 16; tile < part * 16 + 16; ++tile) run_tjob_tile(j, tile, (float*)lds, tid, true);
  }
}

DI void phase6(const Params& p, unsigned char* lds) {
  const int tid = TIDX, lane = tid & 63, wid = tid >> 6, r = lane & 31, h = lane >> 5;
  unsigned char* ws = p.ws;
  for (int t = blockIdx.x; t < 68 * 20; t += gridDim.x) {
    const int tm = t / 20, tn = t % 20, m0 = tm * 256, n0 = tn * 256;
    GemmAcc acc2[2];
    gemm256((const bf16_t*)(ws + WS_XN) + (size_t)m0 * 1024, 1024, (const bf16_t*)(ws + WS_WKB) + (size_t)n0 * 1024, 1024, 1024, lds, acc2, tid);
    const int sec = n0 >> 10;
    const bool samp = m0 >= TP;
#pragma unroll
    for (int mh = 0; mh < 2; ++mh) {
    const GemmAcc& acc = acc2[mh];
    const int wr = (wid >> 2) * 2 + mh, wc = wid & 3;
#pragma unroll
    for (int a = 0; a < 2; ++a)
#pragma unroll
      for (int b = 0; b < 2; ++b) {
        __builtin_amdgcn_sched_barrier(0);
        const int n = n0 + wc * 64 + 32 * b + r, mb = m0 + wr * 64 + 32 * a;
        if (sec == 0) {
          const int f = n;
          if (b == 1) {
            float mx = 0.f;
#pragma unroll
            for (int i = 0; i < 16; ++i) {
              float ss = acc.a[a][0][i] * acc.a[a][0][i] + acc.a[a][1][i] * acc.a[a][1][i];
              ss += __shfl_xor(ss, 1); ss += __shfl_xor(ss, 2); ss += __shfl_xor(ss, 4); ss += __shfl_xor(ss, 8); ss += __shfl_xor(ss, 16);
              mx = fmaxf(mx, ss);
            }
            mx = fmaxf(mx, __shfl_xor(mx, 32));
            if (lane == 0) {
              const int strm = samp ? 1 + ((mb - TP) >> 6) : 0;
              atomicMax((unsigned*)(ws + WS_KMAX) + strm * 16 + ((n0 + wc * 64) >> 6), __float_as_uint(sqrtf(mx)));
            }
          }
#pragma unroll
          for (int i = 0; i < 16; ++i) {
            const int m = mb + crow(i, h);
            const float v = acc.a[a][b][i];
            if (!samp) { (p.out + O_PK)[(unsigned)(m * 1024 + f)] = v; ((bf16_t*)(ws + WS_KBP))[(unsigned)(m * 1024 + f)] = f2bf(v); }
            else { const int ms = m - TP, bb = ms >> 6, s = ms & 63; (p.out + O_SK)[(unsigned)(ms * 1024 + f)] = v;
                   ((bf16_t*)(ws + WS_KBS))[(unsigned)((bb * SKV + PAST + s) * 1024 + f)] = f2bf(v); }
          }
        } else if (sec == 1) {
          const int f = n - 1024, hd = f >> 7, vd = f & 127;
#pragma unroll
          for (int i = 0; i < 16; ++i) {
            const int m = mb + crow(i, h);
            if (!samp) (p.out + O_PV)[(unsigned)(m * 1024 + f)] = acc.a[a][b][i]; else (p.out + O_SV)[(unsigned)((m - TP) * 1024 + f)] = acc.a[a][b][i];
          }
#pragma unroll
          for (int g = 0; g < 4; ++g) {
            const int m0r = mb + 8 * g + 4 * h, pq = (m0r >> 2) & 3;
            const int m = (m0r & ~15) + 4 * (((pq & 1) << 1) | (pq >> 1));
            u32x2 o = {pk2(acc.a[a][b][4 * g], acc.a[a][b][4 * g + 1]), pk2(acc.a[a][b][4 * g + 2], acc.a[a][b][4 * g + 3])};
            if (!samp) *(u32x2*)((bf16_t*)(ws + WS_VTP) + (unsigned)((hd * 128 + vd) * TP + m)) = o;
            else { const int ms = m - TP, bb = ms >> 6, s = ms & 63; *(u32x2*)((bf16_t*)(ws + WS_VTS) + (unsigned)(((bb * 8 + hd) * 128 + vd) * SKV + PAST + s)) = o; }
          }
        } else {
          const float sc = sec == 2 ? 0.125f * LOG2E : 1.f;
          bf16_t* PB = (bf16_t*)(ws + WS_PB);
#pragma unroll
          for (int i = 0; i < 16; ++i) PB[(unsigned)((mb + crow(i, h)) * 3072 + (n - 2048))] = f2bf(acc.a[a][b][i] * sc);
        }
      }
    }
  }
}

constexpr int A_BUF = 32768, A_KB = 16384, A_FLAGS = 3 * A_BUF;

DI void diffattn_task(const Params& p, unsigned char* lds, int sb  , int qt  , int hd, float lam) {
  const int tid = TIDX, lane = tid & 63, wid = __builtin_amdgcn_readfirstlane(tid >> 6), r = lane & 31, h = lane >> 5;
  unsigned char* ws = p.ws;
  const int cq = wid >> 2, sub = (wid >> 1) & 1, map = wid & 1;
  const int ncq = sb < 0 ? 2 : 1;
  const int base_chunk = sb < 0 ? 2 * qt : 64;
  const int tok0 = sb < 0 ? qt * 128 : TP + sb * 64;
  const bool wvalid = cq < ncq;
  const int qc = base_chunk + cq;
  const int tl = 32 * sub + r;
  const int tok = tok0 + 64 * (wvalid ? cq : 0) + tl;
  const bf16_t* Kb = sb < 0 ? (const bf16_t*)(ws + WS_KBP) + hd * 128 : (const bf16_t*)(ws + WS_KBS) + (size_t)sb * SKV * 1024 + hd * 128;
  const bf16_t* Vb = sb < 0 ? (const bf16_t*)(ws + WS_VTP) + (size_t)hd * 128 * TP : (const bf16_t*)(ws + WS_VTS) + (size_t)(sb * 8 + hd) * 128 * SKV;
  const unsigned ldv = sb < 0 ? TP : SKV;
  const bf16_t* PB = (const bf16_t*)(ws + WS_PB);
  bf16x8 qf[4];
  float qn = 0.f;
  {
    const unsigned qo = (unsigned)tok * 3072u + hd * 128 + map * 64 + 8 * h;
#pragma unroll
    for (int kk = 0; kk < 4; ++kk) {
      const u32x4 u = *(const u32x4*)(PB + (qo + 16 * kk));
      qf[kk] = __builtin_bit_cast(bf16x8, u);
#pragma unroll
      for (int e = 0; e < 4; ++e) { const float a = bflo(u[e]), b = bfhi(u[e]); qn += a * a + b * b; }
    }
    qn += __shfl_xor(qn, 32);
    qn = sqrtf(qn);
  }
  const float kmax = ((const float*)(ws + WS_KMAX))[(sb < 0 ? 0 : 1 + sb) * 16 + hd * 2 + map];
  const float shift = qn * kmax * 1.02f + 0.5f - 40.f;
  const float sl2 = exp2f(-(float)(hd + 1)) * LOG2E;
  const int wd = diff_window(hd);
  const float bh0 = sl2 * (float)(4 * h) - sl2 * (float)tl - shift, bh1 = bh0 + 32.f * sl2;
  float cs[16];
#pragma unroll
  for (int i = 0; i < 16; ++i) cs[i] = __uint_as_float(__builtin_amdgcn_readfirstlane(__float_as_uint(sl2 * (float)((i & 3) + 8 * (i >> 2)))));
  f32x16 O[4];
#pragma unroll
  for (int vt = 0; vt < 4; ++vt) O[vt] = zero16();
  float l = 0.f;
  const int jmax = base_chunk + ncq - 1;
  const int jmin = max(0, base_chunk - wd);
  const int nit = jmax - jmin + 1;
  unsigned kofs[2], vofs[2];
#pragma unroll
  for (int e = 0; e < 2; ++e) {
    const int q = wid * 2 + e;
    { const int row = 4 * q + (lane >> 4), lc = (lane & 15) ^ (row & 15); kofs[e] = (unsigned)row * 1024u + 8u * lc; }
    { const int row = 8 * q + (lane >> 3), lc = (lane & 7) ^ ((row >> 1) & 7); vofs[e] = (unsigned)row * ldv + 8u * lc; }
  }
  auto issue = [&](int j, int buf) {
    const bf16_t* kj = Kb + (size_t)j * 65536;
    const bf16_t* vj = Vb + (size_t)j * 64;
    unsigned char* base = lds + buf * A_BUF;
#pragma unroll
    for (int e = 0; e < 2; ++e) {
      dma16(kj + kofs[e], base + (wid * 2 + e) * 1024);
      dma16(vj + vofs[e], base + A_KB + (wid * 2 + e) * 1024);
    }
  };
  unsigned kco[4], vco[4];
#pragma unroll
  for (int kk = 0; kk < 4; ++kk) kco[kk] = (unsigned)r * 256u + ((((unsigned)(8 * map + 2 * kk + h)) ^ (unsigned)(r & 15)) << 4);
#pragma unroll
  for (int sx = 0; sx < 4; ++sx) vco[sx] = A_KB + (unsigned)r * 128u + ((((unsigned)(2 * sx + h)) ^ (unsigned)((r >> 1) & 7)) << 4);
  asm volatile("s_waitcnt vmcnt(0)" ::: "memory");
  __syncthreads();
  issue(jmax, 0);
  if (nit > 1) issue(jmax - 1, 1);
  for (int it = 0; it < nit; ++it) {
    const int j = jmax - it;
    if (it + 1 < nit) asm volatile("s_waitcnt vmcnt(4)" ::: "memory"); else asm volatile("s_waitcnt vmcnt(0)" ::: "memory");
    asm volatile("s_waitcnt lgkmcnt(0)" ::: "memory");
    __builtin_amdgcn_s_barrier();
    if (it + 2 < nit) issue(j - 2, (it + 2) % 3);
    if (wvalid && j <= qc && qc - j <= wd) {
      const unsigned char* base = lds + (it % 3) * A_BUF;
      const float dofs = sl2 * (float)((qc - j) * 64);
      float sum = 0.f;
#pragma unroll
      for (int half = 0; half < 2; ++half) {
        f32x16 sc;
        {
          float b0 = (half ? bh1 : bh0) - dofs;
          asm volatile("" : "+v"(b0));
#pragma unroll
          for (int i = 0; i < 16; ++i) sc[i] = b0 + cs[i];
        }
        if (j == qc) {
          int tlv = tl;
          asm volatile("" : "+v"(tlv));
          const float m2 = -2.f * sl2, xt = (float)(4 * h + 32 * half - tlv);
#pragma unroll
          for (int i = 0; i < 16; ++i) sc[i] = fmaf(m2, fmaxf(xt + (float)((i & 3) + 8 * (i >> 2)), 0.f), sc[i]);
        }
        {
          bf16x8 kf[4];
#pragma unroll
          for (int kk = 0; kk < 4; ++kk) kf[kk] = ld16(base + 8192 * half + kco[kk]);
#pragma unroll
          for (int kk = 0; kk < 4; ++kk) sc = MFMA32(kf[kk], qf[kk], sc);
        }
        bf16x8 vf[8];
#pragma unroll
        for (int vt = 0; vt < 4; ++vt) { vf[2 * vt] = ld16(base + 4096 * vt + vco[2 * half]); vf[2 * vt + 1] = ld16(base + 4096 * vt + vco[2 * half + 1]); }
#pragma unroll
        for (int i = 0; i < 16; ++i) { sc[i] = fexp2(sc[i]); sum += sc[i]; }
        const bf16x8 p0 = pack_acc(sc, 0), p1 = pack_acc(sc, 1);
#pragma unroll
        for (int vt = 0; vt < 4; ++vt) { O[vt] = MFMA32(vf[2 * vt], p0, O[vt]); O[vt] = MFMA32(vf[2 * vt + 1], p1, O[vt]); }
      }
      l += sum;
    }
  }
  asm volatile("s_waitcnt vmcnt(0)" ::: "memory");
  __syncthreads();
  l += __shfl_xor(l, 32);
  const float inv = wvalid ? 1.f / l : 0.f;
  float* xch = (float*)lds + (size_t)(wid >> 1) * 4096;
  if (map == 1 && wvalid) {
    const float sc = inv * lam;
#pragma unroll
    for (int vt = 0; vt < 4; ++vt)
#pragma unroll
      for (int i = 0; i < 16; ++i) xch[(vt * 16 + i) * 64 + lane] = O[vt][i] * sc;
  }
  __syncthreads();
  if (map == 0 && wvalid) {
    float ss = 0.f;
#pragma unroll
    for (int vt = 0; vt < 4; ++vt)
#pragma unroll
      for (int i = 0; i < 16; ++i) { const float o = O[vt][i] * inv - xch[(vt * 16 + i) * 64 + lane]; O[vt][i] = o; ss += o * o; }
    ss += __shfl_xor(ss, 32);
    const float lam_init = 0.8f - 0.6f * 0.7408182206817179f;
    const float rs = __builtin_amdgcn_rsqf(ss * (1.f / 128.f) + EPS) * (1.f - lam_init);
    const unsigned zo = (unsigned)tok * 3072u + 1024 + hd * 128, oo = (unsigned)tok * 1536u + hd * 128;
    bf16_t* AOp = (bf16_t*)(ws + WS_AO);
    const float* sg = p.in[I_SUBG];
#pragma unroll
    for (int vt = 0; vt < 4; ++vt)
#pragma unroll
      for (int g = 0; g < 4; ++g) {
        const int v = 32 * vt + 8 * g + 4 * h;
        const u32x2 z = *(const u32x2*)(PB + (zo + v));
        const f32x4 gg = *(const f32x4*)(sg + v);
        const float o0 = O[vt][4 * g] * rs * gg[0] * siluf_(bflo(z[0])), o1 = O[vt][4 * g + 1] * rs * gg[1] * siluf_(bfhi(z[0]));
        const float o2 = O[vt][4 * g + 2] * rs * gg[2] * siluf_(bflo(z[1])), o3 = O[vt][4 * g + 3] * rs * gg[3] * siluf_(bfhi(z[1]));
        u32x2 o = {pk2(o0, o1), pk2(o2, o3)};
        *(u32x2*)(AOp + (oo + v)) = o;
      }
  }
  __syncthreads();
}

DI void phase7(const Params& p, unsigned char* lds) {
  unsigned* ctr = (unsigned*)(p.ws + WS_CTR) + 1 + 8 * p.pad;
  const bf16_t* PB = (const bf16_t*)(p.ws + WS_PB);
  float lam;
  {
    const int lane = TIDX & 63;
    const float* lv = p.in[I_LAMB];
    const float a = wave_sum(lv[lane] * lv[64 + lane]), b = wave_sum(lv[128 + lane] * lv[192 + lane]);
    const float lam_init = 0.8f - 0.6f * 0.7408182206817179f;
    lam = __expf(a) - __expf(b) + lam_init;
  }
  const int n_s = 128, n_p = 1024, n_ma = 256 + 64;
  const int* tord = (const int*)(p.ws + WS_TORD);
  for (;;) {
    const int it = next_item(ctr, lds + LDS_BYTES - 16, TIDX);
    if (it >= n_s + n_p) break;
    const int a = tord[it];
    const bool pr = a < n_p;
    diffattn_task(p, lds, pr ? -1 : ((a - n_p) >> 3), pr ? (a >> 3) : 0, a & 7, lam);
  }
  for (;;) {
    const int it = next_item(ctr + 1, lds + LDS_BYTES - 16, TIDX);
    if (it >= n_ma) break;
    memattn_task(p, lds, it, 1, PB + 2048, PB + 2560, 3072);
  }
}

DI void phase9(const Params& p) {
  const int tid = TIDX, lane = tid & 63, wid = tid >> 6;
  const int gw = blockIdx.x * 8 + wid, nw = gridDim.x * 8;
  for (int r = gw; r < TT; r += nw) {
    f32x4 v[4];
    float* row = p.out + O_Y + (size_t)r * 1024;
    const float rstd = row_load_rstd(row, v, lane);
#pragma unroll
    for (int j = 0; j < 4; ++j) {
      const f32x4 g = *(const f32x4*)(p.in[I_FNG] + 4 * lane + 256 * j);
      *(f32x4*)(row + 4 * lane + 256 * j) = v[j] * rstd * g;
    }
  }
}

DI void grid_barrier(unsigned* bar, unsigned target, int tid) {
  asm volatile("s_waitcnt vmcnt(0)" ::: "memory");
  __syncthreads();
  if (tid == 0) {
    __builtin_amdgcn_fence(__ATOMIC_RELEASE, "agent");
    asm volatile("s_waitcnt vmcnt(0)" ::: "memory");
    __hip_atomic_fetch_add(bar, 1u, __ATOMIC_RELAXED, __HIP_MEMORY_SCOPE_AGENT);
    while (__hip_atomic_load(bar, __ATOMIC_RELAXED, __HIP_MEMORY_SCOPE_AGENT) < target) __builtin_amdgcn_s_sleep(1);
    __builtin_amdgcn_fence(__ATOMIC_ACQUIRE, "agent");
    asm volatile("s_waitcnt vmcnt(0)" ::: "memory");
  }
  __syncthreads();
}

__global__ __launch_bounds__(512) void mk(Params pin) {
  extern __shared__ __attribute__((aligned(16))) unsigned char lds[];
  Params p = pin;
  p.wv = __builtin_amdgcn_readfirstlane((int)(__builtin_amdgcn_workitem_id_x() >> 6));
  cg::grid_group grid = cg::this_grid();
  unsigned nbar = 0;
  unsigned* bar = (unsigned*)(p.ws + WS_CTR) + 32;
#define RUN_PHASE(PH, CALL) if (p.ph_lo <= PH && PH < p.ph_hi) { CALL; if (PH + 1 < p.ph_hi) { ++nbar; grid_barrier(bar, nbar * gridDim.x, TIDX); } }
  if (p.ph_lo <= 0 && 0 < p.ph_hi) { phase0(p, lds); if (1 < p.ph_hi) grid.sync(); }
  RUN_PHASE(1, phase1(p, lds))
  RUN_PHASE(2, phase2(p, lds))
  if (p.ph_lo <= 2 && 2 < p.ph_hi) { phase2c(p, lds); ++nbar; grid_barrier(bar, nbar * gridDim.x, TIDX); }
  RUN_PHASE(3, phase3(p))
  RUN_PHASE(4, phase_outproj(p, lds, 0))
  RUN_PHASE(5, phase5(p, lds))
  RUN_PHASE(6, phase6(p, lds))
  RUN_PHASE(7, phase7(p, lds))
  RUN_PHASE(8, phase_outproj(p, lds, 1))
  RUN_PHASE(9, phase9(p))
}

extern "C" void kernel_launch(void* const* d_in, const int* in_sizes, int n_in, void* d_out, int out_size,
                              void* d_ws, size_t ws_size, hipStream_t stream) {
  static int grid_blocks = 0;
  if (!grid_blocks) {
    int dev = 0, cus = 0, per_cu = 0;
    (void)hipGetDevice(&dev);
    (void)hipDeviceGetAttribute(&cus, hipDeviceAttributeMultiprocessorCount, dev);
    (void)hipFuncSetAttribute((const void*)mk, hipFuncAttributeMaxDynamicSharedMemorySize, LDS_BYTES);
    (void)hipOccupancyMaxActiveBlocksPerMultiprocessor(&per_cu, (const void*)mk, NTHREADS, LDS_BYTES);
    grid_blocks = cus;
    fprintf(stderr, "kernel_launch: cus=%d per_cu=%d grid=%d ws=%zu need=%zu\n", cus, per_cu, grid_blocks, ws_size, (size_t)WS_END);
  }
  if (ws_size < WS_END) { fprintf(stderr, "workspace too small\n"); return; }
  Params p{};
  for (int i = 0; i < 24; ++i) p.in[i] = (const float*)d_in[i];
  p.out = (float*)d_out; p.ws = (unsigned char*)d_ws; p.ph_lo = 0; p.ph_hi = NPHASE;
  void* args[] = {&p};
  hipError_t e = hipLaunchCooperativeKernel((const void*)mk, dim3(grid_blocks), dim3(NTHREADS), args, LDS_BYTES, stream);
  if (e != hipSuccess) fprintf(stderr, "cooperative launch failed: %s (grid %d)\n", hipGetErrorString(e), grid_blocks);
  if (PROBE_REP >= 0) {
    Params q = p;
    q.out = (float*)((unsigned char*)d_ws + WS_END); q.ph_lo = PROBE_REP; q.ph_hi = PROBE_REP + 1; q.pad = 1;
    void* args2[] = {&q};
    (void)hipLaunchCooperativeKernel((const void*)mk, dim3(grid_blocks), dim3(NTHREADS), args2, LDS_BYTES, stream);
  }
}
```

```cpp
#include <hip/hip_runtime.h>
#include <hip/hip_cooperative_groups.h>
#include <cstdio>
#include <cstdint>
namespace cg = cooperative_groups;

typedef unsigned short bf16_t;
typedef short bf16x8 __attribute__((ext_vector_type(8)));
typedef short s16x4 __attribute__((ext_vector_type(4)));
typedef float f32x16 __attribute__((ext_vector_type(16)));
typedef float f32x4 __attribute__((ext_vector_type(4)));
typedef float f32x2 __attribute__((ext_vector_type(2)));
typedef __bf16 bf2_t __attribute__((ext_vector_type(2)));
typedef unsigned u32x4 __attribute__((ext_vector_type(4)));
typedef unsigned u32x2 __attribute__((ext_vector_type(2)));
#define DI __device__ __forceinline__
#define MFMA32(a, b, c) __builtin_amdgcn_mfma_f32_32x32x16_bf16((a), (b), (c), 0, 0, 0)

struct Params { const float* in[24]; float* out; unsigned char* ws; int ph_lo, ph_hi; int wv, pad; };
#define TIDX (p.wv * 64 + (int)__builtin_amdgcn_mbcnt_hi(~0u, __builtin_amdgcn_mbcnt_lo(~0u, 0u)))
constexpr int LDS_BYTES = 148480;
constexpr int NTHREADS = 512;
constexpr int NPHASE = 10;
#ifndef PROBE_REP
#define PROBE_REP -1
#endif

constexpr int TP = 16384, TS = 1024, TT = 17408, DM = 1024;
constexpr int NCH = 272;
constexpr int PAST = 4096, SKV = 4160;
constexpr float EPS = 1e-6f;
constexpr float LOG2E = 1.4426950408889634f;
enum { I_XP = 0, I_XS, I_CK, I_CV, I_CMK, I_CMV, I_SC, I_SN, I_SM, I_MEMP, I_NG, I_FNG, I_MNG, I_WMKV, I_WINA, I_BGA, I_HGA, I_WOA,
       I_KVNG, I_WKV, I_WINB, I_LAMB, I_SUBG, I_WOB };
constexpr size_t O_Y = 0, O_PC = 17825792, O_PN = 18087936, O_PM = 18088960, O_PK = 18088964, O_PV = 34866180, O_PMK = 51643396,
                 O_PMV = 51905540, O_SC = 52167684, O_SN = 56361988, O_SM = 56378372, O_SK = 56378436, O_SV = 57427012;
constexpr size_t WS_CTR = 0;
constexpr size_t WS_KMAX = 1024;
constexpr size_t WS_TORD = 8192;
constexpr size_t WS_WA = 16384;
constexpr size_t WS_WOA = WS_WA + (size_t)6144 * 1024 * 2;
constexpr size_t WS_WKB = WS_WOA + (size_t)1024 * 1536 * 2;
constexpr size_t WS_WOB = WS_WKB + (size_t)5120 * 1024 * 2;
constexpr size_t WS_WM = WS_WOB + (size_t)1024 * 1536 * 2;
constexpr size_t WS_MEMN = WS_WM + (size_t)2 * 1024 * 1024 * 2;
constexpr size_t WS_MEMK = WS_MEMN + (size_t)2 * 256 * 1024 * 2;
constexpr size_t WS_MEMVT = WS_MEMK + (size_t)2 * 17 * 256 * 512 * 2;
constexpr size_t WS_GATE = WS_MEMVT + (size_t)2 * 17 * 256 * 512 * 2;
constexpr size_t SZ_CH = (size_t)NCH * 4 * 64 * 4;
constexpr size_t WS_GC = WS_GATE + (size_t)TT * 8 * 4;
constexpr size_t WS_MT = WS_GC + SZ_CH;
constexpr size_t WS_WS = WS_MT + SZ_CH;
constexpr size_t WS_WI = WS_WS + SZ_CH;
constexpr size_t WS_AS = WS_WI + SZ_CH;
constexpr size_t WS_BT = WS_AS + SZ_CH;
constexpr size_t WS_DEC = WS_BT + SZ_CH;
constexpr size_t WS_DENI = WS_DEC + 8192;
constexpr size_t WS_DENA = WS_DENI + (size_t)TT * 4 * 4;
constexpr size_t WS_XN = WS_DENA + (size_t)TT * 4 * 4;
constexpr size_t WS_AO = WS_XN + (size_t)TT * 1024 * 2;
constexpr size_t WS_Y1 = WS_AO + (size_t)TT * 1536 * 2;
constexpr size_t WS_KT = WS_Y1 + (size_t)TT * 1024 * 4;
constexpr size_t WS_VTA = WS_KT + (size_t)NCH * 4 * 256 * 64 * 2;
constexpr size_t WS_R1 = WS_VTA + (size_t)NCH * 4 * 256 * 64 * 2;
constexpr size_t SZ_R1 = (size_t)TT * 6144 * 2;
constexpr size_t WS_PB = WS_R1;
constexpr size_t WS_KBP = WS_PB + (size_t)TT * 3072 * 2;
constexpr size_t WS_VTP = WS_KBP + (size_t)TP * 1024 * 2;
constexpr size_t WS_R2 = WS_R1 + SZ_R1;
constexpr size_t WS_HINTER = WS_R2;
constexpr size_t WS_HINTRA = WS_R2 + (size_t)TT * 1024 * 4;
constexpr size_t WS_KBS = WS_R2;
constexpr size_t WS_VTS = WS_KBS + (size_t)16 * SKV * 1024 * 2;
constexpr size_t WS_WVT = WS_VTS + (size_t)16 * SKV * 1024 * 2;
constexpr size_t WS_U = WS_WVT + (size_t)NCH * 4 * 288 * 64 * 2;
constexpr size_t WS_CFAC = WS_U + SZ_CH;
constexpr size_t WS_CLOCC = WS_CFAC + 8192;
constexpr size_t WS_PM = WS_CLOCC + (size_t)256 * 4 * 9 * 8 * 2 * 64 * 16;
constexpr size_t WS_CHS = WS_PM + SZ_CH;
constexpr size_t WS_LD = WS_CHS + 16384;
constexpr size_t WS_CLOC = WS_LD + 8192;
constexpr size_t WS_END = WS_CLOC + (size_t)16 * 36 * 8 * 64 * 16 * 4;
constexpr int GRP = 16;
static_assert(WS_VTP + (size_t)TP * 1024 * 2 <= WS_R2, "R1 overflow");

DI unsigned pk2(float lo, float hi) { f32x2 v = {lo, hi}; return __builtin_bit_cast(unsigned, __builtin_convertvector(v, bf2_t)); }
DI bf16_t f2bf(float x) { return (bf16_t)(pk2(x, 0.f) & 0xffffu); }
DI float bf2f(unsigned v16) { return __uint_as_float(v16 << 16); }
DI float bflo(unsigned u) { return __uint_as_float(u << 16); }
DI float bfhi(unsigned u) { return __uint_as_float(u & 0xffff0000u); }
DI float rbf(float x) { return bflo(pk2(x, 0.f) & 0xffffu); }
DI int crow(int i, int h) { return (i & 3) + 8 * (i >> 2) + 4 * h; }
DI float wave_sum(float v) {
#pragma unroll
  for (int o = 32; o >= 1; o >>= 1) v += __shfl_xor(v, o);
  return v;
}
DI float fexp2(float x) { return __builtin_amdgcn_exp2f(x); }
DI float fexp(float x) { return __builtin_amdgcn_exp2f(x * LOG2E); }
DI float sigmoidf_(float x) { return 1.f / (1.f + __expf(-x)); }
DI float siluf_(float x) { return x / (1.f + __expf(-x)); }
DI bf16x8 pack_acc(const f32x16& x, int s) {
  u32x4 p;
  p[0] = pk2(x[8 * s + 0], x[8 * s + 1]); p[1] = pk2(x[8 * s + 2], x[8 * s + 3]);
  p[2] = pk2(x[8 * s + 4], x[8 * s + 5]); p[3] = pk2(x[8 * s + 6], x[8 * s + 7]);
  return __builtin_bit_cast(bf16x8, p);
}
DI bf16x8 ld16(const void* p) { return *(const bf16x8*)p; }
DI bf16x8 ld8x2(const void* p0, const void* p1) {
  u32x2 a = *(const u32x2*)p0, b = *(const u32x2*)p1; u32x4 r = {a[0], a[1], b[0], b[1]};
  return __builtin_bit_cast(bf16x8, r);
}
DI f32x16 zero16() { f32x16 z; for (int i = 0; i < 16; ++i) z[i] = 0.f; return z; }

DI void transpose_tile(const float* __restrict__ src, size_t ld_s, bf16_t* __restrict__ dst, size_t ld_d, const float* __restrict__ scale,
                       float* scr, int t, bool perm = false) {
  {
    const int c4 = t & 31, rb = t >> 5;
    f32x4 v[4];
#pragma unroll
    for (int i = 0; i < 4; ++i) v[i] = *(const f32x4*)(src + (size_t)(rb + 16 * i) * ld_s + 4 * c4);
#pragma unroll
    for (int i = 0; i < 4; ++i) {
      const int r = rb + 16 * i;
      f32x4 x = v[i];
      if (scale) { const float sc = scale[r]; x = x * sc; }
      float* d = scr + r * 129 + 4 * c4; d[0] = x[0]; d[1] = x[1]; d[2] = x[2]; d[3] = x[3];
    }
  }
  __syncthreads();
#pragma unroll
  for (int i = 0; i < 2; ++i) {
    const int id = t + 512 * i, c = id >> 3, rg = id & 7;
    const float* s = scr + (8 * rg) * 129 + c;
    u32x4 o; o[0] = pk2(s[0], s[129]); o[1] = pk2(s[2 * 129], s[3 * 129]); o[2] = pk2(s[4 * 129], s[5 * 129]); o[3] = pk2(s[6 * 129], s[7 * 129]);
    if (!perm) *(u32x4*)(dst + (size_t)c * ld_d + 8 * rg) = o;
    else {
      bf16_t* d = dst + (size_t)c * ld_d + 16 * (rg >> 1) + 4 * (rg & 1);
      u32x2 lo = {o[0], o[1]}, hi = {o[2], o[3]};
      *(u32x2*)d = lo; *(u32x2*)(d + 8) = hi;
    }
  }
  __syncthreads();
}

struct TJob { const float* src; size_t ld_s; bf16_t* dst; size_t ld_d; const float* scale; int tr, tc; };

DI void run_tjob_tile(const TJob& j, int tile, float* scr, int tid, bool perm = false) {
  const int ir = tile / j.tc, ic = tile % j.tc;
  transpose_tile(j.src + (size_t)(64 * ir) * j.ld_s + 128 * ic, j.ld_s, j.dst + (size_t)(128 * ic) * j.ld_d + 64 * ir, j.ld_d,
                 j.scale ? j.scale + 64 * ir : nullptr, scr, tid, perm);
}

DI float row_load_rstd(const float* xrow, f32x4 (&v)[4], int lane) {
  float ss = 0.f;
#pragma unroll
  for (int j = 0; j < 4; ++j) { v[j] = *(const f32x4*)(xrow + 4 * lane + 256 * j); ss += v[j][0] * v[j][0] + v[j][1] * v[j][1] + v[j][2] * v[j][2] + v[j][3] * v[j][3]; }
  ss = wave_sum(ss);
  return __builtin_amdgcn_rsqf(ss * (1.f / 1024.f) + EPS);
}

DI int diff_window(int hd) { const float sl2 = exp2f(-(float)(hd + 1)) * LOG2E; return (int)floorf((63.f + 192.f / sl2) * (1.f / 64.f)); }
DI int diff_est(int a) {
  const int hd = a & 7;
  const int w = diff_window(hd) + (a < 1024 ? 2 : 1);
  const int n = a < 1024 ? 2 * (a >> 3) + 2 : 65;
  return n < w ? n : w;
}

DI void phase0(const Params& p, unsigned char* lds) {
  const int tid = TIDX, lane = tid & 63, wid = tid >> 6;
  unsigned char* ws = p.ws;
  if (blockIdx.x == 0 && tid < 64) ((unsigned*)(ws + WS_CTR))[tid] = 0u;
  if (blockIdx.x == 0 && tid < 272) ((unsigned*)(ws + WS_KMAX))[tid] = 0u;
  if (blockIdx.x == 1) {
    int* est = (int*)lds;
    for (int a = tid; a < 1152; a += NTHREADS) est[a] = diff_est(a);
    __syncthreads();
    for (int a = tid; a < 1152; a += NTHREADS) {
      const int ea = est[a];
      int rank = 0;
      for (int b = 0; b < 1152; ++b) { const int eb = est[b]; rank += (eb > ea) || (eb == ea && b < a); }
      ((int*)(ws + WS_TORD))[rank] = a;
    }
    __syncthreads();
  }
  {
    TJob jobs[8];
    jobs[0] = {p.in[I_WINA], 6152, (bf16_t*)(ws + WS_WA), 1024, p.in[I_NG], 16, 40};
    jobs[1] = {p.in[I_WINA] + 5128, 6152, (bf16_t*)(ws + WS_WA) + (size_t)5120 * 1024, 1024, p.in[I_NG], 16, 8};
    jobs[2] = {p.in[I_WOA], 1024, (bf16_t*)(ws + WS_WOA), 1536, nullptr, 24, 8};
    jobs[3] = {p.in[I_WKV], 2048, (bf16_t*)(ws + WS_WKB), 1024, p.in[I_KVNG], 16, 16};
    jobs[4] = {p.in[I_WINB], 3072, (bf16_t*)(ws + WS_WKB) + (size_t)2048 * 1024, 1024, p.in[I_NG] + 1024, 16, 24};
    jobs[5] = {p.in[I_WOB], 1024, (bf16_t*)(ws + WS_WOB), 1536, nullptr, 24, 8};
    jobs[6] = {p.in[I_WMKV], 1024, (bf16_t*)(ws + WS_WM), 1024, nullptr, 16, 8};
    jobs[7] = {p.in[I_WMKV] + (size_t)1024 * 1024, 1024, (bf16_t*)(ws + WS_WM) + (size_t)1024 * 1024, 1024, nullptr, 16, 8};
    int base = 0;
#pragma unroll
    for (int j = 0; j < 8; ++j) {
      if (j >= 2 && j <= 5) continue;
      const int n = jobs[j].tr * jobs[j].tc;
      for (int t = blockIdx.x; t < n; t += gridDim.x) run_tjob_tile(jobs[j], t, (float*)lds, tid);
      base += n;
    }
    for (int t = blockIdx.x; t < 128 * 4; t += gridDim.x) {
      const int jb = t >> 2, tile = t & 3, l = jb >> 6, b = (jb >> 2) & 15, h = jb & 3;
      TJob j = {p.in[I_CMV] + ((size_t)(l * 16 + b) * 256) * 512 + h * 128, 512,
                (bf16_t*)(ws + WS_MEMVT) + ((size_t)(l * 17 + 1 + b) * 4 + h) * 128 * 256, 256, nullptr, 4, 1};
      run_tjob_tile(j, tile, (float*)lds, tid, true);
    }
  }
  {
    const size_t n8 = (size_t)2 * 16 * 256 * 512 / 8;
    for (size_t i = (size_t)blockIdx.x * NTHREADS + tid; i < n8; i += (size_t)gridDim.x * NTHREADS) {
      const size_t e = i * 8; const int l = (int)(e / ((size_t)16 * 131072)); const size_t rem = e - (size_t)l * 16 * 131072;
      const f32x4 a = *(const f32x4*)(p.in[I_CMK] + e), b = *(const f32x4*)(p.in[I_CMK] + e + 4);
      u32x4 o = {pk2(a[0], a[1]), pk2(a[2], a[3]), pk2(b[0], b[1]), pk2(b[2], b[3])};
      *(u32x4*)((bf16_t*)(ws + WS_MEMK) + ((size_t)(l * 17 + 1) * 131072) + rem) = o;
    }
  }
  {
    const int gw = blockIdx.x * 8 + wid, nw = gridDim.x * 8;
    const float* ng = p.in[I_NG];
    float* gwt = (float*)(lds + 32768);
    float* sg = (float*)(lds + 32768 + 36864);
    __syncthreads();
    for (int i = tid; i < 8192; i += NTHREADS) { const int k = i >> 3, c = i & 7; gwt[k * 8 + (k >> 2) * 4 + c] = p.in[I_WINA][(size_t)k * 6152 + 5120 + c] * ng[k]; }
    __syncthreads();
    for (int cc = blockIdx.x; cc < NCH; cc += gridDim.x) {
      f32x4 vn[4];
      {
        const int r0 = cc * 64 + wid * 8;
        const float* x0 = r0 < TP ? p.in[I_XP] + (size_t)r0 * 1024 : p.in[I_XS] + (size_t)(r0 - TP) * 1024;
#pragma unroll
        for (int j = 0; j < 4; ++j) vn[j] = *(const f32x4*)(x0 + 4 * lane + 256 * j);
      }
      for (int ri = 0; ri < 8; ++ri) {
        const int r = cc * 64 + wid * 8 + ri;
        f32x4 v[4];
#pragma unroll
        for (int j = 0; j < 4; ++j) v[j] = vn[j];
        if (ri + 1 < 8) {
          const float* x1 = (r + 1) < TP ? p.in[I_XP] + (size_t)(r + 1) * 1024 : p.in[I_XS] + (size_t)(r + 1 - TP) * 1024;
#pragma unroll
          for (int j = 0; j < 4; ++j) vn[j] = *(const f32x4*)(x1 + 4 * lane + 256 * j);
        }
        float ssq = 0.f;
#pragma unroll
        for (int j = 0; j < 4; ++j) ssq += v[j][0] * v[j][0] + v[j][1] * v[j][1] + v[j][2] * v[j][2] + v[j][3] * v[j][3];
        const float rstd = __builtin_amdgcn_rsqf(wave_sum(ssq) * (1.f / 1024.f) + EPS);
        float gacc[8];
#pragma unroll
        for (int c = 0; c < 8; ++c) gacc[c] = 0.f;
        bf16_t* xn = (bf16_t*)(ws + WS_XN) + (size_t)r * 1024;
#pragma unroll
        for (int j = 0; j < 4; ++j) {
          const int k0 = 4 * lane + 256 * j;
          const f32x4 xs = v[j] * rstd;
          u32x2 o = {pk2(xs[0], xs[1]), pk2(xs[2], xs[3])};
          *(u32x2*)(xn + k0) = o;
#pragma unroll
          for (int e = 0; e < 4; ++e) {
            const float* wr = gwt + (k0 + e) * 8 + (k0 >> 2) * 4;
            const f32x4 w0 = *(const f32x4*)wr, w1 = *(const f32x4*)(wr + 4);
            gacc[0] += xs[e] * w0[0]; gacc[1] += xs[e] * w0[1]; gacc[2] += xs[e] * w0[2]; gacc[3] += xs[e] * w0[3];
            gacc[4] += xs[e] * w1[0]; gacc[5] += xs[e] * w1[1]; gacc[6] += xs[e] * w1[2]; gacc[7] += xs[e] * w1[3];
          }
        }
#pragma unroll
        for (int c = 0; c < 8; ++c) gacc[c] = wave_sum(gacc[c]);
        if (lane < 8) {
          float gv = gacc[0];
#pragma unroll
          for (int c = 1; c < 8; ++c) gv = lane == c ? gacc[c] : gv;
          gv += p.in[I_BGA][lane];
          if (lane >= 4) gv = fminf(gv, 0.f) - log1pf(__expf(-fabsf(gv)));
          sg[(wid * 8 + ri) * 8 + lane] = gv;
        }
      }
      __syncthreads();
      if (wid < 4) {
        const int hd = wid, pr = cc * 4 + hd;
        const float ig = sg[lane * 8 + hd], lf = sg[lane * 8 + 4 + hd];
        float g = lf;
#pragma unroll
        for (int o = 1; o < 64; o <<= 1) { const float t = __shfl_up(g, o); if (lane >= o) g += t; }
        const float a = ig - g;
        float pm = a;
#pragma unroll
        for (int o = 1; o < 64; o <<= 1) { const float t = __shfl_up(pm, o); if (lane >= o) pm = fmaxf(pm, t); }
        const size_t o = (size_t)pr * 64 + lane;
        ((float*)(ws + WS_GC))[o] = g;
        ((float*)(ws + WS_AS))[o] = a;
        ((float*)(ws + WS_PM))[o] = pm;
        if (lane == 63) { ((float*)(ws + WS_CHS))[pr * 2] = g; ((float*)(ws + WS_CHS))[pr * 2 + 1] = pm; }
        const float u = __expf(a - __shfl(pm, 63));
        ((float*)(ws + WS_U))[o] = u;
        bf16_t* wr = (bf16_t*)(ws + WS_WVT) + ((size_t)pr * 288 + 256) * 64 + lane;
        wr[0] = f2bf(u);
#pragma unroll 4
        for (int rr = 1; rr < 32; ++rr) wr[rr * 64] = 0;
      }
      __syncthreads();
    }
    for (int r = gw; r < 512; r += nw) {
      const int l = r >> 8, rr = r & 255;
      f32x4 v[4];
      const float rstd = row_load_rstd(p.in[I_MEMP] + (size_t)rr * 1024, v, lane);
      bf16_t* o = (bf16_t*)(ws + WS_MEMN) + (size_t)r * 1024;
#pragma unroll
      for (int j = 0; j < 4; ++j) {
        const int k0 = 4 * lane + 256 * j;
        const f32x4 g = *(const f32x4*)(p.in[I_MNG] + l * 1024 + k0);
        const f32x4 xs = v[j] * rstd * g;
        u32x2 ov = {pk2(xs[0], xs[1]), pk2(xs[2], xs[3])};
        *(u32x2*)(o + k0) = ov;
      }
    }
  }
}

constexpr int G_STAGE = 49152;
struct GemmAcc { f32x16 a[2][2]; };
DI void dma16(const void* g, unsigned char* l) { __builtin_amdgcn_global_load_lds((const unsigned*)g, (unsigned*)l, 16, 0, 0); }

template <int NB = 2>
DI void gemm_tile(const bf16_t* __restrict__ A, size_t lda, const bf16_t* __restrict__ Bt, size_t ldb, int K, unsigned char* lds, GemmAcc& acc, int tid) {
  const int lane = tid & 63, wid = __builtin_amdgcn_readfirstlane(tid >> 6), r = lane & 31, h = lane >> 5;
  const int wr = wid >> 1, wc = wid & 1;
#pragma unroll
  for (int a = 0; a < 2; ++a)
#pragma unroll
    for (int b = 0; b < 2; ++b) acc.a[a][b] = zero16();
  const int nk = K / 64;
  unsigned aoff[4], boff[2];
#pragma unroll
  for (int e = 0; e < 4; ++e) { const int row = 8 * (wid * 4 + e) + (lane >> 3), lc = (lane & 7) ^ ((row >> 1) & 7); aoff[e] = (unsigned)row * (unsigned)lda + 8u * lc; }
#pragma unroll
  for (int e = 0; e < NB; ++e) { const int row = 8 * (wid * NB + e) + (lane >> 3), lc = (lane & 7) ^ ((row >> 1) & 7); boff[e] = (unsigned)row * (unsigned)ldb + 8u * lc; }
  auto issue = [&](int kt, int buf) {
    unsigned char* base = lds + buf * G_STAGE;
#pragma unroll
    for (int e = 0; e < 4; ++e) dma16(A + (aoff[e] + 64u * kt), base + (wid * 4 + e) * 1024);
#pragma unroll
    for (int e = 0; e < NB; ++e) dma16(Bt + (boff[e] + 64u * kt), base + 32768 + (wid * NB + e) * 1024);
  };
  asm volatile("s_waitcnt vmcnt(0)" ::: "memory");
  __syncthreads();
  issue(0, 0);
  if (nk > 1) issue(1, 1);
  const unsigned sw = (r >> 1) & 7;
  unsigned co[4];
#pragma unroll
  for (int kk = 0; kk < 4; ++kk) co[kk] = (((2 * kk + h) ^ sw) << 4);
  const unsigned ra = (wr * 64 + r) * 128, rb = 32768 + (wc * 32 * NB + r) * 128;
  for (int kt = 0; kt < nk; ++kt) {
    if (kt + 1 < nk) { if (NB == 2) asm volatile("s_waitcnt vmcnt(6)" ::: "memory"); else asm volatile("s_waitcnt vmcnt(5)" ::: "memory"); }
    else asm volatile("s_waitcnt vmcnt(0)" ::: "memory");
    asm volatile("s_waitcnt lgkmcnt(0)" ::: "memory");
    __builtin_amdgcn_s_barrier();
    if (kt + 2 < nk) issue(kt + 2, (kt + 2) % 3);
    const unsigned char* base = lds + (kt % 3) * G_STAGE;
    const unsigned char* pa = base + ra;
    const unsigned char* pb = base + rb;
#pragma unroll
    for (int kk = 0; kk < 4; ++kk) {
      const bf16x8 a0 = ld16(pa + co[kk]), a1 = ld16(pa + 4096 + co[kk]);
      const bf16x8 b0 = ld16(pb + co[kk]);
      acc.a[0][0] = MFMA32(a0, b0, acc.a[0][0]);
      acc.a[1][0] = MFMA32(a1, b0, acc.a[1][0]);
      if (NB == 2) {
        const bf16x8 b1 = ld16(pb + 4096 + co[kk]);
        acc.a[0][1] = MFMA32(a0, b1, acc.a[0][1]);
        acc.a[1][1] = MFMA32(a1, b1, acc.a[1][1]);
      }
    }
    __builtin_amdgcn_sched_group_barrier(0x100, 2 + NB, 0);
    __builtin_amdgcn_sched_group_barrier(0x100, 2 + NB, 0); __builtin_amdgcn_sched_group_barrier(0x008, 2 * NB, 0);
    __builtin_amdgcn_sched_group_barrier(0x100, 2 + NB, 0); __builtin_amdgcn_sched_group_barrier(0x008, 2 * NB, 0);
    __builtin_amdgcn_sched_group_barrier(0x100, 2 + NB, 0); __builtin_amdgcn_sched_group_barrier(0x008, 2 * NB, 0);
    __builtin_amdgcn_sched_group_barrier(0x008, 2 * NB, 0);
  }
}

DI void gemm256(const bf16_t* __restrict__ A, size_t lda, const bf16_t* __restrict__ Bt, size_t ldb, int K, unsigned char* lds, GemmAcc (&acc)[2], int tid) {
  const int lane = tid & 63, wid = __builtin_amdgcn_readfirstlane(tid >> 6), r = lane & 31, h = lane >> 5;
  const int wr = wid >> 2, wc = wid & 3;
#pragma unroll
  for (int mh = 0; mh < 2; ++mh)
#pragma unroll
    for (int a = 0; a < 2; ++a)
#pragma unroll
      for (int b = 0; b < 2; ++b) acc[mh].a[a][b] = zero16();
  const int nk = K / 64;
  unsigned aoff[4], boff[4];
#pragma unroll
  for (int e = 0; e < 4; ++e) {
    const int row = 8 * (wid * 4 + e) + (lane >> 3), lc = (lane & 7) ^ ((row >> 1) & 7);
    aoff[e] = (unsigned)row * (unsigned)lda + 8u * lc; boff[e] = (unsigned)row * (unsigned)ldb + 8u * lc;
  }
  auto issue = [&](int kt, int buf) {
    unsigned char* base = lds + buf * 65536;
#pragma unroll
    for (int e = 0; e < 4; ++e) { dma16(A + (aoff[e] + 64u * kt), base + (wid * 4 + e) * 1024); dma16(Bt + (boff[e] + 64u * kt), base + 32768 + (wid * 4 + e) * 1024); }
  };
  asm volatile("s_waitcnt vmcnt(0)" ::: "memory");
  __syncthreads();
  issue(0, 0);
  const unsigned sw = (r >> 1) & 7;
  unsigned co[4];
#pragma unroll
  for (int kk = 0; kk < 4; ++kk) co[kk] = (((2 * kk + h) ^ sw) << 4);
  const unsigned ra = (wr * 128 + r) * 128, rb = 32768 + (wc * 64 + r) * 128;
  for (int kt = 0; kt < nk; ++kt) {
    asm volatile("s_waitcnt vmcnt(0)" ::: "memory");
    asm volatile("s_waitcnt lgkmcnt(0)" ::: "memory");
    __builtin_amdgcn_s_barrier();
    if (kt + 1 < nk) issue(kt + 1, (kt + 1) & 1);
    const unsigned char* base = lds + (kt & 1) * 65536;
    const unsigned char* pa = base + ra;
    const unsigned char* pb = base + rb;
#pragma unroll
    for (int kk = 0; kk < 4; ++kk) {
      const bf16x8 b0 = ld16(pb + co[kk]), b1 = ld16(pb + 4096 + co[kk]);
#pragma unroll
      for (int mh = 0; mh < 2; ++mh) {
        const bf16x8 a0 = ld16(pa + 8192 * mh + co[kk]), a1 = ld16(pa + 8192 * mh + 4096 + co[kk]);
        acc[mh].a[0][0] = MFMA32(a0, b0, acc[mh].a[0][0]);
        acc[mh].a[0][1] = MFMA32(a0, b1, acc[mh].a[0][1]);
        acc[mh].a[1][0] = MFMA32(a1, b0, acc[mh].a[1][0]);
        acc[mh].a[1][1] = MFMA32(a1, b1, acc[mh].a[1][1]);
      }
    }
#define SGB_R(N) __builtin_amdgcn_sched_group_barrier(0x100, N, 0)
#define SGB_M(N) __builtin_amdgcn_sched_group_barrier(0x008, N, 0)
    SGB_R(4);
    SGB_R(2); SGB_M(4); SGB_R(4); SGB_M(4);
    SGB_R(2); SGB_M(4); SGB_R(4); SGB_M(4);
    SGB_R(2); SGB_M(4); SGB_R(4); SGB_M(4);
    SGB_R(2); SGB_M(4); SGB_M(4);
  }
}

DI void gate_scan(const Params& p, unsigned char* lds) {
  const int tid = TIDX, lane = tid & 63, wid = tid >> 6;
  unsigned char* ws = p.ws;
  float* s_ch = (float*)lds;
  float* s_mc = s_ch + NCH * 8;
  float* s_mn = s_mc + NCH * 4;
  __syncthreads();
  for (int i = tid; i < NCH * 8; i += NTHREADS) s_ch[i] = ((const float*)(ws + WS_CHS))[i];
  __syncthreads();
  if (tid < 4) {
    float m = 0.f, ld = 0.f;
    float* LD = (float*)(ws + WS_LD);
    const bool wr = blockIdx.x == 0;
#pragma unroll 8
    for (int c = 0; c < 256; ++c) {
      s_mc[c * 4 + tid] = m; if (wr) LD[c * 4 + tid] = ld;
      const float gl = s_ch[(c * 4 + tid) * 2], mn = gl + fmaxf(m, s_ch[(c * 4 + tid) * 2 + 1]);
      ld += gl + m - mn;
      m = mn; s_mn[c * 4 + tid] = m;
    }
    if (wr) { LD[256 * 4 + tid] = ld; p.out[O_PM + tid] = m; }
  } else if (tid >= 64 && tid < 128) {
    const int b = (tid - 64) >> 2, hd = tid & 3, pr = (256 + b) * 4 + hd;
    const float m0 = p.in[I_SM][b * 4 + hd];
    const float m = s_ch[pr * 2] + fmaxf(m0, s_ch[pr * 2 + 1]);
    s_mc[pr] = m0; s_mn[pr] = m;
    if (blockIdx.x == 0) p.out[O_SM + b * 4 + hd] = m;
  }
  __syncthreads();
  for (int cc = blockIdx.x; cc < NCH; cc += gridDim.x) {
    if (wid < 4) {
      const int hd = wid, pr = cc * 4 + hd;
      const size_t o = (size_t)pr * 64 + lane;
      const float g = ((const float*)(ws + WS_GC))[o], a = ((const float*)(ws + WS_AS))[o], pm = ((const float*)(ws + WS_PM))[o];
      const float mc = s_mc[pr], mn = s_mn[pr], gl = s_ch[pr * 2];
      const float mt = g + fmaxf(mc, pm);
      ((float*)(ws + WS_MT))[o] = mt;
      ((float*)(ws + WS_WS))[o] = __expf(gl + a - mn);
      ((float*)(ws + WS_WI))[o] = __expf(g + mc - mt);
      ((float*)(ws + WS_AS))[o] = a * LOG2E;
      ((float*)(ws + WS_BT))[o] = (g - mt) * LOG2E;
      if (lane == 0) { ((float*)(ws + WS_DEC))[pr] = __expf(gl + mc - mn); const float amx = s_ch[pr * 2 + 1]; ((float*)(ws + WS_CFAC))[pr] = __expf(amx - fmaxf(mc, amx)); }
    }
  }
  __syncthreads();
}

DI void phase1(const Params& p, unsigned char* lds) {
  const int tid = TIDX, lane = tid & 63, wid = tid >> 6, r = lane & 31, h = lane >> 5;
  unsigned char* ws = p.ws;
  gate_scan(p, lds);
  const int n_main = 68 * 24, n_mem = 16;
  for (int t = blockIdx.x; t < n_main + n_mem; t += gridDim.x) {
    if (t < n_main) {
      const int tm = t / 24, tn = t % 24, m0 = tm * 256, n0 = tn * 256;
      GemmAcc acc2[2];
      gemm256((const bf16_t*)(ws + WS_XN) + (size_t)m0 * 1024, 1024, (const bf16_t*)(ws + WS_WA) + (size_t)n0 * 1024, 1024, 1024, lds, acc2, tid);
#pragma unroll
      for (int mh = 0; mh < 2; ++mh) {
      const GemmAcc& acc = acc2[mh];
      const int wr = (wid >> 2) * 2 + mh, wc = wid & 3;
      bf16_t* PA = (bf16_t*)(ws + WS_R1);
      const int sec = n0 >> 10;
#pragma unroll
      for (int a = 0; a < 2; ++a)
#pragma unroll
        for (int b = 0; b < 2; ++b) {
          __builtin_amdgcn_sched_barrier(0);
          const int n = n0 + wc * 64 + 32 * b + r, mb = m0 + wr * 64 + 32 * a;
          if (sec != 2) {
            const float sc = sec == 1 ? 0.0625f : 1.f;
            const int pc = (n >> 2) & 3, np = sec <= 1 ? (n & ~15) + 4 * (((pc & 1) << 1) | (pc >> 1)) + (n & 3) : n;
#pragma unroll
            for (int i = 0; i < 16; ++i) PA[(size_t)(mb + crow(i, h)) * 6144 + np] = f2bf(acc.a[a][b][i] * sc);
          }
          if (sec == 1 || sec == 2) {
            const float sc = sec == 1 ? 0.0625f : 1.f;
            const int f = n & 1023, hd = f >> 8, fe = f & 255;
            bf16_t* T = (bf16_t*)(ws + (sec == 1 ? WS_KT : WS_VTA));
#pragma unroll
            for (int g = 0; g < 4; ++g) {
              const int m = mb + 8 * g + 4 * h, cc = m >> 6, s = m & 63;
              u32x2 o = {pk2(acc.a[a][b][4 * g] * sc, acc.a[a][b][4 * g + 1] * sc), pk2(acc.a[a][b][4 * g + 2] * sc, acc.a[a][b][4 * g + 3] * sc)};
              *(u32x2*)(T + (((size_t)cc * 4 + hd) * 256 + fe) * 64 + s) = o;
              if (sec == 2) {
                const f32x4 u = *(const f32x4*)((const float*)(ws + WS_U) + ((size_t)cc * 4 + hd) * 64 + s);
                u32x2 ow = {pk2(acc.a[a][b][4 * g] * u[0], acc.a[a][b][4 * g + 1] * u[1]), pk2(acc.a[a][b][4 * g + 2] * u[2], acc.a[a][b][4 * g + 3] * u[3])};
                *(u32x2*)((bf16_t*)(ws + WS_WVT) + (((size_t)cc * 4 + hd) * 288 + fe) * 64 + s) = ow;
              }
            }
          }
        }
      }
    } else {
      GemmAcc acc;
      const int wr = wid >> 1, wc = wid & 1;
      const int tt = t - n_main, l = tt >> 3, n0 = (tt & 7) * 128;
      gemm_tile((const bf16_t*)(ws + WS_MEMN) + (size_t)l * 256 * 1024, 1024, (const bf16_t*)(ws + WS_WM) + ((size_t)l * 1024 + n0) * 1024, 1024, 1024, lds, acc, tid);
      const bool isv = n0 >= 512;
      float* of = p.out + (isv ? O_PMV : O_PMK) + (size_t)l * 131072;
      bf16_t* mk = (bf16_t*)(ws + WS_MEMK) + (size_t)(l * 17) * 131072;
      bf16_t* mv = (bf16_t*)(ws + WS_MEMVT) + (size_t)(l * 17) * 131072;
#pragma unroll
      for (int a = 0; a < 2; ++a)
#pragma unroll
        for (int b = 0; b < 2; ++b) {
          __builtin_amdgcn_sched_barrier(0);
          const int f = (n0 & 511) + wc * 64 + 32 * b + r, mb = wr * 64 + 32 * a;
#pragma unroll
          for (int g = 0; g < 4; ++g) {
            const int m = mb + 8 * g + 4 * h;
            float* o4 = of + (size_t)m * 512 + f;
            o4[0] = acc.a[a][b][4 * g]; o4[512] = acc.a[a][b][4 * g + 1]; o4[1024] = acc.a[a][b][4 * g + 2]; o4[1536] = acc.a[a][b][4 * g + 3];
            if (!isv) {
              bf16_t* k4 = mk + (size_t)m * 512 + f;
              k4[0] = f2bf(acc.a[a][b][4 * g]); k4[512] = f2bf(acc.a[a][b][4 * g + 1]); k4[1024] = f2bf(acc.a[a][b][4 * g + 2]); k4[1536] = f2bf(acc.a[a][b][4 * g + 3]);
            } else {
              u32x2 o = {pk2(acc.a[a][b][4 * g], acc.a[a][b][4 * g + 1]), pk2(acc.a[a][b][4 * g + 2], acc.a[a][b][4 * g + 3])};
              const int pq = (m >> 2) & 3, mp = (m & ~15) + 4 * (((pq & 1) << 1) | (pq >> 1));
              *(u32x2*)(mv + (size_t)f * 256 + mp) = o;
            }
          }
        }
    }
  }
}

DI void scan_task(const Params& p, unsigned char* lds, int sb  , int hd, int j, int grp) {
  const int tid = TIDX, lane = tid & 63, wid = tid >> 6, r = lane & 31, h = lane >> 5;
  unsigned char* ws = p.ws;
  const int cc0 = sb < 0 ? GRP * grp : 256 + sb, nch = sb < 0 ? GRP : 1;
  const bf16_t* PA = (const bf16_t*)(ws + WS_R1);
  const bf16_t* KT = (const bf16_t*)(ws + WS_KT);
  const bf16_t* VT = (const bf16_t*)(ws + WS_VTA);
  const float* WSa = (const float*)(ws + WS_WS);
  const float* WIa = (const float*)(ws + WS_WI);
  const float* DEC = (const float*)(ws + WS_DEC);
  float* red = (float*)lds;
  const bool nsl = j == 8;
  f32x16 S = zero16();
  if (sb >= 0) {
    if (!nsl) {
      const float* C0 = p.in[I_SC] + ((size_t)(sb * 4 + hd) * 256 + 32 * j + r) * 256 + 32 * wid;
#pragma unroll
      for (int g = 0; g < 4; ++g) { const f32x4 c = *(const f32x4*)(C0 + 8 * g + 4 * h); S[4 * g] = c[0]; S[4 * g + 1] = c[1]; S[4 * g + 2] = c[2]; S[4 * g + 3] = c[3]; }
    } else if (r == 0) {
      const float* n0 = p.in[I_SN] + (size_t)(sb * 4 + hd) * 256 + 32 * wid;
#pragma unroll
      for (int g = 0; g < 4; ++g) { const f32x4 c = *(const f32x4*)(n0 + 8 * g + 4 * h); S[4 * g] = c[0]; S[4 * g + 1] = c[1]; S[4 * g + 2] = c[2]; S[4 * g + 3] = c[3]; }
    }
  }
  bf16x8 kt[4], wv[4], qf[2][2];
  u32x4 ktn[4], vn[4], qn[2][2];
  float wsn;
  float* wsl = (float*)(lds + 69632);
  auto loadraw = [&](int cc) {
    const size_t ch = (size_t)cc * 4 + hd;
    const bf16_t* kp = KT + (ch * 256 + 32 * wid + r) * 64 + 8 * h;
#pragma unroll
    for (int st = 0; st < 4; ++st) ktn[st] = *(const u32x4*)(kp + 16 * st);
    wsn = WSa[ch * 64 + lane];
    if (!nsl) {
      const bf16_t* vp = VT + (ch * 256 + 32 * j + r) * 64 + 8 * h;
#pragma unroll
      for (int st = 0; st < 4; ++st) vn[st] = *(const u32x4*)(vp + 16 * st);
    }
#pragma unroll
    for (int tt = 0; tt < 2; ++tt) {
      const bf16_t* qp = PA + (size_t)(cc * 64 + 32 * tt + r) * 6144 + hd * 256 + 32 * wid + 8 * h;
#pragma unroll
      for (int s2 = 0; s2 < 2; ++s2) qn[tt][s2] = *(const u32x4*)(qp + 16 * s2);
    }
  };
  auto convert = [&]() {
    __syncthreads();
    if (wid == 0) wsl[lane] = wsn;
    __syncthreads();
#pragma unroll
    for (int st = 0; st < 4; ++st) {
      kt[st] = __builtin_bit_cast(bf16x8, ktn[st]);
      const f32x4 w0 = *(const f32x4*)(wsl + 16 * st + 8 * h), w1 = *(const f32x4*)(wsl + 16 * st + 8 * h + 4);
      u32x4 o;
      if (!nsl) {
        const u32x4 v = vn[st];
        o[0] = pk2(bflo(v[0]) * w0[0], bfhi(v[0]) * w0[1]); o[1] = pk2(bflo(v[1]) * w0[2], bfhi(v[1]) * w0[3]);
        o[2] = pk2(bflo(v[2]) * w1[0], bfhi(v[2]) * w1[1]); o[3] = pk2(bflo(v[3]) * w1[2], bfhi(v[3]) * w1[3]);
      } else {
        o = (u32x4){pk2(w0[0], w0[1]), pk2(w0[2], w0[3]), pk2(w1[0], w1[1]), pk2(w1[2], w1[3])};
        if (r != 0) o = (u32x4){0u, 0u, 0u, 0u};
      }
      wv[st] = __builtin_bit_cast(bf16x8, o);
    }
#pragma unroll
    for (int tt = 0; tt < 2; ++tt)
#pragma unroll
      for (int s2 = 0; s2 < 2; ++s2) qf[tt][s2] = __builtin_bit_cast(bf16x8, qn[tt][s2]);
  };
  loadraw(cc0);
  convert();
  for (int c = 0; c < nch; ++c) {
    const int cc = cc0 + c;
    if (c + 1 < nch) loadraw(cc + 1);
    const float dec = DEC[cc * 4 + hd];
    const bf16x8 xs0 = pack_acc(S, 0), xs1 = pack_acc(S, 1);
    f32x16 z0 = MFMA32(xs0, qf[0][0], zero16()); z0 = MFMA32(xs1, qf[0][1], z0);
    f32x16 z1 = MFMA32(xs0, qf[1][0], zero16()); z1 = MFMA32(xs1, qf[1][1], z1);
    S = S * dec;
#pragma unroll
    for (int st = 0; st < 4; ++st) S = MFMA32(kt[st], wv[st], S);
    __syncthreads();
    {
      float* rw = red + wid * (64 * 33);
#pragma unroll
      for (int i = 0; i < 16; ++i) { rw[r * 33 + crow(i, h)] = z0[i]; rw[(32 + r) * 33 + crow(i, h)] = z1[i]; }
    }
    __syncthreads();
    {
      const int v = tid & 31;
#pragma unroll
      for (int e = 0; e < 4; ++e) {
        const int t = (tid >> 5) + 16 * e;
        float s = 0.f;
#pragma unroll
        for (int w8 = 0; w8 < 8; ++w8) s += red[w8 * (64 * 33) + t * 33 + v];
        const float wi = WIa[((size_t)cc * 4 + hd) * 64 + t];
        if (!nsl) ((float*)(ws + WS_HINTER))[(size_t)(cc * 64 + t) * 1024 + hd * 256 + 32 * j + v] = s * wi;
        else if (v == 0) ((float*)(ws + WS_DENI))[(size_t)(cc * 64 + t) * 4 + hd] = s * wi;
      }
    }
    if (c + 1 < nch) convert();
  }
  if (sb < 0) {
    float* cl = (float*)(ws + WS_CLOC) + ((((size_t)(grp * 4 + hd) * 9 + j) * 8 + wid) * 64 + lane) * 16;
#pragma unroll
    for (int g = 0; g < 4; ++g) { f32x4 c = {S[4 * g], S[4 * g + 1], S[4 * g + 2], S[4 * g + 3]}; *(f32x4*)(cl + 4 * g) = c; }
  } else {
    if (!nsl) {
      float* Co = (sb < 0 ? p.out + O_PC + (size_t)hd * 65536 : p.out + O_SC + (size_t)(sb * 4 + hd) * 65536) + (size_t)(32 * j + r) * 256 + 32 * wid;
#pragma unroll
      for (int g = 0; g < 4; ++g) { f32x4 c = {S[4 * g], S[4 * g + 1], S[4 * g + 2], S[4 * g + 3]}; *(f32x4*)(Co + 8 * g + 4 * h) = c; }
    } else if (r == 0) {
      float* no = (sb < 0 ? p.out + O_PN + (size_t)hd * 256 : p.out + O_SN + (size_t)(sb * 4 + hd) * 256) + 32 * wid;
#pragma unroll
      for (int g = 0; g < 4; ++g) { f32x4 c = {S[4 * g], S[4 * g + 1], S[4 * g + 2], S[4 * g + 3]}; *(f32x4*)(no + 8 * g + 4 * h) = c; }
    }
  }
  __syncthreads();
}

DI void intra_task(const Params& p, int cc, int hd) {
  const int tid = TIDX, lane = tid & 63, wid = tid >> 6, r = lane & 31, h = lane >> 5;
  unsigned char* ws = p.ws;
  const int tt = wid & 1, vq = wid >> 1;
  const bf16_t* PA = (const bf16_t*)(ws + WS_R1);
  const bf16_t* VT = (const bf16_t*)(ws + WS_VTA);
  const size_t ch = (size_t)cc * 4 + hd;
  f32x16 s0 = zero16(), s1 = zero16();
  {
    const bf16_t* qp = PA + (size_t)(cc * 64 + 32 * tt + r) * 6144 + hd * 256 + 8 * h;
    const bf16_t* kp = PA + (size_t)(cc * 64 + r) * 6144 + 1024 + hd * 256 + 8 * h;
#pragma unroll 4
    for (int kk = 0; kk < 16; ++kk) {
      const bf16x8 q = ld16(qp + 16 * kk), k0 = ld16(kp + 16 * kk), k1 = ld16(kp + (size_t)32 * 6144 + 16 * kk);
      s0 = MFMA32(k0, q, s0);
      if (tt == 1) s1 = MFMA32(k1, q, s1);
    }
  }
  const int t = 32 * tt + r;
  const float bt = ((const float*)(ws + WS_BT))[ch * 64 + t];
  const float* asp = (const float*)(ws + WS_AS) + ch * 64;
  float den = 0.f;
#pragma unroll
  for (int g = 0; g < 4; ++g) {
    const f32x4 a0 = *(const f32x4*)(asp + 8 * g + 4 * h);
    const f32x4 a1 = *(const f32x4*)(asp + 32 + 8 * g + 4 * h);
#pragma unroll
    for (int e = 0; e < 4; ++e) {
      const int s = 8 * g + 4 * h + e;
      const float w0 = s <= t ? fexp2(bt + a0[e]) : 0.f;
      const float w1 = (32 + s) <= t ? fexp2(bt + a1[e]) : 0.f;
      s0[4 * g + e] *= w0; s1[4 * g + e] *= w1;
      den += s0[4 * g + e] + s1[4 * g + e];
    }
  }
  den += __shfl_xor(den, 32);
  if (vq == 0 && h == 0) ((float*)(ws + WS_DENA))[(size_t)(cc * 64 + t) * 4 + hd] = den;
  bf16x8 pf[2][2];
  pf[0][0] = pack_acc(s0, 0); pf[0][1] = pack_acc(s0, 1); pf[1][0] = pack_acc(s1, 0); pf[1][1] = pack_acc(s1, 1);
  float* Ho = (float*)(ws + WS_HINTRA) + (size_t)(cc * 64 + t) * 1024 + hd * 256;
#pragma unroll
  for (int vt = 0; vt < 2; ++vt) {
    const int v0 = vq * 64 + vt * 32;
    const bf16_t* vp = VT + (ch * 256 + v0 + r) * 64 + 4 * h;
    f32x16 o = zero16();
#pragma unroll
    for (int st = 0; st < 2; ++st)
#pragma unroll
      for (int s2 = 0; s2 < 2; ++s2) {
        const bf16x8 a = ld8x2(vp + 32 * st + 16 * s2, vp + 32 * st + 16 * s2 + 8);
        o = MFMA32(a, pf[st][s2], o);
      }
#pragma unroll
    for (int g = 0; g < 4; ++g) { f32x4 c = {o[4 * g], o[4 * g + 1], o[4 * g + 2], o[4 * g + 3]}; *(f32x4*)(Ho + v0 + 8 * g + 4 * h) = c; }
  }
}

DI void memattn_task(const Params& p, unsigned char* lds, int task, int layer, const bf16_t* Qb, const bf16_t* Zb, unsigned ldq) {
  const int tid = TIDX, lane = tid & 63, wid = __builtin_amdgcn_readfirstlane(tid >> 6), r = lane & 31, h = lane >> 5;
  unsigned char* ws = p.ws;
  const bool prm = task < 256;
  const int hd = task & 3, ti = prm ? task >> 2 : (task - 256) >> 2;
  const int sbi = prm ? 0 : 1 + ti, tok0 = prm ? ti * 256 : TP + ti * 64, nact = prm ? 8 : 2;
  const bf16_t* MK = (const bf16_t*)(ws + WS_MEMK) + (size_t)(layer * 17 + sbi) * 131072 + hd * 128;
  const bf16_t* MV = (const bf16_t*)(ws + WS_MEMVT) + ((size_t)(layer * 17 + sbi) * 4 + hd) * 128 * 256;
  asm volatile("s_waitcnt vmcnt(0)" ::: "memory");
  __syncthreads();
#pragma unroll
  for (int e = 0; e < 8; ++e) {
    const int q = wid * 8 + e;
    { const int row = 4 * q + (lane >> 4), lc = (lane & 15) ^ (row & 15); dma16(MK + ((unsigned)row * 512u + 8u * lc), lds + q * 1024); }
    { const int row = 2 * q + (lane >> 5), lc = (lane & 31) ^ (row & 15); dma16(MV + ((unsigned)row * 256u + 8u * lc), lds + 65536 + q * 1024); }
  }
  const int tok = tok0 + (wid < nact ? wid : 0) * 32 + r;
  bf16x8 qf[8];
  {
    const bf16_t* qp = Qb + ((unsigned)tok * ldq + hd * 128 + 8 * h);
#pragma unroll
    for (int kk = 0; kk < 8; ++kk) qf[kk] = ld16(qp + 16 * kk);
  }
  asm volatile("s_waitcnt vmcnt(0)" ::: "memory");
  __syncthreads();
  if (wid >= nact) return;
  const float sc = 0.08838834764831845f * LOG2E;
  f32x16 O[4];
#pragma unroll
  for (int vt = 0; vt < 4; ++vt) O[vt] = zero16();
  float mrun = -1e30f, l = 0.f;
  const unsigned sw = r & 15;
#pragma unroll 1
  for (int kb = 0; kb < 4; ++kb) {
    f32x16 s0 = zero16(), s1 = zero16();
    const unsigned char* kp = lds + (kb * 64 + r) * 256;
#pragma unroll
    for (int kk = 0; kk < 8; ++kk) {
      const unsigned co = ((unsigned)(2 * kk + h) ^ sw) << 4;
      const bf16x8 k0 = ld16(kp + co), k1 = ld16(kp + 8192 + co);
      s0 = MFMA32(k0, qf[kk], s0); s1 = MFMA32(k1, qf[kk], s1);
    }
    float mx = -1e30f;
#pragma unroll
    for (int i = 0; i < 16; ++i) mx = fmaxf(mx, fmaxf(s0[i], s1[i]));
    mx = fmaxf(mx, __shfl_xor(mx, 32)) * sc;
    const float mnew = fmaxf(mrun, mx), alpha = fexp2(mrun - mnew);
    mrun = mnew;
    float sum = 0.f;
#pragma unroll
    for (int i = 0; i < 16; ++i) { s0[i] = fexp2(s0[i] * sc - mnew); s1[i] = fexp2(s1[i] * sc - mnew); sum += s0[i] + s1[i]; }
    l = l * alpha + sum;
#pragma unroll
    for (int vt = 0; vt < 4; ++vt) O[vt] = O[vt] * alpha;
    bf16x8 pf[2][2];
    pf[0][0] = pack_acc(s0, 0); pf[0][1] = pack_acc(s0, 1); pf[1][0] = pack_acc(s1, 0); pf[1][1] = pack_acc(s1, 1);
#pragma unroll
    for (int vt = 0; vt < 4; ++vt) {
      const unsigned char* vp = lds + 65536 + (32 * vt + r) * 512;
#pragma unroll
      for (int st = 0; st < 2; ++st)
#pragma unroll
        for (int s2 = 0; s2 < 2; ++s2) {
          const unsigned co = ((unsigned)(8 * kb + 4 * st + 2 * s2 + h) ^ sw) << 4;
          O[vt] = MFMA32(ld16(vp + co), pf[st][s2], O[vt]);
        }
    }
  }
  l += __shfl_xor(l, 32);
  const float inv = 1.f / l;
  const bf16_t* zp = Zb + ((unsigned)tok * ldq + hd * 128);
  bf16_t* op = (bf16_t*)(ws + WS_AO) + ((unsigned)tok * 1536u + 1024 + hd * 128);
#pragma unroll
  for (int vt = 0; vt < 4; ++vt)
#pragma unroll
    for (int g = 0; g < 4; ++g) {
      const int v = 32 * vt + 8 * g + 4 * h;
      const u32x2 z = *(const u32x2*)(zp + v);
      const float o0 = O[vt][4 * g] * inv * siluf_(bflo(z[0])), o1 = O[vt][4 * g + 1] * inv * siluf_(bfhi(z[0]));
      const float o2 = O[vt][4 * g + 2] * inv * siluf_(bflo(z[1])), o3 = O[vt][4 * g + 3] * inv * siluf_(bfhi(z[1]));
      u32x2 o = {pk2(o0, o1), pk2(o2, o3)};
      *(u32x2*)(op + v) = o;
    }
}

DI int next_item(unsigned* ctr, unsigned char* lds_flag_area, int tid) {
  __syncthreads();
  int* sh = (int*)lds_flag_area;
  if (tid == 0) *sh = (int)atomicAdd(ctr, 1u);
  __syncthreads();
  const int v = *sh;
  return v;
}

DI void scanA_task(const Params& p, int hd, int j, int grp);

DI void late_weight_item(const Params& p, unsigned char* lds, int it) {
  unsigned char* ws = p.ws;
  TJob j; int t = it;
  if (t < 192) j = {p.in[I_WOA], 1024, (bf16_t*)(ws + WS_WOA), 1536, nullptr, 24, 8};
  else if (t < 448) { t -= 192; j = {p.in[I_WKV], 2048, (bf16_t*)(ws + WS_WKB), 1024, p.in[I_KVNG], 16, 16}; }
  else if (t < 832) { t -= 448; j = {p.in[I_WINB], 3072, (bf16_t*)(ws + WS_WKB) + (size_t)2048 * 1024, 1024, p.in[I_NG] + 1024, 16, 24}; }
  else { t -= 832; j = {p.in[I_WOB], 1024, (bf16_t*)(ws + WS_WOB), 1536, nullptr, 24, 8}; }
  run_tjob_tile(j, t, (float*)lds, TIDX);
}

DI void phase2(const Params& p, unsigned char* lds) {
  unsigned* ctr = (unsigned*)(p.ws + WS_CTR) + 0 + 8 * p.pad;
  const bf16_t* PA = (const bf16_t*)(p.ws + WS_R1);
  const int n_ps = 36 * 16, n_ss = 576, n_in = NCH * 4, n_ma = 256 + 64;
  for (;;) {
    const int it = next_item(ctr, lds + LDS_BYTES - 16, TIDX);
    if (it >= n_ps + n_ss + n_in + n_ma + 1024) break;
    if (it >= n_ps + n_ss + n_in + n_ma) { late_weight_item(p, lds, it - (n_ps + n_ss + n_in + n_ma)); continue; }
    if (it < n_ps) scanA_task(p, (it % 36) / 9, it % 9, it / 36);
    else if (it < n_ps + n_ss) { const int q = it - n_ps; scan_task(p, lds, q / 36, (q % 36) / 9, q % 9, 0); }
    else if (it < n_ps + n_ss + n_in) { const int q = it - n_ps - n_ss; intra_task(p, q >> 2, q & 3); }
    else { const int q = it - n_ps - n_ss - n_in; memattn_task(p, lds, q, 0, PA + 5120, PA + 5632, 6144); }
  }
}


DI void scanA_task(const Params& p, int hd, int j, int grp) {
  const int tid = TIDX, lane = tid & 63, wid = tid >> 6, r = lane & 31, h = lane >> 5;
  unsigned char* ws = p.ws;
  const bf16_t* KT = (const bf16_t*)(ws + WS_KT);
  const bf16_t* WV = (const bf16_t*)(ws + WS_WVT);
  f32x16 S = zero16();
  u32x4 kn[4], vn[4];
  auto load = [&](int cc) {
    const size_t ch = (size_t)cc * 4 + hd;
    const bf16_t* kp = KT + (ch * 256 + 32 * wid + r) * 64 + 8 * h;
    const bf16_t* vp = WV + (ch * 288 + 32 * j + r) * 64 + 8 * h;
#pragma unroll
    for (int st = 0; st < 4; ++st) { kn[st] = *(const u32x4*)(kp + 16 * st); vn[st] = *(const u32x4*)(vp + 16 * st); }
  };
  load(GRP * grp);
#pragma unroll 1
  for (int c = 0; c < GRP; ++c) {
    const int cc = GRP * grp + c;
    bf16x8 kt[4], wv[4];
#pragma unroll
    for (int st = 0; st < 4; ++st) { kt[st] = __builtin_bit_cast(bf16x8, kn[st]); wv[st] = __builtin_bit_cast(bf16x8, vn[st]); }
    if (c + 1 < GRP) load(cc + 1);
    u32x4* cl = (u32x4*)(ws + WS_CLOCC) + ((((size_t)cc * 4 + hd) * 9 + j) * 8 + wid) * 128 + lane;
    cl[0] = __builtin_bit_cast(u32x4, pack_acc(S, 0));
    cl[64] = __builtin_bit_cast(u32x4, pack_acc(S, 1));
    f32x16 D = zero16();
#pragma unroll
    for (int st = 0; st < 4; ++st) D = MFMA32(kt[st], wv[st], D);
    const float dec = ((const float*)(ws + WS_DEC))[cc * 4 + hd], cf = ((const float*)(ws + WS_CFAC))[cc * 4 + hd];
    S = S * dec + D * cf;
  }
  float* cl = (float*)(ws + WS_CLOC) + ((((size_t)(grp * 4 + hd) * 9 + j) * 8 + wid) * 64 + lane) * 16;
#pragma unroll
  for (int g = 0; g < 4; ++g) { f32x4 c = {S[4 * g], S[4 * g + 1], S[4 * g + 2], S[4 * g + 3]}; *(f32x4*)(cl + 4 * g) = c; }
}

DI void scanfix_task(const Params& p, unsigned char* lds, int grp, int hd, int j) {
  const int tid = TIDX, lane = tid & 63, wid = tid >> 6, r = lane & 31, h = lane >> 5;
  unsigned char* ws = p.ws;
  const bool nsl = j == 8;
  const float* LD = (const float*)(ws + WS_LD);
  f32x16 S = zero16();
#pragma unroll 4
  for (int gp = 0; gp < grp; ++gp) {
    const float dg = __expf(LD[(GRP * (gp + 1)) * 4 + hd] - LD[(GRP * gp) * 4 + hd]);
    const float* cl = (const float*)(ws + WS_CLOC) + ((((size_t)(gp * 4 + hd) * 9 + j) * 8 + wid) * 64 + lane) * 16;
#pragma unroll
    for (int g = 0; g < 4; ++g) { const f32x4 c = *(const f32x4*)(cl + 4 * g);
      S[4 * g] = S[4 * g] * dg + c[0]; S[4 * g + 1] = S[4 * g + 1] * dg + c[1]; S[4 * g + 2] = S[4 * g + 2] * dg + c[2]; S[4 * g + 3] = S[4 * g + 3] * dg + c[3]; }
  }
  if (grp == 16) {
    if (!nsl) {
      float* Co = p.out + O_PC + (size_t)hd * 65536 + (size_t)(32 * j + r) * 256 + 32 * wid;
#pragma unroll
      for (int g = 0; g < 4; ++g) { f32x4 c = {S[4 * g], S[4 * g + 1], S[4 * g + 2], S[4 * g + 3]}; *(f32x4*)(Co + 8 * g + 4 * h) = c; }
    } else if (r == 0) {
      float* no = p.out + O_PN + (size_t)hd * 256 + 32 * wid;
#pragma unroll
      for (int g = 0; g < 4; ++g) { f32x4 c = {S[4 * g], S[4 * g + 1], S[4 * g + 2], S[4 * g + 3]}; *(f32x4*)(no + 8 * g + 4 * h) = c; }
    }
    return;
  }
  u32x4* fr = (u32x4*)lds;
  float* tp = (float*)(lds + 16384) + wid * (64 * 33);
  __syncthreads();
  fr[(wid * 2 + 0) * 64 + lane] = __builtin_bit_cast(u32x4, pack_acc(S, 0));
  fr[(wid * 2 + 1) * 64 + lane] = __builtin_bit_cast(u32x4, pack_acc(S, 1));
  __syncthreads();
  const bf16_t* PA = (const bf16_t*)(ws + WS_R1);
  const float* WIa = (const float*)(ws + WS_WI);
  const bool hasg = grp > 0;
#pragma unroll
  for (int ci = 0; ci < 2; ++ci) {
    const int cc = GRP * grp + wid + 8 * ci;
    const float D = __expf(LD[cc * 4 + hd] - LD[(GRP * grp) * 4 + hd]);
    const u32x4* clc = (const u32x4*)(ws + WS_CLOCC) + (((size_t)cc * 4 + hd) * 9 + j) * 8 * 128 + lane;
#pragma unroll
    for (int tt = 0; tt < 2; ++tt) {
      const bf16_t* qp = PA + (size_t)(cc * 64 + 32 * tt + r) * 6144 + hd * 256 + 8 * h;
      f32x16 z = zero16(), z2 = zero16();
#pragma unroll
      for (int kt = 0; kt < 8; ++kt)
#pragma unroll
        for (int s2 = 0; s2 < 2; ++s2) {
          const bf16x8 q = ld16(qp + 32 * kt + 16 * s2);
          z = MFMA32(__builtin_bit_cast(bf16x8, clc[(kt * 2 + s2) * 64]), q, z);
          if (hasg) z2 = MFMA32(__builtin_bit_cast(bf16x8, fr[(kt * 2 + s2) * 64 + lane]), q, z2);
        }
#pragma unroll
      for (int i = 0; i < 16; ++i) tp[(32 * tt + r) * 33 + crow(i, h)] = z[i] + D * z2[i];
    }
    const int v = lane & 31;
#pragma unroll 4
    for (int e = 0; e < 32; ++e) {
      const int t = 2 * e + (lane >> 5);
      const float val = tp[t * 33 + v] * WIa[((size_t)cc * 4 + hd) * 64 + t];
      if (!nsl) ((float*)(ws + WS_HINTER))[(size_t)(cc * 64 + t) * 1024 + hd * 256 + 32 * j + v] = val;
      else if (v == 0) ((float*)(ws + WS_DENI))[(size_t)(cc * 64 + t) * 4 + hd] = val;
    }
  }
}

DI void phase2c(const Params& p, unsigned char* lds) {
  unsigned* ctr = (unsigned*)(p.ws + WS_CTR) + 3 + 8 * p.pad;
  for (;;) {
    const int it = next_item(ctr, lds + LDS_BYTES - 16, TIDX);
    if (it >= 17 * 36) break;
    const int g = 16 - it / 36;
    scanfix_task(p, lds, g, (it % 36) / 9, it % 9);
  }
}

DI void phase3(const Params& p) {
  const int tid = TIDX, lane = tid & 63, wid = tid >> 6;
  unsigned char* ws = p.ws;
  const int gw = blockIdx.x * 8 + wid, nw = gridDim.x * 8;
  const bf16_t* PA = (const bf16_t*)(ws + WS_R1);
  for (int it = gw; it < TT * 4; it += nw) {
    const int tok = it >> 2, hd = it & 3, cc = tok >> 6, t = tok & 63;
    const size_t off = (size_t)tok * 1024 + hd * 256 + 4 * lane;
    const f32x4 a = *(const f32x4*)((const float*)(ws + WS_HINTER) + off), b = *(const f32x4*)((const float*)(ws + WS_HINTRA) + off);
    const float den = ((const float*)(ws + WS_DENI))[tok * 4 + hd] + ((const float*)(ws + WS_DENA))[tok * 4 + hd];
    const float mt = ((const float*)(ws + WS_MT))[((size_t)cc * 4 + hd) * 64 + t];
    const float dn = 1.f / fmaxf(fabsf(den), __expf(-mt));
    const u32x2 ou = *(const u32x2*)(PA + (size_t)tok * 6144 + 3072 + hd * 256 + 4 * lane);
    const u32x2 zu = *(const u32x2*)(PA + (size_t)tok * 6144 + 4096 + hd * 256 + 4 * lane);
    f32x4 hv = (a + b) * dn;
    hv[0] *= sigmoidf_(bflo(ou[0])); hv[1] *= sigmoidf_(bfhi(ou[0])); hv[2] *= sigmoidf_(bflo(ou[1])); hv[3] *= sigmoidf_(bfhi(ou[1]));
    float ss = hv[0] * hv[0] + hv[1] * hv[1] + hv[2] * hv[2] + hv[3] * hv[3];
    ss = wave_sum(ss);
    const float rstd = __builtin_amdgcn_rsqf(ss * (1.f / 256.f) + EPS);
    const f32x4 hg = *(const f32x4*)(p.in[I_HGA] + hd * 256 + 4 * lane);
    hv = hv * rstd * hg;
    hv[0] *= siluf_(bflo(zu[0])); hv[1] *= siluf_(bfhi(zu[0])); hv[2] *= siluf_(bflo(zu[1])); hv[3] *= siluf_(bfhi(zu[1]));
    u32x2 o = {pk2(hv[0], hv[1]), pk2(hv[2], hv[3])};
    *(u32x2*)((bf16_t*)(ws + WS_AO) + (size_t)tok * 1536 + hd * 256 + 4 * lane) = o;
  }
}

DI void cacheconv_item(const Params& p, unsigned char* lds, int it);

DI void phase_outproj(const Params& p, unsigned char* lds, int layer) {
  const int tid = TIDX, lane = tid & 63, wid = tid >> 6, r = lane & 31, h = lane >> 5, wr = wid >> 1, wc = wid & 1;
  unsigned char* ws = p.ws;
  const bf16_t* W = (const bf16_t*)(ws + (layer == 0 ? WS_WOA : WS_WOB));
  for (int t = blockIdx.x; t < 512 + 64; t += gridDim.x) {
    GemmAcc acc;
    int m0, n0, nb;
    if (t < 512) {
      m0 = (t >> 3) * 256; n0 = (t & 7) * 128; nb = 2;
      gemm_tile<2>((const bf16_t*)(ws + WS_AO) + (size_t)m0 * 1536, 1536, W + (size_t)n0 * 1536, 1536, 1536, lds, acc, tid);
    } else {
      const int q = t - 512;
      m0 = (64 + (q >> 4)) * 256; n0 = (q & 15) * 64; nb = 1;
      gemm_tile<1>((const bf16_t*)(ws + WS_AO) + (size_t)m0 * 1536, 1536, W + (size_t)n0 * 1536, 1536, 1536, lds, acc, tid);
    }
#pragma unroll
    for (int a = 0; a < 2; ++a)
#pragma unroll
      for (int b = 0; b < 2; ++b) {
        if (b >= nb) continue;
        const int n = n0 + wc * 32 * nb + 32 * b + r, mb = m0 + wr * 64 + 32 * a;
#pragma unroll
        for (int i = 0; i < 16; ++i) {
          const int m = mb + crow(i, h);
          if (layer == 0) {
            const float xv = m < TP ? p.in[I_XP][(size_t)m * 1024 + n] : p.in[I_XS][(size_t)(m - TP) * 1024 + n];
            ((float*)(ws + WS_Y1))[(size_t)m * 1024 + n] = xv + acc.a[a][b][i];
          } else {
            p.out[O_Y + (size_t)m * 1024 + n] = ((const float*)(ws + WS_Y1))[(size_t)m * 1024 + n] + acc.a[a][b][i];
          }
        }
      }
  }
  if (layer == 0) {
    unsigned* ctr = (unsigned*)(p.ws + WS_CTR) + 4 + 8 * p.pad;
    for (;;) {
      const int it = next_item(ctr, lds + LDS_BYTES - 16, TIDX);
      if (it >= 1024) break;
      cacheconv_item(p, lds, it);
    }
  }
}

DI void phase5(const Params& p, unsigned char* lds) {
  const int tid = TIDX, lane = tid & 63, wid = tid >> 6;
  unsigned char* ws = p.ws;
  const int gw = blockIdx.x * 8 + wid, nw = gridDim.x * 8;
  for (int r = gw; r < TT; r += nw) {
    f32x4 v[4];
    const float rstd = row_load_rstd((const float*)(ws + WS_Y1) + (size_t)r * 1024, v, lane);
    bf16_t* xn = (bf16_t*)(ws + WS_XN) + (size_t)r * 1024;
#pragma unroll
    for (int j = 0; j < 4; ++j) { const f32x4 xs = v[j] * rstd; u32x2 o = {pk2(xs[0], xs[1]), pk2(xs[2], xs[3])}; *(u32x2*)(xn + 4 * lane + 256 * j) = o; }
  }
}

DI void cacheconv_item(const Params& p, unsigned char* lds, int it) {
  const int tid = TIDX;
  unsigned char* ws = p.ws;
  if (it < 512) {
    const int b = it >> 5, slab = it & 31;
    float* smax = (float*)lds;
    const int hm = (tid & 127) >> 3;
    __syncthreads();
    if (tid < 16) smax[tid] = 0.f;
    __syncthreads();
    float mx = 0.f;
    const float* src = p.in[I_CK] + ((size_t)b * PAST + slab * 128) * 1024;
    bf16_t* dst = (bf16_t*)(ws + WS_KBS) + ((size_t)b * SKV + slab * 128) * 1024;
#pragma unroll 4
    for (int i = 0; i < 32; ++i) {
      const unsigned e = (unsigned)(i * NTHREADS + tid) * 8u;
      const f32x4 a = *(const f32x4*)(src + e), c = *(const f32x4*)(src + e + 4);
      u32x4 o = {pk2(a[0], a[1]), pk2(a[2], a[3]), pk2(c[0], c[1]), pk2(c[2], c[3])};
      *(u32x4*)(dst + e) = o;
      float ss = a[0] * a[0] + a[1] * a[1] + a[2] * a[2] + a[3] * a[3] + c[0] * c[0] + c[1] * c[1] + c[2] * c[2] + c[3] * c[3];
      ss += __shfl_xor(ss, 1); ss += __shfl_xor(ss, 2); ss += __shfl_xor(ss, 4);
      mx = fmaxf(mx, ss);
    }
    if ((tid & 7) == 0) atomicMax((unsigned*)smax + hm, __float_as_uint(mx));
    __syncthreads();
    if (tid < 16) atomicMax((unsigned*)(ws + WS_KMAX) + (1 + b) * 16 + tid, __float_as_uint(sqrtf(smax[tid])));
  } else {
    const int q = it - 512, jb = q >> 2, part = q & 3, b = jb >> 3, hd = jb & 7;
    TJob j = {p.in[I_CV] + (size_t)b * PAST * 1024 + hd * 128, 1024, (bf16_t*)(ws + WS_VTS) + ((size_t)(b * 8 + hd) * 128) * SKV, SKV, nullptr, 64, 1};
    for (int tile = part * 16; tile < part * 16 + 16; ++tile) run_tjob_tile(j, tile, (float*)lds, tid, true);
  }
}

DI void phase6(const Params& p, unsigned char* lds) {
  const int tid = TIDX, lane = tid & 63, wid = tid >> 6, r = lane & 31, h = lane >> 5;
  unsigned char* ws = p.ws;
  for (int t = blockIdx.x; t < 68 * 20; t += gridDim.x) {
    const int tm = t / 20, tn = t % 20, m0 = tm * 256, n0 = tn * 256;
    GemmAcc acc2[2];
    gemm256((const bf16_t*)(ws + WS_XN) + (size_t)m0 * 1024, 1024, (const bf16_t*)(ws + WS_WKB) + (size_t)n0 * 1024, 1024, 1024, lds, acc2, tid);
    const int sec = n0 >> 10;
    const bool samp = m0 >= TP;
#pragma unroll
    for (int mh = 0; mh < 2; ++mh) {
    const GemmAcc& acc = acc2[mh];
    const int wr = (wid >> 2) * 2 + mh, wc = wid & 3;
#pragma unroll
    for (int a = 0; a < 2; ++a)
#pragma unroll
      for (int b = 0; b < 2; ++b) {
        __builtin_amdgcn_sched_barrier(0);
        const int n = n0 + wc * 64 + 32 * b + r, mb = m0 + wr * 64 + 32 * a;
        if (sec == 0) {
          const int f = n;
          if (b == 1) {
            float mx = 0.f;
#pragma unroll
            for (int i = 0; i < 16; ++i) {
              float ss = acc.a[a][0][i] * acc.a[a][0][i] + acc.a[a][1][i] * acc.a[a][1][i];
              ss += __shfl_xor(ss, 1); ss += __shfl_xor(ss, 2); ss += __shfl_xor(ss, 4); ss += __shfl_xor(ss, 8); ss += __shfl_xor(ss, 16);
              mx = fmaxf(mx, ss);
            }
            mx = fmaxf(mx, __shfl_xor(mx, 32));
            if (lane == 0) {
              const int strm = samp ? 1 + ((mb - TP) >> 6) : 0;
              atomicMax((unsigned*)(ws + WS_KMAX) + strm * 16 + ((n0 + wc * 64) >> 6), __float_as_uint(sqrtf(mx)));
            }
          }
#pragma unroll
          for (int i = 0; i < 16; ++i) {
            const int m = mb + crow(i, h);
            const float v = acc.a[a][b][i];
            if (!samp) { (p.out + O_PK)[(unsigned)(m * 1024 + f)] = v; ((bf16_t*)(ws + WS_KBP))[(unsigned)(m * 1024 + f)] = f2bf(v); }
            else { const int ms = m - TP, bb = ms >> 6, s = ms & 63; (p.out + O_SK)[(unsigned)(ms * 1024 + f)] = v;
                   ((bf16_t*)(ws + WS_KBS))[(unsigned)((bb * SKV + PAST + s) * 1024 + f)] = f2bf(v); }
          }
        } else if (sec == 1) {
          const int f = n - 1024, hd = f >> 7, vd = f & 127;
#pragma unroll
          for (int i = 0; i < 16; ++i) {
            const int m = mb + crow(i, h);
            if (!samp) (p.out + O_PV)[(unsigned)(m * 1024 + f)] = acc.a[a][b][i]; else (p.out + O_SV)[(unsigned)((m - TP) * 1024 + f)] = acc.a[a][b][i];
          }
#pragma unroll
          for (int g = 0; g < 4; ++g) {
            const int m0r = mb + 8 * g + 4 * h, pq = (m0r >> 2) & 3;
            const int m = (m0r & ~15) + 4 * (((pq & 1) << 1) | (pq >> 1));
            u32x2 o = {pk2(acc.a[a][b][4 * g], acc.a[a][b][4 * g + 1]), pk2(acc.a[a][b][4 * g + 2], acc.a[a][b][4 * g + 3])};
            if (!samp) *(u32x2*)((bf16_t*)(ws + WS_VTP) + (unsigned)((hd * 128 + vd) * TP + m)) = o;
            else { const int ms = m - TP, bb = ms >> 6, s = ms & 63; *(u32x2*)((bf16_t*)(ws + WS_VTS) + (unsigned)(((bb * 8 + hd) * 128 + vd) * SKV + PAST + s)) = o; }
          }
        } else {
          const float sc = sec == 2 ? 0.125f * LOG2E : 1.f;
          bf16_t* PB = (bf16_t*)(ws + WS_PB);
#pragma unroll
          for (int i = 0; i < 16; ++i) PB[(unsigned)((mb + crow(i, h)) * 3072 + (n - 2048))] = f2bf(acc.a[a][b][i] * sc);
        }
      }
    }
  }
}

constexpr int A_BUF = 32768, A_KB = 16384, A_FLAGS = 3 * A_BUF;

DI void diffattn_task(const Params& p, unsigned char* lds, int sb  , int qt  , int hd, float lam) {
  const int tid = TIDX, lane = tid & 63, wid = __builtin_amdgcn_readfirstlane(tid >> 6), r = lane & 31, h = lane >> 5;
  unsigned char* ws = p.ws;
  const int cq = wid >> 2, sub = (wid >> 1) & 1, map = wid & 1;
  const int ncq = sb < 0 ? 2 : 1;
  const int base_chunk = sb < 0 ? 2 * qt : 64;
  const int tok0 = sb < 0 ? qt * 128 : TP + sb * 64;
  const bool wvalid = cq < ncq;
  const int qc = base_chunk + cq;
  const int tl = 32 * sub + r;
  const int tok = tok0 + 64 * (wvalid ? cq : 0) + tl;
  const bf16_t* Kb = sb < 0 ? (const bf16_t*)(ws + WS_KBP) + hd * 128 : (const bf16_t*)(ws + WS_KBS) + (size_t)sb * SKV * 1024 + hd * 128;
  const bf16_t* Vb = sb < 0 ? (const bf16_t*)(ws + WS_VTP) + (size_t)hd * 128 * TP : (const bf16_t*)(ws + WS_VTS) + (size_t)(sb * 8 + hd) * 128 * SKV;
  const unsigned ldv = sb < 0 ? TP : SKV;
  const bf16_t* PB = (const bf16_t*)(ws + WS_PB);
  bf16x8 qf[4];
  float qn = 0.f;
  {
    const unsigned qo = (unsigned)tok * 3072u + hd * 128 + map * 64 + 8 * h;
#pragma unroll
    for (int kk = 0; kk < 4; ++kk) {
      const u32x4 u = *(const u32x4*)(PB + (qo + 16 * kk));
      qf[kk] = __builtin_bit_cast(bf16x8, u);
#pragma unroll
      for (int e = 0; e < 4; ++e) { const float a = bflo(u[e]), b = bfhi(u[e]); qn += a * a + b * b; }
    }
    qn += __shfl_xor(qn, 32);
    qn = sqrtf(qn);
  }
  const float kmax = ((const float*)(ws + WS_KMAX))[(sb < 0 ? 0 : 1 + sb) * 16 + hd * 2 + map];
  const float shift = qn * kmax * 1.02f + 0.5f - 40.f;
  const float sl2 = exp2f(-(float)(hd + 1)) * LOG2E;
  const int wd = diff_window(hd);
  const float bh0 = sl2 * (float)(4 * h) - sl2 * (float)tl - shift, bh1 = bh0 + 32.f * sl2;
  float cs[16];
#pragma unroll
  for (int i = 0; i < 16; ++i) cs[i] = __uint_as_float(__builtin_amdgcn_readfirstlane(__float_as_uint(sl2 * (float)((i & 3) + 8 * (i >> 2)))));
  f32x16 O[4];
#pragma unroll
  for (int vt = 0; vt < 4; ++vt) O[vt] = zero16();
  float l = 0.f;
  const int jmax = base_chunk + ncq - 1;
  const int jmin = max(0, base_chunk - wd);
  const int nit = jmax - jmin + 1;
  unsigned kofs[2], vofs[2];
#pragma unroll
  for (int e = 0; e < 2; ++e) {
    const int q = wid * 2 + e;
    { const int row = 4 * q + (lane >> 4), lc = (lane & 15) ^ (row & 15); kofs[e] = (unsigned)row * 1024u + 8u * lc; }
    { const int row = 8 * q + (lane >> 3), lc = (lane & 7) ^ ((row >> 1) & 7); vofs[e] = (unsigned)row * ldv + 8u * lc; }
  }
  auto issue = [&](int j, int buf) {
    const bf16_t* kj = Kb + (size_t)j * 65536;
    const bf16_t* vj = Vb + (size_t)j * 64;
    unsigned char* base = lds + buf * A_BUF;
#pragma unroll
    for (int e = 0; e < 2; ++e) {
      dma16(kj + kofs[e], base + (wid * 2 + e) * 1024);
      dma16(vj + vofs[e], base + A_KB + (wid * 2 + e) * 1024);
    }
  };
  unsigned kco[4], vco[4];
#pragma unroll
  for (int kk = 0; kk < 4; ++kk) kco[kk] = (unsigned)r * 256u + ((((unsigned)(8 * map + 2 * kk + h)) ^ (unsigned)(r & 15)) << 4);
#pragma unroll
  for (int sx = 0; sx < 4; ++sx) vco[sx] = A_KB + (unsigned)r * 128u + ((((unsigned)(2 * sx + h)) ^ (unsigned)((r >> 1) & 7)) << 4);
  asm volatile("s_waitcnt vmcnt(0)" ::: "memory");
  __syncthreads();
  issue(jmax, 0);
  if (nit > 1) issue(jmax - 1, 1);
  for (int it = 0; it < nit; ++it) {
    const int j = jmax - it;
    if (it + 1 < nit) asm volatile("s_waitcnt vmcnt(4)" ::: "memory"); else asm volatile("s_waitcnt vmcnt(0)" ::: "memory");
    asm volatile("s_waitcnt lgkmcnt(0)" ::: "memory");
    __builtin_amdgcn_s_barrier();
    if (it + 2 < nit) issue(j - 2, (it + 2) % 3);
    if (wvalid && j <= qc && qc - j <= wd) {
      const unsigned char* base = lds + (it % 3) * A_BUF;
      const float dofs = sl2 * (float)((qc - j) * 64);
      float sum = 0.f;
#pragma unroll
      for (int half = 0; half < 2; ++half) {
        f32x16 sc;
        {
          float b0 = (half ? bh1 : bh0) - dofs;
          asm volatile("" : "+v"(b0));
#pragma unroll
          for (int i = 0; i < 16; ++i) sc[i] = b0 + cs[i];
        }
        if (j == qc) {
          int tlv = tl;
          asm volatile("" : "+v"(tlv));
          const float m2 = -2.f * sl2, xt = (float)(4 * h + 32 * half - tlv);
#pragma unroll
          for (int i = 0; i < 16; ++i) sc[i] = fmaf(m2, fmaxf(xt + (float)((i & 3) + 8 * (i >> 2)), 0.f), sc[i]);
        }
        {
          bf16x8 kf[4];
#pragma unroll
          for (int kk = 0; kk < 4; ++kk) kf[kk] = ld16(base + 8192 * half + kco[kk]);
#pragma unroll
          for (int kk = 0; kk < 4; ++kk) sc = MFMA32(kf[kk], qf[kk], sc);
        }
        bf16x8 vf[8];
#pragma unroll
        for (int vt = 0; vt < 4; ++vt) { vf[2 * vt] = ld16(base + 4096 * vt + vco[2 * half]); vf[2 * vt + 1] = ld16(base + 4096 * vt + vco[2 * half + 1]); }
#pragma unroll
        for (int i = 0; i < 16; ++i) { sc[i] = fexp2(sc[i]); sum += sc[i]; }
        const bf16x8 p0 = pack_acc(sc, 0), p1 = pack_acc(sc, 1);
#pragma unroll
        for (int vt = 0; vt < 4; ++vt) { O[vt] = MFMA32(vf[2 * vt], p0, O[vt]); O[vt] = MFMA32(vf[2 * vt + 1], p1, O[vt]); }
      }
      l += sum;
    }
  }
  asm volatile("s_waitcnt vmcnt(0)" ::: "memory");
  __syncthreads();
  l += __shfl_xor(l, 32);
  const float inv = wvalid ? 1.f / l : 0.f;
  float* xch = (float*)lds + (size_t)(wid >> 1) * 4096;
  if (map == 1 && wvalid) {
    const float sc = inv * lam;
#pragma unroll
    for (int vt = 0; vt < 4; ++vt)
#pragma unroll
      for (int i = 0; i < 16; ++i) xch[(vt * 16 + i) * 64 + lane] = O[vt][i] * sc;
  }
  __syncthreads();
  if (map == 0 && wvalid) {
    float ss = 0.f;
#pragma unroll
    for (int vt = 0; vt < 4; ++vt)
#pragma unroll
      for (int i = 0; i < 16; ++i) { const float o = O[vt][i] * inv - xch[(vt * 16 + i) * 64 + lane]; O[vt][i] = o; ss += o * o; }
    ss += __shfl_xor(ss, 32);
    const float lam_init = 0.8f - 0.6f * 0.7408182206817179f;
    const float rs = __builtin_amdgcn_rsqf(ss * (1.f / 128.f) + EPS) * (1.f - lam_init);
    const unsigned zo = (unsigned)tok * 3072u + 1024 + hd * 128, oo = (unsigned)tok * 1536u + hd * 128;
    bf16_t* AOp = (bf16_t*)(ws + WS_AO);
    const float* sg = p.in[I_SUBG];
#pragma unroll
    for (int vt = 0; vt < 4; ++vt)
#pragma unroll
      for (int g = 0; g < 4; ++g) {
        const int v = 32 * vt + 8 * g + 4 * h;
        const u32x2 z = *(const u32x2*)(PB + (zo + v));
        const f32x4 gg = *(const f32x4*)(sg + v);
        const float o0 = O[vt][4 * g] * rs * gg[0] * siluf_(bflo(z[0])), o1 = O[vt][4 * g + 1] * rs * gg[1] * siluf_(bfhi(z[0]));
        const float o2 = O[vt][4 * g + 2] * rs * gg[2] * siluf_(bflo(z[1])), o3 = O[vt][4 * g + 3] * rs * gg[3] * siluf_(bfhi(z[1]));
        u32x2 o = {pk2(o0, o1), pk2(o2, o3)};
        *(u32x2*)(AOp + (oo + v)) = o;
      }
  }
  __syncthreads();
}

DI void phase7(const Params& p, unsigned char* lds) {
  unsigned* ctr = (unsigned*)(p.ws + WS_CTR) + 1 + 8 * p.pad;
  const bf16_t* PB = (const bf16_t*)(p.ws + WS_PB);
  float lam;
  {
    const int lane = TIDX & 63;
    const float* lv = p.in[I_LAMB];
    const float a = wave_sum(lv[lane] * lv[64 + lane]), b = wave_sum(lv[128 + lane] * lv[192 + lane]);
    const float lam_init = 0.8f - 0.6f * 0.7408182206817179f;
    lam = __expf(a) - __expf(b) + lam_init;
  }
  const int n_s = 128, n_p = 1024, n_ma = 256 + 64;
  const int* tord = (const int*)(p.ws + WS_TORD);
  for (;;) {
    const int it = next_item(ctr, lds + LDS_BYTES - 16, TIDX);
    if (it >= n_s + n_p) break;
    const int a = tord[it];
    const bool pr = a < n_p;
    diffattn_task(p, lds, pr ? -1 : ((a - n_p) >> 3), pr ? (a >> 3) : 0, a & 7, lam);
  }
  for (;;) {
    const int it = next_item(ctr + 1, lds + LDS_BYTES - 16, TIDX);
    if (it >= n_ma) break;
    memattn_task(p, lds, it, 1, PB + 2048, PB + 2560, 3072);
  }
}

DI void phase9(const Params& p) {
  const int tid = TIDX, lane = tid & 63, wid = tid >> 6;
  const int gw = blockIdx.x * 8 + wid, nw = gridDim.x * 8;
  for (int r = gw; r < TT; r += nw) {
    f32x4 v[4];
    float* row = p.out + O_Y + (size_t)r * 1024;
    const float rstd = row_load_rstd(row, v, lane);
#pragma unroll
    for (int j = 0; j < 4; ++j) {
      const f32x4 g = *(const f32x4*)(p.in[I_FNG] + 4 * lane + 256 * j);
      *(f32x4*)(row + 4 * lane + 256 * j) = v[j] * rstd * g;
    }
  }
}

DI void grid_barrier(unsigned* bar, unsigned target, int tid) {
  asm volatile("s_waitcnt vmcnt(0)" ::: "memory");
  __syncthreads();
  if (tid == 0) {
    __builtin_amdgcn_fence(__ATOMIC_RELEASE, "agent");
    asm volatile("s_waitcnt vmcnt(0)" ::: "memory");
    __hip_atomic_fetch_add(bar, 1u, __ATOMIC_RELAXED, __HIP_MEMORY_SCOPE_AGENT);
    while (__hip_atomic_load(bar, __ATOMIC_RELAXED, __HIP_MEMORY_SCOPE_AGENT) < target) __builtin_amdgcn_s_sleep(1);
    __builtin_amdgcn_fence(__ATOMIC_ACQUIRE, "agent");
    asm volatile("s_waitcnt vmcnt(0)" ::: "memory");
  }
  __syncthreads();
}

__global__ __launch_bounds__(512) void mk(Params pin) {
  extern __shared__ __attribute__((aligned(16))) unsigned char lds[];
  Params p = pin;
  p.wv = __builtin_amdgcn_readfirstlane((int)(__builtin_amdgcn_workitem_id_x() >> 6));
  cg::grid_group grid = cg::this_grid();
  unsigned nbar = 0;
  unsigned* bar = (unsigned*)(p.ws + WS_CTR) + 32;
#define RUN_PHASE(PH, CALL) if (p.ph_lo <= PH && PH < p.ph_hi) { CALL; if (PH + 1 < p.ph_hi) { ++nbar; grid_barrier(bar, nbar * gridDim.x, TIDX); } }
  if (p.ph_lo <= 0 && 0 < p.ph_hi) { phase0(p, lds); if (1 < p.ph_hi) grid.sync(); }
  RUN_PHASE(1, phase1(p, lds))
  RUN_PHASE(2, phase2(p, lds))
  if (p.ph_lo <= 2 && 2 < p.ph_hi) { phase2c(p, lds); ++nbar; grid_barrier(bar, nbar * gridDim.x, TIDX); }
  RUN_PHASE(3, phase3(p))
  RUN_PHASE(4, phase_outproj(p, lds, 0))
  RUN_PHASE(5, phase5(p, lds))
  RUN_PHASE(6, phase6(p, lds))
  RUN_PHASE(7, phase7(p, lds))
  RUN_PHASE(8, phase_outproj(p, lds, 1))
  RUN_PHASE(9, phase9(p))
}

extern "C" void kernel_launch(void* const* d_in, const int* in_sizes, int n_in, void* d_out, int out_size,
                              void* d_ws, size_t ws_size, hipStream_t stream) {
  static int grid_blocks = 0;
  if (!grid_blocks) {
    int dev = 0, cus = 0, per_cu = 0;
    (void)hipGetDevice(&dev);
    (void)hipDeviceGetAttribute(&cus, hipDeviceAttributeMultiprocessorCount, dev);
    (void)hipFuncSetAttribute((const void*)mk, hipFuncAttributeMaxDynamicSharedMemorySize, LDS_BYTES);
    (void)hipOccupancyMaxActiveBlocksPerMultiprocessor(&per_cu, (const void*)mk, NTHREADS, LDS_BYTES);
    grid_blocks = cus;
    fprintf(stderr, "kernel_launch: cus=%d per_cu=%d grid=%d ws=%zu need=%zu\n", cus, per_cu, grid_blocks, ws_size, (size_t)WS_END);
  }
  if (ws_size < WS_END) { fprintf(stderr, "workspace too small\n"); return; }
  Params p{};
  for (int i = 0; i < 24; ++i) p.in[i] = (const float*)d_in[i];
  p.out = (float*)d_out; p.ws = (unsigned char*)d_ws; p.ph_lo = 0; p.ph_hi = NPHASE;
  void* args[] = {&p};
  hipError_t e = hipLaunchCooperativeKernel((const void*)mk, dim3(grid_blocks), dim3(NTHREADS), args, LDS_BYTES, stream);
  if (e != hipSuccess) fprintf(stderr, "cooperative launch failed: %s (grid %d)\n", hipGetErrorString(e), grid_blocks);
  if (PROBE_REP >= 0) {
    Params q = p;
    q.out = (float*)((unsigned char*)d_ws + WS_END); q.ph_lo = PROBE_REP; q.ph_hi = PROBE_REP + 1; q.pad = 1;
    void* args2[] = {&q};
    (void)hipLaunchCooperativeKernel((const void*)mk, dim3(grid_blocks), dim3(NTHREADS), args2, LDS_BYTES, stream);
  }
}
```

```cpp
#include <hip/hip_runtime.h>
#include <hip/hip_cooperative_groups.h>
#include <cstdio>
#include <cstdint>
namespace cg = cooperative_groups;

typedef unsigned short bf16_t;
typedef short bf16x8 __attribute__((ext_vector_type(8)));
typedef short s16x4 __attribute__((ext_vector_type(4)));
typedef float f32x16 __attribute__((ext_vector_type(16)));
typedef float f32x4 __attribute__((ext_vector_type(4)));
typedef float f32x2 __attribute__((ext_vector_type(2)));
typedef __bf16 bf2_t __attribute__((ext_vector_type(2)));
typedef unsigned u32x4 __attribute__((ext_vector_type(4)));
typedef unsigned u32x2 __attribute__((ext_vector_type(2)));
#define DI __device__ __forceinline__
#define MFMA32(a, b, c) __builtin_amdgcn_mfma_f32_32x32x16_bf16((a), (b), (c), 0, 0, 0)

struct Params { const float* in[24]; float* out; unsigned char* ws; int ph_lo, ph_hi; int wv, pad; };
#define TIDX (p.wv * 64 + (int)__builtin_amdgcn_mbcnt_hi(~0u, __builtin_amdgcn_mbcnt_lo(~0u, 0u)))
constexpr int LDS_BYTES = 148480;
constexpr int NTHREADS = 512;
constexpr int NPHASE = 10;
#ifndef PROBE_REP
#define PROBE_REP -1
#endif

constexpr int TP = 16384, TS = 1024, TT = 17408, DM = 1024;
constexpr int NCH = 272;
constexpr int PAST = 4096, SKV = 4160;
constexpr float EPS = 1e-6f;
constexpr float LOG2E = 1.4426950408889634f;
enum { I_XP = 0, I_XS, I_CK, I_CV, I_CMK, I_CMV, I_SC, I_SN, I_SM, I_MEMP, I_NG, I_FNG, I_MNG, I_WMKV, I_WINA, I_BGA, I_HGA, I_WOA,
       I_KVNG, I_WKV, I_WINB, I_LAMB, I_SUBG, I_WOB };
constexpr size_t O_Y = 0, O_PC = 17825792, O_PN = 18087936, O_PM = 18088960, O_PK = 18088964, O_PV = 34866180, O_PMK = 51643396,
                 O_PMV = 51905540, O_SC = 52167684, O_SN = 56361988, O_SM = 56378372, O_SK = 56378436, O_SV = 57427012;
constexpr size_t WS_CTR = 0;
constexpr size_t WS_KMAX = 1024;
constexpr size_t WS_TORD = 8192;
constexpr size_t WS_WA = 16384;
constexpr size_t WS_WOA = WS_WA + (size_t)6144 * 1024 * 2;
constexpr size_t WS_WKB = WS_WOA + (size_t)1024 * 1536 * 2;
constexpr size_t WS_WOB = WS_WKB + (size_t)5120 * 1024 * 2;
constexpr size_t WS_WM = WS_WOB + (size_t)1024 * 1536 * 2;
constexpr size_t WS_MEMN = WS_WM + (size_t)2 * 1024 * 1024 * 2;
constexpr size_t WS_MEMK = WS_MEMN + (size_t)2 * 256 * 1024 * 2;
constexpr size_t WS_MEMVT = WS_MEMK + (size_t)2 * 17 * 256 * 512 * 2;
constexpr size_t WS_GATE = WS_MEMVT + (size_t)2 * 17 * 256 * 512 * 2;
constexpr size_t SZ_CH = (size_t)NCH * 4 * 64 * 4;
constexpr size_t WS_GC = WS_GATE + (size_t)TT * 8 * 4;
constexpr size_t WS_MT = WS_GC + SZ_CH;
constexpr size_t WS_WS = WS_MT + SZ_CH;
constexpr size_t WS_WI = WS_WS + SZ_CH;
constexpr size_t WS_AS = WS_WI + SZ_CH;
constexpr size_t WS_BT = WS_AS + SZ_CH;
constexpr size_t WS_DEC = WS_BT + SZ_CH;
constexpr size_t WS_DENI = WS_DEC + 8192;
constexpr size_t WS_DENA = WS_DENI + (size_t)TT * 4 * 4;
constexpr size_t WS_XN = WS_DENA + (size_t)TT * 4 * 4;
constexpr size_t WS_AO = WS_XN + (size_t)TT * 1024 * 2;
constexpr size_t WS_Y1 = WS_AO + (size_t)TT * 1536 * 2;
constexpr size_t WS_KT = WS_Y1 + (size_t)TT * 1024 * 4;
constexpr size_t WS_VTA = WS_KT + (size_t)NCH * 4 * 256 * 64 * 2;
constexpr size_t WS_R1 = WS_VTA + (size_t)NCH * 4 * 256 * 64 * 2;
constexpr size_t SZ_R1 = (size_t)TT * 6144 * 2;
constexpr size_t WS_PB = WS_R1;
constexpr size_t WS_KBP = WS_PB + (size_t)TT * 3072 * 2;
constexpr size_t WS_VTP = WS_KBP + (size_t)TP * 1024 * 2;
constexpr size_t WS_R2 = WS_R1 + SZ_R1;
constexpr size_t WS_HINTER = WS_R2;
constexpr size_t WS_HINTRA = WS_R2 + (size_t)TT * 1024 * 4;
constexpr size_t WS_KBS = WS_R2;
constexpr size_t WS_VTS = WS_KBS + (size_t)16 * SKV * 1024 * 2;
constexpr size_t WS_WVT = WS_VTS + (size_t)16 * SKV * 1024 * 2;
constexpr size_t WS_U = WS_WVT + (size_t)NCH * 4 * 288 * 64 * 2;
constexpr size_t WS_CFAC = WS_U + SZ_CH;
constexpr size_t WS_CLOCC = WS_CFAC + 8192;
constexpr size_t WS_PM = WS_CLOCC + (size_t)256 * 4 * 9 * 8 * 2 * 64 * 16;
constexpr size_t WS_CHS = WS_PM + SZ_CH;
constexpr size_t WS_LD = WS_CHS + 16384;
constexpr size_t WS_CLOC = WS_LD + 8192;
constexpr size_t WS_XBAR = WS_CLOC + (size_t)16 * 36 * 8 * 64 * 16 * 4;
constexpr size_t WS_END = WS_XBAR + 16384;
constexpr int GRP = 16;
static_assert(WS_VTP + (size_t)TP * 1024 * 2 <= WS_R2, "R1 overflow");

DI unsigned pk2(float lo, float hi) { f32x2 v = {lo, hi}; return __builtin_bit_cast(unsigned, __builtin_convertvector(v, bf2_t)); }
DI bf16_t f2bf(float x) { return (bf16_t)(pk2(x, 0.f) & 0xffffu); }
DI float bf2f(unsigned v16) { return __uint_as_float(v16 << 16); }
DI float bflo(unsigned u) { return __uint_as_float(u << 16); }
DI float bfhi(unsigned u) { return __uint_as_float(u & 0xffff0000u); }
DI float rbf(float x) { return bflo(pk2(x, 0.f) & 0xffffu); }
DI int crow(int i, int h) { return (i & 3) + 8 * (i >> 2) + 4 * h; }
DI float wave_sum(float v) {
#pragma unroll
  for (int o = 32; o >= 1; o >>= 1) v += __shfl_xor(v, o);
  return v;
}
DI float fexp2(float x) { return __builtin_amdgcn_exp2f(x); }
DI float fexp(float x) { return __builtin_amdgcn_exp2f(x * LOG2E); }
DI float sigmoidf_(float x) { return 1.f / (1.f + __expf(-x)); }
DI float siluf_(float x) { return x / (1.f + __expf(-x)); }
DI bf16x8 pack_acc(const f32x16& x, int s) {
  u32x4 p;
  p[0] = pk2(x[8 * s + 0], x[8 * s + 1]); p[1] = pk2(x[8 * s + 2], x[8 * s + 3]);
  p[2] = pk2(x[8 * s + 4], x[8 * s + 5]); p[3] = pk2(x[8 * s + 6], x[8 * s + 7]);
  return __builtin_bit_cast(bf16x8, p);
}
DI bf16x8 ld16(const void* p) { return *(const bf16x8*)p; }
DI bf16x8 ld8x2(const void* p0, const void* p1) {
  u32x2 a = *(const u32x2*)p0, b = *(const u32x2*)p1; u32x4 r = {a[0], a[1], b[0], b[1]};
  return __builtin_bit_cast(bf16x8, r);
}
DI f32x16 zero16() { f32x16 z; for (int i = 0; i < 16; ++i) z[i] = 0.f; return z; }

DI void transpose_tile(const float* __restrict__ src, size_t ld_s, bf16_t* __restrict__ dst, size_t ld_d, const float* __restrict__ scale,
                       float* scr, int t, bool perm = false) {
  {
    const int c4 = t & 31, rb = t >> 5;
    f32x4 v[4];
#pragma unroll
    for (int i = 0; i < 4; ++i) v[i] = *(const f32x4*)(src + (size_t)(rb + 16 * i) * ld_s + 4 * c4);
#pragma unroll
    for (int i = 0; i < 4; ++i) {
      const int r = rb + 16 * i;
      f32x4 x = v[i];
      if (scale) { const float sc = scale[r]; x = x * sc; }
      float* d = scr + r * 129 + 4 * c4; d[0] = x[0]; d[1] = x[1]; d[2] = x[2]; d[3] = x[3];
    }
  }
  __syncthreads();
#pragma unroll
  for (int i = 0; i < 2; ++i) {
    const int id = t + 512 * i, c = id >> 3, rg = id & 7;
    const float* s = scr + (8 * rg) * 129 + c;
    u32x4 o; o[0] = pk2(s[0], s[129]); o[1] = pk2(s[2 * 129], s[3 * 129]); o[2] = pk2(s[4 * 129], s[5 * 129]); o[3] = pk2(s[6 * 129], s[7 * 129]);
    if (!perm) *(u32x4*)(dst + (size_t)c * ld_d + 8 * rg) = o;
    else {
      bf16_t* d = dst + (size_t)c * ld_d + 16 * (rg >> 1) + 4 * (rg & 1);
      u32x2 lo = {o[0], o[1]}, hi = {o[2], o[3]};
      *(u32x2*)d = lo; *(u32x2*)(d + 8) = hi;
    }
  }
  __syncthreads();
}

struct TJob { const float* src; size_t ld_s; bf16_t* dst; size_t ld_d; const float* scale; int tr, tc; };

DI void run_tjob_tile(const TJob& j, int tile, float* scr, int tid, bool perm = false) {
  const int ir = tile / j.tc, ic = tile % j.tc;
  transpose_tile(j.src + (size_t)(64 * ir) * j.ld_s + 128 * ic, j.ld_s, j.dst + (size_t)(128 * ic) * j.ld_d + 64 * ir, j.ld_d,
                 j.scale ? j.scale + 64 * ir : nullptr, scr, tid, perm);
}

DI float row_load_rstd(const float* xrow, f32x4 (&v)[4], int lane) {
  float ss = 0.f;
#pragma unroll
  for (int j = 0; j < 4; ++j) { v[j] = *(const f32x4*)(xrow + 4 * lane + 256 * j); ss += v[j][0] * v[j][0] + v[j][1] * v[j][1] + v[j][2] * v[j][2] + v[j][3] * v[j][3]; }
  ss = wave_sum(ss);
  return __builtin_amdgcn_rsqf(ss * (1.f / 1024.f) + EPS);
}

DI int diff_window(int hd) { const float sl2 = exp2f(-(float)(hd + 1)) * LOG2E; return (int)floorf((63.f + 192.f / sl2) * (1.f / 64.f)); }
DI int diff_est(int a) {
  const int hd = a & 7;
  const int w = diff_window(hd) + (a < 1024 ? 2 : 1);
  const int n = a < 1024 ? 2 * (a >> 3) + 2 : 65;
  return n < w ? n : w;
}

DI void phase0(const Params& p, unsigned char* lds) {
  const int tid = TIDX, lane = tid & 63, wid = tid >> 6;
  unsigned char* ws = p.ws;
  if (blockIdx.x == 0 && tid < 64) ((unsigned*)(ws + WS_CTR))[tid] = 0u;
  if (blockIdx.x == 0 && tid < 272) ((unsigned*)(ws + WS_KMAX))[tid] = 0u;
  if (blockIdx.x == 0) for (int i = tid; i < 4096; i += NTHREADS) ((unsigned*)(ws + WS_XBAR))[i] = 0u;
  if (blockIdx.x == 1) {
    int* est = (int*)lds;
    for (int a = tid; a < 1152; a += NTHREADS) est[a] = diff_est(a);
    __syncthreads();
    for (int a = tid; a < 1152; a += NTHREADS) {
      const int ea = est[a];
      int rank = 0;
      for (int b = 0; b < 1152; ++b) { const int eb = est[b]; rank += (eb > ea) || (eb == ea && b < a); }
      ((int*)(ws + WS_TORD))[rank] = a;
    }
    __syncthreads();
  }
  {
    TJob jobs[8];
    jobs[0] = {p.in[I_WINA], 6152, (bf16_t*)(ws + WS_WA), 1024, p.in[I_NG], 16, 40};
    jobs[1] = {p.in[I_WINA] + 5128, 6152, (bf16_t*)(ws + WS_WA) + (size_t)5120 * 1024, 1024, p.in[I_NG], 16, 8};
    jobs[2] = {p.in[I_WOA], 1024, (bf16_t*)(ws + WS_WOA), 1536, nullptr, 24, 8};
    jobs[3] = {p.in[I_WKV], 2048, (bf16_t*)(ws + WS_WKB), 1024, p.in[I_KVNG], 16, 16};
    jobs[4] = {p.in[I_WINB], 3072, (bf16_t*)(ws + WS_WKB) + (size_t)2048 * 1024, 1024, p.in[I_NG] + 1024, 16, 24};
    jobs[5] = {p.in[I_WOB], 1024, (bf16_t*)(ws + WS_WOB), 1536, nullptr, 24, 8};
    jobs[6] = {p.in[I_WMKV], 1024, (bf16_t*)(ws + WS_WM), 1024, nullptr, 16, 8};
    jobs[7] = {p.in[I_WMKV] + (size_t)1024 * 1024, 1024, (bf16_t*)(ws + WS_WM) + (size_t)1024 * 1024, 1024, nullptr, 16, 8};
    int base = 0;
#pragma unroll
    for (int j = 0; j < 8; ++j) {
      if (j >= 2 && j <= 5) continue;
      const int n = jobs[j].tr * jobs[j].tc;
      for (int t = blockIdx.x; t < n; t += gridDim.x) run_tjob_tile(jobs[j], t, (float*)lds, tid);
      base += n;
    }
    for (int t = blockIdx.x; t < 128 * 4; t += gridDim.x) {
      const int jb = t >> 2, tile = t & 3, l = jb >> 6, b = (jb >> 2) & 15, h = jb & 3;
      TJob j = {p.in[I_CMV] + ((size_t)(l * 16 + b) * 256) * 512 + h * 128, 512,
                (bf16_t*)(ws + WS_MEMVT) + ((size_t)(l * 17 + 1 + b) * 4 + h) * 128 * 256, 256, nullptr, 4, 1};
      run_tjob_tile(j, tile, (float*)lds, tid, true);
    }
  }
  {
    const size_t n8 = (size_t)2 * 16 * 256 * 512 / 8;
    for (size_t i = (size_t)blockIdx.x * NTHREADS + tid; i < n8; i += (size_t)gridDim.x * NTHREADS) {
      const size_t e = i * 8; const int l = (int)(e / ((size_t)16 * 131072)); const size_t rem = e - (size_t)l * 16 * 131072;
      const f32x4 a = *(const f32x4*)(p.in[I_CMK] + e), b = *(const f32x4*)(p.in[I_CMK] + e + 4);
      u32x4 o = {pk2(a[0], a[1]), pk2(a[2], a[3]), pk2(b[0], b[1]), pk2(b[2], b[3])};
      *(u32x4*)((bf16_t*)(ws + WS_MEMK) + ((size_t)(l * 17 + 1) * 131072) + rem) = o;
    }
  }
  {
    const int gw = blockIdx.x * 8 + wid, nw = gridDim.x * 8;
    const float* ng = p.in[I_NG];
    float* gwt = (float*)(lds + 32768);
    float* sg = (float*)(lds + 32768 + 36864);
    __syncthreads();
    for (int i = tid; i < 8192; i += NTHREADS) { const int k = i >> 3, c = i & 7; gwt[k * 8 + (k >> 2) * 4 + c] = p.in[I_WINA][(size_t)k * 6152 + 5120 + c] * ng[k]; }
    __syncthreads();
    for (int cc = blockIdx.x; cc < NCH; cc += gridDim.x) {
      f32x4 vn[4];
      {
        const int r0 = cc * 64 + wid * 8;
        const float* x0 = r0 < TP ? p.in[I_XP] + (size_t)r0 * 1024 : p.in[I_XS] + (size_t)(r0 - TP) * 1024;
#pragma unroll
        for (int j = 0; j < 4; ++j) vn[j] = *(const f32x4*)(x0 + 4 * lane + 256 * j);
      }
      for (int ri = 0; ri < 8; ++ri) {
        const int r = cc * 64 + wid * 8 + ri;
        f32x4 v[4];
#pragma unroll
        for (int j = 0; j < 4; ++j) v[j] = vn[j];
        if (ri + 1 < 8) {
          const float* x1 = (r + 1) < TP ? p.in[I_XP] + (size_t)(r + 1) * 1024 : p.in[I_XS] + (size_t)(r + 1 - TP) * 1024;
#pragma unroll
          for (int j = 0; j < 4; ++j) vn[j] = *(const f32x4*)(x1 + 4 * lane + 256 * j);
        }
        float ssq = 0.f;
#pragma unroll
        for (int j = 0; j < 4; ++j) ssq += v[j][0] * v[j][0] + v[j][1] * v[j][1] + v[j][2] * v[j][2] + v[j][3] * v[j][3];
        const float rstd = __builtin_amdgcn_rsqf(wave_sum(ssq) * (1.f / 1024.f) + EPS);
        float gacc[8];
#pragma unroll
        for (int c = 0; c < 8; ++c) gacc[c] = 0.f;
        bf16_t* xn = (bf16_t*)(ws + WS_XN) + (size_t)r * 1024;
#pragma unroll
        for (int j = 0; j < 4; ++j) {
          const int k0 = 4 * lane + 256 * j;
          const f32x4 xs = v[j] * rstd;
          u32x2 o = {pk2(xs[0], xs[1]), pk2(xs[2], xs[3])};
          *(u32x2*)(xn + k0) = o;
#pragma unroll
          for (int e = 0; e < 4; ++e) {
            const float* wr = gwt + (k0 + e) * 8 + (k0 >> 2) * 4;
            const f32x4 w0 = *(const f32x4*)wr, w1 = *(const f32x4*)(wr + 4);
            gacc[0] += xs[e] * w0[0]; gacc[1] += xs[e] * w0[1]; gacc[2] += xs[e] * w0[2]; gacc[3] += xs[e] * w0[3];
            gacc[4] += xs[e] * w1[0]; gacc[5] += xs[e] * w1[1]; gacc[6] += xs[e] * w1[2]; gacc[7] += xs[e] * w1[3];
          }
        }
#pragma unroll
        for (int c = 0; c < 8; ++c) gacc[c] = wave_sum(gacc[c]);
        if (lane < 8) {
          float gv = gacc[0];
#pragma unroll
          for (int c = 1; c < 8; ++c) gv = lane == c ? gacc[c] : gv;
          gv += p.in[I_BGA][lane];
          if (lane >= 4) gv = fminf(gv, 0.f) - log1pf(__expf(-fabsf(gv)));
          sg[(wid * 8 + ri) * 8 + lane] = gv;
        }
      }
      __syncthreads();
      if (wid < 4) {
        const int hd = wid, pr = cc * 4 + hd;
        const float ig = sg[lane * 8 + hd], lf = sg[lane * 8 + 4 + hd];
        float g = lf;
#pragma unroll
        for (int o = 1; o < 64; o <<= 1) { const float t = __shfl_up(g, o); if (lane >= o) g += t; }
        const float a = ig - g;
        float pm = a;
#pragma unroll
        for (int o = 1; o < 64; o <<= 1) { const float t = __shfl_up(pm, o); if (lane >= o) pm = fmaxf(pm, t); }
        const size_t o = (size_t)pr * 64 + lane;
        ((float*)(ws + WS_GC))[o] = g;
        ((float*)(ws + WS_AS))[o] = a;
        ((float*)(ws + WS_PM))[o] = pm;
        if (lane == 63) { ((float*)(ws + WS_CHS))[pr * 2] = g; ((float*)(ws + WS_CHS))[pr * 2 + 1] = pm; }
        const float u = __expf(a - __shfl(pm, 63));
        ((float*)(ws + WS_U))[o] = u;
        bf16_t* wr = (bf16_t*)(ws + WS_WVT) + ((size_t)pr * 288 + 256) * 64 + lane;
        wr[0] = f2bf(u);
#pragma unroll 4
        for (int rr = 1; rr < 32; ++rr) wr[rr * 64] = 0;
      }
      __syncthreads();
    }
    for (int r = gw; r < 512; r += nw) {
      const int l = r >> 8, rr = r & 255;
      f32x4 v[4];
      const float rstd = row_load_rstd(p.in[I_MEMP] + (size_t)rr * 1024, v, lane);
      bf16_t* o = (bf16_t*)(ws + WS_MEMN) + (size_t)r * 1024;
#pragma unroll
      for (int j = 0; j < 4; ++j) {
        const int k0 = 4 * lane + 256 * j;
        const f32x4 g = *(const f32x4*)(p.in[I_MNG] + l * 1024 + k0);
        const f32x4 xs = v[j] * rstd * g;
        u32x2 ov = {pk2(xs[0], xs[1]), pk2(xs[2], xs[3])};
        *(u32x2*)(o + k0) = ov;
      }
    }
  }
}

constexpr int G_STAGE = 49152;
struct GemmAcc { f32x16 a[2][2]; };
DI void dma16(const void* g, unsigned char* l) { __builtin_amdgcn_global_load_lds((const unsigned*)g, (unsigned*)l, 16, 0, 0); }

template <int NB = 2>
DI void gemm_tile(const bf16_t* __restrict__ A, size_t lda, const bf16_t* __restrict__ Bt, size_t ldb, int K, unsigned char* lds, GemmAcc& acc, int tid) {
  const int lane = tid & 63, wid = __builtin_amdgcn_readfirstlane(tid >> 6), r = lane & 31, h = lane >> 5;
  const int wr = wid >> 1, wc = wid & 1;
#pragma unroll
  for (int a = 0; a < 2; ++a)
#pragma unroll
    for (int b = 0; b < 2; ++b) acc.a[a][b] = zero16();
  const int nk = K / 64;
  unsigned aoff[4], boff[2];
#pragma unroll
  for (int e = 0; e < 4; ++e) { const int row = 8 * (wid * 4 + e) + (lane >> 3), lc = (lane & 7) ^ ((row >> 1) & 7); aoff[e] = (unsigned)row * (unsigned)lda + 8u * lc; }
#pragma unroll
  for (int e = 0; e < NB; ++e) { const int row = 8 * (wid * NB + e) + (lane >> 3), lc = (lane & 7) ^ ((row >> 1) & 7); boff[e] = (unsigned)row * (unsigned)ldb + 8u * lc; }
  auto issue = [&](int kt, int buf) {
    unsigned char* base = lds + buf * G_STAGE;
#pragma unroll
    for (int e = 0; e < 4; ++e) dma16(A + (aoff[e] + 64u * kt), base + (wid * 4 + e) * 1024);
#pragma unroll
    for (int e = 0; e < NB; ++e) dma16(Bt + (boff[e] + 64u * kt), base + 32768 + (wid * NB + e) * 1024);
  };
  asm volatile("s_waitcnt vmcnt(0)" ::: "memory");
  __syncthreads();
  issue(0, 0);
  if (nk > 1) issue(1, 1);
  const unsigned sw = (r >> 1) & 7;
  unsigned co[4];
#pragma unroll
  for (int kk = 0; kk < 4; ++kk) co[kk] = (((2 * kk + h) ^ sw) << 4);
  const unsigned ra = (wr * 64 + r) * 128, rb = 32768 + (wc * 32 * NB + r) * 128;
  for (int kt = 0; kt < nk; ++kt) {
    if (kt + 1 < nk) { if (NB == 2) asm volatile("s_waitcnt vmcnt(6)" ::: "memory"); else asm volatile("s_waitcnt vmcnt(5)" ::: "memory"); }
    else asm volatile("s_waitcnt vmcnt(0)" ::: "memory");
    asm volatile("s_waitcnt lgkmcnt(0)" ::: "memory");
    __builtin_amdgcn_s_barrier();
    if (kt + 2 < nk) issue(kt + 2, (kt + 2) % 3);
    const unsigned char* base = lds + (kt % 3) * G_STAGE;
    const unsigned char* pa = base + ra;
    const unsigned char* pb = base + rb;
#pragma unroll
    for (int kk = 0; kk < 4; ++kk) {
      const bf16x8 a0 = ld16(pa + co[kk]), a1 = ld16(pa + 4096 + co[kk]);
      const bf16x8 b0 = ld16(pb + co[kk]);
      acc.a[0][0] = MFMA32(a0, b0, acc.a[0][0]);
      acc.a[1][0] = MFMA32(a1, b0, acc.a[1][0]);
      if (NB == 2) {
        const bf16x8 b1 = ld16(pb + 4096 + co[kk]);
        acc.a[0][1] = MFMA32(a0, b1, acc.a[0][1]);
        acc.a[1][1] = MFMA32(a1, b1, acc.a[1][1]);
      }
    }
    __builtin_amdgcn_sched_group_barrier(0x100, 2 + NB, 0);
    __builtin_amdgcn_sched_group_barrier(0x100, 2 + NB, 0); __builtin_amdgcn_sched_group_barrier(0x008, 2 * NB, 0);
    __builtin_amdgcn_sched_group_barrier(0x100, 2 + NB, 0); __builtin_amdgcn_sched_group_barrier(0x008, 2 * NB, 0);
    __builtin_amdgcn_sched_group_barrier(0x100, 2 + NB, 0); __builtin_amdgcn_sched_group_barrier(0x008, 2 * NB, 0);
    __builtin_amdgcn_sched_group_barrier(0x008, 2 * NB, 0);
  }
}

DI void gemm256(const bf16_t* __restrict__ A, size_t lda, const bf16_t* __restrict__ Bt, size_t ldb, int K, unsigned char* lds, GemmAcc (&acc)[2], int tid) {
  const int lane = tid & 63, wid = __builtin_amdgcn_readfirstlane(tid >> 6), r = lane & 31, h = lane >> 5;
  const int wr = wid >> 2, wc = wid & 3;
#pragma unroll
  for (int mh = 0; mh < 2; ++mh)
#pragma unroll
    for (int a = 0; a < 2; ++a)
#pragma unroll
      for (int b = 0; b < 2; ++b) acc[mh].a[a][b] = zero16();
  const int nk = K / 64;
  unsigned aoff[4], boff[4];
#pragma unroll
  for (int e = 0; e < 4; ++e) {
    const int row = 8 * (wid * 4 + e) + (lane >> 3), lc = (lane & 7) ^ ((row >> 1) & 7);
    aoff[e] = (unsigned)row * (unsigned)lda + 8u * lc; boff[e] = (unsigned)row * (unsigned)ldb + 8u * lc;
  }
  auto issue = [&](int kt, int buf) {
    unsigned char* base = lds + buf * 65536;
#pragma unroll
    for (int e = 0; e < 4; ++e) { dma16(A + (aoff[e] + 64u * kt), base + (wid * 4 + e) * 1024); dma16(Bt + (boff[e] + 64u * kt), base + 32768 + (wid * 4 + e) * 1024); }
  };
  asm volatile("s_waitcnt vmcnt(0)" ::: "memory");
  __syncthreads();
  issue(0, 0);
  const unsigned sw = (r >> 1) & 7;
  unsigned co[4];
#pragma unroll
  for (int kk = 0; kk < 4; ++kk) co[kk] = (((2 * kk + h) ^ sw) << 4);
  const unsigned ra = (wr * 128 + r) * 128, rb = 32768 + (wc * 64 + r) * 128;
  for (int kt = 0; kt < nk; ++kt) {
    asm volatile("s_waitcnt vmcnt(0)" ::: "memory");
    asm volatile("s_waitcnt lgkmcnt(0)" ::: "memory");
    __builtin_amdgcn_s_barrier();
    if (kt + 1 < nk) issue(kt + 1, (kt + 1) & 1);
    const unsigned char* base = lds + (kt & 1) * 65536;
    const unsigned char* pa = base + ra;
    const unsigned char* pb = base + rb;
#pragma unroll
    for (int kk = 0; kk < 4; ++kk) {
      const bf16x8 b0 = ld16(pb + co[kk]), b1 = ld16(pb + 4096 + co[kk]);
#pragma unroll
      for (int mh = 0; mh < 2; ++mh) {
        const bf16x8 a0 = ld16(pa + 8192 * mh + co[kk]), a1 = ld16(pa + 8192 * mh + 4096 + co[kk]);
        acc[mh].a[0][0] = MFMA32(a0, b0, acc[mh].a[0][0]);
        acc[mh].a[0][1] = MFMA32(a0, b1, acc[mh].a[0][1]);
        acc[mh].a[1][0] = MFMA32(a1, b0, acc[mh].a[1][0]);
        acc[mh].a[1][1] = MFMA32(a1, b1, acc[mh].a[1][1]);
      }
    }
#define SGB_R(N) __builtin_amdgcn_sched_group_barrier(0x100, N, 0)
#define SGB_M(N) __builtin_amdgcn_sched_group_barrier(0x008, N, 0)
    SGB_R(4);
    SGB_R(2); SGB_M(4); SGB_R(4); SGB_M(4);
    SGB_R(2); SGB_M(4); SGB_R(4); SGB_M(4);
    SGB_R(2); SGB_M(4); SGB_R(4); SGB_M(4);
    SGB_R(2); SGB_M(4); SGB_M(4);
  }
}

DI void gate_scan(const Params& p, unsigned char* lds) {
  const int tid = TIDX, lane = tid & 63, wid = tid >> 6;
  unsigned char* ws = p.ws;
  float* s_ch = (float*)lds;
  float* s_mc = s_ch + NCH * 8;
  float* s_mn = s_mc + NCH * 4;
  __syncthreads();
  for (int i = tid; i < NCH * 8; i += NTHREADS) s_ch[i] = ((const float*)(ws + WS_CHS))[i];
  __syncthreads();
  if (tid < 4) {
    float m = 0.f, ld = 0.f;
    float* LD = (float*)(ws + WS_LD);
    const bool wr = blockIdx.x == 0;
#pragma unroll 8
    for (int c = 0; c < 256; ++c) {
      s_mc[c * 4 + tid] = m; if (wr) LD[c * 4 + tid] = ld;
      const float gl = s_ch[(c * 4 + tid) * 2], mn = gl + fmaxf(m, s_ch[(c * 4 + tid) * 2 + 1]);
      ld += gl + m - mn;
      m = mn; s_mn[c * 4 + tid] = m;
    }
    if (wr) { LD[256 * 4 + tid] = ld; p.out[O_PM + tid] = m; }
  } else if (tid >= 64 && tid < 128) {
    const int b = (tid - 64) >> 2, hd = tid & 3, pr = (256 + b) * 4 + hd;
    const float m0 = p.in[I_SM][b * 4 + hd];
    const float m = s_ch[pr * 2] + fmaxf(m0, s_ch[pr * 2 + 1]);
    s_mc[pr] = m0; s_mn[pr] = m;
    if (blockIdx.x == 0) p.out[O_SM + b * 4 + hd] = m;
  }
  __syncthreads();
  for (int cc = blockIdx.x; cc < NCH; cc += gridDim.x) {
    if (wid < 4) {
      const int hd = wid, pr = cc * 4 + hd;
      const size_t o = (size_t)pr * 64 + lane;
      const float g = ((const float*)(ws + WS_GC))[o], a = ((const float*)(ws + WS_AS))[o], pm = ((const float*)(ws + WS_PM))[o];
      const float mc = s_mc[pr], mn = s_mn[pr], gl = s_ch[pr * 2];
      const float mt = g + fmaxf(mc, pm);
      ((float*)(ws + WS_MT))[o] = mt;
      ((float*)(ws + WS_WS))[o] = __expf(gl + a - mn);
      ((float*)(ws + WS_WI))[o] = __expf(g + mc - mt);
      ((float*)(ws + WS_AS))[o] = a * LOG2E;
      ((float*)(ws + WS_BT))[o] = (g - mt) * LOG2E;
      if (lane == 0) { ((float*)(ws + WS_DEC))[pr] = __expf(gl + mc - mn); const float amx = s_ch[pr * 2 + 1]; ((float*)(ws + WS_CFAC))[pr] = __expf(amx - fmaxf(mc, amx)); }
    }
  }
  __syncthreads();
}

DI void phase1(const Params& p, unsigned char* lds) {
  const int tid = TIDX, lane = tid & 63, wid = tid >> 6, r = lane & 31, h = lane >> 5;
  unsigned char* ws = p.ws;
  gate_scan(p, lds);
  const int n_main = 68 * 24, n_mem = 16;
  for (int t = blockIdx.x; t < n_main + n_mem; t += gridDim.x) {
    if (t < n_main) {
      const int tm = t / 24, tn = t % 24, m0 = tm * 256, n0 = tn * 256;
      GemmAcc acc2[2];
      gemm256((const bf16_t*)(ws + WS_XN) + (size_t)m0 * 1024, 1024, (const bf16_t*)(ws + WS_WA) + (size_t)n0 * 1024, 1024, 1024, lds, acc2, tid);
#pragma unroll
      for (int mh = 0; mh < 2; ++mh) {
      const GemmAcc& acc = acc2[mh];
      const int wr = (wid >> 2) * 2 + mh, wc = wid & 3;
      bf16_t* PA = (bf16_t*)(ws + WS_R1);
      const int sec = n0 >> 10;
#pragma unroll
      for (int a = 0; a < 2; ++a)
#pragma unroll
        for (int b = 0; b < 2; ++b) {
          __builtin_amdgcn_sched_barrier(0);
          const int n = n0 + wc * 64 + 32 * b + r, mb = m0 + wr * 64 + 32 * a;
          if (sec != 2) {
            const float sc = sec == 1 ? 0.0625f : 1.f;
            const int pc = (n >> 2) & 3, np = sec <= 1 ? (n & ~15) + 4 * (((pc & 1) << 1) | (pc >> 1)) + (n & 3) : n;
#pragma unroll
            for (int i = 0; i < 16; ++i) PA[(size_t)(mb + crow(i, h)) * 6144 + np] = f2bf(acc.a[a][b][i] * sc);
          }
          if (sec == 1 || sec == 2) {
            const float sc = sec == 1 ? 0.0625f : 1.f;
            const int f = n & 1023, hd = f >> 8, fe = f & 255;
            bf16_t* T = (bf16_t*)(ws + (sec == 1 ? WS_KT : WS_VTA));
#pragma unroll
            for (int g = 0; g < 4; ++g) {
              const int m = mb + 8 * g + 4 * h, cc = m >> 6, s = m & 63;
              u32x2 o = {pk2(acc.a[a][b][4 * g] * sc, acc.a[a][b][4 * g + 1] * sc), pk2(acc.a[a][b][4 * g + 2] * sc, acc.a[a][b][4 * g + 3] * sc)};
              *(u32x2*)(T + (((size_t)cc * 4 + hd) * 256 + fe) * 64 + s) = o;
              if (sec == 2) {
                const f32x4 u = *(const f32x4*)((const float*)(ws + WS_U) + ((size_t)cc * 4 + hd) * 64 + s);
                u32x2 ow = {pk2(acc.a[a][b][4 * g] * u[0], acc.a[a][b][4 * g + 1] * u[1]), pk2(acc.a[a][b][4 * g + 2] * u[2], acc.a[a][b][4 * g + 3] * u[3])};
                *(u32x2*)((bf16_t*)(ws + WS_WVT) + (((size_t)cc * 4 + hd) * 288 + fe) * 64 + s) = ow;
              }
            }
          }
        }
      }
    } else {
      GemmAcc acc;
      const int wr = wid >> 1, wc = wid & 1;
      const int tt = t - n_main, l = tt >> 3, n0 = (tt & 7) * 128;
      gemm_tile((const bf16_t*)(ws + WS_MEMN) + (size_t)l * 256 * 1024, 1024, (const bf16_t*)(ws + WS_WM) + ((size_t)l * 1024 + n0) * 1024, 1024, 1024, lds, acc, tid);
      const bool isv = n0 >= 512;
      float* of = p.out + (isv ? O_PMV : O_PMK) + (size_t)l * 131072;
      bf16_t* mk = (bf16_t*)(ws + WS_MEMK) + (size_t)(l * 17) * 131072;
      bf16_t* mv = (bf16_t*)(ws + WS_MEMVT) + (size_t)(l * 17) * 131072;
#pragma unroll
      for (int a = 0; a < 2; ++a)
#pragma unroll
        for (int b = 0; b < 2; ++b) {
          __builtin_amdgcn_sched_barrier(0);
          const int f = (n0 & 511) + wc * 64 + 32 * b + r, mb = wr * 64 + 32 * a;
#pragma unroll
          for (int g = 0; g < 4; ++g) {
            const int m = mb + 8 * g + 4 * h;
            float* o4 = of + (size_t)m * 512 + f;
            o4[0] = acc.a[a][b][4 * g]; o4[512] = acc.a[a][b][4 * g + 1]; o4[1024] = acc.a[a][b][4 * g + 2]; o4[1536] = acc.a[a][b][4 * g + 3];
            if (!isv) {
              bf16_t* k4 = mk + (size_t)m * 512 + f;
              k4[0] = f2bf(acc.a[a][b][4 * g]); k4[512] = f2bf(acc.a[a][b][4 * g + 1]); k4[1024] = f2bf(acc.a[a][b][4 * g + 2]); k4[1536] = f2bf(acc.a[a][b][4 * g + 3]);
            } else {
              u32x2 o = {pk2(acc.a[a][b][4 * g], acc.a[a][b][4 * g + 1]), pk2(acc.a[a][b][4 * g + 2], acc.a[a][b][4 * g + 3])};
              const int pq = (m >> 2) & 3, mp = (m & ~15) + 4 * (((pq & 1) << 1) | (pq >> 1));
              *(u32x2*)(mv + (size_t)f * 256 + mp) = o;
            }
          }
        }
    }
  }
}

DI void scan_task(const Params& p, unsigned char* lds, int sb  , int hd, int j, int grp) {
  const int tid = TIDX, lane = tid & 63, wid = tid >> 6, r = lane & 31, h = lane >> 5;
  unsigned char* ws = p.ws;
  const int cc0 = sb < 0 ? GRP * grp : 256 + sb, nch = sb < 0 ? GRP : 1;
  const bf16_t* PA = (const bf16_t*)(ws + WS_R1);
  const bf16_t* KT = (const bf16_t*)(ws + WS_KT);
  const bf16_t* VT = (const bf16_t*)(ws + WS_VTA);
  const float* WSa = (const float*)(ws + WS_WS);
  const float* WIa = (const float*)(ws + WS_WI);
  const float* DEC = (const float*)(ws + WS_DEC);
  float* red = (float*)lds;
  const bool nsl = j == 8;
  f32x16 S = zero16();
  if (sb >= 0) {
    if (!nsl) {
      const float* C0 = p.in[I_SC] + ((size_t)(sb * 4 + hd) * 256 + 32 * j + r) * 256 + 32 * wid;
#pragma unroll
      for (int g = 0; g < 4; ++g) { const f32x4 c = *(const f32x4*)(C0 + 8 * g + 4 * h); S[4 * g] = c[0]; S[4 * g + 1] = c[1]; S[4 * g + 2] = c[2]; S[4 * g + 3] = c[3]; }
    } else if (r == 0) {
      const float* n0 = p.in[I_SN] + (size_t)(sb * 4 + hd) * 256 + 32 * wid;
#pragma unroll
      for (int g = 0; g < 4; ++g) { const f32x4 c = *(const f32x4*)(n0 + 8 * g + 4 * h); S[4 * g] = c[0]; S[4 * g + 1] = c[1]; S[4 * g + 2] = c[2]; S[4 * g + 3] = c[3]; }
    }
  }
  bf16x8 kt[4], wv[4], qf[2][2];
  u32x4 ktn[4], vn[4], qn[2][2];
  float wsn;
  float* wsl = (float*)(lds + 69632);
  auto loadraw = [&](int cc) {
    const size_t ch = (size_t)cc * 4 + hd;
    const bf16_t* kp = KT + (ch * 256 + 32 * wid + r) * 64 + 8 * h;
#pragma unroll
    for (int st = 0; st < 4; ++st) ktn[st] = *(const u32x4*)(kp + 16 * st);
    wsn = WSa[ch * 64 + lane];
    if (!nsl) {
      const bf16_t* vp = VT + (ch * 256 + 32 * j + r) * 64 + 8 * h;
#pragma unroll
      for (int st = 0; st < 4; ++st) vn[st] = *(const u32x4*)(vp + 16 * st);
    }
#pragma unroll
    for (int tt = 0; tt < 2; ++tt) {
      const bf16_t* qp = PA + (size_t)(cc * 64 + 32 * tt + r) * 6144 + hd * 256 + 32 * wid + 8 * h;
#pragma unroll
      for (int s2 = 0; s2 < 2; ++s2) qn[tt][s2] = *(const u32x4*)(qp + 16 * s2);
    }
  };
  auto convert = [&]() {
    __syncthreads();
    if (wid == 0) wsl[lane] = wsn;
    __syncthreads();
#pragma unroll
    for (int st = 0; st < 4; ++st) {
      kt[st] = __builtin_bit_cast(bf16x8, ktn[st]);
      const f32x4 w0 = *(const f32x4*)(wsl + 16 * st + 8 * h), w1 = *(const f32x4*)(wsl + 16 * st + 8 * h + 4);
      u32x4 o;
      if (!nsl) {
        const u32x4 v = vn[st];
        o[0] = pk2(bflo(v[0]) * w0[0], bfhi(v[0]) * w0[1]); o[1] = pk2(bflo(v[1]) * w0[2], bfhi(v[1]) * w0[3]);
        o[2] = pk2(bflo(v[2]) * w1[0], bfhi(v[2]) * w1[1]); o[3] = pk2(bflo(v[3]) * w1[2], bfhi(v[3]) * w1[3]);
      } else {
        o = (u32x4){pk2(w0[0], w0[1]), pk2(w0[2], w0[3]), pk2(w1[0], w1[1]), pk2(w1[2], w1[3])};
        if (r != 0) o = (u32x4){0u, 0u, 0u, 0u};
      }
      wv[st] = __builtin_bit_cast(bf16x8, o);
    }
#pragma unroll
    for (int tt = 0; tt < 2; ++tt)
#pragma unroll
      for (int s2 = 0; s2 < 2; ++s2) qf[tt][s2] = __builtin_bit_cast(bf16x8, qn[tt][s2]);
  };
  loadraw(cc0);
  convert();
  for (int c = 0; c < nch; ++c) {
    const int cc = cc0 + c;
    if (c + 1 < nch) loadraw(cc + 1);
    const float dec = DEC[cc * 4 + hd];
    const bf16x8 xs0 = pack_acc(S, 0), xs1 = pack_acc(S, 1);
    f32x16 z0 = MFMA32(xs0, qf[0][0], zero16()); z0 = MFMA32(xs1, qf[0][1], z0);
    f32x16 z1 = MFMA32(xs0, qf[1][0], zero16()); z1 = MFMA32(xs1, qf[1][1], z1);
    S = S * dec;
#pragma unroll
    for (int st = 0; st < 4; ++st) S = MFMA32(kt[st], wv[st], S);
    __syncthreads();
    {
      float* rw = red + wid * (64 * 33);
#pragma unroll
      for (int i = 0; i < 16; ++i) { rw[r * 33 + crow(i, h)] = z0[i]; rw[(32 + r) * 33 + crow(i, h)] = z1[i]; }
    }
    __syncthreads();
    {
      const int v = tid & 31;
#pragma unroll
      for (int e = 0; e < 4; ++e) {
        const int t = (tid >> 5) + 16 * e;
        float s = 0.f;
#pragma unroll
        for (int w8 = 0; w8 < 8; ++w8) s += red[w8 * (64 * 33) + t * 33 + v];
        const float wi = WIa[((size_t)cc * 4 + hd) * 64 + t];
        if (!nsl) ((float*)(ws + WS_HINTER))[(size_t)(cc * 64 + t) * 1024 + hd * 256 + 32 * j + v] = s * wi;
        else if (v == 0) ((float*)(ws + WS_DENI))[(size_t)(cc * 64 + t) * 4 + hd] = s * wi;
      }
    }
    if (c + 1 < nch) convert();
  }
  if (sb < 0) {
    float* cl = (float*)(ws + WS_CLOC) + ((((size_t)(grp * 4 + hd) * 9 + j) * 8 + wid) * 64 + lane) * 16;
#pragma unroll
    for (int g = 0; g < 4; ++g) { f32x4 c = {S[4 * g], S[4 * g + 1], S[4 * g + 2], S[4 * g + 3]}; *(f32x4*)(cl + 4 * g) = c; }
  } else {
    if (!nsl) {
      float* Co = (sb < 0 ? p.out + O_PC + (size_t)hd * 65536 : p.out + O_SC + (size_t)(sb * 4 + hd) * 65536) + (size_t)(32 * j + r) * 256 + 32 * wid;
#pragma unroll
      for (int g = 0; g < 4; ++g) { f32x4 c = {S[4 * g], S[4 * g + 1], S[4 * g + 2], S[4 * g + 3]}; *(f32x4*)(Co + 8 * g + 4 * h) = c; }
    } else if (r == 0) {
      float* no = (sb < 0 ? p.out + O_PN + (size_t)hd * 256 : p.out + O_SN + (size_t)(sb * 4 + hd) * 256) + 32 * wid;
#pragma unroll
      for (int g = 0; g < 4; ++g) { f32x4 c = {S[4 * g], S[4 * g + 1], S[4 * g + 2], S[4 * g + 3]}; *(f32x4*)(no + 8 * g + 4 * h) = c; }
    }
  }
  __syncthreads();
}

DI void intra_task(const Params& p, int cc, int hd) {
  const int tid = TIDX, lane = tid & 63, wid = tid >> 6, r = lane & 31, h = lane >> 5;
  unsigned char* ws = p.ws;
  const int tt = wid & 1, vq = wid >> 1;
  const bf16_t* PA = (const bf16_t*)(ws + WS_R1);
  const bf16_t* VT = (const bf16_t*)(ws + WS_VTA);
  const size_t ch = (size_t)cc * 4 + hd;
  f32x16 s0 = zero16(), s1 = zero16();
  {
    const bf16_t* qp = PA + (size_t)(cc * 64 + 32 * tt + r) * 6144 + hd * 256 + 8 * h;
    const bf16_t* kp = PA + (size_t)(cc * 64 + r) * 6144 + 1024 + hd * 256 + 8 * h;
#pragma unroll 4
    for (int kk = 0; kk < 16; ++kk) {
      const bf16x8 q = ld16(qp + 16 * kk), k0 = ld16(kp + 16 * kk), k1 = ld16(kp + (size_t)32 * 6144 + 16 * kk);
      s0 = MFMA32(k0, q, s0);
      if (tt == 1) s1 = MFMA32(k1, q, s1);
    }
  }
  const int t = 32 * tt + r;
  const float bt = ((const float*)(ws + WS_BT))[ch * 64 + t];
  const float* asp = (const float*)(ws + WS_AS) + ch * 64;
  float den = 0.f;
#pragma unroll
  for (int g = 0; g < 4; ++g) {
    const f32x4 a0 = *(const f32x4*)(asp + 8 * g + 4 * h);
    const f32x4 a1 = *(const f32x4*)(asp + 32 + 8 * g + 4 * h);
#pragma unroll
    for (int e = 0; e < 4; ++e) {
      const int s = 8 * g + 4 * h + e;
      const float w0 = s <= t ? fexp2(bt + a0[e]) : 0.f;
      const float w1 = (32 + s) <= t ? fexp2(bt + a1[e]) : 0.f;
      s0[4 * g + e] *= w0; s1[4 * g + e] *= w1;
      den += s0[4 * g + e] + s1[4 * g + e];
    }
  }
  den += __shfl_xor(den, 32);
  if (vq == 0 && h == 0) ((float*)(ws + WS_DENA))[(size_t)(cc * 64 + t) * 4 + hd] = den;
  bf16x8 pf[2][2];
  pf[0][0] = pack_acc(s0, 0); pf[0][1] = pack_acc(s0, 1); pf[1][0] = pack_acc(s1, 0); pf[1][1] = pack_acc(s1, 1);
  float* Ho = (float*)(ws + WS_HINTRA) + (size_t)(cc * 64 + t) * 1024 + hd * 256;
#pragma unroll
  for (int vt = 0; vt < 2; ++vt) {
    const int v0 = vq * 64 + vt * 32;
    const bf16_t* vp = VT + (ch * 256 + v0 + r) * 64 + 4 * h;
    f32x16 o = zero16();
#pragma unroll
    for (int st = 0; st < 2; ++st)
#pragma unroll
      for (int s2 = 0; s2 < 2; ++s2) {
        const bf16x8 a = ld8x2(vp + 32 * st + 16 * s2, vp + 32 * st + 16 * s2 + 8);
        o = MFMA32(a, pf[st][s2], o);
      }
#pragma unroll
    for (int g = 0; g < 4; ++g) { f32x4 c = {o[4 * g], o[4 * g + 1], o[4 * g + 2], o[4 * g + 3]}; *(f32x4*)(Ho + v0 + 8 * g + 4 * h) = c; }
  }
}

DI void memattn_task(const Params& p, unsigned char* lds, int task, int layer, const bf16_t* Qb, const bf16_t* Zb, unsigned ldq) {
  const int tid = TIDX, lane = tid & 63, wid = __builtin_amdgcn_readfirstlane(tid >> 6), r = lane & 31, h = lane >> 5;
  unsigned char* ws = p.ws;
  const bool prm = task < 256;
  const int hd = task & 3, ti = prm ? task >> 2 : (task - 256) >> 2;
  const int sbi = prm ? 0 : 1 + ti, tok0 = prm ? ti * 256 : TP + ti * 64, nact = prm ? 8 : 2;
  const bf16_t* MK = (const bf16_t*)(ws + WS_MEMK) + (size_t)(layer * 17 + sbi) * 131072 + hd * 128;
  const bf16_t* MV = (const bf16_t*)(ws + WS_MEMVT) + ((size_t)(layer * 17 + sbi) * 4 + hd) * 128 * 256;
  asm volatile("s_waitcnt vmcnt(0)" ::: "memory");
  __syncthreads();
#pragma unroll
  for (int e = 0; e < 8; ++e) {
    const int q = wid * 8 + e;
    { const int row = 4 * q + (lane >> 4), lc = (lane & 15) ^ (row & 15); dma16(MK + ((unsigned)row * 512u + 8u * lc), lds + q * 1024); }
    { const int row = 2 * q + (lane >> 5), lc = (lane & 31) ^ (row & 15); dma16(MV + ((unsigned)row * 256u + 8u * lc), lds + 65536 + q * 1024); }
  }
  const int tok = tok0 + (wid < nact ? wid : 0) * 32 + r;
  bf16x8 qf[8];
  {
    const bf16_t* qp = Qb + ((unsigned)tok * ldq + hd * 128 + 8 * h);
#pragma unroll
    for (int kk = 0; kk < 8; ++kk) qf[kk] = ld16(qp + 16 * kk);
  }
  asm volatile("s_waitcnt vmcnt(0)" ::: "memory");
  __syncthreads();
  if (wid >= nact) return;
  const float sc = 0.08838834764831845f * LOG2E;
  f32x16 O[4];
#pragma unroll
  for (int vt = 0; vt < 4; ++vt) O[vt] = zero16();
  float mrun = -1e30f, l = 0.f;
  const unsigned sw = r & 15;
#pragma unroll 1
  for (int kb = 0; kb < 4; ++kb) {
    f32x16 s0 = zero16(), s1 = zero16();
    const unsigned char* kp = lds + (kb * 64 + r) * 256;
#pragma unroll
    for (int kk = 0; kk < 8; ++kk) {
      const unsigned co = ((unsigned)(2 * kk + h) ^ sw) << 4;
      const bf16x8 k0 = ld16(kp + co), k1 = ld16(kp + 8192 + co);
      s0 = MFMA32(k0, qf[kk], s0); s1 = MFMA32(k1, qf[kk], s1);
    }
    float mx = -1e30f;
#pragma unroll
    for (int i = 0; i < 16; ++i) mx = fmaxf(mx, fmaxf(s0[i], s1[i]));
    mx = fmaxf(mx, __shfl_xor(mx, 32)) * sc;
    const float mnew = fmaxf(mrun, mx), alpha = fexp2(mrun - mnew);
    mrun = mnew;
    float sum = 0.f;
#pragma unroll
    for (int i = 0; i < 16; ++i) { s0[i] = fexp2(s0[i] * sc - mnew); s1[i] = fexp2(s1[i] * sc - mnew); sum += s0[i] + s1[i]; }
    l = l * alpha + sum;
#pragma unroll
    for (int vt = 0; vt < 4; ++vt) O[vt] = O[vt] * alpha;
    bf16x8 pf[2][2];
    pf[0][0] = pack_acc(s0, 0); pf[0][1] = pack_acc(s0, 1); pf[1][0] = pack_acc(s1, 0); pf[1][1] = pack_acc(s1, 1);
#pragma unroll
    for (int vt = 0; vt < 4; ++vt) {
      const unsigned char* vp = lds + 65536 + (32 * vt + r) * 512;
#pragma unroll
      for (int st = 0; st < 2; ++st)
#pragma unroll
        for (int s2 = 0; s2 < 2; ++s2) {
          const unsigned co = ((unsigned)(8 * kb + 4 * st + 2 * s2 + h) ^ sw) << 4;
          O[vt] = MFMA32(ld16(vp + co), pf[st][s2], O[vt]);
        }
    }
  }
  l += __shfl_xor(l, 32);
  const float inv = 1.f / l;
  const bf16_t* zp = Zb + ((unsigned)tok * ldq + hd * 128);
  bf16_t* op = (bf16_t*)(ws + WS_AO) + ((unsigned)tok * 1536u + 1024 + hd * 128);
#pragma unroll
  for (int vt = 0; vt < 4; ++vt)
#pragma unroll
    for (int g = 0; g < 4; ++g) {
      const int v = 32 * vt + 8 * g + 4 * h;
      const u32x2 z = *(const u32x2*)(zp + v);
      const float o0 = O[vt][4 * g] * inv * siluf_(bflo(z[0])), o1 = O[vt][4 * g + 1] * inv * siluf_(bfhi(z[0]));
      const float o2 = O[vt][4 * g + 2] * inv * siluf_(bflo(z[1])), o3 = O[vt][4 * g + 3] * inv * siluf_(bfhi(z[1]));
      u32x2 o = {pk2(o0, o1), pk2(o2, o3)};
      *(u32x2*)(op + v) = o;
    }
}

DI int next_item(unsigned* ctr, unsigned char* lds_flag_area, int tid) {
  __syncthreads();
  int* sh = (int*)lds_flag_area;
  if (tid == 0) *sh = (int)atomicAdd(ctr, 1u);
  __syncthreads();
  const int v = *sh;
  return v;
}

DI void scanA_task(const Params& p, int hd, int j, int grp);

DI void late_weight_item(const Params& p, unsigned char* lds, int it) {
  unsigned char* ws = p.ws;
  TJob j; int t = it;
  if (t < 192) j = {p.in[I_WOA], 1024, (bf16_t*)(ws + WS_WOA), 1536, nullptr, 24, 8};
  else if (t < 448) { t -= 192; j = {p.in[I_WKV], 2048, (bf16_t*)(ws + WS_WKB), 1024, p.in[I_KVNG], 16, 16}; }
  else if (t < 832) { t -= 448; j = {p.in[I_WINB], 3072, (bf16_t*)(ws + WS_WKB) + (size_t)2048 * 1024, 1024, p.in[I_NG] + 1024, 16, 24}; }
  else { t -= 832; j = {p.in[I_WOB], 1024, (bf16_t*)(ws + WS_WOB), 1536, nullptr, 24, 8}; }
  run_tjob_tile(j, t, (float*)lds, TIDX);
}

DI void phase2(const Params& p, unsigned char* lds) {
  unsigned* ctr = (unsigned*)(p.ws + WS_CTR) + 0 + 8 * p.pad;
  const bf16_t* PA = (const bf16_t*)(p.ws + WS_R1);
  const int n_ps = 36 * 16, n_ss = 576, n_in = NCH * 4, n_ma = 256 + 64;
  for (;;) {
    const int it = next_item(ctr, lds + LDS_BYTES - 16, TIDX);
    if (it >= n_ps + n_ss + n_in + n_ma + 1024) break;
    if (it >= n_ps + n_ss + n_in + n_ma) { late_weight_item(p, lds, it - (n_ps + n_ss + n_in + n_ma)); continue; }
    if (it < n_ps) scanA_task(p, (it % 36) / 9, it % 9, it / 36);
    else if (it < n_ps + n_ss) { const int q = it - n_ps; scan_task(p, lds, q / 36, (q % 36) / 9, q % 9, 0); }
    else if (it < n_ps + n_ss + n_in) { const int q = it - n_ps - n_ss; intra_task(p, q >> 2, q & 3); }
    else { const int q = it - n_ps - n_ss - n_in; memattn_task(p, lds, q, 0, PA + 5120, PA + 5632, 6144); }
  }
}


DI void scanA_task(const Params& p, int hd, int j, int grp) {
  const int tid = TIDX, lane = tid & 63, wid = tid >> 6, r = lane & 31, h = lane >> 5;
  unsigned char* ws = p.ws;
  const bf16_t* KT = (const bf16_t*)(ws + WS_KT);
  const bf16_t* WV = (const bf16_t*)(ws + WS_WVT);
  f32x16 S = zero16();
  u32x4 kn[4], vn[4];
  auto load = [&](int cc) {
    const size_t ch = (size_t)cc * 4 + hd;
    const bf16_t* kp = KT + (ch * 256 + 32 * wid + r) * 64 + 8 * h;
    const bf16_t* vp = WV + (ch * 288 + 32 * j + r) * 64 + 8 * h;
#pragma unroll
    for (int st = 0; st < 4; ++st) { kn[st] = *(const u32x4*)(kp + 16 * st); vn[st] = *(const u32x4*)(vp + 16 * st); }
  };
  load(GRP * grp);
#pragma unroll 1
  for (int c = 0; c < GRP; ++c) {
    const int cc = GRP * grp + c;
    bf16x8 kt[4], wv[4];
#pragma unroll
    for (int st = 0; st < 4; ++st) { kt[st] = __builtin_bit_cast(bf16x8, kn[st]); wv[st] = __builtin_bit_cast(bf16x8, vn[st]); }
    if (c + 1 < GRP) load(cc + 1);
    u32x4* cl = (u32x4*)(ws + WS_CLOCC) + ((((size_t)cc * 4 + hd) * 9 + j) * 8 + wid) * 128 + lane;
    cl[0] = __builtin_bit_cast(u32x4, pack_acc(S, 0));
    cl[64] = __builtin_bit_cast(u32x4, pack_acc(S, 1));
    f32x16 D = zero16();
#pragma unroll
    for (int st = 0; st < 4; ++st) D = MFMA32(kt[st], wv[st], D);
    const float dec = ((const float*)(ws + WS_DEC))[cc * 4 + hd], cf = ((const float*)(ws + WS_CFAC))[cc * 4 + hd];
    S = S * dec + D * cf;
  }
  float* cl = (float*)(ws + WS_CLOC) + ((((size_t)(grp * 4 + hd) * 9 + j) * 8 + wid) * 64 + lane) * 16;
#pragma unroll
  for (int g = 0; g < 4; ++g) { f32x4 c = {S[4 * g], S[4 * g + 1], S[4 * g + 2], S[4 * g + 3]}; *(f32x4*)(cl + 4 * g) = c; }
}

DI void scanfix_task(const Params& p, unsigned char* lds, int grp, int hd, int j) {
  const int tid = TIDX, lane = tid & 63, wid = tid >> 6, r = lane & 31, h = lane >> 5;
  unsigned char* ws = p.ws;
  const bool nsl = j == 8;
  const float* LD = (const float*)(ws + WS_LD);
  f32x16 S = zero16();
#pragma unroll 4
  for (int gp = 0; gp < grp; ++gp) {
    const float dg = __expf(LD[(GRP * (gp + 1)) * 4 + hd] - LD[(GRP * gp) * 4 + hd]);
    const float* cl = (const float*)(ws + WS_CLOC) + ((((size_t)(gp * 4 + hd) * 9 + j) * 8 + wid) * 64 + lane) * 16;
#pragma unroll
    for (int g = 0; g < 4; ++g) { const f32x4 c = *(const f32x4*)(cl + 4 * g);
      S[4 * g] = S[4 * g] * dg + c[0]; S[4 * g + 1] = S[4 * g + 1] * dg + c[1]; S[4 * g + 2] = S[4 * g + 2] * dg + c[2]; S[4 * g + 3] = S[4 * g + 3] * dg + c[3]; }
  }
  if (grp == 16) {
    if (!nsl) {
      float* Co = p.out + O_PC + (size_t)hd * 65536 + (size_t)(32 * j + r) * 256 + 32 * wid;
#pragma unroll
      for (int g = 0; g < 4; ++g) { f32x4 c = {S[4 * g], S[4 * g + 1], S[4 * g + 2], S[4 * g + 3]}; *(f32x4*)(Co + 8 * g + 4 * h) = c; }
    } else if (r == 0) {
      float* no = p.out + O_PN + (size_t)hd * 256 + 32 * wid;
#pragma unroll
      for (int g = 0; g < 4; ++g) { f32x4 c = {S[4 * g], S[4 * g + 1], S[4 * g + 2], S[4 * g + 3]}; *(f32x4*)(no + 8 * g + 4 * h) = c; }
    }
    return;
  }
  u32x4* fr = (u32x4*)lds;
  float* tp = (float*)(lds + 16384) + wid * (64 * 33);
  __syncthreads();
  fr[(wid * 2 + 0) * 64 + lane] = __builtin_bit_cast(u32x4, pack_acc(S, 0));
  fr[(wid * 2 + 1) * 64 + lane] = __builtin_bit_cast(u32x4, pack_acc(S, 1));
  __syncthreads();
  const bf16_t* PA = (const bf16_t*)(ws + WS_R1);
  const float* WIa = (const float*)(ws + WS_WI);
  const bool hasg = grp > 0;
#pragma unroll
  for (int ci = 0; ci < 2; ++ci) {
    const int cc = GRP * grp + wid + 8 * ci;
    const float D = __expf(LD[cc * 4 + hd] - LD[(GRP * grp) * 4 + hd]);
    const u32x4* clc = (const u32x4*)(ws + WS_CLOCC) + (((size_t)cc * 4 + hd) * 9 + j) * 8 * 128 + lane;
#pragma unroll
    for (int tt = 0; tt < 2; ++tt) {
      const bf16_t* qp = PA + (size_t)(cc * 64 + 32 * tt + r) * 6144 + hd * 256 + 8 * h;
      f32x16 z = zero16(), z2 = zero16();
#pragma unroll
      for (int kt = 0; kt < 8; ++kt)
#pragma unroll
        for (int s2 = 0; s2 < 2; ++s2) {
          const bf16x8 q = ld16(qp + 32 * kt + 16 * s2);
          z = MFMA32(__builtin_bit_cast(bf16x8, clc[(kt * 2 + s2) * 64]), q, z);
          if (hasg) z2 = MFMA32(__builtin_bit_cast(bf16x8, fr[(kt * 2 + s2) * 64 + lane]), q, z2);
        }
#pragma unroll
      for (int i = 0; i < 16; ++i) tp[(32 * tt + r) * 33 + crow(i, h)] = z[i] + D * z2[i];
    }
    const int v = lane & 31;
#pragma unroll 4
    for (int e = 0; e < 32; ++e) {
      const int t = 2 * e + (lane >> 5);
      const float val = tp[t * 33 + v] * WIa[((size_t)cc * 4 + hd) * 64 + t];
      if (!nsl) ((float*)(ws + WS_HINTER))[(size_t)(cc * 64 + t) * 1024 + hd * 256 + 32 * j + v] = val;
      else if (v == 0) ((float*)(ws + WS_DENI))[(size_t)(cc * 64 + t) * 4 + hd] = val;
    }
  }
}

DI void phase2c(const Params& p, unsigned char* lds) {
  unsigned* ctr = (unsigned*)(p.ws + WS_CTR) + 3 + 8 * p.pad;
  for (;;) {
    const int it = next_item(ctr, lds + LDS_BYTES - 16, TIDX);
    if (it >= 17 * 36) break;
    const int g = 16 - it / 36;
    scanfix_task(p, lds, g, (it % 36) / 9, it % 9);
  }
}

DI void phase3(const Params& p) {
  const int tid = TIDX, lane = tid & 63, wid = tid >> 6;
  unsigned char* ws = p.ws;
  const int gw = blockIdx.x * 8 + wid, nw = gridDim.x * 8;
  const bf16_t* PA = (const bf16_t*)(ws + WS_R1);
  for (int it = gw; it < TT * 4; it += nw) {
    const int tok = it >> 2, hd = it & 3, cc = tok >> 6, t = tok & 63;
    const size_t off = (size_t)tok * 1024 + hd * 256 + 4 * lane;
    const f32x4 a = *(const f32x4*)((const float*)(ws + WS_HINTER) + off), b = *(const f32x4*)((const float*)(ws + WS_HINTRA) + off);
    const float den = ((const float*)(ws + WS_DENI))[tok * 4 + hd] + ((const float*)(ws + WS_DENA))[tok * 4 + hd];
    const float mt = ((const float*)(ws + WS_MT))[((size_t)cc * 4 + hd) * 64 + t];
    const float dn = 1.f / fmaxf(fabsf(den), __expf(-mt));
    const u32x2 ou = *(const u32x2*)(PA + (size_t)tok * 6144 + 3072 + hd * 256 + 4 * lane);
    const u32x2 zu = *(const u32x2*)(PA + (size_t)tok * 6144 + 4096 + hd * 256 + 4 * lane);
    f32x4 hv = (a + b) * dn;
    hv[0] *= sigmoidf_(bflo(ou[0])); hv[1] *= sigmoidf_(bfhi(ou[0])); hv[2] *= sigmoidf_(bflo(ou[1])); hv[3] *= sigmoidf_(bfhi(ou[1]));
    float ss = hv[0] * hv[0] + hv[1] * hv[1] + hv[2] * hv[2] + hv[3] * hv[3];
    ss = wave_sum(ss);
    const float rstd = __builtin_amdgcn_rsqf(ss * (1.f / 256.f) + EPS);
    const f32x4 hg = *(const f32x4*)(p.in[I_HGA] + hd * 256 + 4 * lane);
    hv = hv * rstd * hg;
    hv[0] *= siluf_(bflo(zu[0])); hv[1] *= siluf_(bfhi(zu[0])); hv[2] *= siluf_(bflo(zu[1])); hv[3] *= siluf_(bfhi(zu[1]));
    u32x2 o = {pk2(hv[0], hv[1]), pk2(hv[2], hv[3])};
    *(u32x2*)((bf16_t*)(ws + WS_AO) + (size_t)tok * 1536 + hd * 256 + 4 * lane) = o;
  }
}

DI void cacheconv_item(const Params& p, unsigned char* lds, int it);

DI void phase_outproj(const Params& p, unsigned char* lds, int layer) {
  const int tid = TIDX, lane = tid & 63, wid = tid >> 6, r = lane & 31, h = lane >> 5, wr = wid >> 1, wc = wid & 1;
  unsigned char* ws = p.ws;
  const bf16_t* W = (const bf16_t*)(ws + (layer == 0 ? WS_WOA : WS_WOB));
  for (int t = blockIdx.x; t < 512 + 64; t += gridDim.x) {
    GemmAcc acc;
    int m0, n0, nb;
    if (t < 512) {
      m0 = (t >> 3) * 256; n0 = (t & 7) * 128; nb = 2;
      gemm_tile<2>((const bf16_t*)(ws + WS_AO) + (size_t)m0 * 1536, 1536, W + (size_t)n0 * 1536, 1536, 1536, lds, acc, tid);
    } else {
      const int q = t - 512;
      m0 = (64 + (q >> 4)) * 256; n0 = (q & 15) * 64; nb = 1;
      gemm_tile<1>((const bf16_t*)(ws + WS_AO) + (size_t)m0 * 1536, 1536, W + (size_t)n0 * 1536, 1536, 1536, lds, acc, tid);
    }
#pragma unroll
    for (int a = 0; a < 2; ++a)
#pragma unroll
      for (int b = 0; b < 2; ++b) {
        if (b >= nb) continue;
        const int n = n0 + wc * 32 * nb + 32 * b + r, mb = m0 + wr * 64 + 32 * a;
#pragma unroll
        for (int i = 0; i < 16; ++i) {
          const int m = mb + crow(i, h);
          if (layer == 0) {
            const float xv = m < TP ? p.in[I_XP][(size_t)m * 1024 + n] : p.in[I_XS][(size_t)(m - TP) * 1024 + n];
            ((float*)(ws + WS_Y1))[(size_t)m * 1024 + n] = xv + acc.a[a][b][i];
          } else {
            p.out[O_Y + (size_t)m * 1024 + n] = ((const float*)(ws + WS_Y1))[(size_t)m * 1024 + n] + acc.a[a][b][i];
          }
        }
      }
  }
  if (layer == 0) {
    unsigned* ctr = (unsigned*)(p.ws + WS_CTR) + 4 + 8 * p.pad;
    for (;;) {
      const int it = next_item(ctr, lds + LDS_BYTES - 16, TIDX);
      if (it >= 1024) break;
      cacheconv_item(p, lds, it);
    }
  }
}

DI void phase5(const Params& p, unsigned char* lds) {
  const int tid = TIDX, lane = tid & 63, wid = tid >> 6;
  unsigned char* ws = p.ws;
  const int gw = blockIdx.x * 8 + wid, nw = gridDim.x * 8;
  for (int r = gw; r < TT; r += nw) {
    f32x4 v[4];
    const float rstd = row_load_rstd((const float*)(ws + WS_Y1) + (size_t)r * 1024, v, lane);
    bf16_t* xn = (bf16_t*)(ws + WS_XN) + (size_t)r * 1024;
#pragma unroll
    for (int j = 0; j < 4; ++j) { const f32x4 xs = v[j] * rstd; u32x2 o = {pk2(xs[0], xs[1]), pk2(xs[2], xs[3])}; *(u32x2*)(xn + 4 * lane + 256 * j) = o; }
  }
}

DI void cacheconv_item(const Params& p, unsigned char* lds, int it) {
  const int tid = TIDX;
  unsigned char* ws = p.ws;
  if (it < 512) {
    const int b = it >> 5, slab = it & 31;
    float* smax = (float*)lds;
    const int hm = (tid & 127) >> 3;
    __syncthreads();
    if (tid < 16) smax[tid] = 0.f;
    __syncthreads();
    float mx = 0.f;
    const float* src = p.in[I_CK] + ((size_t)b * PAST + slab * 128) * 1024;
    bf16_t* dst = (bf16_t*)(ws + WS_KBS) + ((size_t)b * SKV + slab * 128) * 1024;
#pragma unroll 4
    for (int i = 0; i < 32; ++i) {
      const unsigned e = (unsigned)(i * NTHREADS + tid) * 8u;
      const f32x4 a = *(const f32x4*)(src + e), c = *(const f32x4*)(src + e + 4);
      u32x4 o = {pk2(a[0], a[1]), pk2(a[2], a[3]), pk2(c[0], c[1]), pk2(c[2], c[3])};
      *(u32x4*)(dst + e) = o;
      float ss = a[0] * a[0] + a[1] * a[1] + a[2] * a[2] + a[3] * a[3] + c[0] * c[0] + c[1] * c[1] + c[2] * c[2] + c[3] * c[3];
      ss += __shfl_xor(ss, 1); ss += __shfl_xor(ss, 2); ss += __shfl_xor(ss, 4);
      mx = fmaxf(mx, ss);
    }
    if ((tid & 7) == 0) atomicMax((unsigned*)smax + hm, __float_as_uint(mx));
    __syncthreads();
    if (tid < 16) atomicMax((unsigned*)(ws + WS_KMAX) + (1 + b) * 16 + tid, __float_as_uint(sqrtf(smax[tid])));
  } else {
    const int q = it - 512, jb = q >> 2, part = q & 3, b = jb >> 3, hd = jb & 7;
    TJob j = {p.in[I_CV] + (size_t)b * PAST * 1024 + hd * 128, 1024, (bf16_t*)(ws + WS_VTS) + ((size_t)(b * 8 + hd) * 128) * SKV, SKV, nullptr, 64, 1};
    for (int tile = part * 16; tile < part * 16 + 16; ++tile) run_tjob_tile(j, tile, (float*)lds, tid, true);
  }
}

DI void phase6(const Params& p, unsigned char* lds) {
  const int tid = TIDX, lane = tid & 63, wid = tid >> 6, r = lane & 31, h = lane >> 5;
  unsigned char* ws = p.ws;
  for (int t = blockIdx.x; t < 68 * 20; t += gridDim.x) {
    const int tm = t / 20, tn = t % 20, m0 = tm * 256, n0 = tn * 256;
    GemmAcc acc2[2];
    gemm256((const bf16_t*)(ws + WS_XN) + (size_t)m0 * 1024, 1024, (const bf16_t*)(ws + WS_WKB) + (size_t)n0 * 1024, 1024, 1024, lds, acc2, tid);
    const int sec = n0 >> 10;
    const bool samp = m0 >= TP;
#pragma unroll
    for (int mh = 0; mh < 2; ++mh) {
    const GemmAcc& acc = acc2[mh];
    const int wr = (wid >> 2) * 2 + mh, wc = wid & 3;
#pragma unroll
    for (int a = 0; a < 2; ++a)
#pragma unroll
      for (int b = 0; b < 2; ++b) {
        __builtin_amdgcn_sched_barrier(0);
        const int n = n0 + wc * 64 + 32 * b + r, mb = m0 + wr * 64 + 32 * a;
        if (sec == 0) {
          const int f = n;
          if (b == 1) {
            float mx = 0.f;
#pragma unroll
            for (int i = 0; i < 16; ++i) {
              float ss = acc.a[a][0][i] * acc.a[a][0][i] + acc.a[a][1][i] * acc.a[a][1][i];
              ss += __shfl_xor(ss, 1); ss += __shfl_xor(ss, 2); ss += __shfl_xor(ss, 4); ss += __shfl_xor(ss, 8); ss += __shfl_xor(ss, 16);
              mx = fmaxf(mx, ss);
            }
            mx = fmaxf(mx, __shfl_xor(mx, 32));
            if (lane == 0) {
              const int strm = samp ? 1 + ((mb - TP) >> 6) : 0;
              atomicMax((unsigned*)(ws + WS_KMAX) + strm * 16 + ((n0 + wc * 64) >> 6), __float_as_uint(sqrtf(mx)));
            }
          }
#pragma unroll
          for (int i = 0; i < 16; ++i) {
            const int m = mb + crow(i, h);
            const float v = acc.a[a][b][i];
            if (!samp) { (p.out + O_PK)[(unsigned)(m * 1024 + f)] = v; ((bf16_t*)(ws + WS_KBP))[(unsigned)(m * 1024 + f)] = f2bf(v); }
            else { const int ms = m - TP, bb = ms >> 6, s = ms & 63; (p.out + O_SK)[(unsigned)(ms * 1024 + f)] = v;
                   ((bf16_t*)(ws + WS_KBS))[(unsigned)((bb * SKV + PAST + s) * 1024 + f)] = f2bf(v); }
          }
        } else if (sec == 1) {
          const int f = n - 1024, hd = f >> 7, vd = f & 127;
#pragma unroll
          for (int i = 0; i < 16; ++i) {
            const int m = mb + crow(i, h);
            if (!samp) (p.out + O_PV)[(unsigned)(m * 1024 + f)] = acc.a[a][b][i]; else (p.out + O_SV)[(unsigned)((m - TP) * 1024 + f)] = acc.a[a][b][i];
          }
#pragma unroll
          for (int g = 0; g < 4; ++g) {
            const int m0r = mb + 8 * g + 4 * h, pq = (m0r >> 2) & 3;
            const int m = (m0r & ~15) + 4 * (((pq & 1) << 1) | (pq >> 1));
            u32x2 o = {pk2(acc.a[a][b][4 * g], acc.a[a][b][4 * g + 1]), pk2(acc.a[a][b][4 * g + 2], acc.a[a][b][4 * g + 3])};
            if (!samp) *(u32x2*)((bf16_t*)(ws + WS_VTP) + (unsigned)((hd * 128 + vd) * TP + m)) = o;
            else { const int ms = m - TP, bb = ms >> 6, s = ms & 63; *(u32x2*)((bf16_t*)(ws + WS_VTS) + (unsigned)(((bb * 8 + hd) * 128 + vd) * SKV + PAST + s)) = o; }
          }
        } else {
          const float sc = sec == 2 ? 0.125f * LOG2E : 1.f;
          bf16_t* PB = (bf16_t*)(ws + WS_PB);
#pragma unroll
          for (int i = 0; i < 16; ++i) PB[(unsigned)((mb + crow(i, h)) * 3072 + (n - 2048))] = f2bf(acc.a[a][b][i] * sc);
        }
      }
    }
  }
}

constexpr int A_BUF = 32768, A_KB = 16384, A_FLAGS = 3 * A_BUF;

DI void diffattn_task(const Params& p, unsigned char* lds, int sb  , int qt  , int hd, float lam) {
  const int tid = TIDX, lane = tid & 63, wid = __builtin_amdgcn_readfirstlane(tid >> 6), r = lane & 31, h = lane >> 5;
  unsigned char* ws = p.ws;
  const int cq = wid >> 2, sub = (wid >> 1) & 1, map = wid & 1;
  const int ncq = sb < 0 ? 2 : 1;
  const int base_chunk = sb < 0 ? 2 * qt : 64;
  const int tok0 = sb < 0 ? qt * 128 : TP + sb * 64;
  const bool wvalid = cq < ncq;
  const int qc = base_chunk + cq;
  const int tl = 32 * sub + r;
  const int tok = tok0 + 64 * (wvalid ? cq : 0) + tl;
  const bf16_t* Kb = sb < 0 ? (const bf16_t*)(ws + WS_KBP) + hd * 128 : (const bf16_t*)(ws + WS_KBS) + (size_t)sb * SKV * 1024 + hd * 128;
  const bf16_t* Vb = sb < 0 ? (const bf16_t*)(ws + WS_VTP) + (size_t)hd * 128 * TP : (const bf16_t*)(ws + WS_VTS) + (size_t)(sb * 8 + hd) * 128 * SKV;
  const unsigned ldv = sb < 0 ? TP : SKV;
  const bf16_t* PB = (const bf16_t*)(ws + WS_PB);
  bf16x8 qf[4];
  float qn = 0.f;
  {
    const unsigned qo = (unsigned)tok * 3072u + hd * 128 + map * 64 + 8 * h;
#pragma unroll
    for (int kk = 0; kk < 4; ++kk) {
      const u32x4 u = *(const u32x4*)(PB + (qo + 16 * kk));
      qf[kk] = __builtin_bit_cast(bf16x8, u);
#pragma unroll
      for (int e = 0; e < 4; ++e) { const float a = bflo(u[e]), b = bfhi(u[e]); qn += a * a + b * b; }
    }
    qn += __shfl_xor(qn, 32);
    qn = sqrtf(qn);
  }
  const float kmax = ((const float*)(ws + WS_KMAX))[(sb < 0 ? 0 : 1 + sb) * 16 + hd * 2 + map];
  const float shift = qn * kmax * 1.02f + 0.5f - 40.f;
  const float sl2 = exp2f(-(float)(hd + 1)) * LOG2E;
  const int wd = diff_window(hd);
  const float bh0 = sl2 * (float)(4 * h) - sl2 * (float)tl - shift, bh1 = bh0 + 32.f * sl2;
  float cs[16];
#pragma unroll
  for (int i = 0; i < 16; ++i) cs[i] = __uint_as_float(__builtin_amdgcn_readfirstlane(__float_as_uint(sl2 * (float)((i & 3) + 8 * (i >> 2)))));
  f32x16 O[4];
#pragma unroll
  for (int vt = 0; vt < 4; ++vt) O[vt] = zero16();
  float l = 0.f;
  const int jmax = base_chunk + ncq - 1;
  const int jmin = max(0, base_chunk - wd);
  const int nit = jmax - jmin + 1;
  unsigned kofs[2], vofs[2];
#pragma unroll
  for (int e = 0; e < 2; ++e) {
    const int q = wid * 2 + e;
    { const int row = 4 * q + (lane >> 4), lc = (lane & 15) ^ (row & 15); kofs[e] = (unsigned)row * 1024u + 8u * lc; }
    { const int row = 8 * q + (lane >> 3), lc = (lane & 7) ^ ((row >> 1) & 7); vofs[e] = (unsigned)row * ldv + 8u * lc; }
  }
  auto issue = [&](int j, int buf) {
    const bf16_t* kj = Kb + (size_t)j * 65536;
    const bf16_t* vj = Vb + (size_t)j * 64;
    unsigned char* base = lds + buf * A_BUF;
#pragma unroll
    for (int e = 0; e < 2; ++e) {
      dma16(kj + kofs[e], base + (wid * 2 + e) * 1024);
      dma16(vj + vofs[e], base + A_KB + (wid * 2 + e) * 1024);
    }
  };
  unsigned kco[4], vco[4];
#pragma unroll
  for (int kk = 0; kk < 4; ++kk) kco[kk] = (unsigned)r * 256u + ((((unsigned)(8 * map + 2 * kk + h)) ^ (unsigned)(r & 15)) << 4);
#pragma unroll
  for (int sx = 0; sx < 4; ++sx) vco[sx] = A_KB + (unsigned)r * 128u + ((((unsigned)(2 * sx + h)) ^ (unsigned)((r >> 1) & 7)) << 4);
  asm volatile("s_waitcnt vmcnt(0)" ::: "memory");
  __syncthreads();
  issue(jmax, 0);
  if (nit > 1) issue(jmax - 1, 1);
  for (int it = 0; it < nit; ++it) {
    const int j = jmax - it;
    if (it + 1 < nit) asm volatile("s_waitcnt vmcnt(4)" ::: "memory"); else asm volatile("s_waitcnt vmcnt(0)" ::: "memory");
    asm volatile("s_waitcnt lgkmcnt(0)" ::: "memory");
    __builtin_amdgcn_s_barrier();
    if (it + 2 < nit) issue(j - 2, (it + 2) % 3);
    if (wvalid && j <= qc && qc - j <= wd) {
      const unsigned char* base = lds + (it % 3) * A_BUF;
      const float dofs = sl2 * (float)((qc - j) * 64);
      float sum = 0.f;
#pragma unroll
      for (int half = 0; half < 2; ++half) {
        f32x16 sc;
        {
          float b0 = (half ? bh1 : bh0) - dofs;
          asm volatile("" : "+v"(b0));
#pragma unroll
          for (int i = 0; i < 16; ++i) sc[i] = b0 + cs[i];
        }
        if (j == qc) {
          int tlv = tl;
          asm volatile("" : "+v"(tlv));
          const float m2 = -2.f * sl2, xt = (float)(4 * h + 32 * half - tlv);
#pragma unroll
          for (int i = 0; i < 16; ++i) sc[i] = fmaf(m2, fmaxf(xt + (float)((i & 3) + 8 * (i >> 2)), 0.f), sc[i]);
        }
        {
          bf16x8 kf[4];
#pragma unroll
          for (int kk = 0; kk < 4; ++kk) kf[kk] = ld16(base + 8192 * half + kco[kk]);
#pragma unroll
          for (int kk = 0; kk < 4; ++kk) sc = MFMA32(kf[kk], qf[kk], sc);
        }
        bf16x8 vf[8];
#pragma unroll
        for (int vt = 0; vt < 4; ++vt) { vf[2 * vt] = ld16(base + 4096 * vt + vco[2 * half]); vf[2 * vt + 1] = ld16(base + 4096 * vt + vco[2 * half + 1]); }
#pragma unroll
        for (int i = 0; i < 16; ++i) { sc[i] = fexp2(sc[i]); sum += sc[i]; }
        const bf16x8 p0 = pack_acc(sc, 0), p1 = pack_acc(sc, 1);
#pragma unroll
        for (int vt = 0; vt < 4; ++vt) { O[vt] = MFMA32(vf[2 * vt], p0, O[vt]); O[vt] = MFMA32(vf[2 * vt + 1], p1, O[vt]); }
      }
      l += sum;
    }
  }
  asm volatile("s_waitcnt vmcnt(0)" ::: "memory");
  __syncthreads();
  l += __shfl_xor(l, 32);
  const float inv = wvalid ? 1.f / l : 0.f;
  float* xch = (float*)lds + (size_t)(wid >> 1) * 4096;
  if (map == 1 && wvalid) {
    const float sc = inv * lam;
#pragma unroll
    for (int vt = 0; vt < 4; ++vt)
#pragma unroll
      for (int i = 0; i < 16; ++i) xch[(vt * 16 + i) * 64 + lane] = O[vt][i] * sc;
  }
  __syncthreads();
  if (map == 0 && wvalid) {
    float ss = 0.f;
#pragma unroll
    for (int vt = 0; vt < 4; ++vt)
#pragma unroll
      for (int i = 0; i < 16; ++i) { const float o = O[vt][i] * inv - xch[(vt * 16 + i) * 64 + lane]; O[vt][i] = o; ss += o * o; }
    ss += __shfl_xor(ss, 32);
    const float lam_init = 0.8f - 0.6f * 0.7408182206817179f;
    const float rs = __builtin_amdgcn_rsqf(ss * (1.f / 128.f) + EPS) * (1.f - lam_init);
    const unsigned zo = (unsigned)tok * 3072u + 1024 + hd * 128, oo = (unsigned)tok * 1536u + hd * 128;
    bf16_t* AOp = (bf16_t*)(ws + WS_AO);
    const float* sg = p.in[I_SUBG];
#pragma unroll
    for (int vt = 0; vt < 4; ++vt)
#pragma unroll
      for (int g = 0; g < 4; ++g) {
        const int v = 32 * vt + 8 * g + 4 * h;
        const u32x2 z = *(const u32x2*)(PB + (zo + v));
        const f32x4 gg = *(const f32x4*)(sg + v);
        const float o0 = O[vt][4 * g] * rs * gg[0] * siluf_(bflo(z[0])), o1 = O[vt][4 * g + 1] * rs * gg[1] * siluf_(bfhi(z[0]));
        const float o2 = O[vt][4 * g + 2] * rs * gg[2] * siluf_(bflo(z[1])), o3 = O[vt][4 * g + 3] * rs * gg[3] * siluf_(bfhi(z[1]));
        u32x2 o = {pk2(o0, o1), pk2(o2, o3)};
        *(u32x2*)(AOp + (oo + v)) = o;
      }
  }
  __syncthreads();
}

DI void phase7(const Params& p, unsigned char* lds) {
  unsigned* ctr = (unsigned*)(p.ws + WS_CTR) + 1 + 8 * p.pad;
  const bf16_t* PB = (const bf16_t*)(p.ws + WS_PB);
  float lam;
  {
    const int lane = TIDX & 63;
    const float* lv = p.in[I_LAMB];
    const float a = wave_sum(lv[lane] * lv[64 + lane]), b = wave_sum(lv[128 + lane] * lv[192 + lane]);
    const float lam_init = 0.8f - 0.6f * 0.7408182206817179f;
    lam = __expf(a) - __expf(b) + lam_init;
  }
  const int n_s = 128, n_p = 1024, n_ma = 256 + 64;
  const int* tord = (const int*)(p.ws + WS_TORD);
  for (;;) {
    const int it = next_item(ctr, lds + LDS_BYTES - 16, TIDX);
    if (it >= n_s + n_p) break;
    const int a = tord[it];
    const bool pr = a < n_p;
    diffattn_task(p, lds, pr ? -1 : ((a - n_p) >> 3), pr ? (a >> 3) : 0, a & 7, lam);
  }
  for (;;) {
    const int it = next_item(ctr + 1, lds + LDS_BYTES - 16, TIDX);
    if (it >= n_ma) break;
    memattn_task(p, lds, it, 1, PB + 2048, PB + 2560, 3072);
  }
}

DI void phase9(const Params& p) {
  const int tid = TIDX, lane = tid & 63, wid = tid >> 6;
  const int gw = blockIdx.x * 8 + wid, nw = gridDim.x * 8;
  for (int r = gw; r < TT; r += nw) {
    f32x4 v[4];
    float* row = p.out + O_Y + (size_t)r * 1024;
    const float rstd = row_load_rstd(row, v, lane);
#pragma unroll
    for (int j = 0; j < 4; ++j) {
      const f32x4 g = *(const f32x4*)(p.in[I_FNG] + 4 * lane + 256 * j);
      *(f32x4*)(row + 4 * lane + 256 * j) = v[j] * rstd * g;
    }
  }
}

#define XB_TMO      128
#define XB_XCNT(j)  (256  + 64 * (j))
#define XB_XSUB(j)  (1280 + 64 * (j))
#define XB_XGEN(j)  (2304 + 64 * (j))
#define XB_TOP      3328
#define XB_TOPGEN   3392
#define XB_SPIN_CAP (1u << 20)
DI unsigned xb_ld(unsigned* p)              { return __hip_atomic_load(p, __ATOMIC_RELAXED, __HIP_MEMORY_SCOPE_AGENT); }
DI unsigned xb_add(unsigned* p, unsigned v) { return __hip_atomic_fetch_add(p, v, __ATOMIC_RELAXED, __HIP_MEMORY_SCOPE_AGENT); }
DI unsigned xb_xcc_id() { return (unsigned)__builtin_amdgcn_s_getreg((3 << 11) | 20) & 0xFu; }
#define XB_SPIN(cond, bar) do { unsigned _sp = 0; while (cond) { __builtin_amdgcn_s_sleep(1); \
    if ((++_sp & 255u) == 0u) { if (xb_ld(&(bar)[XB_TMO])) break; if (_sp > XB_SPIN_CAP) { atomicAdd(&(bar)[XB_TMO], 1u); break; } } } } while (0)

DI void xcd_barrier_complete(unsigned* bar, unsigned x, unsigned& nloc, unsigned& nx) {
  const unsigned G = gridDim.x;
  unsigned sum, cnt, mine, sp = 0u;
  for (;;) {
    sum = 0u; cnt = 0u; mine = 0u;
#pragma unroll
    for (unsigned j = 0; j < 16; ++j) { const unsigned c = xb_ld(&bar[XB_XCNT(j)]); sum += c; cnt += (c > 0u) ? 1u : 0u; mine = (j == x) ? c : mine; }
    if (sum == G) break;
    __builtin_amdgcn_s_sleep(1);
    if ((++sp & 255u) == 0u) { if (xb_ld(&bar[XB_TMO])) break; if (sp > XB_SPIN_CAP) { atomicAdd(&bar[XB_TMO], 1u); break; } }
  }
  nloc = mine > 0u ? mine : 1u; nx = cnt > 0u ? cnt : 1u;
}

DI void grid_barrier(unsigned* bar, unsigned x, volatile unsigned* st, int tid) {
  asm volatile("s_waitcnt vmcnt(0)" ::: "memory");
  __syncthreads();
  if (tid == 0) {
    __builtin_amdgcn_s_waitcnt(0);
    unsigned nloc = st[0], nx = st[1];
    if (nloc == 0u) { xcd_barrier_complete(bar, x, nloc, nx); st[0] = nloc; st[1] = nx; }
    const unsigned old = xb_add(&bar[XB_XSUB(x)], 1u);
    const unsigned gen = old / nloc;
    if (old + 1u == (gen + 1u) * nloc) {
      __builtin_amdgcn_fence(__ATOMIC_RELEASE, "agent");
      asm volatile("s_waitcnt vmcnt(0)" ::: "memory");
      const unsigned og = xb_add(&bar[XB_TOP], 1u);
      const unsigned tg = og / nx;
      if (og + 1u == (tg + 1u) * nx) xb_add(&bar[XB_TOPGEN], 1u);
      else XB_SPIN(xb_ld(&bar[XB_TOPGEN]) == tg, bar);
      __builtin_amdgcn_fence(__ATOMIC_ACQUIRE, "agent");
      xb_add(&bar[XB_XGEN(x)], 1u);
      asm volatile("s_waitcnt vmcnt(0)" ::: "memory");
    } else {
      XB_SPIN(xb_ld(&bar[XB_XGEN(x)]) == gen, bar);
      __builtin_amdgcn_fence(__ATOMIC_ACQUIRE, "agent");
      asm volatile("s_waitcnt vmcnt(0)" ::: "memory");
    }
  }
  __syncthreads();
}

__global__ __launch_bounds__(512) void mk(Params pin) {
  extern __shared__ __attribute__((aligned(16))) unsigned char lds[];
  Params p = pin;
  p.wv = __builtin_amdgcn_readfirstlane((int)(__builtin_amdgcn_workitem_id_x() >> 6));
  cg::grid_group grid = cg::this_grid();
  unsigned* bar = (unsigned*)(p.ws + WS_XBAR);
  volatile unsigned* st = (volatile unsigned*)(lds + LDS_BYTES - 64);
  unsigned xcc = 0;
#define RUN_PHASE(PH, CALL) if (p.ph_lo <= PH && PH < p.ph_hi) { CALL; if (PH + 1 < p.ph_hi) grid_barrier(bar, xcc, st, TIDX); }
  if (p.ph_lo <= 0 && 0 < p.ph_hi) { phase0(p, lds); if (1 < p.ph_hi) grid.sync(); }
  {
    xcc = xb_xcc_id();
    __syncthreads();
    if (TIDX == 0) { st[0] = 0u; st[1] = 0u; (void)xb_add(&bar[XB_XCNT(xcc)], 1u); }
    __syncthreads();
  }
  RUN_PHASE(1, phase1(p, lds))
  RUN_PHASE(2, phase2(p, lds))
  if (p.ph_lo <= 2 && 2 < p.ph_hi) { phase2c(p, lds); grid_barrier(bar, xcc, st, TIDX); }
  RUN_PHASE(3, phase3(p))
  RUN_PHASE(4, phase_outproj(p, lds, 0))
  RUN_PHASE(5, phase5(p, lds))
  RUN_PHASE(6, phase6(p, lds))
  RUN_PHASE(7, phase7(p, lds))
  RUN_PHASE(8, phase_outproj(p, lds, 1))
  RUN_PHASE(9, phase9(p))
}

extern "C" void kernel_launch(void* const* d_in, const int* in_sizes, int n_in, void* d_out, int out_size,
                              void* d_ws, size_t ws_size, hipStream_t stream) {
  static int grid_blocks = 0;
  if (!grid_blocks) {
    int dev = 0, cus = 0, per_cu = 0;
    (void)hipGetDevice(&dev);
    (void)hipDeviceGetAttribute(&cus, hipDeviceAttributeMultiprocessorCount, dev);
    (void)hipFuncSetAttribute((const void*)mk, hipFuncAttributeMaxDynamicSharedMemorySize, LDS_BYTES);
    (void)hipOccupancyMaxActiveBlocksPerMultiprocessor(&per_cu, (const void*)mk, NTHREADS, LDS_BYTES);
    grid_blocks = cus;
    fprintf(stderr, "kernel_launch: cus=%d per_cu=%d grid=%d ws=%zu need=%zu\n", cus, per_cu, grid_blocks, ws_size, (size_t)WS_END);
  }
  if (ws_size < WS_END) { fprintf(stderr, "workspace too small\n"); return; }
  Params p{};
  for (int i = 0; i < 24; ++i) p.in[i] = (const float*)d_in[i];
  p.out = (float*)d_out; p.ws = (unsigned char*)d_ws; p.ph_lo = 0; p.ph_hi = NPHASE;
  void* args[] = {&p};
  hipError_t e = hipLaunchCooperativeKernel((const void*)mk, dim3(grid_blocks), dim3(NTHREADS), args, LDS_BYTES, stream);
  if (e != hipSuccess) fprintf(stderr, "cooperative launch failed: %s (grid %d)\n", hipGetErrorString(e), grid_blocks);
  if (PROBE_REP >= 0) {
    Params q = p;
    q.out = (float*)((unsigned char*)d_ws + WS_END); q.ph_lo = PROBE_REP; q.ph_hi = PROBE_REP + 1; q.pad = 1;
    void* args2[] = {&q};
    (void)hipLaunchCooperativeKernel((const void*)mk, dim3(grid_blocks), dim3(NTHREADS), args2, LDS_BYTES, stream);
  }
}
```

```cpp
#include <hip/hip_runtime.h>
#include <hip/hip_cooperative_groups.h>
#include <cstdio>
#include <cstdint>
namespace cg = cooperative_groups;

typedef unsigned short bf16_t;
typedef short bf16x8 __attribute__((ext_vector_type(8)));
typedef short s16x4 __attribute__((ext_vector_type(4)));
typedef float f32x16 __attribute__((ext_vector_type(16)));
typedef float f32x4 __attribute__((ext_vector_type(4)));
typedef float f32x2 __attribute__((ext_vector_type(2)));
typedef __bf16 bf2_t __attribute__((ext_vector_type(2)));
typedef unsigned u32x4 __attribute__((ext_vector_type(4)));
typedef unsigned u32x2 __attribute__((ext_vector_type(2)));
#define DI __device__ __forceinline__
#define MFMA32(a, b, c) __builtin_amdgcn_mfma_f32_32x32x16_bf16((a), (b), (c), 0, 0, 0)

struct Params { const float* in[24]; float* out; unsigned char* ws; int ph_lo, ph_hi; int wv, pad; };
#define TIDX (p.wv * 64 + (int)__builtin_amdgcn_mbcnt_hi(~0u, __builtin_amdgcn_mbcnt_lo(~0u, 0u)))
constexpr int LDS_BYTES = 148480;
constexpr int NTHREADS = 512;
constexpr int NPHASE = 10;
#ifndef PROBE_REP
#define PROBE_REP -1
#endif

constexpr int TP = 16384, TS = 1024, TT = 17408, DM = 1024;
constexpr int NCH = 272;
constexpr int PAST = 4096, SKV = 4160;
constexpr float EPS = 1e-6f;
constexpr float LOG2E = 1.4426950408889634f;
enum { I_XP = 0, I_XS, I_CK, I_CV, I_CMK, I_CMV, I_SC, I_SN, I_SM, I_MEMP, I_NG, I_FNG, I_MNG, I_WMKV, I_WINA, I_BGA, I_HGA, I_WOA,
       I_KVNG, I_WKV, I_WINB, I_LAMB, I_SUBG, I_WOB };
constexpr size_t O_Y = 0, O_PC = 17825792, O_PN = 18087936, O_PM = 18088960, O_PK = 18088964, O_PV = 34866180, O_PMK = 51643396,
                 O_PMV = 51905540, O_SC = 52167684, O_SN = 56361988, O_SM = 56378372, O_SK = 56378436, O_SV = 57427012;
constexpr size_t WS_CTR = 0;
constexpr size_t WS_KMAX = 1024;
constexpr size_t WS_TORD = 8192;
constexpr size_t WS_WA = 16384;
constexpr size_t WS_WOA = WS_WA + (size_t)6144 * 1024 * 2;
constexpr size_t WS_WKB = WS_WOA + (size_t)1024 * 1536 * 2;
constexpr size_t WS_WOB = WS_WKB + (size_t)5120 * 1024 * 2;
constexpr size_t WS_WM = WS_WOB + (size_t)1024 * 1536 * 2;
constexpr size_t WS_MEMN = WS_WM + (size_t)2 * 1024 * 1024 * 2;
constexpr size_t WS_MEMK = WS_MEMN + (size_t)2 * 256 * 1024 * 2;
constexpr size_t WS_MEMVT = WS_MEMK + (size_t)2 * 17 * 256 * 512 * 2;
constexpr size_t WS_GATE = WS_MEMVT + (size_t)2 * 17 * 256 * 512 * 2;
constexpr size_t SZ_CH = (size_t)NCH * 4 * 64 * 4;
constexpr size_t WS_GC = WS_GATE + (size_t)TT * 8 * 4;
constexpr size_t WS_MT = WS_GC + SZ_CH;
constexpr size_t WS_WS = WS_MT + SZ_CH;
constexpr size_t WS_WI = WS_WS + SZ_CH;
constexpr size_t WS_AS = WS_WI + SZ_CH;
constexpr size_t WS_BT = WS_AS + SZ_CH;
constexpr size_t WS_DEC = WS_BT + SZ_CH;
constexpr size_t WS_DENI = WS_DEC + 8192;
constexpr size_t WS_DENA = WS_DENI + (size_t)TT * 4 * 4;
constexpr size_t WS_XN = WS_DENA + (size_t)TT * 4 * 4;
constexpr size_t WS_AO = WS_XN + (size_t)TT * 1024 * 2;
constexpr size_t WS_Y1 = WS_AO + (size_t)TT * 1536 * 2;
constexpr size_t WS_KT = WS_Y1 + (size_t)TT * 1024 * 4;
constexpr size_t WS_VTA = WS_KT + (size_t)NCH * 4 * 256 * 64 * 2;
constexpr size_t WS_R1 = WS_VTA + (size_t)NCH * 4 * 256 * 64 * 2;
constexpr size_t SZ_R1 = (size_t)TT * 6144 * 2;
constexpr size_t WS_PB = WS_R1;
constexpr size_t WS_KBP = WS_PB + (size_t)TT * 3072 * 2;
constexpr size_t WS_VTP = WS_KBP + (size_t)TP * 1024 * 2;
constexpr size_t WS_R2 = WS_R1 + SZ_R1;
constexpr size_t WS_HINTER = WS_R2;
constexpr size_t WS_HINTRA = WS_R2 + (size_t)TT * 1024 * 4;
constexpr size_t WS_KBS = WS_R2;
constexpr size_t WS_VTS = WS_KBS + (size_t)16 * SKV * 1024 * 2;
constexpr size_t WS_WVT = WS_VTS + (size_t)16 * SKV * 1024 * 2;
constexpr size_t WS_U = WS_WVT + (size_t)NCH * 4 * 288 * 64 * 2;
constexpr size_t WS_CFAC = WS_U + SZ_CH;
constexpr size_t WS_CLOCC = WS_CFAC + 8192;
constexpr size_t WS_PM = WS_CLOCC + (size_t)256 * 4 * 9 * 8 * 2 * 64 * 16;
constexpr size_t WS_CHS = WS_PM + SZ_CH;
constexpr size_t WS_LD = WS_CHS + 16384;
constexpr size_t WS_CLOC = WS_LD + 8192;
constexpr size_t WS_XBAR = WS_CLOC + (size_t)16 * 36 * 8 * 64 * 16 * 4;
constexpr size_t WS_END = WS_XBAR + 16384;
constexpr int GRP = 16;
static_assert(WS_VTP + (size_t)TP * 1024 * 2 <= WS_R2, "R1 overflow");

DI unsigned pk2(float lo, float hi) { f32x2 v = {lo, hi}; return __builtin_bit_cast(unsigned, __builtin_convertvector(v, bf2_t)); }
DI bf16_t f2bf(float x) { return (bf16_t)(pk2(x, 0.f) & 0xffffu); }
DI float bf2f(unsigned v16) { return __uint_as_float(v16 << 16); }
DI float bflo(unsigned u) { return __uint_as_float(u << 16); }
DI float bfhi(unsigned u) { return __uint_as_float(u & 0xffff0000u); }
DI float rbf(float x) { return bflo(pk2(x, 0.f) & 0xffffu); }
DI int crow(int i, int h) { return (i & 3) + 8 * (i >> 2) + 4 * h; }
DI float wave_sum(float v) {
#pragma unroll
  for (int o = 32; o >= 1; o >>= 1) v += __shfl_xor(v, o);
  return v;
}
DI float fexp2(float x) { return __builtin_amdgcn_exp2f(x); }
DI float fexp(float x) { return __builtin_amdgcn_exp2f(x * LOG2E); }
DI float sigmoidf_(float x) { return 1.f / (1.f + __expf(-x)); }
DI float siluf_(float x) { return x / (1.f + __expf(-x)); }
DI bf16x8 pack_acc(const f32x16& x, int s) {
  u32x4 p;
  p[0] = pk2(x[8 * s + 0], x[8 * s + 1]); p[1] = pk2(x[8 * s + 2], x[8 * s + 3]);
  p[2] = pk2(x[8 * s + 4], x[8 * s + 5]); p[3] = pk2(x[8 * s + 6], x[8 * s + 7]);
  return __builtin_bit_cast(bf16x8, p);
}
DI bf16x8 ld16(const void* p) { return *(const bf16x8*)p; }
DI bf16x8 ld8x2(const void* p0, const void* p1) {
  u32x2 a = *(const u32x2*)p0, b = *(const u32x2*)p1; u32x4 r = {a[0], a[1], b[0], b[1]};
  return __builtin_bit_cast(bf16x8, r);
}
DI f32x16 zero16() { f32x16 z; for (int i = 0; i < 16; ++i) z[i] = 0.f; return z; }

DI void transpose_tile(const float* __restrict__ src, size_t ld_s, bf16_t* __restrict__ dst, size_t ld_d, const float* __restrict__ scale,
                       float* scr, int t, bool perm = false) {
  {
    const int c4 = t & 31, rb = t >> 5;
    f32x4 v[4];
#pragma unroll
    for (int i = 0; i < 4; ++i) v[i] = *(const f32x4*)(src + (size_t)(rb + 16 * i) * ld_s + 4 * c4);
#pragma unroll
    for (int i = 0; i < 4; ++i) {
      const int r = rb + 16 * i;
      f32x4 x = v[i];
      if (scale) { const float sc = scale[r]; x = x * sc; }
      float* d = scr + r * 129 + 4 * c4; d[0] = x[0]; d[1] = x[1]; d[2] = x[2]; d[3] = x[3];
    }
  }
  __syncthreads();
#pragma unroll
  for (int i = 0; i < 2; ++i) {
    const int id = t + 512 * i, c = id >> 3, rg = id & 7;
    const float* s = scr + (8 * rg) * 129 + c;
    u32x4 o; o[0] = pk2(s[0], s[129]); o[1] = pk2(s[2 * 129], s[3 * 129]); o[2] = pk2(s[4 * 129], s[5 * 129]); o[3] = pk2(s[6 * 129], s[7 * 129]);
    if (!perm) *(u32x4*)(dst + (size_t)c * ld_d + 8 * rg) = o;
    else {
      bf16_t* d = dst + (size_t)c * ld_d + 16 * (rg >> 1) + 4 * (rg & 1);
      u32x2 lo = {o[0], o[1]}, hi = {o[2], o[3]};
      *(u32x2*)d = lo; *(u32x2*)(d + 8) = hi;
    }
  }
  __syncthreads();
}

struct TJob { const float* src; size_t ld_s; bf16_t* dst; size_t ld_d; const float* scale; int tr, tc; };

DI void run_tjob_tile(const TJob& j, int tile, float* scr, int tid, bool perm = false) {
  const int ir = tile / j.tc, ic = tile % j.tc;
  transpose_tile(j.src + (size_t)(64 * ir) * j.ld_s + 128 * ic, j.ld_s, j.dst + (size_t)(128 * ic) * j.ld_d + 64 * ir, j.ld_d,
                 j.scale ? j.scale + 64 * ir : nullptr, scr, tid, perm);
}

DI float row_load_rstd(const float* xrow, f32x4 (&v)[4], int lane) {
  float ss = 0.f;
#pragma unroll
  for (int j = 0; j < 4; ++j) { v[j] = *(const f32x4*)(xrow + 4 * lane + 256 * j); ss += v[j][0] * v[j][0] + v[j][1] * v[j][1] + v[j][2] * v[j][2] + v[j][3] * v[j][3]; }
  ss = wave_sum(ss);
  return __builtin_amdgcn_rsqf(ss * (1.f / 1024.f) + EPS);
}

DI int diff_window(int hd) { const float sl2 = exp2f(-(float)(hd + 1)) * LOG2E; return (int)floorf((63.f + 192.f / sl2) * (1.f / 64.f)); }
DI int diff_est(int a) {
  const int hd = a & 7;
  const int w = diff_window(hd) + (a < 1024 ? 2 : 1);
  const int n = a < 1024 ? 2 * (a >> 3) + 2 : 65;
  return n < w ? n : w;
}

DI void phase0(const Params& p, unsigned char* lds) {
  const int tid = TIDX, lane = tid & 63, wid = tid >> 6;
  unsigned char* ws = p.ws;
  if (blockIdx.x == 0 && tid < 64) ((unsigned*)(ws + WS_CTR))[tid] = 0u;
  if (blockIdx.x == 0 && tid < 272) ((unsigned*)(ws + WS_KMAX))[tid] = 0u;
  if (blockIdx.x == 0) for (int i = tid; i < 4096; i += NTHREADS) ((unsigned*)(ws + WS_XBAR))[i] = 0u;
  if (blockIdx.x == gridDim.x - 1) {
    int* est = (int*)lds;
    for (int a = tid; a < 1152; a += NTHREADS) est[a] = diff_est(a);
    __syncthreads();
    for (int a = tid; a < 1152; a += NTHREADS) {
      const int ea = est[a];
      int rank = 0;
      for (int b = 0; b < 1152; ++b) { const int eb = est[b]; rank += (eb > ea) || (eb == ea && b < a); }
      ((int*)(ws + WS_TORD))[rank] = a;
    }
    __syncthreads();
  }
  {
    TJob jobs[8];
    jobs[0] = {p.in[I_WINA], 6152, (bf16_t*)(ws + WS_WA), 1024, p.in[I_NG], 16, 40};
    jobs[1] = {p.in[I_WINA] + 5128, 6152, (bf16_t*)(ws + WS_WA) + (size_t)5120 * 1024, 1024, p.in[I_NG], 16, 8};
    jobs[2] = {p.in[I_WOA], 1024, (bf16_t*)(ws + WS_WOA), 1536, nullptr, 24, 8};
    jobs[3] = {p.in[I_WKV], 2048, (bf16_t*)(ws + WS_WKB), 1024, p.in[I_KVNG], 16, 16};
    jobs[4] = {p.in[I_WINB], 3072, (bf16_t*)(ws + WS_WKB) + (size_t)2048 * 1024, 1024, p.in[I_NG] + 1024, 16, 24};
    jobs[5] = {p.in[I_WOB], 1024, (bf16_t*)(ws + WS_WOB), 1536, nullptr, 24, 8};
    jobs[6] = {p.in[I_WMKV], 1024, (bf16_t*)(ws + WS_WM), 1024, nullptr, 16, 8};
    jobs[7] = {p.in[I_WMKV] + (size_t)1024 * 1024, 1024, (bf16_t*)(ws + WS_WM) + (size_t)1024 * 1024, 1024, nullptr, 16, 8};
    int base = 0;
#pragma unroll
    for (int j = 0; j < 8; ++j) {
      if (j >= 2 && j <= 5) continue;
      const int n = jobs[j].tr * jobs[j].tc;
      if (blockIdx.x >= 16) for (int t = blockIdx.x - 16; t < n; t += gridDim.x - 16) run_tjob_tile(jobs[j], t, (float*)lds, tid);
      base += n;
    }
    if (blockIdx.x >= 16) for (int t = blockIdx.x - 16; t < 128 * 4; t += gridDim.x - 16) {
      const int jb = t >> 2, tile = t & 3, l = jb >> 6, b = (jb >> 2) & 15, h = jb & 3;
      TJob j = {p.in[I_CMV] + ((size_t)(l * 16 + b) * 256) * 512 + h * 128, 512,
                (bf16_t*)(ws + WS_MEMVT) + ((size_t)(l * 17 + 1 + b) * 4 + h) * 128 * 256, 256, nullptr, 4, 1};
      run_tjob_tile(j, tile, (float*)lds, tid, true);
    }
  }
  {
    const size_t n8 = (size_t)2 * 16 * 256 * 512 / 8;
    for (size_t i = (size_t)blockIdx.x * NTHREADS + tid; i < n8; i += (size_t)gridDim.x * NTHREADS) {
      const size_t e = i * 8; const int l = (int)(e / ((size_t)16 * 131072)); const size_t rem = e - (size_t)l * 16 * 131072;
      const f32x4 a = *(const f32x4*)(p.in[I_CMK] + e), b = *(const f32x4*)(p.in[I_CMK] + e + 4);
      u32x4 o = {pk2(a[0], a[1]), pk2(a[2], a[3]), pk2(b[0], b[1]), pk2(b[2], b[3])};
      *(u32x4*)((bf16_t*)(ws + WS_MEMK) + ((size_t)(l * 17 + 1) * 131072) + rem) = o;
    }
  }
  {
    const int gw = blockIdx.x * 8 + wid, nw = gridDim.x * 8;
    const float* ng = p.in[I_NG];
    float* gwt = (float*)(lds + 32768);
    float* sg = (float*)(lds + 32768 + 36864);
    __syncthreads();
    for (int i = tid; i < 8192; i += NTHREADS) { const int k = i >> 3, c = i & 7; gwt[k * 8 + (k >> 2) * 4 + c] = p.in[I_WINA][(size_t)k * 6152 + 5120 + c] * ng[k]; }
    __syncthreads();
    for (int cc = blockIdx.x; cc < NCH; cc += gridDim.x) {
      f32x4 vn[4];
      {
        const int r0 = cc * 64 + wid * 8;
        const float* x0 = r0 < TP ? p.in[I_XP] + (size_t)r0 * 1024 : p.in[I_XS] + (size_t)(r0 - TP) * 1024;
#pragma unroll
        for (int j = 0; j < 4; ++j) vn[j] = *(const f32x4*)(x0 + 4 * lane + 256 * j);
      }
      for (int ri = 0; ri < 8; ++ri) {
        const int r = cc * 64 + wid * 8 + ri;
        f32x4 v[4];
#pragma unroll
        for (int j = 0; j < 4; ++j) v[j] = vn[j];
        if (ri + 1 < 8) {
          const float* x1 = (r + 1) < TP ? p.in[I_XP] + (size_t)(r + 1) * 1024 : p.in[I_XS] + (size_t)(r + 1 - TP) * 1024;
#pragma unroll
          for (int j = 0; j < 4; ++j) vn[j] = *(const f32x4*)(x1 + 4 * lane + 256 * j);
        }
        float ssq = 0.f;
#pragma unroll
        for (int j = 0; j < 4; ++j) ssq += v[j][0] * v[j][0] + v[j][1] * v[j][1] + v[j][2] * v[j][2] + v[j][3] * v[j][3];
        const float rstd = __builtin_amdgcn_rsqf(wave_sum(ssq) * (1.f / 1024.f) + EPS);
        float gacc[8];
#pragma unroll
        for (int c = 0; c < 8; ++c) gacc[c] = 0.f;
        bf16_t* xn = (bf16_t*)(ws + WS_XN) + (size_t)r * 1024;
#pragma unroll
        for (int j = 0; j < 4; ++j) {
          const int k0 = 4 * lane + 256 * j;
          const f32x4 xs = v[j] * rstd;
          u32x2 o = {pk2(xs[0], xs[1]), pk2(xs[2], xs[3])};
          *(u32x2*)(xn + k0) = o;
#pragma unroll
          for (int e = 0; e < 4; ++e) {
            const float* wr = gwt + (k0 + e) * 8 + (k0 >> 2) * 4;
            const f32x4 w0 = *(const f32x4*)wr, w1 = *(const f32x4*)(wr + 4);
            gacc[0] += xs[e] * w0[0]; gacc[1] += xs[e] * w0[1]; gacc[2] += xs[e] * w0[2]; gacc[3] += xs[e] * w0[3];
            gacc[4] += xs[e] * w1[0]; gacc[5] += xs[e] * w1[1]; gacc[6] += xs[e] * w1[2]; gacc[7] += xs[e] * w1[3];
          }
        }
#pragma unroll
        for (int c = 0; c < 8; ++c) gacc[c] = wave_sum(gacc[c]);
        if (lane < 8) {
          float gv = gacc[0];
#pragma unroll
          for (int c = 1; c < 8; ++c) gv = lane == c ? gacc[c] : gv;
          gv += p.in[I_BGA][lane];
          if (lane >= 4) gv = fminf(gv, 0.f) - log1pf(__expf(-fabsf(gv)));
          sg[(wid * 8 + ri) * 8 + lane] = gv;
        }
      }
      __syncthreads();
      if (wid < 4) {
        const int hd = wid, pr = cc * 4 + hd;
        const float ig = sg[lane * 8 + hd], lf = sg[lane * 8 + 4 + hd];
        float g = lf;
#pragma unroll
        for (int o = 1; o < 64; o <<= 1) { const float t = __shfl_up(g, o); if (lane >= o) g += t; }
        const float a = ig - g;
        float pm = a;
#pragma unroll
        for (int o = 1; o < 64; o <<= 1) { const float t = __shfl_up(pm, o); if (lane >= o) pm = fmaxf(pm, t); }
        const size_t o = (size_t)pr * 64 + lane;
        ((float*)(ws + WS_GC))[o] = g;
        ((float*)(ws + WS_AS))[o] = a;
        ((float*)(ws + WS_PM))[o] = pm;
        if (lane == 63) { ((float*)(ws + WS_CHS))[pr * 2] = g; ((float*)(ws + WS_CHS))[pr * 2 + 1] = pm; }
        const float u = __expf(a - __shfl(pm, 63));
        ((float*)(ws + WS_U))[o] = u;
        bf16_t* wr = (bf16_t*)(ws + WS_WVT) + ((size_t)pr * 288 + 256) * 64 + lane;
        wr[0] = f2bf(u);
#pragma unroll 4
        for (int rr = 1; rr < 32; ++rr) wr[rr * 64] = 0;
      }
      __syncthreads();
    }
    for (int r = gw; r < 512; r += nw) {
      const int l = r >> 8, rr = r & 255;
      f32x4 v[4];
      const float rstd = row_load_rstd(p.in[I_MEMP] + (size_t)rr * 1024, v, lane);
      bf16_t* o = (bf16_t*)(ws + WS_MEMN) + (size_t)r * 1024;
#pragma unroll
      for (int j = 0; j < 4; ++j) {
        const int k0 = 4 * lane + 256 * j;
        const f32x4 g = *(const f32x4*)(p.in[I_MNG] + l * 1024 + k0);
        const f32x4 xs = v[j] * rstd * g;
        u32x2 ov = {pk2(xs[0], xs[1]), pk2(xs[2], xs[3])};
        *(u32x2*)(o + k0) = ov;
      }
    }
  }
}

constexpr int G_STAGE = 49152;
struct GemmAcc { f32x16 a[2][2]; };
DI void dma16(const void* g, unsigned char* l) { __builtin_amdgcn_global_load_lds((const unsigned*)g, (unsigned*)l, 16, 0, 0); }

template <int NB = 2>
DI void gemm_tile(const bf16_t* __restrict__ A, size_t lda, const bf16_t* __restrict__ Bt, size_t ldb, int K, unsigned char* lds, GemmAcc& acc, int tid) {
  const int lane = tid & 63, wid = __builtin_amdgcn_readfirstlane(tid >> 6), r = lane & 31, h = lane >> 5;
  const int wr = wid >> 1, wc = wid & 1;
#pragma unroll
  for (int a = 0; a < 2; ++a)
#pragma unroll
    for (int b = 0; b < 2; ++b) acc.a[a][b] = zero16();
  const int nk = K / 64;
  unsigned aoff[4], boff[2];
#pragma unroll
  for (int e = 0; e < 4; ++e) { const int row = 8 * (wid * 4 + e) + (lane >> 3), lc = (lane & 7) ^ ((row >> 1) & 7); aoff[e] = (unsigned)row * (unsigned)lda + 8u * lc; }
#pragma unroll
  for (int e = 0; e < NB; ++e) { const int row = 8 * (wid * NB + e) + (lane >> 3), lc = (lane & 7) ^ ((row >> 1) & 7); boff[e] = (unsigned)row * (unsigned)ldb + 8u * lc; }
  auto issue = [&](int kt, int buf) {
    unsigned char* base = lds + buf * G_STAGE;
#pragma unroll
    for (int e = 0; e < 4; ++e) dma16(A + (aoff[e] + 64u * kt), base + (wid * 4 + e) * 1024);
#pragma unroll
    for (int e = 0; e < NB; ++e) dma16(Bt + (boff[e] + 64u * kt), base + 32768 + (wid * NB + e) * 1024);
  };
  asm volatile("s_waitcnt vmcnt(0)" ::: "memory");
  __syncthreads();
  issue(0, 0);
  if (nk > 1) issue(1, 1);
  const unsigned sw = (r >> 1) & 7;
  unsigned co[4];
#pragma unroll
  for (int kk = 0; kk < 4; ++kk) co[kk] = (((2 * kk + h) ^ sw) << 4);
  const unsigned ra = (wr * 64 + r) * 128, rb = 32768 + (wc * 32 * NB + r) * 128;
  for (int kt = 0; kt < nk; ++kt) {
    if (kt + 1 < nk) { if (NB == 2) asm volatile("s_waitcnt vmcnt(6)" ::: "memory"); else asm volatile("s_waitcnt vmcnt(5)" ::: "memory"); }
    else asm volatile("s_waitcnt vmcnt(0)" ::: "memory");
    asm volatile("s_waitcnt lgkmcnt(0)" ::: "memory");
    __builtin_amdgcn_s_barrier();
    if (kt + 2 < nk) issue(kt + 2, (kt + 2) % 3);
    const unsigned char* base = lds + (kt % 3) * G_STAGE;
    const unsigned char* pa = base + ra;
    const unsigned char* pb = base + rb;
#pragma unroll
    for (int kk = 0; kk < 4; ++kk) {
      const bf16x8 a0 = ld16(pa + co[kk]), a1 = ld16(pa + 4096 + co[kk]);
      const bf16x8 b0 = ld16(pb + co[kk]);
      acc.a[0][0] = MFMA32(a0, b0, acc.a[0][0]);
      acc.a[1][0] = MFMA32(a1, b0, acc.a[1][0]);
      if (NB == 2) {
        const bf16x8 b1 = ld16(pb + 4096 + co[kk]);
        acc.a[0][1] = MFMA32(a0, b1, acc.a[0][1]);
        acc.a[1][1] = MFMA32(a1, b1, acc.a[1][1]);
      }
    }
    __builtin_amdgcn_sched_group_barrier(0x100, 2 + NB, 0);
    __builtin_amdgcn_sched_group_barrier(0x100, 2 + NB, 0); __builtin_amdgcn_sched_group_barrier(0x008, 2 * NB, 0);
    __builtin_amdgcn_sched_group_barrier(0x100, 2 + NB, 0); __builtin_amdgcn_sched_group_barrier(0x008, 2 * NB, 0);
    __builtin_amdgcn_sched_group_barrier(0x100, 2 + NB, 0); __builtin_amdgcn_sched_group_barrier(0x008, 2 * NB, 0);
    __builtin_amdgcn_sched_group_barrier(0x008, 2 * NB, 0);
  }
}

DI void gemm256(const bf16_t* __restrict__ A, size_t lda, const bf16_t* __restrict__ Bt, size_t ldb, int K, unsigned char* lds, GemmAcc (&acc)[2], int tid) {
  const int lane = tid & 63, wid = __builtin_amdgcn_readfirstlane(tid >> 6), r = lane & 31, h = lane >> 5;
  const int wr = wid >> 2, wc = wid & 3;
#pragma unroll
  for (int mh = 0; mh < 2; ++mh)
#pragma unroll
    for (int a = 0; a < 2; ++a)
#pragma unroll
      for (int b = 0; b < 2; ++b) acc[mh].a[a][b] = zero16();
  const int nk = K / 64;
  unsigned aoff[4], boff[4];
#pragma unroll
  for (int e = 0; e < 4; ++e) {
    const int row = 8 * (wid * 4 + e) + (lane >> 3), lc = (lane & 7) ^ ((row >> 1) & 7);
    aoff[e] = (unsigned)row * (unsigned)lda + 8u * lc; boff[e] = (unsigned)row * (unsigned)ldb + 8u * lc;
  }
  auto issue = [&](int kt, int buf) {
    unsigned char* base = lds + buf * 65536;
#pragma unroll
    for (int e = 0; e < 4; ++e) { dma16(A + (aoff[e] + 64u * kt), base + (wid * 4 + e) * 1024); dma16(Bt + (boff[e] + 64u * kt), base + 32768 + (wid * 4 + e) * 1024); }
  };
  asm volatile("s_waitcnt vmcnt(0)" ::: "memory");
  __syncthreads();
  issue(0, 0);
  const unsigned sw = (r >> 1) & 7;
  unsigned co[4];
#pragma unroll
  for (int kk = 0; kk < 4; ++kk) co[kk] = (((2 * kk + h) ^ sw) << 4);
  const unsigned ra = (wr * 128 + r) * 128, rb = 32768 + (wc * 64 + r) * 128;
  for (int kt = 0; kt < nk; ++kt) {
    asm volatile("s_waitcnt vmcnt(0)" ::: "memory");
    asm volatile("s_waitcnt lgkmcnt(0)" ::: "memory");
    __builtin_amdgcn_s_barrier();
    if (kt + 1 < nk) issue(kt + 1, (kt + 1) & 1);
    const unsigned char* base = lds + (kt & 1) * 65536;
    const unsigned char* pa = base + ra;
    const unsigned char* pb = base + rb;
#pragma unroll
    for (int kk = 0; kk < 4; ++kk) {
      const bf16x8 b0 = ld16(pb + co[kk]), b1 = ld16(pb + 4096 + co[kk]);
#pragma unroll
      for (int mh = 0; mh < 2; ++mh) {
        const bf16x8 a0 = ld16(pa + 8192 * mh + co[kk]), a1 = ld16(pa + 8192 * mh + 4096 + co[kk]);
        acc[mh].a[0][0] = MFMA32(a0, b0, acc[mh].a[0][0]);
        acc[mh].a[0][1] = MFMA32(a0, b1, acc[mh].a[0][1]);
        acc[mh].a[1][0] = MFMA32(a1, b0, acc[mh].a[1][0]);
        acc[mh].a[1][1] = MFMA32(a1, b1, acc[mh].a[1][1]);
      }
    }
#define SGB_R(N) __builtin_amdgcn_sched_group_barrier(0x100, N, 0)
#define SGB_M(N) __builtin_amdgcn_sched_group_barrier(0x008, N, 0)
    SGB_R(4);
    SGB_R(2); SGB_M(4); SGB_R(4); SGB_M(4);
    SGB_R(2); SGB_M(4); SGB_R(4); SGB_M(4);
    SGB_R(2); SGB_M(4); SGB_R(4); SGB_M(4);
    SGB_R(2); SGB_M(4); SGB_M(4);
  }
}

DI void gate_scan(const Params& p, unsigned char* lds) {
  const int tid = TIDX, lane = tid & 63, wid = tid >> 6;
  unsigned char* ws = p.ws;
  float* s_ch = (float*)lds;
  float* s_mc = s_ch + NCH * 8;
  float* s_mn = s_mc + NCH * 4;
  __syncthreads();
  for (int i = tid; i < NCH * 8; i += NTHREADS) s_ch[i] = ((const float*)(ws + WS_CHS))[i];
  __syncthreads();
  if (tid < 4) {
    float m = 0.f, ld = 0.f;
    float* LD = (float*)(ws + WS_LD);
    const bool wr = blockIdx.x == 0;
#pragma unroll 8
    for (int c = 0; c < 256; ++c) {
      s_mc[c * 4 + tid] = m; if (wr) LD[c * 4 + tid] = ld;
      const float gl = s_ch[(c * 4 + tid) * 2], mn = gl + fmaxf(m, s_ch[(c * 4 + tid) * 2 + 1]);
      ld += gl + m - mn;
      m = mn; s_mn[c * 4 + tid] = m;
    }
    if (wr) { LD[256 * 4 + tid] = ld; p.out[O_PM + tid] = m; }
  } else if (tid >= 64 && tid < 128) {
    const int b = (tid - 64) >> 2, hd = tid & 3, pr = (256 + b) * 4 + hd;
    const float m0 = p.in[I_SM][b * 4 + hd];
    const float m = s_ch[pr * 2] + fmaxf(m0, s_ch[pr * 2 + 1]);
    s_mc[pr] = m0; s_mn[pr] = m;
    if (blockIdx.x == 0) p.out[O_SM + b * 4 + hd] = m;
  }
  __syncthreads();
  for (int cc = blockIdx.x; cc < NCH; cc += gridDim.x) {
    if (wid < 4) {
      const int hd = wid, pr = cc * 4 + hd;
      const size_t o = (size_t)pr * 64 + lane;
      const float g = ((const float*)(ws + WS_GC))[o], a = ((const float*)(ws + WS_AS))[o], pm = ((const float*)(ws + WS_PM))[o];
      const float mc = s_mc[pr], mn = s_mn[pr], gl = s_ch[pr * 2];
      const float mt = g + fmaxf(mc, pm);
      ((float*)(ws + WS_MT))[o] = mt;
      ((float*)(ws + WS_WS))[o] = __expf(gl + a - mn);
      ((float*)(ws + WS_WI))[o] = __expf(g + mc - mt);
      ((float*)(ws + WS_AS))[o] = a * LOG2E;
      ((float*)(ws + WS_BT))[o] = (g - mt) * LOG2E;
      if (lane == 0) { ((float*)(ws + WS_DEC))[pr] = __expf(gl + mc - mn); const float amx = s_ch[pr * 2 + 1]; ((float*)(ws + WS_CFAC))[pr] = __expf(amx - fmaxf(mc, amx)); }
    }
  }
  __syncthreads();
}

DI void phase1(const Params& p, unsigned char* lds) {
  const int tid = TIDX, lane = tid & 63, wid = tid >> 6, r = lane & 31, h = lane >> 5;
  unsigned char* ws = p.ws;
  gate_scan(p, lds);
  const int n_main = 68 * 24, n_mem = 16;
  for (int t = blockIdx.x; t < n_main + n_mem; t += gridDim.x) {
    if (t < n_main) {
      const int tm = t / 24, tn = t % 24, m0 = tm * 256, n0 = tn * 256;
      GemmAcc acc2[2];
      gemm256((const bf16_t*)(ws + WS_XN) + (size_t)m0 * 1024, 1024, (const bf16_t*)(ws + WS_WA) + (size_t)n0 * 1024, 1024, 1024, lds, acc2, tid);
#pragma unroll
      for (int mh = 0; mh < 2; ++mh) {
      const GemmAcc& acc = acc2[mh];
      const int wr = (wid >> 2) * 2 + mh, wc = wid & 3;
      bf16_t* PA = (bf16_t*)(ws + WS_R1);
      const int sec = n0 >> 10;
#pragma unroll
      for (int a = 0; a < 2; ++a)
#pragma unroll
        for (int b = 0; b < 2; ++b) {
          __builtin_amdgcn_sched_barrier(0);
          const int n = n0 + wc * 64 + 32 * b + r, mb = m0 + wr * 64 + 32 * a;
          if (sec != 2) {
            const float sc = sec == 1 ? 0.0625f : 1.f;
            const int pc = (n >> 2) & 3, np = sec <= 1 ? (n & ~15) + 4 * (((pc & 1) << 1) | (pc >> 1)) + (n & 3) : n;
#pragma unroll
            for (int i = 0; i < 16; ++i) PA[(size_t)(mb + crow(i, h)) * 6144 + np] = f2bf(acc.a[a][b][i] * sc);
          }
          if (sec == 1 || sec == 2) {
            const float sc = sec == 1 ? 0.0625f : 1.f;
            const int f = n & 1023, hd = f >> 8, fe = f & 255;
            bf16_t* T = (bf16_t*)(ws + (sec == 1 ? WS_KT : WS_VTA));
#pragma unroll
            for (int g = 0; g < 4; ++g) {
              const int m = mb + 8 * g + 4 * h, cc = m >> 6, s = m & 63;
              u32x2 o = {pk2(acc.a[a][b][4 * g] * sc, acc.a[a][b][4 * g + 1] * sc), pk2(acc.a[a][b][4 * g + 2] * sc, acc.a[a][b][4 * g + 3] * sc)};
              *(u32x2*)(T + (((size_t)cc * 4 + hd) * 256 + fe) * 64 + s) = o;
              if (sec == 2) {
                const f32x4 u = *(const f32x4*)((const float*)(ws + WS_U) + ((size_t)cc * 4 + hd) * 64 + s);
                u32x2 ow = {pk2(acc.a[a][b][4 * g] * u[0], acc.a[a][b][4 * g + 1] * u[1]), pk2(acc.a[a][b][4 * g + 2] * u[2], acc.a[a][b][4 * g + 3] * u[3])};
                *(u32x2*)((bf16_t*)(ws + WS_WVT) + (((size_t)cc * 4 + hd) * 288 + fe) * 64 + s) = ow;
              }
            }
          }
        }
      }
    } else {
      GemmAcc acc;
      const int wr = wid >> 1, wc = wid & 1;
      const int tt = t - n_main, l = tt >> 3, n0 = (tt & 7) * 128;
      gemm_tile((const bf16_t*)(ws + WS_MEMN) + (size_t)l * 256 * 1024, 1024, (const bf16_t*)(ws + WS_WM) + ((size_t)l * 1024 + n0) * 1024, 1024, 1024, lds, acc, tid);
      const bool isv = n0 >= 512;
      float* of = p.out + (isv ? O_PMV : O_PMK) + (size_t)l * 131072;
      bf16_t* mk = (bf16_t*)(ws + WS_MEMK) + (size_t)(l * 17) * 131072;
      bf16_t* mv = (bf16_t*)(ws + WS_MEMVT) + (size_t)(l * 17) * 131072;
#pragma unroll
      for (int a = 0; a < 2; ++a)
#pragma unroll
        for (int b = 0; b < 2; ++b) {
          __builtin_amdgcn_sched_barrier(0);
          const int f = (n0 & 511) + wc * 64 + 32 * b + r, mb = wr * 64 + 32 * a;
#pragma unroll
          for (int g = 0; g < 4; ++g) {
            const int m = mb + 8 * g + 4 * h;
            float* o4 = of + (size_t)m * 512 + f;
            o4[0] = acc.a[a][b][4 * g]; o4[512] = acc.a[a][b][4 * g + 1]; o4[1024] = acc.a[a][b][4 * g + 2]; o4[1536] = acc.a[a][b][4 * g + 3];
            if (!isv) {
              bf16_t* k4 = mk + (size_t)m * 512 + f;
              k4[0] = f2bf(acc.a[a][b][4 * g]); k4[512] = f2bf(acc.a[a][b][4 * g + 1]); k4[1024] = f2bf(acc.a[a][b][4 * g + 2]); k4[1536] = f2bf(acc.a[a][b][4 * g + 3]);
            } else {
              u32x2 o = {pk2(acc.a[a][b][4 * g], acc.a[a][b][4 * g + 1]), pk2(acc.a[a][b][4 * g + 2], acc.a[a][b][4 * g + 3])};
              const int pq = (m >> 2) & 3, mp = (m & ~15) + 4 * (((pq & 1) << 1) | (pq >> 1));
              *(u32x2*)(mv + (size_t)f * 256 + mp) = o;
            }
          }
        }
    }
  }
}

DI void scan_task(const Params& p, unsigned char* lds, int sb  , int hd, int j, int grp) {
  const int tid = TIDX, lane = tid & 63, wid = tid >> 6, r = lane & 31, h = lane >> 5;
  unsigned char* ws = p.ws;
  const int cc0 = sb < 0 ? GRP * grp : 256 + sb, nch = sb < 0 ? GRP : 1;
  const bf16_t* PA = (const bf16_t*)(ws + WS_R1);
  const bf16_t* KT = (const bf16_t*)(ws + WS_KT);
  const bf16_t* VT = (const bf16_t*)(ws + WS_VTA);
  const float* WSa = (const float*)(ws + WS_WS);
  const float* WIa = (const float*)(ws + WS_WI);
  const float* DEC = (const float*)(ws + WS_DEC);
  float* red = (float*)lds;
  const bool nsl = j == 8;
  f32x16 S = zero16();
  if (sb >= 0) {
    if (!nsl) {
      const float* C0 = p.in[I_SC] + ((size_t)(sb * 4 + hd) * 256 + 32 * j + r) * 256 + 32 * wid;
#pragma unroll
      for (int g = 0; g < 4; ++g) { const f32x4 c = *(const f32x4*)(C0 + 8 * g + 4 * h); S[4 * g] = c[0]; S[4 * g + 1] = c[1]; S[4 * g + 2] = c[2]; S[4 * g + 3] = c[3]; }
    } else if (r == 0) {
      const float* n0 = p.in[I_SN] + (size_t)(sb * 4 + hd) * 256 + 32 * wid;
#pragma unroll
      for (int g = 0; g < 4; ++g) { const f32x4 c = *(const f32x4*)(n0 + 8 * g + 4 * h); S[4 * g] = c[0]; S[4 * g + 1] = c[1]; S[4 * g + 2] = c[2]; S[4 * g + 3] = c[3]; }
    }
  }
  bf16x8 kt[4], wv[4], qf[2][2];
  u32x4 ktn[4], vn[4], qn[2][2];
  float wsn;
  float* wsl = (float*)(lds + 69632);
  auto loadraw = [&](int cc) {
    const size_t ch = (size_t)cc * 4 + hd;
    const bf16_t* kp = KT + (ch * 256 + 32 * wid + r) * 64 + 8 * h;
#pragma unroll
    for (int st = 0; st < 4; ++st) ktn[st] = *(const u32x4*)(kp + 16 * st);
    wsn = WSa[ch * 64 + lane];
    if (!nsl) {
      const bf16_t* vp = VT + (ch * 256 + 32 * j + r) * 64 + 8 * h;
#pragma unroll
      for (int st = 0; st < 4; ++st) vn[st] = *(const u32x4*)(vp + 16 * st);
    }
#pragma unroll
    for (int tt = 0; tt < 2; ++tt) {
      const bf16_t* qp = PA + (size_t)(cc * 64 + 32 * tt + r) * 6144 + hd * 256 + 32 * wid + 8 * h;
#pragma unroll
      for (int s2 = 0; s2 < 2; ++s2) qn[tt][s2] = *(const u32x4*)(qp + 16 * s2);
    }
  };
  auto convert = [&]() {
    __syncthreads();
    if (wid == 0) wsl[lane] = wsn;
    __syncthreads();
#pragma unroll
    for (int st = 0; st < 4; ++st) {
      kt[st] = __builtin_bit_cast(bf16x8, ktn[st]);
      const f32x4 w0 = *(const f32x4*)(wsl + 16 * st + 8 * h), w1 = *(const f32x4*)(wsl + 16 * st + 8 * h + 4);
      u32x4 o;
      if (!nsl) {
        const u32x4 v = vn[st];
        o[0] = pk2(bflo(v[0]) * w0[0], bfhi(v[0]) * w0[1]); o[1] = pk2(bflo(v[1]) * w0[2], bfhi(v[1]) * w0[3]);
        o[2] = pk2(bflo(v[2]) * w1[0], bfhi(v[2]) * w1[1]); o[3] = pk2(bflo(v[3]) * w1[2], bfhi(v[3]) * w1[3]);
      } else {
        o = (u32x4){pk2(w0[0], w0[1]), pk2(w0[2], w0[3]), pk2(w1[0], w1[1]), pk2(w1[2], w1[3])};
        if (r != 0) o = (u32x4){0u, 0u, 0u, 0u};
      }
      wv[st] = __builtin_bit_cast(bf16x8, o);
    }
#pragma unroll
    for (int tt = 0; tt < 2; ++tt)
#pragma unroll
      for (int s2 = 0; s2 < 2; ++s2) qf[tt][s2] = __builtin_bit_cast(bf16x8, qn[tt][s2]);
  };
  loadraw(cc0);
  convert();
  for (int c = 0; c < nch; ++c) {
    const int cc = cc0 + c;
    if (c + 1 < nch) loadraw(cc + 1);
    const float dec = DEC[cc * 4 + hd];
    const bf16x8 xs0 = pack_acc(S, 0), xs1 = pack_acc(S, 1);
    f32x16 z0 = MFMA32(xs0, qf[0][0], zero16()); z0 = MFMA32(xs1, qf[0][1], z0);
    f32x16 z1 = MFMA32(xs0, qf[1][0], zero16()); z1 = MFMA32(xs1, qf[1][1], z1);
    S = S * dec;
#pragma unroll
    for (int st = 0; st < 4; ++st) S = MFMA32(kt[st], wv[st], S);
    __syncthreads();
    {
      float* rw = red + wid * (64 * 33);
#pragma unroll
      for (int i = 0; i < 16; ++i) { rw[r * 33 + crow(i, h)] = z0[i]; rw[(32 + r) * 33 + crow(i, h)] = z1[i]; }
    }
    __syncthreads();
    {
      const int v = tid & 31;
#pragma unroll
      for (int e = 0; e < 4; ++e) {
        const int t = (tid >> 5) + 16 * e;
        float s = 0.f;
#pragma unroll
        for (int w8 = 0; w8 < 8; ++w8) s += red[w8 * (64 * 33) + t * 33 + v];
        const float wi = WIa[((size_t)cc * 4 + hd) * 64 + t];
        if (!nsl) ((float*)(ws + WS_HINTER))[(size_t)(cc * 64 + t) * 1024 + hd * 256 + 32 * j + v] = s * wi;
        else if (v == 0) ((float*)(ws + WS_DENI))[(size_t)(cc * 64 + t) * 4 + hd] = s * wi;
      }
    }
    if (c + 1 < nch) convert();
  }
  if (sb < 0) {
    float* cl = (float*)(ws + WS_CLOC) + ((((size_t)(grp * 4 + hd) * 9 + j) * 8 + wid) * 64 + lane) * 16;
#pragma unroll
    for (int g = 0; g < 4; ++g) { f32x4 c = {S[4 * g], S[4 * g + 1], S[4 * g + 2], S[4 * g + 3]}; *(f32x4*)(cl + 4 * g) = c; }
  } else {
    if (!nsl) {
      float* Co = (sb < 0 ? p.out + O_PC + (size_t)hd * 65536 : p.out + O_SC + (size_t)(sb * 4 + hd) * 65536) + (size_t)(32 * j + r) * 256 + 32 * wid;
#pragma unroll
      for (int g = 0; g < 4; ++g) { f32x4 c = {S[4 * g], S[4 * g + 1], S[4 * g + 2], S[4 * g + 3]}; *(f32x4*)(Co + 8 * g + 4 * h) = c; }
    } else if (r == 0) {
      float* no = (sb < 0 ? p.out + O_PN + (size_t)hd * 256 : p.out + O_SN + (size_t)(sb * 4 + hd) * 256) + 32 * wid;
#pragma unroll
      for (int g = 0; g < 4; ++g) { f32x4 c = {S[4 * g], S[4 * g + 1], S[4 * g + 2], S[4 * g + 3]}; *(f32x4*)(no + 8 * g + 4 * h) = c; }
    }
  }
  __syncthreads();
}

DI void intra_task(const Params& p, int cc, int hd) {
  const int tid = TIDX, lane = tid & 63, wid = tid >> 6, r = lane & 31, h = lane >> 5;
  unsigned char* ws = p.ws;
  const int tt = wid & 1, vq = wid >> 1;
  const bf16_t* PA = (const bf16_t*)(ws + WS_R1);
  const bf16_t* VT = (const bf16_t*)(ws + WS_VTA);
  const size_t ch = (size_t)cc * 4 + hd;
  f32x16 s0 = zero16(), s1 = zero16();
  {
    const bf16_t* qp = PA + (size_t)(cc * 64 + 32 * tt + r) * 6144 + hd * 256 + 8 * h;
    const bf16_t* kp = PA + (size_t)(cc * 64 + r) * 6144 + 1024 + hd * 256 + 8 * h;
#pragma unroll 4
    for (int kk = 0; kk < 16; ++kk) {
      const bf16x8 q = ld16(qp + 16 * kk), k0 = ld16(kp + 16 * kk), k1 = ld16(kp + (size_t)32 * 6144 + 16 * kk);
      s0 = MFMA32(k0, q, s0);
      if (tt == 1) s1 = MFMA32(k1, q, s1);
    }
  }
  const int t = 32 * tt + r;
  const float bt = ((const float*)(ws + WS_BT))[ch * 64 + t];
  const float* asp = (const float*)(ws + WS_AS) + ch * 64;
  float den = 0.f;
#pragma unroll
  for (int g = 0; g < 4; ++g) {
    const f32x4 a0 = *(const f32x4*)(asp + 8 * g + 4 * h);
    const f32x4 a1 = *(const f32x4*)(asp + 32 + 8 * g + 4 * h);
#pragma unroll
    for (int e = 0; e < 4; ++e) {
      const int s = 8 * g + 4 * h + e;
      const float w0 = s <= t ? fexp2(bt + a0[e]) : 0.f;
      const float w1 = (32 + s) <= t ? fexp2(bt + a1[e]) : 0.f;
      s0[4 * g + e] *= w0; s1[4 * g + e] *= w1;
      den += s0[4 * g + e] + s1[4 * g + e];
    }
  }
  den += __shfl_xor(den, 32);
  if (vq == 0 && h == 0) ((float*)(ws + WS_DENA))[(size_t)(cc * 64 + t) * 4 + hd] = den;
  bf16x8 pf[2][2];
  pf[0][0] = pack_acc(s0, 0); pf[0][1] = pack_acc(s0, 1); pf[1][0] = pack_acc(s1, 0); pf[1][1] = pack_acc(s1, 1);
  float* Ho = (float*)(ws + WS_HINTRA) + (size_t)(cc * 64 + t) * 1024 + hd * 256;
#pragma unroll
  for (int vt = 0; vt < 2; ++vt) {
    const int v0 = vq * 64 + vt * 32;
    const bf16_t* vp = VT + (ch * 256 + v0 + r) * 64 + 4 * h;
    f32x16 o = zero16();
#pragma unroll
    for (int st = 0; st < 2; ++st)
#pragma unroll
      for (int s2 = 0; s2 < 2; ++s2) {
        const bf16x8 a = ld8x2(vp + 32 * st + 16 * s2, vp + 32 * st + 16 * s2 + 8);
        o = MFMA32(a, pf[st][s2], o);
      }
#pragma unroll
    for (int g = 0; g < 4; ++g) { f32x4 c = {o[4 * g], o[4 * g + 1], o[4 * g + 2], o[4 * g + 3]}; *(f32x4*)(Ho + v0 + 8 * g + 4 * h) = c; }
  }
}

DI void memattn_task(const Params& p, unsigned char* lds, int task, int layer, const bf16_t* Qb, const bf16_t* Zb, unsigned ldq) {
  const int tid = TIDX, lane = tid & 63, wid = __builtin_amdgcn_readfirstlane(tid >> 6), r = lane & 31, h = lane >> 5;
  unsigned char* ws = p.ws;
  const bool prm = task < 256;
  const int hd = task & 3, ti = prm ? task >> 2 : (task - 256) >> 2;
  const int sbi = prm ? 0 : 1 + ti, tok0 = prm ? ti * 256 : TP + ti * 64, nact = prm ? 8 : 2;
  const bf16_t* MK = (const bf16_t*)(ws + WS_MEMK) + (size_t)(layer * 17 + sbi) * 131072 + hd * 128;
  const bf16_t* MV = (const bf16_t*)(ws + WS_MEMVT) + ((size_t)(layer * 17 + sbi) * 4 + hd) * 128 * 256;
  asm volatile("s_waitcnt vmcnt(0)" ::: "memory");
  __syncthreads();
#pragma unroll
  for (int e = 0; e < 8; ++e) {
    const int q = wid * 8 + e;
    { const int row = 4 * q + (lane >> 4), lc = (lane & 15) ^ (row & 15); dma16(MK + ((unsigned)row * 512u + 8u * lc), lds + q * 1024); }
    { const int row = 2 * q + (lane >> 5), lc = (lane & 31) ^ (row & 15); dma16(MV + ((unsigned)row * 256u + 8u * lc), lds + 65536 + q * 1024); }
  }
  const int tok = tok0 + (wid < nact ? wid : 0) * 32 + r;
  bf16x8 qf[8];
  {
    const bf16_t* qp = Qb + ((unsigned)tok * ldq + hd * 128 + 8 * h);
#pragma unroll
    for (int kk = 0; kk < 8; ++kk) qf[kk] = ld16(qp + 16 * kk);
  }
  asm volatile("s_waitcnt vmcnt(0)" ::: "memory");
  __syncthreads();
  if (wid >= nact) return;
  const float sc = 0.08838834764831845f * LOG2E;
  f32x16 O[4];
#pragma unroll
  for (int vt = 0; vt < 4; ++vt) O[vt] = zero16();
  float mrun = -1e30f, l = 0.f;
  const unsigned sw = r & 15;
#pragma unroll 1
  for (int kb = 0; kb < 4; ++kb) {
    f32x16 s0 = zero16(), s1 = zero16();
    const unsigned char* kp = lds + (kb * 64 + r) * 256;
#pragma unroll
    for (int kk = 0; kk < 8; ++kk) {
      const unsigned co = ((unsigned)(2 * kk + h) ^ sw) << 4;
      const bf16x8 k0 = ld16(kp + co), k1 = ld16(kp + 8192 + co);
      s0 = MFMA32(k0, qf[kk], s0); s1 = MFMA32(k1, qf[kk], s1);
    }
    float mx = -1e30f;
#pragma unroll
    for (int i = 0; i < 16; ++i) mx = fmaxf(mx, fmaxf(s0[i], s1[i]));
    mx = fmaxf(mx, __shfl_xor(mx, 32)) * sc;
    const float mnew = fmaxf(mrun, mx), alpha = fexp2(mrun - mnew);
    mrun = mnew;
    float sum = 0.f;
#pragma unroll
    for (int i = 0; i < 16; ++i) { s0[i] = fexp2(s0[i] * sc - mnew); s1[i] = fexp2(s1[i] * sc - mnew); sum += s0[i] + s1[i]; }
    l = l * alpha + sum;
#pragma unroll
    for (int vt = 0; vt < 4; ++vt) O[vt] = O[vt] * alpha;
    bf16x8 pf[2][2];
    pf[0][0] = pack_acc(s0, 0); pf[0][1] = pack_acc(s0, 1); pf[1][0] = pack_acc(s1, 0); pf[1][1] = pack_acc(s1, 1);
#pragma unroll
    for (int vt = 0; vt < 4; ++vt) {
      const unsigned char* vp = lds + 65536 + (32 * vt + r) * 512;
#pragma unroll
      for (int st = 0; st < 2; ++st)
#pragma unroll
        for (int s2 = 0; s2 < 2; ++s2) {
          const unsigned co = ((unsigned)(8 * kb + 4 * st + 2 * s2 + h) ^ sw) << 4;
          O[vt] = MFMA32(ld16(vp + co), pf[st][s2], O[vt]);
        }
    }
  }
  l += __shfl_xor(l, 32);
  const float inv = 1.f / l;
  const bf16_t* zp = Zb + ((unsigned)tok * ldq + hd * 128);
  bf16_t* op = (bf16_t*)(ws + WS_AO) + ((unsigned)tok * 1536u + 1024 + hd * 128);
#pragma unroll
  for (int vt = 0; vt < 4; ++vt)
#pragma unroll
    for (int g = 0; g < 4; ++g) {
      const int v = 32 * vt + 8 * g + 4 * h;
      const u32x2 z = *(const u32x2*)(zp + v);
      const float o0 = O[vt][4 * g] * inv * siluf_(bflo(z[0])), o1 = O[vt][4 * g + 1] * inv * siluf_(bfhi(z[0]));
      const float o2 = O[vt][4 * g + 2] * inv * siluf_(bflo(z[1])), o3 = O[vt][4 * g + 3] * inv * siluf_(bfhi(z[1]));
      u32x2 o = {pk2(o0, o1), pk2(o2, o3)};
      *(u32x2*)(op + v) = o;
    }
}

DI int next_item(unsigned* ctr, unsigned char* lds_flag_area, int tid) {
  __syncthreads();
  int* sh = (int*)lds_flag_area;
  if (tid == 0) *sh = (int)atomicAdd(ctr, 1u);
  __syncthreads();
  const int v = *sh;
  return v;
}

DI void scanA_task(const Params& p, int hd, int j, int grp);

DI void late_weight_item(const Params& p, unsigned char* lds, int it) {
  unsigned char* ws = p.ws;
  TJob j; int t = it;
  if (t < 192) j = {p.in[I_WOA], 1024, (bf16_t*)(ws + WS_WOA), 1536, nullptr, 24, 8};
  else if (t < 448) { t -= 192; j = {p.in[I_WKV], 2048, (bf16_t*)(ws + WS_WKB), 1024, p.in[I_KVNG], 16, 16}; }
  else if (t < 832) { t -= 448; j = {p.in[I_WINB], 3072, (bf16_t*)(ws + WS_WKB) + (size_t)2048 * 1024, 1024, p.in[I_NG] + 1024, 16, 24}; }
  else { t -= 832; j = {p.in[I_WOB], 1024, (bf16_t*)(ws + WS_WOB), 1536, nullptr, 24, 8}; }
  run_tjob_tile(j, t, (float*)lds, TIDX);
}

DI void phase2(const Params& p, unsigned char* lds) {
  unsigned* ctr = (unsigned*)(p.ws + WS_CTR) + 0 + 8 * p.pad;
  const bf16_t* PA = (const bf16_t*)(p.ws + WS_R1);
  const int n_ps = 36 * 16, n_ss = 576, n_in = NCH * 4, n_ma = 256 + 64;
  for (;;) {
    const int it = next_item(ctr, lds + LDS_BYTES - 16, TIDX);
    if (it >= n_ps + n_ss + n_in + n_ma + 1024) break;
    if (it >= n_ps + n_ss + n_in + n_ma) { late_weight_item(p, lds, it - (n_ps + n_ss + n_in + n_ma)); continue; }
    if (it < n_ps) scanA_task(p, (it % 36) / 9, it % 9, it / 36);
    else if (it < n_ps + n_ss) { const int q = it - n_ps; scan_task(p, lds, q / 36, (q % 36) / 9, q % 9, 0); }
    else if (it < n_ps + n_ss + n_in) { const int q = it - n_ps - n_ss; intra_task(p, q >> 2, q & 3); }
    else { const int q = it - n_ps - n_ss - n_in; memattn_task(p, lds, q, 0, PA + 5120, PA + 5632, 6144); }
  }
}


DI void scanA_task(const Params& p, int hd, int j, int grp) {
  const int tid = TIDX, lane = tid & 63, wid = tid >> 6, r = lane & 31, h = lane >> 5;
  unsigned char* ws = p.ws;
  const bf16_t* KT = (const bf16_t*)(ws + WS_KT);
  const bf16_t* WV = (const bf16_t*)(ws + WS_WVT);
  f32x16 S = zero16();
  u32x4 kn[4], vn[4];
  auto load = [&](int cc) {
    const size_t ch = (size_t)cc * 4 + hd;
    const bf16_t* kp = KT + (ch * 256 + 32 * wid + r) * 64 + 8 * h;
    const bf16_t* vp = WV + (ch * 288 + 32 * j + r) * 64 + 8 * h;
#pragma unroll
    for (int st = 0; st < 4; ++st) { kn[st] = *(const u32x4*)(kp + 16 * st); vn[st] = *(const u32x4*)(vp + 16 * st); }
  };
  load(GRP * grp);
#pragma unroll 1
  for (int c = 0; c < GRP; ++c) {
    const int cc = GRP * grp + c;
    bf16x8 kt[4], wv[4];
#pragma unroll
    for (int st = 0; st < 4; ++st) { kt[st] = __builtin_bit_cast(bf16x8, kn[st]); wv[st] = __builtin_bit_cast(bf16x8, vn[st]); }
    if (c + 1 < GRP) load(cc + 1);
    u32x4* cl = (u32x4*)(ws + WS_CLOCC) + ((((size_t)cc * 4 + hd) * 9 + j) * 8 + wid) * 128 + lane;
    cl[0] = __builtin_bit_cast(u32x4, pack_acc(S, 0));
    cl[64] = __builtin_bit_cast(u32x4, pack_acc(S, 1));
    f32x16 D = zero16();
#pragma unroll
    for (int st = 0; st < 4; ++st) D = MFMA32(kt[st], wv[st], D);
    const float dec = ((const float*)(ws + WS_DEC))[cc * 4 + hd], cf = ((const float*)(ws + WS_CFAC))[cc * 4 + hd];
    S = S * dec + D * cf;
  }
  float* cl = (float*)(ws + WS_CLOC) + ((((size_t)(grp * 4 + hd) * 9 + j) * 8 + wid) * 64 + lane) * 16;
#pragma unroll
  for (int g = 0; g < 4; ++g) { f32x4 c = {S[4 * g], S[4 * g + 1], S[4 * g + 2], S[4 * g + 3]}; *(f32x4*)(cl + 4 * g) = c; }
}

DI void scanfix_task(const Params& p, unsigned char* lds, int grp, int hd, int j) {
  const int tid = TIDX, lane = tid & 63, wid = tid >> 6, r = lane & 31, h = lane >> 5;
  unsigned char* ws = p.ws;
  const bool nsl = j == 8;
  const float* LD = (const float*)(ws + WS_LD);
  f32x16 S = zero16();
#pragma unroll 4
  for (int gp = 0; gp < grp; ++gp) {
    const float dg = __expf(LD[(GRP * (gp + 1)) * 4 + hd] - LD[(GRP * gp) * 4 + hd]);
    const float* cl = (const float*)(ws + WS_CLOC) + ((((size_t)(gp * 4 + hd) * 9 + j) * 8 + wid) * 64 + lane) * 16;
#pragma unroll
    for (int g = 0; g < 4; ++g) { const f32x4 c = *(const f32x4*)(cl + 4 * g);
      S[4 * g] = S[4 * g] * dg + c[0]; S[4 * g + 1] = S[4 * g + 1] * dg + c[1]; S[4 * g + 2] = S[4 * g + 2] * dg + c[2]; S[4 * g + 3] = S[4 * g + 3] * dg + c[3]; }
  }
  if (grp == 16) {
    if (!nsl) {
      float* Co = p.out + O_PC + (size_t)hd * 65536 + (size_t)(32 * j + r) * 256 + 32 * wid;
#pragma unroll
      for (int g = 0; g < 4; ++g) { f32x4 c = {S[4 * g], S[4 * g + 1], S[4 * g + 2], S[4 * g + 3]}; *(f32x4*)(Co + 8 * g + 4 * h) = c; }
    } else if (r == 0) {
      float* no = p.out + O_PN + (size_t)hd * 256 + 32 * wid;
#pragma unroll
      for (int g = 0; g < 4; ++g) { f32x4 c = {S[4 * g], S[4 * g + 1], S[4 * g + 2], S[4 * g + 3]}; *(f32x4*)(no + 8 * g + 4 * h) = c; }
    }
    return;
  }
  u32x4* fr = (u32x4*)lds;
  float* tp = (float*)(lds + 16384) + wid * (64 * 33);
  __syncthreads();
  fr[(wid * 2 + 0) * 64 + lane] = __builtin_bit_cast(u32x4, pack_acc(S, 0));
  fr[(wid * 2 + 1) * 64 + lane] = __builtin_bit_cast(u32x4, pack_acc(S, 1));
  __syncthreads();
  const bf16_t* PA = (const bf16_t*)(ws + WS_R1);
  const float* WIa = (const float*)(ws + WS_WI);
  const bool hasg = grp > 0;
#pragma unroll
  for (int ci = 0; ci < 2; ++ci) {
    const int cc = GRP * grp + wid + 8 * ci;
    const float D = __expf(LD[cc * 4 + hd] - LD[(GRP * grp) * 4 + hd]);
    const u32x4* clc = (const u32x4*)(ws + WS_CLOCC) + (((size_t)cc * 4 + hd) * 9 + j) * 8 * 128 + lane;
#pragma unroll
    for (int tt = 0; tt < 2; ++tt) {
      const bf16_t* qp = PA + (size_t)(cc * 64 + 32 * tt + r) * 6144 + hd * 256 + 8 * h;
      f32x16 z = zero16(), z2 = zero16();
#pragma unroll
      for (int kt = 0; kt < 8; ++kt)
#pragma unroll
        for (int s2 = 0; s2 < 2; ++s2) {
          const bf16x8 q = ld16(qp + 32 * kt + 16 * s2);
          z = MFMA32(__builtin_bit_cast(bf16x8, clc[(kt * 2 + s2) * 64]), q, z);
          if (hasg) z2 = MFMA32(__builtin_bit_cast(bf16x8, fr[(kt * 2 + s2) * 64 + lane]), q, z2);
        }
#pragma unroll
      for (int i = 0; i < 16; ++i) tp[(32 * tt + r) * 33 + crow(i, h)] = z[i] + D * z2[i];
    }
    const int v = lane & 31;
#pragma unroll 4
    for (int e = 0; e < 32; ++e) {
      const int t = 2 * e + (lane >> 5);
      const float val = tp[t * 33 + v] * WIa[((size_t)cc * 4 + hd) * 64 + t];
      if (!nsl) ((float*)(ws + WS_HINTER))[(size_t)(cc * 64 + t) * 1024 + hd * 256 + 32 * j + v] = val;
      else if (v == 0) ((float*)(ws + WS_DENI))[(size_t)(cc * 64 + t) * 4 + hd] = val;
    }
  }
}

DI void phase2c(const Params& p, unsigned char* lds) {
  unsigned* ctr = (unsigned*)(p.ws + WS_CTR) + 3 + 8 * p.pad;
  for (;;) {
    const int it = next_item(ctr, lds + LDS_BYTES - 16, TIDX);
    if (it >= 17 * 36) break;
    const int g = 16 - it / 36;
    scanfix_task(p, lds, g, (it % 36) / 9, it % 9);
  }
}

DI void phase3(const Params& p) {
  const int tid = TIDX, lane = tid & 63, wid = tid >> 6;
  unsigned char* ws = p.ws;
  const int gw = blockIdx.x * 8 + wid, nw = gridDim.x * 8;
  const bf16_t* PA = (const bf16_t*)(ws + WS_R1);
  for (int it = gw; it < TT * 4; it += nw) {
    const int tok = it >> 2, hd = it & 3, cc = tok >> 6, t = tok & 63;
    const size_t off = (size_t)tok * 1024 + hd * 256 + 4 * lane;
    const f32x4 a = *(const f32x4*)((const float*)(ws + WS_HINTER) + off), b = *(const f32x4*)((const float*)(ws + WS_HINTRA) + off);
    const float den = ((const float*)(ws + WS_DENI))[tok * 4 + hd] + ((const float*)(ws + WS_DENA))[tok * 4 + hd];
    const float mt = ((const float*)(ws + WS_MT))[((size_t)cc * 4 + hd) * 64 + t];
    const float dn = 1.f / fmaxf(fabsf(den), __expf(-mt));
    const u32x2 ou = *(const u32x2*)(PA + (size_t)tok * 6144 + 3072 + hd * 256 + 4 * lane);
    const u32x2 zu = *(const u32x2*)(PA + (size_t)tok * 6144 + 4096 + hd * 256 + 4 * lane);
    f32x4 hv = (a + b) * dn;
    hv[0] *= sigmoidf_(bflo(ou[0])); hv[1] *= sigmoidf_(bfhi(ou[0])); hv[2] *= sigmoidf_(bflo(ou[1])); hv[3] *= sigmoidf_(bfhi(ou[1]));
    float ss = hv[0] * hv[0] + hv[1] * hv[1] + hv[2] * hv[2] + hv[3] * hv[3];
    ss = wave_sum(ss);
    const float rstd = __builtin_amdgcn_rsqf(ss * (1.f / 256.f) + EPS);
    const f32x4 hg = *(const f32x4*)(p.in[I_HGA] + hd * 256 + 4 * lane);
    hv = hv * rstd * hg;
    hv[0] *= siluf_(bflo(zu[0])); hv[1] *= siluf_(bfhi(zu[0])); hv[2] *= siluf_(bflo(zu[1])); hv[3] *= siluf_(bfhi(zu[1]));
    u32x2 o = {pk2(hv[0], hv[1]), pk2(hv[2], hv[3])};
    *(u32x2*)((bf16_t*)(ws + WS_AO) + (size_t)tok * 1536 + hd * 256 + 4 * lane) = o;
  }
}

DI void cacheconv_item(const Params& p, unsigned char* lds, int it);

DI void phase_outproj(const Params& p, unsigned char* lds, int layer) {
  const int tid = TIDX, lane = tid & 63, wid = tid >> 6, r = lane & 31, h = lane >> 5, wr = wid >> 1, wc = wid & 1;
  unsigned char* ws = p.ws;
  const bf16_t* W = (const bf16_t*)(ws + (layer == 0 ? WS_WOA : WS_WOB));
  for (int t = blockIdx.x; t < 512 + 64; t += gridDim.x) {
    GemmAcc acc;
    int m0, n0, nb;
    if (t < 512) {
      m0 = (t >> 3) * 256; n0 = (t & 7) * 128; nb = 2;
      gemm_tile<2>((const bf16_t*)(ws + WS_AO) + (size_t)m0 * 1536, 1536, W + (size_t)n0 * 1536, 1536, 1536, lds, acc, tid);
    } else {
      const int q = t - 512;
      m0 = (64 + (q >> 4)) * 256; n0 = (q & 15) * 64; nb = 1;
      gemm_tile<1>((const bf16_t*)(ws + WS_AO) + (size_t)m0 * 1536, 1536, W + (size_t)n0 * 1536, 1536, 1536, lds, acc, tid);
    }
#pragma unroll
    for (int a = 0; a < 2; ++a)
#pragma unroll
      for (int b = 0; b < 2; ++b) {
        if (b >= nb) continue;
        const int n = n0 + wc * 32 * nb + 32 * b + r, mb = m0 + wr * 64 + 32 * a;
#pragma unroll
        for (int i = 0; i < 16; ++i) {
          const int m = mb + crow(i, h);
          if (layer == 0) {
            const float xv = m < TP ? p.in[I_XP][(size_t)m * 1024 + n] : p.in[I_XS][(size_t)(m - TP) * 1024 + n];
            ((float*)(ws + WS_Y1))[(size_t)m * 1024 + n] = xv + acc.a[a][b][i];
          } else {
            p.out[O_Y + (size_t)m * 1024 + n] = ((const float*)(ws + WS_Y1))[(size_t)m * 1024 + n] + acc.a[a][b][i];
          }
        }
      }
  }
  if (layer == 0) {
    unsigned* ctr = (unsigned*)(p.ws + WS_CTR) + 4 + 8 * p.pad;
    for (;;) {
      const int it = next_item(ctr, lds + LDS_BYTES - 16, TIDX);
      if (it >= 1024) break;
      cacheconv_item(p, lds, it);
    }
  }
}

DI void phase5(const Params& p, unsigned char* lds) {
  const int tid = TIDX, lane = tid & 63, wid = tid >> 6;
  unsigned char* ws = p.ws;
  const int gw = blockIdx.x * 8 + wid, nw = gridDim.x * 8;
  for (int r = gw; r < TT; r += nw) {
    f32x4 v[4];
    const float rstd = row_load_rstd((const float*)(ws + WS_Y1) + (size_t)r * 1024, v, lane);
    bf16_t* xn = (bf16_t*)(ws + WS_XN) + (size_t)r * 1024;
#pragma unroll
    for (int j = 0; j < 4; ++j) { const f32x4 xs = v[j] * rstd; u32x2 o = {pk2(xs[0], xs[1]), pk2(xs[2], xs[3])}; *(u32x2*)(xn + 4 * lane + 256 * j) = o; }
  }
}

DI void cacheconv_item(const Params& p, unsigned char* lds, int it) {
  const int tid = TIDX;
  unsigned char* ws = p.ws;
  if (it < 512) {
    const int b = it >> 5, slab = it & 31;
    float* smax = (float*)lds;
    const int hm = (tid & 127) >> 3;
    __syncthreads();
    if (tid < 16) smax[tid] = 0.f;
    __syncthreads();
    float mx = 0.f;
    const float* src = p.in[I_CK] + ((size_t)b * PAST + slab * 128) * 1024;
    bf16_t* dst = (bf16_t*)(ws + WS_KBS) + ((size_t)b * SKV + slab * 128) * 1024;
#pragma unroll 4
    for (int i = 0; i < 32; ++i) {
      const unsigned e = (unsigned)(i * NTHREADS + tid) * 8u;
      const f32x4 a = *(const f32x4*)(src + e), c = *(const f32x4*)(src + e + 4);
      u32x4 o = {pk2(a[0], a[1]), pk2(a[2], a[3]), pk2(c[0], c[1]), pk2(c[2], c[3])};
      *(u32x4*)(dst + e) = o;
      float ss = a[0] * a[0] + a[1] * a[1] + a[2] * a[2] + a[3] * a[3] + c[0] * c[0] + c[1] * c[1] + c[2] * c[2] + c[3] * c[3];
      ss += __shfl_xor(ss, 1); ss += __shfl_xor(ss, 2); ss += __shfl_xor(ss, 4);
      mx = fmaxf(mx, ss);
    }
    if ((tid & 7) == 0) atomicMax((unsigned*)smax + hm, __float_as_uint(mx));
    __syncthreads();
    if (tid < 16) atomicMax((unsigned*)(ws + WS_KMAX) + (1 + b) * 16 + tid, __float_as_uint(sqrtf(smax[tid])));
  } else {
    const int q = it - 512, jb = q >> 2, part = q & 3, b = jb >> 3, hd = jb & 7;
    TJob j = {p.in[I_CV] + (size_t)b * PAST * 1024 + hd * 128, 1024, (bf16_t*)(ws + WS_VTS) + ((size_t)(b * 8 + hd) * 128) * SKV, SKV, nullptr, 64, 1};
    for (int tile = part * 16; tile < part * 16 + 16; ++tile) run_tjob_tile(j, tile, (float*)lds, tid, true);
  }
}

DI void phase6(const Params& p, unsigned char* lds) {
  const int tid = TIDX, lane = tid & 63, wid = tid >> 6, r = lane & 31, h = lane >> 5;
  unsigned char* ws = p.ws;
  for (int t = blockIdx.x; t < 68 * 20; t += gridDim.x) {
    const int tm = t / 20, tn = t % 20, m0 = tm * 256, n0 = tn * 256;
    GemmAcc acc2[2];
    gemm256((const bf16_t*)(ws + WS_XN) + (size_t)m0 * 1024, 1024, (const bf16_t*)(ws + WS_WKB) + (size_t)n0 * 1024, 1024, 1024, lds, acc2, tid);
    const int sec = n0 >> 10;
    const bool samp = m0 >= TP;
#pragma unroll
    for (int mh = 0; mh < 2; ++mh) {
    const GemmAcc& acc = acc2[mh];
    const int wr = (wid >> 2) * 2 + mh, wc = wid & 3;
#pragma unroll
    for (int a = 0; a < 2; ++a)
#pragma unroll
      for (int b = 0; b < 2; ++b) {
        __builtin_amdgcn_sched_barrier(0);
        const int n = n0 + wc * 64 + 32 * b + r, mb = m0 + wr * 64 + 32 * a;
        if (sec == 0) {
          const int f = n;
          if (b == 1) {
            float mx = 0.f;
#pragma unroll
            for (int i = 0; i < 16; ++i) {
              float ss = acc.a[a][0][i] * acc.a[a][0][i] + acc.a[a][1][i] * acc.a[a][1][i];
              ss += __shfl_xor(ss, 1); ss += __shfl_xor(ss, 2); ss += __shfl_xor(ss, 4); ss += __shfl_xor(ss, 8); ss += __shfl_xor(ss, 16);
              mx = fmaxf(mx, ss);
            }
            mx = fmaxf(mx, __shfl_xor(mx, 32));
            if (lane == 0) {
              const int strm = samp ? 1 + ((mb - TP) >> 6) : 0;
              atomicMax((unsigned*)(ws + WS_KMAX) + strm * 16 + ((n0 + wc * 64) >> 6), __float_as_uint(sqrtf(mx)));
            }
          }
#pragma unroll
          for (int i = 0; i < 16; ++i) {
            const int m = mb + crow(i, h);
            const float v = acc.a[a][b][i];
            if (!samp) { (p.out + O_PK)[(unsigned)(m * 1024 + f)] = v; ((bf16_t*)(ws + WS_KBP))[(unsigned)(m * 1024 + f)] = f2bf(v); }
            else { const int ms = m - TP, bb = ms >> 6, s = ms & 63; (p.out + O_SK)[(unsigned)(ms * 1024 + f)] = v;
                   ((bf16_t*)(ws + WS_KBS))[(unsigned)((bb * SKV + PAST + s) * 1024 + f)] = f2bf(v); }
          }
        } else if (sec == 1) {
          const int f = n - 1024, hd = f >> 7, vd = f & 127;
#pragma unroll
          for (int i = 0; i < 16; ++i) {
            const int m = mb + crow(i, h);
            if (!samp) (p.out + O_PV)[(unsigned)(m * 1024 + f)] = acc.a[a][b][i]; else (p.out + O_SV)[(unsigned)((m - TP) * 1024 + f)] = acc.a[a][b][i];
          }
#pragma unroll
          for (int g = 0; g < 4; ++g) {
            const int m0r = mb + 8 * g + 4 * h, pq = (m0r >> 2) & 3;
            const int m = (m0r & ~15) + 4 * (((pq & 1) << 1) | (pq >> 1));
            u32x2 o = {pk2(acc.a[a][b][4 * g], acc.a[a][b][4 * g + 1]), pk2(acc.a[a][b][4 * g + 2], acc.a[a][b][4 * g + 3])};
            if (!samp) *(u32x2*)((bf16_t*)(ws + WS_VTP) + (unsigned)((hd * 128 + vd) * TP + m)) = o;
            else { const int ms = m - TP, bb = ms >> 6, s = ms & 63; *(u32x2*)((bf16_t*)(ws + WS_VTS) + (unsigned)(((bb * 8 + hd) * 128 + vd) * SKV + PAST + s)) = o; }
          }
        } else {
          const float sc = sec == 2 ? 0.125f * LOG2E : 1.f;
          bf16_t* PB = (bf16_t*)(ws + WS_PB);
#pragma unroll
          for (int i = 0; i < 16; ++i) PB[(unsigned)((mb + crow(i, h)) * 3072 + (n - 2048))] = f2bf(acc.a[a][b][i] * sc);
        }
      }
    }
  }
}

constexpr int A_BUF = 32768, A_KB = 16384, A_FLAGS = 3 * A_BUF;

DI void diffattn_task(const Params& p, unsigned char* lds, int sb  , int qt  , int hd, float lam) {
  const int tid = TIDX, lane = tid & 63, wid = __builtin_amdgcn_readfirstlane(tid >> 6), r = lane & 31, h = lane >> 5;
  unsigned char* ws = p.ws;
  const int cq = wid >> 2, sub = (wid >> 1) & 1, map = wid & 1;
  const int ncq = sb < 0 ? 2 : 1;
  const int base_chunk = sb < 0 ? 2 * qt : 64;
  const int tok0 = sb < 0 ? qt * 128 : TP + sb * 64;
  const bool wvalid = cq < ncq;
  const int qc = base_chunk + cq;
  const int tl = 32 * sub + r;
  const int tok = tok0 + 64 * (wvalid ? cq : 0) + tl;
  const bf16_t* Kb = sb < 0 ? (const bf16_t*)(ws + WS_KBP) + hd * 128 : (const bf16_t*)(ws + WS_KBS) + (size_t)sb * SKV * 1024 + hd * 128;
  const bf16_t* Vb = sb < 0 ? (const bf16_t*)(ws + WS_VTP) + (size_t)hd * 128 * TP : (const bf16_t*)(ws + WS_VTS) + (size_t)(sb * 8 + hd) * 128 * SKV;
  const unsigned ldv = sb < 0 ? TP : SKV;
  const bf16_t* PB = (const bf16_t*)(ws + WS_PB);
  bf16x8 qf[4];
  float qn = 0.f;
  {
    const unsigned qo = (unsigned)tok * 3072u + hd * 128 + map * 64 + 8 * h;
#pragma unroll
    for (int kk = 0; kk < 4; ++kk) {
      const u32x4 u = *(const u32x4*)(PB + (qo + 16 * kk));
      qf[kk] = __builtin_bit_cast(bf16x8, u);
#pragma unroll
      for (int e = 0; e < 4; ++e) { const float a = bflo(u[e]), b = bfhi(u[e]); qn += a * a + b * b; }
    }
    qn += __shfl_xor(qn, 32);
    qn = sqrtf(qn);
  }
  const float kmax = ((const float*)(ws + WS_KMAX))[(sb < 0 ? 0 : 1 + sb) * 16 + hd * 2 + map];
  const float shift = qn * kmax * 1.02f + 0.5f - 40.f;
  const float sl2 = exp2f(-(float)(hd + 1)) * LOG2E;
  const int wd = diff_window(hd);
  const float bh0 = sl2 * (float)(4 * h) - sl2 * (float)tl - shift, bh1 = bh0 + 32.f * sl2;
  float cs[16];
#pragma unroll
  for (int i = 0; i < 16; ++i) cs[i] = __uint_as_float(__builtin_amdgcn_readfirstlane(__float_as_uint(sl2 * (float)((i & 3) + 8 * (i >> 2)))));
  f32x16 O[4];
#pragma unroll
  for (int vt = 0; vt < 4; ++vt) O[vt] = zero16();
  float l = 0.f;
  const int jmax = base_chunk + ncq - 1;
  const int jmin = max(0, base_chunk - wd);
  const int nit = jmax - jmin + 1;
  unsigned kofs[2], vofs[2];
#pragma unroll
  for (int e = 0; e < 2; ++e) {
    const int q = wid * 2 + e;
    { const int row = 4 * q + (lane >> 4), lc = (lane & 15) ^ (row & 15); kofs[e] = (unsigned)row * 1024u + 8u * lc; }
    { const int row = 8 * q + (lane >> 3), lc = (lane & 7) ^ ((row >> 1) & 7); vofs[e] = (unsigned)row * ldv + 8u * lc; }
  }
  auto issue = [&](int j, int buf) {
    const bf16_t* kj = Kb + (size_t)j * 65536;
    const bf16_t* vj = Vb + (size_t)j * 64;
    unsigned char* base = lds + buf * A_BUF;
#pragma unroll
    for (int e = 0; e < 2; ++e) {
      dma16(kj + kofs[e], base + (wid * 2 + e) * 1024);
      dma16(vj + vofs[e], base + A_KB + (wid * 2 + e) * 1024);
    }
  };
  unsigned kco[4], vco[4];
#pragma unroll
  for (int kk = 0; kk < 4; ++kk) kco[kk] = (unsigned)r * 256u + ((((unsigned)(8 * map + 2 * kk + h)) ^ (unsigned)(r & 15)) << 4);
#pragma unroll
  for (int sx = 0; sx < 4; ++sx) vco[sx] = A_KB + (unsigned)r * 128u + ((((unsigned)(2 * sx + h)) ^ (unsigned)((r >> 1) & 7)) << 4);
  asm volatile("s_waitcnt vmcnt(0)" ::: "memory");
  __syncthreads();
  issue(jmax, 0);
  if (nit > 1) issue(jmax - 1, 1);
  for (int it = 0; it < nit; ++it) {
    const int j = jmax - it;
    if (it + 1 < nit) asm volatile("s_waitcnt vmcnt(4)" ::: "memory"); else asm volatile("s_waitcnt vmcnt(0)" ::: "memory");
    asm volatile("s_waitcnt lgkmcnt(0)" ::: "memory");
    __builtin_amdgcn_s_barrier();
    if (it + 2 < nit) issue(j - 2, (it + 2) % 3);
    if (wvalid && j <= qc && qc - j <= wd) {
      const unsigned char* base = lds + (it % 3) * A_BUF;
      const float dofs = sl2 * (float)((qc - j) * 64);
      float sum = 0.f;
#pragma unroll
      for (int half = 0; half < 2; ++half) {
        f32x16 sc;
        {
          float b0 = (half ? bh1 : bh0) - dofs;
          asm volatile("" : "+v"(b0));
#pragma unroll
          for (int i = 0; i < 16; ++i) sc[i] = b0 + cs[i];
        }
        if (j == qc) {
          int tlv = tl;
          asm volatile("" : "+v"(tlv));
          const float m2 = -2.f * sl2, xt = (float)(4 * h + 32 * half - tlv);
#pragma unroll
          for (int i = 0; i < 16; ++i) sc[i] = fmaf(m2, fmaxf(xt + (float)((i & 3) + 8 * (i >> 2)), 0.f), sc[i]);
        }
        {
          bf16x8 kf[4];
#pragma unroll
          for (int kk = 0; kk < 4; ++kk) kf[kk] = ld16(base + 8192 * half + kco[kk]);
#pragma unroll
          for (int kk = 0; kk < 4; ++kk) sc = MFMA32(kf[kk], qf[kk], sc);
        }
        bf16x8 vf[8];
#pragma unroll
        for (int vt = 0; vt < 4; ++vt) { vf[2 * vt] = ld16(base + 4096 * vt + vco[2 * half]); vf[2 * vt + 1] = ld16(base + 4096 * vt + vco[2 * half + 1]); }
#pragma unroll
        for (int i = 0; i < 16; ++i) { sc[i] = fexp2(sc[i]); sum += sc[i]; }
        const bf16x8 p0 = pack_acc(sc, 0), p1 = pack_acc(sc, 1);
#pragma unroll
        for (int vt = 0; vt < 4; ++vt) { O[vt] = MFMA32(vf[2 * vt], p0, O[vt]); O[vt] = MFMA32(vf[2 * vt + 1], p1, O[vt]); }
      }
      l += sum;
    }
  }
  asm volatile("s_waitcnt vmcnt(0)" ::: "memory");
  __syncthreads();
  l += __shfl_xor(l, 32);
  const float inv = wvalid ? 1.f / l : 0.f;
  float* xch = (float*)lds + (size_t)(wid >> 1) * 4096;
  if (map == 1 && wvalid) {
    const float sc = inv * lam;
#pragma unroll
    for (int vt = 0; vt < 4; ++vt)
#pragma unroll
      for (int i = 0; i < 16; ++i) xch[(vt * 16 + i) * 64 + lane] = O[vt][i] * sc;
  }
  __syncthreads();
  if (map == 0 && wvalid) {
    float ss = 0.f;
#pragma unroll
    for (int vt = 0; vt < 4; ++vt)
#pragma unroll
      for (int i = 0; i < 16; ++i) { const float o = O[vt][i] * inv - xch[(vt * 16 + i) * 64 + lane]; O[vt][i] = o; ss += o * o; }
    ss += __shfl_xor(ss, 32);
    const float lam_init = 0.8f - 0.6f * 0.7408182206817179f;
    const float rs = __builtin_amdgcn_rsqf(ss * (1.f / 128.f) + EPS) * (1.f - lam_init);
    const unsigned zo = (unsigned)tok * 3072u + 1024 + hd * 128, oo = (unsigned)tok * 1536u + hd * 128;
    bf16_t* AOp = (bf16_t*)(ws + WS_AO);
    const float* sg = p.in[I_SUBG];
#pragma unroll
    for (int vt = 0; vt < 4; ++vt)
#pragma unroll
      for (int g = 0; g < 4; ++g) {
        const int v = 32 * vt + 8 * g + 4 * h;
        const u32x2 z = *(const u32x2*)(PB + (zo + v));
        const f32x4 gg = *(const f32x4*)(sg + v);
        const float o0 = O[vt][4 * g] * rs * gg[0] * siluf_(bflo(z[0])), o1 = O[vt][4 * g + 1] * rs * gg[1] * siluf_(bfhi(z[0]));
        const float o2 = O[vt][4 * g + 2] * rs * gg[2] * siluf_(bflo(z[1])), o3 = O[vt][4 * g + 3] * rs * gg[3] * siluf_(bfhi(z[1]));
        u32x2 o = {pk2(o0, o1), pk2(o2, o3)};
        *(u32x2*)(AOp + (oo + v)) = o;
      }
  }
  __syncthreads();
}

DI void phase7(const Params& p, unsigned char* lds) {
  unsigned* ctr = (unsigned*)(p.ws + WS_CTR) + 1 + 8 * p.pad;
  const bf16_t* PB = (const bf16_t*)(p.ws + WS_PB);
  float lam;
  {
    const int lane = TIDX & 63;
    const float* lv = p.in[I_LAMB];
    const float a = wave_sum(lv[lane] * lv[64 + lane]), b = wave_sum(lv[128 + lane] * lv[192 + lane]);
    const float lam_init = 0.8f - 0.6f * 0.7408182206817179f;
    lam = __expf(a) - __expf(b) + lam_init;
  }
  const int n_s = 128, n_p = 1024, n_ma = 256 + 64;
  const int* tord = (const int*)(p.ws + WS_TORD);
  for (;;) {
    const int it = next_item(ctr, lds + LDS_BYTES - 16, TIDX);
    if (it >= n_s + n_p) break;
    const int a = tord[it];
    const bool pr = a < n_p;
    diffattn_task(p, lds, pr ? -1 : ((a - n_p) >> 3), pr ? (a >> 3) : 0, a & 7, lam);
  }
  for (;;) {
    const int it = next_item(ctr + 1, lds + LDS_BYTES - 16, TIDX);
    if (it >= n_ma) break;
    memattn_task(p, lds, it, 1, PB + 2048, PB + 2560, 3072);
  }
}

DI void phase9(const Params& p) {
  const int tid = TIDX, lane = tid & 63, wid = tid >> 6;
  const int gw = blockIdx.x * 8 + wid, nw = gridDim.x * 8;
  for (int r = gw; r < TT; r += nw) {
    f32x4 v[4];
    float* row = p.out + O_Y + (size_t)r * 1024;
    const float rstd = row_load_rstd(row, v, lane);
#pragma unroll
    for (int j = 0; j < 4; ++j) {
      const f32x4 g = *(const f32x4*)(p.in[I_FNG] + 4 * lane + 256 * j);
      *(f32x4*)(row + 4 * lane + 256 * j) = v[j] * rstd * g;
    }
  }
}

#define XB_TMO      128
#define XB_XCNT(j)  (256  + 64 * (j))
#define XB_XSUB(j)  (1280 + 64 * (j))
#define XB_XGEN(j)  (2304 + 64 * (j))
#define XB_TOP      3328
#define XB_TOPGEN   3392
#define XB_SPIN_CAP (1u << 20)
DI unsigned xb_ld(unsigned* p)              { return __hip_atomic_load(p, __ATOMIC_RELAXED, __HIP_MEMORY_SCOPE_AGENT); }
DI unsigned xb_add(unsigned* p, unsigned v) { return __hip_atomic_fetch_add(p, v, __ATOMIC_RELAXED, __HIP_MEMORY_SCOPE_AGENT); }
DI unsigned xb_xcc_id() { return (unsigned)__builtin_amdgcn_s_getreg((3 << 11) | 20) & 0xFu; }
#define XB_SPIN(cond, bar) do { unsigned _sp = 0; while (cond) { __builtin_amdgcn_s_sleep(1); \
    if ((++_sp & 255u) == 0u) { if (xb_ld(&(bar)[XB_TMO])) break; if (_sp > XB_SPIN_CAP) { atomicAdd(&(bar)[XB_TMO], 1u); break; } } } } while (0)

DI void xcd_barrier_complete(unsigned* bar, unsigned x, unsigned& nloc, unsigned& nx) {
  const unsigned G = gridDim.x;
  unsigned sum, cnt, mine, sp = 0u;
  for (;;) {
    sum = 0u; cnt = 0u; mine = 0u;
#pragma unroll
    for (unsigned j = 0; j < 16; ++j) { const unsigned c = xb_ld(&bar[XB_XCNT(j)]); sum += c; cnt += (c > 0u) ? 1u : 0u; mine = (j == x) ? c : mine; }
    if (sum == G) break;
    __builtin_amdgcn_s_sleep(1);
    if ((++sp & 255u) == 0u) { if (xb_ld(&bar[XB_TMO])) break; if (sp > XB_SPIN_CAP) { atomicAdd(&bar[XB_TMO], 1u); break; } }
  }
  nloc = mine > 0u ? mine : 1u; nx = cnt > 0u ? cnt : 1u;
}

DI void grid_barrier(unsigned* bar, unsigned x, volatile unsigned* st, int tid) {
  asm volatile("s_waitcnt vmcnt(0)" ::: "memory");
  __syncthreads();
  if (tid == 0) {
    __builtin_amdgcn_s_waitcnt(0);
    unsigned nloc = st[0], nx = st[1];
    if (nloc == 0u) { xcd_barrier_complete(bar, x, nloc, nx); st[0] = nloc; st[1] = nx; }
    const unsigned old = xb_add(&bar[XB_XSUB(x)], 1u);
    const unsigned gen = old / nloc;
    if (old + 1u == (gen + 1u) * nloc) {
      __builtin_amdgcn_fence(__ATOMIC_RELEASE, "agent");
      asm volatile("s_waitcnt vmcnt(0)" ::: "memory");
      const unsigned og = xb_add(&bar[XB_TOP], 1u);
      const unsigned tg = og / nx;
      if (og + 1u == (tg + 1u) * nx) xb_add(&bar[XB_TOPGEN], 1u);
      else XB_SPIN(xb_ld(&bar[XB_TOPGEN]) == tg, bar);
      __builtin_amdgcn_fence(__ATOMIC_ACQUIRE, "agent");
      xb_add(&bar[XB_XGEN(x)], 1u);
      asm volatile("s_waitcnt vmcnt(0)" ::: "memory");
    } else {
      XB_SPIN(xb_ld(&bar[XB_XGEN(x)]) == gen, bar);
      __builtin_amdgcn_fence(__ATOMIC_ACQUIRE, "agent");
      asm volatile("s_waitcnt vmcnt(0)" ::: "memory");
    }
  }
  __syncthreads();
}

__global__ __launch_bounds__(512) void mk(Params pin) {
  extern __shared__ __attribute__((aligned(16))) unsigned char lds[];
  Params p = pin;
  p.wv = __builtin_amdgcn_readfirstlane((int)(__builtin_amdgcn_workitem_id_x() >> 6));
  cg::grid_group grid = cg::this_grid();
  unsigned* bar = (unsigned*)(p.ws + WS_XBAR);
  volatile unsigned* st = (volatile unsigned*)(lds + LDS_BYTES - 64);
  unsigned xcc = 0;
#define RUN_PHASE(PH, CALL) if (p.ph_lo <= PH && PH < p.ph_hi) { CALL; if (PH + 1 < p.ph_hi) grid_barrier(bar, xcc, st, TIDX); }
  if (p.ph_lo <= 0 && 0 < p.ph_hi) { phase0(p, lds); if (1 < p.ph_hi) grid.sync(); }
  {
    xcc = xb_xcc_id();
    __syncthreads();
    if (TIDX == 0) { st[0] = 0u; st[1] = 0u; (void)xb_add(&bar[XB_XCNT(xcc)], 1u); }
    __syncthreads();
  }
  RUN_PHASE(1, phase1(p, lds))
  RUN_PHASE(2, phase2(p, lds))
  if (p.ph_lo <= 2 && 2 < p.ph_hi) { phase2c(p, lds); grid_barrier(bar, xcc, st, TIDX); }
  RUN_PHASE(3, phase3(p))
  RUN_PHASE(4, phase_outproj(p, lds, 0))
  RUN_PHASE(5, phase5(p, lds))
  RUN_PHASE(6, phase6(p, lds))
  RUN_PHASE(7, phase7(p, lds))
  RUN_PHASE(8, phase_outproj(p, lds, 1))
  RUN_PHASE(9, phase9(p))
}

extern "C" void kernel_launch(void* const* d_in, const int* in_sizes, int n_in, void* d_out, int out_size,
                              void* d_ws, size_t ws_size, hipStream_t stream) {
  static int grid_blocks = 0;
  if (!grid_blocks) {
    int dev = 0, cus = 0, per_cu = 0;
    (void)hipGetDevice(&dev);
    (void)hipDeviceGetAttribute(&cus, hipDeviceAttributeMultiprocessorCount, dev);
    (void)hipFuncSetAttribute((const void*)mk, hipFuncAttributeMaxDynamicSharedMemorySize, LDS_BYTES);
    (void)hipOccupancyMaxActiveBlocksPerMultiprocessor(&per_cu, (const void*)mk, NTHREADS, LDS_BYTES);
    grid_blocks = cus;
    fprintf(stderr, "kernel_launch: cus=%d per_cu=%d grid=%d ws=%zu need=%zu\n", cus, per_cu, grid_blocks, ws_size, (size_t)WS_END);
  }
  if (ws_size < WS_END) { fprintf(stderr, "workspace too small\n"); return; }
  Params p{};
  for (int i = 0; i < 24; ++i) p.in[i] = (const float*)d_in[i];
  p.out = (float*)d_out; p.ws = (unsigned char*)d_ws; p.ph_lo = 0; p.ph_hi = NPHASE;
  void* args[] = {&p};
  hipError_t e = hipLaunchCooperativeKernel((const void*)mk, dim3(grid_blocks), dim3(NTHREADS), args, LDS_BYTES, stream);
  if (e != hipSuccess) fprintf(stderr, "cooperative launch failed: %s (grid %d)\n", hipGetErrorString(e), grid_blocks);
  if (PROBE_REP >= 0) {
    Params q = p;
    q.out = (float*)((unsigned char*)d_ws + WS_END); q.ph_lo = PROBE_REP; q.ph_hi = PROBE_REP + 1; q.pad = 1;
    void* args2[] = {&q};
    (void)hipLaunchCooperativeKernel((const void*)mk, dim3(grid_blocks), dim3(NTHREADS), args2, LDS_BYTES, stream);
  }
}
```

```cpp
#include <hip/hip_runtime.h>
#include <hip/hip_cooperative_groups.h>
#include <cstdio>
#include <cstdint>
namespace cg = cooperative_groups;

typedef unsigned short bf16_t;
typedef short bf16x8 __attribute__((ext_vector_type(8)));
typedef short s16x4 __attribute__((ext_vector_type(4)));
typedef float f32x16 __attribute__((ext_vector_type(16)));
typedef float f32x4 __attribute__((ext_vector_type(4)));
typedef float f32x2 __attribute__((ext_vector_type(2)));
typedef __bf16 bf2_t __attribute__((ext_vector_type(2)));
typedef unsigned u32x4 __attribute__((ext_vector_type(4)));
typedef unsigned u32x2 __attribute__((ext_vector_type(2)));
#define DI __device__ __forceinline__
#define MFMA32(a, b, c) __builtin_amdgcn_mfma_f32_32x32x16_bf16((a), (b), (c), 0, 0, 0)

struct Params { const float* in[24]; float* out; unsigned char* ws; int ph_lo, ph_hi; int wv, pad; };
#define TIDX (p.wv * 64 + (int)__builtin_amdgcn_mbcnt_hi(~0u, __builtin_amdgcn_mbcnt_lo(~0u, 0u)))
constexpr int LDS_BYTES = 148480;
constexpr int NTHREADS = 512;
constexpr int NPHASE = 10;
#ifndef PROBE_REP
#define PROBE_REP -1
#endif

constexpr int TP = 16384, TS = 1024, TT = 17408, DM = 1024;
constexpr int NCH = 272;
constexpr int PAST = 4096, SKV = 4160;
constexpr float EPS = 1e-6f;
constexpr float LOG2E = 1.4426950408889634f;
enum { I_XP = 0, I_XS, I_CK, I_CV, I_CMK, I_CMV, I_SC, I_SN, I_SM, I_MEMP, I_NG, I_FNG, I_MNG, I_WMKV, I_WINA, I_BGA, I_HGA, I_WOA,
       I_KVNG, I_WKV, I_WINB, I_LAMB, I_SUBG, I_WOB };
constexpr size_t O_Y = 0, O_PC = 17825792, O_PN = 18087936, O_PM = 18088960, O_PK = 18088964, O_PV = 34866180, O_PMK = 51643396,
                 O_PMV = 51905540, O_SC = 52167684, O_SN = 56361988, O_SM = 56378372, O_SK = 56378436, O_SV = 57427012;
constexpr size_t WS_CTR = 0;
constexpr size_t WS_KMAX = 1024;
constexpr size_t WS_TORD = 8192;
constexpr size_t WS_WA = 16384;
constexpr size_t WS_WOA = WS_WA + (size_t)6144 * 1024 * 2;
constexpr size_t WS_WKB = WS_WOA + (size_t)1024 * 1536 * 2;
constexpr size_t WS_WOB = WS_WKB + (size_t)5120 * 1024 * 2;
constexpr size_t WS_WM = WS_WOB + (size_t)1024 * 1536 * 2;
constexpr size_t WS_MEMN = WS_WM + (size_t)2 * 1024 * 1024 * 2;
constexpr size_t WS_MEMK = WS_MEMN + (size_t)2 * 256 * 1024 * 2;
constexpr size_t WS_MEMVT = WS_MEMK + (size_t)2 * 17 * 256 * 512 * 2;
constexpr size_t WS_GATE = WS_MEMVT + (size_t)2 * 17 * 256 * 512 * 2;
constexpr size_t SZ_CH = (size_t)NCH * 4 * 64 * 4;
constexpr size_t WS_GC = WS_GATE + (size_t)TT * 8 * 4;
constexpr size_t WS_MT = WS_GC + SZ_CH;
constexpr size_t WS_WS = WS_MT + SZ_CH;
constexpr size_t WS_WI = WS_WS + SZ_CH;
constexpr size_t WS_AS = WS_WI + SZ_CH;
constexpr size_t WS_BT = WS_AS + SZ_CH;
constexpr size_t WS_DEC = WS_BT + SZ_CH;
constexpr size_t WS_DENI = WS_DEC + 8192;
constexpr size_t WS_DENA = WS_DENI + (size_t)TT * 4 * 4;
constexpr size_t WS_XN = WS_DENA + (size_t)TT * 4 * 4;
constexpr size_t WS_AO = WS_XN + (size_t)TT * 1024 * 2;
constexpr size_t WS_Y1 = WS_AO + (size_t)TT * 1536 * 2;
constexpr size_t WS_KT = WS_Y1 + (size_t)TT * 1024 * 4;
constexpr size_t WS_VTA = WS_KT + (size_t)NCH * 4 * 256 * 64 * 2;
constexpr size_t WS_R1 = WS_VTA + (size_t)NCH * 4 * 256 * 64 * 2;
constexpr size_t SZ_R1 = (size_t)TT * 6144 * 2;
constexpr size_t WS_PB = WS_R1;
constexpr size_t WS_KBP = WS_PB + (size_t)TT * 3072 * 2;
constexpr size_t WS_VTP = WS_KBP + (size_t)TP * 1024 * 2;
constexpr size_t WS_R2 = WS_R1 + SZ_R1;
constexpr size_t WS_HINTER = WS_R2;
constexpr size_t WS_HINTRA = WS_R2 + (size_t)TT * 1024 * 4;
constexpr size_t WS_KBS = WS_R2;
constexpr size_t WS_VTS = WS_KBS + (size_t)16 * SKV * 1024 * 2;
constexpr size_t WS_WVT = WS_VTS + (size_t)16 * SKV * 1024 * 2;
constexpr size_t WS_U = WS_WVT + (size_t)NCH * 4 * 288 * 64 * 2;
constexpr size_t WS_CFAC = WS_U + SZ_CH;
constexpr size_t WS_CLOCC = WS_CFAC + 8192;
constexpr size_t WS_PM = WS_CLOCC + (size_t)256 * 4 * 9 * 8 * 2 * 64 * 16;
constexpr size_t WS_CHS = WS_PM + SZ_CH;
constexpr size_t WS_LD = WS_CHS + 16384;
constexpr size_t WS_CLOC = WS_LD + 8192;
constexpr size_t WS_XBAR = WS_CLOC + (size_t)16 * 36 * 8 * 64 * 16 * 4;
constexpr size_t WS_END = WS_XBAR + 16384;
constexpr int GRP = 16;
static_assert(WS_VTP + (size_t)TP * 1024 * 2 <= WS_R2, "R1 overflow");

DI unsigned pk2(float lo, float hi) { f32x2 v = {lo, hi}; return __builtin_bit_cast(unsigned, __builtin_convertvector(v, bf2_t)); }
DI bf16_t f2bf(float x) { return (bf16_t)(pk2(x, 0.f) & 0xffffu); }
DI float bf2f(unsigned v16) { return __uint_as_float(v16 << 16); }
DI float bflo(unsigned u) { return __uint_as_float(u << 16); }
DI float bfhi(unsigned u) { return __uint_as_float(u & 0xffff0000u); }
DI float rbf(float x) { return bflo(pk2(x, 0.f) & 0xffffu); }
DI int crow(int i, int h) { return (i & 3) + 8 * (i >> 2) + 4 * h; }
DI float wave_sum(float v) {
#pragma unroll
  for (int o = 32; o >= 1; o >>= 1) v += __shfl_xor(v, o);
  return v;
}
DI float fexp2(float x) { return __builtin_amdgcn_exp2f(x); }
DI float fexp(float x) { return __builtin_amdgcn_exp2f(x * LOG2E); }
DI float sigmoidf_(float x) { return 1.f / (1.f + __expf(-x)); }
DI float siluf_(float x) { return x / (1.f + __expf(-x)); }
DI bf16x8 pack_acc(const f32x16& x, int s) {
  u32x4 p;
  p[0] = pk2(x[8 * s + 0], x[8 * s + 1]); p[1] = pk2(x[8 * s + 2], x[8 * s + 3]);
  p[2] = pk2(x[8 * s + 4], x[8 * s + 5]); p[3] = pk2(x[8 * s + 6], x[8 * s + 7]);
  return __builtin_bit_cast(bf16x8, p);
}
DI bf16x8 ld16(const void* p) { return *(const bf16x8*)p; }
DI bf16x8 ld8x2(const void* p0, const void* p1) {
  u32x2 a = *(const u32x2*)p0, b = *(const u32x2*)p1; u32x4 r = {a[0], a[1], b[0], b[1]};
  return __builtin_bit_cast(bf16x8, r);
}
DI f32x16 zero16() { f32x16 z; for (int i = 0; i < 16; ++i) z[i] = 0.f; return z; }

DI void transpose_tile(const float* __restrict__ src, size_t ld_s, bf16_t* __restrict__ dst, size_t ld_d, const float* __restrict__ scale,
                       float* scr, int t, bool perm = false) {
  {
    const int c4 = t & 31, rb = t >> 5;
    f32x4 v[4];
#pragma unroll
    for (int i = 0; i < 4; ++i) v[i] = *(const f32x4*)(src + (size_t)(rb + 16 * i) * ld_s + 4 * c4);
#pragma unroll
    for (int i = 0; i < 4; ++i) {
      const int r = rb + 16 * i;
      f32x4 x = v[i];
      if (scale) { const float sc = scale[r]; x = x * sc; }
      float* d = scr + r * 129 + 4 * c4; d[0] = x[0]; d[1] = x[1]; d[2] = x[2]; d[3] = x[3];
    }
  }
  __syncthreads();
#pragma unroll
  for (int i = 0; i < 2; ++i) {
    const int id = t + 512 * i, c = id >> 3, rg = id & 7;
    const float* s = scr + (8 * rg) * 129 + c;
    u32x4 o; o[0] = pk2(s[0], s[129]); o[1] = pk2(s[2 * 129], s[3 * 129]); o[2] = pk2(s[4 * 129], s[5 * 129]); o[3] = pk2(s[6 * 129], s[7 * 129]);
    if (!perm) *(u32x4*)(dst + (size_t)c * ld_d + 8 * rg) = o;
    else {
      bf16_t* d = dst + (size_t)c * ld_d + 16 * (rg >> 1) + 4 * (rg & 1);
      u32x2 lo = {o[0], o[1]}, hi = {o[2], o[3]};
      *(u32x2*)d = lo; *(u32x2*)(d + 8) = hi;
    }
  }
  __syncthreads();
}

struct TJob { const float* src; size_t ld_s; bf16_t* dst; size_t ld_d; const float* scale; int tr, tc; };

DI void run_tjob_tile(const TJob& j, int tile, float* scr, int tid, bool perm = false) {
  const int ir = tile / j.tc, ic = tile % j.tc;
  transpose_tile(j.src + (size_t)(64 * ir) * j.ld_s + 128 * ic, j.ld_s, j.dst + (size_t)(128 * ic) * j.ld_d + 64 * ir, j.ld_d,
                 j.scale ? j.scale + 64 * ir : nullptr, scr, tid, perm);
}

DI float row_load_rstd(const float* xrow, f32x4 (&v)[4], int lane) {
  float ss = 0.f;
#pragma unroll
  for (int j = 0; j < 4; ++j) { v[j] = *(const f32x4*)(xrow + 4 * lane + 256 * j); ss += v[j][0] * v[j][0] + v[j][1] * v[j][1] + v[j][2] * v[j][2] + v[j][3] * v[j][3]; }
  ss = wave_sum(ss);
  return __builtin_amdgcn_rsqf(ss * (1.f / 1024.f) + EPS);
}

DI int diff_window(int hd) { const float sl2 = exp2f(-(float)(hd + 1)) * LOG2E; return (int)floorf((63.f + 168.f / sl2) * (1.f / 64.f)); }
DI int diff_est(int a) {
  const int hd = a & 7;
  const int w = diff_window(hd) + (a < 1024 ? 2 : 1);
  const int n = a < 1024 ? 2 * (a >> 3) + 2 : 65;
  return n < w ? n : w;
}

DI void phase0(const Params& p, unsigned char* lds) {
  const int tid = TIDX, lane = tid & 63, wid = tid >> 6;
  unsigned char* ws = p.ws;
  if (blockIdx.x == 0 && tid < 64) ((unsigned*)(ws + WS_CTR))[tid] = 0u;
  if (blockIdx.x == 0 && tid < 272) ((unsigned*)(ws + WS_KMAX))[tid] = 0u;
  if (blockIdx.x == 0) for (int i = tid; i < 4096; i += NTHREADS) ((unsigned*)(ws + WS_XBAR))[i] = 0u;
  if (blockIdx.x == gridDim.x - 1) {
    int* est = (int*)lds;
    for (int a = tid; a < 1152; a += NTHREADS) est[a] = diff_est(a);
    __syncthreads();
    for (int a = tid; a < 1152; a += NTHREADS) {
      const int ea = est[a];
      int rank = 0;
      for (int b = 0; b < 1152; ++b) { const int eb = est[b]; rank += (eb > ea) || (eb == ea && b < a); }
      ((int*)(ws + WS_TORD))[rank] = a;
    }
    __syncthreads();
  }
  {
    TJob jobs[8];
    jobs[0] = {p.in[I_WINA], 6152, (bf16_t*)(ws + WS_WA), 1024, p.in[I_NG], 16, 40};
    jobs[1] = {p.in[I_WINA] + 5128, 6152, (bf16_t*)(ws + WS_WA) + (size_t)5120 * 1024, 1024, p.in[I_NG], 16, 8};
    jobs[2] = {p.in[I_WOA], 1024, (bf16_t*)(ws + WS_WOA), 1536, nullptr, 24, 8};
    jobs[3] = {p.in[I_WKV], 2048, (bf16_t*)(ws + WS_WKB), 1024, p.in[I_KVNG], 16, 16};
    jobs[4] = {p.in[I_WINB], 3072, (bf16_t*)(ws + WS_WKB) + (size_t)2048 * 1024, 1024, p.in[I_NG] + 1024, 16, 24};
    jobs[5] = {p.in[I_WOB], 1024, (bf16_t*)(ws + WS_WOB), 1536, nullptr, 24, 8};
    jobs[6] = {p.in[I_WMKV], 1024, (bf16_t*)(ws + WS_WM), 1024, nullptr, 16, 8};
    jobs[7] = {p.in[I_WMKV] + (size_t)1024 * 1024, 1024, (bf16_t*)(ws + WS_WM) + (size_t)1024 * 1024, 1024, nullptr, 16, 8};
    int base = 0;
#pragma unroll
    for (int j = 0; j < 8; ++j) {
      if (j >= 2 && j <= 5) continue;
      const int n = jobs[j].tr * jobs[j].tc;
      if (blockIdx.x >= 16) for (int t = blockIdx.x - 16; t < n; t += gridDim.x - 16) run_tjob_tile(jobs[j], t, (float*)lds, tid);
      base += n;
    }
    if (blockIdx.x >= 16) for (int t = blockIdx.x - 16; t < 128 * 4; t += gridDim.x - 16) {
      const int jb = t >> 2, tile = t & 3, l = jb >> 6, b = (jb >> 2) & 15, h = jb & 3;
      TJob j = {p.in[I_CMV] + ((size_t)(l * 16 + b) * 256) * 512 + h * 128, 512,
                (bf16_t*)(ws + WS_MEMVT) + ((size_t)(l * 17 + 1 + b) * 4 + h) * 128 * 256, 256, nullptr, 4, 1};
      run_tjob_tile(j, tile, (float*)lds, tid, true);
    }
  }
  {
    const size_t n8 = (size_t)2 * 16 * 256 * 512 / 8;
    for (size_t i = (size_t)blockIdx.x * NTHREADS + tid; i < n8; i += (size_t)gridDim.x * NTHREADS) {
      const size_t e = i * 8; const int l = (int)(e / ((size_t)16 * 131072)); const size_t rem = e - (size_t)l * 16 * 131072;
      const f32x4 a = *(const f32x4*)(p.in[I_CMK] + e), b = *(const f32x4*)(p.in[I_CMK] + e + 4);
      u32x4 o = {pk2(a[0], a[1]), pk2(a[2], a[3]), pk2(b[0], b[1]), pk2(b[2], b[3])};
      *(u32x4*)((bf16_t*)(ws + WS_MEMK) + ((size_t)(l * 17 + 1) * 131072) + rem) = o;
    }
  }
  {
    const int gw = blockIdx.x * 8 + wid, nw = gridDim.x * 8;
    const float* ng = p.in[I_NG];
    float* gwt = (float*)(lds + 32768);
    float* sg = (float*)(lds + 32768 + 36864);
    __syncthreads();
    for (int i = tid; i < 8192; i += NTHREADS) { const int k = i >> 3, c = i & 7; gwt[k * 8 + (k >> 2) * 4 + c] = p.in[I_WINA][(size_t)k * 6152 + 5120 + c] * ng[k]; }
    __syncthreads();
    for (int cc = blockIdx.x; cc < NCH; cc += gridDim.x) {
      f32x4 vn[4];
      {
        const int r0 = cc * 64 + wid * 8;
        const float* x0 = r0 < TP ? p.in[I_XP] + (size_t)r0 * 1024 : p.in[I_XS] + (size_t)(r0 - TP) * 1024;
#pragma unroll
        for (int j = 0; j < 4; ++j) vn[j] = *(const f32x4*)(x0 + 4 * lane + 256 * j);
      }
      for (int ri = 0; ri < 8; ++ri) {
        const int r = cc * 64 + wid * 8 + ri;
        f32x4 v[4];
#pragma unroll
        for (int j = 0; j < 4; ++j) v[j] = vn[j];
        if (ri + 1 < 8) {
          const float* x1 = (r + 1) < TP ? p.in[I_XP] + (size_t)(r + 1) * 1024 : p.in[I_XS] + (size_t)(r + 1 - TP) * 1024;
#pragma unroll
          for (int j = 0; j < 4; ++j) vn[j] = *(const f32x4*)(x1 + 4 * lane + 256 * j);
        }
        float ssq = 0.f;
#pragma unroll
        for (int j = 0; j < 4; ++j) ssq += v[j][0] * v[j][0] + v[j][1] * v[j][1] + v[j][2] * v[j][2] + v[j][3] * v[j][3];
        const float rstd = __builtin_amdgcn_rsqf(wave_sum(ssq) * (1.f / 1024.f) + EPS);
        float gacc[8];
#pragma unroll
        for (int c = 0; c < 8; ++c) gacc[c] = 0.f;
        bf16_t* xn = (bf16_t*)(ws + WS_XN) + (size_t)r * 1024;
#pragma unroll
        for (int j = 0; j < 4; ++j) {
          const int k0 = 4 * lane + 256 * j;
          const f32x4 xs = v[j] * rstd;
          u32x2 o = {pk2(xs[0], xs[1]), pk2(xs[2], xs[3])};
          *(u32x2*)(xn + k0) = o;
#pragma unroll
          for (int e = 0; e < 4; ++e) {
            const float* wr = gwt + (k0 + e) * 8 + (k0 >> 2) * 4;
            const f32x4 w0 = *(const f32x4*)wr, w1 = *(const f32x4*)(wr + 4);
            gacc[0] += xs[e] * w0[0]; gacc[1] += xs[e] * w0[1]; gacc[2] += xs[e] * w0[2]; gacc[3] += xs[e] * w0[3];
            gacc[4] += xs[e] * w1[0]; gacc[5] += xs[e] * w1[1]; gacc[6] += xs[e] * w1[2]; gacc[7] += xs[e] * w1[3];
          }
        }
#pragma unroll
        for (int c = 0; c < 8; ++c) gacc[c] = wave_sum(gacc[c]);
        if (lane < 8) {
          float gv = gacc[0];
#pragma unroll
          for (int c = 1; c < 8; ++c) gv = lane == c ? gacc[c] : gv;
          gv += p.in[I_BGA][lane];
          if (lane >= 4) gv = fminf(gv, 0.f) - log1pf(__expf(-fabsf(gv)));
          sg[(wid * 8 + ri) * 8 + lane] = gv;
        }
      }
      __syncthreads();
      if (wid < 4) {
        const int hd = wid, pr = cc * 4 + hd;
        const float ig = sg[lane * 8 + hd], lf = sg[lane * 8 + 4 + hd];
        float g = lf;
#pragma unroll
        for (int o = 1; o < 64; o <<= 1) { const float t = __shfl_up(g, o); if (lane >= o) g += t; }
        const float a = ig - g;
        float pm = a;
#pragma unroll
        for (int o = 1; o < 64; o <<= 1) { const float t = __shfl_up(pm, o); if (lane >= o) pm = fmaxf(pm, t); }
        const size_t o = (size_t)pr * 64 + lane;
        ((float*)(ws + WS_GC))[o] = g;
        ((float*)(ws + WS_AS))[o] = a;
        ((float*)(ws + WS_PM))[o] = pm;
        if (lane == 63) { ((float*)(ws + WS_CHS))[pr * 2] = g; ((float*)(ws + WS_CHS))[pr * 2 + 1] = pm; }
        const float u = __expf(a - __shfl(pm, 63));
        ((float*)(ws + WS_U))[o] = u;
        bf16_t* wr = (bf16_t*)(ws + WS_WVT) + ((size_t)pr * 288 + 256) * 64 + lane;
        wr[0] = f2bf(u);
#pragma unroll 4
        for (int rr = 1; rr < 32; ++rr) wr[rr * 64] = 0;
      }
      __syncthreads();
    }
    for (int r = gw; r < 512; r += nw) {
      const int l = r >> 8, rr = r & 255;
      f32x4 v[4];
      const float rstd = row_load_rstd(p.in[I_MEMP] + (size_t)rr * 1024, v, lane);
      bf16_t* o = (bf16_t*)(ws + WS_MEMN) + (size_t)r * 1024;
#pragma unroll
      for (int j = 0; j < 4; ++j) {
        const int k0 = 4 * lane + 256 * j;
        const f32x4 g = *(const f32x4*)(p.in[I_MNG] + l * 1024 + k0);
        const f32x4 xs = v[j] * rstd * g;
        u32x2 ov = {pk2(xs[0], xs[1]), pk2(xs[2], xs[3])};
        *(u32x2*)(o + k0) = ov;
      }
    }
  }
}

constexpr int G_STAGE = 49152;
struct GemmAcc { f32x16 a[2][2]; };
DI void dma16(const void* g, unsigned char* l) { __builtin_amdgcn_global_load_lds((const unsigned*)g, (unsigned*)l, 16, 0, 0); }

template <int NB = 2>
DI void gemm_tile(const bf16_t* __restrict__ A, size_t lda, const bf16_t* __restrict__ Bt, size_t ldb, int K, unsigned char* lds, GemmAcc& acc, int tid) {
  const int lane = tid & 63, wid = __builtin_amdgcn_readfirstlane(tid >> 6), r = lane & 31, h = lane >> 5;
  const int wr = wid >> 1, wc = wid & 1;
#pragma unroll
  for (int a = 0; a < 2; ++a)
#pragma unroll
    for (int b = 0; b < 2; ++b) acc.a[a][b] = zero16();
  const int nk = K / 64;
  unsigned aoff[4], boff[2];
#pragma unroll
  for (int e = 0; e < 4; ++e) { const int row = 8 * (wid * 4 + e) + (lane >> 3), lc = (lane & 7) ^ ((row >> 1) & 7); aoff[e] = (unsigned)row * (unsigned)lda + 8u * lc; }
#pragma unroll
  for (int e = 0; e < NB; ++e) { const int row = 8 * (wid * NB + e) + (lane >> 3), lc = (lane & 7) ^ ((row >> 1) & 7); boff[e] = (unsigned)row * (unsigned)ldb + 8u * lc; }
  auto issue = [&](int kt, int buf) {
    unsigned char* base = lds + buf * G_STAGE;
#pragma unroll
    for (int e = 0; e < 4; ++e) dma16(A + (aoff[e] + 64u * kt), base + (wid * 4 + e) * 1024);
#pragma unroll
    for (int e = 0; e < NB; ++e) dma16(Bt + (boff[e] + 64u * kt), base + 32768 + (wid * NB + e) * 1024);
  };
  asm volatile("s_waitcnt vmcnt(0)" ::: "memory");
  __syncthreads();
  issue(0, 0);
  if (nk > 1) issue(1, 1);
  const unsigned sw = (r >> 1) & 7;
  unsigned co[4];
#pragma unroll
  for (int kk = 0; kk < 4; ++kk) co[kk] = (((2 * kk + h) ^ sw) << 4);
  const unsigned ra = (wr * 64 + r) * 128, rb = 32768 + (wc * 32 * NB + r) * 128;
  for (int kt = 0; kt < nk; ++kt) {
    if (kt + 1 < nk) { if (NB == 2) asm volatile("s_waitcnt vmcnt(6)" ::: "memory"); else asm volatile("s_waitcnt vmcnt(5)" ::: "memory"); }
    else asm volatile("s_waitcnt vmcnt(0)" ::: "memory");
    asm volatile("s_waitcnt lgkmcnt(0)" ::: "memory");
    __builtin_amdgcn_s_barrier();
    if (kt + 2 < nk) issue(kt + 2, (kt + 2) % 3);
    const unsigned char* base = lds + (kt % 3) * G_STAGE;
    const unsigned char* pa = base + ra;
    const unsigned char* pb = base + rb;
#pragma unroll
    for (int kk = 0; kk < 4; ++kk) {
      const bf16x8 a0 = ld16(pa + co[kk]), a1 = ld16(pa + 4096 + co[kk]);
      const bf16x8 b0 = ld16(pb + co[kk]);
      acc.a[0][0] = MFMA32(a0, b0, acc.a[0][0]);
      acc.a[1][0] = MFMA32(a1, b0, acc.a[1][0]);
      if (NB == 2) {
        const bf16x8 b1 = ld16(pb + 4096 + co[kk]);
        acc.a[0][1] = MFMA32(a0, b1, acc.a[0][1]);
        acc.a[1][1] = MFMA32(a1, b1, acc.a[1][1]);
      }
    }
    __builtin_amdgcn_sched_group_barrier(0x100, 2 + NB, 0);
    __builtin_amdgcn_sched_group_barrier(0x100, 2 + NB, 0); __builtin_amdgcn_sched_group_barrier(0x008, 2 * NB, 0);
    __builtin_amdgcn_sched_group_barrier(0x100, 2 + NB, 0); __builtin_amdgcn_sched_group_barrier(0x008, 2 * NB, 0);
    __builtin_amdgcn_sched_group_barrier(0x100, 2 + NB, 0); __builtin_amdgcn_sched_group_barrier(0x008, 2 * NB, 0);
    __builtin_amdgcn_sched_group_barrier(0x008, 2 * NB, 0);
  }
}

DI void gemm256(const bf16_t* __restrict__ A, size_t lda, const bf16_t* __restrict__ Bt, size_t ldb, int K, unsigned char* lds, GemmAcc (&acc)[2], int tid) {
  const int lane = tid & 63, wid = __builtin_amdgcn_readfirstlane(tid >> 6), r = lane & 31, h = lane >> 5;
  const int wr = wid >> 2, wc = wid & 3;
#pragma unroll
  for (int mh = 0; mh < 2; ++mh)
#pragma unroll
    for (int a = 0; a < 2; ++a)
#pragma unroll
      for (int b = 0; b < 2; ++b) acc[mh].a[a][b] = zero16();
  const int nk = K / 64;
  unsigned aoff[4], boff[4];
#pragma unroll
  for (int e = 0; e < 4; ++e) {
    const int row = 8 * (wid * 4 + e) + (lane >> 3), lc = (lane & 7) ^ ((row >> 1) & 7);
    aoff[e] = (unsigned)row * (unsigned)lda + 8u * lc; boff[e] = (unsigned)row * (unsigned)ldb + 8u * lc;
  }
  auto issue = [&](int kt, int buf) {
    unsigned char* base = lds + buf * 65536;
#pragma unroll
    for (int e = 0; e < 4; ++e) { dma16(A + (aoff[e] + 64u * kt), base + (wid * 4 + e) * 1024); dma16(Bt + (boff[e] + 64u * kt), base + 32768 + (wid * 4 + e) * 1024); }
  };
  asm volatile("s_waitcnt vmcnt(0)" ::: "memory");
  __syncthreads();
  issue(0, 0);
  const unsigned sw = (r >> 1) & 7;
  unsigned co[4];
#pragma unroll
  for (int kk = 0; kk < 4; ++kk) co[kk] = (((2 * kk + h) ^ sw) << 4);
  const unsigned ra = (wr * 128 + r) * 128, rb = 32768 + (wc * 64 + r) * 128;
  for (int kt = 0; kt < nk; ++kt) {
    asm volatile("s_waitcnt vmcnt(0)" ::: "memory");
    asm volatile("s_waitcnt lgkmcnt(0)" ::: "memory");
    __builtin_amdgcn_s_barrier();
    if (kt + 1 < nk) issue(kt + 1, (kt + 1) & 1);
    const unsigned char* base = lds + (kt & 1) * 65536;
    const unsigned char* pa = base + ra;
    const unsigned char* pb = base + rb;
#pragma unroll
    for (int kk = 0; kk < 4; ++kk) {
      const bf16x8 b0 = ld16(pb + co[kk]), b1 = ld16(pb + 4096 + co[kk]);
#pragma unroll
      for (int mh = 0; mh < 2; ++mh) {
        const bf16x8 a0 = ld16(pa + 8192 * mh + co[kk]), a1 = ld16(pa + 8192 * mh + 4096 + co[kk]);
        acc[mh].a[0][0] = MFMA32(a0, b0, acc[mh].a[0][0]);
        acc[mh].a[0][1] = MFMA32(a0, b1, acc[mh].a[0][1]);
        acc[mh].a[1][0] = MFMA32(a1, b0, acc[mh].a[1][0]);
        acc[mh].a[1][1] = MFMA32(a1, b1, acc[mh].a[1][1]);
      }
    }
#define SGB_R(N) __builtin_amdgcn_sched_group_barrier(0x100, N, 0)
#define SGB_M(N) __builtin_amdgcn_sched_group_barrier(0x008, N, 0)
    SGB_R(4);
    SGB_R(2); SGB_M(4); SGB_R(4); SGB_M(4);
    SGB_R(2); SGB_M(4); SGB_R(4); SGB_M(4);
    SGB_R(2); SGB_M(4); SGB_R(4); SGB_M(4);
    SGB_R(2); SGB_M(4); SGB_M(4);
  }
}

DI void gate_scan(const Params& p, unsigned char* lds) {
  const int tid = TIDX, lane = tid & 63, wid = tid >> 6;
  unsigned char* ws = p.ws;
  float* s_ch = (float*)lds;
  float* s_mc = s_ch + NCH * 8;
  float* s_mn = s_mc + NCH * 4;
  __syncthreads();
  for (int i = tid; i < NCH * 8; i += NTHREADS) s_ch[i] = ((const float*)(ws + WS_CHS))[i];
  __syncthreads();
  if (tid < 4) {
    float m = 0.f, ld = 0.f;
    float* LD = (float*)(ws + WS_LD);
    const bool wr = blockIdx.x == 0;
#pragma unroll 8
    for (int c = 0; c < 256; ++c) {
      s_mc[c * 4 + tid] = m; if (wr) LD[c * 4 + tid] = ld;
      const float gl = s_ch[(c * 4 + tid) * 2], mn = gl + fmaxf(m, s_ch[(c * 4 + tid) * 2 + 1]);
      ld += gl + m - mn;
      m = mn; s_mn[c * 4 + tid] = m;
    }
    if (wr) { LD[256 * 4 + tid] = ld; p.out[O_PM + tid] = m; }
  } else if (tid >= 64 && tid < 128) {
    const int b = (tid - 64) >> 2, hd = tid & 3, pr = (256 + b) * 4 + hd;
    const float m0 = p.in[I_SM][b * 4 + hd];
    const float m = s_ch[pr * 2] + fmaxf(m0, s_ch[pr * 2 + 1]);
    s_mc[pr] = m0; s_mn[pr] = m;
    if (blockIdx.x == 0) p.out[O_SM + b * 4 + hd] = m;
  }
  __syncthreads();
  for (int cc = blockIdx.x; cc < NCH; cc += gridDim.x) {
    if (wid < 4) {
      const int hd = wid, pr = cc * 4 + hd;
      const size_t o = (size_t)pr * 64 + lane;
      const float g = ((const float*)(ws + WS_GC))[o], a = ((const float*)(ws + WS_AS))[o], pm = ((const float*)(ws + WS_PM))[o];
      const float mc = s_mc[pr], mn = s_mn[pr], gl = s_ch[pr * 2];
      const float mt = g + fmaxf(mc, pm);
      ((float*)(ws + WS_MT))[o] = mt;
      ((float*)(ws + WS_WS))[o] = __expf(gl + a - mn);
      ((float*)(ws + WS_WI))[o] = __expf(g + mc - mt);
      ((float*)(ws + WS_AS))[o] = a * LOG2E;
      ((float*)(ws + WS_BT))[o] = (g - mt) * LOG2E;
      if (lane == 0) { ((float*)(ws + WS_DEC))[pr] = __expf(gl + mc - mn); const float amx = s_ch[pr * 2 + 1]; ((float*)(ws + WS_CFAC))[pr] = __expf(amx - fmaxf(mc, amx)); }
    }
  }
  __syncthreads();
}

DI void phase1(const Params& p, unsigned char* lds) {
  const int tid = TIDX, lane = tid & 63, wid = tid >> 6, r = lane & 31, h = lane >> 5;
  unsigned char* ws = p.ws;
  gate_scan(p, lds);
  const int n_main = 68 * 24, n_mem = 16;
  for (int t = blockIdx.x; t < n_main + n_mem; t += gridDim.x) {
    if (t < n_main) {
      const int tm = t / 24, tn = t % 24, m0 = tm * 256, n0 = tn * 256;
      GemmAcc acc2[2];
      gemm256((const bf16_t*)(ws + WS_XN) + (size_t)m0 * 1024, 1024, (const bf16_t*)(ws + WS_WA) + (size_t)n0 * 1024, 1024, 1024, lds, acc2, tid);
#pragma unroll
      for (int mh = 0; mh < 2; ++mh) {
      const GemmAcc& acc = acc2[mh];
      const int wr = (wid >> 2) * 2 + mh, wc = wid & 3;
      bf16_t* PA = (bf16_t*)(ws + WS_R1);
      const int sec = n0 >> 10;
#pragma unroll
      for (int a = 0; a < 2; ++a)
#pragma unroll
        for (int b = 0; b < 2; ++b) {
          __builtin_amdgcn_sched_barrier(0);
          const int n = n0 + wc * 64 + 32 * b + r, mb = m0 + wr * 64 + 32 * a;
          if (sec != 2) {
            const float sc = sec == 1 ? 0.0625f : 1.f;
            const int pc = (n >> 2) & 3, np = sec <= 1 ? (n & ~15) + 4 * (((pc & 1) << 1) | (pc >> 1)) + (n & 3) : n;
#pragma unroll
            for (int i = 0; i < 16; ++i) PA[(size_t)(mb + crow(i, h)) * 6144 + np] = f2bf(acc.a[a][b][i] * sc);
          }
          if (sec == 1 || sec == 2) {
            const float sc = sec == 1 ? 0.0625f : 1.f;
            const int f = n & 1023, hd = f >> 8, fe = f & 255;
            bf16_t* T = (bf16_t*)(ws + (sec == 1 ? WS_KT : WS_VTA));
#pragma unroll
            for (int g = 0; g < 4; ++g) {
              const int m = mb + 8 * g + 4 * h, cc = m >> 6, s = m & 63;
              u32x2 o = {pk2(acc.a[a][b][4 * g] * sc, acc.a[a][b][4 * g + 1] * sc), pk2(acc.a[a][b][4 * g + 2] * sc, acc.a[a][b][4 * g + 3] * sc)};
              *(u32x2*)(T + (((size_t)cc * 4 + hd) * 256 + fe) * 64 + s) = o;
              if (sec == 2) {
                const f32x4 u = *(const f32x4*)((const float*)(ws + WS_U) + ((size_t)cc * 4 + hd) * 64 + s);
                u32x2 ow = {pk2(acc.a[a][b][4 * g] * u[0], acc.a[a][b][4 * g + 1] * u[1]), pk2(acc.a[a][b][4 * g + 2] * u[2], acc.a[a][b][4 * g + 3] * u[3])};
                *(u32x2*)((bf16_t*)(ws + WS_WVT) + (((size_t)cc * 4 + hd) * 288 + fe) * 64 + s) = ow;
              }
            }
          }
        }
      }
    } else {
      GemmAcc acc;
      const int wr = wid >> 1, wc = wid & 1;
      const int tt = t - n_main, l = tt >> 3, n0 = (tt & 7) * 128;
      gemm_tile((const bf16_t*)(ws + WS_MEMN) + (size_t)l * 256 * 1024, 1024, (const bf16_t*)(ws + WS_WM) + ((size_t)l * 1024 + n0) * 1024, 1024, 1024, lds, acc, tid);
      const bool isv = n0 >= 512;
      float* of = p.out + (isv ? O_PMV : O_PMK) + (size_t)l * 131072;
      bf16_t* mk = (bf16_t*)(ws + WS_MEMK) + (size_t)(l * 17) * 131072;
      bf16_t* mv = (bf16_t*)(ws + WS_MEMVT) + (size_t)(l * 17) * 131072;
#pragma unroll
      for (int a = 0; a < 2; ++a)
#pragma unroll
        for (int b = 0; b < 2; ++b) {
          __builtin_amdgcn_sched_barrier(0);
          const int f = (n0 & 511) + wc * 64 + 32 * b + r, mb = wr * 64 + 32 * a;
#pragma unroll
          for (int g = 0; g < 4; ++g) {
            const int m = mb + 8 * g + 4 * h;
            float* o4 = of + (size_t)m * 512 + f;
            o4[0] = acc.a[a][b][4 * g]; o4[512] = acc.a[a][b][4 * g + 1]; o4[1024] = acc.a[a][b][4 * g + 2]; o4[1536] = acc.a[a][b][4 * g + 3];
            if (!isv) {
              bf16_t* k4 = mk + (size_t)m * 512 + f;
              k4[0] = f2bf(acc.a[a][b][4 * g]); k4[512] = f2bf(acc.a[a][b][4 * g + 1]); k4[1024] = f2bf(acc.a[a][b][4 * g + 2]); k4[1536] = f2bf(acc.a[a][b][4 * g + 3]);
            } else {
              u32x2 o = {pk2(acc.a[a][b][4 * g], acc.a[a][b][4 * g + 1]), pk2(acc.a[a][b][4 * g + 2], acc.a[a][b][4 * g + 3])};
              const int pq = (m >> 2) & 3, mp = (m & ~15) + 4 * (((pq & 1) << 1) | (pq >> 1));
              *(u32x2*)(mv + (size_t)f * 256 + mp) = o;
            }
          }
        }
    }
  }
}

DI void scan_task(const Params& p, unsigned char* lds, int sb  , int hd, int j, int grp) {
  const int tid = TIDX, lane = tid & 63, wid = tid >> 6, r = lane & 31, h = lane >> 5;
  unsigned char* ws = p.ws;
  const int cc0 = sb < 0 ? GRP * grp : 256 + sb, nch = sb < 0 ? GRP : 1;
  const bf16_t* PA = (const bf16_t*)(ws + WS_R1);
  const bf16_t* KT = (const bf16_t*)(ws + WS_KT);
  const bf16_t* VT = (const bf16_t*)(ws + WS_VTA);
  const float* WSa = (const float*)(ws + WS_WS);
  const float* WIa = (const float*)(ws + WS_WI);
  const float* DEC = (const float*)(ws + WS_DEC);
  float* red = (float*)lds;
  const bool nsl = j == 8;
  f32x16 S = zero16();
  if (sb >= 0) {
    if (!nsl) {
      const float* C0 = p.in[I_SC] + ((size_t)(sb * 4 + hd) * 256 + 32 * j + r) * 256 + 32 * wid;
#pragma unroll
      for (int g = 0; g < 4; ++g) { const f32x4 c = *(const f32x4*)(C0 + 8 * g + 4 * h); S[4 * g] = c[0]; S[4 * g + 1] = c[1]; S[4 * g + 2] = c[2]; S[4 * g + 3] = c[3]; }
    } else if (r == 0) {
      const float* n0 = p.in[I_SN] + (size_t)(sb * 4 + hd) * 256 + 32 * wid;
#pragma unroll
      for (int g = 0; g < 4; ++g) { const f32x4 c = *(const f32x4*)(n0 + 8 * g + 4 * h); S[4 * g] = c[0]; S[4 * g + 1] = c[1]; S[4 * g + 2] = c[2]; S[4 * g + 3] = c[3]; }
    }
  }
  bf16x8 kt[4], wv[4], qf[2][2];
  u32x4 ktn[4], vn[4], qn[2][2];
  float wsn;
  float* wsl = (float*)(lds + 69632);
  auto loadraw = [&](int cc) {
    const size_t ch = (size_t)cc * 4 + hd;
    const bf16_t* kp = KT + (ch * 256 + 32 * wid + r) * 64 + 8 * h;
#pragma unroll
    for (int st = 0; st < 4; ++st) ktn[st] = *(const u32x4*)(kp + 16 * st);
    wsn = WSa[ch * 64 + lane];
    if (!nsl) {
      const bf16_t* vp = VT + (ch * 256 + 32 * j + r) * 64 + 8 * h;
#pragma unroll
      for (int st = 0; st < 4; ++st) vn[st] = *(const u32x4*)(vp + 16 * st);
    }
#pragma unroll
    for (int tt = 0; tt < 2; ++tt) {
      const bf16_t* qp = PA + (size_t)(cc * 64 + 32 * tt + r) * 6144 + hd * 256 + 32 * wid + 8 * h;
#pragma unroll
      for (int s2 = 0; s2 < 2; ++s2) qn[tt][s2] = *(const u32x4*)(qp + 16 * s2);
    }
  };
  auto convert = [&]() {
    __syncthreads();
    if (wid == 0) wsl[lane] = wsn;
    __syncthreads();
#pragma unroll
    for (int st = 0; st < 4; ++st) {
      kt[st] = __builtin_bit_cast(bf16x8, ktn[st]);
      const f32x4 w0 = *(const f32x4*)(wsl + 16 * st + 8 * h), w1 = *(const f32x4*)(wsl + 16 * st + 8 * h + 4);
      u32x4 o;
      if (!nsl) {
        const u32x4 v = vn[st];
        o[0] = pk2(bflo(v[0]) * w0[0], bfhi(v[0]) * w0[1]); o[1] = pk2(bflo(v[1]) * w0[2], bfhi(v[1]) * w0[3]);
        o[2] = pk2(bflo(v[2]) * w1[0], bfhi(v[2]) * w1[1]); o[3] = pk2(bflo(v[3]) * w1[2], bfhi(v[3]) * w1[3]);
      } else {
        o = (u32x4){pk2(w0[0], w0[1]), pk2(w0[2], w0[3]), pk2(w1[0], w1[1]), pk2(w1[2], w1[3])};
        if (r != 0) o = (u32x4){0u, 0u, 0u, 0u};
      }
      wv[st] = __builtin_bit_cast(bf16x8, o);
    }
#pragma unroll
    for (int tt = 0; tt < 2; ++tt)
#pragma unroll
      for (int s2 = 0; s2 < 2; ++s2) qf[tt][s2] = __builtin_bit_cast(bf16x8, qn[tt][s2]);
  };
  loadraw(cc0);
  convert();
  for (int c = 0; c < nch; ++c) {
    const int cc = cc0 + c;
    if (c + 1 < nch) loadraw(cc + 1);
    const float dec = DEC[cc * 4 + hd];
    const bf16x8 xs0 = pack_acc(S, 0), xs1 = pack_acc(S, 1);
    f32x16 z0 = MFMA32(xs0, qf[0][0], zero16()); z0 = MFMA32(xs1, qf[0][1], z0);
    f32x16 z1 = MFMA32(xs0, qf[1][0], zero16()); z1 = MFMA32(xs1, qf[1][1], z1);
    S = S * dec;
#pragma unroll
    for (int st = 0; st < 4; ++st) S = MFMA32(kt[st], wv[st], S);
    __syncthreads();
    {
      float* rw = red + wid * (64 * 33);
#pragma unroll
      for (int i = 0; i < 16; ++i) { rw[r * 33 + crow(i, h)] = z0[i]; rw[(32 + r) * 33 + crow(i, h)] = z1[i]; }
    }
    __syncthreads();
    {
      const int v = tid & 31;
#pragma unroll
      for (int e = 0; e < 4; ++e) {
        const int t = (tid >> 5) + 16 * e;
        float s = 0.f;
#pragma unroll
        for (int w8 = 0; w8 < 8; ++w8) s += red[w8 * (64 * 33) + t * 33 + v];
        const float wi = WIa[((size_t)cc * 4 + hd) * 64 + t];
        if (!nsl) ((float*)(ws + WS_HINTER))[(size_t)(cc * 64 + t) * 1024 + hd * 256 + 32 * j + v] = s * wi;
        else if (v == 0) ((float*)(ws + WS_DENI))[(size_t)(cc * 64 + t) * 4 + hd] = s * wi;
      }
    }
    if (c + 1 < nch) convert();
  }
  if (sb < 0) {
    float* cl = (float*)(ws + WS_CLOC) + ((((size_t)(grp * 4 + hd) * 9 + j) * 8 + wid) * 64 + lane) * 16;
#pragma unroll
    for (int g = 0; g < 4; ++g) { f32x4 c = {S[4 * g], S[4 * g + 1], S[4 * g + 2], S[4 * g + 3]}; *(f32x4*)(cl + 4 * g) = c; }
  } else {
    if (!nsl) {
      float* Co = (sb < 0 ? p.out + O_PC + (size_t)hd * 65536 : p.out + O_SC + (size_t)(sb * 4 + hd) * 65536) + (size_t)(32 * j + r) * 256 + 32 * wid;
#pragma unroll
      for (int g = 0; g < 4; ++g) { f32x4 c = {S[4 * g], S[4 * g + 1], S[4 * g + 2], S[4 * g + 3]}; *(f32x4*)(Co + 8 * g + 4 * h) = c; }
    } else if (r == 0) {
      float* no = (sb < 0 ? p.out + O_PN + (size_t)hd * 256 : p.out + O_SN + (size_t)(sb * 4 + hd) * 256) + 32 * wid;
#pragma unroll
      for (int g = 0; g < 4; ++g) { f32x4 c = {S[4 * g], S[4 * g + 1], S[4 * g + 2], S[4 * g + 3]}; *(f32x4*)(no + 8 * g + 4 * h) = c; }
    }
  }
  __syncthreads();
}

DI void intra_task(const Params& p, int cc, int hd) {
  const int tid = TIDX, lane = tid & 63, wid = tid >> 6, r = lane & 31, h = lane >> 5;
  unsigned char* ws = p.ws;
  const int tt = wid & 1, vq = wid >> 1;
  const bf16_t* PA = (const bf16_t*)(ws + WS_R1);
  const bf16_t* VT = (const bf16_t*)(ws + WS_VTA);
  const size_t ch = (size_t)cc * 4 + hd;
  f32x16 s0 = zero16(), s1 = zero16();
  {
    const bf16_t* qp = PA + (size_t)(cc * 64 + 32 * tt + r) * 6144 + hd * 256 + 8 * h;
    const bf16_t* kp = PA + (size_t)(cc * 64 + r) * 6144 + 1024 + hd * 256 + 8 * h;
#pragma unroll 4
    for (int kk = 0; kk < 16; ++kk) {
      const bf16x8 q = ld16(qp + 16 * kk), k0 = ld16(kp + 16 * kk), k1 = ld16(kp + (size_t)32 * 6144 + 16 * kk);
      s0 = MFMA32(k0, q, s0);
      if (tt == 1) s1 = MFMA32(k1, q, s1);
    }
  }
  const int t = 32 * tt + r;
  const float bt = ((const float*)(ws + WS_BT))[ch * 64 + t];
  const float* asp = (const float*)(ws + WS_AS) + ch * 64;
  float den = 0.f;
#pragma unroll
  for (int g = 0; g < 4; ++g) {
    const f32x4 a0 = *(const f32x4*)(asp + 8 * g + 4 * h);
    const f32x4 a1 = *(const f32x4*)(asp + 32 + 8 * g + 4 * h);
#pragma unroll
    for (int e = 0; e < 4; ++e) {
      const int s = 8 * g + 4 * h + e;
      const float w0 = s <= t ? fexp2(bt + a0[e]) : 0.f;
      const float w1 = (32 + s) <= t ? fexp2(bt + a1[e]) : 0.f;
      s0[4 * g + e] *= w0; s1[4 * g + e] *= w1;
      den += s0[4 * g + e] + s1[4 * g + e];
    }
  }
  den += __shfl_xor(den, 32);
  if (vq == 0 && h == 0) ((float*)(ws + WS_DENA))[(size_t)(cc * 64 + t) * 4 + hd] = den;
  bf16x8 pf[2][2];
  pf[0][0] = pack_acc(s0, 0); pf[0][1] = pack_acc(s0, 1); pf[1][0] = pack_acc(s1, 0); pf[1][1] = pack_acc(s1, 1);
  float* Ho = (float*)(ws + WS_HINTRA) + (size_t)(cc * 64 + t) * 1024 + hd * 256;
#pragma unroll
  for (int vt = 0; vt < 2; ++vt) {
    const int v0 = vq * 64 + vt * 32;
    const bf16_t* vp = VT + (ch * 256 + v0 + r) * 64 + 4 * h;
    f32x16 o = zero16();
#pragma unroll
    for (int st = 0; st < 2; ++st)
#pragma unroll
      for (int s2 = 0; s2 < 2; ++s2) {
        const bf16x8 a = ld8x2(vp + 32 * st + 16 * s2, vp + 32 * st + 16 * s2 + 8);
        o = MFMA32(a, pf[st][s2], o);
      }
#pragma unroll
    for (int g = 0; g < 4; ++g) { f32x4 c = {o[4 * g], o[4 * g + 1], o[4 * g + 2], o[4 * g + 3]}; *(f32x4*)(Ho + v0 + 8 * g + 4 * h) = c; }
  }
}

DI void memattn_task(const Params& p, unsigned char* lds, int task, int layer, const bf16_t* Qb, const bf16_t* Zb, unsigned ldq) {
  const int tid = TIDX, lane = tid & 63, wid = __builtin_amdgcn_readfirstlane(tid >> 6), r = lane & 31, h = lane >> 5;
  unsigned char* ws = p.ws;
  const bool prm = task < 256;
  const int hd = task & 3, ti = prm ? task >> 2 : (task - 256) >> 2;
  const int sbi = prm ? 0 : 1 + ti, tok0 = prm ? ti * 256 : TP + ti * 64, nact = prm ? 8 : 2;
  const bf16_t* MK = (const bf16_t*)(ws + WS_MEMK) + (size_t)(layer * 17 + sbi) * 131072 + hd * 128;
  const bf16_t* MV = (const bf16_t*)(ws + WS_MEMVT) + ((size_t)(layer * 17 + sbi) * 4 + hd) * 128 * 256;
  asm volatile("s_waitcnt vmcnt(0)" ::: "memory");
  __syncthreads();
#pragma unroll
  for (int e = 0; e < 8; ++e) {
    const int q = wid * 8 + e;
    { const int row = 4 * q + (lane >> 4), lc = (lane & 15) ^ (row & 15); dma16(MK + ((unsigned)row * 512u + 8u * lc), lds + q * 1024); }
    { const int row = 2 * q + (lane >> 5), lc = (lane & 31) ^ (row & 15); dma16(MV + ((unsigned)row * 256u + 8u * lc), lds + 65536 + q * 1024); }
  }
  const int tok = tok0 + (wid < nact ? wid : 0) * 32 + r;
  bf16x8 qf[8];
  {
    const bf16_t* qp = Qb + ((unsigned)tok * ldq + hd * 128 + 8 * h);
#pragma unroll
    for (int kk = 0; kk < 8; ++kk) qf[kk] = ld16(qp + 16 * kk);
  }
  asm volatile("s_waitcnt vmcnt(0)" ::: "memory");
  __syncthreads();
  if (wid >= nact) return;
  const float sc = 0.08838834764831845f * LOG2E;
  f32x16 O[4];
#pragma unroll
  for (int vt = 0; vt < 4; ++vt) O[vt] = zero16();
  float mrun = -1e30f, l = 0.f;
  const unsigned sw = r & 15;
#pragma unroll 1
  for (int kb = 0; kb < 4; ++kb) {
    f32x16 s0 = zero16(), s1 = zero16();
    const unsigned char* kp = lds + (kb * 64 + r) * 256;
#pragma unroll
    for (int kk = 0; kk < 8; ++kk) {
      const unsigned co = ((unsigned)(2 * kk + h) ^ sw) << 4;
      const bf16x8 k0 = ld16(kp + co), k1 = ld16(kp + 8192 + co);
      s0 = MFMA32(k0, qf[kk], s0); s1 = MFMA32(k1, qf[kk], s1);
    }
    float mx = -1e30f;
#pragma unroll
    for (int i = 0; i < 16; ++i) mx = fmaxf(mx, fmaxf(s0[i], s1[i]));
    mx = fmaxf(mx, __shfl_xor(mx, 32)) * sc;
    const float mnew = fmaxf(mrun, mx), alpha = fexp2(mrun - mnew);
    mrun = mnew;
    float sum = 0.f;
#pragma unroll
    for (int i = 0; i < 16; ++i) { s0[i] = fexp2(s0[i] * sc - mnew); s1[i] = fexp2(s1[i] * sc - mnew); sum += s0[i] + s1[i]; }
    l = l * alpha + sum;
#pragma unroll
    for (int vt = 0; vt < 4; ++vt) O[vt] = O[vt] * alpha;
    bf16x8 pf[2][2];
    pf[0][0] = pack_acc(s0, 0); pf[0][1] = pack_acc(s0, 1); pf[1][0] = pack_acc(s1, 0); pf[1][1] = pack_acc(s1, 1);
#pragma unroll
    for (int vt = 0; vt < 4; ++vt) {
      const unsigned char* vp = lds + 65536 + (32 * vt + r) * 512;
#pragma unroll
      for (int st = 0; st < 2; ++st)
#pragma unroll
        for (int s2 = 0; s2 < 2; ++s2) {
          const unsigned co = ((unsigned)(8 * kb + 4 * st + 2 * s2 + h) ^ sw) << 4;
          O[vt] = MFMA32(ld16(vp + co), pf[st][s2], O[vt]);
        }
    }
  }
  l += __shfl_xor(l, 32);
  const float inv = 1.f / l;
  const bf16_t* zp = Zb + ((unsigned)tok * ldq + hd * 128);
  bf16_t* op = (bf16_t*)(ws + WS_AO) + ((unsigned)tok * 1536u + 1024 + hd * 128);
#pragma unroll
  for (int vt = 0; vt < 4; ++vt)
#pragma unroll
    for (int g = 0; g < 4; ++g) {
      const int v = 32 * vt + 8 * g + 4 * h;
      const u32x2 z = *(const u32x2*)(zp + v);
      const float o0 = O[vt][4 * g] * inv * siluf_(bflo(z[0])), o1 = O[vt][4 * g + 1] * inv * siluf_(bfhi(z[0]));
      const float o2 = O[vt][4 * g + 2] * inv * siluf_(bflo(z[1])), o3 = O[vt][4 * g + 3] * inv * siluf_(bfhi(z[1]));
      u32x2 o = {pk2(o0, o1), pk2(o2, o3)};
      *(u32x2*)(op + v) = o;
    }
}

DI int next_item(unsigned* ctr, unsigned char* lds_flag_area, int tid) {
  __syncthreads();
  int* sh = (int*)lds_flag_area;
  if (tid == 0) *sh = (int)atomicAdd(ctr, 1u);
  __syncthreads();
  const int v = *sh;
  return v;
}

DI void scanA_task(const Params& p, int hd, int j, int grp);

DI void late_weight_item(const Params& p, unsigned char* lds, int it) {
  unsigned char* ws = p.ws;
  TJob j; int t = it;
  if (t < 192) j = {p.in[I_WOA], 1024, (bf16_t*)(ws + WS_WOA), 1536, nullptr, 24, 8};
  else if (t < 448) { t -= 192; j = {p.in[I_WKV], 2048, (bf16_t*)(ws + WS_WKB), 1024, p.in[I_KVNG], 16, 16}; }
  else if (t < 832) { t -= 448; j = {p.in[I_WINB], 3072, (bf16_t*)(ws + WS_WKB) + (size_t)2048 * 1024, 1024, p.in[I_NG] + 1024, 16, 24}; }
  else { t -= 832; j = {p.in[I_WOB], 1024, (bf16_t*)(ws + WS_WOB), 1536, nullptr, 24, 8}; }
  run_tjob_tile(j, t, (float*)lds, TIDX);
}

DI void phase2(const Params& p, unsigned char* lds) {
  unsigned* ctr = (unsigned*)(p.ws + WS_CTR) + 0 + 8 * p.pad;
  const bf16_t* PA = (const bf16_t*)(p.ws + WS_R1);
  const int n_ps = 36 * 16, n_ss = 576, n_in = NCH * 4, n_ma = 256 + 64;
  for (;;) {
    const int it = next_item(ctr, lds + LDS_BYTES - 16, TIDX);
    if (it >= n_ps + n_ss + n_in + n_ma + 1024) break;
    if (it >= n_ps + n_ss + n_in + n_ma) { late_weight_item(p, lds, it - (n_ps + n_ss + n_in + n_ma)); continue; }
    if (it < n_ps) scanA_task(p, (it % 36) / 9, it % 9, it / 36);
    else if (it < n_ps + n_ss) { const int q = it - n_ps; scan_task(p, lds, q / 36, (q % 36) / 9, q % 9, 0); }
    else if (it < n_ps + n_ss + n_in) { const int q = it - n_ps - n_ss; intra_task(p, q >> 2, q & 3); }
    else { const int q = it - n_ps - n_ss - n_in; memattn_task(p, lds, q, 0, PA + 5120, PA + 5632, 6144); }
  }
}


DI void scanA_task(const Params& p, int hd, int j, int grp) {
  const int tid = TIDX, lane = tid & 63, wid = tid >> 6, r = lane & 31, h = lane >> 5;
  unsigned char* ws = p.ws;
  const bf16_t* KT = (const bf16_t*)(ws + WS_KT);
  const bf16_t* WV = (const bf16_t*)(ws + WS_WVT);
  f32x16 S = zero16();
  u32x4 kn[4], vn[4];
  auto load = [&](int cc) {
    const size_t ch = (size_t)cc * 4 + hd;
    const bf16_t* kp = KT + (ch * 256 + 32 * wid + r) * 64 + 8 * h;
    const bf16_t* vp = WV + (ch * 288 + 32 * j + r) * 64 + 8 * h;
#pragma unroll
    for (int st = 0; st < 4; ++st) { kn[st] = *(const u32x4*)(kp + 16 * st); vn[st] = *(const u32x4*)(vp + 16 * st); }
  };
  load(GRP * grp);
#pragma unroll 1
  for (int c = 0; c < GRP; ++c) {
    const int cc = GRP * grp + c;
    bf16x8 kt[4], wv[4];
#pragma unroll
    for (int st = 0; st < 4; ++st) { kt[st] = __builtin_bit_cast(bf16x8, kn[st]); wv[st] = __builtin_bit_cast(bf16x8, vn[st]); }
    if (c + 1 < GRP) load(cc + 1);
    u32x4* cl = (u32x4*)(ws + WS_CLOCC) + ((((size_t)cc * 4 + hd) * 9 + j) * 8 + wid) * 128 + lane;
    cl[0] = __builtin_bit_cast(u32x4, pack_acc(S, 0));
    cl[64] = __builtin_bit_cast(u32x4, pack_acc(S, 1));
    f32x16 D = zero16();
#pragma unroll
    for (int st = 0; st < 4; ++st) D = MFMA32(kt[st], wv[st], D);
    const float dec = ((const float*)(ws + WS_DEC))[cc * 4 + hd], cf = ((const float*)(ws + WS_CFAC))[cc * 4 + hd];
    S = S * dec + D * cf;
  }
  float* cl = (float*)(ws + WS_CLOC) + ((((size_t)(grp * 4 + hd) * 9 + j) * 8 + wid) * 64 + lane) * 16;
#pragma unroll
  for (int g = 0; g < 4; ++g) { f32x4 c = {S[4 * g], S[4 * g + 1], S[4 * g + 2], S[4 * g + 3]}; *(f32x4*)(cl + 4 * g) = c; }
}

DI void scanfix_task(const Params& p, unsigned char* lds, int grp, int hd, int j) {
  const int tid = TIDX, lane = tid & 63, wid = tid >> 6, r = lane & 31, h = lane >> 5;
  unsigned char* ws = p.ws;
  const bool nsl = j == 8;
  const float* LD = (const float*)(ws + WS_LD);
  f32x16 S = zero16();
#pragma unroll 4
  for (int gp = 0; gp < grp; ++gp) {
    const float dg = __expf(LD[(GRP * (gp + 1)) * 4 + hd] - LD[(GRP * gp) * 4 + hd]);
    const float* cl = (const float*)(ws + WS_CLOC) + ((((size_t)(gp * 4 + hd) * 9 + j) * 8 + wid) * 64 + lane) * 16;
#pragma unroll
    for (int g = 0; g < 4; ++g) { const f32x4 c = *(const f32x4*)(cl + 4 * g);
      S[4 * g] = S[4 * g] * dg + c[0]; S[4 * g + 1] = S[4 * g + 1] * dg + c[1]; S[4 * g + 2] = S[4 * g + 2] * dg + c[2]; S[4 * g + 3] = S[4 * g + 3] * dg + c[3]; }
  }
  if (grp == 16) {
    if (!nsl) {
      float* Co = p.out + O_PC + (size_t)hd * 65536 + (size_t)(32 * j + r) * 256 + 32 * wid;
#pragma unroll
      for (int g = 0; g < 4; ++g) { f32x4 c = {S[4 * g], S[4 * g + 1], S[4 * g + 2], S[4 * g + 3]}; *(f32x4*)(Co + 8 * g + 4 * h) = c; }
    } else if (r == 0) {
      float* no = p.out + O_PN + (size_t)hd * 256 + 32 * wid;
#pragma unroll
      for (int g = 0; g < 4; ++g) { f32x4 c = {S[4 * g], S[4 * g + 1], S[4 * g + 2], S[4 * g + 3]}; *(f32x4*)(no + 8 * g + 4 * h) = c; }
    }
    return;
  }
  u32x4* fr = (u32x4*)lds;
  float* tp = (float*)(lds + 16384) + wid * (64 * 33);
  __syncthreads();
  fr[(wid * 2 + 0) * 64 + lane] = __builtin_bit_cast(u32x4, pack_acc(S, 0));
  fr[(wid * 2 + 1) * 64 + lane] = __builtin_bit_cast(u32x4, pack_acc(S, 1));
  __syncthreads();
  const bf16_t* PA = (const bf16_t*)(ws + WS_R1);
  const float* WIa = (const float*)(ws + WS_WI);
  const bool hasg = grp > 0;
#pragma unroll
  for (int ci = 0; ci < 2; ++ci) {
    const int cc = GRP * grp + wid + 8 * ci;
    const float D = __expf(LD[cc * 4 + hd] - LD[(GRP * grp) * 4 + hd]);
    const u32x4* clc = (const u32x4*)(ws + WS_CLOCC) + (((size_t)cc * 4 + hd) * 9 + j) * 8 * 128 + lane;
#pragma unroll
    for (int tt = 0; tt < 2; ++tt) {
      const bf16_t* qp = PA + (size_t)(cc * 64 + 32 * tt + r) * 6144 + hd * 256 + 8 * h;
      f32x16 z = zero16(), z2 = zero16();
#pragma unroll
      for (int kt = 0; kt < 8; ++kt)
#pragma unroll
        for (int s2 = 0; s2 < 2; ++s2) {
          const bf16x8 q = ld16(qp + 32 * kt + 16 * s2);
          z = MFMA32(__builtin_bit_cast(bf16x8, clc[(kt * 2 + s2) * 64]), q, z);
          if (hasg) z2 = MFMA32(__builtin_bit_cast(bf16x8, fr[(kt * 2 + s2) * 64 + lane]), q, z2);
        }
#pragma unroll
      for (int i = 0; i < 16; ++i) tp[(32 * tt + r) * 33 + crow(i, h)] = z[i] + D * z2[i];
    }
    const int v = lane & 31;
#pragma unroll 4
    for (int e = 0; e < 32; ++e) {
      const int t = 2 * e + (lane >> 5);
      const float val = tp[t * 33 + v] * WIa[((size_t)cc * 4 + hd) * 64 + t];
      if (!nsl) ((float*)(ws + WS_HINTER))[(size_t)(cc * 64 + t) * 1024 + hd * 256 + 32 * j + v] = val;
      else if (v == 0) ((float*)(ws + WS_DENI))[(size_t)(cc * 64 + t) * 4 + hd] = val;
    }
  }
}

DI void phase2c(const Params& p, unsigned char* lds) {
  unsigned* ctr = (unsigned*)(p.ws + WS_CTR) + 3 + 8 * p.pad;
  for (;;) {
    const int it = next_item(ctr, lds + LDS_BYTES - 16, TIDX);
    if (it >= 17 * 36) break;
    const int g = 16 - it / 36;
    scanfix_task(p, lds, g, (it % 36) / 9, it % 9);
  }
}

DI void phase3(const Params& p) {
  const int tid = TIDX, lane = tid & 63, wid = tid >> 6;
  unsigned char* ws = p.ws;
  const int gw = blockIdx.x * 8 + wid, nw = gridDim.x * 8;
  const bf16_t* PA = (const bf16_t*)(ws + WS_R1);
  for (int it = gw; it < TT * 4; it += nw) {
    const int tok = it >> 2, hd = it & 3, cc = tok >> 6, t = tok & 63;
    const size_t off = (size_t)tok * 1024 + hd * 256 + 4 * lane;
    const f32x4 a = *(const f32x4*)((const float*)(ws + WS_HINTER) + off), b = *(const f32x4*)((const float*)(ws + WS_HINTRA) + off);
    const float den = ((const float*)(ws + WS_DENI))[tok * 4 + hd] + ((const float*)(ws + WS_DENA))[tok * 4 + hd];
    const float mt = ((const float*)(ws + WS_MT))[((size_t)cc * 4 + hd) * 64 + t];
    const float dn = 1.f / fmaxf(fabsf(den), __expf(-mt));
    const u32x2 ou = *(const u32x2*)(PA + (size_t)tok * 6144 + 3072 + hd * 256 + 4 * lane);
    const u32x2 zu = *(const u32x2*)(PA + (size_t)tok * 6144 + 4096 + hd * 256 + 4 * lane);
    f32x4 hv = (a + b) * dn;
    hv[0] *= sigmoidf_(bflo(ou[0])); hv[1] *= sigmoidf_(bfhi(ou[0])); hv[2] *= sigmoidf_(bflo(ou[1])); hv[3] *= sigmoidf_(bfhi(ou[1]));
    float ss = hv[0] * hv[0] + hv[1] * hv[1] + hv[2] * hv[2] + hv[3] * hv[3];
    ss = wave_sum(ss);
    const float rstd = __builtin_amdgcn_rsqf(ss * (1.f / 256.f) + EPS);
    const f32x4 hg = *(const f32x4*)(p.in[I_HGA] + hd * 256 + 4 * lane);
    hv = hv * rstd * hg;
    hv[0] *= siluf_(bflo(zu[0])); hv[1] *= siluf_(bfhi(zu[0])); hv[2] *= siluf_(bflo(zu[1])); hv[3] *= siluf_(bfhi(zu[1]));
    u32x2 o = {pk2(hv[0], hv[1]), pk2(hv[2], hv[3])};
    *(u32x2*)((bf16_t*)(ws + WS_AO) + (size_t)tok * 1536 + hd * 256 + 4 * lane) = o;
  }
}

DI void cacheconv_item(const Params& p, unsigned char* lds, int it);

DI void phase_outproj(const Params& p, unsigned char* lds, int layer) {
  const int tid = TIDX, lane = tid & 63, wid = tid >> 6, r = lane & 31, h = lane >> 5, wr = wid >> 1, wc = wid & 1;
  unsigned char* ws = p.ws;
  const bf16_t* W = (const bf16_t*)(ws + (layer == 0 ? WS_WOA : WS_WOB));
  for (int t = blockIdx.x; t < 512 + 64; t += gridDim.x) {
    GemmAcc acc;
    int m0, n0, nb;
    if (t < 512) {
      m0 = (t >> 3) * 256; n0 = (t & 7) * 128; nb = 2;
      gemm_tile<2>((const bf16_t*)(ws + WS_AO) + (size_t)m0 * 1536, 1536, W + (size_t)n0 * 1536, 1536, 1536, lds, acc, tid);
    } else {
      const int q = t - 512;
      m0 = (64 + (q >> 4)) * 256; n0 = (q & 15) * 64; nb = 1;
      gemm_tile<1>((const bf16_t*)(ws + WS_AO) + (size_t)m0 * 1536, 1536, W + (size_t)n0 * 1536, 1536, 1536, lds, acc, tid);
    }
#pragma unroll
    for (int a = 0; a < 2; ++a)
#pragma unroll
      for (int b = 0; b < 2; ++b) {
        if (b >= nb) continue;
        const int n = n0 + wc * 32 * nb + 32 * b + r, mb = m0 + wr * 64 + 32 * a;
#pragma unroll
        for (int i = 0; i < 16; ++i) {
          const int m = mb + crow(i, h);
          if (layer == 0) {
            const float xv = m < TP ? p.in[I_XP][(size_t)m * 1024 + n] : p.in[I_XS][(size_t)(m - TP) * 1024 + n];
            ((float*)(ws + WS_Y1))[(size_t)m * 1024 + n] = xv + acc.a[a][b][i];
          } else {
            p.out[O_Y + (size_t)m * 1024 + n] = ((const float*)(ws + WS_Y1))[(size_t)m * 1024 + n] + acc.a[a][b][i];
          }
        }
      }
  }
  if (layer == 0) {
    unsigned* ctr = (unsigned*)(p.ws + WS_CTR) + 4 + 8 * p.pad;
    for (;;) {
      const int it = next_item(ctr, lds + LDS_BYTES - 16, TIDX);
      if (it >= 1024) break;
      cacheconv_item(p, lds, it);
    }
  }
}

DI void phase5(const Params& p, unsigned char* lds) {
  const int tid = TIDX, lane = tid & 63, wid = tid >> 6;
  unsigned char* ws = p.ws;
  const int gw = blockIdx.x * 8 + wid, nw = gridDim.x * 8;
  for (int r = gw; r < TT; r += nw) {
    f32x4 v[4];
    const float rstd = row_load_rstd((const float*)(ws + WS_Y1) + (size_t)r * 1024, v, lane);
    bf16_t* xn = (bf16_t*)(ws + WS_XN) + (size_t)r * 1024;
#pragma unroll
    for (int j = 0; j < 4; ++j) { const f32x4 xs = v[j] * rstd; u32x2 o = {pk2(xs[0], xs[1]), pk2(xs[2], xs[3])}; *(u32x2*)(xn + 4 * lane + 256 * j) = o; }
  }
}

DI void cacheconv_item(const Params& p, unsigned char* lds, int it) {
  const int tid = TIDX;
  unsigned char* ws = p.ws;
  if (it < 512) {
    const int b = it >> 5, slab = it & 31;
    float* smax = (float*)lds;
    const int hm = (tid & 127) >> 3;
    __syncthreads();
    if (tid < 16) smax[tid] = 0.f;
    __syncthreads();
    float mx = 0.f;
    const float* src = p.in[I_CK] + ((size_t)b * PAST + slab * 128) * 1024;
    bf16_t* dst = (bf16_t*)(ws + WS_KBS) + ((size_t)b * SKV + slab * 128) * 1024;
#pragma unroll 4
    for (int i = 0; i < 32; ++i) {
      const unsigned e = (unsigned)(i * NTHREADS + tid) * 8u;
      const f32x4 a = *(const f32x4*)(src + e), c = *(const f32x4*)(src + e + 4);
      u32x4 o = {pk2(a[0], a[1]), pk2(a[2], a[3]), pk2(c[0], c[1]), pk2(c[2], c[3])};
      *(u32x4*)(dst + e) = o;
      float ss = a[0] * a[0] + a[1] * a[1] + a[2] * a[2] + a[3] * a[3] + c[0] * c[0] + c[1] * c[1] + c[2] * c[2] + c[3] * c[3];
      ss += __shfl_xor(ss, 1); ss += __shfl_xor(ss, 2); ss += __shfl_xor(ss, 4);
      mx = fmaxf(mx, ss);
    }
    if ((tid & 7) == 0) atomicMax((unsigned*)smax + hm, __float_as_uint(mx));
    __syncthreads();
    if (tid < 16) atomicMax((unsigned*)(ws + WS_KMAX) + (1 + b) * 16 + tid, __float_as_uint(sqrtf(smax[tid])));
  } else {
    const int q = it - 512, jb = q >> 2, part = q & 3, b = jb >> 3, hd = jb & 7;
    TJob j = {p.in[I_CV] + (size_t)b * PAST * 1024 + hd * 128, 1024, (bf16_t*)(ws + WS_VTS) + ((size_t)(b * 8 + hd) * 128) * SKV, SKV, nullptr, 64, 1};
    for (int tile = part * 16; tile < part * 16 + 16; ++tile) run_tjob_tile(j, tile, (float*)lds, tid, true);
  }
}

DI void phase6(const Params& p, unsigned char* lds) {
  const int tid = TIDX, lane = tid & 63, wid = tid >> 6, r = lane & 31, h = lane >> 5;
  unsigned char* ws = p.ws;
  for (int t = blockIdx.x; t < 68 * 20; t += gridDim.x) {
    const int tm = t / 20, tn = t % 20, m0 = tm * 256, n0 = tn * 256;
    GemmAcc acc2[2];
    gemm256((const bf16_t*)(ws + WS_XN) + (size_t)m0 * 1024, 1024, (const bf16_t*)(ws + WS_WKB) + (size_t)n0 * 1024, 1024, 1024, lds, acc2, tid);
    const int sec = n0 >> 10;
    const bool samp = m0 >= TP;
#pragma unroll
    for (int mh = 0; mh < 2; ++mh) {
    const GemmAcc& acc = acc2[mh];
    const int wr = (wid >> 2) * 2 + mh, wc = wid & 3;
#pragma unroll
    for (int a = 0; a < 2; ++a)
#pragma unroll
      for (int b = 0; b < 2; ++b) {
        __builtin_amdgcn_sched_barrier(0);
        const int n = n0 + wc * 64 + 32 * b + r, mb = m0 + wr * 64 + 32 * a;
        if (sec == 0) {
          const int f = n;
          if (b == 1) {
            float mx = 0.f;
#pragma unroll
            for (int i = 0; i < 16; ++i) {
              float ss = acc.a[a][0][i] * acc.a[a][0][i] + acc.a[a][1][i] * acc.a[a][1][i];
              ss += __shfl_xor(ss, 1); ss += __shfl_xor(ss, 2); ss += __shfl_xor(ss, 4); ss += __shfl_xor(ss, 8); ss += __shfl_xor(ss, 16);
              mx = fmaxf(mx, ss);
            }
            mx = fmaxf(mx, __shfl_xor(mx, 32));
            if (lane == 0) {
              const int strm = samp ? 1 + ((mb - TP) >> 6) : 0;
              atomicMax((unsigned*)(ws + WS_KMAX) + strm * 16 + ((n0 + wc * 64) >> 6), __float_as_uint(sqrtf(mx)));
            }
          }
#pragma unroll
          for (int i = 0; i < 16; ++i) {
            const int m = mb + crow(i, h);
            const float v = acc.a[a][b][i];
            if (!samp) { (p.out + O_PK)[(unsigned)(m * 1024 + f)] = v; ((bf16_t*)(ws + WS_KBP))[(unsigned)(m * 1024 + f)] = f2bf(v); }
            else { const int ms = m - TP, bb = ms >> 6, s = ms & 63; (p.out + O_SK)[(unsigned)(ms * 1024 + f)] = v;
                   ((bf16_t*)(ws + WS_KBS))[(unsigned)((bb * SKV + PAST + s) * 1024 + f)] = f2bf(v); }
          }
        } else if (sec == 1) {
          const int f = n - 1024, hd = f >> 7, vd = f & 127;
#pragma unroll
          for (int i = 0; i < 16; ++i) {
            const int m = mb + crow(i, h);
            if (!samp) (p.out + O_PV)[(unsigned)(m * 1024 + f)] = acc.a[a][b][i]; else (p.out + O_SV)[(unsigned)((m - TP) * 1024 + f)] = acc.a[a][b][i];
          }
#pragma unroll
          for (int g = 0; g < 4; ++g) {
            const int m0r = mb + 8 * g + 4 * h, pq = (m0r >> 2) & 3;
            const int m = (m0r & ~15) + 4 * (((pq & 1) << 1) | (pq >> 1));
            u32x2 o = {pk2(acc.a[a][b][4 * g], acc.a[a][b][4 * g + 1]), pk2(acc.a[a][b][4 * g + 2], acc.a[a][b][4 * g + 3])};
            if (!samp) *(u32x2*)((bf16_t*)(ws + WS_VTP) + (unsigned)((hd * 128 + vd) * TP + m)) = o;
            else { const int ms = m - TP, bb = ms >> 6, s = ms & 63; *(u32x2*)((bf16_t*)(ws + WS_VTS) + (unsigned)(((bb * 8 + hd) * 128 + vd) * SKV + PAST + s)) = o; }
          }
        } else {
          const float sc = sec == 2 ? 0.125f * LOG2E : 1.f;
          bf16_t* PB = (bf16_t*)(ws + WS_PB);
#pragma unroll
          for (int i = 0; i < 16; ++i) PB[(unsigned)((mb + crow(i, h)) * 3072 + (n - 2048))] = f2bf(acc.a[a][b][i] * sc);
        }
      }
    }
  }
}

constexpr int A_BUF = 32768, A_KB = 16384, A_FLAGS = 3 * A_BUF;

DI void diffattn_task(const Params& p, unsigned char* lds, int sb  , int qt  , int hd, float lam) {
  const int tid = TIDX, lane = tid & 63, wid = __builtin_amdgcn_readfirstlane(tid >> 6), r = lane & 31, h = lane >> 5;
  unsigned char* ws = p.ws;
  const int cq = wid >> 2, sub = (wid >> 1) & 1, map = wid & 1;
  const int ncq = sb < 0 ? 2 : 1;
  const int base_chunk = sb < 0 ? 2 * qt : 64;
  const int tok0 = sb < 0 ? qt * 128 : TP + sb * 64;
  const bool wvalid = cq < ncq;
  const int qc = base_chunk + cq;
  const int tl = 32 * sub + r;
  const int tok = tok0 + 64 * (wvalid ? cq : 0) + tl;
  const bf16_t* Kb = sb < 0 ? (const bf16_t*)(ws + WS_KBP) + hd * 128 : (const bf16_t*)(ws + WS_KBS) + (size_t)sb * SKV * 1024 + hd * 128;
  const bf16_t* Vb = sb < 0 ? (const bf16_t*)(ws + WS_VTP) + (size_t)hd * 128 * TP : (const bf16_t*)(ws + WS_VTS) + (size_t)(sb * 8 + hd) * 128 * SKV;
  const unsigned ldv = sb < 0 ? TP : SKV;
  const bf16_t* PB = (const bf16_t*)(ws + WS_PB);
  bf16x8 qf[4];
  float qn = 0.f;
  {
    const unsigned qo = (unsigned)tok * 3072u + hd * 128 + map * 64 + 8 * h;
#pragma unroll
    for (int kk = 0; kk < 4; ++kk) {
      const u32x4 u = *(const u32x4*)(PB + (qo + 16 * kk));
      qf[kk] = __builtin_bit_cast(bf16x8, u);
#pragma unroll
      for (int e = 0; e < 4; ++e) { const float a = bflo(u[e]), b = bfhi(u[e]); qn += a * a + b * b; }
    }
    qn += __shfl_xor(qn, 32);
    qn = sqrtf(qn);
  }
  const float kmax = ((const float*)(ws + WS_KMAX))[(sb < 0 ? 0 : 1 + sb) * 16 + hd * 2 + map];
  const float shift = qn * kmax * 1.02f + 0.5f - 16.f;
  const float sl2 = exp2f(-(float)(hd + 1)) * LOG2E;
  const int wd = diff_window(hd);
  const float bh0 = sl2 * (float)(4 * h) - sl2 * (float)tl - shift, bh1 = bh0 + 32.f * sl2;
  float cs[16];
#pragma unroll
  for (int i = 0; i < 16; ++i) cs[i] = __uint_as_float(__builtin_amdgcn_readfirstlane(__float_as_uint(sl2 * (float)((i & 3) + 8 * (i >> 2)))));
  f32x16 O[4];
#pragma unroll
  for (int vt = 0; vt < 4; ++vt) O[vt] = zero16();
  float l = 0.f;
  const int jmax = base_chunk + ncq - 1;
  const int jmin = max(0, base_chunk - wd);
  const int nit = jmax - jmin + 1;
  unsigned kofs[2], vofs[2];
#pragma unroll
  for (int e = 0; e < 2; ++e) {
    const int q = wid * 2 + e;
    { const int row = 4 * q + (lane >> 4), lc = (lane & 15) ^ (row & 15); kofs[e] = (unsigned)row * 1024u + 8u * lc; }
    { const int row = 8 * q + (lane >> 3), lc = (lane & 7) ^ ((row >> 1) & 7); vofs[e] = (unsigned)row * ldv + 8u * lc; }
  }
  auto issue = [&](int j, int buf) {
    const bf16_t* kj = Kb + (size_t)j * 65536;
    const bf16_t* vj = Vb + (size_t)j * 64;
    unsigned char* base = lds + buf * A_BUF;
#pragma unroll
    for (int e = 0; e < 2; ++e) {
      dma16(kj + kofs[e], base + (wid * 2 + e) * 1024);
      dma16(vj + vofs[e], base + A_KB + (wid * 2 + e) * 1024);
    }
  };
  unsigned kco[4], vco[4];
#pragma unroll
  for (int kk = 0; kk < 4; ++kk) kco[kk] = (unsigned)r * 256u + ((((unsigned)(8 * map + 2 * kk + h)) ^ (unsigned)(r & 15)) << 4);
#pragma unroll
  for (int sx = 0; sx < 4; ++sx) vco[sx] = A_KB + (unsigned)r * 128u + ((((unsigned)(2 * sx + h)) ^ (unsigned)((r >> 1) & 7)) << 4);
  asm volatile("s_waitcnt vmcnt(0)" ::: "memory");
  __syncthreads();
  issue(jmax, 0);
  if (nit > 1) issue(jmax - 1, 1);
  for (int it = 0; it < nit; ++it) {
    const int j = jmax - it;
    if (it + 1 < nit) asm volatile("s_waitcnt vmcnt(4)" ::: "memory"); else asm volatile("s_waitcnt vmcnt(0)" ::: "memory");
    asm volatile("s_waitcnt lgkmcnt(0)" ::: "memory");
    __builtin_amdgcn_s_barrier();
    if (it + 2 < nit) issue(j - 2, (it + 2) % 3);
    if (wvalid && j <= qc && qc - j <= wd) {
      const unsigned char* base = lds + (it % 3) * A_BUF;
      const float dofs = sl2 * (float)((qc - j) * 64);
      float sum = 0.f;
#pragma unroll
      for (int half = 0; half < 2; ++half) {
        f32x16 sc;
        {
          float b0 = (half ? bh1 : bh0) - dofs;
          asm volatile("" : "+v"(b0));
#pragma unroll
          for (int i = 0; i < 16; ++i) sc[i] = b0 + cs[i];
        }
        if (j == qc) {
          int tlv = tl;
          asm volatile("" : "+v"(tlv));
          const float m2 = -2.f * sl2, xt = (float)(4 * h + 32 * half - tlv);
#pragma unroll
          for (int i = 0; i < 16; ++i) sc[i] = fmaf(m2, fmaxf(xt + (float)((i & 3) + 8 * (i >> 2)), 0.f), sc[i]);
        }
        {
          bf16x8 kf[4];
#pragma unroll
          for (int kk = 0; kk < 4; ++kk) kf[kk] = ld16(base + 8192 * half + kco[kk]);
#pragma unroll
          for (int kk = 0; kk < 4; ++kk) sc = MFMA32(kf[kk], qf[kk], sc);
        }
        bf16x8 vf[8];
#pragma unroll
        for (int vt = 0; vt < 4; ++vt) { vf[2 * vt] = ld16(base + 4096 * vt + vco[2 * half]); vf[2 * vt + 1] = ld16(base + 4096 * vt + vco[2 * half + 1]); }
#pragma unroll
        for (int i = 0; i < 16; ++i) { sc[i] = fexp2(sc[i]); sum += sc[i]; }
        const bf16x8 p0 = pack_acc(sc, 0), p1 = pack_acc(sc, 1);
#pragma unroll
        for (int vt = 0; vt < 4; ++vt) { O[vt] = MFMA32(vf[2 * vt], p0, O[vt]); O[vt] = MFMA32(vf[2 * vt + 1], p1, O[vt]); }
      }
      l += sum;
    }
  }
  asm volatile("s_waitcnt vmcnt(0)" ::: "memory");
  __syncthreads();
  l += __shfl_xor(l, 32);
  const float inv = wvalid ? 1.f / l : 0.f;
  float* xch = (float*)lds + (size_t)(wid >> 1) * 4096;
  if (map == 1 && wvalid) {
    const float sc = inv * lam;
#pragma unroll
    for (int vt = 0; vt < 4; ++vt)
#pragma unroll
      for (int i = 0; i < 16; ++i) xch[(vt * 16 + i) * 64 + lane] = O[vt][i] * sc;
  }
  __syncthreads();
  if (map == 0 && wvalid) {
    float ss = 0.f;
#pragma unroll
    for (int vt = 0; vt < 4; ++vt)
#pragma unroll
      for (int i = 0; i < 16; ++i) { const float o = O[vt][i] * inv - xch[(vt * 16 + i) * 64 + lane]; O[vt][i] = o; ss += o * o; }
    ss += __shfl_xor(ss, 32);
    const float lam_init = 0.8f - 0.6f * 0.7408182206817179f;
    const float rs = __builtin_amdgcn_rsqf(ss * (1.f / 128.f) + EPS) * (1.f - lam_init);
    const unsigned zo = (unsigned)tok * 3072u + 1024 + hd * 128, oo = (unsigned)tok * 1536u + hd * 128;
    bf16_t* AOp = (bf16_t*)(ws + WS_AO);
    const float* sg = p.in[I_SUBG];
#pragma unroll
    for (int vt = 0; vt < 4; ++vt)
#pragma unroll
      for (int g = 0; g < 4; ++g) {
        const int v = 32 * vt + 8 * g + 4 * h;
        const u32x2 z = *(const u32x2*)(PB + (zo + v));
        const f32x4 gg = *(const f32x4*)(sg + v);
        const float o0 = O[vt][4 * g] * rs * gg[0] * siluf_(bflo(z[0])), o1 = O[vt][4 * g + 1] * rs * gg[1] * siluf_(bfhi(z[0]));
        const float o2 = O[vt][4 * g + 2] * rs * gg[2] * siluf_(bflo(z[1])), o3 = O[vt][4 * g + 3] * rs * gg[3] * siluf_(bfhi(z[1]));
        u32x2 o = {pk2(o0, o1), pk2(o2, o3)};
        *(u32x2*)(AOp + (oo + v)) = o;
      }
  }
  __syncthreads();
}

DI void phase7(const Params& p, unsigned char* lds) {
  unsigned* ctr = (unsigned*)(p.ws + WS_CTR) + 1 + 8 * p.pad;
  const bf16_t* PB = (const bf16_t*)(p.ws + WS_PB);
  float lam;
  {
    const int lane = TIDX & 63;
    const float* lv = p.in[I_LAMB];
    const float a = wave_sum(lv[lane] * lv[64 + lane]), b = wave_sum(lv[128 + lane] * lv[192 + lane]);
    const float lam_init = 0.8f - 0.6f * 0.7408182206817179f;
    lam = __expf(a) - __expf(b) + lam_init;
  }
  const int n_s = 128, n_p = 1024, n_ma = 256 + 64;
  const int* tord = (const int*)(p.ws + WS_TORD);
  for (;;) {
    const int it = next_item(ctr, lds + LDS_BYTES - 16, TIDX);
    if (it >= n_s + n_p) break;
    const int a = tord[it];
    const bool pr = a < n_p;
    diffattn_task(p, lds, pr ? -1 : ((a - n_p) >> 3), pr ? (a >> 3) : 0, a & 7, lam);
  }
  for (;;) {
    const int it = next_item(ctr + 1, lds + LDS_BYTES - 16, TIDX);
    if (it >= n_ma) break;
    memattn_task(p, lds, it, 1, PB + 2048, PB + 2560, 3072);
  }
}

DI void phase9(const Params& p) {
  const int tid = TIDX, lane = tid & 63, wid = tid >> 6;
  const int gw = blockIdx.x * 8 + wid, nw = gridDim.x * 8;
  for (int r = gw; r < TT; r += nw) {
    f32x4 v[4];
    float* row = p.out + O_Y + (size_t)r * 1024;
    const float rstd = row_load_rstd(row, v, lane);
#pragma unroll
    for (int j = 0; j < 4; ++j) {
      const f32x4 g = *(const f32x4*)(p.in[I_FNG] + 4 * lane + 256 * j);
      *(f32x4*)(row + 4 * lane + 256 * j) = v[j] * rstd * g;
    }
  }
}

#define XB_TMO      128
#define XB_XCNT(j)  (256  + 64 * (j))
#define XB_XSUB(j)  (1280 + 64 * (j))
#define XB_XGEN(j)  (2304 + 64 * (j))
#define XB_TOP      3328
#define XB_TOPGEN   3392
#define XB_SPIN_CAP (1u << 20)
DI unsigned xb_ld(unsigned* p)              { return __hip_atomic_load(p, __ATOMIC_RELAXED, __HIP_MEMORY_SCOPE_AGENT); }
DI unsigned xb_add(unsigned* p, unsigned v) { return __hip_atomic_fetch_add(p, v, __ATOMIC_RELAXED, __HIP_MEMORY_SCOPE_AGENT); }
DI unsigned xb_xcc_id() { return (unsigned)__builtin_amdgcn_s_getreg((3 << 11) | 20) & 0xFu; }
#define XB_SPIN(cond, bar) do { unsigned _sp = 0; while (cond) { __builtin_amdgcn_s_sleep(1); \
    if ((++_sp & 255u) == 0u) { if (xb_ld(&(bar)[XB_TMO])) break; if (_sp > XB_SPIN_CAP) { atomicAdd(&(bar)[XB_TMO], 1u); break; } } } } while (0)

DI void xcd_barrier_complete(unsigned* bar, unsigned x, unsigned& nloc, unsigned& nx) {
  const unsigned G = gridDim.x;
  unsigned sum, cnt, mine, sp = 0u;
  for (;;) {
    sum = 0u; cnt = 0u; mine = 0u;
#pragma unroll
    for (unsigned j = 0; j < 16; ++j) { const unsigned c = xb_ld(&bar[XB_XCNT(j)]); sum += c; cnt += (c > 0u) ? 1u : 0u; mine = (j == x) ? c : mine; }
    if (sum == G) break;
    __builtin_amdgcn_s_sleep(1);
    if ((++sp & 255u) == 0u) { if (xb_ld(&bar[XB_TMO])) break; if (sp > XB_SPIN_CAP) { atomicAdd(&bar[XB_TMO], 1u); break; } }
  }
  nloc = mine > 0u ? mine : 1u; nx = cnt > 0u ? cnt : 1u;
}

DI void grid_barrier(unsigned* bar, unsigned x, volatile unsigned* st, int tid) {
  asm volatile("s_waitcnt vmcnt(0)" ::: "memory");
  __syncthreads();
  if (tid == 0) {
    __builtin_amdgcn_s_waitcnt(0);
    unsigned nloc = st[0], nx = st[1];
    if (nloc == 0u) { xcd_barrier_complete(bar, x, nloc, nx); st[0] = nloc; st[1] = nx; }
    const unsigned old = xb_add(&bar[XB_XSUB(x)], 1u);
    const unsigned gen = old / nloc;
    if (old + 1u == (gen + 1u) * nloc) {
      __builtin_amdgcn_fence(__ATOMIC_RELEASE, "agent");
      asm volatile("s_waitcnt vmcnt(0)" ::: "memory");
      const unsigned og = xb_add(&bar[XB_TOP], 1u);
      const unsigned tg = og / nx;
      if (og + 1u == (tg + 1u) * nx) xb_add(&bar[XB_TOPGEN], 1u);
      else XB_SPIN(xb_ld(&bar[XB_TOPGEN]) == tg, bar);
      __builtin_amdgcn_fence(__ATOMIC_ACQUIRE, "agent");
      xb_add(&bar[XB_XGEN(x)], 1u);
      asm volatile("s_waitcnt vmcnt(0)" ::: "memory");
    } else {
      XB_SPIN(xb_ld(&bar[XB_XGEN(x)]) == gen, bar);
      __builtin_amdgcn_fence(__ATOMIC_ACQUIRE, "agent");
      asm volatile("s_waitcnt vmcnt(0)" ::: "memory");
    }
  }
  __syncthreads();
}

__global__ __launch_bounds__(512) void mk(Params pin) {
  extern __shared__ __attribute__((aligned(16))) unsigned char lds[];
  Params p = pin;
  p.wv = __builtin_amdgcn_readfirstlane((int)(__builtin_amdgcn_workitem_id_x() >> 6));
  cg::grid_group grid = cg::this_grid();
  unsigned* bar = (unsigned*)(p.ws + WS_XBAR);
  volatile unsigned* st = (volatile unsigned*)(lds + LDS_BYTES - 64);
  unsigned xcc = 0;
#define RUN_PHASE(PH, CALL) if (p.ph_lo <= PH && PH < p.ph_hi) { CALL; if (PH + 1 < p.ph_hi) grid_barrier(bar, xcc, st, TIDX); }
  if (p.ph_lo <= 0 && 0 < p.ph_hi) { phase0(p, lds); if (1 < p.ph_hi) grid.sync(); }
  {
    xcc = xb_xcc_id();
    __syncthreads();
    if (TIDX == 0) { st[0] = 0u; st[1] = 0u; (void)xb_add(&bar[XB_XCNT(xcc)], 1u); }
    __syncthreads();
  }
  RUN_PHASE(1, phase1(p, lds))
  RUN_PHASE(2, phase2(p, lds))
  if (p.ph_lo <= 2 && 2 < p.ph_hi) { phase2c(p, lds); grid_barrier(bar, xcc, st, TIDX); }
  RUN_PHASE(3, phase3(p))
  RUN_PHASE(4, phase_outproj(p, lds, 0))
  RUN_PHASE(5, phase5(p, lds))
  RUN_PHASE(6, phase6(p, lds))
  RUN_PHASE(7, phase7(p, lds))
  RUN_PHASE(8, phase_outproj(p, lds, 1))
  RUN_PHASE(9, phase9(p))
}

extern "C" void kernel_launch(void* const* d_in, const int* in_sizes, int n_in, void* d_out, int out_size,
                              void* d_ws, size_t ws_size, hipStream_t stream) {
  static int grid_blocks = 0;
  if (!grid_blocks) {
    int dev = 0, cus = 0, per_cu = 0;
    (void)hipGetDevice(&dev);
    (void)hipDeviceGetAttribute(&cus, hipDeviceAttributeMultiprocessorCount, dev);
    (void)hipFuncSetAttribute((const void*)mk, hipFuncAttributeMaxDynamicSharedMemorySize, LDS_BYTES);
    (void)hipOccupancyMaxActiveBlocksPerMultiprocessor(&per_cu, (const void*)mk, NTHREADS, LDS_BYTES);
    grid_blocks = cus;
    fprintf(stderr, "kernel_launch: cus=%d per_cu=%d grid=%d ws=%zu need=%zu\n", cus, per_cu, grid_blocks, ws_size, (size_t)WS_END);
  }
  if (ws_size < WS_END) { fprintf(stderr, "workspace too small\n"); return; }
  Params p{};
  for (int i = 0; i < 24; ++i) p.in[i] = (const float*)d_in[i];
  p.out = (float*)d_out; p.ws = (unsigned char*)d_ws; p.ph_lo = 0; p.ph_hi = NPHASE;
  void* args[] = {&p};
  hipError_t e = hipLaunchCooperativeKernel((const void*)mk, dim3(grid_blocks), dim3(NTHREADS), args, LDS_BYTES, stream);
  if (e != hipSuccess) fprintf(stderr, "cooperative launch failed: %s (grid %d)\n", hipGetErrorString(e), grid_blocks);
  if (PROBE_REP >= 0) {
    Params q = p;
    q.out = (float*)((unsigned char*)d_ws + WS_END); q.ph_lo = PROBE_REP; q.ph_hi = PROBE_REP + 1; q.pad = 1;
    void* args2[] = {&q};
    (void)hipLaunchCooperativeKernel((const void*)mk, dim3(grid_blocks), dim3(NTHREADS), args2, LDS_BYTES, stream);
  }
}
```
